# Optimizing an MI355X kernel written in HIP

```python
import math
import jax
import jax.numpy as jnp
from jax import lax
import numpy as np

D_MODEL = 1024
BATCH = 8
SEQ = 4096
DEPTH = 2
DEC_BATCH = 8
DEC_SEQ = 64
PAST_LEN = 1024

CHUNK = 64
N_META = 16
N_EVEN = (DEPTH + 1) // 2
N_ODD = DEPTH // 2
A_HEADS = 4
A_DK = 128
A_WIDTH = D_MODEL // 2
A_DV = A_WIDTH // A_HEADS
A_QK = A_HEADS * A_DK
B_WIDTH = D_MODEL - A_WIDTH
S5_GROUP = 16
S5_GROUPS = B_WIDTH // S5_GROUP
S5_STATE = 64
EVEN_IN = 2 * A_QK + 2 * A_WIDTH + B_WIDTH
C_HEADS = 8
C_HD = D_MODEL // C_HEADS
C_WIDTH = C_HEADS * C_HD
SB_BLOCK = 128
D_FF = 4 * D_MODEL
EPS = 1e-6
DT_MIN = 1e-3
DT_MAX = 1e-1

kernel_name = 'hybrid_streaming_encoder_step'


def rmsnorm(x, g):
    xf = x.astype(jnp.float32)
    r = lax.rsqrt(jnp.mean(xf * xf, axis=-1, keepdims=True) + EPS)
    return (xf * r * g.astype(jnp.float32)).astype(x.dtype)


def heads(a, n):
    b, t, w = a.shape
    return a.reshape(b, t, n, w // n).transpose(0, 2, 1, 3)


def sq_relu_mlp(h, w_up, w_down):
    return jnp.square(jax.nn.relu(h @ w_up)) @ w_down


def hgrn_chunk(S0, q, k, logf, iv):
    L = q.shape[2]
    b = jnp.cumsum(logf, axis=2)
    causal = jnp.tril(jnp.ones((L, L), dtype=bool))[:, :, None]
    diff = b[:, :, :, None, :] - b[:, :, None, :, :]
    dec = jnp.where(causal, jnp.exp(jnp.where(causal, diff, 0.0)), 0.0)
    att = jnp.einsum('bhtsd,bhtd,bhsd->bhts', dec, q, k)
    o = (jnp.einsum('bhts,bhsv->bhtv', att, iv)
         + jnp.einsum('bhtd,bhdv->bhtv', q * jnp.exp(b), S0))
    b_last = b[:, :, -1]
    S = (jnp.exp(b_last)[..., None] * S0
         + jnp.einsum('bhsd,bhsv->bhdv', k * jnp.exp(b_last[:, :, None] - b), iv))
    return S, o


def hgrn_recur(q, k, logf, iv, S0, n_lead):
    S, o_lead = hgrn_chunk(S0, q[:, :, :n_lead], k[:, :, :n_lead], logf[:, :, :n_lead], iv[:, :, :n_lead])
    bsz, nh, T, _ = q.shape
    rest = T - n_lead
    if rest == 0:
        return o_lead, S
    nc = rest // CHUNK

    def to_chunks(a):
        return a[:, :, n_lead:].reshape(bsz, nh, nc, CHUNK, a.shape[-1]).transpose(2, 0, 1, 3, 4)

    def step(S_c, xs):
        return hgrn_chunk(S_c, xs[0], xs[1], xs[2], xs[3])

    S, o_rest = lax.scan(step, S, (to_chunks(q), to_chunks(k), to_chunks(logf), to_chunks(iv)))
    o_rest = o_rest.transpose(1, 2, 0, 3, 4).reshape(bsz, nh, rest, iv.shape[-1])
    return jnp.concatenate([o_lead, o_rest], axis=2), S


def cplx_scan(a_re, a_im, b_re, b_im):
    def combine(e1, e2):
        a1r, a1i, b1r, b1i = e1
        a2r, a2i, b2r, b2i = e2
        return (a2r * a1r - a2i * a1i,
                a2r * a1i + a2i * a1r,
                a2r * b1r - a2i * b1i + b2r,
                a2r * b1i + a2i * b1r + b2i)
    _, _, x_re, x_im = lax.associative_scan(combine, (a_re, a_im, b_re, b_im), axis=0)
    return x_re, x_im


def s5_mix(u, a_re, a_im, log_dt, b_re, b_im, c_re, c_im, d_skip, x0_re, x0_im):
    bsz, T, _ = u.shape
    f32 = jnp.float32
    uf = u.astype(f32).reshape(bsz, T, S5_GROUPS, S5_GROUP)
    ar = a_re.astype(f32)
    ai = a_im.astype(f32)
    dt = jnp.exp(log_dt.astype(f32))[:, None]
    mag = jnp.exp(dt * ar)
    abar_re = mag * jnp.cos(dt * ai)
    abar_im = mag * jnp.sin(dt * ai)
    den = ar * ar + ai * ai
    zr = ((abar_re - 1.0) * ar + abar_im * ai) / den
    zi = (abar_im * ar - (abar_re - 1.0) * ai) / den
    br = b_re.astype(f32)
    bi = b_im.astype(f32)
    bbar_re = zr[..., None] * br - zi[..., None] * bi
    bbar_im = zr[..., None] * bi + zi[..., None] * br
    bu_re = jnp.einsum('btgp,gnp->btgn', uf, bbar_re)
    bu_im = jnp.einsum('btgp,gnp->btgn', uf, bbar_im)
    if x0_re is not None:
        x0r = x0_re.astype(f32)
        x0i = x0_im.astype(f32)
        bu_re = bu_re.at[:, 0].add(abar_re * x0r - abar_im * x0i)
        bu_im = bu_im.at[:, 0].add(abar_re * x0i + abar_im * x0r)
    a_seq_re = jnp.broadcast_to(abar_re, (T, S5_GROUPS, S5_STATE))
    a_seq_im = jnp.broadcast_to(abar_im, (T, S5_GROUPS, S5_STATE))
    xs_re, xs_im = jax.vmap(cplx_scan, in_axes=(None, None, 0, 0))(a_seq_re, a_seq_im, bu_re, bu_im)
    y = (jnp.einsum('btgn,gpn->btgp', xs_re, c_re.astype(f32))
         - jnp.einsum('btgn,gpn->btgp', xs_im, c_im.astype(f32))
         + d_skip.astype(f32) * uf)
    return y.reshape(bsz, T, B_WIDTH), xs_re[:, -1], xs_im[:, -1]


def even_mixer(h, S0, x0_re, x0_im, n_lead, w_in, lb, g_norm, a_re, a_im, log_dt,
               b_re, b_im, c_re, c_im, d_skip, w_glu, w_out):
    bsz, T, _ = h.shape
    f32 = jnp.float32
    p = h @ w_in
    q, zf, iv, g, u = jnp.split(p, [A_QK, 2 * A_QK, 2 * A_QK + A_WIDTH, 2 * A_QK + 2 * A_WIDTH], axis=-1)
    fgate = lb + (1.0 - lb) * jax.nn.sigmoid(zf.astype(f32))
    logf = jnp.log(fgate)
    kk = 1.0 - fgate
    o_a, S = hgrn_recur(heads(q.astype(f32), A_HEADS), heads(kk, A_HEADS), heads(logf, A_HEADS),
                        heads(iv.astype(f32), A_HEADS), S0.astype(f32), n_lead)
    o_a = rmsnorm(o_a.transpose(0, 2, 1, 3), g_norm).reshape(bsz, T, A_WIDTH)
    o_a = (o_a * jax.nn.silu(g.astype(f32))).astype(h.dtype)
    y, xr, xi = s5_mix(u, a_re, a_im, log_dt, b_re, b_im, c_re, c_im, d_skip, x0_re, x0_im)
    yg = jax.nn.gelu(y, approximate=False).astype(h.dtype)
    o_b = yg * jax.nn.sigmoid(yg @ w_glu)
    out = jnp.concatenate([o_a, o_b], axis=-1) @ w_out
    return out, S, xr, xi


def sb_attend(q, k, v, q_pos, k_pos):
    z = jnp.einsum('bqhd,bkhd->bhqk', q.astype(jnp.float32), k.astype(jnp.float32)) * (C_HD ** -0.5)
    mask = k_pos[None, :] < q_pos[:, None]
    log_b = jax.nn.log_sigmoid(z)
    log_1mb = jnp.where(mask, log_b - z, 0.0)
    later = lax.cumsum(log_1mb, axis=3, reverse=True) - log_1mb
    w = jnp.where(mask, jnp.exp(log_b + later), 0.0)
    return jnp.einsum('bhqk,bkhd->bqhd', w, v.astype(jnp.float32))


def sb_qkv(h, w_in):
    bsz, T, _ = h.shape
    q, k, v = jnp.split(h @ w_in, 3, axis=-1)
    shp = (bsz, T, C_HEADS, C_HD)
    return q.reshape(shp), k.reshape(shp), v.reshape(shp)


def sb_prompt(h, w_in, w_out):
    bsz, T, _ = h.shape
    q, k, v = sb_qkv(h, w_in)
    pos = jnp.arange(T)
    o_meta = sb_attend(q[:, :N_META], k[:, :N_META], v[:, :N_META], pos[:N_META], pos[:N_META])
    nb = (T - N_META) // SB_BLOCK
    qb = q[:, N_META:].reshape(bsz, nb, SB_BLOCK, C_HEADS, C_HD).transpose(1, 0, 2, 3, 4)
    pb = pos[N_META:].reshape(nb, SB_BLOCK)
    ob = lax.map(lambda a: sb_attend(a[0], k, v, a[1], pos), (qb, pb))
    ob = ob.transpose(1, 0, 2, 3, 4).reshape(bsz, T - N_META, C_HEADS, C_HD)
    o = jnp.concatenate([o_meta, ob], axis=1).reshape(bsz, T, C_WIDTH).astype(h.dtype)
    return o @ w_out, k, v


def sb_sample(h, ck, cv, w_in, w_out):
    bsz, T, _ = h.shape
    past = ck.shape[1]
    q, k, v = sb_qkv(h, w_in)
    k_all = jnp.concatenate([ck.astype(k.dtype), k], axis=1)
    v_all = jnp.concatenate([cv.astype(v.dtype), v], axis=1)
    k_pos = jnp.arange(past + T)
    q_pos = past + jnp.arange(T)
    o = sb_attend(q, k_all, v_all, q_pos, k_pos).reshape(bsz, T, C_WIDTH).astype(h.dtype)
    return o @ w_out, k, v


def setup_inputs(seed: int = 0) -> dict:
    key = jax.random.key(seed)
    ks = jax.random.split(key, 32)
    f32 = jnp.float32
    nrm = lambda k, shp, s: jax.random.normal(k, shp, f32) * s
    n_idx = jnp.arange(S5_STATE, dtype=f32)
    return {
        'x_prompt': nrm(ks[0], (BATCH, SEQ, D_MODEL), 1.0),
        'x_sample': nrm(ks[1], (DEC_BATCH, DEC_SEQ, D_MODEL), 1.0),
        'state_hgrn': nrm(ks[2], (N_EVEN, DEC_BATCH, A_HEADS, A_DK, A_DV), 0.5),
        'state_ssm_re': nrm(ks[3], (N_EVEN, DEC_BATCH, S5_GROUPS, S5_STATE), 0.1),
        'state_ssm_im': nrm(ks[4], (N_EVEN, DEC_BATCH, S5_GROUPS, S5_STATE), 0.1),
        'cache_k': nrm(ks[5], (N_ODD, DEC_BATCH, PAST_LEN, C_HEADS, C_HD), 1.0),
        'cache_v': nrm(ks[6], (N_ODD, DEC_BATCH, PAST_LEN, C_HEADS, C_HD), 1.0),
        'meta_tokens': nrm(ks[7], (N_META, D_MODEL), 1.0),
        'ln_mix': 1.0 + nrm(ks[8], (DEPTH, D_MODEL), 0.01),
        'ln_mlp': 1.0 + nrm(ks[9], (DEPTH, D_MODEL), 0.01),
        'ln_final': 1.0 + nrm(ks[10], (D_MODEL,), 0.01),
        'w_in_even': nrm(ks[11], (N_EVEN, D_MODEL, EVEN_IN), D_MODEL ** -0.5),
        'hgrn_lb': nrm(ks[12], (N_EVEN + 1, A_QK), 1.0),
        'hgrn_norm': 1.0 + nrm(ks[13], (N_EVEN, A_DV), 0.01),
        'ssm_a_re': -0.5 + nrm(ks[14], (N_EVEN, S5_GROUPS, S5_STATE), 0.01),
        'ssm_a_im': math.pi * n_idx + nrm(ks[15], (N_EVEN, S5_GROUPS, S5_STATE), 0.01),
        'ssm_log_dt': jax.random.uniform(ks[16], (N_EVEN, S5_GROUPS), f32, math.log(DT_MIN), math.log(DT_MAX)),
        'ssm_b_re': nrm(ks[17], (N_EVEN, S5_GROUPS, S5_STATE, S5_GROUP), (2 * S5_GROUP) ** -0.5),
        'ssm_b_im': nrm(ks[18], (N_EVEN, S5_GROUPS, S5_STATE, S5_GROUP), (2 * S5_GROUP) ** -0.5),
        'ssm_c_re': nrm(ks[19], (N_EVEN, S5_GROUPS, S5_GROUP, S5_STATE), S5_STATE ** -0.5),
        'ssm_c_im': nrm(ks[20], (N_EVEN, S5_GROUPS, S5_GROUP, S5_STATE), S5_STATE ** -0.5),
        'ssm_d': nrm(ks[21], (N_EVEN, S5_GROUPS, S5_GROUP), 1.0),
        'w_glu': nrm(ks[22], (N_EVEN, B_WIDTH, B_WIDTH), B_WIDTH ** -0.5),
        'w_out_even': nrm(ks[23], (N_EVEN, A_WIDTH + B_WIDTH, D_MODEL), (A_WIDTH + B_WIDTH) ** -0.5),
        'w_in_odd': nrm(ks[24], (N_ODD, D_MODEL, 3 * C_WIDTH), D_MODEL ** -0.5),
        'w_out_odd': nrm(ks[25], (N_ODD, C_WIDTH, D_MODEL), C_WIDTH ** -0.5),
        'w_up': nrm(ks[26], (DEPTH, D_MODEL, D_FF), D_MODEL ** -0.5),
        'w_down': nrm(ks[27], (DEPTH, D_FF, D_MODEL), D_FF ** -0.5),
    }


def reference(x_prompt, x_sample, state_hgrn, state_ssm_re, state_ssm_im, cache_k, cache_v,
              meta_tokens, ln_mix, ln_mlp, ln_final, w_in_even, hgrn_lb, hgrn_norm,
              ssm_a_re, ssm_a_im, ssm_log_dt, ssm_b_re, ssm_b_im, ssm_c_re, ssm_c_im, ssm_d,
              w_glu, w_out_even, w_in_odd, w_out_odd, w_up, w_down):
    bsz = x_prompt.shape[0]
    meta = jnp.broadcast_to(meta_tokens.astype(x_prompt.dtype)[None], (bsz, N_META, D_MODEL))
    xp = jnp.concatenate([meta, x_prompt], axis=1)
    xs = x_sample
    lb_all = jnp.cumsum(jax.nn.softmax(hgrn_lb.astype(jnp.float32), axis=0), axis=0)
    hg_p, hg_s, sr_p, si_p, sr_s, si_s, k_p, v_p, k_s, v_s = [], [], [], [], [], [], [], [], [], []
    for l in range(DEPTH):
        j = l // 2
        hp = rmsnorm(xp, ln_mix[l])
        hs = rmsnorm(xs, ln_mix[l])
        if l % 2 == 0:
            shared = (w_in_even[j], lb_all[j], hgrn_norm[j], ssm_a_re[j], ssm_a_im[j], ssm_log_dt[j],
                      ssm_b_re[j], ssm_b_im[j], ssm_c_re[j], ssm_c_im[j], ssm_d[j], w_glu[j], w_out_even[j])
            S0p = jnp.zeros((bsz, A_HEADS, A_DK, A_DV), jnp.float32)
            op, Sp, xr_p, xi_p = even_mixer(hp, S0p, None, None, N_META, *shared)
            os_, Ss, xr_s, xi_s = even_mixer(hs, state_hgrn[j], state_ssm_re[j], state_ssm_im[j],
                                             xs.shape[1], *shared)
            hg_p.append(Sp)
            hg_s.append(Ss)
            sr_p.append(xr_p)
            si_p.append(xi_p)
            sr_s.append(xr_s)
            si_s.append(xi_s)
        else:
            op, kp, vp = sb_prompt(hp, w_in_odd[j], w_out_odd[j])
            os_, ks_, vs_ = sb_sample(hs, cache_k[j], cache_v[j], w_in_odd[j], w_out_odd[j])
            k_p.append(kp)
            v_p.append(vp)
            k_s.append(ks_)
            v_s.append(vs_)
        xp = xp + op
        xs = xs + os_
        xp = xp + sq_relu_mlp(rmsnorm(xp, ln_mlp[l]), w_up[l], w_down[l])
        xs = xs + sq_relu_mlp(rmsnorm(xs, ln_mlp[l]), w_up[l], w_down[l])
    y_prompt = rmsnorm(xp[:, N_META:], ln_final)
    y_sample = rmsnorm(xs, ln_final)
    new_hgrn_prompt = jnp.stack(hg_p, 0)
    new_hgrn_sample = jnp.stack(hg_s, 0)
    new_ssm_re_prompt = jnp.stack(sr_p, 0)
    new_ssm_im_prompt = jnp.stack(si_p, 0)
    new_ssm_re_sample = jnp.stack(sr_s, 0)
    new_ssm_im_sample = jnp.stack(si_s, 0)
    new_k_prompt = jnp.stack(k_p, 0)
    new_v_prompt = jnp.stack(v_p, 0)
    new_k_sample = jnp.stack(k_s, 0)
    new_v_sample = jnp.stack(v_s, 0)
    return (y_prompt, y_sample, new_hgrn_prompt, new_hgrn_sample, new_ssm_re_prompt, new_ssm_im_prompt,
            new_ssm_re_sample, new_ssm_im_sample, new_k_prompt, new_v_prompt, new_k_sample, new_v_sample)
```

```cpp
#include <hip/hip_runtime.h>
#include <hip/hip_cooperative_groups.h>
#include <cstdio>
#include <cstdint>
namespace cg = cooperative_groups;
namespace pg8 {
#define PG8_LAS __attribute__((address_space(3)))
typedef unsigned short bf16_t;
typedef short bf16x8 __attribute__((ext_vector_type(8)));
typedef float f32x4 __attribute__((ext_vector_type(4)));
typedef unsigned u32x4 __attribute__((ext_vector_type(4)));
constexpr int BM = 256, BK = 64, HALF = 128, HTB = HALF * BK * 2  , STAGE_BYTES = 8 * HTB, NXCD = 8, WGM = 8;

__host__ __device__ __forceinline__ int lds_byte(int r, int c) { const int st = (r >> 4) * 2 + (c >> 5), rr = r & 15, cc = c & 31, ob = rr * 64 + cc * 2; return st * 1024 + (ob ^ (((ob >> 9) & 1) << 5)); }
__host__ __device__ __forceinline__ void stage_rc(int b, int& R, int& C) { const int st = b / 1024, sb = b % 1024, swz = sb ^ (((sb >> 9) & 1) << 5); R = (st >> 1) * 16 + swz / 64; C = (st & 1) * 32 + (swz % 64) / 2; }
__host__ __device__ __forceinline__ int perm32(int rho) { const int n = rho >> 4, i = rho & 15; return 8 * (i >> 2) + 4 * n + (i & 3); }

struct Unit { int pm, pn; };
struct Gemm { const bf16_t* A; const bf16_t* Bt; int M, N, K; };

struct StaticOrder {
    int nM, nN, nwg, G, c;
    __host__ __device__ void init(int M, int N, int G_, int c_) { nM = M / BM; nN = N / BM; nwg = nM * nN; G = G_; c = c_; }
    __host__ __device__ bool next(int i, Unit& u) const {
        const long L = (long)i * G + c; if (L >= nwg) return false;
        int wgid = (int)L; { const int q = nwg / NXCD, r = nwg % NXCD, xcd = wgid % NXCD, off = wgid / NXCD; wgid = (xcd < r ? xcd * (q + 1) : r * (q + 1) + (xcd - r) * q) + off; }
        const int nig = WGM * nN, gid = wgid / nig, fm = gid * WGM, gsz = (nM - fm) < WGM ? (nM - fm) : WGM;
        u.pm = fm + ((wgid % nig) % gsz); u.pn = (wgid % nig) / gsz; return true;
    }
    __device__ __forceinline__ void a_ready(const Unit&) const {}
    __device__ __forceinline__ void done(const Unit&) const {}
};
template <class Epi, class Sched>
__device__ __forceinline__ void gemm_phase(PG8_LAS unsigned char* lds, const Gemm g, const Sched& S, const Epi& E) {
    const int tid = threadIdx.x, wid = __builtin_amdgcn_readfirstlane(tid >> 6), lane = tid & 63, wr = wid >> 2, wc = wid & 3, fr = lane & 15, fq = lane >> 4;
    const int K = g.K, nt = K / BK;
    unsigned voffA[2], voffB[2];
#pragma unroll
    for (int i = 0; i < 2; ++i) { int R, C; stage_rc(tid * 16 + i * 8192, R, C); const int Rb = Epi::PERM ? ((R & ~31) + perm32(R & 31)) : R;
        voffA[i] = (unsigned)(R * K + C) * 2u; voffB[i] = (unsigned)(Rb * K + C) * 2u; }
    const size_t kstep = (size_t)(BK * 2);
    const size_t hstep = (size_t)HALF * K * 2;
    const size_t tstep = 2 * hstep;
    const unsigned ldsw = (unsigned)wid * 1024u;
    const int aoff = lds_byte(wr * 64 + fr, fq * 8), boff = lds_byte(wc * 32 + fr, fq * 8);
#define PG8_SA(b, h) (((b) * 2 + (h)) * HTB)
#define PG8_SB(b, h) ((4 + (b) * 2 + (h)) * HTB)
#define PG8_STAGE(bufoff, gbase, voff) do { _Pragma("unroll") for (int _i = 0; _i < 2; ++_i) \
        __builtin_amdgcn_global_load_lds((const unsigned*)((const char*)(gbase) + (voff)[_i]), (PG8_LAS unsigned*)(lds + (bufoff) + ldsw + _i * 8192), 16, 0, 0); } while (0)
#define PG8_LDA(dst, b, h) do { _Pragma("unroll") for (int m = 0; m < 4; ++m) _Pragma("unroll") for (int k = 0; k < 2; ++k) dst[m][k] = *(const PG8_LAS bf16x8*)(lds + PG8_SA(b, h) + aoff + m * 2048 + k * 1024); } while (0)
#define PG8_LDB(dst, b, h) do { _Pragma("unroll") for (int n = 0; n < 2; ++n) _Pragma("unroll") for (int k = 0; k < 2; ++k) dst[n][k] = *(const PG8_LAS bf16x8*)(lds + PG8_SB(b, h) + boff + n * 2048 + k * 1024); } while (0)
#define PG8_MMA(ai, bj, At, Bt) do { __builtin_amdgcn_s_setprio(1); _Pragma("unroll") for (int m = 0; m < 4; ++m) _Pragma("unroll") for (int n = 0; n < 2; ++n) _Pragma("unroll") for (int k = 0; k < 2; ++k) \
        acc[ai][bj][m][n] = __builtin_amdgcn_mfma_f32_16x16x32_bf16(Bt[n][k], At[m][k], acc[ai][bj][m][n], 0, 0, 0); __builtin_amdgcn_s_setprio(0); } while (0)
#define PG8_WAIT_V(n) asm volatile("s_waitcnt vmcnt(" #n ")" ::: "memory")
#define PG8_WAIT_L(n) asm volatile("s_waitcnt lgkmcnt(" #n ")" ::: "memory")
#define PG8_BAR __builtin_amdgcn_s_barrier()
#define PG8_SCHED __builtin_amdgcn_sched_barrier(0)
    Unit cur, nxt; int ui = 0;
    if (!S.next(0, cur)) return;
    f32x4 acc[2][2][4][2];
#pragma unroll
    for (int a = 0; a < 2; ++a)
#pragma unroll
        for (int b = 0; b < 2; ++b)
#pragma unroll
            for (int m = 0; m < 4; ++m)
#pragma unroll
                for (int n = 0; n < 2; ++n) acc[a][b][m][n] = (f32x4){0.f, 0.f, 0.f, 0.f};
    bf16x8 At[4][2], B0[2][2], B1[2][2];
    const char* cA = (const char*)g.A + (size_t)cur.pm * tstep; const char* cB = (const char*)g.Bt + (size_t)cur.pn * tstep;
    S.a_ready(cur);
    PG8_STAGE(PG8_SB(0, 0), cB, voffB); PG8_STAGE(PG8_SA(0, 0), cA, voffA); PG8_STAGE(PG8_SB(0, 1), cB + hstep, voffB); PG8_STAGE(PG8_SA(0, 1), cA + hstep, voffA);
    if (wr == 1) PG8_BAR;
    PG8_WAIT_V(4); PG8_BAR;
    PG8_STAGE(PG8_SB(1, 0), cB + kstep, voffB); PG8_STAGE(PG8_SA(1, 0), cA + kstep, voffA); PG8_STAGE(PG8_SB(1, 1), cB + hstep + kstep, voffB);
    PG8_WAIT_V(6); PG8_BAR;
    for (;;) {
        const bool has_next = S.next(ui + 1, nxt);
        const char* nA = has_next ? (const char*)g.A + (size_t)nxt.pm * tstep : cA; const char* nB = has_next ? (const char*)g.Bt + (size_t)nxt.pn * tstep : cB;
        for (int t = 0; t < nt; t += 2) {
            const bool last = (t == nt - 2);
            const char* a1 = cA + (size_t)(t + 1) * kstep;
            const char* a2 = last ? nA : cA + (size_t)(t + 2) * kstep; const char* b2 = last ? nB : cB + (size_t)(t + 2) * kstep;
            const char* a3 = a2 + kstep; const char* b3 = b2 + kstep;
            if (last && has_next) S.a_ready(nxt);
            PG8_LDB(B0, 0, 0); PG8_SCHED; PG8_LDA(At, 0, 0); PG8_STAGE(PG8_SA(1, 1), a1 + hstep, voffA);
            PG8_WAIT_L(8); PG8_BAR; PG8_WAIT_L(0); PG8_MMA(0, 0, At, B0); PG8_BAR; PG8_SCHED;
            PG8_LDB(B1, 0, 1); PG8_STAGE(PG8_SB(0, 0), b2, voffB);
            PG8_BAR; PG8_WAIT_L(0); PG8_MMA(0, 1, At, B1); PG8_BAR;
            PG8_LDA(At, 0, 1); PG8_STAGE(PG8_SA(0, 0), a2, voffA);
            PG8_BAR; PG8_WAIT_L(0); PG8_MMA(1, 0, At, B0); PG8_BAR; PG8_SCHED;
            PG8_STAGE(PG8_SB(0, 1), b2 + hstep, voffB);
            PG8_WAIT_V(6); PG8_BAR; PG8_MMA(1, 1, At, B1); PG8_BAR;
            PG8_LDB(B0, 1, 0); PG8_SCHED; PG8_LDA(At, 1, 0); PG8_STAGE(PG8_SA(0, 1), a2 + hstep, voffA);
            PG8_WAIT_L(8); PG8_BAR; PG8_WAIT_L(0); PG8_MMA(0, 0, At, B0); PG8_BAR; PG8_SCHED;
            PG8_LDB(B1, 1, 1); PG8_STAGE(PG8_SB(1, 0), b3, voffB);
            PG8_BAR; PG8_WAIT_L(0); PG8_MMA(0, 1, At, B1); PG8_BAR;
            PG8_LDA(At, 1, 1); PG8_STAGE(PG8_SA(1, 0), a3, voffA);
            PG8_BAR; PG8_WAIT_L(0); PG8_MMA(1, 0, At, B0); PG8_BAR; PG8_SCHED;
            PG8_STAGE(PG8_SB(1, 1), b3 + hstep, voffB);
            PG8_WAIT_V(6); PG8_BAR; PG8_MMA(1, 1, At, B1); PG8_BAR;
        }
        if constexpr (!Epi::AFTER_DRAIN) { E(acc, cur, wr, wc, fr, fq); S.done(cur); }
        if (!has_next) break;
#pragma unroll
        for (int a = 0; a < 2; ++a)
#pragma unroll
            for (int b = 0; b < 2; ++b)
#pragma unroll
                for (int m = 0; m < 4; ++m)
#pragma unroll
                    for (int n = 0; n < 2; ++n) acc[a][b][m][n] = (f32x4){0.f, 0.f, 0.f, 0.f};
        cur = nxt; cA = nA; cB = nB; ++ui;
    }
    PG8_WAIT_V(0);
    if (wr == 0) PG8_BAR;
    PG8_BAR;
    if constexpr (Epi::AFTER_DRAIN) { E.fused(acc, cur, wr, wc, fr, fq, lds, wid, lane); S.done(cur); }
#undef PG8_SA
#undef PG8_SB
#undef PG8_STAGE
#undef PG8_LDA
#undef PG8_LDB
#undef PG8_MMA
#undef PG8_WAIT_V
#undef PG8_WAIT_L
#undef PG8_BAR
#undef PG8_SCHED
}
}
using pg8::bf16_t; using pg8::bf16x8; using pg8::f32x4; using pg8::Unit;
typedef float f32x16 __attribute__((ext_vector_type(16)));
typedef float f32x2v __attribute__((ext_vector_type(2)));
typedef unsigned u32x2 __attribute__((ext_vector_type(2)));
typedef unsigned u32x4v __attribute__((ext_vector_type(4)));
#define LAS __attribute__((address_space(3)))
#define DI __device__ __forceinline__

constexpr int DM = 1024, TP = 4112, NTP = 8 * TP  , NTS = 512, NT = NTP + NTS  , MP = 33536  ;
constexpr int NITEM_H = 2112;
constexpr int NCOL = NT / 16;
constexpr float EPSN = 1e-6f;
constexpr size_t O_YP = 0, O_YS = O_YP + (size_t)8 * 4096 * 1024, O_HGP = O_YS + 524288, O_HGS = O_HGP + 524288, O_SRP = O_HGS + 524288, O_SIP = O_SRP + 16384,
                 O_SRS = O_SIP + 16384, O_SIS = O_SRS + 16384, O_KP = O_SIS + 16384, O_VP = O_KP + (size_t)NTP * 1024, O_KS = O_VP + (size_t)NTP * 1024, O_VS = O_KS + 524288, O_END = O_VS + 524288;

struct Prm {
    const float *x_prompt, *x_sample, *state_hgrn, *ssm_re0, *ssm_im0, *cache_k, *cache_v, *meta, *ln_mix, *ln_mlp, *ln_final, *w_in_even, *hgrn_lb, *hgrn_norm,
        *a_re, *a_im, *log_dt, *b_re, *b_im, *c_re, *c_im, *ssm_d, *w_glu, *w_out_even, *w_in_odd, *w_out_odd, *w_up, *w_down;
    float* out;
    bf16_t *Wt1, *Wglu, *Wo0, *Wup0, *Wdn0, *Wqkv, *Wo1, *Wup1, *Wdn1;
    bf16_t* XB; float* SSQ; float* LB; float* KTAB; bf16_t* TG; bf16_t* HT; float* A16;
    bf16_t *Qh, *IV, *GS, *U; unsigned short* LOGF; bf16_t* UT; float* AL; float* XLOC; bf16_t* XPREV; bf16_t* YG; bf16_t* CAT;
    bf16_t* H;
    bf16_t *Q, *KP, *KS, *VTP, *VTS, *O;
};

DI unsigned pk2(float lo, float hi) { unsigned r; asm volatile("v_cvt_pk_bf16_f32 %0, %1, %2" : "=v"(r) : "v"(lo), "v"(hi)); return r; }
DI float bflo(unsigned u) { return __uint_as_float(u << 16); }
DI float bfhi(unsigned u) { return __uint_as_float(u & 0xffff0000u); }
DI float bf2f(unsigned short b) { return __uint_as_float(((unsigned)b) << 16); }
DI unsigned short f2bf(float f) { return (unsigned short)(pk2(f, 0.f) & 0xffffu); }
DI unsigned pkh2(float lo, float hi) { union { _Float16 h[2]; unsigned u; } x; x.h[0] = (_Float16)lo; x.h[1] = (_Float16)hi; return x.u; }
DI float h2f(unsigned short h) { union { unsigned short s; _Float16 h; } x; x.s = h; return (float)x.h; }
DI float wave_sum(float v) {
#pragma unroll
    for (int o = 1; o < 64; o <<= 1) v += __shfl_xor(v, o);
    return v;
}
DI float fexp(float x) { return __expf(x); }
DI float sigm(float x) { return __builtin_amdgcn_rcpf(1.f + __expf(-x)); }
DI float row_rinv(const float* SSQ, int row) {
    const f32x4* s = (const f32x4*)(SSQ + (size_t)row * 16); f32x4 a = s[0] + s[1] + s[2] + s[3];
    return rsqrtf(((a.x + a.y) + (a.z + a.w)) * (1.f / 1024.f) + EPSN);
}
#define LDS_WAIT() asm volatile("s_waitcnt lgkmcnt(0)" ::: "memory")

struct EpiIn0 {
    static constexpr bool PERM = false, AFTER_DRAIN = false;
    const float* SSQ; const float* LB; bf16_t *Qh, *IV, *GS, *U; unsigned short* LOGF;
    DI void operator()(const f32x4 (&acc)[2][2][4][2], const Unit& u, int wr, int wc, int fr, int fq) const {
        const int seg = u.pn >> 1, cb = (u.pn & 1) * 256 + wc * 32 + 4 * fq, row0 = u.pm * 256 + wr * 64 + fr;
        unsigned short* dst = seg == 0 ? Qh : seg == 1 ? LOGF : seg == 2 ? IV : seg == 3 ? GS : U;
#pragma unroll
        for (int ai = 0; ai < 2; ++ai)
#pragma unroll
            for (int m = 0; m < 4; ++m) { const int row = row0 + ai * 128 + m * 16; const float r = row_rinv(SSQ, row);
#pragma unroll
                for (int bj = 0; bj < 2; ++bj)
#pragma unroll
                    for (int n = 0; n < 2; ++n) { const int cs = cb + bj * 128 + n * 16; f32x4 v = acc[ai][bj][m][n] * r; u32x2 o;
                        if (seg == 1) { const f32x4 lb = *(const f32x4*)(LB + cs); f32x4 f;
#pragma unroll
                            for (int e = 0; e < 4; ++e) f[e] = __logf(lb[e] + (1.f - lb[e]) * sigm(v[e]));
                            o.x = pkh2(f[0], f[1]); o.y = pkh2(f[2], f[3]); }
                        else { if (seg == 3) {
#pragma unroll
                                for (int e = 0; e < 4; ++e) v[e] = v[e] * sigm(v[e]); }
                            o.x = pk2(v[0], v[1]); o.y = pk2(v[2], v[3]); }
                        *(u32x2*)(dst + (size_t)row * 512 + cs) = o; } }
    }
};
struct EpiGlu {
    static constexpr bool PERM = false, AFTER_DRAIN = false;
    const bf16_t* YG; bf16_t* CAT;
    DI void operator()(const f32x4 (&acc)[2][2][4][2], const Unit& u, int wr, int wc, int fr, int fq) const {
        const int cb = u.pn * 256 + wc * 32 + 4 * fq, row0 = u.pm * 256 + wr * 64 + fr;
#pragma unroll
        for (int ai = 0; ai < 2; ++ai)
#pragma unroll
            for (int m = 0; m < 4; ++m) { const int row = row0 + ai * 128 + m * 16;
#pragma unroll
                for (int bj = 0; bj < 2; ++bj)
#pragma unroll
                    for (int n = 0; n < 2; ++n) { const int cs = cb + bj * 128 + n * 16; const f32x4 v = acc[ai][bj][m][n];
                        const u32x2 y = *(const u32x2*)(YG + (size_t)row * 512 + cs); u32x2 o;
                        o.x = pk2(bflo(y.x) * sigm(v[0]), bfhi(y.x) * sigm(v[1])); o.y = pk2(bflo(y.y) * sigm(v[2]), bfhi(y.y) * sigm(v[3]));
                        *(u32x2*)(CAT + (size_t)row * 1024 + 512 + cs) = o; } }
    }
};
struct EpiRes {
    static constexpr bool PERM = false, AFTER_DRAIN = false;
    bf16_t* XB; float* SSQ;
    DI void operator()(const f32x4 (&acc)[2][2][4][2], const Unit& u, int wr, int wc, int fr, int fq) const {
        const int cb = u.pn * 256 + wc * 32 + 4 * fq, row0 = u.pm * 256 + wr * 64 + fr;
#pragma unroll
        for (int ai = 0; ai < 2; ++ai)
#pragma unroll
            for (int m = 0; m < 4; ++m) { const int row = row0 + ai * 128 + m * 16; float ss = 0.f;
#pragma unroll
                for (int bj = 0; bj < 2; ++bj)
#pragma unroll
                    for (int n = 0; n < 2; ++n) { const int cs = cb + bj * 128 + n * 16; const f32x4 v = acc[ai][bj][m][n];
                        u32x2* px = (u32x2*)(XB + (size_t)row * 1024 + cs); const u32x2 x = *px; u32x2 o;
                        o.x = pk2(bflo(x.x) + v[0], bfhi(x.x) + v[1]); o.y = pk2(bflo(x.y) + v[2], bfhi(x.y) + v[3]); *px = o;
                        const float a0 = bflo(o.x), a1 = bfhi(o.x), a2 = bflo(o.y), a3 = bfhi(o.y); ss += (a0 * a0 + a1 * a1) + (a2 * a2 + a3 * a3); }
                ss += __shfl_xor(ss, 16); ss += __shfl_xor(ss, 32);
                if (fq == 0) SSQ[(size_t)row * 16 + u.pn * 4 + wc] = ss; }
    }
};
struct EpiUp {
    static constexpr bool PERM = false, AFTER_DRAIN = false;
    const float* SSQ; bf16_t* H;
    DI void operator()(const f32x4 (&acc)[2][2][4][2], const Unit& u, int wr, int wc, int fr, int fq) const {
        const int cb = u.pn * 256 + wc * 32 + 4 * fq, row0 = u.pm * 256 + wr * 64 + fr;
#pragma unroll
        for (int ai = 0; ai < 2; ++ai)
#pragma unroll
            for (int m = 0; m < 4; ++m) { const int row = row0 + ai * 128 + m * 16; const float r = row_rinv(SSQ, row);
#pragma unroll
                for (int bj = 0; bj < 2; ++bj)
#pragma unroll
                    for (int n = 0; n < 2; ++n) { const int cs = cb + bj * 128 + n * 16; f32x4 v = acc[ai][bj][m][n] * r;
#pragma unroll
                        for (int e = 0; e < 4; ++e) { const float t = fmaxf(v[e], 0.f); v[e] = t * t; }
                        u32x2 o; o.x = pk2(v[0], v[1]); o.y = pk2(v[2], v[3]); *(u32x2*)(H + (size_t)row * 4096 + cs) = o; } }
    }
};
struct EpiQkv {
    static constexpr bool PERM = false, AFTER_DRAIN = false;
    const float* SSQ; float* out; bf16_t *Q, *KP, *KS, *VTP, *VTS;
    DI void operator()(const f32x4 (&acc)[2][2][4][2], const Unit& u, int wr, int wc, int fr, int fq) const {
        const int third = u.pn >> 2, cb = (u.pn & 3) * 256 + wc * 32 + 4 * fq, row0 = u.pm * 256 + wr * 64 + fr;
#pragma unroll
        for (int ai = 0; ai < 2; ++ai)
#pragma unroll
            for (int m = 0; m < 4; ++m) { const int row = row0 + ai * 128 + m * 16; const float r = row_rinv(SSQ, row);
                const bool smp = row >= NTP; const int s = row - NTP; const int srow = (s >> 6) * 1088 + 1024 + (s & 63);
#pragma unroll
                for (int bj = 0; bj < 2; ++bj)
#pragma unroll
                    for (int n = 0; n < 2; ++n) { const int cs = cb + bj * 128 + n * 16; const f32x4 v = acc[ai][bj][m][n] * r;
                        u32x2 o; o.x = pk2(v[0], v[1]); o.y = pk2(v[2], v[3]);
                        if (third == 0) { *(u32x2*)(Q + (size_t)row * 1024 + cs) = o; }
                        else if (row < NT) {
                            if (third == 1) { *(f32x4*)(out + (smp ? O_KS + (size_t)s * 1024 : O_KP + (size_t)row * 1024) + cs) = v;
                                *(u32x2*)((smp ? KS + (size_t)srow * 1024 : KP + (size_t)row * 1024) + cs) = o; }
                            else { *(f32x4*)(out + (smp ? O_VS + (size_t)s * 1024 : O_VP + (size_t)row * 1024) + cs) = v;
                                bf16_t* vt = smp ? VTS + (size_t)cs * 8704 + srow : VTP + (size_t)cs * NTP + row; const size_t vp = smp ? 8704 : NTP;
                                vt[0] = (bf16_t)(o.x & 0xffffu); vt[vp] = (bf16_t)(o.x >> 16); vt[2 * vp] = (bf16_t)(o.y & 0xffffu); vt[3 * vp] = (bf16_t)(o.y >> 16); } } } }
    }
};
struct EpiFin {
    static constexpr bool PERM = false, AFTER_DRAIN = false;
    const bf16_t* XB; float* SSQ; float* out;
    DI void operator()(const f32x4 (&acc)[2][2][4][2], const Unit& u, int wr, int wc, int fr, int fq) const {
        const int cb = u.pn * 256 + wc * 32 + 4 * fq, row0 = u.pm * 256 + wr * 64 + fr;
#pragma unroll
        for (int ai = 0; ai < 2; ++ai)
#pragma unroll
            for (int m = 0; m < 4; ++m) { const int row = row0 + ai * 128 + m * 16; float ss = 0.f;
                const int b = row / TP, t = row - b * TP; const bool ok = row < NT && (row >= NTP || t >= 16);
                float* dst = out + (row >= NTP ? O_YS + (size_t)(row - NTP) * 1024 : O_YP + ((size_t)b * 4096 + (t - 16)) * 1024);
#pragma unroll
                for (int bj = 0; bj < 2; ++bj)
#pragma unroll
                    for (int n = 0; n < 2; ++n) { const int cs = cb + bj * 128 + n * 16; f32x4 v = acc[ai][bj][m][n];
                        const u32x2 x = *(const u32x2*)(XB + (size_t)row * 1024 + cs);
                        v[0] += bflo(x.x); v[1] += bfhi(x.x); v[2] += bflo(x.y); v[3] += bfhi(x.y);
                        if (ok) *(f32x4*)(dst + cs) = v;
                        ss += (v[0] * v[0] + v[1] * v[1]) + (v[2] * v[2] + v[3] * v[3]); }
                ss += __shfl_xor(ss, 16); ss += __shfl_xor(ss, 32);
                if (fq == 0) SSQ[(size_t)row * 16 + u.pn * 4 + wc] = ss; }
    }
};
template <class Epi> DI void run_gemm(LAS unsigned char* lds, const bf16_t* A, const bf16_t* Bt, int N, int K, const Epi& E) {
    pg8::Gemm g; g.A = A; g.Bt = Bt; g.M = MP; g.N = N; g.K = K;
    pg8::StaticOrder S; S.init(MP, N, (int)gridDim.x, (int)blockIdx.x);
    pg8::gemm_phase<Epi, pg8::StaticOrder>(lds, g, S, E);
}
DI void transpose_item(const float* W, int N, bf16_t* WT, size_t ldo, const float* sc, LAS float* scr, int item, int lane) {
    const int nblk = N / 32, kb = item / nblk, nb = item % nblk, k0 = 64 * kb, n0 = 32 * nb;
#pragma unroll 8
    for (int i = 0; i < 32; ++i) { const int kk = 2 * i + (lane >> 5); float w = W[(size_t)(k0 + kk) * N + n0 + (lane & 31)]; if (sc) w *= sc[k0 + kk]; scr[kk * 33 + (lane & 31)] = w; }
    LDS_WAIT();
    const int c = lane & 7;
#pragma unroll
    for (int j = 0; j < 4; ++j) { const int n = (lane >> 3) + 8 * j; const LAS float* s = scr + (8 * c) * 33 + n;
        u32x4v o; o.x = pk2(s[0 * 33], s[1 * 33]); o.y = pk2(s[2 * 33], s[3 * 33]); o.z = pk2(s[4 * 33], s[5 * 33]); o.w = pk2(s[6 * 33], s[7 * 33]);
        *(u32x4v*)(WT + (size_t)(n0 + n) * ldo + k0 + 8 * c) = o; }
    LDS_WAIT();
}
DI void s5_pow(const Prm& p, int g, int n, float k, float& re, float& im) {
    const float dt = __expf(p.log_dt[g]), ar = p.a_re[g * 64 + n], ai = p.a_im[g * 64 + n];
    const float mag = __expf(k * dt * ar); float rev = k * dt * ai * 0.15915494309189535f; rev -= rintf(rev);
    re = mag * __builtin_amdgcn_cosf(rev); im = mag * __builtin_amdgcn_sinf(rev);
}
DI void s5_bbar(const Prm& p, int g, int n, int pp, float& re, float& im) {
    const float ar = p.a_re[g * 64 + n], ai = p.a_im[g * 64 + n]; float abr, abi; s5_pow(p, g, n, 1.f, abr, abi);
    const float den = ar * ar + ai * ai, zr = ((abr - 1.f) * ar + abi * ai) / den, zi = (abi * ar - (abr - 1.f) * ai) / den;
    const float br = p.b_re[(g * 64 + n) * 16 + pp], bi = p.b_im[(g * 64 + n) * 16 + pp];
    re = zr * br - zi * bi; im = zr * bi + zi * br;
}
DI void phase_prologue(const Prm& p, LAS unsigned char* lds, int tid, int lane, int wave) {
    const int gw = blockIdx.x * 8 + wave, NGW = gridDim.x * 8, gtid = blockIdx.x * 512 + tid, GT = gridDim.x * 512;
    LAS float* scr = (LAS float*)(lds + wave * 16384);
    constexpr int I1 = 16 * 80, I2 = 8 * 16, I3 = 16 * 32, I4 = 16 * 128, I5 = 64 * 32, I6 = 16 * 96;
    constexpr int NITEMS = I1 + I2 + I3 + I4 + I5 + I6 + I3 + I4 + I5;
    for (int it = gw; it < NITEMS; it += NGW) {
        int r = it;
        if (r < I1) { transpose_item(p.w_in_even, 2560, p.Wt1, 1024, p.ln_mix, scr, r, lane); continue; } r -= I1;
        if (r < I2) { transpose_item(p.w_glu, 512, p.Wglu, 512, nullptr, scr, r, lane); continue; } r -= I2;
        if (r < I3) { transpose_item(p.w_out_even, 1024, p.Wo0, 1024, nullptr, scr, r, lane); continue; } r -= I3;
        if (r < I4) { transpose_item(p.w_up, 4096, p.Wup0, 1024, p.ln_mlp, scr, r, lane); continue; } r -= I4;
        if (r < I5) { transpose_item(p.w_down, 1024, p.Wdn0, 4096, nullptr, scr, r, lane); continue; } r -= I5;
        if (r < I6) { transpose_item(p.w_in_odd, 3072, p.Wqkv, 1024, p.ln_mix + 1024, scr, r, lane); continue; } r -= I6;
        if (r < I3) { transpose_item(p.w_out_odd, 1024, p.Wo1, 1024, nullptr, scr, r, lane); continue; } r -= I3;
        if (r < I4) { transpose_item(p.w_up + (size_t)1024 * 4096, 4096, p.Wup1, 1024, p.ln_mlp + 1024, scr, r, lane); continue; } r -= I4;
        transpose_item(p.w_down + (size_t)4096 * 1024, 1024, p.Wdn1, 4096, nullptr, scr, r, lane);
    }
    for (int row = gw; row < NT; row += NGW) {
        const float* src;
        if (row < NTP) { const int b = row / TP, t = row - b * TP; src = t < 16 ? p.meta + (size_t)t * 1024 : p.x_prompt + ((size_t)b * 4096 + (t - 16)) * 1024; }
        else src = p.x_sample + (size_t)(row - NTP) * 1024;
        float ss = 0.f;
#pragma unroll
        for (int j = 0; j < 4; ++j) { const f32x4 v = ((const f32x4*)src)[lane + 64 * j]; u32x2 o; o.x = pk2(v.x, v.y); o.y = pk2(v.z, v.w);
            const float a0 = bflo(o.x), a1 = bfhi(o.x), a2 = bflo(o.y), a3 = bfhi(o.y); ss += (a0 * a0 + a1 * a1) + (a2 * a2 + a3 * a3);
            ((u32x2*)(p.XB + (size_t)row * 1024))[lane + 64 * j] = o; }
        ss = wave_sum(ss);
        if (lane < 16) p.SSQ[(size_t)row * 16 + lane] = lane == 0 ? ss : 0.f;
    }
    if (gtid < 512) p.LB[gtid] = 1.f / (1.f + __expf(p.hgrn_lb[512 + gtid] - p.hgrn_lb[gtid]));
    for (int i = gtid; i < 32 * 16 * 256; i += GT) {
        const int g = i >> 12, tau = (i >> 8) & 15, pch = (i >> 4) & 15, pp = i & 15; float acc = 0.f;
        for (int n = 0; n < 64; ++n) { float wr_, wi_, br_, bi_; s5_pow(p, g, n, (float)tau, wr_, wi_); s5_bbar(p, g, n, pp, br_, bi_);
            const float cr = p.c_re[(g * 16 + pch) * 64 + n], ci = p.c_im[(g * 16 + pch) * 64 + n];
            const float cwr = cr * wr_ - ci * wi_, cwi = cr * wi_ + ci * wr_; acc += cwr * br_ - cwi * bi_; }
        if (tau == 0 && pch == pp) acc += p.ssm_d[g * 16 + pch];
        p.KTAB[i] = acc; }
    for (int i = gtid; i < 32 * 256 * 64; i += GT) {
        const int g = i >> 14, t = (i >> 10) & 15, pch = (i >> 6) & 15, n = i & 63; float wr_, wi_; s5_pow(p, g, n, (float)(t + 1), wr_, wi_);
        const float cr = p.c_re[(g * 16 + pch) * 64 + n], ci = p.c_im[(g * 16 + pch) * 64 + n];
        *(unsigned*)(p.TG + ((size_t)(g * 256 + t * 16 + pch)) * 384 + 256 + 2 * n) = pk2(cr * wr_ - ci * wi_, -(cr * wi_ + ci * wr_)); }
    for (int i = gtid; i < 32 * 64 * 256; i += GT) {
        const int g = i >> 14, n = (i >> 8) & 63, s = (i >> 4) & 15, pp = i & 15; float wr_, wi_, br_, bi_; s5_pow(p, g, n, (float)(15 - s), wr_, wi_); s5_bbar(p, g, n, pp, br_, bi_);
        p.HT[((size_t)(g * 128 + 2 * n)) * 256 + s * 16 + pp] = f2bf(wr_ * br_ - wi_ * bi_);
        p.HT[((size_t)(g * 128 + 2 * n + 1)) * 256 + s * 16 + pp] = f2bf(wr_ * bi_ + wi_ * br_); }
    if (gtid < 2048) { float wr_, wi_; s5_pow(p, gtid >> 6, gtid & 63, 16.f, wr_, wi_); p.A16[2 * gtid] = wr_; p.A16[2 * gtid + 1] = wi_; }
}

constexpr int HP = 136, TPI = 72;
constexpr int L_QT = 0, L_QH = 17408, L_KT = 34816, L_KTT = 52224, L_IVT = 70656, L_ATT = 89088, L_SUM = 98304, L_VEC = 100352, L_OB = 0  ;
struct HItem { int row0, L, h, bh; };
DI HItem hgrn_item(int item) {
    HItem it;
    if (item < 2080) { const int bh = item / 65, c = item - bh * 65, b = bh >> 2; it.h = bh & 3; it.bh = bh; it.L = c == 0 ? 16 : 64; it.row0 = b * TP + (c == 0 ? 0 : 16 + 64 * (c - 1)); }
    else { const int s = item - 2080, b = s >> 2; it.h = s & 3; it.bh = 32 + s; it.L = 64; it.row0 = NTP + b * 64; }
    return it;
}
template <bool FULL> DI void hgrn_prep(const Prm& p, const HItem& it, LAS unsigned char* lds, int tid) {
    const int d = tid & 127, tq = tid >> 7, t0 = 16 * tq, col = it.h * 128 + d;
    LAS float* sums = (LAS float*)(lds + L_SUM); LAS float* vec = (LAS float*)(lds + L_VEC);
    float cs[16], lf[16];
    float run = 0.f;
#pragma unroll
    for (int j = 0; j < 16; ++j) { const int t = t0 + j; lf[j] = t < it.L ? h2f(p.LOGF[(size_t)(it.row0 + t) * 512 + col]) : 0.f; run += lf[j]; cs[j] = run; }
    sums[tq * 128 + d] = run;
    unsigned ivp[8];
#pragma unroll
    for (int j = 0; j < 8; ++j) { const int t = t0 + 2 * j;
        const unsigned lo = t < it.L ? p.IV[(size_t)(it.row0 + t) * 512 + col] : 0u, hi = t + 1 < it.L ? p.IV[(size_t)(it.row0 + t + 1) * 512 + col] : 0u; ivp[j] = lo | (hi << 16); }
    { LAS u32x4v* dst = (LAS u32x4v*)(lds + L_IVT + (d * TPI + t0) * 2); u32x4v a, b; a.x = ivp[0]; a.y = ivp[1]; a.z = ivp[2]; a.w = ivp[3]; b.x = ivp[4]; b.y = ivp[5]; b.z = ivp[6]; b.w = ivp[7]; dst[0] = a; dst[1] = b; }
    __syncthreads();
    const float s0 = sums[d], s1 = sums[128 + d], s2 = sums[256 + d], s3 = sums[384 + d];
    const float off = tq == 0 ? 0.f : tq == 1 ? s0 : tq == 2 ? s0 + s1 : s0 + s1 + s2, r = s0 + s1, bL = r + s2 + s3;
    if (tq == 0) { vec[d] = r; vec[128 + d] = bL; }
    unsigned ktp[8]; float kprev = 0.f;
#pragma unroll
    for (int j = 0; j < 16; ++j) { const int t = t0 + j; const bool valid = t < it.L; const float b = off + cs[j];
        const float kt = valid ? (1.f - __expf(lf[j])) * __expf(r - b) : 0.f;
        if (j & 1) ktp[j >> 1] = pk2(kprev, kt); else kprev = kt;
        if (FULL) { const float qv = valid ? bf2f(p.Qh[(size_t)(it.row0 + t) * 512 + col]) : 0.f;
            *(LAS unsigned short*)(lds + L_KT + (t * HP + d) * 2) = f2bf(kt);
            *(LAS unsigned short*)(lds + L_QT + (t * HP + d) * 2) = f2bf(qv * __expf(b - r));
            *(LAS unsigned short*)(lds + L_QH + (t * HP + d) * 2) = f2bf(qv * __expf(b)); } }
    if (!FULL) { LAS u32x4v* dst = (LAS u32x4v*)(lds + L_KTT + (d * TPI + t0) * 2); u32x4v a, b; a.x = ktp[0]; a.y = ktp[1]; a.z = ktp[2]; a.w = ktp[3]; b.x = ktp[4]; b.y = ktp[5]; b.z = ktp[6]; b.w = ktp[7]; dst[0] = a; dst[1] = b; }
    __syncthreads();
}
#define MFMA16(a, b, c) __builtin_amdgcn_mfma_f32_16x16x32_bf16((a), (b), (c), 0, 0, 0)
#define MFMA32(a, b, c) __builtin_amdgcn_mfma_f32_32x32x16_bf16((a), (b), (c), 0, 0, 0)
DI void hgrn_b1(const Prm& p, int item, LAS unsigned char* lds, int tid, int lane, int wave) {
    const HItem it = hgrn_item(item);
    hgrn_prep<false>(p, it, lds, tid);
    const LAS float* vec = (const LAS float*)(lds + L_VEC);
    const int fr = lane & 15, fq = lane >> 4;
    bf16x8 a[2];
#pragma unroll
    for (int ks = 0; ks < 2; ++ks) a[ks] = *(const LAS bf16x8*)(lds + L_KTT + ((16 * wave + fr) * TPI + 32 * ks + 8 * fq) * 2);
    float e2[4];
#pragma unroll
    for (int j = 0; j < 4; ++j) { const int d = 16 * wave + 4 * fq + j; e2[j] = __expf(vec[128 + d] - vec[d]); }
#pragma unroll
    for (int vt = 0; vt < 8; ++vt) { f32x4 acc = {0.f, 0.f, 0.f, 0.f};
#pragma unroll
        for (int ks = 0; ks < 2; ++ks) { const bf16x8 b = *(const LAS bf16x8*)(lds + L_IVT + ((16 * vt + fr) * TPI + 32 * ks + 8 * fq) * 2); acc = MFMA16(a[ks], b, acc); }
        u32x2 o; o.x = pk2(acc[0] * e2[0], acc[1] * e2[1]); o.y = pk2(acc[2] * e2[2], acc[3] * e2[3]);
        *(u32x2*)(p.UT + (size_t)item * 16384 + (16 * vt + fr) * 128 + 16 * wave + 4 * fq) = o; }
    if (tid < 128) p.AL[(size_t)item * 128 + tid] = __expf(vec[128 + tid]);
    __syncthreads();
}
DI void hgrn_b2(const Prm& p, int gtid, int GT) {
    for (int idx = gtid; idx < 64 * 4096; idx += GT) {
        const int bhx = idx >> 12, e = idx & 4095, v = e >> 5, d4 = (e & 31) * 4; const bool smp = bhx >= 32;
        const int item0 = smp ? 2080 + (bhx - 32) : bhx * 65, nch = smp ? 1 : 65;
        float S[4] = {0.f, 0.f, 0.f, 0.f};
        if (smp) {
#pragma unroll
            for (int j = 0; j < 4; ++j) S[j] = p.state_hgrn[((size_t)(bhx - 32) * 128 + d4 + j) * 128 + v]; }
        for (int c0 = 0; c0 < nch; c0 += 5) {
            u32x2 uu[5]; f32x4 al[5];
#pragma unroll
            for (int i = 0; i < 5; ++i) if (c0 + i < nch) { uu[i] = *(const u32x2*)(p.UT + (size_t)(item0 + c0 + i) * 16384 + v * 128 + d4); al[i] = *(const f32x4*)(p.AL + (size_t)(item0 + c0 + i) * 128 + d4); }
#pragma unroll
            for (int i = 0; i < 5; ++i) if (c0 + i < nch) { u32x2 o; o.x = pk2(S[0], S[1]); o.y = pk2(S[2], S[3]);
                *(u32x2*)(p.UT + (size_t)(item0 + c0 + i) * 16384 + v * 128 + d4) = o;
                S[0] = al[i][0] * S[0] + bflo(uu[i].x); S[1] = al[i][1] * S[1] + bfhi(uu[i].x); S[2] = al[i][2] * S[2] + bflo(uu[i].y); S[3] = al[i][3] * S[3] + bfhi(uu[i].y); } }
        float* dst = p.out + (smp ? O_HGS + (size_t)(bhx - 32) * 16384 : O_HGP + (size_t)bhx * 16384);
#pragma unroll
        for (int j = 0; j < 4; ++j) dst[(d4 + j) * 128 + v] = S[j];
    }
}
DI void hgrn_b3(const Prm& p, int item, LAS unsigned char* lds, int tid, int lane, int wave) {
    const HItem it = hgrn_item(item);
    hgrn_prep<true>(p, it, lds, tid);
    const int fr = lane & 15, fq = lane >> 4;
    {
        const int tt = wave >> 1;
#pragma unroll
        for (int i = 0; i < 2; ++i) { const int st = 2 * (wave & 1) + i; f32x4 acc = {0.f, 0.f, 0.f, 0.f};
#pragma unroll
            for (int ks = 0; ks < 4; ++ks) { const bf16x8 a = *(const LAS bf16x8*)(lds + L_KT + ((16 * st + fr) * HP + 32 * ks + 8 * fq) * 2);
                const bf16x8 b = *(const LAS bf16x8*)(lds + L_QT + ((16 * tt + fr) * HP + 32 * ks + 8 * fq) * 2); acc = MFMA16(a, b, acc); }
            const int t = 16 * tt + fr, s0 = 16 * st + 4 * fq;
            u32x2 o; o.x = pk2(s0 <= t ? acc[0] : 0.f, s0 + 1 <= t ? acc[1] : 0.f); o.y = pk2(s0 + 2 <= t ? acc[2] : 0.f, s0 + 3 <= t ? acc[3] : 0.f);
            *(LAS u32x2*)(lds + L_ATT + (t * TPI + s0) * 2) = o; }
    }
    __syncthreads();
    f32x4 oacc[4];
    {   const int tt = wave & 3;
        bf16x8 aa[2], aq[4];
#pragma unroll
        for (int ks = 0; ks < 2; ++ks) aa[ks] = *(const LAS bf16x8*)(lds + L_ATT + ((16 * tt + fr) * TPI + 32 * ks + 8 * fq) * 2);
#pragma unroll
        for (int ks = 0; ks < 4; ++ks) aq[ks] = *(const LAS bf16x8*)(lds + L_QH + ((16 * tt + fr) * HP + 32 * ks + 8 * fq) * 2);
#pragma unroll
        for (int i = 0; i < 4; ++i) { const int vt = 4 * (wave >> 2) + i; f32x4 acc = {0.f, 0.f, 0.f, 0.f};
#pragma unroll
            for (int ks = 0; ks < 2; ++ks) { const bf16x8 b = *(const LAS bf16x8*)(lds + L_IVT + ((16 * vt + fr) * TPI + 32 * ks + 8 * fq) * 2); acc = MFMA16(aa[ks], b, acc); }
#pragma unroll
            for (int ks = 0; ks < 4; ++ks) { const bf16x8 b = *(const bf16x8*)(p.UT + (size_t)item * 16384 + (16 * vt + fr) * 128 + 32 * ks + 8 * fq); acc = MFMA16(aq[ks], b, acc); }
            oacc[i] = acc; }
    }
    __syncthreads();
    {   const int tt = wave & 3; LAS float* ob = (LAS float*)(lds + L_OB);
#pragma unroll
        for (int i = 0; i < 4; ++i) { const int v = 16 * (4 * (wave >> 2) + i) + fr;
#pragma unroll
            for (int j = 0; j < 4; ++j) ob[(16 * tt + 4 * fq + j) * 132 + v] = oacc[i][j]; }
    }
    __syncthreads();
    {   const int t = tid >> 3, sg = tid & 7; const LAS float* ob = (const LAS float*)(lds + L_OB) + t * 132 + 16 * sg;
        f32x4 x[4]; float ss = 0.f;
#pragma unroll
        for (int j = 0; j < 4; ++j) { x[j] = ((const LAS f32x4*)ob)[j]; ss += (x[j].x * x[j].x + x[j].y * x[j].y) + (x[j].z * x[j].z + x[j].w * x[j].w); }
        ss += __shfl_xor(ss, 1); ss += __shfl_xor(ss, 2); ss += __shfl_xor(ss, 4);
        const float rr = rsqrtf(ss * (1.f / 128.f) + EPSN);
        if (t < it.L) { const size_t row = it.row0 + t; const int c0 = it.h * 128 + 16 * sg;
            const u32x4v g0 = *(const u32x4v*)(p.GS + row * 512 + c0), g1 = *(const u32x4v*)(p.GS + row * 512 + c0 + 8);
            const f32x4* gn = (const f32x4*)(p.hgrn_norm + 16 * sg);
            const f32x4 n0 = gn[0], n1 = gn[1], n2 = gn[2], n3 = gn[3];
            u32x4v o0, o1;
            o0.x = pk2(x[0].x * rr * n0.x * bflo(g0.x), x[0].y * rr * n0.y * bfhi(g0.x)); o0.y = pk2(x[0].z * rr * n0.z * bflo(g0.y), x[0].w * rr * n0.w * bfhi(g0.y));
            o0.z = pk2(x[1].x * rr * n1.x * bflo(g0.z), x[1].y * rr * n1.y * bfhi(g0.z)); o0.w = pk2(x[1].z * rr * n1.z * bflo(g0.w), x[1].w * rr * n1.w * bfhi(g0.w));
            o1.x = pk2(x[2].x * rr * n2.x * bflo(g1.x), x[2].y * rr * n2.y * bfhi(g1.x)); o1.y = pk2(x[2].z * rr * n2.z * bflo(g1.y), x[2].w * rr * n2.w * bfhi(g1.y));
            o1.z = pk2(x[3].x * rr * n3.x * bflo(g1.z), x[3].y * rr * n3.y * bfhi(g1.z)); o1.w = pk2(x[3].z * rr * n3.z * bflo(g1.w), x[3].w * rr * n3.w * bfhi(g1.w));
            *(u32x4v*)(p.CAT + row * 1024 + c0) = o0; *(u32x4v*)(p.CAT + row * 1024 + c0 + 8) = o1; }
    }
    __syncthreads();
}
DI void s5_fill_tg(const Prm& p, int gtid, int GT) {
    for (int i = gtid; i < 32 * 16 * 16 * 16 * 8; i += GT) {
        const int g = i >> 15, t = (i >> 11) & 15, pch = (i >> 7) & 15, s = (i >> 3) & 15, pp = (i & 7) * 2;
        unsigned v = 0u; if (s <= t) { const float* k = p.KTAB + (((g * 16 + (t - s)) * 16 + pch) * 16 + pp); v = pk2(k[0], k[1]); }
        *(unsigned*)(p.TG + ((size_t)(g * 256 + t * 16 + pch)) * 384 + s * 16 + pp) = v; }
}
DI void s5_load_u(const Prm& p, int mt, int g, int lane, bf16x8 (&uf)[8]) {
    const int fr = lane & 15, fq = lane >> 4; int col = 16 * mt + fr; if (col >= NCOL) col = NCOL - 1;
#pragma unroll
    for (int ks = 0; ks < 8; ++ks) uf[ks] = *(const bf16x8*)(p.U + ((size_t)(16 * col + 2 * ks + (fq >> 1))) * 512 + 16 * g + 8 * (fq & 1));
}
DI void s5_b(const Prm& p, int gw, int NGW, int lane) {
    const int fr = lane & 15, fq = lane >> 4;
    for (int task = gw; task < 131 * 32; task += NGW) { const int mt = task >> 5, g = task & 31;
        bf16x8 uf[8]; s5_load_u(p, mt, g, lane, uf);
#pragma unroll
        for (int nt = 0; nt < 8; ++nt) { f32x4 acc = {0.f, 0.f, 0.f, 0.f};
#pragma unroll
            for (int ks = 0; ks < 8; ++ks) { const bf16x8 b = *(const bf16x8*)(p.HT + ((size_t)(g * 128 + 16 * nt + fr)) * 256 + 32 * ks + 8 * fq); acc = MFMA16(uf[ks], b, acc); }
#pragma unroll
            for (int j = 0; j < 4; ++j) { const int col = 16 * mt + 4 * fq + j; if (col < NCOL) p.XLOC[(size_t)col * 4096 + g * 128 + 16 * nt + fr] = acc[j]; } }
    }
}
DI void s5_c(const Prm& p, int gtid) {
    if (gtid >= 16 * 2048) return;
    const int seq = gtid >> 11, g = (gtid >> 6) & 31, n = gtid & 63; const bool smp = seq >= 8; const int b = seq & 7;
    const int col0 = smp ? 2056 + 4 * b : 257 * b, nch = smp ? 4 : 257;
    float xr = 0.f, xi = 0.f; if (smp) { xr = p.ssm_re0[(b * 32 + g) * 64 + n]; xi = p.ssm_im0[(b * 32 + g) * 64 + n]; }
    const float ar = p.A16[2 * (g * 64 + n)], ai = p.A16[2 * (g * 64 + n) + 1];
    const size_t base = (size_t)g * 128 + 2 * n;
    for (int c0 = 0; c0 < nch; c0 += 8) {
        f32x2v xl[8];
#pragma unroll
        for (int i = 0; i < 8; ++i) if (c0 + i < nch) xl[i] = *(const f32x2v*)(p.XLOC + (size_t)(col0 + c0 + i) * 4096 + base);
#pragma unroll
        for (int i = 0; i < 8; ++i) if (c0 + i < nch) { *(unsigned*)(p.XPREV + (size_t)(col0 + c0 + i) * 4096 + base) = pk2(xr, xi);
            const float nr = ar * xr - ai * xi + xl[i].x, ni = ar * xi + ai * xr + xl[i].y; xr = nr; xi = ni; } }
    const size_t o = (size_t)(b * 32 + g) * 64 + n;
    p.out[(smp ? O_SRS : O_SRP) + o] = xr; p.out[(smp ? O_SIS : O_SIP) + o] = xi;
}
DI f32x2v gelu_pk(f32x2v v) {
    const f32x2v av = __builtin_elementwise_abs(v), d = av * 0.2316418882f + 1.0f;
    f32x2v t; t.x = __builtin_amdgcn_rcpf(d.x); t.y = __builtin_amdgcn_rcpf(d.y);
    f32x2v q = t * 0.5307027145f + (-0.7265760135f); q = q * t + 0.7107068705f; q = q * t + (-0.142248368f); q = q * t + 0.127414796f; q = q * t;
    const f32x2v s = (v * v) * (-0.72134752044f);
    f32x2v e; e.x = __builtin_amdgcn_exp2f(s.x); e.y = __builtin_amdgcn_exp2f(s.y);
    const f32x2v m = v * (q * e), r = v - m;
    f32x2v o; o.x = v.x < 0.f ? m.x : r.x; o.y = v.y < 0.f ? m.y : r.y; return o;
}
DI void s5_d(const Prm& p, int gw, int NGW, int lane) {
    const int fr = lane & 15, fq = lane >> 4;
    for (int task = gw; task < 131 * 32; task += NGW) { const int mt = task >> 5, g = task & 31;
        bf16x8 uf[8], xf[4]; s5_load_u(p, mt, g, lane, uf);
        int colc = 16 * mt + fr; if (colc >= NCOL) colc = NCOL - 1;
#pragma unroll
        for (int ks = 0; ks < 4; ++ks) xf[ks] = *(const bf16x8*)(p.XPREV + (size_t)colc * 4096 + g * 128 + 32 * ks + 8 * fq);
        const bf16_t* tg = p.TG + ((size_t)(g * 256 + fr)) * 384 + 8 * fq;
        const bool ok = 16 * mt + fr < NCOL;
#pragma unroll
        for (int t = 0; t < 16; ++t) { f32x4 acc = {0.f, 0.f, 0.f, 0.f};
#pragma unroll
            for (int ks = 0; ks < 8; ++ks) if (ks <= (t >> 1)) { const bf16x8 a = *(const bf16x8*)(tg + (size_t)t * 16 * 384 + 32 * ks); acc = MFMA16(a, uf[ks], acc); }
#pragma unroll
            for (int ks = 0; ks < 4; ++ks) { const bf16x8 a = *(const bf16x8*)(tg + (size_t)t * 16 * 384 + 256 + 32 * ks); acc = MFMA16(a, xf[ks], acc); }
            const f32x2v y0 = gelu_pk((f32x2v){acc[0], acc[1]}), y1 = gelu_pk((f32x2v){acc[2], acc[3]});
            u32x2 o; o.x = pk2(y0.x, y0.y); o.y = pk2(y1.x, y1.y);
            if (ok) *(u32x2*)(p.YG + ((size_t)(16 * (16 * mt + fr) + t)) * 512 + 16 * g + 4 * fq) = o; }
    }
}
DI void cache_convert(const Prm& p, LAS unsigned char* lds, int tid, int lane, int wave) {
    const int gw = blockIdx.x * 8 + wave, NGW = gridDim.x * 8; LAS float* scr = (LAS float*)(lds + wave * 16384);
    for (int it = gw; it < 8 * 512; it += NGW) { const int b = it >> 9, r = it & 511;
        transpose_item(p.cache_v + (size_t)b * 1024 * 1024, 1024, p.VTS + (size_t)b * 1088, 8704, nullptr, scr, r, lane); }
    for (size_t i = (size_t)blockIdx.x * 512 + tid; i < (size_t)8 * 1024 * 256; i += (size_t)gridDim.x * 512) {
        const size_t row = i >> 8; const int c4 = (int)(i & 255) * 4, b = (int)(row >> 10), pos = (int)(row & 1023);
        const f32x4 v = *(const f32x4*)(p.cache_k + row * 1024 + c4); u32x2 o; o.x = pk2(v.x, v.y); o.y = pk2(v.z, v.w);
        *(u32x2*)(p.KS + ((size_t)b * 1088 + pos) * 1024 + c4) = o; }
}
DI void attn_phase(const Prm& p, int gw, int NGW, int lane) {
    const int q = lane & 31, half = lane >> 5;
    for (int it = gw; it < 8256 + 128; it += NGW) {
        bool smp; int b, h, qb;
        if (it < 8256) { smp = false; b = it / 1032; const int rem = it - b * 1032; h = rem / 129; qb = rem - h * 129; } else { const int s = it - 8256; smp = true; b = s >> 4; h = (s >> 1) & 7; qb = s & 1; }
        const bf16_t* Kb = smp ? p.KS + (size_t)b * 1088 * 1024 : p.KP + (size_t)b * TP * 1024;
        const bf16_t* Vb = smp ? p.VTS + (size_t)b * 1088 : p.VTP + (size_t)b * TP; const size_t vpitch = smp ? 8704 : NTP;
        const int qpos0 = (smp ? 1024 : 0) + 32 * qb, qrow0 = smp ? NTP + b * 64 + 32 * qb : b * TP + 32 * qb;
        const int qpos = qpos0 + q; const bool qvalid = smp || qpos < TP; const size_t qrow = qvalid ? qrow0 + q : qrow0;
        bf16x8 qf[8];
#pragma unroll
        for (int ks = 0; ks < 8; ++ks) qf[ks] = *(const bf16x8*)(p.Q + qrow * 1024 + h * 128 + 16 * ks + 8 * half);
        f32x16 o[4];
#pragma unroll
        for (int db = 0; db < 4; ++db)
#pragma unroll
            for (int e = 0; e < 16; ++e) o[db][e] = 0.f;
        float C = 1.f;
        for (int kt = (qpos0 + 30) >> 5; kt >= 0; --kt) {
            f32x16 s;
#pragma unroll
            for (int e = 0; e < 16; ++e) s[e] = 0.f;
            const bf16_t* kr = Kb + ((size_t)(32 * kt + q)) * 1024 + h * 128 + 8 * half;
#pragma unroll
            for (int ks = 0; ks < 8; ++ks) { const bf16x8 kf = *(const bf16x8*)(kr + 16 * ks); s = MFMA32(kf, qf[ks], s); }
            float pr[16], be[16], G[4], Gp[4];
#pragma unroll
            for (int i = 0; i < 4; ++i) {
#pragma unroll
                for (int j = 0; j < 4; ++j) { const int key = 32 * kt + 8 * i + 4 * half + j; const bool valid = key < qpos;
                    float z = s[4 * i + j] * 0.08838834764831845f; z = fminf(fmaxf(z, -80.f), 80.f);
                    const float e = __expf(z), pp = __builtin_amdgcn_rcpf(1.f + e); pr[4 * i + j] = valid ? pp : 1.f; be[4 * i + j] = valid ? e * pp : 0.f; }
                G[i] = (pr[4 * i] * pr[4 * i + 1]) * (pr[4 * i + 2] * pr[4 * i + 3]); }
#pragma unroll
            for (int i = 0; i < 4; ++i) Gp[i] = __shfl_xor(G[i], 32);
            float w[16]; float E1 = 1.f;
#pragma unroll
            for (int i = 3; i >= 0; --i) { const float Glo = half ? Gp[i] : G[i], Ghi = half ? G[i] : Gp[i];
                float suf = C * (half ? E1 : E1 * Ghi);
#pragma unroll
                for (int j = 3; j >= 0; --j) { w[4 * i + j] = be[4 * i + j] * suf; suf *= pr[4 * i + j]; }
                E1 *= Glo * Ghi; }
            C *= E1;
#pragma unroll
            for (int c = 0; c < 2; ++c) { union { bf16x8 v; unsigned u[4]; } wf;
#pragma unroll
                for (int e = 0; e < 4; ++e) wf.u[e] = pk2(w[8 * c + 2 * e], w[8 * c + 2 * e + 1]);
#pragma unroll
                for (int db = 0; db < 4; ++db) { const bf16_t* vr = Vb + ((size_t)(h * 128 + 32 * db + q)) * vpitch + 32 * kt + 16 * c + 4 * half;
                    union { bf16x8 v; u32x2 u[2]; } vf; vf.u[0] = *(const u32x2*)vr; vf.u[1] = *(const u32x2*)(vr + 8);
                    o[db] = MFMA32(vf.v, wf.v, o[db]); } }
            if (__all(C < 1e-37f)) break;
        }
        if (qvalid) {
#pragma unroll
            for (int db = 0; db < 4; ++db)
#pragma unroll
                for (int i = 0; i < 4; ++i) { u32x2 ov; ov.x = pk2(o[db][4 * i], o[db][4 * i + 1]); ov.y = pk2(o[db][4 * i + 2], o[db][4 * i + 3]);
                    *(u32x2*)(p.O + qrow * 1024 + h * 128 + 32 * db + 8 * i + 4 * half) = ov; } }
    }
}
DI void final_norm(const Prm& p, int gw, int NGW, int lane) {
    for (int r = gw; r < 32768 + 512; r += NGW) {
        int grow; float* dst;
        if (r < 32768) { const int b = r >> 12, t = r & 4095; grow = b * TP + 16 + t; dst = p.out + O_YP + (size_t)r * 1024; } else { grow = NTP + (r - 32768); dst = p.out + O_YS + (size_t)(r - 32768) * 1024; }
        const float rr = row_rinv(p.SSQ, grow);
#pragma unroll
        for (int j = 0; j < 4; ++j) { f32x4 v = ((f32x4*)dst)[lane + 64 * j]; const f32x4 g = ((const f32x4*)p.ln_final)[lane + 64 * j]; v = v * rr * g; ((f32x4*)dst)[lane + 64 * j] = v; }
    }
}
constexpr int LDS_BYTES = 131072;
__global__ void __launch_bounds__(512, 2) fwd_megakernel(Prm p) {
    extern __shared__ __attribute__((aligned(16))) unsigned char shm[];
    LAS unsigned char* lds = (LAS unsigned char*)shm;
    cg::grid_group grid = cg::this_grid();
    const int tid = threadIdx.x, lane = tid & 63, wave = __builtin_amdgcn_readfirstlane(tid >> 6);
    const int gw = blockIdx.x * 8 + wave, NGW = gridDim.x * 8, gtid = blockIdx.x * 512 + tid, GT = gridDim.x * 512;
    phase_prologue(p, lds, tid, lane, wave);
    grid.sync();
    { EpiIn0 E; E.SSQ = p.SSQ; E.LB = p.LB; E.Qh = p.Qh; E.IV = p.IV; E.GS = p.GS; E.U = p.U; E.LOGF = p.LOGF; run_gemm(lds, p.XB, p.Wt1, 2560, 1024, E); }
    grid.sync();
    s5_fill_tg(p, gtid, GT);
    for (int item = blockIdx.x; item < NITEM_H; item += gridDim.x) hgrn_b1(p, item, lds, tid, lane, wave);
    s5_b(p, gw, NGW, lane);
    grid.sync();
    hgrn_b2(p, gtid, GT);
    s5_c(p, gtid);
    grid.sync();
    for (int item = blockIdx.x; item < NITEM_H; item += gridDim.x) hgrn_b3(p, item, lds, tid, lane, wave);
    s5_d(p, gw, NGW, lane);
    grid.sync();
    { EpiGlu E; E.YG = p.YG; E.CAT = p.CAT; run_gemm(lds, p.YG, p.Wglu, 512, 512, E); }
    grid.sync();
    { EpiRes E; E.XB = p.XB; E.SSQ = p.SSQ; run_gemm(lds, p.CAT, p.Wo0, 1024, 1024, E); }
    grid.sync();
    { EpiUp E; E.SSQ = p.SSQ; E.H = p.H; run_gemm(lds, p.XB, p.Wup0, 4096, 1024, E); }
    grid.sync();
    { EpiRes E; E.XB = p.XB; E.SSQ = p.SSQ; run_gemm(lds, p.H, p.Wdn0, 1024, 4096, E); }
    grid.sync();
    cache_convert(p, lds, tid, lane, wave);
    __syncthreads();
    { EpiQkv E; E.SSQ = p.SSQ; E.out = p.out; E.Q = p.Q; E.KP = p.KP; E.KS = p.KS; E.VTP = p.VTP; E.VTS = p.VTS; run_gemm(lds, p.XB, p.Wqkv, 3072, 1024, E); }
    grid.sync();
    attn_phase(p, gw, NGW, lane);
    grid.sync();
    { EpiRes E; E.XB = p.XB; E.SSQ = p.SSQ; run_gemm(lds, p.O, p.Wo1, 1024, 1024, E); }
    grid.sync();
    { EpiUp E; E.SSQ = p.SSQ; E.H = p.H; run_gemm(lds, p.XB, p.Wup1, 4096, 1024, E); }
    grid.sync();
    { EpiFin E; E.XB = p.XB; E.SSQ = p.SSQ; E.out = p.out; run_gemm(lds, p.H, p.Wdn1, 1024, 4096, E); }
    grid.sync();
    final_norm(p, gw, NGW, lane);
}

extern "C" void kernel_launch(void* const* d_in, const int* in_sizes, int n_in, void* d_out, int out_size, void* d_ws, size_t ws_size, hipStream_t stream) {
    static int grid_blocks = 0;
    if (grid_blocks == 0) {
        int dev = 0, cus = 0, per_cu = 0;
        hipGetDevice(&dev); hipDeviceGetAttribute(&cus, hipDeviceAttributeMultiprocessorCount, dev);
        if (hipFuncSetAttribute((const void*)fwd_megakernel, hipFuncAttributeMaxDynamicSharedMemorySize, LDS_BYTES) != hipSuccess) fprintf(stderr, "kernel_launch: hipFuncSetAttribute failed\n");
        if (hipOccupancyMaxActiveBlocksPerMultiprocessor(&per_cu, (const void*)fwd_megakernel, 512, LDS_BYTES) != hipSuccess || per_cu < 1) { fprintf(stderr, "kernel_launch: occupancy query says %d\n", per_cu); per_cu = 1; }
        (void)hipGetLastError();
        grid_blocks = cus > 0 ? cus : 256;
    }
    Prm p{};
    const float* const* in = (const float* const*)d_in;
    p.x_prompt = in[0]; p.x_sample = in[1]; p.state_hgrn = in[2]; p.ssm_re0 = in[3]; p.ssm_im0 = in[4]; p.cache_k = in[5]; p.cache_v = in[6]; p.meta = in[7]; p.ln_mix = in[8]; p.ln_mlp = in[9];
    p.ln_final = in[10]; p.w_in_even = in[11]; p.hgrn_lb = in[12]; p.hgrn_norm = in[13]; p.a_re = in[14]; p.a_im = in[15]; p.log_dt = in[16]; p.b_re = in[17]; p.b_im = in[18]; p.c_re = in[19];
    p.c_im = in[20]; p.ssm_d = in[21]; p.w_glu = in[22]; p.w_out_even = in[23]; p.w_in_odd = in[24]; p.w_out_odd = in[25]; p.w_up = in[26]; p.w_down = in[27];
    p.out = (float*)d_out;
    unsigned char* ws = (unsigned char*)d_ws; size_t off = 0;
    auto take = [&](size_t bytes) { unsigned char* r = ws + off; off += (bytes + 255) & ~(size_t)255; return r; };
    p.Wt1 = (bf16_t*)take((size_t)2560 * 1024 * 2); p.Wglu = (bf16_t*)take((size_t)512 * 512 * 2); p.Wo0 = (bf16_t*)take((size_t)1024 * 1024 * 2); p.Wup0 = (bf16_t*)take((size_t)4096 * 1024 * 2);
    p.Wdn0 = (bf16_t*)take((size_t)4096 * 1024 * 2); p.Wqkv = (bf16_t*)take((size_t)3072 * 1024 * 2); p.Wo1 = (bf16_t*)take((size_t)1024 * 1024 * 2); p.Wup1 = (bf16_t*)take((size_t)4096 * 1024 * 2);
    p.Wdn1 = (bf16_t*)take((size_t)4096 * 1024 * 2);
    p.XB = (bf16_t*)take((size_t)MP * 1024 * 2); p.SSQ = (float*)take((size_t)MP * 16 * 4); p.LB = (float*)take(2048); p.KTAB = (float*)take((size_t)32 * 16 * 256 * 4);
    p.TG = (bf16_t*)take((size_t)32 * 256 * 384 * 2); p.HT = (bf16_t*)take((size_t)32 * 128 * 256 * 2); p.A16 = (float*)take(32 * 64 * 2 * 4);
    const size_t S0 = off; constexpr size_t SZ512 = (size_t)MP * 512 * 2;
    p.Qh = (bf16_t*)take(SZ512); p.LOGF = (unsigned short*)take(SZ512); p.IV = (bf16_t*)take(SZ512); p.GS = (bf16_t*)take(SZ512); p.U = (bf16_t*)take(SZ512);
    p.UT = (bf16_t*)take((size_t)NITEM_H * 16384 * 2); p.AL = (float*)take((size_t)NITEM_H * 128 * 4);
    p.XLOC = (float*)take(SZ512); p.YG = (bf16_t*)p.XLOC;
    p.XPREV = (bf16_t*)take((size_t)NCOL * 4096 * 2); p.CAT = (bf16_t*)take((size_t)MP * 1024 * 2);
    size_t end = off;
    off = S0; p.H = (bf16_t*)take((size_t)MP * 4096 * 2); if (off > end) end = off;
    off = S0; p.Q = (bf16_t*)take((size_t)MP * 1024 * 2); p.KP = (bf16_t*)take((size_t)NTP * 1024 * 2 + 65536); p.KS = (bf16_t*)take((size_t)8704 * 1024 * 2 + 65536);
    p.VTP = (bf16_t*)take((size_t)1024 * NTP * 2 + 4096); p.VTS = (bf16_t*)take((size_t)1024 * 8704 * 2 + 4096); p.O = (bf16_t*)take((size_t)MP * 1024 * 2); if (off > end) end = off;
    if (end > ws_size || n_in != 28 || (size_t)out_size != O_END) { fprintf(stderr, "kernel_launch: workspace/shape mismatch: need %zu have %zu, n_in %d, out %d\n", end, ws_size, n_in, out_size); return; }
    void* args[] = {&p};
    hipError_t e = hipLaunchCooperativeKernel((const void*)fwd_megakernel, dim3(grid_blocks), dim3(512), args, LDS_BYTES, stream);
    if (e != hipSuccess) fprintf(stderr, "cooperative launch failed: %s (grid %d)\n", hipGetErrorString(e), grid_blocks);
}
```

```cpp
#include <hip/hip_runtime.h>
#include <hip/hip_cooperative_groups.h>
#include <cstdio>
#include <cstdint>
namespace cg = cooperative_groups;
namespace pg8 {
#define PG8_LAS __attribute__((address_space(3)))
typedef unsigned short bf16_t;
typedef short bf16x8 __attribute__((ext_vector_type(8)));
typedef float f32x4 __attribute__((ext_vector_type(4)));
typedef unsigned u32x4 __attribute__((ext_vector_type(4)));
constexpr int BM = 256, BK = 64, HALF = 128, HTB = HALF * BK * 2  , STAGE_BYTES = 8 * HTB, NXCD = 8, WGM = 8;

__host__ __device__ __forceinline__ int lds_byte(int r, int c) { const int st = (r >> 4) * 2 + (c >> 5), rr = r & 15, cc = c & 31, ob = rr * 64 + cc * 2; return st * 1024 + (ob ^ (((ob >> 9) & 1) << 5)); }
__host__ __device__ __forceinline__ void stage_rc(int b, int& R, int& C) { const int st = b / 1024, sb = b % 1024, swz = sb ^ (((sb >> 9) & 1) << 5); R = (st >> 1) * 16 + swz / 64; C = (st & 1) * 32 + (swz % 64) / 2; }
__host__ __device__ __forceinline__ int perm32(int rho) { const int n = rho >> 4, i = rho & 15; return 8 * (i >> 2) + 4 * n + (i & 3); }

struct Unit { int pm, pn; };
struct Gemm { const bf16_t* A; const bf16_t* Bt; int M, N, K; };

struct StaticOrder {
    int nM, nN, nwg, G, c;
    __host__ __device__ void init(int M, int N, int G_, int c_) { nM = M / BM; nN = N / BM; nwg = nM * nN; G = G_; c = c_; }
    __host__ __device__ bool next(int i, Unit& u) const {
        const long L = (long)i * G + c; if (L >= nwg) return false;
        int wgid = (int)L; { const int q = nwg / NXCD, r = nwg % NXCD, xcd = wgid % NXCD, off = wgid / NXCD; wgid = (xcd < r ? xcd * (q + 1) : r * (q + 1) + (xcd - r) * q) + off; }
        const int nig = WGM * nN, gid = wgid / nig, fm = gid * WGM, gsz = (nM - fm) < WGM ? (nM - fm) : WGM;
        u.pm = fm + ((wgid % nig) % gsz); u.pn = (wgid % nig) / gsz; return true;
    }
    __device__ __forceinline__ void a_ready(const Unit&) const {}
    __device__ __forceinline__ void done(const Unit&) const {}
};
template <class Epi, class Sched>
__device__ __forceinline__ void gemm_phase(PG8_LAS unsigned char* lds, const Gemm g, const Sched& S, const Epi& E) {
    const int tid = threadIdx.x, wid = __builtin_amdgcn_readfirstlane(tid >> 6), lane = tid & 63, wr = wid >> 2, wc = wid & 3, fr = lane & 15, fq = lane >> 4;
    const int K = g.K, nt = K / BK;
    unsigned voffA[2], voffB[2];
#pragma unroll
    for (int i = 0; i < 2; ++i) { int R, C; stage_rc(tid * 16 + i * 8192, R, C); const int Rb = Epi::PERM ? ((R & ~31) + perm32(R & 31)) : R;
        voffA[i] = (unsigned)(R * K + C) * 2u; voffB[i] = (unsigned)(Rb * K + C) * 2u; }
    const size_t kstep = (size_t)(BK * 2);
    const size_t hstep = (size_t)HALF * K * 2;
    const size_t tstep = 2 * hstep;
    const unsigned ldsw = (unsigned)wid * 1024u;
    const int aoff = lds_byte(wr * 64 + fr, fq * 8), boff = lds_byte(wc * 32 + fr, fq * 8);
#define PG8_SA(b, h) (((b) * 2 + (h)) * HTB)
#define PG8_SB(b, h) ((4 + (b) * 2 + (h)) * HTB)
#define PG8_STAGE(bufoff, gbase, voff) do { _Pragma("unroll") for (int _i = 0; _i < 2; ++_i) \
        __builtin_amdgcn_global_load_lds((const unsigned*)((const char*)(gbase) + (voff)[_i]), (PG8_LAS unsigned*)(lds + (bufoff) + ldsw + _i * 8192), 16, 0, 0); } while (0)
#define PG8_LDA(dst, b, h) do { _Pragma("unroll") for (int m = 0; m < 4; ++m) _Pragma("unroll") for (int k = 0; k < 2; ++k) dst[m][k] = *(const PG8_LAS bf16x8*)(lds + PG8_SA(b, h) + aoff + m * 2048 + k * 1024); } while (0)
#define PG8_LDB(dst, b, h) do { _Pragma("unroll") for (int n = 0; n < 2; ++n) _Pragma("unroll") for (int k = 0; k < 2; ++k) dst[n][k] = *(const PG8_LAS bf16x8*)(lds + PG8_SB(b, h) + boff + n * 2048 + k * 1024); } while (0)
#define PG8_MMA(ai, bj, At, Bt) do { __builtin_amdgcn_s_setprio(1); _Pragma("unroll") for (int m = 0; m < 4; ++m) _Pragma("unroll") for (int n = 0; n < 2; ++n) _Pragma("unroll") for (int k = 0; k < 2; ++k) \
        acc[ai][bj][m][n] = __builtin_amdgcn_mfma_f32_16x16x32_bf16(Bt[n][k], At[m][k], acc[ai][bj][m][n], 0, 0, 0); __builtin_amdgcn_s_setprio(0); } while (0)
#define PG8_WAIT_V(n) asm volatile("s_waitcnt vmcnt(" #n ")" ::: "memory")
#define PG8_WAIT_L(n) asm volatile("s_waitcnt lgkmcnt(" #n ")" ::: "memory")
#define PG8_BAR __builtin_amdgcn_s_barrier()
#define PG8_SCHED __builtin_amdgcn_sched_barrier(0)
    Unit cur, nxt; int ui = 0;
    if (!S.next(0, cur)) return;
    f32x4 acc[2][2][4][2];
#pragma unroll
    for (int a = 0; a < 2; ++a)
#pragma unroll
        for (int b = 0; b < 2; ++b)
#pragma unroll
            for (int m = 0; m < 4; ++m)
#pragma unroll
                for (int n = 0; n < 2; ++n) acc[a][b][m][n] = (f32x4){0.f, 0.f, 0.f, 0.f};
    bf16x8 At[4][2], B0[2][2], B1[2][2];
    const char* cA = (const char*)g.A + (size_t)cur.pm * tstep; const char* cB = (const char*)g.Bt + (size_t)cur.pn * tstep;
    S.a_ready(cur);
    PG8_STAGE(PG8_SB(0, 0), cB, voffB); PG8_STAGE(PG8_SA(0, 0), cA, voffA); PG8_STAGE(PG8_SB(0, 1), cB + hstep, voffB); PG8_STAGE(PG8_SA(0, 1), cA + hstep, voffA);
    if (wr == 1) PG8_BAR;
    PG8_WAIT_V(4); PG8_BAR;
    PG8_STAGE(PG8_SB(1, 0), cB + kstep, voffB); PG8_STAGE(PG8_SA(1, 0), cA + kstep, voffA); PG8_STAGE(PG8_SB(1, 1), cB + hstep + kstep, voffB);
    PG8_WAIT_V(6); PG8_BAR;
    for (;;) {
        const bool has_next = S.next(ui + 1, nxt);
        const char* nA = has_next ? (const char*)g.A + (size_t)nxt.pm * tstep : cA; const char* nB = has_next ? (const char*)g.Bt + (size_t)nxt.pn * tstep : cB;
        for (int t = 0; t < nt; t += 2) {
            const bool last = (t == nt - 2);
            const char* a1 = cA + (size_t)(t + 1) * kstep;
            const char* a2 = last ? nA : cA + (size_t)(t + 2) * kstep; const char* b2 = last ? nB : cB + (size_t)(t + 2) * kstep;
            const char* a3 = a2 + kstep; const char* b3 = b2 + kstep;
            if (last && has_next) S.a_ready(nxt);
            PG8_LDB(B0, 0, 0); PG8_SCHED; PG8_LDA(At, 0, 0); PG8_STAGE(PG8_SA(1, 1), a1 + hstep, voffA);
            PG8_WAIT_L(8); PG8_BAR; PG8_WAIT_L(0); PG8_MMA(0, 0, At, B0); PG8_BAR; PG8_SCHED;
            PG8_LDB(B1, 0, 1); PG8_STAGE(PG8_SB(0, 0), b2, voffB);
            PG8_BAR; PG8_WAIT_L(0); PG8_MMA(0, 1, At, B1); PG8_BAR;
            PG8_LDA(At, 0, 1); PG8_STAGE(PG8_SA(0, 0), a2, voffA);
            PG8_BAR; PG8_WAIT_L(0); PG8_MMA(1, 0, At, B0); PG8_BAR; PG8_SCHED;
            PG8_STAGE(PG8_SB(0, 1), b2 + hstep, voffB);
            PG8_WAIT_V(6); PG8_BAR; PG8_MMA(1, 1, At, B1); PG8_BAR;
            PG8_LDB(B0, 1, 0); PG8_SCHED; PG8_LDA(At, 1, 0); PG8_STAGE(PG8_SA(0, 1), a2 + hstep, voffA);
            PG8_WAIT_L(8); PG8_BAR; PG8_WAIT_L(0); PG8_MMA(0, 0, At, B0); PG8_BAR; PG8_SCHED;
            PG8_LDB(B1, 1, 1); PG8_STAGE(PG8_SB(1, 0), b3, voffB);
            PG8_BAR; PG8_WAIT_L(0); PG8_MMA(0, 1, At, B1); PG8_BAR;
            PG8_LDA(At, 1, 1); PG8_STAGE(PG8_SA(1, 0), a3, voffA);
            PG8_BAR; PG8_WAIT_L(0); PG8_MMA(1, 0, At, B0); PG8_BAR; PG8_SCHED;
            PG8_STAGE(PG8_SB(1, 1), b3 + hstep, voffB);
            PG8_WAIT_V(6); PG8_BAR; PG8_MMA(1, 1, At, B1); PG8_BAR;
        }
        if constexpr (!Epi::AFTER_DRAIN) { E(acc, cur, wr, wc, fr, fq); S.done(cur); }
        if (!has_next) break;
#pragma unroll
        for (int a = 0; a < 2; ++a)
#pragma unroll
            for (int b = 0; b < 2; ++b)
#pragma unroll
                for (int m = 0; m < 4; ++m)
#pragma unroll
                    for (int n = 0; n < 2; ++n) acc[a][b][m][n] = (f32x4){0.f, 0.f, 0.f, 0.f};
        cur = nxt; cA = nA; cB = nB; ++ui;
    }
    PG8_WAIT_V(0);
    if (wr == 0) PG8_BAR;
    PG8_BAR;
    if constexpr (Epi::AFTER_DRAIN) { E.fused(acc, cur, wr, wc, fr, fq, lds, wid, lane); S.done(cur); }
#undef PG8_SA
#undef PG8_SB
#undef PG8_STAGE
#undef PG8_LDA
#undef PG8_LDB
#undef PG8_MMA
#undef PG8_WAIT_V
#undef PG8_WAIT_L
#undef PG8_BAR
#undef PG8_SCHED
}
}
using pg8::bf16_t; using pg8::bf16x8; using pg8::f32x4; using pg8::Unit;
typedef float f32x16 __attribute__((ext_vector_type(16)));
typedef float f32x2v __attribute__((ext_vector_type(2)));
typedef unsigned u32x2 __attribute__((ext_vector_type(2)));
typedef unsigned u32x4v __attribute__((ext_vector_type(4)));
#define LAS __attribute__((address_space(3)))
#define DI __device__ __forceinline__

constexpr int DM = 1024, TP = 4112, NTP = 8 * TP  , NTS = 512, NT = NTP + NTS  , MP = 33536  ;
constexpr int NITEM_H = 2112;
constexpr int NCOL = NT / 16;
constexpr float EPSN = 1e-6f;
constexpr size_t O_YP = 0, O_YS = O_YP + (size_t)8 * 4096 * 1024, O_HGP = O_YS + 524288, O_HGS = O_HGP + 524288, O_SRP = O_HGS + 524288, O_SIP = O_SRP + 16384,
                 O_SRS = O_SIP + 16384, O_SIS = O_SRS + 16384, O_KP = O_SIS + 16384, O_VP = O_KP + (size_t)NTP * 1024, O_KS = O_VP + (size_t)NTP * 1024, O_VS = O_KS + 524288, O_END = O_VS + 524288;

struct Prm {
    const float *x_prompt, *x_sample, *state_hgrn, *ssm_re0, *ssm_im0, *cache_k, *cache_v, *meta, *ln_mix, *ln_mlp, *ln_final, *w_in_even, *hgrn_lb, *hgrn_norm,
        *a_re, *a_im, *log_dt, *b_re, *b_im, *c_re, *c_im, *ssm_d, *w_glu, *w_out_even, *w_in_odd, *w_out_odd, *w_up, *w_down;
    float* out;
    bf16_t *Wt1, *Wglu, *Wo0, *Wup0, *Wdn0, *Wqkv, *Wo1, *Wup1, *Wdn1;
    bf16_t* XB; float* SSQ; float* LB; float* KTAB; bf16_t* TG; bf16_t* HT; float* A16;
    bf16_t *Qh, *IV, *GS, *U; unsigned short* LOGF; bf16_t* UT; float* AL; float* XLOC; bf16_t* XPREV; bf16_t* YG; bf16_t* CAT;
    bf16_t* H;
    bf16_t *Q, *KP, *KS, *VTP, *VTS, *O;
};

DI unsigned pk2(float lo, float hi) { unsigned r; asm volatile("v_cvt_pk_bf16_f32 %0, %1, %2" : "=v"(r) : "v"(lo), "v"(hi)); return r; }
DI float bflo(unsigned u) { return __uint_as_float(u << 16); }
DI float bfhi(unsigned u) { return __uint_as_float(u & 0xffff0000u); }
DI float bf2f(unsigned short b) { return __uint_as_float(((unsigned)b) << 16); }
DI unsigned short f2bf(float f) { return (unsigned short)(pk2(f, 0.f) & 0xffffu); }
DI unsigned pkh2(float lo, float hi) { union { _Float16 h[2]; unsigned u; } x; x.h[0] = (_Float16)lo; x.h[1] = (_Float16)hi; return x.u; }
DI float h2f(unsigned short h) { union { unsigned short s; _Float16 h; } x; x.s = h; return (float)x.h; }
DI float wave_sum(float v) {
#pragma unroll
    for (int o = 1; o < 64; o <<= 1) v += __shfl_xor(v, o);
    return v;
}
DI float fexp(float x) { return __expf(x); }
DI float sigm(float x) { return __builtin_amdgcn_rcpf(1.f + __expf(-x)); }
DI float row_rinv(const float* SSQ, int row) {
    const f32x4* s = (const f32x4*)(SSQ + (size_t)row * 16); f32x4 a = s[0] + s[1] + s[2] + s[3];
    return rsqrtf(((a.x + a.y) + (a.z + a.w)) * (1.f / 1024.f) + EPSN);
}
#define LDS_WAIT() asm volatile("s_waitcnt lgkmcnt(0)" ::: "memory")

struct EpiIn0 {
    static constexpr bool PERM = false, AFTER_DRAIN = false;
    const float* SSQ; const float* LB; bf16_t *Qh, *IV, *GS, *U; unsigned short* LOGF;
    DI void operator()(const f32x4 (&acc)[2][2][4][2], const Unit& u, int wr, int wc, int fr, int fq) const {
        const int seg = u.pn >> 1, cb = (u.pn & 1) * 256 + wc * 32 + 4 * fq, row0 = u.pm * 256 + wr * 64 + fr;
        unsigned short* dst = seg == 0 ? Qh : seg == 1 ? LOGF : seg == 2 ? IV : seg == 3 ? GS : U;
#pragma unroll
        for (int ai = 0; ai < 2; ++ai)
#pragma unroll
            for (int m = 0; m < 4; ++m) { const int row = row0 + ai * 128 + m * 16; const float r = row_rinv(SSQ, row);
#pragma unroll
                for (int bj = 0; bj < 2; ++bj)
#pragma unroll
                    for (int n = 0; n < 2; ++n) { const int cs = cb + bj * 128 + n * 16; f32x4 v = acc[ai][bj][m][n] * r; u32x2 o;
                        if (seg == 1) { const f32x4 lb = *(const f32x4*)(LB + cs); f32x4 f;
#pragma unroll
                            for (int e = 0; e < 4; ++e) f[e] = __logf(lb[e] + (1.f - lb[e]) * sigm(v[e]));
                            o.x = pkh2(f[0], f[1]); o.y = pkh2(f[2], f[3]); }
                        else { if (seg == 3) {
#pragma unroll
                                for (int e = 0; e < 4; ++e) v[e] = v[e] * sigm(v[e]); }
                            o.x = pk2(v[0], v[1]); o.y = pk2(v[2], v[3]); }
                        *(u32x2*)(dst + (size_t)row * 512 + cs) = o; } }
    }
};
struct EpiGlu {
    static constexpr bool PERM = false, AFTER_DRAIN = false;
    const bf16_t* YG; bf16_t* CAT;
    DI void operator()(const f32x4 (&acc)[2][2][4][2], const Unit& u, int wr, int wc, int fr, int fq) const {
        const int cb = u.pn * 256 + wc * 32 + 4 * fq, row0 = u.pm * 256 + wr * 64 + fr;
#pragma unroll
        for (int ai = 0; ai < 2; ++ai)
#pragma unroll
            for (int m = 0; m < 4; ++m) { const int row = row0 + ai * 128 + m * 16;
#pragma unroll
                for (int bj = 0; bj < 2; ++bj)
#pragma unroll
                    for (int n = 0; n < 2; ++n) { const int cs = cb + bj * 128 + n * 16; const f32x4 v = acc[ai][bj][m][n];
                        const u32x2 y = *(const u32x2*)(YG + (size_t)row * 512 + cs); u32x2 o;
                        o.x = pk2(bflo(y.x) * sigm(v[0]), bfhi(y.x) * sigm(v[1])); o.y = pk2(bflo(y.y) * sigm(v[2]), bfhi(y.y) * sigm(v[3]));
                        *(u32x2*)(CAT + (size_t)row * 1024 + 512 + cs) = o; } }
    }
};
struct EpiRes {
    static constexpr bool PERM = false, AFTER_DRAIN = false;
    bf16_t* XB; float* SSQ;
    DI void operator()(const f32x4 (&acc)[2][2][4][2], const Unit& u, int wr, int wc, int fr, int fq) const {
        const int cb = u.pn * 256 + wc * 32 + 4 * fq, row0 = u.pm * 256 + wr * 64 + fr;
#pragma unroll
        for (int ai = 0; ai < 2; ++ai)
#pragma unroll
            for (int m = 0; m < 4; ++m) { const int row = row0 + ai * 128 + m * 16; float ss = 0.f;
#pragma unroll
                for (int bj = 0; bj < 2; ++bj)
#pragma unroll
                    for (int n = 0; n < 2; ++n) { const int cs = cb + bj * 128 + n * 16; const f32x4 v = acc[ai][bj][m][n];
                        u32x2* px = (u32x2*)(XB + (size_t)row * 1024 + cs); const u32x2 x = *px; u32x2 o;
                        o.x = pk2(bflo(x.x) + v[0], bfhi(x.x) + v[1]); o.y = pk2(bflo(x.y) + v[2], bfhi(x.y) + v[3]); *px = o;
                        const float a0 = bflo(o.x), a1 = bfhi(o.x), a2 = bflo(o.y), a3 = bfhi(o.y); ss += (a0 * a0 + a1 * a1) + (a2 * a2 + a3 * a3); }
                ss += __shfl_xor(ss, 16); ss += __shfl_xor(ss, 32);
                if (fq == 0) SSQ[(size_t)row * 16 + u.pn * 4 + wc] = ss; }
    }
};
struct EpiUp {
    static constexpr bool PERM = false, AFTER_DRAIN = false;
    const float* SSQ; bf16_t* H;
    DI void operator()(const f32x4 (&acc)[2][2][4][2], const Unit& u, int wr, int wc, int fr, int fq) const {
        const int cb = u.pn * 256 + wc * 32 + 4 * fq, row0 = u.pm * 256 + wr * 64 + fr;
#pragma unroll
        for (int ai = 0; ai < 2; ++ai)
#pragma unroll
            for (int m = 0; m < 4; ++m) { const int row = row0 + ai * 128 + m * 16; const float r = row_rinv(SSQ, row);
#pragma unroll
                for (int bj = 0; bj < 2; ++bj)
#pragma unroll
                    for (int n = 0; n < 2; ++n) { const int cs = cb + bj * 128 + n * 16; f32x4 v = acc[ai][bj][m][n] * r;
#pragma unroll
                        for (int e = 0; e < 4; ++e) { const float t = fmaxf(v[e], 0.f); v[e] = t * t; }
                        u32x2 o; o.x = pk2(v[0], v[1]); o.y = pk2(v[2], v[3]); *(u32x2*)(H + (size_t)row * 4096 + cs) = o; } }
    }
};
DI size_t kf_index(int seqh, int nkt, int key, int d) { return ((((size_t)seqh * nkt + (key >> 5)) * 8 + (d >> 4)) * 64 + ((key & 31) + 32 * ((d >> 3) & 1))) * 8 + (d & 7); }
DI size_t vf_index(int seqh, int nkt, int key, int d) { const int kk = key & 31;
    return ((((size_t)seqh * nkt + (key >> 5)) * 8 + (kk >> 4) * 4 + (d >> 5)) * 64 + ((d & 31) + 32 * ((kk >> 2) & 1))) * 8 + ((kk >> 3) & 1) * 4 + (kk & 3); }
struct EpiQkv {
    static constexpr bool PERM = false, AFTER_DRAIN = false;
    const float* SSQ; float* out; bf16_t *Q, *KP, *KS, *VTP, *VTS;
    DI void operator()(const f32x4 (&acc)[2][2][4][2], const Unit& u, int wr, int wc, int fr, int fq) const {
        const int third = u.pn >> 2, cb = (u.pn & 3) * 256 + wc * 32 + 4 * fq, row0 = u.pm * 256 + wr * 64 + fr;
#pragma unroll
        for (int ai = 0; ai < 2; ++ai)
#pragma unroll
            for (int m = 0; m < 4; ++m) { const int row = row0 + ai * 128 + m * 16; const float r = row_rinv(SSQ, row);
                const bool smp = row >= NTP; const int s = row - NTP; const int b = smp ? (s >> 6) : row / TP, key = smp ? 1024 + (s & 63) : row - b * TP, nkt = smp ? 34 : 129;
#pragma unroll
                for (int bj = 0; bj < 2; ++bj)
#pragma unroll
                    for (int n = 0; n < 2; ++n) { const int cs = cb + bj * 128 + n * 16; const f32x4 v = acc[ai][bj][m][n] * r;
                        u32x2 o; o.x = pk2(v[0], v[1]); o.y = pk2(v[2], v[3]);
                        if (third == 0) { *(u32x2*)(Q + (size_t)row * 1024 + cs) = o; }
                        else if (row < NT) { const int h = cs >> 7, d = cs & 127;
                            if (third == 1) { *(f32x4*)(out + (smp ? O_KS + (size_t)s * 1024 : O_KP + (size_t)row * 1024) + cs) = v;
                                *(u32x2*)((smp ? KS : KP) + kf_index(b * 8 + h, nkt, key, d)) = o; }
                            else { *(f32x4*)(out + (smp ? O_VS + (size_t)s * 1024 : O_VP + (size_t)row * 1024) + cs) = v;
                                bf16_t* vt = (smp ? VTS : VTP) + vf_index(b * 8 + h, nkt, key, d);
                                vt[0] = (bf16_t)(o.x & 0xffffu); vt[8] = (bf16_t)(o.x >> 16); vt[16] = (bf16_t)(o.y & 0xffffu); vt[24] = (bf16_t)(o.y >> 16); } } } }
    }
};
struct EpiFin {
    static constexpr bool PERM = false, AFTER_DRAIN = false;
    const bf16_t* XB; float* SSQ; float* out;
    DI void operator()(const f32x4 (&acc)[2][2][4][2], const Unit& u, int wr, int wc, int fr, int fq) const {
        const int cb = u.pn * 256 + wc * 32 + 4 * fq, row0 = u.pm * 256 + wr * 64 + fr;
#pragma unroll
        for (int ai = 0; ai < 2; ++ai)
#pragma unroll
            for (int m = 0; m < 4; ++m) { const int row = row0 + ai * 128 + m * 16; float ss = 0.f;
                const int b = row / TP, t = row - b * TP; const bool ok = row < NT && (row >= NTP || t >= 16);
                float* dst = out + (row >= NTP ? O_YS + (size_t)(row - NTP) * 1024 : O_YP + ((size_t)b * 4096 + (t - 16)) * 1024);
#pragma unroll
                for (int bj = 0; bj < 2; ++bj)
#pragma unroll
                    for (int n = 0; n < 2; ++n) { const int cs = cb + bj * 128 + n * 16; f32x4 v = acc[ai][bj][m][n];
                        const u32x2 x = *(const u32x2*)(XB + (size_t)row * 1024 + cs);
                        v[0] += bflo(x.x); v[1] += bfhi(x.x); v[2] += bflo(x.y); v[3] += bfhi(x.y);
                        if (ok) *(f32x4*)(dst + cs) = v;
                        ss += (v[0] * v[0] + v[1] * v[1]) + (v[2] * v[2] + v[3] * v[3]); }
                ss += __shfl_xor(ss, 16); ss += __shfl_xor(ss, 32);
                if (fq == 0) SSQ[(size_t)row * 16 + u.pn * 4 + wc] = ss; }
    }
};
template <class Epi> DI void run_gemm(LAS unsigned char* lds, const bf16_t* A, const bf16_t* Bt, int N, int K, const Epi& E) {
    pg8::Gemm g; g.A = A; g.Bt = Bt; g.M = MP; g.N = N; g.K = K;
    pg8::StaticOrder S; S.init(MP, N, (int)gridDim.x, (int)blockIdx.x);
    pg8::gemm_phase<Epi, pg8::StaticOrder>(lds, g, S, E);
}
DI void transpose_item(const float* W, int N, bf16_t* WT, size_t ldo, const float* sc, LAS float* scr, int item, int lane) {
    const int nblk = N / 32, kb = item / nblk, nb = item % nblk, k0 = 64 * kb, n0 = 32 * nb;
#pragma unroll 8
    for (int i = 0; i < 32; ++i) { const int kk = 2 * i + (lane >> 5); float w = W[(size_t)(k0 + kk) * N + n0 + (lane & 31)]; if (sc) w *= sc[k0 + kk]; scr[kk * 33 + (lane & 31)] = w; }
    LDS_WAIT();
    const int c = lane & 7;
#pragma unroll
    for (int j = 0; j < 4; ++j) { const int n = (lane >> 3) + 8 * j; const LAS float* s = scr + (8 * c) * 33 + n;
        u32x4v o; o.x = pk2(s[0 * 33], s[1 * 33]); o.y = pk2(s[2 * 33], s[3 * 33]); o.z = pk2(s[4 * 33], s[5 * 33]); o.w = pk2(s[6 * 33], s[7 * 33]);
        *(u32x4v*)(WT + (size_t)(n0 + n) * ldo + k0 + 8 * c) = o; }
    LDS_WAIT();
}
DI void s5_pow(const Prm& p, int g, int n, float k, float& re, float& im) {
    const float dt = __expf(p.log_dt[g]), ar = p.a_re[g * 64 + n], ai = p.a_im[g * 64 + n];
    const float mag = __expf(k * dt * ar); float rev = k * dt * ai * 0.15915494309189535f; rev -= rintf(rev);
    re = mag * __builtin_amdgcn_cosf(rev); im = mag * __builtin_amdgcn_sinf(rev);
}
DI void s5_bbar(const Prm& p, int g, int n, int pp, float& re, float& im) {
    const float ar = p.a_re[g * 64 + n], ai = p.a_im[g * 64 + n]; float abr, abi; s5_pow(p, g, n, 1.f, abr, abi);
    const float den = ar * ar + ai * ai, zr = ((abr - 1.f) * ar + abi * ai) / den, zi = (abi * ar - (abr - 1.f) * ai) / den;
    const float br = p.b_re[(g * 64 + n) * 16 + pp], bi = p.b_im[(g * 64 + n) * 16 + pp];
    re = zr * br - zi * bi; im = zr * bi + zi * br;
}
DI void phase_prologue(const Prm& p, LAS unsigned char* lds, int tid, int lane, int wave) {
    const int gw = blockIdx.x * 8 + wave, NGW = gridDim.x * 8, gtid = blockIdx.x * 512 + tid, GT = gridDim.x * 512;
    LAS float* scr = (LAS float*)(lds + wave * 16384);
    constexpr int I1 = 16 * 80, I2 = 8 * 16, I3 = 16 * 32, I4 = 16 * 128, I5 = 64 * 32, I6 = 16 * 96;
    constexpr int NITEMS = I1 + I2 + I3 + I4 + I5 + I6 + I3 + I4 + I5;
    for (int it = gw; it < NITEMS; it += NGW) {
        int r = it;
        if (r < I1) { transpose_item(p.w_in_even, 2560, p.Wt1, 1024, p.ln_mix, scr, r, lane); continue; } r -= I1;
        if (r < I2) { transpose_item(p.w_glu, 512, p.Wglu, 512, nullptr, scr, r, lane); continue; } r -= I2;
        if (r < I3) { transpose_item(p.w_out_even, 1024, p.Wo0, 1024, nullptr, scr, r, lane); continue; } r -= I3;
        if (r < I4) { transpose_item(p.w_up, 4096, p.Wup0, 1024, p.ln_mlp, scr, r, lane); continue; } r -= I4;
        if (r < I5) { transpose_item(p.w_down, 1024, p.Wdn0, 4096, nullptr, scr, r, lane); continue; } r -= I5;
        if (r < I6) { transpose_item(p.w_in_odd, 3072, p.Wqkv, 1024, p.ln_mix + 1024, scr, r, lane); continue; } r -= I6;
        if (r < I3) { transpose_item(p.w_out_odd, 1024, p.Wo1, 1024, nullptr, scr, r, lane); continue; } r -= I3;
        if (r < I4) { transpose_item(p.w_up + (size_t)1024 * 4096, 4096, p.Wup1, 1024, p.ln_mlp + 1024, scr, r, lane); continue; } r -= I4;
        transpose_item(p.w_down + (size_t)4096 * 1024, 1024, p.Wdn1, 4096, nullptr, scr, r, lane);
    }
    for (int row = gw; row < NT; row += NGW) {
        const float* src;
        if (row < NTP) { const int b = row / TP, t = row - b * TP; src = t < 16 ? p.meta + (size_t)t * 1024 : p.x_prompt + ((size_t)b * 4096 + (t - 16)) * 1024; }
        else src = p.x_sample + (size_t)(row - NTP) * 1024;
        float ss = 0.f;
#pragma unroll
        for (int j = 0; j < 4; ++j) { const f32x4 v = ((const f32x4*)src)[lane + 64 * j]; u32x2 o; o.x = pk2(v.x, v.y); o.y = pk2(v.z, v.w);
            const float a0 = bflo(o.x), a1 = bfhi(o.x), a2 = bflo(o.y), a3 = bfhi(o.y); ss += (a0 * a0 + a1 * a1) + (a2 * a2 + a3 * a3);
            ((u32x2*)(p.XB + (size_t)row * 1024))[lane + 64 * j] = o; }
        ss = wave_sum(ss);
        if (lane < 16) p.SSQ[(size_t)row * 16 + lane] = lane == 0 ? ss : 0.f;
    }
    if (gtid < 512) p.LB[gtid] = 1.f / (1.f + __expf(p.hgrn_lb[512 + gtid] - p.hgrn_lb[gtid]));
    __syncthreads();
    {
        LAS float* zr_ = (LAS float*)lds; LAS float* zi_ = zr_ + 64; LAS float* wr_ = zi_ + 64; LAS float* wi_ = wr_ + 64;
        LAS float* bbr = wi_ + 64; LAS float* bbi = bbr + 1024; LAS float* cwr = bbi + 1024; LAS float* cwi = cwr + 16 * 65;
        for (int pair = blockIdx.x; pair < 512; pair += gridDim.x) { const int g = pair >> 4, tau = pair & 15;
            if (tid < 64) { const int n = tid; const float ar = p.a_re[g * 64 + n], ai = p.a_im[g * 64 + n]; float abr, abi; s5_pow(p, g, n, 1.f, abr, abi);
                const float den = ar * ar + ai * ai; zr_[n] = ((abr - 1.f) * ar + abi * ai) / den; zi_[n] = (abi * ar - (abr - 1.f) * ai) / den;
                float a, b; s5_pow(p, g, n, (float)tau, a, b); wr_[n] = a; wi_[n] = b; }
            __syncthreads();
#pragma unroll
            for (int k = 0; k < 2; ++k) { const int e = tid + 512 * k;
                { const int n = e >> 4; const float br = p.b_re[g * 1024 + e], bi = p.b_im[g * 1024 + e]; bbr[e] = zr_[n] * br - zi_[n] * bi; bbi[e] = zr_[n] * bi + zi_[n] * br; }
                { const int pch = e >> 6, n = e & 63; const float cr = p.c_re[g * 1024 + e], ci = p.c_im[g * 1024 + e]; cwr[pch * 65 + n] = cr * wr_[n] - ci * wi_[n]; cwi[pch * 65 + n] = cr * wi_[n] + ci * wr_[n]; } }
            __syncthreads();
            if (tid < 256) { const int pch = tid >> 4, pp = tid & 15; float acc = 0.f;
#pragma unroll 8
                for (int n = 0; n < 64; ++n) acc += cwr[pch * 65 + n] * bbr[n * 16 + pp] - cwi[pch * 65 + n] * bbi[n * 16 + pp];
                if (tau == 0 && pch == pp) acc += p.ssm_d[g * 16 + pch];
                const bf16_t kv = f2bf(acc);
                for (int t = tau; t < 16; ++t) p.TG[((size_t)(g * 256 + t * 16 + pch)) * 384 + (t - tau) * 16 + pp] = kv;
                if (tau > 0) for (int t = 0; t < 16 - tau; ++t) p.TG[((size_t)(g * 256 + t * 16 + pch)) * 384 + (t + tau) * 16 + pp] = 0; }
            __syncthreads(); }
    }
    for (int i = gtid; i < 32 * 256 * 64; i += GT) {
        const int g = i >> 14, t = (i >> 10) & 15, pch = (i >> 6) & 15, n = i & 63; float wr_, wi_; s5_pow(p, g, n, (float)(t + 1), wr_, wi_);
        const float cr = p.c_re[(g * 16 + pch) * 64 + n], ci = p.c_im[(g * 16 + pch) * 64 + n];
        *(unsigned*)(p.TG + ((size_t)(g * 256 + t * 16 + pch)) * 384 + 256 + 2 * n) = pk2(cr * wr_ - ci * wi_, -(cr * wi_ + ci * wr_)); }
    for (int i = gtid; i < 32 * 64 * 256; i += GT) {
        const int g = i >> 14, n = (i >> 8) & 63, s = (i >> 4) & 15, pp = i & 15; float wr_, wi_, br_, bi_; s5_pow(p, g, n, (float)(15 - s), wr_, wi_); s5_bbar(p, g, n, pp, br_, bi_);
        p.HT[((size_t)(g * 128 + 2 * n)) * 256 + s * 16 + pp] = f2bf(wr_ * br_ - wi_ * bi_);
        p.HT[((size_t)(g * 128 + 2 * n + 1)) * 256 + s * 16 + pp] = f2bf(wr_ * bi_ + wi_ * br_); }
    if (gtid < 2048) { float wr_, wi_; s5_pow(p, gtid >> 6, gtid & 63, 16.f, wr_, wi_); p.A16[2 * gtid] = wr_; p.A16[2 * gtid + 1] = wi_; }
}

constexpr int HP = 136, TPI = 72;
constexpr int L_QT = 0, L_QH = 17408, L_KT = 34816, L_KTT = 52224, L_IVT = 70656, L_ATT = 89088, L_SUM = 98304, L_VEC = 100352, L_OB = 0  ;
struct HItem { int row0, L, h, bh; };
DI HItem hgrn_item(int item) {
    HItem it;
    if (item < 2080) { const int bh = item / 65, c = item - bh * 65, b = bh >> 2; it.h = bh & 3; it.bh = bh; it.L = c == 0 ? 16 : 64; it.row0 = b * TP + (c == 0 ? 0 : 16 + 64 * (c - 1)); }
    else { const int s = item - 2080, b = s >> 2; it.h = s & 3; it.bh = 32 + s; it.L = 64; it.row0 = NTP + b * 64; }
    return it;
}
template <bool FULL> DI void hgrn_prep(const Prm& p, const HItem& it, LAS unsigned char* lds, int tid) {
    const int d = tid & 127, tq = tid >> 7, t0 = 16 * tq, col = it.h * 128 + d;
    LAS float* sums = (LAS float*)(lds + L_SUM); LAS float* vec = (LAS float*)(lds + L_VEC);
    float cs[16], lf[16];
    float run = 0.f;
#pragma unroll
    for (int j = 0; j < 16; ++j) { const int t = t0 + j; lf[j] = t < it.L ? h2f(p.LOGF[(size_t)(it.row0 + t) * 512 + col]) : 0.f; run += lf[j]; cs[j] = run; }
    sums[tq * 128 + d] = run;
    unsigned ivp[8];
#pragma unroll
    for (int j = 0; j < 8; ++j) { const int t = t0 + 2 * j;
        const unsigned lo = t < it.L ? p.IV[(size_t)(it.row0 + t) * 512 + col] : 0u, hi = t + 1 < it.L ? p.IV[(size_t)(it.row0 + t + 1) * 512 + col] : 0u; ivp[j] = lo | (hi << 16); }
    { LAS u32x4v* dst = (LAS u32x4v*)(lds + L_IVT + (d * TPI + t0) * 2); u32x4v a, b; a.x = ivp[0]; a.y = ivp[1]; a.z = ivp[2]; a.w = ivp[3]; b.x = ivp[4]; b.y = ivp[5]; b.z = ivp[6]; b.w = ivp[7]; dst[0] = a; dst[1] = b; }
    __syncthreads();
    const float s0 = sums[d], s1 = sums[128 + d], s2 = sums[256 + d], s3 = sums[384 + d];
    const float off = tq == 0 ? 0.f : tq == 1 ? s0 : tq == 2 ? s0 + s1 : s0 + s1 + s2, r = s0 + s1, bL = r + s2 + s3;
    if (tq == 0) { vec[d] = r; vec[128 + d] = bL; }
    unsigned ktp[8]; float kprev = 0.f;
#pragma unroll
    for (int j = 0; j < 16; ++j) { const int t = t0 + j; const bool valid = t < it.L; const float b = off + cs[j];
        const float kt = valid ? (1.f - __expf(lf[j])) * __expf(r - b) : 0.f;
        if (j & 1) ktp[j >> 1] = pk2(kprev, kt); else kprev = kt;
        if (FULL) { const float qv = valid ? bf2f(p.Qh[(size_t)(it.row0 + t) * 512 + col]) : 0.f;
            *(LAS unsigned short*)(lds + L_KT + (t * HP + d) * 2) = f2bf(kt);
            *(LAS unsigned short*)(lds + L_QT + (t * HP + d) * 2) = f2bf(qv * __expf(b - r));
            *(LAS unsigned short*)(lds + L_QH + (t * HP + d) * 2) = f2bf(qv * __expf(b)); } }
    if (!FULL) { LAS u32x4v* dst = (LAS u32x4v*)(lds + L_KTT + (d * TPI + t0) * 2); u32x4v a, b; a.x = ktp[0]; a.y = ktp[1]; a.z = ktp[2]; a.w = ktp[3]; b.x = ktp[4]; b.y = ktp[5]; b.z = ktp[6]; b.w = ktp[7]; dst[0] = a; dst[1] = b; }
    __syncthreads();
}
#define MFMA16(a, b, c) __builtin_amdgcn_mfma_f32_16x16x32_bf16((a), (b), (c), 0, 0, 0)
#define MFMA32(a, b, c) __builtin_amdgcn_mfma_f32_32x32x16_bf16((a), (b), (c), 0, 0, 0)
DI void hgrn_b1(const Prm& p, int item, LAS unsigned char* lds, int tid, int lane, int wave) {
    const HItem it = hgrn_item(item);
    hgrn_prep<false>(p, it, lds, tid);
    const LAS float* vec = (const LAS float*)(lds + L_VEC);
    const int fr = lane & 15, fq = lane >> 4;
    bf16x8 a[2];
#pragma unroll
    for (int ks = 0; ks < 2; ++ks) a[ks] = *(const LAS bf16x8*)(lds + L_KTT + ((16 * wave + fr) * TPI + 32 * ks + 8 * fq) * 2);
    float e2[4];
#pragma unroll
    for (int j = 0; j < 4; ++j) { const int d = 16 * wave + 4 * fq + j; e2[j] = __expf(vec[128 + d] - vec[d]); }
#pragma unroll
    for (int vt = 0; vt < 8; ++vt) { f32x4 acc = {0.f, 0.f, 0.f, 0.f};
#pragma unroll
        for (int ks = 0; ks < 2; ++ks) { const bf16x8 b = *(const LAS bf16x8*)(lds + L_IVT + ((16 * vt + fr) * TPI + 32 * ks + 8 * fq) * 2); acc = MFMA16(a[ks], b, acc); }
        u32x2 o; o.x = pk2(acc[0] * e2[0], acc[1] * e2[1]); o.y = pk2(acc[2] * e2[2], acc[3] * e2[3]);
        *(u32x2*)(p.UT + (size_t)item * 16384 + (16 * vt + fr) * 128 + 16 * wave + 4 * fq) = o; }
    if (tid < 128) p.AL[(size_t)item * 128 + tid] = __expf(vec[128 + tid]);
    __syncthreads();
}
DI void hgrn_b2(const Prm& p, int gtid, int GT) {
    for (int idx = gtid; idx < 64 * 4096; idx += GT) {
        const int bhx = idx >> 12, e = idx & 4095, v = e >> 5, d4 = (e & 31) * 4; const bool smp = bhx >= 32;
        const int item0 = smp ? 2080 + (bhx - 32) : bhx * 65, nch = smp ? 1 : 65;
        float S[4] = {0.f, 0.f, 0.f, 0.f};
        if (smp) {
#pragma unroll
            for (int j = 0; j < 4; ++j) S[j] = p.state_hgrn[((size_t)(bhx - 32) * 128 + d4 + j) * 128 + v]; }
        for (int c0 = 0; c0 < nch; c0 += 5) {
            u32x2 uu[5]; f32x4 al[5];
#pragma unroll
            for (int i = 0; i < 5; ++i) if (c0 + i < nch) { uu[i] = *(const u32x2*)(p.UT + (size_t)(item0 + c0 + i) * 16384 + v * 128 + d4); al[i] = *(const f32x4*)(p.AL + (size_t)(item0 + c0 + i) * 128 + d4); }
#pragma unroll
            for (int i = 0; i < 5; ++i) if (c0 + i < nch) { u32x2 o; o.x = pk2(S[0], S[1]); o.y = pk2(S[2], S[3]);
                *(u32x2*)(p.UT + (size_t)(item0 + c0 + i) * 16384 + v * 128 + d4) = o;
                S[0] = al[i][0] * S[0] + bflo(uu[i].x); S[1] = al[i][1] * S[1] + bfhi(uu[i].x); S[2] = al[i][2] * S[2] + bflo(uu[i].y); S[3] = al[i][3] * S[3] + bfhi(uu[i].y); } }
        float* dst = p.out + (smp ? O_HGS + (size_t)(bhx - 32) * 16384 : O_HGP + (size_t)bhx * 16384);
#pragma unroll
        for (int j = 0; j < 4; ++j) dst[(d4 + j) * 128 + v] = S[j];
    }
}
DI void hgrn_b3(const Prm& p, int item, LAS unsigned char* lds, int tid, int lane, int wave) {
    const HItem it = hgrn_item(item);
    hgrn_prep<true>(p, it, lds, tid);
    const int fr = lane & 15, fq = lane >> 4;
    {
        const int tt = wave >> 1;
#pragma unroll
        for (int i = 0; i < 2; ++i) { const int st = 2 * (wave & 1) + i; f32x4 acc = {0.f, 0.f, 0.f, 0.f};
#pragma unroll
            for (int ks = 0; ks < 4; ++ks) { const bf16x8 a = *(const LAS bf16x8*)(lds + L_KT + ((16 * st + fr) * HP + 32 * ks + 8 * fq) * 2);
                const bf16x8 b = *(const LAS bf16x8*)(lds + L_QT + ((16 * tt + fr) * HP + 32 * ks + 8 * fq) * 2); acc = MFMA16(a, b, acc); }
            const int t = 16 * tt + fr, s0 = 16 * st + 4 * fq;
            u32x2 o; o.x = pk2(s0 <= t ? acc[0] : 0.f, s0 + 1 <= t ? acc[1] : 0.f); o.y = pk2(s0 + 2 <= t ? acc[2] : 0.f, s0 + 3 <= t ? acc[3] : 0.f);
            *(LAS u32x2*)(lds + L_ATT + (t * TPI + s0) * 2) = o; }
    }
    __syncthreads();
    f32x4 oacc[4];
    {   const int tt = wave & 3;
        bf16x8 aa[2], aq[4];
#pragma unroll
        for (int ks = 0; ks < 2; ++ks) aa[ks] = *(const LAS bf16x8*)(lds + L_ATT + ((16 * tt + fr) * TPI + 32 * ks + 8 * fq) * 2);
#pragma unroll
        for (int ks = 0; ks < 4; ++ks) aq[ks] = *(const LAS bf16x8*)(lds + L_QH + ((16 * tt + fr) * HP + 32 * ks + 8 * fq) * 2);
#pragma unroll
        for (int i = 0; i < 4; ++i) { const int vt = 4 * (wave >> 2) + i; f32x4 acc = {0.f, 0.f, 0.f, 0.f};
#pragma unroll
            for (int ks = 0; ks < 2; ++ks) { const bf16x8 b = *(const LAS bf16x8*)(lds + L_IVT + ((16 * vt + fr) * TPI + 32 * ks + 8 * fq) * 2); acc = MFMA16(aa[ks], b, acc); }
#pragma unroll
            for (int ks = 0; ks < 4; ++ks) { const bf16x8 b = *(const bf16x8*)(p.UT + (size_t)item * 16384 + (16 * vt + fr) * 128 + 32 * ks + 8 * fq); acc = MFMA16(aq[ks], b, acc); }
            oacc[i] = acc; }
    }
    __syncthreads();
    {   const int tt = wave & 3; LAS float* ob = (LAS float*)(lds + L_OB);
#pragma unroll
        for (int i = 0; i < 4; ++i) { const int v = 16 * (4 * (wave >> 2) + i) + fr;
#pragma unroll
            for (int j = 0; j < 4; ++j) ob[(16 * tt + 4 * fq + j) * 132 + v] = oacc[i][j]; }
    }
    __syncthreads();
    {   const int t = tid >> 3, sg = tid & 7; const LAS float* ob = (const LAS float*)(lds + L_OB) + t * 132 + 16 * sg;
        f32x4 x[4]; float ss = 0.f;
#pragma unroll
        for (int j = 0; j < 4; ++j) { x[j] = ((const LAS f32x4*)ob)[j]; ss += (x[j].x * x[j].x + x[j].y * x[j].y) + (x[j].z * x[j].z + x[j].w * x[j].w); }
        ss += __shfl_xor(ss, 1); ss += __shfl_xor(ss, 2); ss += __shfl_xor(ss, 4);
        const float rr = rsqrtf(ss * (1.f / 128.f) + EPSN);
        if (t < it.L) { const size_t row = it.row0 + t; const int c0 = it.h * 128 + 16 * sg;
            const u32x4v g0 = *(const u32x4v*)(p.GS + row * 512 + c0), g1 = *(const u32x4v*)(p.GS + row * 512 + c0 + 8);
            const f32x4* gn = (const f32x4*)(p.hgrn_norm + 16 * sg);
            const f32x4 n0 = gn[0], n1 = gn[1], n2 = gn[2], n3 = gn[3];
            u32x4v o0, o1;
            o0.x = pk2(x[0].x * rr * n0.x * bflo(g0.x), x[0].y * rr * n0.y * bfhi(g0.x)); o0.y = pk2(x[0].z * rr * n0.z * bflo(g0.y), x[0].w * rr * n0.w * bfhi(g0.y));
            o0.z = pk2(x[1].x * rr * n1.x * bflo(g0.z), x[1].y * rr * n1.y * bfhi(g0.z)); o0.w = pk2(x[1].z * rr * n1.z * bflo(g0.w), x[1].w * rr * n1.w * bfhi(g0.w));
            o1.x = pk2(x[2].x * rr * n2.x * bflo(g1.x), x[2].y * rr * n2.y * bfhi(g1.x)); o1.y = pk2(x[2].z * rr * n2.z * bflo(g1.y), x[2].w * rr * n2.w * bfhi(g1.y));
            o1.z = pk2(x[3].x * rr * n3.x * bflo(g1.z), x[3].y * rr * n3.y * bfhi(g1.z)); o1.w = pk2(x[3].z * rr * n3.z * bflo(g1.w), x[3].w * rr * n3.w * bfhi(g1.w));
            *(u32x4v*)(p.CAT + row * 1024 + c0) = o0; *(u32x4v*)(p.CAT + row * 1024 + c0 + 8) = o1; }
    }
    __syncthreads();
}
DI void s5_load_u(const Prm& p, int mt, int g, int lane, bf16x8 (&uf)[8]) {
    const int fr = lane & 15, fq = lane >> 4; int col = 16 * mt + fr; if (col >= NCOL) col = NCOL - 1;
#pragma unroll
    for (int ks = 0; ks < 8; ++ks) uf[ks] = *(const bf16x8*)(p.U + ((size_t)(16 * col + 2 * ks + (fq >> 1))) * 512 + 16 * g + 8 * (fq & 1));
}
DI void s5_b(const Prm& p, int gw, int NGW, int lane) {
    const int fr = lane & 15, fq = lane >> 4;
    for (int task = gw; task < 131 * 32; task += NGW) { const int mt = task >> 5, g = task & 31;
        bf16x8 uf[8]; s5_load_u(p, mt, g, lane, uf);
#pragma unroll
        for (int nt = 0; nt < 8; ++nt) { f32x4 acc = {0.f, 0.f, 0.f, 0.f};
#pragma unroll
            for (int ks = 0; ks < 8; ++ks) { const bf16x8 b = *(const bf16x8*)(p.HT + ((size_t)(g * 128 + 16 * nt + fr)) * 256 + 32 * ks + 8 * fq); acc = MFMA16(uf[ks], b, acc); }
#pragma unroll
            for (int j = 0; j < 4; ++j) { const int col = 16 * mt + 4 * fq + j; if (col < NCOL) p.XLOC[(size_t)col * 4096 + g * 128 + 16 * nt + fr] = acc[j]; } }
    }
}
DI void s5_c(const Prm& p, int gtid) {
    if (gtid >= 16 * 2048) return;
    const int seq = gtid >> 11, g = (gtid >> 6) & 31, n = gtid & 63; const bool smp = seq >= 8; const int b = seq & 7;
    const int col0 = smp ? 2056 + 4 * b : 257 * b, nch = smp ? 4 : 257;
    float xr = 0.f, xi = 0.f; if (smp) { xr = p.ssm_re0[(b * 32 + g) * 64 + n]; xi = p.ssm_im0[(b * 32 + g) * 64 + n]; }
    const float ar = p.A16[2 * (g * 64 + n)], ai = p.A16[2 * (g * 64 + n) + 1];
    const size_t base = (size_t)g * 128 + 2 * n;
    for (int c0 = 0; c0 < nch; c0 += 8) {
        f32x2v xl[8];
#pragma unroll
        for (int i = 0; i < 8; ++i) if (c0 + i < nch) xl[i] = *(const f32x2v*)(p.XLOC + (size_t)(col0 + c0 + i) * 4096 + base);
#pragma unroll
        for (int i = 0; i < 8; ++i) if (c0 + i < nch) { *(unsigned*)(p.XPREV + (size_t)(col0 + c0 + i) * 4096 + base) = pk2(xr, xi);
            const float nr = ar * xr - ai * xi + xl[i].x, ni = ar * xi + ai * xr + xl[i].y; xr = nr; xi = ni; } }
    const size_t o = (size_t)(b * 32 + g) * 64 + n;
    p.out[(smp ? O_SRS : O_SRP) + o] = xr; p.out[(smp ? O_SIS : O_SIP) + o] = xi;
}
DI f32x2v gelu_pk(f32x2v v) {
    const f32x2v av = __builtin_elementwise_abs(v), d = av * 0.2316418882f + 1.0f;
    f32x2v t; t.x = __builtin_amdgcn_rcpf(d.x); t.y = __builtin_amdgcn_rcpf(d.y);
    f32x2v q = t * 0.5307027145f + (-0.7265760135f); q = q * t + 0.7107068705f; q = q * t + (-0.142248368f); q = q * t + 0.127414796f; q = q * t;
    const f32x2v s = (v * v) * (-0.72134752044f);
    f32x2v e; e.x = __builtin_amdgcn_exp2f(s.x); e.y = __builtin_amdgcn_exp2f(s.y);
    const f32x2v m = v * (q * e), r = v - m;
    f32x2v o; o.x = v.x < 0.f ? m.x : r.x; o.y = v.y < 0.f ? m.y : r.y; return o;
}
DI void s5_d(const Prm& p, int gw, int NGW, int lane) {
    const int fr = lane & 15, fq = lane >> 4;
    for (int task = gw; task < 131 * 32; task += NGW) { const int mt = task >> 5, g = task & 31;
        bf16x8 uf[8], xf[4]; s5_load_u(p, mt, g, lane, uf);
        int colc = 16 * mt + fr; if (colc >= NCOL) colc = NCOL - 1;
#pragma unroll
        for (int ks = 0; ks < 4; ++ks) xf[ks] = *(const bf16x8*)(p.XPREV + (size_t)colc * 4096 + g * 128 + 32 * ks + 8 * fq);
        const bf16_t* tg = p.TG + ((size_t)(g * 256 + fr)) * 384 + 8 * fq;
        const bool ok = 16 * mt + fr < NCOL;
#pragma unroll
        for (int t = 0; t < 16; ++t) { f32x4 acc = {0.f, 0.f, 0.f, 0.f};
#pragma unroll
            for (int ks = 0; ks < 8; ++ks) if (ks <= (t >> 1)) { const bf16x8 a = *(const bf16x8*)(tg + (size_t)t * 16 * 384 + 32 * ks); acc = MFMA16(a, uf[ks], acc); }
#pragma unroll
            for (int ks = 0; ks < 4; ++ks) { const bf16x8 a = *(const bf16x8*)(tg + (size_t)t * 16 * 384 + 256 + 32 * ks); acc = MFMA16(a, xf[ks], acc); }
            const f32x2v y0 = gelu_pk((f32x2v){acc[0], acc[1]}), y1 = gelu_pk((f32x2v){acc[2], acc[3]});
            u32x2 o; o.x = pk2(y0.x, y0.y); o.y = pk2(y1.x, y1.y);
            if (ok) *(u32x2*)(p.YG + ((size_t)(16 * (16 * mt + fr) + t)) * 512 + 16 * g + 4 * fq) = o; }
    }
}
DI void cache_convert(const Prm& p, int gtid, int GT) {
    for (size_t i = (size_t)gtid; i < (size_t)8 * 1024 * 256; i += (size_t)GT) {
        const size_t row = i >> 8; const int c4 = (int)(i & 255) * 4, b = (int)(row >> 10), pos = (int)(row & 1023), h = c4 >> 7, d = c4 & 127;
        const f32x4 k = *(const f32x4*)(p.cache_k + row * 1024 + c4); u32x2 o; o.x = pk2(k.x, k.y); o.y = pk2(k.z, k.w);
        *(u32x2*)(p.KS + kf_index(b * 8 + h, 34, pos, d)) = o;
        const f32x4 v = *(const f32x4*)(p.cache_v + row * 1024 + c4); bf16_t* vt = p.VTS + vf_index(b * 8 + h, 34, pos, d);
        vt[0] = f2bf(v.x); vt[8] = f2bf(v.y); vt[16] = f2bf(v.z); vt[24] = f2bf(v.w); }
}
DI void attn_phase(const Prm& p, int gw, int NGW, int lane) {
    const int q = lane & 31, half = lane >> 5;
    for (int it = gw; it < 8256 + 128; it += NGW) {
        bool smp; int b, h, qb;
        if (it < 8256) { smp = false; b = it / 1032; const int rem = it - b * 1032; h = rem / 129; qb = rem - h * 129; } else { const int s = it - 8256; smp = true; b = s >> 4; h = (s >> 1) & 7; qb = s & 1; }
        const size_t tbase = (size_t)(b * 8 + h) * (smp ? 34 : 129) * 4096 + lane * 8;
        const bf16_t* Kb = (smp ? p.KS : p.KP) + tbase; const bf16_t* Vb = (smp ? p.VTS : p.VTP) + tbase;
        const int qpos0 = (smp ? 1024 : 0) + 32 * qb, qrow0 = smp ? NTP + b * 64 + 32 * qb : b * TP + 32 * qb;
        const int qpos = qpos0 + q; const bool qvalid = smp || qpos < TP; const size_t qrow = qvalid ? qrow0 + q : qrow0;
        bf16x8 qf[8];
#pragma unroll
        for (int ks = 0; ks < 8; ++ks) qf[ks] = *(const bf16x8*)(p.Q + qrow * 1024 + h * 128 + 16 * ks + 8 * half);
        f32x16 o[4];
#pragma unroll
        for (int db = 0; db < 4; ++db)
#pragma unroll
            for (int e = 0; e < 16; ++e) o[db][e] = 0.f;
        float C = 1.f;
        for (int kt = (qpos0 + 30) >> 5; kt >= 0; --kt) {
            f32x16 s;
#pragma unroll
            for (int e = 0; e < 16; ++e) s[e] = 0.f;
            const bf16_t* kr = Kb + (size_t)kt * 4096; const bf16_t* vr = Vb + (size_t)kt * 4096;
            bf16x8 kf[8], vf[8];
#pragma unroll
            for (int ks = 0; ks < 8; ++ks) kf[ks] = *(const bf16x8*)(kr + ks * 512);
#pragma unroll
            for (int ks = 0; ks < 8; ++ks) vf[ks] = *(const bf16x8*)(vr + ks * 512);
#pragma unroll
            for (int ks = 0; ks < 8; ++ks) s = MFMA32(kf[ks], qf[ks], s);
            float pr[16], be[16], G[4], Gp[4];
#pragma unroll
            for (int i = 0; i < 4; ++i) {
#pragma unroll
                for (int j = 0; j < 4; ++j) { const int key = 32 * kt + 8 * i + 4 * half + j; const bool valid = key < qpos;
                    float z = s[4 * i + j] * 0.08838834764831845f; z = fminf(fmaxf(z, -80.f), 80.f);
                    const float e = __expf(z), pp = __builtin_amdgcn_rcpf(1.f + e); pr[4 * i + j] = valid ? pp : 1.f; be[4 * i + j] = valid ? e * pp : 0.f; }
                G[i] = (pr[4 * i] * pr[4 * i + 1]) * (pr[4 * i + 2] * pr[4 * i + 3]); }
#pragma unroll
            for (int i = 0; i < 4; ++i) Gp[i] = __shfl_xor(G[i], 32);
            float w[16]; float E1 = 1.f;
#pragma unroll
            for (int i = 3; i >= 0; --i) { const float Glo = half ? Gp[i] : G[i], Ghi = half ? G[i] : Gp[i];
                float suf = C * (half ? E1 : E1 * Ghi);
#pragma unroll
                for (int j = 3; j >= 0; --j) { w[4 * i + j] = be[4 * i + j] * suf; suf *= pr[4 * i + j]; }
                E1 *= Glo * Ghi; }
            C *= E1;
#pragma unroll
            for (int c = 0; c < 2; ++c) { union { bf16x8 v; unsigned u[4]; } wf;
#pragma unroll
                for (int e = 0; e < 4; ++e) wf.u[e] = pk2(w[8 * c + 2 * e], w[8 * c + 2 * e + 1]);
#pragma unroll
                for (int db = 0; db < 4; ++db) o[db] = MFMA32(vf[4 * c + db], wf.v, o[db]); }
            if (__all(C < 1e-24f)) break;
        }
        if (qvalid) {
#pragma unroll
            for (int db = 0; db < 4; ++db)
#pragma unroll
                for (int i = 0; i < 4; ++i) { u32x2 ov; ov.x = pk2(o[db][4 * i], o[db][4 * i + 1]); ov.y = pk2(o[db][4 * i + 2], o[db][4 * i + 3]);
                    *(u32x2*)(p.O + qrow * 1024 + h * 128 + 32 * db + 8 * i + 4 * half) = ov; } }
    }
}
DI void final_norm(const Prm& p, int gw, int NGW, int lane) {
    for (int r = gw; r < 32768 + 512; r += NGW) {
        int grow; float* dst;
        if (r < 32768) { const int b = r >> 12, t = r & 4095; grow = b * TP + 16 + t; dst = p.out + O_YP + (size_t)r * 1024; } else { grow = NTP + (r - 32768); dst = p.out + O_YS + (size_t)(r - 32768) * 1024; }
        const float rr = row_rinv(p.SSQ, grow);
#pragma unroll
        for (int j = 0; j < 4; ++j) { f32x4 v = ((f32x4*)dst)[lane + 64 * j]; const f32x4 g = ((const f32x4*)p.ln_final)[lane + 64 * j]; v = v * rr * g; ((f32x4*)dst)[lane + 64 * j] = v; }
    }
}
constexpr int LDS_BYTES = 131072;
__global__ void __launch_bounds__(512, 2) fwd_megakernel(Prm p) {
    extern __shared__ __attribute__((aligned(16))) unsigned char shm[];
    LAS unsigned char* lds = (LAS unsigned char*)shm;
    cg::grid_group grid = cg::this_grid();
    const int tid = threadIdx.x, lane = tid & 63, wave = __builtin_amdgcn_readfirstlane(tid >> 6);
    const int gw = blockIdx.x * 8 + wave, NGW = gridDim.x * 8, gtid = blockIdx.x * 512 + tid, GT = gridDim.x * 512;
    phase_prologue(p, lds, tid, lane, wave);
    grid.sync();
    { EpiIn0 E; E.SSQ = p.SSQ; E.LB = p.LB; E.Qh = p.Qh; E.IV = p.IV; E.GS = p.GS; E.U = p.U; E.LOGF = p.LOGF; run_gemm(lds, p.XB, p.Wt1, 2560, 1024, E); }
    grid.sync();
    for (int item = blockIdx.x; item < NITEM_H; item += gridDim.x) hgrn_b1(p, item, lds, tid, lane, wave);
    s5_b(p, gw, NGW, lane);
    grid.sync();
    hgrn_b2(p, gtid, GT);
    s5_c(p, gtid);
    grid.sync();
    for (int item = blockIdx.x; item < NITEM_H; item += gridDim.x) hgrn_b3(p, item, lds, tid, lane, wave);
    s5_d(p, gw, NGW, lane);
    grid.sync();
    { EpiGlu E; E.YG = p.YG; E.CAT = p.CAT; run_gemm(lds, p.YG, p.Wglu, 512, 512, E); }
    grid.sync();
    { EpiRes E; E.XB = p.XB; E.SSQ = p.SSQ; run_gemm(lds, p.CAT, p.Wo0, 1024, 1024, E); }
    grid.sync();
    { EpiUp E; E.SSQ = p.SSQ; E.H = p.H; run_gemm(lds, p.XB, p.Wup0, 4096, 1024, E); }
    grid.sync();
    { EpiRes E; E.XB = p.XB; E.SSQ = p.SSQ; run_gemm(lds, p.H, p.Wdn0, 1024, 4096, E); }
    grid.sync();
    cache_convert(p, gtid, GT);
    { EpiQkv E; E.SSQ = p.SSQ; E.out = p.out; E.Q = p.Q; E.KP = p.KP; E.KS = p.KS; E.VTP = p.VTP; E.VTS = p.VTS; run_gemm(lds, p.XB, p.Wqkv, 3072, 1024, E); }
    grid.sync();
    attn_phase(p, gw, NGW, lane);
    grid.sync();
    { EpiRes E; E.XB = p.XB; E.SSQ = p.SSQ; run_gemm(lds, p.O, p.Wo1, 1024, 1024, E); }
    grid.sync();
    { EpiUp E; E.SSQ = p.SSQ; E.H = p.H; run_gemm(lds, p.XB, p.Wup1, 4096, 1024, E); }
    grid.sync();
    { EpiFin E; E.XB = p.XB; E.SSQ = p.SSQ; E.out = p.out; run_gemm(lds, p.H, p.Wdn1, 1024, 4096, E); }
    grid.sync();
    final_norm(p, gw, NGW, lane);
}

extern "C" void kernel_launch(void* const* d_in, const int* in_sizes, int n_in, void* d_out, int out_size, void* d_ws, size_t ws_size, hipStream_t stream) {
    static int grid_blocks = 0;
    if (grid_blocks == 0) {
        int dev = 0, cus = 0, per_cu = 0;
        hipGetDevice(&dev); hipDeviceGetAttribute(&cus, hipDeviceAttributeMultiprocessorCount, dev);
        if (hipFuncSetAttribute((const void*)fwd_megakernel, hipFuncAttributeMaxDynamicSharedMemorySize, LDS_BYTES) != hipSuccess) fprintf(stderr, "kernel_launch: hipFuncSetAttribute failed\n");
        if (hipOccupancyMaxActiveBlocksPerMultiprocessor(&per_cu, (const void*)fwd_megakernel, 512, LDS_BYTES) != hipSuccess || per_cu < 1) { fprintf(stderr, "kernel_launch: occupancy query says %d\n", per_cu); per_cu = 1; }
        (void)hipGetLastError();
        grid_blocks = cus > 0 ? cus : 256;
    }
    Prm p{};
    const float* const* in = (const float* const*)d_in;
    p.x_prompt = in[0]; p.x_sample = in[1]; p.state_hgrn = in[2]; p.ssm_re0 = in[3]; p.ssm_im0 = in[4]; p.cache_k = in[5]; p.cache_v = in[6]; p.meta = in[7]; p.ln_mix = in[8]; p.ln_mlp = in[9];
    p.ln_final = in[10]; p.w_in_even = in[11]; p.hgrn_lb = in[12]; p.hgrn_norm = in[13]; p.a_re = in[14]; p.a_im = in[15]; p.log_dt = in[16]; p.b_re = in[17]; p.b_im = in[18]; p.c_re = in[19];
    p.c_im = in[20]; p.ssm_d = in[21]; p.w_glu = in[22]; p.w_out_even = in[23]; p.w_in_odd = in[24]; p.w_out_odd = in[25]; p.w_up = in[26]; p.w_down = in[27];
    p.out = (float*)d_out;
    unsigned char* ws = (unsigned char*)d_ws; size_t off = 0;
    auto take = [&](size_t bytes) { unsigned char* r = ws + off; off += (bytes + 255) & ~(size_t)255; return r; };
    p.Wt1 = (bf16_t*)take((size_t)2560 * 1024 * 2); p.Wglu = (bf16_t*)take((size_t)512 * 512 * 2); p.Wo0 = (bf16_t*)take((size_t)1024 * 1024 * 2); p.Wup0 = (bf16_t*)take((size_t)4096 * 1024 * 2);
    p.Wdn0 = (bf16_t*)take((size_t)4096 * 1024 * 2); p.Wqkv = (bf16_t*)take((size_t)3072 * 1024 * 2); p.Wo1 = (bf16_t*)take((size_t)1024 * 1024 * 2); p.Wup1 = (bf16_t*)take((size_t)4096 * 1024 * 2);
    p.Wdn1 = (bf16_t*)take((size_t)4096 * 1024 * 2);
    p.XB = (bf16_t*)take((size_t)MP * 1024 * 2); p.SSQ = (float*)take((size_t)MP * 16 * 4); p.LB = (float*)take(2048); p.KTAB = (float*)take((size_t)32 * 16 * 256 * 4);
    p.TG = (bf16_t*)take((size_t)32 * 256 * 384 * 2); p.HT = (bf16_t*)take((size_t)32 * 128 * 256 * 2); p.A16 = (float*)take(32 * 64 * 2 * 4);
    const size_t S0 = off; constexpr size_t SZ512 = (size_t)MP * 512 * 2;
    p.Qh = (bf16_t*)take(SZ512); p.LOGF = (unsigned short*)take(SZ512); p.IV = (bf16_t*)take(SZ512); p.GS = (bf16_t*)take(SZ512); p.U = (bf16_t*)take(SZ512);
    p.UT = (bf16_t*)take((size_t)NITEM_H * 16384 * 2); p.AL = (float*)take((size_t)NITEM_H * 128 * 4);
    p.XLOC = (float*)take(SZ512); p.YG = (bf16_t*)p.XLOC;
    p.XPREV = (bf16_t*)take((size_t)NCOL * 4096 * 2); p.CAT = (bf16_t*)take((size_t)MP * 1024 * 2);
    size_t end = off;
    off = S0; p.H = (bf16_t*)take((size_t)MP * 4096 * 2); if (off > end) end = off;
    off = S0; p.Q = (bf16_t*)take((size_t)MP * 1024 * 2); p.KP = (bf16_t*)take((size_t)64 * 129 * 4096 * 2); p.KS = (bf16_t*)take((size_t)64 * 34 * 4096 * 2);
    p.VTP = (bf16_t*)take((size_t)64 * 129 * 4096 * 2); p.VTS = (bf16_t*)take((size_t)64 * 34 * 4096 * 2); p.O = (bf16_t*)take((size_t)MP * 1024 * 2); if (off > end) end = off;
    if (end > ws_size || n_in != 28 || (size_t)out_size != O_END) { fprintf(stderr, "kernel_launch: workspace/shape mismatch: need %zu have %zu, n_in %d, out %d\n", end, ws_size, n_in, out_size); return; }
    void* args[] = {&p};
    hipError_t e = hipLaunchCooperativeKernel((const void*)fwd_megakernel, dim3(grid_blocks), dim3(512), args, LDS_BYTES, stream);
    if (e != hipSuccess) fprintf(stderr, "cooperative launch failed: %s (grid %d)\n", hipGetErrorString(e), grid_blocks);
}
```

```cpp
#include <hip/hip_runtime.h>
#include <hip/hip_cooperative_groups.h>
#include <cstdio>
#include <cstdint>
namespace cg = cooperative_groups;
namespace pg8 {
#define PG8_LAS __attribute__((address_space(3)))
typedef unsigned short bf16_t;
typedef short bf16x8 __attribute__((ext_vector_type(8)));
typedef float f32x4 __attribute__((ext_vector_type(4)));
typedef unsigned u32x4 __attribute__((ext_vector_type(4)));
constexpr int BM = 256, BK = 64, HALF = 128, HTB = HALF * BK * 2  , STAGE_BYTES = 8 * HTB, NXCD = 8, WGM = 8;

__host__ __device__ __forceinline__ int lds_byte(int r, int c) { const int st = (r >> 4) * 2 + (c >> 5), rr = r & 15, cc = c & 31, ob = rr * 64 + cc * 2; return st * 1024 + (ob ^ (((ob >> 9) & 1) << 5)); }
__host__ __device__ __forceinline__ void stage_rc(int b, int& R, int& C) { const int st = b / 1024, sb = b % 1024, swz = sb ^ (((sb >> 9) & 1) << 5); R = (st >> 1) * 16 + swz / 64; C = (st & 1) * 32 + (swz % 64) / 2; }
__host__ __device__ __forceinline__ int perm32(int rho) { const int n = rho >> 4, i = rho & 15; return 8 * (i >> 2) + 4 * n + (i & 3); }

struct Unit { int pm, pn, kb, nk, part; };
struct Gemm { const bf16_t* A; const bf16_t* Bt; int M, N, K; float* part; };

struct StaticOrder {
    int nM, nN, nwg, G, c;
    __host__ __device__ void init(int M, int N, int G_, int c_) { nM = M / BM; nN = N / BM; nwg = nM * nN; G = G_; c = c_; }
    __host__ __device__ void map(int L, Unit& u) const {
        int wgid = L; { const int q = nwg / NXCD, r = nwg % NXCD, xcd = wgid % NXCD, off = wgid / NXCD; wgid = (xcd < r ? xcd * (q + 1) : r * (q + 1) + (xcd - r) * q) + off; }
        const int nig = WGM * nN, gid = wgid / nig, fm = gid * WGM, gsz = (nM - fm) < WGM ? (nM - fm) : WGM;
        u.pm = fm + ((wgid % nig) % gsz); u.pn = (wgid % nig) / gsz; u.kb = 0; u.nk = 0; u.part = -1;
    }
    __host__ __device__ bool next(int i, Unit& u) const {
        const long L = (long)i * G + c; if (L >= nwg) return false;
        map((int)L, u); return true;
    }
    __device__ __forceinline__ void a_ready(const Unit&) const {}
    __device__ __forceinline__ void done(const Unit&) const {}
};
template <class Epi, class Sched>
__device__ __forceinline__ void gemm_phase(PG8_LAS unsigned char* lds, const Gemm g, const Sched& S, const Epi& E) {
    const int tid = threadIdx.x, wid = __builtin_amdgcn_readfirstlane(tid >> 6), lane = tid & 63, wr = wid >> 2, wc = wid & 3, fr = lane & 15, fq = lane >> 4;
    const int K = g.K, nt = K / BK;
    unsigned voffA[2], voffB[2];
#pragma unroll
    for (int i = 0; i < 2; ++i) { int R, C; stage_rc(tid * 16 + i * 8192, R, C); const int Rb = Epi::PERM ? ((R & ~31) + perm32(R & 31)) : R;
        voffA[i] = (unsigned)(R * K + C) * 2u; voffB[i] = (unsigned)(Rb * K + C) * 2u; }
    const size_t kstep = (size_t)(BK * 2);
    const size_t hstep = (size_t)HALF * K * 2;
    const size_t tstep = 2 * hstep;
    const unsigned ldsw = (unsigned)wid * 1024u;
    const int aoff = lds_byte(wr * 64 + fr, fq * 8), boff = lds_byte(wc * 32 + fr, fq * 8);
#define PG8_SA(b, h) (((b) * 2 + (h)) * HTB)
#define PG8_SB(b, h) ((4 + (b) * 2 + (h)) * HTB)
#define PG8_STAGE(bufoff, gbase, voff) do { _Pragma("unroll") for (int _i = 0; _i < 2; ++_i) \
        __builtin_amdgcn_global_load_lds((const unsigned*)((const char*)(gbase) + (voff)[_i]), (PG8_LAS unsigned*)(lds + (bufoff) + ldsw + _i * 8192), 16, 0, 0); } while (0)
#define PG8_LDA(dst, b, h) do { _Pragma("unroll") for (int m = 0; m < 4; ++m) _Pragma("unroll") for (int k = 0; k < 2; ++k) dst[m][k] = *(const PG8_LAS bf16x8*)(lds + PG8_SA(b, h) + aoff + m * 2048 + k * 1024); } while (0)
#define PG8_LDB(dst, b, h) do { _Pragma("unroll") for (int n = 0; n < 2; ++n) _Pragma("unroll") for (int k = 0; k < 2; ++k) dst[n][k] = *(const PG8_LAS bf16x8*)(lds + PG8_SB(b, h) + boff + n * 2048 + k * 1024); } while (0)
#define PG8_MMA(ai, bj, At, Bt) do { __builtin_amdgcn_s_setprio(1); _Pragma("unroll") for (int m = 0; m < 4; ++m) _Pragma("unroll") for (int n = 0; n < 2; ++n) _Pragma("unroll") for (int k = 0; k < 2; ++k) \
        acc[ai][bj][m][n] = __builtin_amdgcn_mfma_f32_16x16x32_bf16(Bt[n][k], At[m][k], acc[ai][bj][m][n], 0, 0, 0); __builtin_amdgcn_s_setprio(0); } while (0)
#define PG8_WAIT_V(n) asm volatile("s_waitcnt vmcnt(" #n ")" ::: "memory")
#define PG8_WAIT_L(n) asm volatile("s_waitcnt lgkmcnt(" #n ")" ::: "memory")
#define PG8_BAR __builtin_amdgcn_s_barrier()
#define PG8_SCHED __builtin_amdgcn_sched_barrier(0)
    Unit cur, nxt; int ui = 0;
    if (!S.next(0, cur)) return;
    f32x4 acc[2][2][4][2];
#pragma unroll
    for (int a = 0; a < 2; ++a)
#pragma unroll
        for (int b = 0; b < 2; ++b)
#pragma unroll
            for (int m = 0; m < 4; ++m)
#pragma unroll
                for (int n = 0; n < 2; ++n) acc[a][b][m][n] = (f32x4){0.f, 0.f, 0.f, 0.f};
    bf16x8 At[4][2], B0[2][2], B1[2][2];
    const char* cA = (const char*)g.A + (size_t)cur.pm * tstep + (size_t)cur.kb * kstep; const char* cB = (const char*)g.Bt + (size_t)cur.pn * tstep + (size_t)cur.kb * kstep;
    S.a_ready(cur);
    PG8_STAGE(PG8_SB(0, 0), cB, voffB); PG8_STAGE(PG8_SA(0, 0), cA, voffA); PG8_STAGE(PG8_SB(0, 1), cB + hstep, voffB); PG8_STAGE(PG8_SA(0, 1), cA + hstep, voffA);
    if (wr == 1) PG8_BAR;
    PG8_WAIT_V(4); PG8_BAR;
    PG8_STAGE(PG8_SB(1, 0), cB + kstep, voffB); PG8_STAGE(PG8_SA(1, 0), cA + kstep, voffA); PG8_STAGE(PG8_SB(1, 1), cB + hstep + kstep, voffB);
    PG8_WAIT_V(6); PG8_BAR;
    for (;;) {
        const bool has_next = S.next(ui + 1, nxt);
        const char* nA = has_next ? (const char*)g.A + (size_t)nxt.pm * tstep + (size_t)nxt.kb * kstep : cA; const char* nB = has_next ? (const char*)g.Bt + (size_t)nxt.pn * tstep + (size_t)nxt.kb * kstep : cB;
        const int cnk = cur.nk ? cur.nk : nt;
        for (int t = 0; t < cnk; t += 2) {
            const bool last = (t == cnk - 2);
            const char* a1 = cA + (size_t)(t + 1) * kstep;
            const char* a2 = last ? nA : cA + (size_t)(t + 2) * kstep; const char* b2 = last ? nB : cB + (size_t)(t + 2) * kstep;
            const char* a3 = a2 + kstep; const char* b3 = b2 + kstep;
            if (last && has_next) S.a_ready(nxt);
            PG8_LDB(B0, 0, 0); PG8_SCHED; PG8_LDA(At, 0, 0); PG8_STAGE(PG8_SA(1, 1), a1 + hstep, voffA);
            PG8_WAIT_L(8); PG8_BAR; PG8_WAIT_L(0); PG8_MMA(0, 0, At, B0); PG8_BAR; PG8_SCHED;
            PG8_LDB(B1, 0, 1); PG8_STAGE(PG8_SB(0, 0), b2, voffB);
            PG8_BAR; PG8_WAIT_L(0); PG8_MMA(0, 1, At, B1); PG8_BAR;
            PG8_LDA(At, 0, 1); PG8_STAGE(PG8_SA(0, 0), a2, voffA);
            PG8_BAR; PG8_WAIT_L(0); PG8_MMA(1, 0, At, B0); PG8_BAR; PG8_SCHED;
            PG8_STAGE(PG8_SB(0, 1), b2 + hstep, voffB);
            PG8_WAIT_V(6); PG8_BAR; PG8_MMA(1, 1, At, B1); PG8_BAR;
            PG8_LDB(B0, 1, 0); PG8_SCHED; PG8_LDA(At, 1, 0); PG8_STAGE(PG8_SA(0, 1), a2 + hstep, voffA);
            PG8_WAIT_L(8); PG8_BAR; PG8_WAIT_L(0); PG8_MMA(0, 0, At, B0); PG8_BAR; PG8_SCHED;
            PG8_LDB(B1, 1, 1); PG8_STAGE(PG8_SB(1, 0), b3, voffB);
            PG8_BAR; PG8_WAIT_L(0); PG8_MMA(0, 1, At, B1); PG8_BAR;
            PG8_LDA(At, 1, 1); PG8_STAGE(PG8_SA(1, 0), a3, voffA);
            PG8_BAR; PG8_WAIT_L(0); PG8_MMA(1, 0, At, B0); PG8_BAR; PG8_SCHED;
            PG8_STAGE(PG8_SB(1, 1), b3 + hstep, voffB);
            PG8_WAIT_V(6); PG8_BAR; PG8_MMA(1, 1, At, B1); PG8_BAR;
        }
        if constexpr (!Epi::AFTER_DRAIN) {
            if (cur.part < 0) E(acc, cur, wr, wc, fr, fq);
            else { f32x4* pp = (f32x4*)g.part + (size_t)cur.part * 32 * 512 + tid;
#pragma unroll
                for (int a = 0; a < 2; ++a)
#pragma unroll
                    for (int b = 0; b < 2; ++b)
#pragma unroll
                        for (int m = 0; m < 4; ++m)
#pragma unroll
                            for (int n = 0; n < 2; ++n) pp[(size_t)(((a * 2 + b) * 4 + m) * 2 + n) * 512] = acc[a][b][m][n]; }
            S.done(cur); }
        if (!has_next) break;
#pragma unroll
        for (int a = 0; a < 2; ++a)
#pragma unroll
            for (int b = 0; b < 2; ++b)
#pragma unroll
                for (int m = 0; m < 4; ++m)
#pragma unroll
                    for (int n = 0; n < 2; ++n) acc[a][b][m][n] = (f32x4){0.f, 0.f, 0.f, 0.f};
        cur = nxt; cA = nA; cB = nB; ++ui;
    }
    PG8_WAIT_V(0);
    if (wr == 0) PG8_BAR;
    PG8_BAR;
    if constexpr (Epi::AFTER_DRAIN) { E.fused(acc, cur, wr, wc, fr, fq, lds, wid, lane); S.done(cur); }
#undef PG8_SA
#undef PG8_SB
#undef PG8_STAGE
#undef PG8_LDA
#undef PG8_LDB
#undef PG8_MMA
#undef PG8_WAIT_V
#undef PG8_WAIT_L
#undef PG8_BAR
#undef PG8_SCHED
}
}
using pg8::bf16_t; using pg8::bf16x8; using pg8::f32x4; using pg8::Unit;
typedef float f32x16 __attribute__((ext_vector_type(16)));
typedef float f32x2v __attribute__((ext_vector_type(2)));
typedef unsigned u32x2 __attribute__((ext_vector_type(2)));
typedef unsigned u32x4v __attribute__((ext_vector_type(4)));
#define LAS __attribute__((address_space(3)))
#define DI __device__ __forceinline__

constexpr int DM = 1024, TP = 4112, NTP = 8 * TP  , NTS = 512, NT = NTP + NTS  , MP = 33536  ;
constexpr int NITEM_H = 2112;
constexpr int NCOL = NT / 16;
constexpr float EPSN = 1e-6f;
constexpr size_t O_YP = 0, O_YS = O_YP + (size_t)8 * 4096 * 1024, O_HGP = O_YS + 524288, O_HGS = O_HGP + 524288, O_SRP = O_HGS + 524288, O_SIP = O_SRP + 16384,
                 O_SRS = O_SIP + 16384, O_SIS = O_SRS + 16384, O_KP = O_SIS + 16384, O_VP = O_KP + (size_t)NTP * 1024, O_KS = O_VP + (size_t)NTP * 1024, O_VS = O_KS + 524288, O_END = O_VS + 524288;

struct Prm {
    const float *x_prompt, *x_sample, *state_hgrn, *ssm_re0, *ssm_im0, *cache_k, *cache_v, *meta, *ln_mix, *ln_mlp, *ln_final, *w_in_even, *hgrn_lb, *hgrn_norm,
        *a_re, *a_im, *log_dt, *b_re, *b_im, *c_re, *c_im, *ssm_d, *w_glu, *w_out_even, *w_in_odd, *w_out_odd, *w_up, *w_down;
    float* out;
    bf16_t *Wt1, *Wglu, *Wo0, *Wup0, *Wdn0, *Wqkv, *Wo1, *Wup1, *Wdn1;
    bf16_t* XB; float* SSQ; float* LB; float* KTAB; bf16_t* TG; bf16_t* HT; float* A16;
    bf16_t *Qh, *IV, *GS, *U; unsigned short* LOGF; bf16_t* UT; float* AL; float* XLOC; bf16_t* XPREV; bf16_t* YG; bf16_t* CAT;
    bf16_t* H;
    bf16_t *Q, *KP, *KS, *VTP, *VTS, *O;
};

DI unsigned pk2(float lo, float hi) { unsigned r; asm volatile("v_cvt_pk_bf16_f32 %0, %1, %2" : "=v"(r) : "v"(lo), "v"(hi)); return r; }
DI float bflo(unsigned u) { return __uint_as_float(u << 16); }
DI float bfhi(unsigned u) { return __uint_as_float(u & 0xffff0000u); }
DI float bf2f(unsigned short b) { return __uint_as_float(((unsigned)b) << 16); }
DI unsigned short f2bf(float f) { return (unsigned short)(pk2(f, 0.f) & 0xffffu); }
DI unsigned pkh2(float lo, float hi) { union { _Float16 h[2]; unsigned u; } x; x.h[0] = (_Float16)lo; x.h[1] = (_Float16)hi; return x.u; }
DI float h2f(unsigned short h) { union { unsigned short s; _Float16 h; } x; x.s = h; return (float)x.h; }
DI float wave_sum(float v) {
#pragma unroll
    for (int o = 1; o < 64; o <<= 1) v += __shfl_xor(v, o);
    return v;
}
DI float fexp(float x) { return __expf(x); }
DI float sigm(float x) { return __builtin_amdgcn_rcpf(1.f + __expf(-x)); }
DI float row_rinv(const float* SSQ, int row) {
    const f32x4* s = (const f32x4*)(SSQ + (size_t)row * 16); f32x4 a = s[0] + s[1] + s[2] + s[3];
    return rsqrtf(((a.x + a.y) + (a.z + a.w)) * (1.f / 1024.f) + EPSN);
}
#define LDS_WAIT() asm volatile("s_waitcnt lgkmcnt(0)" ::: "memory")

struct EpiIn0 {
    static constexpr bool PERM = false, AFTER_DRAIN = false;
    const float* SSQ; const float* LB; bf16_t *Qh, *IV, *GS, *U; unsigned short* LOGF;
    DI void operator()(const f32x4 (&acc)[2][2][4][2], const Unit& u, int wr, int wc, int fr, int fq) const {
        const int seg = u.pn >> 1, cb = (u.pn & 1) * 256 + wc * 32 + 4 * fq, row0 = u.pm * 256 + wr * 64 + fr;
        unsigned short* dst = seg == 0 ? Qh : seg == 1 ? LOGF : seg == 2 ? IV : seg == 3 ? GS : U;
#pragma unroll
        for (int ai = 0; ai < 2; ++ai)
#pragma unroll
            for (int m = 0; m < 4; ++m) { const int row = row0 + ai * 128 + m * 16; const float r = row_rinv(SSQ, row);
#pragma unroll
                for (int bj = 0; bj < 2; ++bj)
#pragma unroll
                    for (int n = 0; n < 2; ++n) { const int cs = cb + bj * 128 + n * 16; f32x4 v = acc[ai][bj][m][n] * r; u32x2 o;
                        if (seg == 1) { const f32x4 lb = *(const f32x4*)(LB + cs); f32x4 f;
#pragma unroll
                            for (int e = 0; e < 4; ++e) f[e] = __logf(lb[e] + (1.f - lb[e]) * sigm(v[e]));
                            o.x = pkh2(f[0], f[1]); o.y = pkh2(f[2], f[3]); }
                        else { if (seg == 3) {
#pragma unroll
                                for (int e = 0; e < 4; ++e) v[e] = v[e] * sigm(v[e]); }
                            o.x = pk2(v[0], v[1]); o.y = pk2(v[2], v[3]); }
                        *(u32x2*)(dst + (size_t)row * 512 + cs) = o; } }
    }
};
struct EpiGlu {
    static constexpr bool PERM = false, AFTER_DRAIN = false;
    const bf16_t* YG; bf16_t* CAT;
    DI void operator()(const f32x4 (&acc)[2][2][4][2], const Unit& u, int wr, int wc, int fr, int fq) const {
        const int cb = u.pn * 256 + wc * 32 + 4 * fq, row0 = u.pm * 256 + wr * 64 + fr;
#pragma unroll
        for (int ai = 0; ai < 2; ++ai)
#pragma unroll
            for (int m = 0; m < 4; ++m) { const int row = row0 + ai * 128 + m * 16;
#pragma unroll
                for (int bj = 0; bj < 2; ++bj)
#pragma unroll
                    for (int n = 0; n < 2; ++n) { const int cs = cb + bj * 128 + n * 16; const f32x4 v = acc[ai][bj][m][n];
                        const u32x2 y = *(const u32x2*)(YG + (size_t)row * 512 + cs); u32x2 o;
                        o.x = pk2(bflo(y.x) * sigm(v[0]), bfhi(y.x) * sigm(v[1])); o.y = pk2(bflo(y.y) * sigm(v[2]), bfhi(y.y) * sigm(v[3]));
                        *(u32x2*)(CAT + (size_t)row * 1024 + 512 + cs) = o; } }
    }
};
struct EpiRes {
    static constexpr bool PERM = false, AFTER_DRAIN = false;
    bf16_t* XB; float* SSQ;
    DI void row(const f32x4 (&a4)[2][2], const Unit& u, int ai, int m, int wr, int wc, int fr, int fq) const {
        const int cb = u.pn * 256 + wc * 32 + 4 * fq, row = u.pm * 256 + wr * 64 + fr + ai * 128 + m * 16; float ss = 0.f;
#pragma unroll
        for (int bj = 0; bj < 2; ++bj)
#pragma unroll
            for (int n = 0; n < 2; ++n) { const int cs = cb + bj * 128 + n * 16; const f32x4 v = a4[bj][n];
                u32x2* px = (u32x2*)(XB + (size_t)row * 1024 + cs); const u32x2 x = *px; u32x2 o;
                o.x = pk2(bflo(x.x) + v[0], bfhi(x.x) + v[1]); o.y = pk2(bflo(x.y) + v[2], bfhi(x.y) + v[3]); *px = o;
                const float a0 = bflo(o.x), a1 = bfhi(o.x), a2 = bflo(o.y), a3 = bfhi(o.y); ss += (a0 * a0 + a1 * a1) + (a2 * a2 + a3 * a3); }
        ss += __shfl_xor(ss, 16); ss += __shfl_xor(ss, 32);
        if (fq == 0) SSQ[(size_t)row * 16 + u.pn * 4 + wc] = ss;
    }
    DI void operator()(const f32x4 (&acc)[2][2][4][2], const Unit& u, int wr, int wc, int fr, int fq) const {
#pragma unroll
        for (int ai = 0; ai < 2; ++ai)
#pragma unroll
            for (int m = 0; m < 4; ++m) { const f32x4 a4[2][2] = {{acc[ai][0][m][0], acc[ai][0][m][1]}, {acc[ai][1][m][0], acc[ai][1][m][1]}}; row(a4, u, ai, m, wr, wc, fr, fq); }
    }
};
struct EpiUp {
    static constexpr bool PERM = false, AFTER_DRAIN = false;
    const float* SSQ; bf16_t* H;
    DI void operator()(const f32x4 (&acc)[2][2][4][2], const Unit& u, int wr, int wc, int fr, int fq) const {
        const int cb = u.pn * 256 + wc * 32 + 4 * fq, row0 = u.pm * 256 + wr * 64 + fr;
#pragma unroll
        for (int ai = 0; ai < 2; ++ai)
#pragma unroll
            for (int m = 0; m < 4; ++m) { const int row = row0 + ai * 128 + m * 16; const float r = row_rinv(SSQ, row);
#pragma unroll
                for (int bj = 0; bj < 2; ++bj)
#pragma unroll
                    for (int n = 0; n < 2; ++n) { const int cs = cb + bj * 128 + n * 16; f32x4 v = acc[ai][bj][m][n] * r;
#pragma unroll
                        for (int e = 0; e < 4; ++e) { const float t = fmaxf(v[e], 0.f); v[e] = t * t; }
                        u32x2 o; o.x = pk2(v[0], v[1]); o.y = pk2(v[2], v[3]); *(u32x2*)(H + (size_t)row * 4096 + cs) = o; } }
    }
};
DI size_t kf_index(int seqh, int nkt, int key, int d) { return ((((size_t)seqh * nkt + (key >> 5)) * 8 + (d >> 4)) * 64 + ((key & 31) + 32 * ((d >> 3) & 1))) * 8 + (d & 7); }
DI size_t vf_index(int seqh, int nkt, int key, int d) { const int kk = key & 31;
    return ((((size_t)seqh * nkt + (key >> 5)) * 8 + (kk >> 4) * 4 + (d >> 5)) * 64 + ((d & 31) + 32 * ((kk >> 2) & 1))) * 8 + ((kk >> 3) & 1) * 4 + (kk & 3); }
struct EpiQkv {
    static constexpr bool PERM = false, AFTER_DRAIN = false;
    const float* SSQ; float* out; bf16_t *Q, *KP, *KS, *VTP, *VTS;
    DI void operator()(const f32x4 (&acc)[2][2][4][2], const Unit& u, int wr, int wc, int fr, int fq) const {
        const int third = u.pn >> 2, cb = (u.pn & 3) * 256 + wc * 32 + 4 * fq, row0 = u.pm * 256 + wr * 64 + fr;
#pragma unroll
        for (int ai = 0; ai < 2; ++ai)
#pragma unroll
            for (int m = 0; m < 4; ++m) { const int row = row0 + ai * 128 + m * 16; const float r = row_rinv(SSQ, row);
                const bool smp = row >= NTP; const int s = row - NTP; const int b = smp ? (s >> 6) : row / TP, key = smp ? 1024 + (s & 63) : row - b * TP, nkt = smp ? 34 : 129;
#pragma unroll
                for (int bj = 0; bj < 2; ++bj)
#pragma unroll
                    for (int n = 0; n < 2; ++n) { const int cs = cb + bj * 128 + n * 16; const f32x4 v = acc[ai][bj][m][n] * r;
                        u32x2 o; o.x = pk2(v[0], v[1]); o.y = pk2(v[2], v[3]);
                        if (third == 0) { *(u32x2*)(Q + (size_t)row * 1024 + cs) = o; }
                        else if (row < NT) { const int h = cs >> 7, d = cs & 127;
                            if (third == 1) { *(f32x4*)(out + (smp ? O_KS + (size_t)s * 1024 : O_KP + (size_t)row * 1024) + cs) = v;
                                *(u32x2*)((smp ? KS : KP) + kf_index(b * 8 + h, nkt, key, d)) = o; }
                            else { *(f32x4*)(out + (smp ? O_VS + (size_t)s * 1024 : O_VP + (size_t)row * 1024) + cs) = v;
                                bf16_t* vt = (smp ? VTS : VTP) + vf_index(b * 8 + h, nkt, key, d);
                                vt[0] = (bf16_t)(o.x & 0xffffu); vt[8] = (bf16_t)(o.x >> 16); vt[16] = (bf16_t)(o.y & 0xffffu); vt[24] = (bf16_t)(o.y >> 16); } } } }
    }
};
struct EpiFin {
    static constexpr bool PERM = false, AFTER_DRAIN = false;
    const bf16_t* XB; float* SSQ; float* out;
    DI void row(const f32x4 (&a4)[2][2], const Unit& u, int ai, int m, int wr, int wc, int fr, int fq) const {
        const int cb = u.pn * 256 + wc * 32 + 4 * fq, row = u.pm * 256 + wr * 64 + fr + ai * 128 + m * 16; float ss = 0.f;
        const int b = row / TP, t = row - b * TP; const bool ok = row < NT && (row >= NTP || t >= 16);
        float* dst = out + (row >= NTP ? O_YS + (size_t)(row - NTP) * 1024 : O_YP + ((size_t)b * 4096 + (t - 16)) * 1024);
#pragma unroll
        for (int bj = 0; bj < 2; ++bj)
#pragma unroll
            for (int n = 0; n < 2; ++n) { const int cs = cb + bj * 128 + n * 16; f32x4 v = a4[bj][n];
                const u32x2 x = *(const u32x2*)(XB + (size_t)row * 1024 + cs);
                v[0] += bflo(x.x); v[1] += bfhi(x.x); v[2] += bflo(x.y); v[3] += bfhi(x.y);
                if (ok) *(f32x4*)(dst + cs) = v;
                ss += (v[0] * v[0] + v[1] * v[1]) + (v[2] * v[2] + v[3] * v[3]); }
        ss += __shfl_xor(ss, 16); ss += __shfl_xor(ss, 32);
        if (fq == 0) SSQ[(size_t)row * 16 + u.pn * 4 + wc] = ss;
    }
    DI void operator()(const f32x4 (&acc)[2][2][4][2], const Unit& u, int wr, int wc, int fr, int fq) const {
#pragma unroll
        for (int ai = 0; ai < 2; ++ai)
#pragma unroll
            for (int m = 0; m < 4; ++m) { const f32x4 a4[2][2] = {{acc[ai][0][m][0], acc[ai][0][m][1]}, {acc[ai][1][m][0], acc[ai][1][m][1]}}; row(a4, u, ai, m, wr, wc, fr, fq); }
    }
};
template <class Epi> DI void run_gemm(LAS unsigned char* lds, const bf16_t* A, const bf16_t* Bt, int N, int K, const Epi& E) {
    pg8::Gemm g; g.A = A; g.Bt = Bt; g.M = MP; g.N = N; g.K = K; g.part = nullptr;
    pg8::StaticOrder S; S.init(MP, N, (int)gridDim.x, (int)blockIdx.x);
    pg8::gemm_phase<Epi, pg8::StaticOrder>(lds, g, S, E);
}
struct SplitOrder : pg8::StaticOrder {
    int nwhole, ntail, S, nks;
    DI void init2(int N, int K) { init(MP, N, (int)gridDim.x, (int)blockIdx.x); nwhole = nwg / G; ntail = nwg - nwhole * G; S = 0; nks = 0;
        if (ntail > 0) { int s = G / ntail; const int nkt = K / 64; while (s > 1 && (nkt % s != 0 || (nkt / s) < 4 || ((nkt / s) & 1))) --s; if (s > 1) { S = s; nks = nkt / s; } } }
    DI bool next(int i, Unit& u) const {
        if (S == 0) return pg8::StaticOrder::next(i, u);
        if (i < nwhole) { map(i * G + c, u); return true; }
        if (i == nwhole && c < ntail * S) { map(nwhole * G + c / S, u); u.kb = (c % S) * nks; u.nk = nks; u.part = c; return true; }
        return false;
    }
};
template <class Epi> DI void run_gemm_split(LAS unsigned char* lds, const bf16_t* A, const bf16_t* Bt, int N, int K, const Epi& E, float* part) {
    pg8::Gemm g; g.A = A; g.Bt = Bt; g.M = MP; g.N = N; g.K = K; g.part = part;
    SplitOrder S; S.init2(N, K);
    pg8::gemm_phase<Epi, SplitOrder>(lds, g, S, E);
}
template <class Epi> DI void gemm_fixup(int N, int K, const Epi& E, const float* part, int tid) {
    SplitOrder S; S.init2(N, K); if (S.S == 0) return;
    const int wid = tid >> 6, lane = tid & 63, wr = wid >> 2, wc = wid & 3, fr = lane & 15, fq = lane >> 4;
    for (int it = blockIdx.x; it < S.ntail * 8; it += gridDim.x) { const int j = it >> 3, ai = (it >> 2) & 1, m = it & 3; Unit u; S.map(S.nwhole * S.G + j, u);
        f32x4 a4[2][2];
#pragma unroll
        for (int b = 0; b < 2; ++b)
#pragma unroll
            for (int n = 0; n < 2; ++n) { const f32x4* pp = (const f32x4*)part + ((size_t)(j * S.S) * 32 + (((ai * 2 + b) * 4 + m) * 2 + n)) * 512 + tid;
                f32x4 v0 = {0.f, 0.f, 0.f, 0.f}, v1 = v0, v2 = v0, v3 = v0;
                for (int sl = 0; sl + 3 < S.S; sl += 4) { v0 += pp[(size_t)sl * 16384]; v1 += pp[(size_t)(sl + 1) * 16384]; v2 += pp[(size_t)(sl + 2) * 16384]; v3 += pp[(size_t)(sl + 3) * 16384]; }
                for (int sl = S.S & ~3; sl < S.S; ++sl) v0 += pp[(size_t)sl * 16384];
                a4[b][n] = (v0 + v1) + (v2 + v3); }
        E.row(a4, u, ai, m, wr, wc, fr, fq); }
}
DI void transpose_item(const float* W, int N, bf16_t* WT, size_t ldo, const float* sc, LAS float* scr, int item, int lane) {
    const int nblk = N / 32, kb = item / nblk, nb = item % nblk, k0 = 64 * kb, n0 = 32 * nb;
#pragma unroll 8
    for (int i = 0; i < 32; ++i) { const int kk = 2 * i + (lane >> 5); float w = W[(size_t)(k0 + kk) * N + n0 + (lane & 31)]; if (sc) w *= sc[k0 + kk]; scr[kk * 33 + (lane & 31)] = w; }
    LDS_WAIT();
    const int c = lane & 7;
#pragma unroll
    for (int j = 0; j < 4; ++j) { const int n = (lane >> 3) + 8 * j; const LAS float* s = scr + (8 * c) * 33 + n;
        u32x4v o; o.x = pk2(s[0 * 33], s[1 * 33]); o.y = pk2(s[2 * 33], s[3 * 33]); o.z = pk2(s[4 * 33], s[5 * 33]); o.w = pk2(s[6 * 33], s[7 * 33]);
        *(u32x4v*)(WT + (size_t)(n0 + n) * ldo + k0 + 8 * c) = o; }
    LDS_WAIT();
}
DI void s5_pow(const Prm& p, int g, int n, float k, float& re, float& im) {
    const float dt = __expf(p.log_dt[g]), ar = p.a_re[g * 64 + n], ai = p.a_im[g * 64 + n];
    const float mag = __expf(k * dt * ar); float rev = k * dt * ai * 0.15915494309189535f; rev -= rintf(rev);
    re = mag * __builtin_amdgcn_cosf(rev); im = mag * __builtin_amdgcn_sinf(rev);
}
DI void s5_bbar(const Prm& p, int g, int n, int pp, float& re, float& im) {
    const float ar = p.a_re[g * 64 + n], ai = p.a_im[g * 64 + n]; float abr, abi; s5_pow(p, g, n, 1.f, abr, abi);
    const float den = ar * ar + ai * ai, zr = ((abr - 1.f) * ar + abi * ai) / den, zi = (abi * ar - (abr - 1.f) * ai) / den;
    const float br = p.b_re[(g * 64 + n) * 16 + pp], bi = p.b_im[(g * 64 + n) * 16 + pp];
    re = zr * br - zi * bi; im = zr * bi + zi * br;
}
DI void phase_prologue(const Prm& p, LAS unsigned char* lds, int tid, int lane, int wave) {
    const int gw = blockIdx.x * 8 + wave, NGW = gridDim.x * 8, gtid = blockIdx.x * 512 + tid, GT = gridDim.x * 512;
    LAS float* scr = (LAS float*)(lds + wave * 16384);
    constexpr int I1 = 16 * 80, I2 = 8 * 16, I3 = 16 * 32, I4 = 16 * 128, I5 = 64 * 32, I6 = 16 * 96;
    constexpr int NITEMS = I1 + I2 + I3 + I4 + I5 + I6 + I3 + I4 + I5;
    for (int it = gw; it < NITEMS; it += NGW) {
        int r = it;
        if (r < I1) { transpose_item(p.w_in_even, 2560, p.Wt1, 1024, p.ln_mix, scr, r, lane); continue; } r -= I1;
        if (r < I2) { transpose_item(p.w_glu, 512, p.Wglu, 512, nullptr, scr, r, lane); continue; } r -= I2;
        if (r < I3) { transpose_item(p.w_out_even, 1024, p.Wo0, 1024, nullptr, scr, r, lane); continue; } r -= I3;
        if (r < I4) { transpose_item(p.w_up, 4096, p.Wup0, 1024, p.ln_mlp, scr, r, lane); continue; } r -= I4;
        if (r < I5) { transpose_item(p.w_down, 1024, p.Wdn0, 4096, nullptr, scr, r, lane); continue; } r -= I5;
        if (r < I6) { transpose_item(p.w_in_odd, 3072, p.Wqkv, 1024, p.ln_mix + 1024, scr, r, lane); continue; } r -= I6;
        if (r < I3) { transpose_item(p.w_out_odd, 1024, p.Wo1, 1024, nullptr, scr, r, lane); continue; } r -= I3;
        if (r < I4) { transpose_item(p.w_up + (size_t)1024 * 4096, 4096, p.Wup1, 1024, p.ln_mlp + 1024, scr, r, lane); continue; } r -= I4;
        transpose_item(p.w_down + (size_t)4096 * 1024, 1024, p.Wdn1, 4096, nullptr, scr, r, lane);
    }
    for (int row = gw; row < NT; row += NGW) {
        const float* src;
        if (row < NTP) { const int b = row / TP, t = row - b * TP; src = t < 16 ? p.meta + (size_t)t * 1024 : p.x_prompt + ((size_t)b * 4096 + (t - 16)) * 1024; }
        else src = p.x_sample + (size_t)(row - NTP) * 1024;
        float ss = 0.f;
#pragma unroll
        for (int j = 0; j < 4; ++j) { const f32x4 v = ((const f32x4*)src)[lane + 64 * j]; u32x2 o; o.x = pk2(v.x, v.y); o.y = pk2(v.z, v.w);
            const float a0 = bflo(o.x), a1 = bfhi(o.x), a2 = bflo(o.y), a3 = bfhi(o.y); ss += (a0 * a0 + a1 * a1) + (a2 * a2 + a3 * a3);
            ((u32x2*)(p.XB + (size_t)row * 1024))[lane + 64 * j] = o; }
        ss = wave_sum(ss);
        if (lane < 16) p.SSQ[(size_t)row * 16 + lane] = lane == 0 ? ss : 0.f;
    }
    if (gtid < 512) p.LB[gtid] = 1.f / (1.f + __expf(p.hgrn_lb[512 + gtid] - p.hgrn_lb[gtid]));
    __syncthreads();
    {
        LAS float* zr_ = (LAS float*)lds; LAS float* zi_ = zr_ + 64; LAS float* wr_ = zi_ + 64; LAS float* wi_ = wr_ + 64;
        LAS float* bbr = wi_ + 64; LAS float* bbi = bbr + 1024; LAS float* cwr = bbi + 1024; LAS float* cwi = cwr + 16 * 65;
        for (int pair = blockIdx.x; pair < 512; pair += gridDim.x) { const int g = pair >> 4, tau = pair & 15;
            if (tid < 64) { const int n = tid; const float ar = p.a_re[g * 64 + n], ai = p.a_im[g * 64 + n]; float abr, abi; s5_pow(p, g, n, 1.f, abr, abi);
                const float den = ar * ar + ai * ai; zr_[n] = ((abr - 1.f) * ar + abi * ai) / den; zi_[n] = (abi * ar - (abr - 1.f) * ai) / den;
                float a, b; s5_pow(p, g, n, (float)tau, a, b); wr_[n] = a; wi_[n] = b; }
            __syncthreads();
#pragma unroll
            for (int k = 0; k < 2; ++k) { const int e = tid + 512 * k;
                { const int n = e >> 4; const float br = p.b_re[g * 1024 + e], bi = p.b_im[g * 1024 + e]; bbr[e] = zr_[n] * br - zi_[n] * bi; bbi[e] = zr_[n] * bi + zi_[n] * br; }
                { const int pch = e >> 6, n = e & 63; const float cr = p.c_re[g * 1024 + e], ci = p.c_im[g * 1024 + e]; cwr[pch * 65 + n] = cr * wr_[n] - ci * wi_[n]; cwi[pch * 65 + n] = cr * wi_[n] + ci * wr_[n]; } }
            __syncthreads();
            if (tid < 256) { const int pch = tid >> 4, pp = tid & 15; float acc = 0.f;
#pragma unroll 8
                for (int n = 0; n < 64; ++n) acc += cwr[pch * 65 + n] * bbr[n * 16 + pp] - cwi[pch * 65 + n] * bbi[n * 16 + pp];
                if (tau == 0 && pch == pp) acc += p.ssm_d[g * 16 + pch];
                const bf16_t kv = f2bf(acc);
                for (int t = tau; t < 16; ++t) p.TG[((size_t)(g * 256 + t * 16 + pch)) * 384 + (t - tau) * 16 + pp] = kv;
                if (tau > 0) for (int t = 0; t < 16 - tau; ++t) p.TG[((size_t)(g * 256 + t * 16 + pch)) * 384 + (t + tau) * 16 + pp] = 0; }
            __syncthreads(); }
    }
    for (int i = gtid; i < 32 * 256 * 64; i += GT) {
        const int g = i >> 14, t = (i >> 10) & 15, pch = (i >> 6) & 15, n = i & 63; float wr_, wi_; s5_pow(p, g, n, (float)(t + 1), wr_, wi_);
        const float cr = p.c_re[(g * 16 + pch) * 64 + n], ci = p.c_im[(g * 16 + pch) * 64 + n];
        *(unsigned*)(p.TG + ((size_t)(g * 256 + t * 16 + pch)) * 384 + 256 + 2 * n) = pk2(cr * wr_ - ci * wi_, -(cr * wi_ + ci * wr_)); }
    for (int i = gtid; i < 32 * 64 * 256; i += GT) {
        const int g = i >> 14, n = (i >> 8) & 63, s = (i >> 4) & 15, pp = i & 15; float wr_, wi_, br_, bi_; s5_pow(p, g, n, (float)(15 - s), wr_, wi_); s5_bbar(p, g, n, pp, br_, bi_);
        p.HT[((size_t)(g * 128 + 2 * n)) * 256 + s * 16 + pp] = f2bf(wr_ * br_ - wi_ * bi_);
        p.HT[((size_t)(g * 128 + 2 * n + 1)) * 256 + s * 16 + pp] = f2bf(wr_ * bi_ + wi_ * br_); }
    if (gtid < 2048) { float wr_, wi_; s5_pow(p, gtid >> 6, gtid & 63, 16.f, wr_, wi_); p.A16[2 * gtid] = wr_; p.A16[2 * gtid + 1] = wi_; }
}

constexpr int HP = 136, TPI = 72;
constexpr int L_QT = 0, L_QH = 17408, L_KT = 34816, L_KTT = 52224, L_IVT = 70656, L_ATT = 89088, L_SUM = 98304, L_VEC = 100352, L_OB = 0  ;
struct HItem { int row0, L, h, bh; };
DI HItem hgrn_item(int item) {
    HItem it;
    if (item < 2080) { const int bh = item / 65, c = item - bh * 65, b = bh >> 2; it.h = bh & 3; it.bh = bh; it.L = c == 0 ? 16 : 64; it.row0 = b * TP + (c == 0 ? 0 : 16 + 64 * (c - 1)); }
    else { const int s = item - 2080, b = s >> 2; it.h = s & 3; it.bh = 32 + s; it.L = 64; it.row0 = NTP + b * 64; }
    return it;
}
template <bool FULL> DI void hgrn_prep(const Prm& p, const HItem& it, LAS unsigned char* lds, int tid) {
    const int d = tid & 127, tq = tid >> 7, t0 = 16 * tq, col = it.h * 128 + d;
    LAS float* sums = (LAS float*)(lds + L_SUM); LAS float* vec = (LAS float*)(lds + L_VEC);
    float cs[16], lf[16];
    float run = 0.f;
#pragma unroll
    for (int j = 0; j < 16; ++j) { const int t = t0 + j; lf[j] = t < it.L ? h2f(p.LOGF[(size_t)(it.row0 + t) * 512 + col]) : 0.f; run += lf[j]; cs[j] = run; }
    sums[tq * 128 + d] = run;
    unsigned ivp[8];
#pragma unroll
    for (int j = 0; j < 8; ++j) { const int t = t0 + 2 * j;
        const unsigned lo = t < it.L ? p.IV[(size_t)(it.row0 + t) * 512 + col] : 0u, hi = t + 1 < it.L ? p.IV[(size_t)(it.row0 + t + 1) * 512 + col] : 0u; ivp[j] = lo | (hi << 16); }
    { LAS u32x4v* dst = (LAS u32x4v*)(lds + L_IVT + (d * TPI + t0) * 2); u32x4v a, b; a.x = ivp[0]; a.y = ivp[1]; a.z = ivp[2]; a.w = ivp[3]; b.x = ivp[4]; b.y = ivp[5]; b.z = ivp[6]; b.w = ivp[7]; dst[0] = a; dst[1] = b; }
    __syncthreads();
    const float s0 = sums[d], s1 = sums[128 + d], s2 = sums[256 + d], s3 = sums[384 + d];
    const float off = tq == 0 ? 0.f : tq == 1 ? s0 : tq == 2 ? s0 + s1 : s0 + s1 + s2, r = s0 + s1, bL = r + s2 + s3;
    if (tq == 0) { vec[d] = r; vec[128 + d] = bL; }
    unsigned ktp[8]; float kprev = 0.f;
#pragma unroll
    for (int j = 0; j < 16; ++j) { const int t = t0 + j; const bool valid = t < it.L; const float b = off + cs[j];
        const float kt = valid ? (1.f - __expf(lf[j])) * __expf(r - b) : 0.f;
        if (j & 1) ktp[j >> 1] = pk2(kprev, kt); else kprev = kt;
        if (FULL) { const float qv = valid ? bf2f(p.Qh[(size_t)(it.row0 + t) * 512 + col]) : 0.f;
            *(LAS unsigned short*)(lds + L_KT + (t * HP + d) * 2) = f2bf(kt);
            *(LAS unsigned short*)(lds + L_QT + (t * HP + d) * 2) = f2bf(qv * __expf(b - r));
            *(LAS unsigned short*)(lds + L_QH + (t * HP + d) * 2) = f2bf(qv * __expf(b)); } }
    if (!FULL) { LAS u32x4v* dst = (LAS u32x4v*)(lds + L_KTT + (d * TPI + t0) * 2); u32x4v a, b; a.x = ktp[0]; a.y = ktp[1]; a.z = ktp[2]; a.w = ktp[3]; b.x = ktp[4]; b.y = ktp[5]; b.z = ktp[6]; b.w = ktp[7]; dst[0] = a; dst[1] = b; }
    __syncthreads();
}
#define MFMA16(a, b, c) __builtin_amdgcn_mfma_f32_16x16x32_bf16((a), (b), (c), 0, 0, 0)
#define MFMA32(a, b, c) __builtin_amdgcn_mfma_f32_32x32x16_bf16((a), (b), (c), 0, 0, 0)
DI void hgrn_b1(const Prm& p, int item, LAS unsigned char* lds, int tid, int lane, int wave) {
    const HItem it = hgrn_item(item);
    hgrn_prep<false>(p, it, lds, tid);
    const LAS float* vec = (const LAS float*)(lds + L_VEC);
    const int fr = lane & 15, fq = lane >> 4;
    bf16x8 a[2];
#pragma unroll
    for (int ks = 0; ks < 2; ++ks) a[ks] = *(const LAS bf16x8*)(lds + L_KTT + ((16 * wave + fr) * TPI + 32 * ks + 8 * fq) * 2);
    float e2[4];
#pragma unroll
    for (int j = 0; j < 4; ++j) { const int d = 16 * wave + 4 * fq + j; e2[j] = __expf(vec[128 + d] - vec[d]); }
#pragma unroll
    for (int vt = 0; vt < 8; ++vt) { f32x4 acc = {0.f, 0.f, 0.f, 0.f};
#pragma unroll
        for (int ks = 0; ks < 2; ++ks) { const bf16x8 b = *(const LAS bf16x8*)(lds + L_IVT + ((16 * vt + fr) * TPI + 32 * ks + 8 * fq) * 2); acc = MFMA16(a[ks], b, acc); }
        u32x2 o; o.x = pk2(acc[0] * e2[0], acc[1] * e2[1]); o.y = pk2(acc[2] * e2[2], acc[3] * e2[3]);
        *(u32x2*)(p.UT + (size_t)item * 16384 + (16 * vt + fr) * 128 + 16 * wave + 4 * fq) = o; }
    if (tid < 128) p.AL[(size_t)item * 128 + tid] = __expf(vec[128 + tid]);
    __syncthreads();
}
DI void hgrn_b2(const Prm& p, int gtid, int GT) {
    for (int idx = gtid; idx < 64 * 4096; idx += GT) {
        const int bhx = idx >> 12, e = idx & 4095, v = e >> 5, d4 = (e & 31) * 4; const bool smp = bhx >= 32;
        const int item0 = smp ? 2080 + (bhx - 32) : bhx * 65, nch = smp ? 1 : 65;
        float S[4] = {0.f, 0.f, 0.f, 0.f};
        if (smp) {
#pragma unroll
            for (int j = 0; j < 4; ++j) S[j] = p.state_hgrn[((size_t)(bhx - 32) * 128 + d4 + j) * 128 + v]; }
        for (int c0 = 0; c0 < nch; c0 += 5) {
            u32x2 uu[5]; f32x4 al[5];
#pragma unroll
            for (int i = 0; i < 5; ++i) if (c0 + i < nch) { uu[i] = *(const u32x2*)(p.UT + (size_t)(item0 + c0 + i) * 16384 + v * 128 + d4); al[i] = *(const f32x4*)(p.AL + (size_t)(item0 + c0 + i) * 128 + d4); }
#pragma unroll
            for (int i = 0; i < 5; ++i) if (c0 + i < nch) { u32x2 o; o.x = pk2(S[0], S[1]); o.y = pk2(S[2], S[3]);
                *(u32x2*)(p.UT + (size_t)(item0 + c0 + i) * 16384 + v * 128 + d4) = o;
                S[0] = al[i][0] * S[0] + bflo(uu[i].x); S[1] = al[i][1] * S[1] + bfhi(uu[i].x); S[2] = al[i][2] * S[2] + bflo(uu[i].y); S[3] = al[i][3] * S[3] + bfhi(uu[i].y); } }
        float* dst = p.out + (smp ? O_HGS + (size_t)(bhx - 32) * 16384 : O_HGP + (size_t)bhx * 16384);
#pragma unroll
        for (int j = 0; j < 4; ++j) dst[(d4 + j) * 128 + v] = S[j];
    }
}
DI void hgrn_b3(const Prm& p, int item, LAS unsigned char* lds, int tid, int lane, int wave) {
    const HItem it = hgrn_item(item);
    hgrn_prep<true>(p, it, lds, tid);
    const int fr = lane & 15, fq = lane >> 4;
    {
        const int tt = wave >> 1;
#pragma unroll
        for (int i = 0; i < 2; ++i) { const int st = 2 * (wave & 1) + i; f32x4 acc = {0.f, 0.f, 0.f, 0.f};
#pragma unroll
            for (int ks = 0; ks < 4; ++ks) { const bf16x8 a = *(const LAS bf16x8*)(lds + L_KT + ((16 * st + fr) * HP + 32 * ks + 8 * fq) * 2);
                const bf16x8 b = *(const LAS bf16x8*)(lds + L_QT + ((16 * tt + fr) * HP + 32 * ks + 8 * fq) * 2); acc = MFMA16(a, b, acc); }
            const int t = 16 * tt + fr, s0 = 16 * st + 4 * fq;
            u32x2 o; o.x = pk2(s0 <= t ? acc[0] : 0.f, s0 + 1 <= t ? acc[1] : 0.f); o.y = pk2(s0 + 2 <= t ? acc[2] : 0.f, s0 + 3 <= t ? acc[3] : 0.f);
            *(LAS u32x2*)(lds + L_ATT + (t * TPI + s0) * 2) = o; }
    }
    __syncthreads();
    f32x4 oacc[4];
    {   const int tt = wave & 3;
        bf16x8 aa[2], aq[4];
#pragma unroll
        for (int ks = 0; ks < 2; ++ks) aa[ks] = *(const LAS bf16x8*)(lds + L_ATT + ((16 * tt + fr) * TPI + 32 * ks + 8 * fq) * 2);
#pragma unroll
        for (int ks = 0; ks < 4; ++ks) aq[ks] = *(const LAS bf16x8*)(lds + L_QH + ((16 * tt + fr) * HP + 32 * ks + 8 * fq) * 2);
#pragma unroll
        for (int i = 0; i < 4; ++i) { const int vt = 4 * (wave >> 2) + i; f32x4 acc = {0.f, 0.f, 0.f, 0.f};
#pragma unroll
            for (int ks = 0; ks < 2; ++ks) { const bf16x8 b = *(const LAS bf16x8*)(lds + L_IVT + ((16 * vt + fr) * TPI + 32 * ks + 8 * fq) * 2); acc = MFMA16(aa[ks], b, acc); }
#pragma unroll
            for (int ks = 0; ks < 4; ++ks) { const bf16x8 b = *(const bf16x8*)(p.UT + (size_t)item * 16384 + (16 * vt + fr) * 128 + 32 * ks + 8 * fq); acc = MFMA16(aq[ks], b, acc); }
            oacc[i] = acc; }
    }
    __syncthreads();
    {   const int tt = wave & 3; LAS float* ob = (LAS float*)(lds + L_OB);
#pragma unroll
        for (int i = 0; i < 4; ++i) { const int v = 16 * (4 * (wave >> 2) + i) + fr;
#pragma unroll
            for (int j = 0; j < 4; ++j) ob[(16 * tt + 4 * fq + j) * 132 + v] = oacc[i][j]; }
    }
    __syncthreads();
    {   const int t = tid >> 3, sg = tid & 7; const LAS float* ob = (const LAS float*)(lds + L_OB) + t * 132 + 16 * sg;
        f32x4 x[4]; float ss = 0.f;
#pragma unroll
        for (int j = 0; j < 4; ++j) { x[j] = ((const LAS f32x4*)ob)[j]; ss += (x[j].x * x[j].x + x[j].y * x[j].y) + (x[j].z * x[j].z + x[j].w * x[j].w); }
        ss += __shfl_xor(ss, 1); ss += __shfl_xor(ss, 2); ss += __shfl_xor(ss, 4);
        const float rr = rsqrtf(ss * (1.f / 128.f) + EPSN);
        if (t < it.L) { const size_t row = it.row0 + t; const int c0 = it.h * 128 + 16 * sg;
            const u32x4v g0 = *(const u32x4v*)(p.GS + row * 512 + c0), g1 = *(const u32x4v*)(p.GS + row * 512 + c0 + 8);
            const f32x4* gn = (const f32x4*)(p.hgrn_norm + 16 * sg);
            const f32x4 n0 = gn[0], n1 = gn[1], n2 = gn[2], n3 = gn[3];
            u32x4v o0, o1;
            o0.x = pk2(x[0].x * rr * n0.x * bflo(g0.x), x[0].y * rr * n0.y * bfhi(g0.x)); o0.y = pk2(x[0].z * rr * n0.z * bflo(g0.y), x[0].w * rr * n0.w * bfhi(g0.y));
            o0.z = pk2(x[1].x * rr * n1.x * bflo(g0.z), x[1].y * rr * n1.y * bfhi(g0.z)); o0.w = pk2(x[1].z * rr * n1.z * bflo(g0.w), x[1].w * rr * n1.w * bfhi(g0.w));
            o1.x = pk2(x[2].x * rr * n2.x * bflo(g1.x), x[2].y * rr * n2.y * bfhi(g1.x)); o1.y = pk2(x[2].z * rr * n2.z * bflo(g1.y), x[2].w * rr * n2.w * bfhi(g1.y));
            o1.z = pk2(x[3].x * rr * n3.x * bflo(g1.z), x[3].y * rr * n3.y * bfhi(g1.z)); o1.w = pk2(x[3].z * rr * n3.z * bflo(g1.w), x[3].w * rr * n3.w * bfhi(g1.w));
            *(u32x4v*)(p.CAT + row * 1024 + c0) = o0; *(u32x4v*)(p.CAT + row * 1024 + c0 + 8) = o1; }
    }
    __syncthreads();
}
DI void s5_load_u(const Prm& p, int mt, int g, int lane, bf16x8 (&uf)[8]) {
    const int fr = lane & 15, fq = lane >> 4; int col = 16 * mt + fr; if (col >= NCOL) col = NCOL - 1;
#pragma unroll
    for (int ks = 0; ks < 8; ++ks) uf[ks] = *(const bf16x8*)(p.U + ((size_t)(16 * col + 2 * ks + (fq >> 1))) * 512 + 16 * g + 8 * (fq & 1));
}
DI void s5_b(const Prm& p, int gw, int NGW, int lane) {
    const int fr = lane & 15, fq = lane >> 4;
    for (int task = gw; task < 131 * 32; task += NGW) { const int mt = task >> 5, g = task & 31;
        bf16x8 uf[8]; s5_load_u(p, mt, g, lane, uf);
#pragma unroll
        for (int nt = 0; nt < 8; ++nt) { f32x4 acc = {0.f, 0.f, 0.f, 0.f};
#pragma unroll
            for (int ks = 0; ks < 8; ++ks) { const bf16x8 b = *(const bf16x8*)(p.HT + ((size_t)(g * 128 + 16 * nt + fr)) * 256 + 32 * ks + 8 * fq); acc = MFMA16(uf[ks], b, acc); }
#pragma unroll
            for (int j = 0; j < 4; ++j) { const int col = 16 * mt + 4 * fq + j; if (col < NCOL) p.XLOC[(size_t)col * 4096 + g * 128 + 16 * nt + fr] = acc[j]; } }
    }
}
DI void s5_c(const Prm& p, int gtid) {
    if (gtid >= 16 * 2048) return;
    const int seq = gtid >> 11, g = (gtid >> 6) & 31, n = gtid & 63; const bool smp = seq >= 8; const int b = seq & 7;
    const int col0 = smp ? 2056 + 4 * b : 257 * b, nch = smp ? 4 : 257;
    float xr = 0.f, xi = 0.f; if (smp) { xr = p.ssm_re0[(b * 32 + g) * 64 + n]; xi = p.ssm_im0[(b * 32 + g) * 64 + n]; }
    const float ar = p.A16[2 * (g * 64 + n)], ai = p.A16[2 * (g * 64 + n) + 1];
    const size_t base = (size_t)g * 128 + 2 * n;
    for (int c0 = 0; c0 < nch; c0 += 8) {
        f32x2v xl[8];
#pragma unroll
        for (int i = 0; i < 8; ++i) if (c0 + i < nch) xl[i] = *(const f32x2v*)(p.XLOC + (size_t)(col0 + c0 + i) * 4096 + base);
#pragma unroll
        for (int i = 0; i < 8; ++i) if (c0 + i < nch) { *(unsigned*)(p.XPREV + (size_t)(col0 + c0 + i) * 4096 + base) = pk2(xr, xi);
            const float nr = ar * xr - ai * xi + xl[i].x, ni = ar * xi + ai * xr + xl[i].y; xr = nr; xi = ni; } }
    const size_t o = (size_t)(b * 32 + g) * 64 + n;
    p.out[(smp ? O_SRS : O_SRP) + o] = xr; p.out[(smp ? O_SIS : O_SIP) + o] = xi;
}
DI f32x2v gelu_pk(f32x2v v) {
    const f32x2v av = __builtin_elementwise_abs(v), d = av * 0.2316418882f + 1.0f;
    f32x2v t; t.x = __builtin_amdgcn_rcpf(d.x); t.y = __builtin_amdgcn_rcpf(d.y);
    f32x2v q = t * 0.5307027145f + (-0.7265760135f); q = q * t + 0.7107068705f; q = q * t + (-0.142248368f); q = q * t + 0.127414796f; q = q * t;
    const f32x2v s = (v * v) * (-0.72134752044f);
    f32x2v e; e.x = __builtin_amdgcn_exp2f(s.x); e.y = __builtin_amdgcn_exp2f(s.y);
    const f32x2v m = v * (q * e), r = v - m;
    f32x2v o; o.x = v.x < 0.f ? m.x : r.x; o.y = v.y < 0.f ? m.y : r.y; return o;
}
DI void s5_d(const Prm& p, int gw, int NGW, int lane) {
    const int fr = lane & 15, fq = lane >> 4;
    for (int task = gw; task < 131 * 32; task += NGW) { const int mt = task >> 5, g = task & 31;
        bf16x8 uf[8], xf[4]; s5_load_u(p, mt, g, lane, uf);
        int colc = 16 * mt + fr; if (colc >= NCOL) colc = NCOL - 1;
#pragma unroll
        for (int ks = 0; ks < 4; ++ks) xf[ks] = *(const bf16x8*)(p.XPREV + (size_t)colc * 4096 + g * 128 + 32 * ks + 8 * fq);
        const bf16_t* tg = p.TG + ((size_t)(g * 256 + fr)) * 384 + 8 * fq;
        const bool ok = 16 * mt + fr < NCOL;
#pragma unroll
        for (int t = 0; t < 16; ++t) { f32x4 acc = {0.f, 0.f, 0.f, 0.f};
#pragma unroll
            for (int ks = 0; ks < 8; ++ks) if (ks <= (t >> 1)) { const bf16x8 a = *(const bf16x8*)(tg + (size_t)t * 16 * 384 + 32 * ks); acc = MFMA16(a, uf[ks], acc); }
#pragma unroll
            for (int ks = 0; ks < 4; ++ks) { const bf16x8 a = *(const bf16x8*)(tg + (size_t)t * 16 * 384 + 256 + 32 * ks); acc = MFMA16(a, xf[ks], acc); }
            const f32x2v y0 = gelu_pk((f32x2v){acc[0], acc[1]}), y1 = gelu_pk((f32x2v){acc[2], acc[3]});
            u32x2 o; o.x = pk2(y0.x, y0.y); o.y = pk2(y1.x, y1.y);
            if (ok) *(u32x2*)(p.YG + ((size_t)(16 * (16 * mt + fr) + t)) * 512 + 16 * g + 4 * fq) = o; }
    }
}
DI void cache_convert(const Prm& p, int gtid, int GT) {
    for (size_t i = (size_t)gtid; i < (size_t)8 * 1024 * 256; i += (size_t)GT) {
        const size_t row = i >> 8; const int c4 = (int)(i & 255) * 4, b = (int)(row >> 10), pos = (int)(row & 1023), h = c4 >> 7, d = c4 & 127;
        const f32x4 k = *(const f32x4*)(p.cache_k + row * 1024 + c4); u32x2 o; o.x = pk2(k.x, k.y); o.y = pk2(k.z, k.w);
        *(u32x2*)(p.KS + kf_index(b * 8 + h, 34, pos, d)) = o;
        const f32x4 v = *(const f32x4*)(p.cache_v + row * 1024 + c4); bf16_t* vt = p.VTS + vf_index(b * 8 + h, 34, pos, d);
        vt[0] = f2bf(v.x); vt[8] = f2bf(v.y); vt[16] = f2bf(v.z); vt[24] = f2bf(v.w); }
}
DI void attn_phase(const Prm& p, int gw, int NGW, int lane) {
    const int q = lane & 31, half = lane >> 5;
    for (int it = gw; it < 8256 + 128; it += NGW) {
        bool smp; int b, h, qb;
        if (it < 8256) { smp = false; b = it / 1032; const int rem = it - b * 1032; h = rem / 129; qb = rem - h * 129; } else { const int s = it - 8256; smp = true; b = s >> 4; h = (s >> 1) & 7; qb = s & 1; }
        const size_t tbase = (size_t)(b * 8 + h) * (smp ? 34 : 129) * 4096 + lane * 8;
        const bf16_t* Kb = (smp ? p.KS : p.KP) + tbase; const bf16_t* Vb = (smp ? p.VTS : p.VTP) + tbase;
        const int qpos0 = (smp ? 1024 : 0) + 32 * qb, qrow0 = smp ? NTP + b * 64 + 32 * qb : b * TP + 32 * qb;
        const int qpos = qpos0 + q; const bool qvalid = smp || qpos < TP; const size_t qrow = qvalid ? qrow0 + q : qrow0;
        bf16x8 qf[8];
#pragma unroll
        for (int ks = 0; ks < 8; ++ks) qf[ks] = *(const bf16x8*)(p.Q + qrow * 1024 + h * 128 + 16 * ks + 8 * half);
        f32x16 o[4];
#pragma unroll
        for (int db = 0; db < 4; ++db)
#pragma unroll
            for (int e = 0; e < 16; ++e) o[db][e] = 0.f;
        float C = 1.f;
        for (int kt = (qpos0 + 30) >> 5; kt >= 0; --kt) {
            f32x16 s;
#pragma unroll
            for (int e = 0; e < 16; ++e) s[e] = 0.f;
            const bf16_t* kr = Kb + (size_t)kt * 4096; const bf16_t* vr = Vb + (size_t)kt * 4096;
            bf16x8 kf[8], vf[8];
#pragma unroll
            for (int ks = 0; ks < 8; ++ks) kf[ks] = *(const bf16x8*)(kr + ks * 512);
#pragma unroll
            for (int ks = 0; ks < 8; ++ks) vf[ks] = *(const bf16x8*)(vr + ks * 512);
#pragma unroll
            for (int ks = 0; ks < 8; ++ks) s = MFMA32(kf[ks], qf[ks], s);
            float pr[16], be[16], G[4], Gp[4];
#pragma unroll
            for (int i = 0; i < 4; ++i) {
#pragma unroll
                for (int j = 0; j < 4; ++j) { const int key = 32 * kt + 8 * i + 4 * half + j; const bool valid = key < qpos;
                    float z = s[4 * i + j] * 0.08838834764831845f; z = fminf(fmaxf(z, -80.f), 80.f);
                    const float e = __expf(z), pp = __builtin_amdgcn_rcpf(1.f + e); pr[4 * i + j] = valid ? pp : 1.f; be[4 * i + j] = valid ? e * pp : 0.f; }
                G[i] = (pr[4 * i] * pr[4 * i + 1]) * (pr[4 * i + 2] * pr[4 * i + 3]); }
#pragma unroll
            for (int i = 0; i < 4; ++i) Gp[i] = __shfl_xor(G[i], 32);
            float w[16]; float E1 = 1.f;
#pragma unroll
            for (int i = 3; i >= 0; --i) { const float Glo = half ? Gp[i] : G[i], Ghi = half ? G[i] : Gp[i];
                float suf = C * (half ? E1 : E1 * Ghi);
#pragma unroll
                for (int j = 3; j >= 0; --j) { w[4 * i + j] = be[4 * i + j] * suf; suf *= pr[4 * i + j]; }
                E1 *= Glo * Ghi; }
            C *= E1;
#pragma unroll
            for (int c = 0; c < 2; ++c) { union { bf16x8 v; unsigned u[4]; } wf;
#pragma unroll
                for (int e = 0; e < 4; ++e) wf.u[e] = pk2(w[8 * c + 2 * e], w[8 * c + 2 * e + 1]);
#pragma unroll
                for (int db = 0; db < 4; ++db) o[db] = MFMA32(vf[4 * c + db], wf.v, o[db]); }
            if (__all(C < 1e-24f)) break;
        }
        if (qvalid) {
#pragma unroll
            for (int db = 0; db < 4; ++db)
#pragma unroll
                for (int i = 0; i < 4; ++i) { u32x2 ov; ov.x = pk2(o[db][4 * i], o[db][4 * i + 1]); ov.y = pk2(o[db][4 * i + 2], o[db][4 * i + 3]);
                    *(u32x2*)(p.O + qrow * 1024 + h * 128 + 32 * db + 8 * i + 4 * half) = ov; } }
    }
}
DI void final_norm(const Prm& p, int gw, int NGW, int lane) {
    for (int r = gw; r < 32768 + 512; r += NGW) {
        int grow; float* dst;
        if (r < 32768) { const int b = r >> 12, t = r & 4095; grow = b * TP + 16 + t; dst = p.out + O_YP + (size_t)r * 1024; } else { grow = NTP + (r - 32768); dst = p.out + O_YS + (size_t)(r - 32768) * 1024; }
        const float rr = row_rinv(p.SSQ, grow);
#pragma unroll
        for (int j = 0; j < 4; ++j) { f32x4 v = ((f32x4*)dst)[lane + 64 * j]; const f32x4 g = ((const f32x4*)p.ln_final)[lane + 64 * j]; v = v * rr * g; ((f32x4*)dst)[lane + 64 * j] = v; }
    }
}
constexpr int LDS_BYTES = 131072;
__global__ void __launch_bounds__(512, 2) fwd_megakernel(Prm p) {
    extern __shared__ __attribute__((aligned(16))) unsigned char shm[];
    LAS unsigned char* lds = (LAS unsigned char*)shm;
    cg::grid_group grid = cg::this_grid();
    const int tid = threadIdx.x, lane = tid & 63, wave = __builtin_amdgcn_readfirstlane(tid >> 6);
    const int gw = blockIdx.x * 8 + wave, NGW = gridDim.x * 8, gtid = blockIdx.x * 512 + tid, GT = gridDim.x * 512;
    phase_prologue(p, lds, tid, lane, wave);
    grid.sync();
    { EpiIn0 E; E.SSQ = p.SSQ; E.LB = p.LB; E.Qh = p.Qh; E.IV = p.IV; E.GS = p.GS; E.U = p.U; E.LOGF = p.LOGF; run_gemm(lds, p.XB, p.Wt1, 2560, 1024, E); }
    grid.sync();
    for (int item = blockIdx.x; item < NITEM_H; item += gridDim.x) hgrn_b1(p, item, lds, tid, lane, wave);
    s5_b(p, gw, NGW, lane);
    grid.sync();
    hgrn_b2(p, gtid, GT);
    s5_c(p, gtid);
    grid.sync();
    for (int item = blockIdx.x; item < NITEM_H; item += gridDim.x) hgrn_b3(p, item, lds, tid, lane, wave);
    s5_d(p, gw, NGW, lane);
    grid.sync();
    { EpiGlu E; E.YG = p.YG; E.CAT = p.CAT; run_gemm(lds, p.YG, p.Wglu, 512, 512, E); }
    grid.sync();
    { EpiRes E; E.XB = p.XB; E.SSQ = p.SSQ; run_gemm(lds, p.CAT, p.Wo0, 1024, 1024, E); }
    grid.sync();
    { EpiUp E; E.SSQ = p.SSQ; E.H = p.H; run_gemm(lds, p.XB, p.Wup0, 4096, 1024, E); }
    grid.sync();
    { EpiRes E; E.XB = p.XB; E.SSQ = p.SSQ; run_gemm_split(lds, p.H, p.Wdn0, 1024, 4096, E, (float*)p.CAT); grid.sync(); gemm_fixup(1024, 4096, E, (const float*)p.CAT, tid); }
    grid.sync();
    cache_convert(p, gtid, GT);
    { EpiQkv E; E.SSQ = p.SSQ; E.out = p.out; E.Q = p.Q; E.KP = p.KP; E.KS = p.KS; E.VTP = p.VTP; E.VTS = p.VTS; run_gemm(lds, p.XB, p.Wqkv, 3072, 1024, E); }
    grid.sync();
    attn_phase(p, gw, NGW, lane);
    grid.sync();
    { EpiRes E; E.XB = p.XB; E.SSQ = p.SSQ; run_gemm(lds, p.O, p.Wo1, 1024, 1024, E); }
    grid.sync();
    { EpiUp E; E.SSQ = p.SSQ; E.H = p.H; run_gemm(lds, p.XB, p.Wup1, 4096, 1024, E); }
    grid.sync();
    { EpiFin E; E.XB = p.XB; E.SSQ = p.SSQ; E.out = p.out; run_gemm_split(lds, p.H, p.Wdn1, 1024, 4096, E, (float*)p.CAT); grid.sync(); gemm_fixup(1024, 4096, E, (const float*)p.CAT, tid); }
    grid.sync();
    final_norm(p, gw, NGW, lane);
}

extern "C" void kernel_launch(void* const* d_in, const int* in_sizes, int n_in, void* d_out, int out_size, void* d_ws, size_t ws_size, hipStream_t stream) {
    static int grid_blocks = 0;
    if (grid_blocks == 0) {
        int dev = 0, cus = 0, per_cu = 0;
        hipGetDevice(&dev); hipDeviceGetAttribute(&cus, hipDeviceAttributeMultiprocessorCount, dev);
        if (hipFuncSetAttribute((const void*)fwd_megakernel, hipFuncAttributeMaxDynamicSharedMemorySize, LDS_BYTES) != hipSuccess) fprintf(stderr, "kernel_launch: hipFuncSetAttribute failed\n");
        if (hipOccupancyMaxActiveBlocksPerMultiprocessor(&per_cu, (const void*)fwd_megakernel, 512, LDS_BYTES) != hipSuccess || per_cu < 1) { fprintf(stderr, "kernel_launch: occupancy query says %d\n", per_cu); per_cu = 1; }
        (void)hipGetLastError();
        grid_blocks = cus > 0 ? cus : 256;
    }
    Prm p{};
    const float* const* in = (const float* const*)d_in;
    p.x_prompt = in[0]; p.x_sample = in[1]; p.state_hgrn = in[2]; p.ssm_re0 = in[3]; p.ssm_im0 = in[4]; p.cache_k = in[5]; p.cache_v = in[6]; p.meta = in[7]; p.ln_mix = in[8]; p.ln_mlp = in[9];
    p.ln_final = in[10]; p.w_in_even = in[11]; p.hgrn_lb = in[12]; p.hgrn_norm = in[13]; p.a_re = in[14]; p.a_im = in[15]; p.log_dt = in[16]; p.b_re = in[17]; p.b_im = in[18]; p.c_re = in[19];
    p.c_im = in[20]; p.ssm_d = in[21]; p.w_glu = in[22]; p.w_out_even = in[23]; p.w_in_odd = in[24]; p.w_out_odd = in[25]; p.w_up = in[26]; p.w_down = in[27];
    p.out = (float*)d_out;
    unsigned char* ws = (unsigned char*)d_ws; size_t off = 0;
    auto take = [&](size_t bytes) { unsigned char* r = ws + off; off += (bytes + 255) & ~(size_t)255; return r; };
    p.Wt1 = (bf16_t*)take((size_t)2560 * 1024 * 2); p.Wglu = (bf16_t*)take((size_t)512 * 512 * 2); p.Wo0 = (bf16_t*)take((size_t)1024 * 1024 * 2); p.Wup0 = (bf16_t*)take((size_t)4096 * 1024 * 2);
    p.Wdn0 = (bf16_t*)take((size_t)4096 * 1024 * 2); p.Wqkv = (bf16_t*)take((size_t)3072 * 1024 * 2); p.Wo1 = (bf16_t*)take((size_t)1024 * 1024 * 2); p.Wup1 = (bf16_t*)take((size_t)4096 * 1024 * 2);
    p.Wdn1 = (bf16_t*)take((size_t)4096 * 1024 * 2);
    p.XB = (bf16_t*)take((size_t)MP * 1024 * 2); p.SSQ = (float*)take((size_t)MP * 16 * 4); p.LB = (float*)take(2048); p.KTAB = (float*)take((size_t)32 * 16 * 256 * 4);
    p.TG = (bf16_t*)take((size_t)32 * 256 * 384 * 2); p.HT = (bf16_t*)take((size_t)32 * 128 * 256 * 2); p.A16 = (float*)take(32 * 64 * 2 * 4);
    const size_t S0 = off; constexpr size_t SZ512 = (size_t)MP * 512 * 2;
    p.Qh = (bf16_t*)take(SZ512); p.LOGF = (unsigned short*)take(SZ512); p.IV = (bf16_t*)take(SZ512); p.GS = (bf16_t*)take(SZ512); p.U = (bf16_t*)take(SZ512);
    p.UT = (bf16_t*)take((size_t)NITEM_H * 16384 * 2); p.AL = (float*)take((size_t)NITEM_H * 128 * 4);
    p.XLOC = (float*)take(SZ512); p.YG = (bf16_t*)p.XLOC;
    p.XPREV = (bf16_t*)take((size_t)NCOL * 4096 * 2); p.CAT = (bf16_t*)take((size_t)MP * 1024 * 2);
    size_t end = off;
    off = S0; p.H = (bf16_t*)take((size_t)MP * 4096 * 2); if (off > end) end = off;
    off = S0; p.Q = (bf16_t*)take((size_t)MP * 1024 * 2); p.KP = (bf16_t*)take((size_t)64 * 129 * 4096 * 2); p.KS = (bf16_t*)take((size_t)64 * 34 * 4096 * 2);
    p.VTP = (bf16_t*)take((size_t)64 * 129 * 4096 * 2); p.VTS = (bf16_t*)take((size_t)64 * 34 * 4096 * 2); p.O = (bf16_t*)take((size_t)MP * 1024 * 2); if (off > end) end = off;
    if (end > ws_size || n_in != 28 || (size_t)out_size != O_END) { fprintf(stderr, "kernel_launch: workspace/shape mismatch: need %zu have %zu, n_in %d, out %d\n", end, ws_size, n_in, out_size); return; }
    void* args[] = {&p};
    hipError_t e = hipLaunchCooperativeKernel((const void*)fwd_megakernel, dim3(grid_blocks), dim3(512), args, LDS_BYTES, stream);
    if (e != hipSuccess) fprintf(stderr, "cooperative launch failed: %s (grid %d)\n", hipGetErrorString(e), grid_blocks);
}
```

```cpp
#include <hip/hip_runtime.h>
#include <hip/hip_cooperative_groups.h>
#include <cstdio>
#include <cstdint>
namespace cg = cooperative_groups;
namespace pg8 {
#define PG8_LAS __attribute__((address_space(3)))
typedef unsigned short bf16_t;
typedef short bf16x8 __attribute__((ext_vector_type(8)));
typedef float f32x4 __attribute__((ext_vector_type(4)));
typedef unsigned u32x4 __attribute__((ext_vector_type(4)));
constexpr int BM = 256, BK = 64, HALF = 128, HTB = HALF * BK * 2  , STAGE_BYTES = 8 * HTB, NXCD = 8, WGM = 8;

__host__ __device__ __forceinline__ int lds_byte(int r, int c) { const int st = (r >> 4) * 2 + (c >> 5), rr = r & 15, cc = c & 31, ob = rr * 64 + cc * 2; return st * 1024 + (ob ^ (((ob >> 9) & 1) << 5)); }
__host__ __device__ __forceinline__ void stage_rc(int b, int& R, int& C) { const int st = b / 1024, sb = b % 1024, swz = sb ^ (((sb >> 9) & 1) << 5); R = (st >> 1) * 16 + swz / 64; C = (st & 1) * 32 + (swz % 64) / 2; }
__host__ __device__ __forceinline__ int perm32(int rho) { const int n = rho >> 4, i = rho & 15; return 8 * (i >> 2) + 4 * n + (i & 3); }

struct Unit { int pm, pn, kb, nk, part; };
struct Gemm { const bf16_t* A; const bf16_t* Bt; int M, N, K; float* part; };

struct StaticOrder {
    int nM, nN, nwg, G, c;
    __host__ __device__ void init(int M, int N, int G_, int c_) { nM = M / BM; nN = N / BM; nwg = nM * nN; G = G_; c = c_; }
    __host__ __device__ void map(int L, Unit& u) const {
        int wgid = L; { const int q = nwg / NXCD, r = nwg % NXCD, xcd = wgid % NXCD, off = wgid / NXCD; wgid = (xcd < r ? xcd * (q + 1) : r * (q + 1) + (xcd - r) * q) + off; }
        const int nig = WGM * nN, gid = wgid / nig, fm = gid * WGM, gsz = (nM - fm) < WGM ? (nM - fm) : WGM;
        u.pm = fm + ((wgid % nig) % gsz); u.pn = (wgid % nig) / gsz; u.kb = 0; u.nk = 0; u.part = -1;
    }
    __host__ __device__ bool next(int i, Unit& u) const {
        const long L = (long)i * G + c; if (L >= nwg) return false;
        map((int)L, u); return true;
    }
    __device__ __forceinline__ void a_ready(const Unit&) const {}
    __device__ __forceinline__ void done(const Unit&) const {}
};
template <class Epi, class Sched>
__device__ __forceinline__ void gemm_phase(PG8_LAS unsigned char* lds, const Gemm g, const Sched& S, const Epi& E) {
    const int tid = threadIdx.x, wid = __builtin_amdgcn_readfirstlane(tid >> 6), lane = tid & 63, wr = wid >> 2, wc = wid & 3, fr = lane & 15, fq = lane >> 4;
    const int K = g.K, nt = K / BK;
    unsigned voffA[2], voffB[2];
#pragma unroll
    for (int i = 0; i < 2; ++i) { int R, C; stage_rc(tid * 16 + i * 8192, R, C); const int Rb = Epi::PERM ? ((R & ~31) + perm32(R & 31)) : R;
        voffA[i] = (unsigned)(R * K + C) * 2u; voffB[i] = (unsigned)(Rb * K + C) * 2u; }
    const size_t kstep = (size_t)(BK * 2);
    const size_t hstep = (size_t)HALF * K * 2;
    const size_t tstep = 2 * hstep;
    const unsigned ldsw = (unsigned)wid * 1024u;
    const int aoff = lds_byte(wr * 64 + fr, fq * 8), boff = lds_byte(wc * 32 + fr, fq * 8);
#define PG8_SA(b, h) (((b) * 2 + (h)) * HTB)
#define PG8_SB(b, h) ((4 + (b) * 2 + (h)) * HTB)
#define PG8_STAGE(bufoff, gbase, voff) do { _Pragma("unroll") for (int _i = 0; _i < 2; ++_i) \
        __builtin_amdgcn_global_load_lds((const unsigned*)((const char*)(gbase) + (voff)[_i]), (PG8_LAS unsigned*)(lds + (bufoff) + ldsw + _i * 8192), 16, 0, 0); } while (0)
#define PG8_LDA(dst, b, h) do { _Pragma("unroll") for (int m = 0; m < 4; ++m) _Pragma("unroll") for (int k = 0; k < 2; ++k) dst[m][k] = *(const PG8_LAS bf16x8*)(lds + PG8_SA(b, h) + aoff + m * 2048 + k * 1024); } while (0)
#define PG8_LDB(dst, b, h) do { _Pragma("unroll") for (int n = 0; n < 2; ++n) _Pragma("unroll") for (int k = 0; k < 2; ++k) dst[n][k] = *(const PG8_LAS bf16x8*)(lds + PG8_SB(b, h) + boff + n * 2048 + k * 1024); } while (0)
#define PG8_MMA(ai, bj, At, Bt) do { __builtin_amdgcn_s_setprio(1); _Pragma("unroll") for (int m = 0; m < 4; ++m) _Pragma("unroll") for (int n = 0; n < 2; ++n) _Pragma("unroll") for (int k = 0; k < 2; ++k) \
        acc[ai][bj][m][n] = __builtin_amdgcn_mfma_f32_16x16x32_bf16(Bt[n][k], At[m][k], acc[ai][bj][m][n], 0, 0, 0); __builtin_amdgcn_s_setprio(0); } while (0)
#define PG8_WAIT_V(n) asm volatile("s_waitcnt vmcnt(" #n ")" ::: "memory")
#define PG8_WAIT_L(n) asm volatile("s_waitcnt lgkmcnt(" #n ")" ::: "memory")
#define PG8_BAR __builtin_amdgcn_s_barrier()
#define PG8_SCHED __builtin_amdgcn_sched_barrier(0)
    Unit cur, nxt; int ui = 0;
    if (!S.next(0, cur)) return;
    f32x4 acc[2][2][4][2];
#pragma unroll
    for (int a = 0; a < 2; ++a)
#pragma unroll
        for (int b = 0; b < 2; ++b)
#pragma unroll
            for (int m = 0; m < 4; ++m)
#pragma unroll
                for (int n = 0; n < 2; ++n) acc[a][b][m][n] = (f32x4){0.f, 0.f, 0.f, 0.f};
    bf16x8 At[4][2], B0[2][2], B1[2][2];
    const char* cA = (const char*)g.A + (size_t)cur.pm * tstep + (size_t)cur.kb * kstep; const char* cB = (const char*)g.Bt + (size_t)cur.pn * tstep + (size_t)cur.kb * kstep;
    S.a_ready(cur);
    PG8_STAGE(PG8_SB(0, 0), cB, voffB); PG8_STAGE(PG8_SA(0, 0), cA, voffA); PG8_STAGE(PG8_SB(0, 1), cB + hstep, voffB); PG8_STAGE(PG8_SA(0, 1), cA + hstep, voffA);
    if (wr == 1) PG8_BAR;
    PG8_WAIT_V(4); PG8_BAR;
    PG8_STAGE(PG8_SB(1, 0), cB + kstep, voffB); PG8_STAGE(PG8_SA(1, 0), cA + kstep, voffA); PG8_STAGE(PG8_SB(1, 1), cB + hstep + kstep, voffB);
    PG8_WAIT_V(6); PG8_BAR;
    for (;;) {
        const bool has_next = S.next(ui + 1, nxt);
        const char* nA = has_next ? (const char*)g.A + (size_t)nxt.pm * tstep + (size_t)nxt.kb * kstep : cA; const char* nB = has_next ? (const char*)g.Bt + (size_t)nxt.pn * tstep + (size_t)nxt.kb * kstep : cB;
        const int cnk = cur.nk ? cur.nk : nt;
        for (int t = 0; t < cnk; t += 2) {
            const bool last = (t == cnk - 2);
            const char* a1 = cA + (size_t)(t + 1) * kstep;
            const char* a2 = last ? nA : cA + (size_t)(t + 2) * kstep; const char* b2 = last ? nB : cB + (size_t)(t + 2) * kstep;
            const char* a3 = a2 + kstep; const char* b3 = b2 + kstep;
            if (last && has_next) S.a_ready(nxt);
            PG8_LDB(B0, 0, 0); PG8_SCHED; PG8_LDA(At, 0, 0); PG8_STAGE(PG8_SA(1, 1), a1 + hstep, voffA);
            PG8_WAIT_L(8); PG8_BAR; PG8_WAIT_L(0); PG8_MMA(0, 0, At, B0); PG8_BAR; PG8_SCHED;
            PG8_LDB(B1, 0, 1); PG8_STAGE(PG8_SB(0, 0), b2, voffB);
            PG8_BAR; PG8_WAIT_L(0); PG8_MMA(0, 1, At, B1); PG8_BAR;
            PG8_LDA(At, 0, 1); PG8_STAGE(PG8_SA(0, 0), a2, voffA);
            PG8_BAR; PG8_WAIT_L(0); PG8_MMA(1, 0, At, B0); PG8_BAR; PG8_SCHED;
            PG8_STAGE(PG8_SB(0, 1), b2 + hstep, voffB);
            PG8_WAIT_V(6); PG8_BAR; PG8_MMA(1, 1, At, B1); PG8_BAR;
            PG8_LDB(B0, 1, 0); PG8_SCHED; PG8_LDA(At, 1, 0); PG8_STAGE(PG8_SA(0, 1), a2 + hstep, voffA);
            PG8_WAIT_L(8); PG8_BAR; PG8_WAIT_L(0); PG8_MMA(0, 0, At, B0); PG8_BAR; PG8_SCHED;
            PG8_LDB(B1, 1, 1); PG8_STAGE(PG8_SB(1, 0), b3, voffB);
            PG8_BAR; PG8_WAIT_L(0); PG8_MMA(0, 1, At, B1); PG8_BAR;
            PG8_LDA(At, 1, 1); PG8_STAGE(PG8_SA(1, 0), a3, voffA);
            PG8_BAR; PG8_WAIT_L(0); PG8_MMA(1, 0, At, B0); PG8_BAR; PG8_SCHED;
            PG8_STAGE(PG8_SB(1, 1), b3 + hstep, voffB);
            PG8_WAIT_V(6); PG8_BAR; PG8_MMA(1, 1, At, B1); PG8_BAR;
        }
        if constexpr (!Epi::AFTER_DRAIN) {
            if (cur.part < 0) E(acc, cur, wr, wc, fr, fq);
            else { f32x4* pp = (f32x4*)g.part + (size_t)cur.part * 32 * 512 + tid;
#pragma unroll
                for (int a = 0; a < 2; ++a)
#pragma unroll
                    for (int b = 0; b < 2; ++b)
#pragma unroll
                        for (int m = 0; m < 4; ++m)
#pragma unroll
                            for (int n = 0; n < 2; ++n) pp[(size_t)(((a * 2 + b) * 4 + m) * 2 + n) * 512] = acc[a][b][m][n]; }
            S.done(cur); }
        if (!has_next) break;
#pragma unroll
        for (int a = 0; a < 2; ++a)
#pragma unroll
            for (int b = 0; b < 2; ++b)
#pragma unroll
                for (int m = 0; m < 4; ++m)
#pragma unroll
                    for (int n = 0; n < 2; ++n) acc[a][b][m][n] = (f32x4){0.f, 0.f, 0.f, 0.f};
        cur = nxt; cA = nA; cB = nB; ++ui;
    }
    PG8_WAIT_V(0);
    if (wr == 0) PG8_BAR;
    PG8_BAR;
    if constexpr (Epi::AFTER_DRAIN) { E.fused(acc, cur, wr, wc, fr, fq, lds, wid, lane); S.done(cur); }
#undef PG8_SA
#undef PG8_SB
#undef PG8_STAGE
#undef PG8_LDA
#undef PG8_LDB
#undef PG8_MMA
#undef PG8_WAIT_V
#undef PG8_WAIT_L
#undef PG8_BAR
#undef PG8_SCHED
}
}
using pg8::bf16_t; using pg8::bf16x8; using pg8::f32x4; using pg8::Unit;
typedef float f32x16 __attribute__((ext_vector_type(16)));
typedef float f32x2v __attribute__((ext_vector_type(2)));
typedef unsigned u32x2 __attribute__((ext_vector_type(2)));
typedef unsigned u32x4v __attribute__((ext_vector_type(4)));
#define LAS __attribute__((address_space(3)))
#define DI __device__ __forceinline__

constexpr int DM = 1024, TP = 4112, NTP = 8 * TP  , NTS = 512, NT = NTP + NTS  , MP = 33536  ;
constexpr int NITEM_H = 2112;
constexpr int NCOL = NT / 16;
constexpr float EPSN = 1e-6f;
constexpr size_t O_YP = 0, O_YS = O_YP + (size_t)8 * 4096 * 1024, O_HGP = O_YS + 524288, O_HGS = O_HGP + 524288, O_SRP = O_HGS + 524288, O_SIP = O_SRP + 16384,
                 O_SRS = O_SIP + 16384, O_SIS = O_SRS + 16384, O_KP = O_SIS + 16384, O_VP = O_KP + (size_t)NTP * 1024, O_KS = O_VP + (size_t)NTP * 1024, O_VS = O_KS + 524288, O_END = O_VS + 524288;

struct Prm {
    const float *x_prompt, *x_sample, *state_hgrn, *ssm_re0, *ssm_im0, *cache_k, *cache_v, *meta, *ln_mix, *ln_mlp, *ln_final, *w_in_even, *hgrn_lb, *hgrn_norm,
        *a_re, *a_im, *log_dt, *b_re, *b_im, *c_re, *c_im, *ssm_d, *w_glu, *w_out_even, *w_in_odd, *w_out_odd, *w_up, *w_down;
    float* out;
    bf16_t *Wt1, *Wglu, *Wo0, *Wup0, *Wdn0, *Wqkv, *Wo1, *Wup1, *Wdn1;
    bf16_t* XB; float* SSQ; float* LB; float* KTAB; bf16_t* TG; bf16_t* HT; float* A16;
    bf16_t *Qh, *IV, *GS, *U; unsigned short* LOGF; bf16_t* UT; float* AL; float* XLOC; bf16_t* XPREV; bf16_t* YG; bf16_t* CAT;
    bf16_t* H;
    bf16_t *Q, *KP, *KS, *VTP, *VTS, *O; unsigned* BAR;
};

DI unsigned pk2(float lo, float hi) { unsigned r; asm volatile("v_cvt_pk_bf16_f32 %0, %1, %2" : "=v"(r) : "v"(lo), "v"(hi)); return r; }
DI float bflo(unsigned u) { return __uint_as_float(u << 16); }
DI float bfhi(unsigned u) { return __uint_as_float(u & 0xffff0000u); }
DI float bf2f(unsigned short b) { return __uint_as_float(((unsigned)b) << 16); }
DI unsigned short f2bf(float f) { return (unsigned short)(pk2(f, 0.f) & 0xffffu); }
DI unsigned pkh2(float lo, float hi) { union { _Float16 h[2]; unsigned u; } x; x.h[0] = (_Float16)lo; x.h[1] = (_Float16)hi; return x.u; }
DI float h2f(unsigned short h) { union { unsigned short s; _Float16 h; } x; x.s = h; return (float)x.h; }
DI float wave_sum(float v) {
#pragma unroll
    for (int o = 1; o < 64; o <<= 1) v += __shfl_xor(v, o);
    return v;
}
DI float fexp(float x) { return __expf(x); }
DI float sigm(float x) { return __builtin_amdgcn_rcpf(1.f + __expf(-x)); }
DI float row_rinv(const float* SSQ, int row) {
    const f32x4* s = (const f32x4*)(SSQ + (size_t)row * 16); f32x4 a = s[0] + s[1] + s[2] + s[3];
    return rsqrtf(((a.x + a.y) + (a.z + a.w)) * (1.f / 1024.f) + EPSN);
}
#define LDS_WAIT() asm volatile("s_waitcnt lgkmcnt(0)" ::: "memory")

struct EpiIn0 {
    static constexpr bool PERM = false, AFTER_DRAIN = false;
    const float* SSQ; const float* LB; bf16_t *Qh, *IV, *GS, *U; unsigned short* LOGF;
    DI void operator()(const f32x4 (&acc)[2][2][4][2], const Unit& u, int wr, int wc, int fr, int fq) const {
        const int seg = u.pn >> 1, cb = (u.pn & 1) * 256 + wc * 32 + 4 * fq, row0 = u.pm * 256 + wr * 64 + fr;
        unsigned short* dst = seg == 0 ? Qh : seg == 1 ? LOGF : seg == 2 ? IV : seg == 3 ? GS : U;
#pragma unroll
        for (int ai = 0; ai < 2; ++ai)
#pragma unroll
            for (int m = 0; m < 4; ++m) { const int row = row0 + ai * 128 + m * 16; const float r = row_rinv(SSQ, row);
#pragma unroll
                for (int bj = 0; bj < 2; ++bj)
#pragma unroll
                    for (int n = 0; n < 2; ++n) { const int cs = cb + bj * 128 + n * 16; f32x4 v = acc[ai][bj][m][n] * r; u32x2 o;
                        if (seg == 1) { const f32x4 lb = *(const f32x4*)(LB + cs); f32x4 f;
#pragma unroll
                            for (int e = 0; e < 4; ++e) f[e] = __logf(lb[e] + (1.f - lb[e]) * sigm(v[e]));
                            o.x = pkh2(f[0], f[1]); o.y = pkh2(f[2], f[3]); }
                        else { if (seg == 3) {
#pragma unroll
                                for (int e = 0; e < 4; ++e) v[e] = v[e] * sigm(v[e]); }
                            o.x = pk2(v[0], v[1]); o.y = pk2(v[2], v[3]); }
                        *(u32x2*)(dst + (size_t)row * 512 + cs) = o; } }
    }
};
struct EpiGlu {
    static constexpr bool PERM = false, AFTER_DRAIN = false;
    const bf16_t* YG; bf16_t* CAT;
    DI void operator()(const f32x4 (&acc)[2][2][4][2], const Unit& u, int wr, int wc, int fr, int fq) const {
        const int cb = u.pn * 256 + wc * 32 + 4 * fq, row0 = u.pm * 256 + wr * 64 + fr;
#pragma unroll
        for (int ai = 0; ai < 2; ++ai)
#pragma unroll
            for (int m = 0; m < 4; ++m) { const int row = row0 + ai * 128 + m * 16;
#pragma unroll
                for (int bj = 0; bj < 2; ++bj)
#pragma unroll
                    for (int n = 0; n < 2; ++n) { const int cs = cb + bj * 128 + n * 16; const f32x4 v = acc[ai][bj][m][n];
                        const u32x2 y = *(const u32x2*)(YG + (size_t)row * 512 + cs); u32x2 o;
                        o.x = pk2(bflo(y.x) * sigm(v[0]), bfhi(y.x) * sigm(v[1])); o.y = pk2(bflo(y.y) * sigm(v[2]), bfhi(y.y) * sigm(v[3]));
                        *(u32x2*)(CAT + (size_t)row * 1024 + 512 + cs) = o; } }
    }
};
struct EpiRes {
    static constexpr bool PERM = false, AFTER_DRAIN = false;
    bf16_t* XB; float* SSQ;
    DI void row(const f32x4 (&a4)[2][2], const Unit& u, int ai, int m, int wr, int wc, int fr, int fq) const {
        const int cb = u.pn * 256 + wc * 32 + 4 * fq, row = u.pm * 256 + wr * 64 + fr + ai * 128 + m * 16; float ss = 0.f;
#pragma unroll
        for (int bj = 0; bj < 2; ++bj)
#pragma unroll
            for (int n = 0; n < 2; ++n) { const int cs = cb + bj * 128 + n * 16; const f32x4 v = a4[bj][n];
                u32x2* px = (u32x2*)(XB + (size_t)row * 1024 + cs); const u32x2 x = *px; u32x2 o;
                o.x = pk2(bflo(x.x) + v[0], bfhi(x.x) + v[1]); o.y = pk2(bflo(x.y) + v[2], bfhi(x.y) + v[3]); *px = o;
                const float a0 = bflo(o.x), a1 = bfhi(o.x), a2 = bflo(o.y), a3 = bfhi(o.y); ss += (a0 * a0 + a1 * a1) + (a2 * a2 + a3 * a3); }
        ss += __shfl_xor(ss, 16); ss += __shfl_xor(ss, 32);
        if (fq == 0) SSQ[(size_t)row * 16 + u.pn * 4 + wc] = ss;
    }
    DI void operator()(const f32x4 (&acc)[2][2][4][2], const Unit& u, int wr, int wc, int fr, int fq) const {
#pragma unroll
        for (int ai = 0; ai < 2; ++ai)
#pragma unroll
            for (int m = 0; m < 4; ++m) { const f32x4 a4[2][2] = {{acc[ai][0][m][0], acc[ai][0][m][1]}, {acc[ai][1][m][0], acc[ai][1][m][1]}}; row(a4, u, ai, m, wr, wc, fr, fq); }
    }
};
struct EpiUp {
    static constexpr bool PERM = false, AFTER_DRAIN = false;
    const float* SSQ; bf16_t* H;
    DI void operator()(const f32x4 (&acc)[2][2][4][2], const Unit& u, int wr, int wc, int fr, int fq) const {
        const int cb = u.pn * 256 + wc * 32 + 4 * fq, row0 = u.pm * 256 + wr * 64 + fr;
#pragma unroll
        for (int ai = 0; ai < 2; ++ai)
#pragma unroll
            for (int m = 0; m < 4; ++m) { const int row = row0 + ai * 128 + m * 16; const float r = row_rinv(SSQ, row);
#pragma unroll
                for (int bj = 0; bj < 2; ++bj)
#pragma unroll
                    for (int n = 0; n < 2; ++n) { const int cs = cb + bj * 128 + n * 16; f32x4 v = acc[ai][bj][m][n] * r;
#pragma unroll
                        for (int e = 0; e < 4; ++e) { const float t = fmaxf(v[e], 0.f); v[e] = t * t; }
                        u32x2 o; o.x = pk2(v[0], v[1]); o.y = pk2(v[2], v[3]); *(u32x2*)(H + (size_t)row * 4096 + cs) = o; } }
    }
};
DI size_t kf_index(int seqh, int nkt, int key, int d) { return ((((size_t)seqh * nkt + (key >> 5)) * 8 + (d >> 4)) * 64 + ((key & 31) + 32 * ((d >> 3) & 1))) * 8 + (d & 7); }
DI size_t vf_index(int seqh, int nkt, int key, int d) { const int kk = key & 31;
    return ((((size_t)seqh * nkt + (key >> 5)) * 8 + (kk >> 4) * 4 + (d >> 5)) * 64 + ((d & 31) + 32 * ((kk >> 2) & 1))) * 8 + ((kk >> 3) & 1) * 4 + (kk & 3); }
struct EpiQkv {
    static constexpr bool PERM = false, AFTER_DRAIN = false;
    const float* SSQ; float* out; bf16_t *Q, *KP, *KS, *VTP, *VTS;
    DI void operator()(const f32x4 (&acc)[2][2][4][2], const Unit& u, int wr, int wc, int fr, int fq) const {
        const int third = u.pn >> 2, cb = (u.pn & 3) * 256 + wc * 32 + 4 * fq, row0 = u.pm * 256 + wr * 64 + fr;
#pragma unroll
        for (int ai = 0; ai < 2; ++ai)
#pragma unroll
            for (int m = 0; m < 4; ++m) { const int row = row0 + ai * 128 + m * 16; const float r = row_rinv(SSQ, row);
                const bool smp = row >= NTP; const int s = row - NTP; const int b = smp ? (s >> 6) : row / TP, key = smp ? 1024 + (s & 63) : row - b * TP, nkt = smp ? 34 : 129;
#pragma unroll
                for (int bj = 0; bj < 2; ++bj)
#pragma unroll
                    for (int n = 0; n < 2; ++n) { const int cs = cb + bj * 128 + n * 16; const f32x4 v = acc[ai][bj][m][n] * r;
                        u32x2 o; o.x = pk2(v[0], v[1]); o.y = pk2(v[2], v[3]);
                        if (third == 0) { *(u32x2*)(Q + (size_t)row * 1024 + cs) = o; }
                        else if (row < NT) { const int h = cs >> 7, d = cs & 127;
                            if (third == 1) { *(f32x4*)(out + (smp ? O_KS + (size_t)s * 1024 : O_KP + (size_t)row * 1024) + cs) = v;
                                *(u32x2*)((smp ? KS : KP) + kf_index(b * 8 + h, nkt, key, d)) = o; }
                            else { *(f32x4*)(out + (smp ? O_VS + (size_t)s * 1024 : O_VP + (size_t)row * 1024) + cs) = v;
                                bf16_t* vt = (smp ? VTS : VTP) + vf_index(b * 8 + h, nkt, key, d);
                                vt[0] = (bf16_t)(o.x & 0xffffu); vt[8] = (bf16_t)(o.x >> 16); vt[16] = (bf16_t)(o.y & 0xffffu); vt[24] = (bf16_t)(o.y >> 16); } } } }
    }
};
struct EpiFin {
    static constexpr bool PERM = false, AFTER_DRAIN = false;
    const bf16_t* XB; float* SSQ; float* out;
    DI void row(const f32x4 (&a4)[2][2], const Unit& u, int ai, int m, int wr, int wc, int fr, int fq) const {
        const int cb = u.pn * 256 + wc * 32 + 4 * fq, row = u.pm * 256 + wr * 64 + fr + ai * 128 + m * 16; float ss = 0.f;
        const int b = row / TP, t = row - b * TP; const bool ok = row < NT && (row >= NTP || t >= 16);
        float* dst = out + (row >= NTP ? O_YS + (size_t)(row - NTP) * 1024 : O_YP + ((size_t)b * 4096 + (t - 16)) * 1024);
#pragma unroll
        for (int bj = 0; bj < 2; ++bj)
#pragma unroll
            for (int n = 0; n < 2; ++n) { const int cs = cb + bj * 128 + n * 16; f32x4 v = a4[bj][n];
                const u32x2 x = *(const u32x2*)(XB + (size_t)row * 1024 + cs);
                v[0] += bflo(x.x); v[1] += bfhi(x.x); v[2] += bflo(x.y); v[3] += bfhi(x.y);
                if (ok) *(f32x4*)(dst + cs) = v;
                ss += (v[0] * v[0] + v[1] * v[1]) + (v[2] * v[2] + v[3] * v[3]); }
        ss += __shfl_xor(ss, 16); ss += __shfl_xor(ss, 32);
        if (fq == 0) SSQ[(size_t)row * 16 + u.pn * 4 + wc] = ss;
    }
    DI void operator()(const f32x4 (&acc)[2][2][4][2], const Unit& u, int wr, int wc, int fr, int fq) const {
#pragma unroll
        for (int ai = 0; ai < 2; ++ai)
#pragma unroll
            for (int m = 0; m < 4; ++m) { const f32x4 a4[2][2] = {{acc[ai][0][m][0], acc[ai][0][m][1]}, {acc[ai][1][m][0], acc[ai][1][m][1]}}; row(a4, u, ai, m, wr, wc, fr, fq); }
    }
};
template <class Epi> DI void run_gemm(LAS unsigned char* lds, const bf16_t* A, const bf16_t* Bt, int N, int K, const Epi& E) {
    pg8::Gemm g; g.A = A; g.Bt = Bt; g.M = MP; g.N = N; g.K = K; g.part = nullptr;
    pg8::StaticOrder S; S.init(MP, N, (int)gridDim.x, (int)blockIdx.x);
    pg8::gemm_phase<Epi, pg8::StaticOrder>(lds, g, S, E);
}
struct SplitOrder : pg8::StaticOrder {
    int nwhole, ntail, S, nks;
    DI void init2(int N, int K) { init(MP, N, (int)gridDim.x, (int)blockIdx.x); nwhole = nwg / G; ntail = nwg - nwhole * G; S = 0; nks = 0;
        if (ntail > 0) { int s = G / ntail; const int nkt = K / 64; while (s > 1 && (nkt % s != 0 || (nkt / s) < 4 || ((nkt / s) & 1))) --s; if (s > 1) { S = s; nks = nkt / s; } } }
    DI bool next(int i, Unit& u) const {
        if (S == 0) return pg8::StaticOrder::next(i, u);
        if (i < nwhole) { map(i * G + c, u); return true; }
        if (i == nwhole && c < ntail * S) { map(nwhole * G + c / S, u); u.kb = (c % S) * nks; u.nk = nks; u.part = c; return true; }
        return false;
    }
};
template <class Epi> DI void run_gemm_split(LAS unsigned char* lds, const bf16_t* A, const bf16_t* Bt, int N, int K, const Epi& E, float* part) {
    pg8::Gemm g; g.A = A; g.Bt = Bt; g.M = MP; g.N = N; g.K = K; g.part = part;
    SplitOrder S; S.init2(N, K);
    pg8::gemm_phase<Epi, SplitOrder>(lds, g, S, E);
}
template <class Epi> DI void gemm_fixup(int N, int K, const Epi& E, const float* part, int tid) {
    SplitOrder S; S.init2(N, K); if (S.S == 0) return;
    const int wid = tid >> 6, lane = tid & 63, wr = wid >> 2, wc = wid & 3, fr = lane & 15, fq = lane >> 4;
    for (int it = blockIdx.x; it < S.ntail * 8; it += gridDim.x) { const int j = it >> 3, ai = (it >> 2) & 1, m = it & 3; Unit u; S.map(S.nwhole * S.G + j, u);
        f32x4 a4[2][2];
#pragma unroll
        for (int b = 0; b < 2; ++b)
#pragma unroll
            for (int n = 0; n < 2; ++n) { const f32x4* pp = (const f32x4*)part + ((size_t)(j * S.S) * 32 + (((ai * 2 + b) * 4 + m) * 2 + n)) * 512 + tid;
                f32x4 v0 = {0.f, 0.f, 0.f, 0.f}, v1 = v0, v2 = v0, v3 = v0;
                for (int sl = 0; sl + 3 < S.S; sl += 4) { v0 += pp[(size_t)sl * 16384]; v1 += pp[(size_t)(sl + 1) * 16384]; v2 += pp[(size_t)(sl + 2) * 16384]; v3 += pp[(size_t)(sl + 3) * 16384]; }
                for (int sl = S.S & ~3; sl < S.S; ++sl) v0 += pp[(size_t)sl * 16384];
                a4[b][n] = (v0 + v1) + (v2 + v3); }
        E.row(a4, u, ai, m, wr, wc, fr, fq); }
}
DI void transpose_item(const float* W, int N, bf16_t* WT, size_t ldo, const float* sc, LAS float* scr, int item, int lane) {
    const int nblk = N / 32, kb = item / nblk, nb = item % nblk, k0 = 64 * kb, n0 = 32 * nb;
#pragma unroll 8
    for (int i = 0; i < 32; ++i) { const int kk = 2 * i + (lane >> 5); float w = W[(size_t)(k0 + kk) * N + n0 + (lane & 31)]; if (sc) w *= sc[k0 + kk]; scr[kk * 33 + (lane & 31)] = w; }
    LDS_WAIT();
    const int c = lane & 7;
#pragma unroll
    for (int j = 0; j < 4; ++j) { const int n = (lane >> 3) + 8 * j; const LAS float* s = scr + (8 * c) * 33 + n;
        u32x4v o; o.x = pk2(s[0 * 33], s[1 * 33]); o.y = pk2(s[2 * 33], s[3 * 33]); o.z = pk2(s[4 * 33], s[5 * 33]); o.w = pk2(s[6 * 33], s[7 * 33]);
        *(u32x4v*)(WT + (size_t)(n0 + n) * ldo + k0 + 8 * c) = o; }
    LDS_WAIT();
}
DI void s5_pow(const Prm& p, int g, int n, float k, float& re, float& im) {
    const float dt = __expf(p.log_dt[g]), ar = p.a_re[g * 64 + n], ai = p.a_im[g * 64 + n];
    const float mag = __expf(k * dt * ar); float rev = k * dt * ai * 0.15915494309189535f; rev -= rintf(rev);
    re = mag * __builtin_amdgcn_cosf(rev); im = mag * __builtin_amdgcn_sinf(rev);
}
DI void s5_bbar(const Prm& p, int g, int n, int pp, float& re, float& im) {
    const float ar = p.a_re[g * 64 + n], ai = p.a_im[g * 64 + n]; float abr, abi; s5_pow(p, g, n, 1.f, abr, abi);
    const float den = ar * ar + ai * ai, zr = ((abr - 1.f) * ar + abi * ai) / den, zi = (abi * ar - (abr - 1.f) * ai) / den;
    const float br = p.b_re[(g * 64 + n) * 16 + pp], bi = p.b_im[(g * 64 + n) * 16 + pp];
    re = zr * br - zi * bi; im = zr * bi + zi * br;
}
DI void phase_prologue(const Prm& p, LAS unsigned char* lds, int tid, int lane, int wave) {
    const int gw = blockIdx.x * 8 + wave, NGW = gridDim.x * 8, gtid = blockIdx.x * 512 + tid, GT = gridDim.x * 512;
    LAS float* scr = (LAS float*)(lds + wave * 16384);
    constexpr int I1 = 16 * 80, I2 = 8 * 16, I3 = 16 * 32, I4 = 16 * 128, I5 = 64 * 32, I6 = 16 * 96;
    constexpr int NITEMS = I1 + I2 + I3 + I4 + I5 + I6 + I3 + I4 + I5;
    for (int it = gw; it < NITEMS; it += NGW) {
        int r = it;
        if (r < I1) { transpose_item(p.w_in_even, 2560, p.Wt1, 1024, p.ln_mix, scr, r, lane); continue; } r -= I1;
        if (r < I2) { transpose_item(p.w_glu, 512, p.Wglu, 512, nullptr, scr, r, lane); continue; } r -= I2;
        if (r < I3) { transpose_item(p.w_out_even, 1024, p.Wo0, 1024, nullptr, scr, r, lane); continue; } r -= I3;
        if (r < I4) { transpose_item(p.w_up, 4096, p.Wup0, 1024, p.ln_mlp, scr, r, lane); continue; } r -= I4;
        if (r < I5) { transpose_item(p.w_down, 1024, p.Wdn0, 4096, nullptr, scr, r, lane); continue; } r -= I5;
        if (r < I6) { transpose_item(p.w_in_odd, 3072, p.Wqkv, 1024, p.ln_mix + 1024, scr, r, lane); continue; } r -= I6;
        if (r < I3) { transpose_item(p.w_out_odd, 1024, p.Wo1, 1024, nullptr, scr, r, lane); continue; } r -= I3;
        if (r < I4) { transpose_item(p.w_up + (size_t)1024 * 4096, 4096, p.Wup1, 1024, p.ln_mlp + 1024, scr, r, lane); continue; } r -= I4;
        transpose_item(p.w_down + (size_t)4096 * 1024, 1024, p.Wdn1, 4096, nullptr, scr, r, lane);
    }
    for (int row = gw; row < NT; row += NGW) {
        const float* src;
        if (row < NTP) { const int b = row / TP, t = row - b * TP; src = t < 16 ? p.meta + (size_t)t * 1024 : p.x_prompt + ((size_t)b * 4096 + (t - 16)) * 1024; }
        else src = p.x_sample + (size_t)(row - NTP) * 1024;
        float ss = 0.f;
#pragma unroll
        for (int j = 0; j < 4; ++j) { const f32x4 v = ((const f32x4*)src)[lane + 64 * j]; u32x2 o; o.x = pk2(v.x, v.y); o.y = pk2(v.z, v.w);
            const float a0 = bflo(o.x), a1 = bfhi(o.x), a2 = bflo(o.y), a3 = bfhi(o.y); ss += (a0 * a0 + a1 * a1) + (a2 * a2 + a3 * a3);
            ((u32x2*)(p.XB + (size_t)row * 1024))[lane + 64 * j] = o; }
        ss = wave_sum(ss);
        if (lane < 16) p.SSQ[(size_t)row * 16 + lane] = lane == 0 ? ss : 0.f;
    }
    if (gtid < 512) p.LB[gtid] = 1.f / (1.f + __expf(p.hgrn_lb[512 + gtid] - p.hgrn_lb[gtid]));
    __syncthreads();
    {
        LAS float* zr_ = (LAS float*)lds; LAS float* zi_ = zr_ + 64; LAS float* wr_ = zi_ + 64; LAS float* wi_ = wr_ + 64;
        LAS float* bbr = wi_ + 64; LAS float* bbi = bbr + 1024; LAS float* cwr = bbi + 1024; LAS float* cwi = cwr + 16 * 65;
        for (int pair = blockIdx.x; pair < 512; pair += gridDim.x) { const int g = pair >> 4, tau = pair & 15;
            if (tid < 64) { const int n = tid; const float ar = p.a_re[g * 64 + n], ai = p.a_im[g * 64 + n]; float abr, abi; s5_pow(p, g, n, 1.f, abr, abi);
                const float den = ar * ar + ai * ai; zr_[n] = ((abr - 1.f) * ar + abi * ai) / den; zi_[n] = (abi * ar - (abr - 1.f) * ai) / den;
                float a, b; s5_pow(p, g, n, (float)tau, a, b); wr_[n] = a; wi_[n] = b; }
            __syncthreads();
#pragma unroll
            for (int k = 0; k < 2; ++k) { const int e = tid + 512 * k;
                { const int n = e >> 4; const float br = p.b_re[g * 1024 + e], bi = p.b_im[g * 1024 + e]; bbr[e] = zr_[n] * br - zi_[n] * bi; bbi[e] = zr_[n] * bi + zi_[n] * br; }
                { const int pch = e >> 6, n = e & 63; const float cr = p.c_re[g * 1024 + e], ci = p.c_im[g * 1024 + e]; cwr[pch * 65 + n] = cr * wr_[n] - ci * wi_[n]; cwi[pch * 65 + n] = cr * wi_[n] + ci * wr_[n]; } }
            __syncthreads();
            if (tid < 256) { const int pch = tid >> 4, pp = tid & 15; float acc = 0.f;
#pragma unroll 8
                for (int n = 0; n < 64; ++n) acc += cwr[pch * 65 + n] * bbr[n * 16 + pp] - cwi[pch * 65 + n] * bbi[n * 16 + pp];
                if (tau == 0 && pch == pp) acc += p.ssm_d[g * 16 + pch];
                const bf16_t kv = f2bf(acc);
                for (int t = tau; t < 16; ++t) p.TG[((size_t)(g * 256 + t * 16 + pch)) * 384 + (t - tau) * 16 + pp] = kv;
                if (tau > 0) for (int t = 0; t < 16 - tau; ++t) p.TG[((size_t)(g * 256 + t * 16 + pch)) * 384 + (t + tau) * 16 + pp] = 0; }
            __syncthreads(); }
    }
    for (int i = gtid; i < 32 * 256 * 64; i += GT) {
        const int g = i >> 14, t = (i >> 10) & 15, pch = (i >> 6) & 15, n = i & 63; float wr_, wi_; s5_pow(p, g, n, (float)(t + 1), wr_, wi_);
        const float cr = p.c_re[(g * 16 + pch) * 64 + n], ci = p.c_im[(g * 16 + pch) * 64 + n];
        *(unsigned*)(p.TG + ((size_t)(g * 256 + t * 16 + pch)) * 384 + 256 + 2 * n) = pk2(cr * wr_ - ci * wi_, -(cr * wi_ + ci * wr_)); }
    for (int i = gtid; i < 32 * 64 * 256; i += GT) {
        const int g = i >> 14, n = (i >> 8) & 63, s = (i >> 4) & 15, pp = i & 15; float wr_, wi_, br_, bi_; s5_pow(p, g, n, (float)(15 - s), wr_, wi_); s5_bbar(p, g, n, pp, br_, bi_);
        p.HT[((size_t)(g * 128 + 2 * n)) * 256 + s * 16 + pp] = f2bf(wr_ * br_ - wi_ * bi_);
        p.HT[((size_t)(g * 128 + 2 * n + 1)) * 256 + s * 16 + pp] = f2bf(wr_ * bi_ + wi_ * br_); }
    if (gtid < 2048) { float wr_, wi_; s5_pow(p, gtid >> 6, gtid & 63, 16.f, wr_, wi_); p.A16[2 * gtid] = wr_; p.A16[2 * gtid + 1] = wi_; }
}

constexpr int HP = 136, TPI = 72;
constexpr int L_QT = 0, L_QH = 17408, L_KT = 34816, L_KTT = 52224, L_IVT = 70656, L_ATT = 89088, L_SUM = 98304, L_VEC = 100352, L_OB = 0  ;
struct HItem { int row0, L, h, bh; };
DI HItem hgrn_item(int item) {
    HItem it;
    if (item < 2080) { const int bh = item / 65, c = item - bh * 65, b = bh >> 2; it.h = bh & 3; it.bh = bh; it.L = c == 0 ? 16 : 64; it.row0 = b * TP + (c == 0 ? 0 : 16 + 64 * (c - 1)); }
    else { const int s = item - 2080, b = s >> 2; it.h = s & 3; it.bh = 32 + s; it.L = 64; it.row0 = NTP + b * 64; }
    return it;
}
template <bool FULL> DI void hgrn_prep(const Prm& p, const HItem& it, LAS unsigned char* lds, int tid) {
    const int d = tid & 127, tq = tid >> 7, t0 = 16 * tq, col = it.h * 128 + d;
    LAS float* sums = (LAS float*)(lds + L_SUM); LAS float* vec = (LAS float*)(lds + L_VEC);
    float cs[16], lf[16];
    float run = 0.f;
#pragma unroll
    for (int j = 0; j < 16; ++j) { const int t = t0 + j; lf[j] = t < it.L ? h2f(p.LOGF[(size_t)(it.row0 + t) * 512 + col]) : 0.f; run += lf[j]; cs[j] = run; }
    sums[tq * 128 + d] = run;
    unsigned ivp[8];
#pragma unroll
    for (int j = 0; j < 8; ++j) { const int t = t0 + 2 * j;
        const unsigned lo = t < it.L ? p.IV[(size_t)(it.row0 + t) * 512 + col] : 0u, hi = t + 1 < it.L ? p.IV[(size_t)(it.row0 + t + 1) * 512 + col] : 0u; ivp[j] = lo | (hi << 16); }
    { LAS u32x4v* dst = (LAS u32x4v*)(lds + L_IVT + (d * TPI + t0) * 2); u32x4v a, b; a.x = ivp[0]; a.y = ivp[1]; a.z = ivp[2]; a.w = ivp[3]; b.x = ivp[4]; b.y = ivp[5]; b.z = ivp[6]; b.w = ivp[7]; dst[0] = a; dst[1] = b; }
    __syncthreads();
    const float s0 = sums[d], s1 = sums[128 + d], s2 = sums[256 + d], s3 = sums[384 + d];
    const float off = tq == 0 ? 0.f : tq == 1 ? s0 : tq == 2 ? s0 + s1 : s0 + s1 + s2, r = s0 + s1, bL = r + s2 + s3;
    if (tq == 0) { vec[d] = r; vec[128 + d] = bL; }
    unsigned ktp[8]; float kprev = 0.f;
#pragma unroll
    for (int j = 0; j < 16; ++j) { const int t = t0 + j; const bool valid = t < it.L; const float b = off + cs[j];
        const float kt = valid ? (1.f - __expf(lf[j])) * __expf(r - b) : 0.f;
        if (j & 1) ktp[j >> 1] = pk2(kprev, kt); else kprev = kt;
        if (FULL) { const float qv = valid ? bf2f(p.Qh[(size_t)(it.row0 + t) * 512 + col]) : 0.f;
            *(LAS unsigned short*)(lds + L_KT + (t * HP + d) * 2) = f2bf(kt);
            *(LAS unsigned short*)(lds + L_QT + (t * HP + d) * 2) = f2bf(qv * __expf(b - r));
            *(LAS unsigned short*)(lds + L_QH + (t * HP + d) * 2) = f2bf(qv * __expf(b)); } }
    if (!FULL) { LAS u32x4v* dst = (LAS u32x4v*)(lds + L_KTT + (d * TPI + t0) * 2); u32x4v a, b; a.x = ktp[0]; a.y = ktp[1]; a.z = ktp[2]; a.w = ktp[3]; b.x = ktp[4]; b.y = ktp[5]; b.z = ktp[6]; b.w = ktp[7]; dst[0] = a; dst[1] = b; }
    __syncthreads();
}
#define MFMA16(a, b, c) __builtin_amdgcn_mfma_f32_16x16x32_bf16((a), (b), (c), 0, 0, 0)
#define MFMA32(a, b, c) __builtin_amdgcn_mfma_f32_32x32x16_bf16((a), (b), (c), 0, 0, 0)
DI void hgrn_b1(const Prm& p, int item, LAS unsigned char* lds, int tid, int lane, int wave) {
    const HItem it = hgrn_item(item);
    hgrn_prep<false>(p, it, lds, tid);
    const LAS float* vec = (const LAS float*)(lds + L_VEC);
    const int fr = lane & 15, fq = lane >> 4;
    bf16x8 a[2];
#pragma unroll
    for (int ks = 0; ks < 2; ++ks) a[ks] = *(const LAS bf16x8*)(lds + L_KTT + ((16 * wave + fr) * TPI + 32 * ks + 8 * fq) * 2);
    float e2[4];
#pragma unroll
    for (int j = 0; j < 4; ++j) { const int d = 16 * wave + 4 * fq + j; e2[j] = __expf(vec[128 + d] - vec[d]); }
#pragma unroll
    for (int vt = 0; vt < 8; ++vt) { f32x4 acc = {0.f, 0.f, 0.f, 0.f};
#pragma unroll
        for (int ks = 0; ks < 2; ++ks) { const bf16x8 b = *(const LAS bf16x8*)(lds + L_IVT + ((16 * vt + fr) * TPI + 32 * ks + 8 * fq) * 2); acc = MFMA16(a[ks], b, acc); }
        u32x2 o; o.x = pk2(acc[0] * e2[0], acc[1] * e2[1]); o.y = pk2(acc[2] * e2[2], acc[3] * e2[3]);
        *(u32x2*)(p.UT + (size_t)item * 16384 + (16 * vt + fr) * 128 + 16 * wave + 4 * fq) = o; }
    if (tid < 128) p.AL[(size_t)item * 128 + tid] = __expf(vec[128 + tid]);
    __syncthreads();
}
DI void hgrn_b2(const Prm& p, int gtid, int GT) {
    for (int idx = gtid; idx < 64 * 4096; idx += GT) {
        const int bhx = idx >> 12, e = idx & 4095, v = e >> 5, d4 = (e & 31) * 4; const bool smp = bhx >= 32;
        const int item0 = smp ? 2080 + (bhx - 32) : bhx * 65, nch = smp ? 1 : 65;
        float S[4] = {0.f, 0.f, 0.f, 0.f};
        if (smp) {
#pragma unroll
            for (int j = 0; j < 4; ++j) S[j] = p.state_hgrn[((size_t)(bhx - 32) * 128 + d4 + j) * 128 + v]; }
        for (int c0 = 0; c0 < nch; c0 += 5) {
            u32x2 uu[5]; f32x4 al[5];
#pragma unroll
            for (int i = 0; i < 5; ++i) if (c0 + i < nch) { uu[i] = *(const u32x2*)(p.UT + (size_t)(item0 + c0 + i) * 16384 + v * 128 + d4); al[i] = *(const f32x4*)(p.AL + (size_t)(item0 + c0 + i) * 128 + d4); }
#pragma unroll
            for (int i = 0; i < 5; ++i) if (c0 + i < nch) { u32x2 o; o.x = pk2(S[0], S[1]); o.y = pk2(S[2], S[3]);
                *(u32x2*)(p.UT + (size_t)(item0 + c0 + i) * 16384 + v * 128 + d4) = o;
                S[0] = al[i][0] * S[0] + bflo(uu[i].x); S[1] = al[i][1] * S[1] + bfhi(uu[i].x); S[2] = al[i][2] * S[2] + bflo(uu[i].y); S[3] = al[i][3] * S[3] + bfhi(uu[i].y); } }
        float* dst = p.out + (smp ? O_HGS + (size_t)(bhx - 32) * 16384 : O_HGP + (size_t)bhx * 16384);
#pragma unroll
        for (int j = 0; j < 4; ++j) dst[(d4 + j) * 128 + v] = S[j];
    }
}
DI void hgrn_b3(const Prm& p, int item, LAS unsigned char* lds, int tid, int lane, int wave) {
    const HItem it = hgrn_item(item);
    hgrn_prep<true>(p, it, lds, tid);
    const int fr = lane & 15, fq = lane >> 4;
    {
        const int tt = wave >> 1;
#pragma unroll
        for (int i = 0; i < 2; ++i) { const int st = 2 * (wave & 1) + i; f32x4 acc = {0.f, 0.f, 0.f, 0.f};
#pragma unroll
            for (int ks = 0; ks < 4; ++ks) { const bf16x8 a = *(const LAS bf16x8*)(lds + L_KT + ((16 * st + fr) * HP + 32 * ks + 8 * fq) * 2);
                const bf16x8 b = *(const LAS bf16x8*)(lds + L_QT + ((16 * tt + fr) * HP + 32 * ks + 8 * fq) * 2); acc = MFMA16(a, b, acc); }
            const int t = 16 * tt + fr, s0 = 16 * st + 4 * fq;
            u32x2 o; o.x = pk2(s0 <= t ? acc[0] : 0.f, s0 + 1 <= t ? acc[1] : 0.f); o.y = pk2(s0 + 2 <= t ? acc[2] : 0.f, s0 + 3 <= t ? acc[3] : 0.f);
            *(LAS u32x2*)(lds + L_ATT + (t * TPI + s0) * 2) = o; }
    }
    __syncthreads();
    f32x4 oacc[4];
    {   const int tt = wave & 3;
        bf16x8 aa[2], aq[4];
#pragma unroll
        for (int ks = 0; ks < 2; ++ks) aa[ks] = *(const LAS bf16x8*)(lds + L_ATT + ((16 * tt + fr) * TPI + 32 * ks + 8 * fq) * 2);
#pragma unroll
        for (int ks = 0; ks < 4; ++ks) aq[ks] = *(const LAS bf16x8*)(lds + L_QH + ((16 * tt + fr) * HP + 32 * ks + 8 * fq) * 2);
#pragma unroll
        for (int i = 0; i < 4; ++i) { const int vt = 4 * (wave >> 2) + i; f32x4 acc = {0.f, 0.f, 0.f, 0.f};
#pragma unroll
            for (int ks = 0; ks < 2; ++ks) { const bf16x8 b = *(const LAS bf16x8*)(lds + L_IVT + ((16 * vt + fr) * TPI + 32 * ks + 8 * fq) * 2); acc = MFMA16(aa[ks], b, acc); }
#pragma unroll
            for (int ks = 0; ks < 4; ++ks) { const bf16x8 b = *(const bf16x8*)(p.UT + (size_t)item * 16384 + (16 * vt + fr) * 128 + 32 * ks + 8 * fq); acc = MFMA16(aq[ks], b, acc); }
            oacc[i] = acc; }
    }
    __syncthreads();
    {   const int tt = wave & 3; LAS float* ob = (LAS float*)(lds + L_OB);
#pragma unroll
        for (int i = 0; i < 4; ++i) { const int v = 16 * (4 * (wave >> 2) + i) + fr;
#pragma unroll
            for (int j = 0; j < 4; ++j) ob[(16 * tt + 4 * fq + j) * 132 + v] = oacc[i][j]; }
    }
    __syncthreads();
    {   const int t = tid >> 3, sg = tid & 7; const LAS float* ob = (const LAS float*)(lds + L_OB) + t * 132 + 16 * sg;
        f32x4 x[4]; float ss = 0.f;
#pragma unroll
        for (int j = 0; j < 4; ++j) { x[j] = ((const LAS f32x4*)ob)[j]; ss += (x[j].x * x[j].x + x[j].y * x[j].y) + (x[j].z * x[j].z + x[j].w * x[j].w); }
        ss += __shfl_xor(ss, 1); ss += __shfl_xor(ss, 2); ss += __shfl_xor(ss, 4);
        const float rr = rsqrtf(ss * (1.f / 128.f) + EPSN);
        if (t < it.L) { const size_t row = it.row0 + t; const int c0 = it.h * 128 + 16 * sg;
            const u32x4v g0 = *(const u32x4v*)(p.GS + row * 512 + c0), g1 = *(const u32x4v*)(p.GS + row * 512 + c0 + 8);
            const f32x4* gn = (const f32x4*)(p.hgrn_norm + 16 * sg);
            const f32x4 n0 = gn[0], n1 = gn[1], n2 = gn[2], n3 = gn[3];
            u32x4v o0, o1;
            o0.x = pk2(x[0].x * rr * n0.x * bflo(g0.x), x[0].y * rr * n0.y * bfhi(g0.x)); o0.y = pk2(x[0].z * rr * n0.z * bflo(g0.y), x[0].w * rr * n0.w * bfhi(g0.y));
            o0.z = pk2(x[1].x * rr * n1.x * bflo(g0.z), x[1].y * rr * n1.y * bfhi(g0.z)); o0.w = pk2(x[1].z * rr * n1.z * bflo(g0.w), x[1].w * rr * n1.w * bfhi(g0.w));
            o1.x = pk2(x[2].x * rr * n2.x * bflo(g1.x), x[2].y * rr * n2.y * bfhi(g1.x)); o1.y = pk2(x[2].z * rr * n2.z * bflo(g1.y), x[2].w * rr * n2.w * bfhi(g1.y));
            o1.z = pk2(x[3].x * rr * n3.x * bflo(g1.z), x[3].y * rr * n3.y * bfhi(g1.z)); o1.w = pk2(x[3].z * rr * n3.z * bflo(g1.w), x[3].w * rr * n3.w * bfhi(g1.w));
            *(u32x4v*)(p.CAT + row * 1024 + c0) = o0; *(u32x4v*)(p.CAT + row * 1024 + c0 + 8) = o1; }
    }
    __syncthreads();
}
DI void s5_load_u(const Prm& p, int mt, int g, int lane, bf16x8 (&uf)[8]) {
    const int fr = lane & 15, fq = lane >> 4; int col = 16 * mt + fr; if (col >= NCOL) col = NCOL - 1;
#pragma unroll
    for (int ks = 0; ks < 8; ++ks) uf[ks] = *(const bf16x8*)(p.U + ((size_t)(16 * col + 2 * ks + (fq >> 1))) * 512 + 16 * g + 8 * (fq & 1));
}
DI void s5_b(const Prm& p, int gw, int NGW, int lane) {
    const int fr = lane & 15, fq = lane >> 4;
    for (int task = gw; task < 131 * 32; task += NGW) { const int mt = task >> 5, g = task & 31;
        bf16x8 uf[8]; s5_load_u(p, mt, g, lane, uf);
#pragma unroll
        for (int nt = 0; nt < 8; ++nt) { f32x4 acc = {0.f, 0.f, 0.f, 0.f};
#pragma unroll
            for (int ks = 0; ks < 8; ++ks) { const bf16x8 b = *(const bf16x8*)(p.HT + ((size_t)(g * 128 + 16 * nt + fr)) * 256 + 32 * ks + 8 * fq); acc = MFMA16(uf[ks], b, acc); }
#pragma unroll
            for (int j = 0; j < 4; ++j) { const int col = 16 * mt + 4 * fq + j; if (col < NCOL) p.XLOC[(size_t)col * 4096 + g * 128 + 16 * nt + fr] = acc[j]; } }
    }
}
DI void s5_c(const Prm& p, int gtid) {
    if (gtid >= 16 * 2048) return;
    const int seq = gtid >> 11, g = (gtid >> 6) & 31, n = gtid & 63; const bool smp = seq >= 8; const int b = seq & 7;
    const int col0 = smp ? 2056 + 4 * b : 257 * b, nch = smp ? 4 : 257;
    float xr = 0.f, xi = 0.f; if (smp) { xr = p.ssm_re0[(b * 32 + g) * 64 + n]; xi = p.ssm_im0[(b * 32 + g) * 64 + n]; }
    const float ar = p.A16[2 * (g * 64 + n)], ai = p.A16[2 * (g * 64 + n) + 1];
    const size_t base = (size_t)g * 128 + 2 * n;
    for (int c0 = 0; c0 < nch; c0 += 8) {
        f32x2v xl[8];
#pragma unroll
        for (int i = 0; i < 8; ++i) if (c0 + i < nch) xl[i] = *(const f32x2v*)(p.XLOC + (size_t)(col0 + c0 + i) * 4096 + base);
#pragma unroll
        for (int i = 0; i < 8; ++i) if (c0 + i < nch) { *(unsigned*)(p.XPREV + (size_t)(col0 + c0 + i) * 4096 + base) = pk2(xr, xi);
            const float nr = ar * xr - ai * xi + xl[i].x, ni = ar * xi + ai * xr + xl[i].y; xr = nr; xi = ni; } }
    const size_t o = (size_t)(b * 32 + g) * 64 + n;
    p.out[(smp ? O_SRS : O_SRP) + o] = xr; p.out[(smp ? O_SIS : O_SIP) + o] = xi;
}
DI f32x2v gelu_pk(f32x2v v) {
    const f32x2v av = __builtin_elementwise_abs(v), d = av * 0.2316418882f + 1.0f;
    f32x2v t; t.x = __builtin_amdgcn_rcpf(d.x); t.y = __builtin_amdgcn_rcpf(d.y);
    f32x2v q = t * 0.5307027145f + (-0.7265760135f); q = q * t + 0.7107068705f; q = q * t + (-0.142248368f); q = q * t + 0.127414796f; q = q * t;
    const f32x2v s = (v * v) * (-0.72134752044f);
    f32x2v e; e.x = __builtin_amdgcn_exp2f(s.x); e.y = __builtin_amdgcn_exp2f(s.y);
    const f32x2v m = v * (q * e), r = v - m;
    f32x2v o; o.x = v.x < 0.f ? m.x : r.x; o.y = v.y < 0.f ? m.y : r.y; return o;
}
DI void s5_d(const Prm& p, int gw, int NGW, int lane) {
    const int fr = lane & 15, fq = lane >> 4;
    for (int task = gw; task < 131 * 32; task += NGW) { const int mt = task >> 5, g = task & 31;
        bf16x8 uf[8], xf[4]; s5_load_u(p, mt, g, lane, uf);
        int colc = 16 * mt + fr; if (colc >= NCOL) colc = NCOL - 1;
#pragma unroll
        for (int ks = 0; ks < 4; ++ks) xf[ks] = *(const bf16x8*)(p.XPREV + (size_t)colc * 4096 + g * 128 + 32 * ks + 8 * fq);
        const bf16_t* tg = p.TG + ((size_t)(g * 256 + fr)) * 384 + 8 * fq;
        const bool ok = 16 * mt + fr < NCOL;
#pragma unroll
        for (int t = 0; t < 16; ++t) { f32x4 acc = {0.f, 0.f, 0.f, 0.f};
#pragma unroll
            for (int ks = 0; ks < 8; ++ks) if (ks <= (t >> 1)) { const bf16x8 a = *(const bf16x8*)(tg + (size_t)t * 16 * 384 + 32 * ks); acc = MFMA16(a, uf[ks], acc); }
#pragma unroll
            for (int ks = 0; ks < 4; ++ks) { const bf16x8 a = *(const bf16x8*)(tg + (size_t)t * 16 * 384 + 256 + 32 * ks); acc = MFMA16(a, xf[ks], acc); }
            const f32x2v y0 = gelu_pk((f32x2v){acc[0], acc[1]}), y1 = gelu_pk((f32x2v){acc[2], acc[3]});
            u32x2 o; o.x = pk2(y0.x, y0.y); o.y = pk2(y1.x, y1.y);
            if (ok) *(u32x2*)(p.YG + ((size_t)(16 * (16 * mt + fr) + t)) * 512 + 16 * g + 4 * fq) = o; }
    }
}
DI void cache_convert(const Prm& p, int gtid, int GT) {
    for (size_t i = (size_t)gtid; i < (size_t)8 * 1024 * 256; i += (size_t)GT) {
        const size_t row = i >> 8; const int c4 = (int)(i & 255) * 4, b = (int)(row >> 10), pos = (int)(row & 1023), h = c4 >> 7, d = c4 & 127;
        const f32x4 k = *(const f32x4*)(p.cache_k + row * 1024 + c4); u32x2 o; o.x = pk2(k.x, k.y); o.y = pk2(k.z, k.w);
        *(u32x2*)(p.KS + kf_index(b * 8 + h, 34, pos, d)) = o;
        const f32x4 v = *(const f32x4*)(p.cache_v + row * 1024 + c4); bf16_t* vt = p.VTS + vf_index(b * 8 + h, 34, pos, d);
        vt[0] = f2bf(v.x); vt[8] = f2bf(v.y); vt[16] = f2bf(v.z); vt[24] = f2bf(v.w); }
}
DI void attn_phase(const Prm& p, int gw, int NGW, int lane) {
    const int q = lane & 31, half = lane >> 5;
    for (int it = gw; it < 8256 + 128; it += NGW) {
        bool smp; int b, h, qb;
        if (it < 8256) { smp = false; b = it / 1032; const int rem = it - b * 1032; h = rem / 129; qb = rem - h * 129; } else { const int s = it - 8256; smp = true; b = s >> 4; h = (s >> 1) & 7; qb = s & 1; }
        const size_t tbase = (size_t)(b * 8 + h) * (smp ? 34 : 129) * 4096 + lane * 8;
        const bf16_t* Kb = (smp ? p.KS : p.KP) + tbase; const bf16_t* Vb = (smp ? p.VTS : p.VTP) + tbase;
        const int qpos0 = (smp ? 1024 : 0) + 32 * qb, qrow0 = smp ? NTP + b * 64 + 32 * qb : b * TP + 32 * qb;
        const int qpos = qpos0 + q; const bool qvalid = smp || qpos < TP; const size_t qrow = qvalid ? qrow0 + q : qrow0;
        bf16x8 qf[8];
#pragma unroll
        for (int ks = 0; ks < 8; ++ks) qf[ks] = *(const bf16x8*)(p.Q + qrow * 1024 + h * 128 + 16 * ks + 8 * half);
        f32x16 o[4];
#pragma unroll
        for (int db = 0; db < 4; ++db)
#pragma unroll
            for (int e = 0; e < 16; ++e) o[db][e] = 0.f;
        float C = 1.f;
        for (int kt = (qpos0 + 30) >> 5; kt >= 0; --kt) {
            f32x16 s;
#pragma unroll
            for (int e = 0; e < 16; ++e) s[e] = 0.f;
            const bf16_t* kr = Kb + (size_t)kt * 4096; const bf16_t* vr = Vb + (size_t)kt * 4096;
            bf16x8 kf[8], vf[8];
#pragma unroll
            for (int ks = 0; ks < 8; ++ks) kf[ks] = *(const bf16x8*)(kr + ks * 512);
#pragma unroll
            for (int ks = 0; ks < 8; ++ks) vf[ks] = *(const bf16x8*)(vr + ks * 512);
#pragma unroll
            for (int ks = 0; ks < 8; ++ks) s = MFMA32(kf[ks], qf[ks], s);
            float pr[16], be[16], G[4], Gp[4];
#pragma unroll
            for (int i = 0; i < 4; ++i) {
#pragma unroll
                for (int j = 0; j < 4; ++j) { const int key = 32 * kt + 8 * i + 4 * half + j; const bool valid = key < qpos;
                    float z = s[4 * i + j] * 0.08838834764831845f; z = fminf(fmaxf(z, -80.f), 80.f);
                    const float e = __expf(z), pp = __builtin_amdgcn_rcpf(1.f + e); pr[4 * i + j] = valid ? pp : 1.f; be[4 * i + j] = valid ? e * pp : 0.f; }
                G[i] = (pr[4 * i] * pr[4 * i + 1]) * (pr[4 * i + 2] * pr[4 * i + 3]); }
#pragma unroll
            for (int i = 0; i < 4; ++i) Gp[i] = __shfl_xor(G[i], 32);
            float w[16]; float E1 = 1.f;
#pragma unroll
            for (int i = 3; i >= 0; --i) { const float Glo = half ? Gp[i] : G[i], Ghi = half ? G[i] : Gp[i];
                float suf = C * (half ? E1 : E1 * Ghi);
#pragma unroll
                for (int j = 3; j >= 0; --j) { w[4 * i + j] = be[4 * i + j] * suf; suf *= pr[4 * i + j]; }
                E1 *= Glo * Ghi; }
            C *= E1;
#pragma unroll
            for (int c = 0; c < 2; ++c) { union { bf16x8 v; unsigned u[4]; } wf;
#pragma unroll
                for (int e = 0; e < 4; ++e) wf.u[e] = pk2(w[8 * c + 2 * e], w[8 * c + 2 * e + 1]);
#pragma unroll
                for (int db = 0; db < 4; ++db) o[db] = MFMA32(vf[4 * c + db], wf.v, o[db]); }
            if (__all(C < 1e-24f)) break;
        }
        if (qvalid) {
#pragma unroll
            for (int db = 0; db < 4; ++db)
#pragma unroll
                for (int i = 0; i < 4; ++i) { u32x2 ov; ov.x = pk2(o[db][4 * i], o[db][4 * i + 1]); ov.y = pk2(o[db][4 * i + 2], o[db][4 * i + 3]);
                    *(u32x2*)(p.O + qrow * 1024 + h * 128 + 32 * db + 8 * i + 4 * half) = ov; } }
    }
}
DI void final_norm(const Prm& p, int gw, int NGW, int lane) {
    for (int r = gw; r < 32768 + 512; r += NGW) {
        int grow; float* dst;
        if (r < 32768) { const int b = r >> 12, t = r & 4095; grow = b * TP + 16 + t; dst = p.out + O_YP + (size_t)r * 1024; } else { grow = NTP + (r - 32768); dst = p.out + O_YS + (size_t)(r - 32768) * 1024; }
        const float rr = row_rinv(p.SSQ, grow);
#pragma unroll
        for (int j = 0; j < 4; ++j) { f32x4 v = ((f32x4*)dst)[lane + 64 * j]; const f32x4 g = ((const f32x4*)p.ln_final)[lane + 64 * j]; v = v * rr * g; ((f32x4*)dst)[lane + 64 * j] = v; }
    }
}

#define XB_TMO      128
#define XB_XCNT(j)  (256  + 64 * (j))
#define XB_XSUB(j)  (1280 + 64 * (j))
#define XB_XGEN(j)  (2304 + 64 * (j))
#define XB_TOP      3328
#define XB_TOPGEN   3392
#define XCD_BAR_WORDS 3456
#define XB_SPIN_CAP (1u << 18)
DI unsigned xb_ld(unsigned* p) { return __hip_atomic_load(p, __ATOMIC_RELAXED, __HIP_MEMORY_SCOPE_AGENT); }
DI unsigned xb_add(unsigned* p, unsigned v) { return __hip_atomic_fetch_add(p, v, __ATOMIC_RELAXED, __HIP_MEMORY_SCOPE_AGENT); }
DI unsigned xb_xcc_id() { return (unsigned)__builtin_amdgcn_s_getreg((3 << 11) | 20) & 0xFu; }
#define XB_SPIN(cond, bar) do { unsigned _sp = 0; while (cond) { __builtin_amdgcn_s_sleep(1); \
    if ((++_sp & 255u) == 0u) { if (xb_ld(&(bar)[XB_TMO])) break; if (_sp > XB_SPIN_CAP) { atomicAdd(&(bar)[XB_TMO], 1u); break; } } } } while (0)
struct XcdBarrier { unsigned* bar; unsigned x; volatile LAS unsigned* st; };
DI XcdBarrier xcd_barrier_post(unsigned* bar, volatile LAS unsigned* st) {
    XcdBarrier b; b.bar = bar; b.x = xb_xcc_id(); b.st = st;
    if (threadIdx.x == 0) (void)xb_add(&bar[XB_XCNT(b.x)], 1u);
    return b;
}
DI void xcd_barrier_complete(unsigned* bar, unsigned x, unsigned& nloc, unsigned& nx) {
    const unsigned G = gridDim.x * gridDim.y * gridDim.z;
    unsigned sum, cnt, mine, sp = 0u;
    for (;;) {
        sum = 0u; cnt = 0u; mine = 0u;
#pragma unroll
        for (unsigned j = 0; j < 16; ++j) { const unsigned c = xb_ld(&bar[XB_XCNT(j)]); sum += c; cnt += (c > 0u) ? 1u : 0u; mine = (j == x) ? c : mine; }
        if (sum == G) break;
        __builtin_amdgcn_s_sleep(1);
        if ((++sp & 255u) == 0u) { if (xb_ld(&bar[XB_TMO])) break; if (sp > XB_SPIN_CAP) { atomicAdd(&bar[XB_TMO], 1u); break; } }
    }
    nloc = mine > 0u ? mine : 1u; nx = cnt > 0u ? cnt : 1u;
}
DI void xcd_barrier(const XcdBarrier& b) {
    asm volatile("s_waitcnt vmcnt(0)" ::: "memory");
    __syncthreads();
    if (threadIdx.x == 0) {
        unsigned* bar = b.bar;
        __builtin_amdgcn_s_waitcnt(0);
        unsigned nloc = b.st[0], nx = b.st[1];
        if (nloc == 0u) { xcd_barrier_complete(bar, b.x, nloc, nx); b.st[0] = nloc; b.st[1] = nx; }
        const unsigned old = xb_add(&bar[XB_XSUB(b.x)], 1u);
        const unsigned gen = old / nloc;
        if (old + 1u == (gen + 1u) * nloc) {
            __builtin_amdgcn_fence(__ATOMIC_RELEASE, "agent");
            asm volatile("s_waitcnt vmcnt(0)" ::: "memory");
            const unsigned og = xb_add(&bar[XB_TOP], 1u);
            const unsigned tg = og / nx;
            if (og + 1u == (tg + 1u) * nx) xb_add(&bar[XB_TOPGEN], 1u);
            else XB_SPIN(xb_ld(&bar[XB_TOPGEN]) == tg, bar);
            __builtin_amdgcn_fence(__ATOMIC_ACQUIRE, "agent");
            xb_add(&bar[XB_XGEN(b.x)], 1u);
            asm volatile("s_waitcnt vmcnt(0)" ::: "memory");
        } else {
            XB_SPIN(xb_ld(&bar[XB_XGEN(b.x)]) == gen, bar);
            __builtin_amdgcn_fence(__ATOMIC_ACQUIRE, "agent");
            asm volatile("s_waitcnt vmcnt(0)" ::: "memory");
        }
    }
    __syncthreads();
}
constexpr int LDS_BYTES = 131072 + 256;
__global__ void __launch_bounds__(512, 2) fwd_megakernel(Prm p) {
    extern __shared__ __attribute__((aligned(16))) unsigned char shm[];
    LAS unsigned char* lds = (LAS unsigned char*)shm;
    cg::grid_group grid = cg::this_grid();
    const int tid = threadIdx.x, lane = tid & 63, wave = __builtin_amdgcn_readfirstlane(tid >> 6);
    const int gw = blockIdx.x * 8 + wave, NGW = gridDim.x * 8, gtid = blockIdx.x * 512 + tid, GT = gridDim.x * 512;
    volatile LAS unsigned* xst = (volatile LAS unsigned*)(lds + 131072);
    if (tid == 0) { xst[0] = 0u; xst[1] = 0u; }
    __syncthreads();
    const XcdBarrier xb = xcd_barrier_post(p.BAR, xst);
    phase_prologue(p, lds, tid, lane, wave);
    grid.sync();
    { EpiIn0 E; E.SSQ = p.SSQ; E.LB = p.LB; E.Qh = p.Qh; E.IV = p.IV; E.GS = p.GS; E.U = p.U; E.LOGF = p.LOGF; run_gemm(lds, p.XB, p.Wt1, 2560, 1024, E); }
    xcd_barrier(xb);
    for (int item = blockIdx.x; item < NITEM_H; item += gridDim.x) hgrn_b1(p, item, lds, tid, lane, wave);
    s5_b(p, gw, NGW, lane);
    xcd_barrier(xb);
    hgrn_b2(p, gtid, GT);
    s5_c(p, gtid);
    xcd_barrier(xb);
    for (int item = blockIdx.x; item < NITEM_H; item += gridDim.x) hgrn_b3(p, item, lds, tid, lane, wave);
    s5_d(p, gw, NGW, lane);
    xcd_barrier(xb);
    { EpiGlu E; E.YG = p.YG; E.CAT = p.CAT; run_gemm(lds, p.YG, p.Wglu, 512, 512, E); }
    xcd_barrier(xb);
    { EpiRes E; E.XB = p.XB; E.SSQ = p.SSQ; run_gemm(lds, p.CAT, p.Wo0, 1024, 1024, E); }
    xcd_barrier(xb);
    { EpiUp E; E.SSQ = p.SSQ; E.H = p.H; run_gemm(lds, p.XB, p.Wup0, 4096, 1024, E); }
    xcd_barrier(xb);
    { EpiRes E; E.XB = p.XB; E.SSQ = p.SSQ; run_gemm_split(lds, p.H, p.Wdn0, 1024, 4096, E, (float*)p.CAT); xcd_barrier(xb); gemm_fixup(1024, 4096, E, (const float*)p.CAT, tid); }
    xcd_barrier(xb);
    cache_convert(p, gtid, GT);
    { EpiQkv E; E.SSQ = p.SSQ; E.out = p.out; E.Q = p.Q; E.KP = p.KP; E.KS = p.KS; E.VTP = p.VTP; E.VTS = p.VTS; run_gemm(lds, p.XB, p.Wqkv, 3072, 1024, E); }
    xcd_barrier(xb);
    attn_phase(p, gw, NGW, lane);
    xcd_barrier(xb);
    { EpiRes E; E.XB = p.XB; E.SSQ = p.SSQ; run_gemm(lds, p.O, p.Wo1, 1024, 1024, E); }
    xcd_barrier(xb);
    { EpiUp E; E.SSQ = p.SSQ; E.H = p.H; run_gemm(lds, p.XB, p.Wup1, 4096, 1024, E); }
    xcd_barrier(xb);
    { EpiFin E; E.XB = p.XB; E.SSQ = p.SSQ; E.out = p.out; run_gemm_split(lds, p.H, p.Wdn1, 1024, 4096, E, (float*)p.CAT); xcd_barrier(xb); gemm_fixup(1024, 4096, E, (const float*)p.CAT, tid); }
    xcd_barrier(xb);
    final_norm(p, gw, NGW, lane);
}

extern "C" void kernel_launch(void* const* d_in, const int* in_sizes, int n_in, void* d_out, int out_size, void* d_ws, size_t ws_size, hipStream_t stream) {
    static int grid_blocks = 0;
    if (grid_blocks == 0) {
        int dev = 0, cus = 0, per_cu = 0;
        hipGetDevice(&dev); hipDeviceGetAttribute(&cus, hipDeviceAttributeMultiprocessorCount, dev);
        if (hipFuncSetAttribute((const void*)fwd_megakernel, hipFuncAttributeMaxDynamicSharedMemorySize, LDS_BYTES) != hipSuccess) fprintf(stderr, "kernel_launch: hipFuncSetAttribute failed\n");
        if (hipOccupancyMaxActiveBlocksPerMultiprocessor(&per_cu, (const void*)fwd_megakernel, 512, LDS_BYTES) != hipSuccess || per_cu < 1) { fprintf(stderr, "kernel_launch: occupancy query says %d\n", per_cu); per_cu = 1; }
        (void)hipGetLastError();
        grid_blocks = cus > 0 ? cus : 256;
    }
    Prm p{};
    const float* const* in = (const float* const*)d_in;
    p.x_prompt = in[0]; p.x_sample = in[1]; p.state_hgrn = in[2]; p.ssm_re0 = in[3]; p.ssm_im0 = in[4]; p.cache_k = in[5]; p.cache_v = in[6]; p.meta = in[7]; p.ln_mix = in[8]; p.ln_mlp = in[9];
    p.ln_final = in[10]; p.w_in_even = in[11]; p.hgrn_lb = in[12]; p.hgrn_norm = in[13]; p.a_re = in[14]; p.a_im = in[15]; p.log_dt = in[16]; p.b_re = in[17]; p.b_im = in[18]; p.c_re = in[19];
    p.c_im = in[20]; p.ssm_d = in[21]; p.w_glu = in[22]; p.w_out_even = in[23]; p.w_in_odd = in[24]; p.w_out_odd = in[25]; p.w_up = in[26]; p.w_down = in[27];
    p.out = (float*)d_out;
    unsigned char* ws = (unsigned char*)d_ws; size_t off = 0;
    auto take = [&](size_t bytes) { unsigned char* r = ws + off; off += (bytes + 255) & ~(size_t)255; return r; };
    p.Wt1 = (bf16_t*)take((size_t)2560 * 1024 * 2); p.Wglu = (bf16_t*)take((size_t)512 * 512 * 2); p.Wo0 = (bf16_t*)take((size_t)1024 * 1024 * 2); p.Wup0 = (bf16_t*)take((size_t)4096 * 1024 * 2);
    p.Wdn0 = (bf16_t*)take((size_t)4096 * 1024 * 2); p.Wqkv = (bf16_t*)take((size_t)3072 * 1024 * 2); p.Wo1 = (bf16_t*)take((size_t)1024 * 1024 * 2); p.Wup1 = (bf16_t*)take((size_t)4096 * 1024 * 2);
    p.Wdn1 = (bf16_t*)take((size_t)4096 * 1024 * 2);
    p.XB = (bf16_t*)take((size_t)MP * 1024 * 2); p.SSQ = (float*)take((size_t)MP * 16 * 4); p.LB = (float*)take(2048); p.KTAB = (float*)take((size_t)32 * 16 * 256 * 4);
    p.TG = (bf16_t*)take((size_t)32 * 256 * 384 * 2); p.HT = (bf16_t*)take((size_t)32 * 128 * 256 * 2); p.A16 = (float*)take(32 * 64 * 2 * 4); p.BAR = (unsigned*)take(XCD_BAR_WORDS * 4);
    const size_t S0 = off; constexpr size_t SZ512 = (size_t)MP * 512 * 2;
    p.Qh = (bf16_t*)take(SZ512); p.LOGF = (unsigned short*)take(SZ512); p.IV = (bf16_t*)take(SZ512); p.GS = (bf16_t*)take(SZ512); p.U = (bf16_t*)take(SZ512);
    p.UT = (bf16_t*)take((size_t)NITEM_H * 16384 * 2); p.AL = (float*)take((size_t)NITEM_H * 128 * 4);
    p.XLOC = (float*)take(SZ512); p.YG = (bf16_t*)p.XLOC;
    p.XPREV = (bf16_t*)take((size_t)NCOL * 4096 * 2); p.CAT = (bf16_t*)take((size_t)MP * 1024 * 2);
    size_t end = off;
    off = S0; p.H = (bf16_t*)take((size_t)MP * 4096 * 2); if (off > end) end = off;
    off = S0; p.Q = (bf16_t*)take((size_t)MP * 1024 * 2); p.KP = (bf16_t*)take((size_t)64 * 129 * 4096 * 2); p.KS = (bf16_t*)take((size_t)64 * 34 * 4096 * 2);
    p.VTP = (bf16_t*)take((size_t)64 * 129 * 4096 * 2); p.VTS = (bf16_t*)take((size_t)64 * 34 * 4096 * 2); p.O = (bf16_t*)take((size_t)MP * 1024 * 2); if (off > end) end = off;
    if (end > ws_size || n_in != 28 || (size_t)out_size != O_END) { fprintf(stderr, "kernel_launch: workspace/shape mismatch: need %zu have %zu, n_in %d, out %d\n", end, ws_size, n_in, out_size); return; }
    (void)hipMemsetAsync(p.BAR, 0, XCD_BAR_WORDS * 4, stream);
    void* args[] = {&p};
    hipError_t e = hipLaunchCooperativeKernel((const void*)fwd_megakernel, dim3(grid_blocks), dim3(512), args, LDS_BYTES, stream);
    if (e != hipSuccess) fprintf(stderr, "cooperative launch failed: %s (grid %d)\n", hipGetErrorString(e), grid_blocks);
}
```

```cpp
#include <hip/hip_runtime.h>
#include <hip/hip_cooperative_groups.h>
#include <cstdio>
#include <cstdint>
namespace cg = cooperative_groups;
namespace pg8 {
#define PG8_LAS __attribute__((address_space(3)))
typedef unsigned short bf16_t;
typedef short bf16x8 __attribute__((ext_vector_type(8)));
typedef float f32x4 __attribute__((ext_vector_type(4)));
typedef unsigned u32x4 __attribute__((ext_vector_type(4)));
constexpr int BM = 256, BK = 64, HALF = 128, HTB = HALF * BK * 2  , STAGE_BYTES = 8 * HTB, NXCD = 8, WGM = 8;

__host__ __device__ __forceinline__ int lds_byte(int r, int c) { const int st = (r >> 4) * 2 + (c >> 5), rr = r & 15, cc = c & 31, ob = rr * 64 + cc * 2; return st * 1024 + (ob ^ (((ob >> 9) & 1) << 5)); }
__host__ __device__ __forceinline__ void stage_rc(int b, int& R, int& C) { const int st = b / 1024, sb = b % 1024, swz = sb ^ (((sb >> 9) & 1) << 5); R = (st >> 1) * 16 + swz / 64; C = (st & 1) * 32 + (swz % 64) / 2; }
__host__ __device__ __forceinline__ int perm32(int rho) { const int n = rho >> 4, i = rho & 15; return 8 * (i >> 2) + 4 * n + (i & 3); }

struct Unit { int pm, pn, kb, nk, part; };
struct Gemm { const bf16_t* A; const bf16_t* Bt; int M, N, K; float* part; };

struct StaticOrder {
    int nM, nN, nwg, G, c;
    __host__ __device__ void init(int M, int N, int G_, int c_) { nM = M / BM; nN = N / BM; nwg = nM * nN; G = G_; c = c_; }
    __host__ __device__ void map(int L, Unit& u) const {
        int wgid = L; { const int q = nwg / NXCD, r = nwg % NXCD, xcd = wgid % NXCD, off = wgid / NXCD; wgid = (xcd < r ? xcd * (q + 1) : r * (q + 1) + (xcd - r) * q) + off; }
        const int nig = WGM * nN, gid = wgid / nig, fm = gid * WGM, gsz = (nM - fm) < WGM ? (nM - fm) : WGM;
        u.pm = fm + ((wgid % nig) % gsz); u.pn = (wgid % nig) / gsz; u.kb = 0; u.nk = 0; u.part = -1;
    }
    __host__ __device__ bool next(int i, Unit& u) const {
        const long L = (long)i * G + c; if (L >= nwg) return false;
        map((int)L, u); return true;
    }
    __device__ __forceinline__ void a_ready(const Unit&) const {}
    __device__ __forceinline__ void done(const Unit&) const {}
};
template <class Epi, class Sched>
__device__ __forceinline__ void gemm_phase(PG8_LAS unsigned char* lds, const Gemm g, const Sched& S, const Epi& E) {
    const int tid = threadIdx.x, wid = __builtin_amdgcn_readfirstlane(tid >> 6), lane = tid & 63, wr = wid >> 2, wc = wid & 3, fr = lane & 15, fq = lane >> 4;
    const int K = g.K, nt = K / BK;
    unsigned voffA[2], voffB[2];
#pragma unroll
    for (int i = 0; i < 2; ++i) { int R, C; stage_rc(tid * 16 + i * 8192, R, C); const int Rb = Epi::PERM ? ((R & ~31) + perm32(R & 31)) : R;
        voffA[i] = (unsigned)(R * K + C) * 2u; voffB[i] = (unsigned)(Rb * K + C) * 2u; }
    const size_t kstep = (size_t)(BK * 2);
    const size_t hstep = (size_t)HALF * K * 2;
    const size_t tstep = 2 * hstep;
    const unsigned ldsw = (unsigned)wid * 1024u;
    const int aoff = lds_byte(wr * 64 + fr, fq * 8), boff = lds_byte(wc * 32 + fr, fq * 8);
#define PG8_SA(b, h) (((b) * 2 + (h)) * HTB)
#define PG8_SB(b, h) ((4 + (b) * 2 + (h)) * HTB)
#define PG8_STAGE(bufoff, gbase, voff) do { _Pragma("unroll") for (int _i = 0; _i < 2; ++_i) \
        __builtin_amdgcn_global_load_lds((const unsigned*)((const char*)(gbase) + (voff)[_i]), (PG8_LAS unsigned*)(lds + (bufoff) + ldsw + _i * 8192), 16, 0, 0); } while (0)
#define PG8_LDA(dst, b, h) do { _Pragma("unroll") for (int m = 0; m < 4; ++m) _Pragma("unroll") for (int k = 0; k < 2; ++k) dst[m][k] = *(const PG8_LAS bf16x8*)(lds + PG8_SA(b, h) + aoff + m * 2048 + k * 1024); } while (0)
#define PG8_LDB(dst, b, h) do { _Pragma("unroll") for (int n = 0; n < 2; ++n) _Pragma("unroll") for (int k = 0; k < 2; ++k) dst[n][k] = *(const PG8_LAS bf16x8*)(lds + PG8_SB(b, h) + boff + n * 2048 + k * 1024); } while (0)
#define PG8_MMA(ai, bj, At, Bt) do { __builtin_amdgcn_s_setprio(1); _Pragma("unroll") for (int m = 0; m < 4; ++m) _Pragma("unroll") for (int n = 0; n < 2; ++n) _Pragma("unroll") for (int k = 0; k < 2; ++k) \
        acc[ai][bj][m][n] = __builtin_amdgcn_mfma_f32_16x16x32_bf16(Bt[n][k], At[m][k], acc[ai][bj][m][n], 0, 0, 0); __builtin_amdgcn_s_setprio(0); } while (0)
#define PG8_WAIT_V(n) asm volatile("s_waitcnt vmcnt(" #n ")" ::: "memory")
#define PG8_WAIT_L(n) asm volatile("s_waitcnt lgkmcnt(" #n ")" ::: "memory")
#define PG8_BAR __builtin_amdgcn_s_barrier()
#define PG8_SCHED __builtin_amdgcn_sched_barrier(0)
    Unit cur, nxt; int ui = 0;
    if (!S.next(0, cur)) return;
    f32x4 acc[2][2][4][2];
#pragma unroll
    for (int a = 0; a < 2; ++a)
#pragma unroll
        for (int b = 0; b < 2; ++b)
#pragma unroll
            for (int m = 0; m < 4; ++m)
#pragma unroll
                for (int n = 0; n < 2; ++n) acc[a][b][m][n] = (f32x4){0.f, 0.f, 0.f, 0.f};
    bf16x8 At[4][2], B0[2][2], B1[2][2];
    const char* cA = (const char*)g.A + (size_t)cur.pm * tstep + (size_t)cur.kb * kstep; const char* cB = (const char*)g.Bt + (size_t)cur.pn * tstep + (size_t)cur.kb * kstep;
    S.a_ready(cur);
    PG8_STAGE(PG8_SB(0, 0), cB, voffB); PG8_STAGE(PG8_SA(0, 0), cA, voffA); PG8_STAGE(PG8_SB(0, 1), cB + hstep, voffB); PG8_STAGE(PG8_SA(0, 1), cA + hstep, voffA);
    if (wr == 1) PG8_BAR;
    PG8_WAIT_V(4); PG8_BAR;
    PG8_STAGE(PG8_SB(1, 0), cB + kstep, voffB); PG8_STAGE(PG8_SA(1, 0), cA + kstep, voffA); PG8_STAGE(PG8_SB(1, 1), cB + hstep + kstep, voffB);
    PG8_WAIT_V(6); PG8_BAR;
    for (;;) {
        const bool has_next = S.next(ui + 1, nxt);
        const char* nA = has_next ? (const char*)g.A + (size_t)nxt.pm * tstep + (size_t)nxt.kb * kstep : cA; const char* nB = has_next ? (const char*)g.Bt + (size_t)nxt.pn * tstep + (size_t)nxt.kb * kstep : cB;
        const int cnk = cur.nk ? cur.nk : nt;
        for (int t = 0; t < cnk; t += 2) {
            const bool last = (t == cnk - 2);
            const char* a1 = cA + (size_t)(t + 1) * kstep;
            const char* a2 = last ? nA : cA + (size_t)(t + 2) * kstep; const char* b2 = last ? nB : cB + (size_t)(t + 2) * kstep;
            const char* a3 = a2 + kstep; const char* b3 = b2 + kstep;
            if (last && has_next) S.a_ready(nxt);
            PG8_LDB(B0, 0, 0); PG8_SCHED; PG8_LDA(At, 0, 0); PG8_STAGE(PG8_SA(1, 1), a1 + hstep, voffA);
            PG8_WAIT_L(8); PG8_BAR; PG8_WAIT_L(0); PG8_MMA(0, 0, At, B0); PG8_BAR; PG8_SCHED;
            PG8_LDB(B1, 0, 1); PG8_STAGE(PG8_SB(0, 0), b2, voffB);
            PG8_BAR; PG8_WAIT_L(0); PG8_MMA(0, 1, At, B1); PG8_BAR;
            PG8_LDA(At, 0, 1); PG8_STAGE(PG8_SA(0, 0), a2, voffA);
            PG8_BAR; PG8_WAIT_L(0); PG8_MMA(1, 0, At, B0); PG8_BAR; PG8_SCHED;
            PG8_STAGE(PG8_SB(0, 1), b2 + hstep, voffB);
            PG8_WAIT_V(6); PG8_BAR; PG8_MMA(1, 1, At, B1); PG8_BAR;
            PG8_LDB(B0, 1, 0); PG8_SCHED; PG8_LDA(At, 1, 0); PG8_STAGE(PG8_SA(0, 1), a2 + hstep, voffA);
            PG8_WAIT_L(8); PG8_BAR; PG8_WAIT_L(0); PG8_MMA(0, 0, At, B0); PG8_BAR; PG8_SCHED;
            PG8_LDB(B1, 1, 1); PG8_STAGE(PG8_SB(1, 0), b3, voffB);
            PG8_BAR; PG8_WAIT_L(0); PG8_MMA(0, 1, At, B1); PG8_BAR;
            PG8_LDA(At, 1, 1); PG8_STAGE(PG8_SA(1, 0), a3, voffA);
            PG8_BAR; PG8_WAIT_L(0); PG8_MMA(1, 0, At, B0); PG8_BAR; PG8_SCHED;
            PG8_STAGE(PG8_SB(1, 1), b3 + hstep, voffB);
            PG8_WAIT_V(6); PG8_BAR; PG8_MMA(1, 1, At, B1); PG8_BAR;
        }
        if constexpr (!Epi::AFTER_DRAIN) {
            if (cur.part < 0) E(acc, cur, wr, wc, fr, fq);
            else { f32x4* pp = (f32x4*)g.part + (size_t)cur.part * 32 * 512 + tid;
#pragma unroll
                for (int a = 0; a < 2; ++a)
#pragma unroll
                    for (int b = 0; b < 2; ++b)
#pragma unroll
                        for (int m = 0; m < 4; ++m)
#pragma unroll
                            for (int n = 0; n < 2; ++n) pp[(size_t)(((a * 2 + b) * 4 + m) * 2 + n) * 512] = acc[a][b][m][n]; }
            S.done(cur); }
        if (!has_next) break;
#pragma unroll
        for (int a = 0; a < 2; ++a)
#pragma unroll
            for (int b = 0; b < 2; ++b)
#pragma unroll
                for (int m = 0; m < 4; ++m)
#pragma unroll
                    for (int n = 0; n < 2; ++n) acc[a][b][m][n] = (f32x4){0.f, 0.f, 0.f, 0.f};
        cur = nxt; cA = nA; cB = nB; ++ui;
    }
    PG8_WAIT_V(0);
    if (wr == 0) PG8_BAR;
    PG8_BAR;
    if constexpr (Epi::AFTER_DRAIN) { E.fused(acc, cur, wr, wc, fr, fq, lds, wid, lane); S.done(cur); }
#undef PG8_SA
#undef PG8_SB
#undef PG8_STAGE
#undef PG8_LDA
#undef PG8_LDB
#undef PG8_MMA
#undef PG8_WAIT_V
#undef PG8_WAIT_L
#undef PG8_BAR
#undef PG8_SCHED
}
}
using pg8::bf16_t; using pg8::bf16x8; using pg8::f32x4; using pg8::Unit;
typedef float f32x16 __attribute__((ext_vector_type(16)));
typedef float f32x2v __attribute__((ext_vector_type(2)));
typedef unsigned u32x2 __attribute__((ext_vector_type(2)));
typedef unsigned u32x4v __attribute__((ext_vector_type(4)));
#define LAS __attribute__((address_space(3)))
#define DI __device__ __forceinline__

constexpr int DM = 1024, TP = 4112, NTP = 8 * TP  , NTS = 512, NT = NTP + NTS  , MP = 33536  ;
constexpr int NITEM_H = 2112;
constexpr int NCOL = NT / 16;
constexpr float EPSN = 1e-6f;
constexpr size_t O_YP = 0, O_YS = O_YP + (size_t)8 * 4096 * 1024, O_HGP = O_YS + 524288, O_HGS = O_HGP + 524288, O_SRP = O_HGS + 524288, O_SIP = O_SRP + 16384,
                 O_SRS = O_SIP + 16384, O_SIS = O_SRS + 16384, O_KP = O_SIS + 16384, O_VP = O_KP + (size_t)NTP * 1024, O_KS = O_VP + (size_t)NTP * 1024, O_VS = O_KS + 524288, O_END = O_VS + 524288;

struct Prm {
    const float *x_prompt, *x_sample, *state_hgrn, *ssm_re0, *ssm_im0, *cache_k, *cache_v, *meta, *ln_mix, *ln_mlp, *ln_final, *w_in_even, *hgrn_lb, *hgrn_norm,
        *a_re, *a_im, *log_dt, *b_re, *b_im, *c_re, *c_im, *ssm_d, *w_glu, *w_out_even, *w_in_odd, *w_out_odd, *w_up, *w_down;
    float* out;
    bf16_t *Wt1, *Wglu, *Wo0, *Wup0, *Wdn0, *Wqkv, *Wo1, *Wup1, *Wdn1;
    bf16_t* XB; float* SSQ; float* LB; float* KTAB; bf16_t* TG; bf16_t* HT; float* A16;
    bf16_t *Qh, *IV, *GS, *U; unsigned short* LOGF; bf16_t* UT; float* AL; float* XLOC; bf16_t* XPREV; bf16_t* YG; bf16_t* CAT;
    bf16_t* H;
    bf16_t *Q, *KP, *KS, *VTP, *VTS, *O; unsigned* BAR;
};

DI unsigned pk2(float lo, float hi) { unsigned r; asm volatile("v_cvt_pk_bf16_f32 %0, %1, %2" : "=v"(r) : "v"(lo), "v"(hi)); return r; }
DI float bflo(unsigned u) { return __uint_as_float(u << 16); }
DI float bfhi(unsigned u) { return __uint_as_float(u & 0xffff0000u); }
DI float bf2f(unsigned short b) { return __uint_as_float(((unsigned)b) << 16); }
DI unsigned short f2bf(float f) { return (unsigned short)(pk2(f, 0.f) & 0xffffu); }
DI unsigned pkh2(float lo, float hi) { union { _Float16 h[2]; unsigned u; } x; x.h[0] = (_Float16)lo; x.h[1] = (_Float16)hi; return x.u; }
DI float h2f(unsigned short h) { union { unsigned short s; _Float16 h; } x; x.s = h; return (float)x.h; }
DI float wave_sum(float v) {
#pragma unroll
    for (int o = 1; o < 64; o <<= 1) v += __shfl_xor(v, o);
    return v;
}
DI float fexp(float x) { return __expf(x); }
DI float sigm(float x) { return __builtin_amdgcn_rcpf(1.f + __expf(-x)); }
DI float row_rinv(const float* SSQ, int row) {
    const f32x4* s = (const f32x4*)(SSQ + (size_t)row * 16); f32x4 a = s[0] + s[1] + s[2] + s[3];
    return rsqrtf(((a.x + a.y) + (a.z + a.w)) * (1.f / 1024.f) + EPSN);
}
#define LDS_WAIT() asm volatile("s_waitcnt lgkmcnt(0)" ::: "memory")

struct EpiIn0 {
    static constexpr bool PERM = false, AFTER_DRAIN = false;
    const float* SSQ; const float* LB; bf16_t *Qh, *IV, *GS, *U; unsigned short* LOGF;
    DI void operator()(const f32x4 (&acc)[2][2][4][2], const Unit& u, int wr, int wc, int fr, int fq) const {
        const int seg = u.pn >> 1, cb = (u.pn & 1) * 256 + wc * 32 + 4 * fq, row0 = u.pm * 256 + wr * 64 + fr;
        unsigned short* dst = seg == 0 ? Qh : seg == 1 ? LOGF : seg == 2 ? IV : seg == 3 ? GS : U;
#pragma unroll
        for (int ai = 0; ai < 2; ++ai)
#pragma unroll
            for (int m = 0; m < 4; ++m) { const int row = row0 + ai * 128 + m * 16; const float r = row_rinv(SSQ, row);
#pragma unroll
                for (int bj = 0; bj < 2; ++bj)
#pragma unroll
                    for (int n = 0; n < 2; ++n) { const int cs = cb + bj * 128 + n * 16; f32x4 v = acc[ai][bj][m][n] * r; u32x2 o;
                        if (seg == 1) { const f32x4 lb = *(const f32x4*)(LB + cs); f32x4 f;
#pragma unroll
                            for (int e = 0; e < 4; ++e) f[e] = __logf(lb[e] + (1.f - lb[e]) * sigm(v[e]));
                            o.x = pkh2(f[0], f[1]); o.y = pkh2(f[2], f[3]); }
                        else { if (seg == 3) {
#pragma unroll
                                for (int e = 0; e < 4; ++e) v[e] = v[e] * sigm(v[e]); }
                            o.x = pk2(v[0], v[1]); o.y = pk2(v[2], v[3]); }
                        *(u32x2*)(dst + (size_t)row * 512 + cs) = o; } }
    }
};
struct EpiGlu {
    static constexpr bool PERM = false, AFTER_DRAIN = false;
    const bf16_t* YG; bf16_t* CAT;
    DI void operator()(const f32x4 (&acc)[2][2][4][2], const Unit& u, int wr, int wc, int fr, int fq) const {
        const int cb = u.pn * 256 + wc * 32 + 4 * fq, row0 = u.pm * 256 + wr * 64 + fr;
#pragma unroll
        for (int ai = 0; ai < 2; ++ai)
#pragma unroll
            for (int m = 0; m < 4; ++m) { const int row = row0 + ai * 128 + m * 16;
#pragma unroll
                for (int bj = 0; bj < 2; ++bj)
#pragma unroll
                    for (int n = 0; n < 2; ++n) { const int cs = cb + bj * 128 + n * 16; const f32x4 v = acc[ai][bj][m][n];
                        const u32x2 y = *(const u32x2*)(YG + (size_t)row * 512 + cs); u32x2 o;
                        o.x = pk2(bflo(y.x) * sigm(v[0]), bfhi(y.x) * sigm(v[1])); o.y = pk2(bflo(y.y) * sigm(v[2]), bfhi(y.y) * sigm(v[3]));
                        *(u32x2*)(CAT + (size_t)row * 1024 + 512 + cs) = o; } }
    }
};
struct EpiRes {
    static constexpr bool PERM = false, AFTER_DRAIN = false;
    bf16_t* XB; float* SSQ;
    DI void row(const f32x4 (&a4)[2][2], const Unit& u, int ai, int m, int wr, int wc, int fr, int fq) const {
        const int cb = u.pn * 256 + wc * 32 + 4 * fq, row = u.pm * 256 + wr * 64 + fr + ai * 128 + m * 16; float ss = 0.f;
#pragma unroll
        for (int bj = 0; bj < 2; ++bj)
#pragma unroll
            for (int n = 0; n < 2; ++n) { const int cs = cb + bj * 128 + n * 16; const f32x4 v = a4[bj][n];
                u32x2* px = (u32x2*)(XB + (size_t)row * 1024 + cs); const u32x2 x = *px; u32x2 o;
                o.x = pk2(bflo(x.x) + v[0], bfhi(x.x) + v[1]); o.y = pk2(bflo(x.y) + v[2], bfhi(x.y) + v[3]); *px = o;
                const float a0 = bflo(o.x), a1 = bfhi(o.x), a2 = bflo(o.y), a3 = bfhi(o.y); ss += (a0 * a0 + a1 * a1) + (a2 * a2 + a3 * a3); }
        ss += __shfl_xor(ss, 16); ss += __shfl_xor(ss, 32);
        if (fq == 0) SSQ[(size_t)row * 16 + u.pn * 4 + wc] = ss;
    }
    DI void operator()(const f32x4 (&acc)[2][2][4][2], const Unit& u, int wr, int wc, int fr, int fq) const {
#pragma unroll
        for (int ai = 0; ai < 2; ++ai)
#pragma unroll
            for (int m = 0; m < 4; ++m) { const f32x4 a4[2][2] = {{acc[ai][0][m][0], acc[ai][0][m][1]}, {acc[ai][1][m][0], acc[ai][1][m][1]}}; row(a4, u, ai, m, wr, wc, fr, fq); }
    }
};
struct EpiUp {
    static constexpr bool PERM = false, AFTER_DRAIN = false;
    const float* SSQ; bf16_t* H;
    DI void operator()(const f32x4 (&acc)[2][2][4][2], const Unit& u, int wr, int wc, int fr, int fq) const {
        const int cb = u.pn * 256 + wc * 32 + 4 * fq, row0 = u.pm * 256 + wr * 64 + fr;
#pragma unroll
        for (int ai = 0; ai < 2; ++ai)
#pragma unroll
            for (int m = 0; m < 4; ++m) { const int row = row0 + ai * 128 + m * 16; const float r = row_rinv(SSQ, row);
#pragma unroll
                for (int bj = 0; bj < 2; ++bj)
#pragma unroll
                    for (int n = 0; n < 2; ++n) { const int cs = cb + bj * 128 + n * 16; f32x4 v = acc[ai][bj][m][n] * r;
#pragma unroll
                        for (int e = 0; e < 4; ++e) { const float t = fmaxf(v[e], 0.f); v[e] = t * t; }
                        u32x2 o; o.x = pk2(v[0], v[1]); o.y = pk2(v[2], v[3]); *(u32x2*)(H + (size_t)row * 4096 + cs) = o; } }
    }
};
DI size_t kf_index(int seqh, int nkt, int key, int d) { return ((((size_t)seqh * nkt + (key >> 5)) * 8 + (d >> 4)) * 64 + ((key & 31) + 32 * ((d >> 3) & 1))) * 8 + (d & 7); }
DI size_t vf_index(int seqh, int nkt, int key, int d) { const int kk = key & 31;
    return ((((size_t)seqh * nkt + (key >> 5)) * 8 + (kk >> 4) * 4 + (d >> 5)) * 64 + ((d & 31) + 32 * ((kk >> 2) & 1))) * 8 + ((kk >> 3) & 1) * 4 + (kk & 3); }
struct EpiQkv {
    static constexpr bool PERM = false, AFTER_DRAIN = false;
    const float* SSQ; float* out; bf16_t *Q, *KP, *KS, *VTP, *VTS;
    DI void operator()(const f32x4 (&acc)[2][2][4][2], const Unit& u, int wr, int wc, int fr, int fq) const {
        const int third = u.pn >> 2, cb = (u.pn & 3) * 256 + wc * 32 + 4 * fq, row0 = u.pm * 256 + wr * 64 + fr;
#pragma unroll
        for (int ai = 0; ai < 2; ++ai)
#pragma unroll
            for (int m = 0; m < 4; ++m) { const int row = row0 + ai * 128 + m * 16; const float r = row_rinv(SSQ, row);
                const bool smp = row >= NTP; const int s = row - NTP; const int b = smp ? (s >> 6) : row / TP, key = smp ? 1024 + (s & 63) : row - b * TP, nkt = smp ? 34 : 129;
#pragma unroll
                for (int bj = 0; bj < 2; ++bj)
#pragma unroll
                    for (int n = 0; n < 2; ++n) { const int cs = cb + bj * 128 + n * 16; const f32x4 v = acc[ai][bj][m][n] * r;
                        u32x2 o; o.x = pk2(v[0], v[1]); o.y = pk2(v[2], v[3]);
                        if (third == 0) { *(u32x2*)(Q + (size_t)row * 1024 + cs) = o; }
                        else if (row < NT) { const int h = cs >> 7, d = cs & 127;
                            if (third == 1) { *(f32x4*)(out + (smp ? O_KS + (size_t)s * 1024 : O_KP + (size_t)row * 1024) + cs) = v;
                                *(u32x2*)((smp ? KS : KP) + kf_index(b * 8 + h, nkt, key, d)) = o; }
                            else { *(f32x4*)(out + (smp ? O_VS + (size_t)s * 1024 : O_VP + (size_t)row * 1024) + cs) = v;
                                bf16_t* vt = (smp ? VTS : VTP) + vf_index(b * 8 + h, nkt, key, d);
                                vt[0] = (bf16_t)(o.x & 0xffffu); vt[8] = (bf16_t)(o.x >> 16); vt[16] = (bf16_t)(o.y & 0xffffu); vt[24] = (bf16_t)(o.y >> 16); } } } }
    }
};
struct EpiFin {
    static constexpr bool PERM = false, AFTER_DRAIN = false;
    const bf16_t* XB; float* SSQ; float* out;
    DI void row(const f32x4 (&a4)[2][2], const Unit& u, int ai, int m, int wr, int wc, int fr, int fq) const {
        const int cb = u.pn * 256 + wc * 32 + 4 * fq, row = u.pm * 256 + wr * 64 + fr + ai * 128 + m * 16; float ss = 0.f;
        const int b = row / TP, t = row - b * TP; const bool ok = row < NT && (row >= NTP || t >= 16);
        float* dst = out + (row >= NTP ? O_YS + (size_t)(row - NTP) * 1024 : O_YP + ((size_t)b * 4096 + (t - 16)) * 1024);
#pragma unroll
        for (int bj = 0; bj < 2; ++bj)
#pragma unroll
            for (int n = 0; n < 2; ++n) { const int cs = cb + bj * 128 + n * 16; f32x4 v = a4[bj][n];
                const u32x2 x = *(const u32x2*)(XB + (size_t)row * 1024 + cs);
                v[0] += bflo(x.x); v[1] += bfhi(x.x); v[2] += bflo(x.y); v[3] += bfhi(x.y);
                if (ok) *(f32x4*)(dst + cs) = v;
                ss += (v[0] * v[0] + v[1] * v[1]) + (v[2] * v[2] + v[3] * v[3]); }
        ss += __shfl_xor(ss, 16); ss += __shfl_xor(ss, 32);
        if (fq == 0) SSQ[(size_t)row * 16 + u.pn * 4 + wc] = ss;
    }
    DI void operator()(const f32x4 (&acc)[2][2][4][2], const Unit& u, int wr, int wc, int fr, int fq) const {
#pragma unroll
        for (int ai = 0; ai < 2; ++ai)
#pragma unroll
            for (int m = 0; m < 4; ++m) { const f32x4 a4[2][2] = {{acc[ai][0][m][0], acc[ai][0][m][1]}, {acc[ai][1][m][0], acc[ai][1][m][1]}}; row(a4, u, ai, m, wr, wc, fr, fq); }
    }
};
template <class Epi> DI void run_gemm(LAS unsigned char* lds, const bf16_t* A, const bf16_t* Bt, int N, int K, const Epi& E) {
    pg8::Gemm g; g.A = A; g.Bt = Bt; g.M = MP; g.N = N; g.K = K; g.part = nullptr;
    pg8::StaticOrder S; S.init(MP, N, (int)gridDim.x, (int)blockIdx.x);
    pg8::gemm_phase<Epi, pg8::StaticOrder>(lds, g, S, E);
}
struct SplitOrder : pg8::StaticOrder {
    int nwhole, ntail, S, nks;
    DI void init2(int N, int K) { init(MP, N, (int)gridDim.x, (int)blockIdx.x); nwhole = nwg / G; ntail = nwg - nwhole * G; S = 0; nks = 0;
        if (ntail > 0) { int s = G / ntail; const int nkt = K / 64; while (s > 1 && (nkt % s != 0 || (nkt / s) < 4 || ((nkt / s) & 1))) --s; if (s > 1) { S = s; nks = nkt / s; } } }
    DI bool next(int i, Unit& u) const {
        if (S == 0) return pg8::StaticOrder::next(i, u);
        if (i < nwhole) { map(i * G + c, u); return true; }
        if (i == nwhole && c < ntail * S) { map(nwhole * G + c / S, u); u.kb = (c % S) * nks; u.nk = nks; u.part = c; return true; }
        return false;
    }
};
template <class Epi> DI void run_gemm_split(LAS unsigned char* lds, const bf16_t* A, const bf16_t* Bt, int N, int K, const Epi& E, float* part) {
    pg8::Gemm g; g.A = A; g.Bt = Bt; g.M = MP; g.N = N; g.K = K; g.part = part;
    SplitOrder S; S.init2(N, K);
    pg8::gemm_phase<Epi, SplitOrder>(lds, g, S, E);
}
template <class Epi> DI void gemm_fixup(int N, int K, const Epi& E, const float* part, int tid) {
    SplitOrder S; S.init2(N, K); if (S.S == 0) return;
    const int wid = tid >> 6, lane = tid & 63, wr = wid >> 2, wc = wid & 3, fr = lane & 15, fq = lane >> 4;
    for (int it = blockIdx.x; it < S.ntail * 8; it += gridDim.x) { const int j = it >> 3, ai = (it >> 2) & 1, m = it & 3; Unit u; S.map(S.nwhole * S.G + j, u);
        f32x4 a4[2][2];
#pragma unroll
        for (int b = 0; b < 2; ++b)
#pragma unroll
            for (int n = 0; n < 2; ++n) { const f32x4* pp = (const f32x4*)part + ((size_t)(j * S.S) * 32 + (((ai * 2 + b) * 4 + m) * 2 + n)) * 512 + tid;
                f32x4 v0 = {0.f, 0.f, 0.f, 0.f}, v1 = v0, v2 = v0, v3 = v0;
                for (int sl = 0; sl + 3 < S.S; sl += 4) { v0 += pp[(size_t)sl * 16384]; v1 += pp[(size_t)(sl + 1) * 16384]; v2 += pp[(size_t)(sl + 2) * 16384]; v3 += pp[(size_t)(sl + 3) * 16384]; }
                for (int sl = S.S & ~3; sl < S.S; ++sl) v0 += pp[(size_t)sl * 16384];
                a4[b][n] = (v0 + v1) + (v2 + v3); }
        E.row(a4, u, ai, m, wr, wc, fr, fq); }
}
DI void transpose_item(const float* W, int N, bf16_t* WT, size_t ldo, const float* sc, LAS float* scr, int item, int lane) {
    const int nblk = N / 32, kb = item / nblk, nb = item % nblk, k0 = 64 * kb, n0 = 32 * nb;
#pragma unroll 8
    for (int i = 0; i < 32; ++i) { const int kk = 2 * i + (lane >> 5); float w = W[(size_t)(k0 + kk) * N + n0 + (lane & 31)]; if (sc) w *= sc[k0 + kk]; scr[kk * 33 + (lane & 31)] = w; }
    LDS_WAIT();
    const int c = lane & 7;
#pragma unroll
    for (int j = 0; j < 4; ++j) { const int n = (lane >> 3) + 8 * j; const LAS float* s = scr + (8 * c) * 33 + n;
        u32x4v o; o.x = pk2(s[0 * 33], s[1 * 33]); o.y = pk2(s[2 * 33], s[3 * 33]); o.z = pk2(s[4 * 33], s[5 * 33]); o.w = pk2(s[6 * 33], s[7 * 33]);
        *(u32x4v*)(WT + (size_t)(n0 + n) * ldo + k0 + 8 * c) = o; }
    LDS_WAIT();
}
DI void s5_pow(const Prm& p, int g, int n, float k, float& re, float& im) {
    const float dt = __expf(p.log_dt[g]), ar = p.a_re[g * 64 + n], ai = p.a_im[g * 64 + n];
    const float mag = __expf(k * dt * ar); float rev = k * dt * ai * 0.15915494309189535f; rev -= rintf(rev);
    re = mag * __builtin_amdgcn_cosf(rev); im = mag * __builtin_amdgcn_sinf(rev);
}
DI void s5_bbar(const Prm& p, int g, int n, int pp, float& re, float& im) {
    const float ar = p.a_re[g * 64 + n], ai = p.a_im[g * 64 + n]; float abr, abi; s5_pow(p, g, n, 1.f, abr, abi);
    const float den = ar * ar + ai * ai, zr = ((abr - 1.f) * ar + abi * ai) / den, zi = (abi * ar - (abr - 1.f) * ai) / den;
    const float br = p.b_re[(g * 64 + n) * 16 + pp], bi = p.b_im[(g * 64 + n) * 16 + pp];
    re = zr * br - zi * bi; im = zr * bi + zi * br;
}
DI void phase_prologue(const Prm& p, LAS unsigned char* lds, int tid, int lane, int wave) {
    const int gw = blockIdx.x * 8 + wave, NGW = gridDim.x * 8, gtid = blockIdx.x * 512 + tid, GT = gridDim.x * 512;
    LAS float* scr = (LAS float*)(lds + wave * 16384);
    constexpr int I1 = 16 * 80, I2 = 8 * 16, I3 = 16 * 32, I4 = 16 * 128, I5 = 64 * 32, I6 = 16 * 96;
    constexpr int NITEMS = I1 + I2 + I3 + I4 + I5 + I6 + I3 + I4 + I5;
    for (int it = gw; it < NITEMS; it += NGW) {
        int r = it;
        if (r < I1) { transpose_item(p.w_in_even, 2560, p.Wt1, 1024, p.ln_mix, scr, r, lane); continue; } r -= I1;
        if (r < I2) { transpose_item(p.w_glu, 512, p.Wglu, 512, nullptr, scr, r, lane); continue; } r -= I2;
        if (r < I3) { transpose_item(p.w_out_even, 1024, p.Wo0, 1024, nullptr, scr, r, lane); continue; } r -= I3;
        if (r < I4) { transpose_item(p.w_up, 4096, p.Wup0, 1024, p.ln_mlp, scr, r, lane); continue; } r -= I4;
        if (r < I5) { transpose_item(p.w_down, 1024, p.Wdn0, 4096, nullptr, scr, r, lane); continue; } r -= I5;
        if (r < I6) { transpose_item(p.w_in_odd, 3072, p.Wqkv, 1024, p.ln_mix + 1024, scr, r, lane); continue; } r -= I6;
        if (r < I3) { transpose_item(p.w_out_odd, 1024, p.Wo1, 1024, nullptr, scr, r, lane); continue; } r -= I3;
        if (r < I4) { transpose_item(p.w_up + (size_t)1024 * 4096, 4096, p.Wup1, 1024, p.ln_mlp + 1024, scr, r, lane); continue; } r -= I4;
        transpose_item(p.w_down + (size_t)4096 * 1024, 1024, p.Wdn1, 4096, nullptr, scr, r, lane);
    }
    for (int row = gw; row < NT; row += NGW) {
        const float* src;
        if (row < NTP) { const int b = row / TP, t = row - b * TP; src = t < 16 ? p.meta + (size_t)t * 1024 : p.x_prompt + ((size_t)b * 4096 + (t - 16)) * 1024; }
        else src = p.x_sample + (size_t)(row - NTP) * 1024;
        float ss = 0.f;
#pragma unroll
        for (int j = 0; j < 4; ++j) { const f32x4 v = ((const f32x4*)src)[lane + 64 * j]; u32x2 o; o.x = pk2(v.x, v.y); o.y = pk2(v.z, v.w);
            const float a0 = bflo(o.x), a1 = bfhi(o.x), a2 = bflo(o.y), a3 = bfhi(o.y); ss += (a0 * a0 + a1 * a1) + (a2 * a2 + a3 * a3);
            ((u32x2*)(p.XB + (size_t)row * 1024))[lane + 64 * j] = o; }
        ss = wave_sum(ss);
        if (lane < 16) p.SSQ[(size_t)row * 16 + lane] = lane == 0 ? ss : 0.f;
    }
    if (gtid < 512) p.LB[gtid] = 1.f / (1.f + __expf(p.hgrn_lb[512 + gtid] - p.hgrn_lb[gtid]));
    __syncthreads();
    {
        LAS float* zr_ = (LAS float*)lds; LAS float* zi_ = zr_ + 64; LAS float* wr_ = zi_ + 64; LAS float* wi_ = wr_ + 64;
        LAS float* bbr = wi_ + 64; LAS float* bbi = bbr + 1024; LAS float* cwr = bbi + 1024; LAS float* cwi = cwr + 16 * 65;
        for (int pair = blockIdx.x; pair < 512; pair += gridDim.x) { const int g = pair >> 4, tau = pair & 15;
            if (tid < 64) { const int n = tid; const float ar = p.a_re[g * 64 + n], ai = p.a_im[g * 64 + n]; float abr, abi; s5_pow(p, g, n, 1.f, abr, abi);
                const float den = ar * ar + ai * ai; zr_[n] = ((abr - 1.f) * ar + abi * ai) / den; zi_[n] = (abi * ar - (abr - 1.f) * ai) / den;
                float a, b; s5_pow(p, g, n, (float)tau, a, b); wr_[n] = a; wi_[n] = b; }
            __syncthreads();
#pragma unroll
            for (int k = 0; k < 2; ++k) { const int e = tid + 512 * k;
                { const int n = e >> 4; const float br = p.b_re[g * 1024 + e], bi = p.b_im[g * 1024 + e]; bbr[e] = zr_[n] * br - zi_[n] * bi; bbi[e] = zr_[n] * bi + zi_[n] * br; }
                { const int pch = e >> 6, n = e & 63; const float cr = p.c_re[g * 1024 + e], ci = p.c_im[g * 1024 + e]; cwr[pch * 65 + n] = cr * wr_[n] - ci * wi_[n]; cwi[pch * 65 + n] = cr * wi_[n] + ci * wr_[n]; } }
            __syncthreads();
            if (tid < 256) { const int pch = tid >> 4, pp = tid & 15; float acc = 0.f;
#pragma unroll 8
                for (int n = 0; n < 64; ++n) acc += cwr[pch * 65 + n] * bbr[n * 16 + pp] - cwi[pch * 65 + n] * bbi[n * 16 + pp];
                if (tau == 0 && pch == pp) acc += p.ssm_d[g * 16 + pch];
                const bf16_t kv = f2bf(acc);
                for (int t = tau; t < 16; ++t) p.TG[((size_t)(g * 256 + t * 16 + pch)) * 384 + (t - tau) * 16 + pp] = kv;
                if (tau > 0) for (int t = 0; t < 16 - tau; ++t) p.TG[((size_t)(g * 256 + t * 16 + pch)) * 384 + (t + tau) * 16 + pp] = 0; }
            __syncthreads(); }
    }
    for (int i = gtid; i < 32 * 256 * 64; i += GT) {
        const int g = i >> 14, t = (i >> 10) & 15, pch = (i >> 6) & 15, n = i & 63; float wr_, wi_; s5_pow(p, g, n, (float)(t + 1), wr_, wi_);
        const float cr = p.c_re[(g * 16 + pch) * 64 + n], ci = p.c_im[(g * 16 + pch) * 64 + n];
        *(unsigned*)(p.TG + ((size_t)(g * 256 + t * 16 + pch)) * 384 + 256 + 2 * n) = pk2(cr * wr_ - ci * wi_, -(cr * wi_ + ci * wr_)); }
    for (int i = gtid; i < 32 * 64 * 256; i += GT) {
        const int g = i >> 14, n = (i >> 8) & 63, s = (i >> 4) & 15, pp = i & 15; float wr_, wi_, br_, bi_; s5_pow(p, g, n, (float)(15 - s), wr_, wi_); s5_bbar(p, g, n, pp, br_, bi_);
        p.HT[((size_t)(g * 128 + 2 * n)) * 256 + s * 16 + pp] = f2bf(wr_ * br_ - wi_ * bi_);
        p.HT[((size_t)(g * 128 + 2 * n + 1)) * 256 + s * 16 + pp] = f2bf(wr_ * bi_ + wi_ * br_); }
    if (gtid < 2048) { float wr_, wi_; s5_pow(p, gtid >> 6, gtid & 63, 16.f, wr_, wi_); p.A16[2 * gtid] = wr_; p.A16[2 * gtid + 1] = wi_; }
}

constexpr int HP = 136, TPI = 72;
constexpr int L_QT = 0, L_QH = 17408, L_KT = 34816, L_KTT = 52224, L_IVT = 70656, L_ATT = 89088, L_SUM = 98304, L_VEC = 100352, L_OB = 0  ;
struct HItem { int row0, L, h, bh; };
DI HItem hgrn_item(int item) {
    HItem it;
    if (item < 2080) { const int bh = item / 65, c = item - bh * 65, b = bh >> 2; it.h = bh & 3; it.bh = bh; it.L = c == 0 ? 16 : 64; it.row0 = b * TP + (c == 0 ? 0 : 16 + 64 * (c - 1)); }
    else { const int s = item - 2080, b = s >> 2; it.h = s & 3; it.bh = 32 + s; it.L = 64; it.row0 = NTP + b * 64; }
    return it;
}
template <bool FULL> DI void hgrn_prep(const Prm& p, const HItem& it, LAS unsigned char* lds, int tid) {
    const int d = tid & 127, tq = tid >> 7, t0 = 16 * tq, col = it.h * 128 + d;
    LAS float* sums = (LAS float*)(lds + L_SUM); LAS float* vec = (LAS float*)(lds + L_VEC);
    float cs[16], lf[16];
    float run = 0.f;
#pragma unroll
    for (int j = 0; j < 16; ++j) { const int t = t0 + j; lf[j] = t < it.L ? h2f(p.LOGF[(size_t)(it.row0 + t) * 512 + col]) : 0.f; run += lf[j]; cs[j] = run; }
    sums[tq * 128 + d] = run;
    unsigned ivp[8];
#pragma unroll
    for (int j = 0; j < 8; ++j) { const int t = t0 + 2 * j;
        const unsigned lo = t < it.L ? p.IV[(size_t)(it.row0 + t) * 512 + col] : 0u, hi = t + 1 < it.L ? p.IV[(size_t)(it.row0 + t + 1) * 512 + col] : 0u; ivp[j] = lo | (hi << 16); }
    { LAS u32x4v* dst = (LAS u32x4v*)(lds + L_IVT + (d * TPI + t0) * 2); u32x4v a, b; a.x = ivp[0]; a.y = ivp[1]; a.z = ivp[2]; a.w = ivp[3]; b.x = ivp[4]; b.y = ivp[5]; b.z = ivp[6]; b.w = ivp[7]; dst[0] = a; dst[1] = b; }
    __syncthreads();
    const float s0 = sums[d], s1 = sums[128 + d], s2 = sums[256 + d], s3 = sums[384 + d];
    const float off = tq == 0 ? 0.f : tq == 1 ? s0 : tq == 2 ? s0 + s1 : s0 + s1 + s2, r = s0 + s1, bL = r + s2 + s3;
    if (tq == 0) { vec[d] = r; vec[128 + d] = bL; }
    unsigned ktp[8]; float kprev = 0.f;
#pragma unroll
    for (int j = 0; j < 16; ++j) { const int t = t0 + j; const bool valid = t < it.L; const float b = off + cs[j];
        const float kt = valid ? (1.f - __expf(lf[j])) * __expf(r - b) : 0.f;
        if (j & 1) ktp[j >> 1] = pk2(kprev, kt); else kprev = kt;
        if (FULL) { const float qv = valid ? bf2f(p.Qh[(size_t)(it.row0 + t) * 512 + col]) : 0.f;
            *(LAS unsigned short*)(lds + L_KT + (t * HP + d) * 2) = f2bf(kt);
            *(LAS unsigned short*)(lds + L_QT + (t * HP + d) * 2) = f2bf(qv * __expf(b - r));
            *(LAS unsigned short*)(lds + L_QH + (t * HP + d) * 2) = f2bf(qv * __expf(b)); } }
    if (!FULL) { LAS u32x4v* dst = (LAS u32x4v*)(lds + L_KTT + (d * TPI + t0) * 2); u32x4v a, b; a.x = ktp[0]; a.y = ktp[1]; a.z = ktp[2]; a.w = ktp[3]; b.x = ktp[4]; b.y = ktp[5]; b.z = ktp[6]; b.w = ktp[7]; dst[0] = a; dst[1] = b; }
    __syncthreads();
}
#define MFMA16(a, b, c) __builtin_amdgcn_mfma_f32_16x16x32_bf16((a), (b), (c), 0, 0, 0)
#define MFMA32(a, b, c) __builtin_amdgcn_mfma_f32_32x32x16_bf16((a), (b), (c), 0, 0, 0)
DI void hgrn_b1(const Prm& p, int item, LAS unsigned char* lds, int tid, int lane, int wave) {
    const HItem it = hgrn_item(item);
    hgrn_prep<false>(p, it, lds, tid);
    const LAS float* vec = (const LAS float*)(lds + L_VEC);
    const int fr = lane & 15, fq = lane >> 4;
    bf16x8 a[2];
#pragma unroll
    for (int ks = 0; ks < 2; ++ks) a[ks] = *(const LAS bf16x8*)(lds + L_KTT + ((16 * wave + fr) * TPI + 32 * ks + 8 * fq) * 2);
    float e2[4];
#pragma unroll
    for (int j = 0; j < 4; ++j) { const int d = 16 * wave + 4 * fq + j; e2[j] = __expf(vec[128 + d] - vec[d]); }
#pragma unroll
    for (int vt = 0; vt < 8; ++vt) { f32x4 acc = {0.f, 0.f, 0.f, 0.f};
#pragma unroll
        for (int ks = 0; ks < 2; ++ks) { const bf16x8 b = *(const LAS bf16x8*)(lds + L_IVT + ((16 * vt + fr) * TPI + 32 * ks + 8 * fq) * 2); acc = MFMA16(a[ks], b, acc); }
        u32x2 o; o.x = pk2(acc[0] * e2[0], acc[1] * e2[1]); o.y = pk2(acc[2] * e2[2], acc[3] * e2[3]);
        *(u32x2*)(p.UT + (size_t)item * 16384 + (16 * vt + fr) * 128 + 16 * wave + 4 * fq) = o; }
    if (tid < 128) p.AL[(size_t)item * 128 + tid] = __expf(vec[128 + tid]);
    __syncthreads();
}
DI void hgrn_b2(const Prm& p, int gtid, int GT) {
    for (int idx = gtid; idx < 64 * 4096; idx += GT) {
        const int bhx = idx >> 12, e = idx & 4095, v = e >> 5, d4 = (e & 31) * 4; const bool smp = bhx >= 32;
        const int item0 = smp ? 2080 + (bhx - 32) : bhx * 65, nch = smp ? 1 : 65;
        float S[4] = {0.f, 0.f, 0.f, 0.f};
        if (smp) {
#pragma unroll
            for (int j = 0; j < 4; ++j) S[j] = p.state_hgrn[((size_t)(bhx - 32) * 128 + d4 + j) * 128 + v]; }
        for (int c0 = 0; c0 < nch; c0 += 5) {
            u32x2 uu[5]; f32x4 al[5];
#pragma unroll
            for (int i = 0; i < 5; ++i) if (c0 + i < nch) { uu[i] = *(const u32x2*)(p.UT + (size_t)(item0 + c0 + i) * 16384 + v * 128 + d4); al[i] = *(const f32x4*)(p.AL + (size_t)(item0 + c0 + i) * 128 + d4); }
#pragma unroll
            for (int i = 0; i < 5; ++i) if (c0 + i < nch) { u32x2 o; o.x = pk2(S[0], S[1]); o.y = pk2(S[2], S[3]);
                *(u32x2*)(p.UT + (size_t)(item0 + c0 + i) * 16384 + v * 128 + d4) = o;
                S[0] = al[i][0] * S[0] + bflo(uu[i].x); S[1] = al[i][1] * S[1] + bfhi(uu[i].x); S[2] = al[i][2] * S[2] + bflo(uu[i].y); S[3] = al[i][3] * S[3] + bfhi(uu[i].y); } }
        float* dst = p.out + (smp ? O_HGS + (size_t)(bhx - 32) * 16384 : O_HGP + (size_t)bhx * 16384);
#pragma unroll
        for (int j = 0; j < 4; ++j) dst[(d4 + j) * 128 + v] = S[j];
    }
}
DI void hgrn_b3(const Prm& p, int item, LAS unsigned char* lds, int tid, int lane, int wave) {
    const HItem it = hgrn_item(item);
    hgrn_prep<true>(p, it, lds, tid);
    const int fr = lane & 15, fq = lane >> 4;
    {
        const int tt = wave >> 1;
#pragma unroll
        for (int i = 0; i < 2; ++i) { const int st = 2 * (wave & 1) + i; f32x4 acc = {0.f, 0.f, 0.f, 0.f};
#pragma unroll
            for (int ks = 0; ks < 4; ++ks) { const bf16x8 a = *(const LAS bf16x8*)(lds + L_KT + ((16 * st + fr) * HP + 32 * ks + 8 * fq) * 2);
                const bf16x8 b = *(const LAS bf16x8*)(lds + L_QT + ((16 * tt + fr) * HP + 32 * ks + 8 * fq) * 2); acc = MFMA16(a, b, acc); }
            const int t = 16 * tt + fr, s0 = 16 * st + 4 * fq;
            u32x2 o; o.x = pk2(s0 <= t ? acc[0] : 0.f, s0 + 1 <= t ? acc[1] : 0.f); o.y = pk2(s0 + 2 <= t ? acc[2] : 0.f, s0 + 3 <= t ? acc[3] : 0.f);
            *(LAS u32x2*)(lds + L_ATT + (t * TPI + s0) * 2) = o; }
    }
    __syncthreads();
    f32x4 oacc[4];
    {   const int tt = wave & 3;
        bf16x8 aa[2], aq[4];
#pragma unroll
        for (int ks = 0; ks < 2; ++ks) aa[ks] = *(const LAS bf16x8*)(lds + L_ATT + ((16 * tt + fr) * TPI + 32 * ks + 8 * fq) * 2);
#pragma unroll
        for (int ks = 0; ks < 4; ++ks) aq[ks] = *(const LAS bf16x8*)(lds + L_QH + ((16 * tt + fr) * HP + 32 * ks + 8 * fq) * 2);
#pragma unroll
        for (int i = 0; i < 4; ++i) { const int vt = 4 * (wave >> 2) + i; f32x4 acc = {0.f, 0.f, 0.f, 0.f};
#pragma unroll
            for (int ks = 0; ks < 2; ++ks) { const bf16x8 b = *(const LAS bf16x8*)(lds + L_IVT + ((16 * vt + fr) * TPI + 32 * ks + 8 * fq) * 2); acc = MFMA16(aa[ks], b, acc); }
#pragma unroll
            for (int ks = 0; ks < 4; ++ks) { const bf16x8 b = *(const bf16x8*)(p.UT + (size_t)item * 16384 + (16 * vt + fr) * 128 + 32 * ks + 8 * fq); acc = MFMA16(aq[ks], b, acc); }
            oacc[i] = acc; }
    }
    __syncthreads();
    {   const int tt = wave & 3; LAS float* ob = (LAS float*)(lds + L_OB);
#pragma unroll
        for (int i = 0; i < 4; ++i) { const int v = 16 * (4 * (wave >> 2) + i) + fr;
#pragma unroll
            for (int j = 0; j < 4; ++j) ob[(16 * tt + 4 * fq + j) * 132 + v] = oacc[i][j]; }
    }
    __syncthreads();
    {   const int t = tid >> 3, sg = tid & 7; const LAS float* ob = (const LAS float*)(lds + L_OB) + t * 132 + 16 * sg;
        f32x4 x[4]; float ss = 0.f;
#pragma unroll
        for (int j = 0; j < 4; ++j) { x[j] = ((const LAS f32x4*)ob)[j]; ss += (x[j].x * x[j].x + x[j].y * x[j].y) + (x[j].z * x[j].z + x[j].w * x[j].w); }
        ss += __shfl_xor(ss, 1); ss += __shfl_xor(ss, 2); ss += __shfl_xor(ss, 4);
        const float rr = rsqrtf(ss * (1.f / 128.f) + EPSN);
        if (t < it.L) { const size_t row = it.row0 + t; const int c0 = it.h * 128 + 16 * sg;
            const u32x4v g0 = *(const u32x4v*)(p.GS + row * 512 + c0), g1 = *(const u32x4v*)(p.GS + row * 512 + c0 + 8);
            const f32x4* gn = (const f32x4*)(p.hgrn_norm + 16 * sg);
            const f32x4 n0 = gn[0], n1 = gn[1], n2 = gn[2], n3 = gn[3];
            u32x4v o0, o1;
            o0.x = pk2(x[0].x * rr * n0.x * bflo(g0.x), x[0].y * rr * n0.y * bfhi(g0.x)); o0.y = pk2(x[0].z * rr * n0.z * bflo(g0.y), x[0].w * rr * n0.w * bfhi(g0.y));
            o0.z = pk2(x[1].x * rr * n1.x * bflo(g0.z), x[1].y * rr * n1.y * bfhi(g0.z)); o0.w = pk2(x[1].z * rr * n1.z * bflo(g0.w), x[1].w * rr * n1.w * bfhi(g0.w));
            o1.x = pk2(x[2].x * rr * n2.x * bflo(g1.x), x[2].y * rr * n2.y * bfhi(g1.x)); o1.y = pk2(x[2].z * rr * n2.z * bflo(g1.y), x[2].w * rr * n2.w * bfhi(g1.y));
            o1.z = pk2(x[3].x * rr * n3.x * bflo(g1.z), x[3].y * rr * n3.y * bfhi(g1.z)); o1.w = pk2(x[3].z * rr * n3.z * bflo(g1.w), x[3].w * rr * n3.w * bfhi(g1.w));
            *(u32x4v*)(p.CAT + row * 1024 + c0) = o0; *(u32x4v*)(p.CAT + row * 1024 + c0 + 8) = o1; }
    }
    __syncthreads();
}
DI void s5_load_u(const Prm& p, int mt, int g, int lane, bf16x8 (&uf)[8]) {
    const int fr = lane & 15, fq = lane >> 4; int col = 16 * mt + fr; if (col >= NCOL) col = NCOL - 1;
#pragma unroll
    for (int ks = 0; ks < 8; ++ks) uf[ks] = *(const bf16x8*)(p.U + ((size_t)(16 * col + 2 * ks + (fq >> 1))) * 512 + 16 * g + 8 * (fq & 1));
}
DI void s5_b(const Prm& p, int gw, int NGW, int lane) {
    const int fr = lane & 15, fq = lane >> 4;
    for (int task = gw; task < 131 * 32; task += NGW) { const int mt = task >> 5, g = task & 31;
        bf16x8 uf[8]; s5_load_u(p, mt, g, lane, uf);
#pragma unroll
        for (int nt = 0; nt < 8; ++nt) { f32x4 acc = {0.f, 0.f, 0.f, 0.f};
#pragma unroll
            for (int ks = 0; ks < 8; ++ks) { const bf16x8 b = *(const bf16x8*)(p.HT + ((size_t)(g * 128 + 16 * nt + fr)) * 256 + 32 * ks + 8 * fq); acc = MFMA16(uf[ks], b, acc); }
#pragma unroll
            for (int j = 0; j < 4; ++j) { const int col = 16 * mt + 4 * fq + j; if (col < NCOL) p.XLOC[(size_t)col * 4096 + g * 128 + 16 * nt + fr] = acc[j]; } }
    }
}
DI void s5_c(const Prm& p, int gtid) {
    if (gtid >= 16 * 2048) return;
    const int seq = gtid >> 11, g = (gtid >> 6) & 31, n = gtid & 63; const bool smp = seq >= 8; const int b = seq & 7;
    const int col0 = smp ? 2056 + 4 * b : 257 * b, nch = smp ? 4 : 257;
    float xr = 0.f, xi = 0.f; if (smp) { xr = p.ssm_re0[(b * 32 + g) * 64 + n]; xi = p.ssm_im0[(b * 32 + g) * 64 + n]; }
    const float ar = p.A16[2 * (g * 64 + n)], ai = p.A16[2 * (g * 64 + n) + 1];
    const size_t base = (size_t)g * 128 + 2 * n;
    for (int c0 = 0; c0 < nch; c0 += 8) {
        f32x2v xl[8];
#pragma unroll
        for (int i = 0; i < 8; ++i) if (c0 + i < nch) xl[i] = *(const f32x2v*)(p.XLOC + (size_t)(col0 + c0 + i) * 4096 + base);
#pragma unroll
        for (int i = 0; i < 8; ++i) if (c0 + i < nch) { *(unsigned*)(p.XPREV + (size_t)(col0 + c0 + i) * 4096 + base) = pk2(xr, xi);
            const float nr = ar * xr - ai * xi + xl[i].x, ni = ar * xi + ai * xr + xl[i].y; xr = nr; xi = ni; } }
    const size_t o = (size_t)(b * 32 + g) * 64 + n;
    p.out[(smp ? O_SRS : O_SRP) + o] = xr; p.out[(smp ? O_SIS : O_SIP) + o] = xi;
}
DI f32x2v gelu_pk(f32x2v v) {
    const f32x2v av = __builtin_elementwise_abs(v), d = av * 0.2316418882f + 1.0f;
    f32x2v t; t.x = __builtin_amdgcn_rcpf(d.x); t.y = __builtin_amdgcn_rcpf(d.y);
    f32x2v q = t * 0.5307027145f + (-0.7265760135f); q = q * t + 0.7107068705f; q = q * t + (-0.142248368f); q = q * t + 0.127414796f; q = q * t;
    const f32x2v s = (v * v) * (-0.72134752044f);
    f32x2v e; e.x = __builtin_amdgcn_exp2f(s.x); e.y = __builtin_amdgcn_exp2f(s.y);
    const f32x2v m = v * (q * e), r = v - m;
    f32x2v o; o.x = v.x < 0.f ? m.x : r.x; o.y = v.y < 0.f ? m.y : r.y; return o;
}
DI void s5_d(const Prm& p, int gw, int NGW, int lane) {
    const int fr = lane & 15, fq = lane >> 4;
    for (int task = gw; task < 131 * 32; task += NGW) { const int mt = task >> 5, g = task & 31;
        bf16x8 uf[8], xf[4]; s5_load_u(p, mt, g, lane, uf);
        int colc = 16 * mt + fr; if (colc >= NCOL) colc = NCOL - 1;
#pragma unroll
        for (int ks = 0; ks < 4; ++ks) xf[ks] = *(const bf16x8*)(p.XPREV + (size_t)colc * 4096 + g * 128 + 32 * ks + 8 * fq);
        const bf16_t* tg = p.TG + ((size_t)(g * 256 + fr)) * 384 + 8 * fq;
        const bool ok = 16 * mt + fr < NCOL;
#pragma unroll
        for (int t = 0; t < 16; ++t) { f32x4 acc = {0.f, 0.f, 0.f, 0.f};
#pragma unroll
            for (int ks = 0; ks < 8; ++ks) if (ks <= (t >> 1)) { const bf16x8 a = *(const bf16x8*)(tg + (size_t)t * 16 * 384 + 32 * ks); acc = MFMA16(a, uf[ks], acc); }
#pragma unroll
            for (int ks = 0; ks < 4; ++ks) { const bf16x8 a = *(const bf16x8*)(tg + (size_t)t * 16 * 384 + 256 + 32 * ks); acc = MFMA16(a, xf[ks], acc); }
            const f32x2v y0 = gelu_pk((f32x2v){acc[0], acc[1]}), y1 = gelu_pk((f32x2v){acc[2], acc[3]});
            u32x2 o; o.x = pk2(y0.x, y0.y); o.y = pk2(y1.x, y1.y);
            if (ok) *(u32x2*)(p.YG + ((size_t)(16 * (16 * mt + fr) + t)) * 512 + 16 * g + 4 * fq) = o; }
    }
}
DI void cache_convert(const Prm& p, int gtid, int GT) {
    for (size_t i = (size_t)gtid; i < (size_t)8 * 1024 * 256; i += (size_t)GT) {
        const size_t row = i >> 8; const int c4 = (int)(i & 255) * 4, b = (int)(row >> 10), pos = (int)(row & 1023), h = c4 >> 7, d = c4 & 127;
        const f32x4 k = *(const f32x4*)(p.cache_k + row * 1024 + c4); u32x2 o; o.x = pk2(k.x, k.y); o.y = pk2(k.z, k.w);
        *(u32x2*)(p.KS + kf_index(b * 8 + h, 34, pos, d)) = o;
        const f32x4 v = *(const f32x4*)(p.cache_v + row * 1024 + c4); bf16_t* vt = p.VTS + vf_index(b * 8 + h, 34, pos, d);
        vt[0] = f2bf(v.x); vt[8] = f2bf(v.y); vt[16] = f2bf(v.z); vt[24] = f2bf(v.w); }
}
DI void attn_phase(const Prm& p, int gw, int NGW, int lane) {
    const int q = lane & 31, half = lane >> 5;
    for (int it = gw; it < 8256 + 128; it += NGW) {
        bool smp; int b, h, qb;
        if (it < 8064) { smp = false; b = it / 1008; const int rem = it - b * 1008; h = rem / 126; qb = 3 + rem - h * 126; }
        else if (it < 8192) { const int s = it - 8064; smp = true; b = s >> 4; h = (s >> 1) & 7; qb = s & 1; }
        else { const int s = it - 8192; smp = false; b = s / 24; const int rem = s - b * 24; h = rem / 3; qb = rem - h * 3; }
        const size_t tbase = (size_t)(b * 8 + h) * (smp ? 34 : 129) * 4096 + lane * 8;
        const bf16_t* Kb = (smp ? p.KS : p.KP) + tbase; const bf16_t* Vb = (smp ? p.VTS : p.VTP) + tbase;
        const int qpos0 = (smp ? 1024 : 0) + 32 * qb, qrow0 = smp ? NTP + b * 64 + 32 * qb : b * TP + 32 * qb;
        const int qpos = qpos0 + q; const bool qvalid = smp || qpos < TP; const size_t qrow = qvalid ? qrow0 + q : qrow0;
        bf16x8 qf[8];
#pragma unroll
        for (int ks = 0; ks < 8; ++ks) qf[ks] = *(const bf16x8*)(p.Q + qrow * 1024 + h * 128 + 16 * ks + 8 * half);
        f32x16 o[4];
#pragma unroll
        for (int db = 0; db < 4; ++db)
#pragma unroll
            for (int e = 0; e < 16; ++e) o[db][e] = 0.f;
        float C = 1.f;
        for (int kt = (qpos0 + 30) >> 5; kt >= 0; --kt) {
            f32x16 s;
#pragma unroll
            for (int e = 0; e < 16; ++e) s[e] = 0.f;
            const bf16_t* kr = Kb + (size_t)kt * 4096; const bf16_t* vr = Vb + (size_t)kt * 4096;
            bf16x8 kf[8], vf[8];
#pragma unroll
            for (int ks = 0; ks < 8; ++ks) kf[ks] = *(const bf16x8*)(kr + ks * 512);
#pragma unroll
            for (int ks = 0; ks < 8; ++ks) vf[ks] = *(const bf16x8*)(vr + ks * 512);
#pragma unroll
            for (int ks = 0; ks < 8; ++ks) s = MFMA32(kf[ks], qf[ks], s);
            float pr[16], be[16], G[4], Gp[4];
#pragma unroll
            for (int i = 0; i < 4; ++i) {
#pragma unroll
                for (int j = 0; j < 4; ++j) { const int key = 32 * kt + 8 * i + 4 * half + j; const bool valid = key < qpos;
                    float z = s[4 * i + j] * 0.08838834764831845f; z = fminf(fmaxf(z, -80.f), 80.f);
                    const float e = __expf(z), pp = __builtin_amdgcn_rcpf(1.f + e); pr[4 * i + j] = valid ? pp : 1.f; be[4 * i + j] = valid ? e * pp : 0.f; }
                G[i] = (pr[4 * i] * pr[4 * i + 1]) * (pr[4 * i + 2] * pr[4 * i + 3]); }
#pragma unroll
            for (int i = 0; i < 4; ++i) Gp[i] = __shfl_xor(G[i], 32);
            float w[16]; float E1 = 1.f;
#pragma unroll
            for (int i = 3; i >= 0; --i) { const float Glo = half ? Gp[i] : G[i], Ghi = half ? G[i] : Gp[i];
                float suf = C * (half ? E1 : E1 * Ghi);
#pragma unroll
                for (int j = 3; j >= 0; --j) { w[4 * i + j] = be[4 * i + j] * suf; suf *= pr[4 * i + j]; }
                E1 *= Glo * Ghi; }
            C *= E1;
#pragma unroll
            for (int c = 0; c < 2; ++c) { union { bf16x8 v; unsigned u[4]; } wf;
#pragma unroll
                for (int e = 0; e < 4; ++e) wf.u[e] = pk2(w[8 * c + 2 * e], w[8 * c + 2 * e + 1]);
#pragma unroll
                for (int db = 0; db < 4; ++db) o[db] = MFMA32(vf[4 * c + db], wf.v, o[db]); }
            if (__all(C < 1e-24f)) break;
        }
        if (qvalid) {
#pragma unroll
            for (int db = 0; db < 4; ++db)
#pragma unroll
                for (int i = 0; i < 4; ++i) { u32x2 ov; ov.x = pk2(o[db][4 * i], o[db][4 * i + 1]); ov.y = pk2(o[db][4 * i + 2], o[db][4 * i + 3]);
                    *(u32x2*)(p.O + qrow * 1024 + h * 128 + 32 * db + 8 * i + 4 * half) = ov; } }
    }
}
DI void final_norm(const Prm& p, int gw, int NGW, int lane) {
    for (int r = gw; r < 32768 + 512; r += NGW) {
        int grow; float* dst;
        if (r < 32768) { const int b = r >> 12, t = r & 4095; grow = b * TP + 16 + t; dst = p.out + O_YP + (size_t)r * 1024; } else { grow = NTP + (r - 32768); dst = p.out + O_YS + (size_t)(r - 32768) * 1024; }
        const float rr = row_rinv(p.SSQ, grow);
#pragma unroll
        for (int j = 0; j < 4; ++j) { f32x4 v = ((f32x4*)dst)[lane + 64 * j]; const f32x4 g = ((const f32x4*)p.ln_final)[lane + 64 * j]; v = v * rr * g; ((f32x4*)dst)[lane + 64 * j] = v; }
    }
}

#define XB_TMO      128
#define XB_XCNT(j)  (256  + 64 * (j))
#define XB_XSUB(j)  (1280 + 64 * (j))
#define XB_XGEN(j)  (2304 + 64 * (j))
#define XB_TOP      3328
#define XB_TOPGEN   3392
#define XCD_BAR_WORDS 3456
#define XB_SPIN_CAP (1u << 18)
DI unsigned xb_ld(unsigned* p) { return __hip_atomic_load(p, __ATOMIC_RELAXED, __HIP_MEMORY_SCOPE_AGENT); }
DI unsigned xb_add(unsigned* p, unsigned v) { return __hip_atomic_fetch_add(p, v, __ATOMIC_RELAXED, __HIP_MEMORY_SCOPE_AGENT); }
DI unsigned xb_xcc_id() { return (unsigned)__builtin_amdgcn_s_getreg((3 << 11) | 20) & 0xFu; }
#define XB_SPIN(cond, bar) do { unsigned _sp = 0; while (cond) { __builtin_amdgcn_s_sleep(1); \
    if ((++_sp & 255u) == 0u) { if (xb_ld(&(bar)[XB_TMO])) break; if (_sp > XB_SPIN_CAP) { atomicAdd(&(bar)[XB_TMO], 1u); break; } } } } while (0)
struct XcdBarrier { unsigned* bar; unsigned x; volatile LAS unsigned* st; };
DI XcdBarrier xcd_barrier_post(unsigned* bar, volatile LAS unsigned* st) {
    XcdBarrier b; b.bar = bar; b.x = xb_xcc_id(); b.st = st;
    if (threadIdx.x == 0) (void)xb_add(&bar[XB_XCNT(b.x)], 1u);
    return b;
}
DI void xcd_barrier_complete(unsigned* bar, unsigned x, unsigned& nloc, unsigned& nx) {
    const unsigned G = gridDim.x * gridDim.y * gridDim.z;
    unsigned sum, cnt, mine, sp = 0u;
    for (;;) {
        sum = 0u; cnt = 0u; mine = 0u;
#pragma unroll
        for (unsigned j = 0; j < 16; ++j) { const unsigned c = xb_ld(&bar[XB_XCNT(j)]); sum += c; cnt += (c > 0u) ? 1u : 0u; mine = (j == x) ? c : mine; }
        if (sum == G) break;
        __builtin_amdgcn_s_sleep(1);
        if ((++sp & 255u) == 0u) { if (xb_ld(&bar[XB_TMO])) break; if (sp > XB_SPIN_CAP) { atomicAdd(&bar[XB_TMO], 1u); break; } }
    }
    nloc = mine > 0u ? mine : 1u; nx = cnt > 0u ? cnt : 1u;
}
DI void xcd_barrier(const XcdBarrier& b) {
    asm volatile("s_waitcnt vmcnt(0)" ::: "memory");
    __syncthreads();
    if (threadIdx.x == 0) {
        unsigned* bar = b.bar;
        __builtin_amdgcn_s_waitcnt(0);
        unsigned nloc = b.st[0], nx = b.st[1];
        if (nloc == 0u) { xcd_barrier_complete(bar, b.x, nloc, nx); b.st[0] = nloc; b.st[1] = nx; }
        const unsigned old = xb_add(&bar[XB_XSUB(b.x)], 1u);
        const unsigned gen = old / nloc;
        if (old + 1u == (gen + 1u) * nloc) {
            __builtin_amdgcn_fence(__ATOMIC_RELEASE, "agent");
            asm volatile("s_waitcnt vmcnt(0)" ::: "memory");
            const unsigned og = xb_add(&bar[XB_TOP], 1u);
            const unsigned tg = og / nx;
            if (og + 1u == (tg + 1u) * nx) xb_add(&bar[XB_TOPGEN], 1u);
            else XB_SPIN(xb_ld(&bar[XB_TOPGEN]) == tg, bar);
            __builtin_amdgcn_fence(__ATOMIC_ACQUIRE, "agent");
            xb_add(&bar[XB_XGEN(b.x)], 1u);
            asm volatile("s_waitcnt vmcnt(0)" ::: "memory");
        } else {
            XB_SPIN(xb_ld(&bar[XB_XGEN(b.x)]) == gen, bar);
            __builtin_amdgcn_fence(__ATOMIC_ACQUIRE, "agent");
            asm volatile("s_waitcnt vmcnt(0)" ::: "memory");
        }
    }
    __syncthreads();
}
constexpr int LDS_BYTES = 131072 + 256;
__global__ void __launch_bounds__(512, 2) fwd_megakernel(Prm p) {
    extern __shared__ __attribute__((aligned(16))) unsigned char shm[];
    LAS unsigned char* lds = (LAS unsigned char*)shm;
    cg::grid_group grid = cg::this_grid();
    const int tid = threadIdx.x, lane = tid & 63, wave = __builtin_amdgcn_readfirstlane(tid >> 6);
    const int gw = blockIdx.x * 8 + wave, NGW = gridDim.x * 8, gtid = blockIdx.x * 512 + tid, GT = gridDim.x * 512;
    volatile LAS unsigned* xst = (volatile LAS unsigned*)(lds + 131072);
    if (tid == 0) { xst[0] = 0u; xst[1] = 0u; }
    __syncthreads();
    const XcdBarrier xb = xcd_barrier_post(p.BAR, xst);
    phase_prologue(p, lds, tid, lane, wave);
    grid.sync();
    { EpiIn0 E; E.SSQ = p.SSQ; E.LB = p.LB; E.Qh = p.Qh; E.IV = p.IV; E.GS = p.GS; E.U = p.U; E.LOGF = p.LOGF; run_gemm(lds, p.XB, p.Wt1, 2560, 1024, E); }
    xcd_barrier(xb);
    for (int item = blockIdx.x; item < NITEM_H; item += gridDim.x) hgrn_b1(p, item, lds, tid, lane, wave);
    s5_b(p, gw, NGW, lane);
    xcd_barrier(xb);
    hgrn_b2(p, gtid, GT);
    s5_c(p, gtid);
    xcd_barrier(xb);
    for (int item = blockIdx.x; item < NITEM_H; item += gridDim.x) hgrn_b3(p, item, lds, tid, lane, wave);
    s5_d(p, gw, NGW, lane);
    xcd_barrier(xb);
    { EpiGlu E; E.YG = p.YG; E.CAT = p.CAT; run_gemm(lds, p.YG, p.Wglu, 512, 512, E); }
    xcd_barrier(xb);
    { EpiRes E; E.XB = p.XB; E.SSQ = p.SSQ; run_gemm(lds, p.CAT, p.Wo0, 1024, 1024, E); }
    xcd_barrier(xb);
    { EpiUp E; E.SSQ = p.SSQ; E.H = p.H; run_gemm(lds, p.XB, p.Wup0, 4096, 1024, E); }
    xcd_barrier(xb);
    { EpiRes E; E.XB = p.XB; E.SSQ = p.SSQ; run_gemm_split(lds, p.H, p.Wdn0, 1024, 4096, E, (float*)p.CAT); xcd_barrier(xb); gemm_fixup(1024, 4096, E, (const float*)p.CAT, tid); }
    xcd_barrier(xb);
    { EpiQkv E; E.SSQ = p.SSQ; E.out = p.out; E.Q = p.Q; E.KP = p.KP; E.KS = p.KS; E.VTP = p.VTP; E.VTS = p.VTS; run_gemm(lds, p.XB, p.Wqkv, 3072, 1024, E); }
    if (gridDim.x > 36) { if (blockIdx.x >= 36) cache_convert(p, (blockIdx.x - 36) * 512 + tid, (gridDim.x - 36) * 512); } else cache_convert(p, gtid, GT);
    xcd_barrier(xb);
    attn_phase(p, gw, NGW, lane);
    xcd_barrier(xb);
    { EpiRes E; E.XB = p.XB; E.SSQ = p.SSQ; run_gemm(lds, p.O, p.Wo1, 1024, 1024, E); }
    xcd_barrier(xb);
    { EpiUp E; E.SSQ = p.SSQ; E.H = p.H; run_gemm(lds, p.XB, p.Wup1, 4096, 1024, E); }
    xcd_barrier(xb);
    { EpiFin E; E.XB = p.XB; E.SSQ = p.SSQ; E.out = p.out; run_gemm_split(lds, p.H, p.Wdn1, 1024, 4096, E, (float*)p.CAT); xcd_barrier(xb); gemm_fixup(1024, 4096, E, (const float*)p.CAT, tid); }
    xcd_barrier(xb);
    final_norm(p, gw, NGW, lane);
}

extern "C" void kernel_launch(void* const* d_in, const int* in_sizes, int n_in, void* d_out, int out_size, void* d_ws, size_t ws_size, hipStream_t stream) {
    static int grid_blocks = 0;
    if (grid_blocks == 0) {
        int dev = 0, cus = 0, per_cu = 0;
        hipGetDevice(&dev); hipDeviceGetAttribute(&cus, hipDeviceAttributeMultiprocessorCount, dev);
        if (hipFuncSetAttribute((const void*)fwd_megakernel, hipFuncAttributeMaxDynamicSharedMemorySize, LDS_BYTES) != hipSuccess) fprintf(stderr, "kernel_launch: hipFuncSetAttribute failed\n");
        if (hipOccupancyMaxActiveBlocksPerMultiprocessor(&per_cu, (const void*)fwd_megakernel, 512, LDS_BYTES) != hipSuccess || per_cu < 1) { fprintf(stderr, "kernel_launch: occupancy query says %d\n", per_cu); per_cu = 1; }
        (void)hipGetLastError();
        grid_blocks = cus > 0 ? cus : 256;
    }
    Prm p{};
    const float* const* in = (const float* const*)d_in;
    p.x_prompt = in[0]; p.x_sample = in[1]; p.state_hgrn = in[2]; p.ssm_re0 = in[3]; p.ssm_im0 = in[4]; p.cache_k = in[5]; p.cache_v = in[6]; p.meta = in[7]; p.ln_mix = in[8]; p.ln_mlp = in[9];
    p.ln_final = in[10]; p.w_in_even = in[11]; p.hgrn_lb = in[12]; p.hgrn_norm = in[13]; p.a_re = in[14]; p.a_im = in[15]; p.log_dt = in[16]; p.b_re = in[17]; p.b_im = in[18]; p.c_re = in[19];
    p.c_im = in[20]; p.ssm_d = in[21]; p.w_glu = in[22]; p.w_out_even = in[23]; p.w_in_odd = in[24]; p.w_out_odd = in[25]; p.w_up = in[26]; p.w_down = in[27];
    p.out = (float*)d_out;
    unsigned char* ws = (unsigned char*)d_ws; size_t off = 0;
    auto take = [&](size_t bytes) { unsigned char* r = ws + off; off += (bytes + 255) & ~(size_t)255; return r; };
    p.Wt1 = (bf16_t*)take((size_t)2560 * 1024 * 2); p.Wglu = (bf16_t*)take((size_t)512 * 512 * 2); p.Wo0 = (bf16_t*)take((size_t)1024 * 1024 * 2); p.Wup0 = (bf16_t*)take((size_t)4096 * 1024 * 2);
    p.Wdn0 = (bf16_t*)take((size_t)4096 * 1024 * 2); p.Wqkv = (bf16_t*)take((size_t)3072 * 1024 * 2); p.Wo1 = (bf16_t*)take((size_t)1024 * 1024 * 2); p.Wup1 = (bf16_t*)take((size_t)4096 * 1024 * 2);
    p.Wdn1 = (bf16_t*)take((size_t)4096 * 1024 * 2);
    p.XB = (bf16_t*)take((size_t)MP * 1024 * 2); p.SSQ = (float*)take((size_t)MP * 16 * 4); p.LB = (float*)take(2048); p.KTAB = (float*)take((size_t)32 * 16 * 256 * 4);
    p.TG = (bf16_t*)take((size_t)32 * 256 * 384 * 2); p.HT = (bf16_t*)take((size_t)32 * 128 * 256 * 2); p.A16 = (float*)take(32 * 64 * 2 * 4); p.BAR = (unsigned*)take(XCD_BAR_WORDS * 4);
    const size_t S0 = off; constexpr size_t SZ512 = (size_t)MP * 512 * 2;
    p.Qh = (bf16_t*)take(SZ512); p.LOGF = (unsigned short*)take(SZ512); p.IV = (bf16_t*)take(SZ512); p.GS = (bf16_t*)take(SZ512); p.U = (bf16_t*)take(SZ512);
    p.UT = (bf16_t*)take((size_t)NITEM_H * 16384 * 2); p.AL = (float*)take((size_t)NITEM_H * 128 * 4);
    p.XLOC = (float*)take(SZ512); p.YG = (bf16_t*)p.XLOC;
    p.XPREV = (bf16_t*)take((size_t)NCOL * 4096 * 2); p.CAT = (bf16_t*)take((size_t)MP * 1024 * 2);
    size_t end = off;
    off = S0; p.H = (bf16_t*)take((size_t)MP * 4096 * 2); if (off > end) end = off;
    off = S0; p.Q = (bf16_t*)take((size_t)MP * 1024 * 2); p.KP = (bf16_t*)take((size_t)64 * 129 * 4096 * 2); p.KS = (bf16_t*)take((size_t)64 * 34 * 4096 * 2);
    p.VTP = (bf16_t*)take((size_t)64 * 129 * 4096 * 2); p.VTS = (bf16_t*)take((size_t)64 * 34 * 4096 * 2); p.O = (bf16_t*)take((size_t)MP * 1024 * 2); if (off > end) end = off;
    if (end > ws_size || n_in != 28 || (size_t)out_size != O_END) { fprintf(stderr, "kernel_launch: workspace/shape mismatch: need %zu have %zu, n_in %d, out %d\n", end, ws_size, n_in, out_size); return; }
    (void)hipMemsetAsync(p.BAR, 0, XCD_BAR_WORDS * 4, stream);
    void* args[] = {&p};
    hipError_t e = hipLaunchCooperativeKernel((const void*)fwd_megakernel, dim3(grid_blocks), dim3(512), args, LDS_BYTES, stream);
    if (e != hipSuccess) fprintf(stderr, "cooperative launch failed: %s (grid %d)\n", hipGetErrorString(e), grid_blocks);
}
```

```cpp
#include <hip/hip_runtime.h>
#include <hip/hip_cooperative_groups.h>
#include <cstdio>
#include <cstdint>
namespace cg = cooperative_groups;
namespace pg8 {
#define PG8_LAS __attribute__((address_space(3)))
typedef unsigned short bf16_t;
typedef short bf16x8 __attribute__((ext_vector_type(8)));
typedef float f32x4 __attribute__((ext_vector_type(4)));
typedef unsigned u32x4 __attribute__((ext_vector_type(4)));
constexpr int BM = 256, BK = 64, HALF = 128, HTB = HALF * BK * 2  , STAGE_BYTES = 8 * HTB, NXCD = 8, WGM = 8;

__host__ __device__ __forceinline__ int lds_byte(int r, int c) { const int st = (r >> 4) * 2 + (c >> 5), rr = r & 15, cc = c & 31, ob = rr * 64 + cc * 2; return st * 1024 + (ob ^ (((ob >> 9) & 1) << 5)); }
__host__ __device__ __forceinline__ void stage_rc(int b, int& R, int& C) { const int st = b / 1024, sb = b % 1024, swz = sb ^ (((sb >> 9) & 1) << 5); R = (st >> 1) * 16 + swz / 64; C = (st & 1) * 32 + (swz % 64) / 2; }
__host__ __device__ __forceinline__ int perm32(int rho) { const int n = rho >> 4, i = rho & 15; return 8 * (i >> 2) + 4 * n + (i & 3); }

struct Unit { int pm, pn, kb, nk, part; };
struct Gemm { const bf16_t* A; const bf16_t* Bt; int M, N, K; float* part; };

struct StaticOrder {
    int nM, nN, nwg, G, c;
    __host__ __device__ void init(int M, int N, int G_, int c_) { nM = M / BM; nN = N / BM; nwg = nM * nN; G = G_; c = c_; }
    __host__ __device__ void map(int L, Unit& u) const {
        int wgid = L; { const int q = nwg / NXCD, r = nwg % NXCD, xcd = wgid % NXCD, off = wgid / NXCD; wgid = (xcd < r ? xcd * (q + 1) : r * (q + 1) + (xcd - r) * q) + off; }
        const int nig = WGM * nN, gid = wgid / nig, fm = gid * WGM, gsz = (nM - fm) < WGM ? (nM - fm) : WGM;
        u.pm = fm + ((wgid % nig) % gsz); u.pn = (wgid % nig) / gsz; u.kb = 0; u.nk = 0; u.part = -1;
    }
    __host__ __device__ bool next(int i, Unit& u) const {
        const long L = (long)i * G + c; if (L >= nwg) return false;
        map((int)L, u); return true;
    }
    __device__ __forceinline__ void a_ready(const Unit&) const {}
    __device__ __forceinline__ void done(const Unit&) const {}
};
template <class Epi, class Sched>
__device__ __forceinline__ void gemm_phase(PG8_LAS unsigned char* lds, const Gemm g, const Sched& S, const Epi& E) {
    const int tid = threadIdx.x, wid = __builtin_amdgcn_readfirstlane(tid >> 6), lane = tid & 63, wr = wid >> 2, wc = wid & 3, fr = lane & 15, fq = lane >> 4;
    const int K = g.K, nt = K / BK;
    unsigned voffA[2], voffB[2];
#pragma unroll
    for (int i = 0; i < 2; ++i) { int R, C; stage_rc(tid * 16 + i * 8192, R, C); const int Rb = Epi::PERM ? ((R & ~31) + perm32(R & 31)) : R;
        voffA[i] = (unsigned)(R * K + C) * 2u; voffB[i] = (unsigned)(Rb * K + C) * 2u; }
    const size_t kstep = (size_t)(BK * 2);
    const size_t hstep = (size_t)HALF * K * 2;
    const size_t tstep = 2 * hstep;
    const unsigned ldsw = (unsigned)wid * 1024u;
    const int aoff = lds_byte(wr * 64 + fr, fq * 8), boff = lds_byte(wc * 32 + fr, fq * 8);
#define PG8_SA(b, h) (((b) * 2 + (h)) * HTB)
#define PG8_SB(b, h) ((4 + (b) * 2 + (h)) * HTB)
#define PG8_STAGE(bufoff, gbase, voff) do { _Pragma("unroll") for (int _i = 0; _i < 2; ++_i) \
        __builtin_amdgcn_global_load_lds((const unsigned*)((const char*)(gbase) + (voff)[_i]), (PG8_LAS unsigned*)(lds + (bufoff) + ldsw + _i * 8192), 16, 0, 0); } while (0)
#define PG8_LDA(dst, b, h) do { _Pragma("unroll") for (int m = 0; m < 4; ++m) _Pragma("unroll") for (int k = 0; k < 2; ++k) dst[m][k] = *(const PG8_LAS bf16x8*)(lds + PG8_SA(b, h) + aoff + m * 2048 + k * 1024); } while (0)
#define PG8_LDB(dst, b, h) do { _Pragma("unroll") for (int n = 0; n < 2; ++n) _Pragma("unroll") for (int k = 0; k < 2; ++k) dst[n][k] = *(const PG8_LAS bf16x8*)(lds + PG8_SB(b, h) + boff + n * 2048 + k * 1024); } while (0)
#define PG8_MMA(ai, bj, At, Bt) do { __builtin_amdgcn_s_setprio(1); _Pragma("unroll") for (int m = 0; m < 4; ++m) _Pragma("unroll") for (int n = 0; n < 2; ++n) _Pragma("unroll") for (int k = 0; k < 2; ++k) \
        acc[ai][bj][m][n] = __builtin_amdgcn_mfma_f32_16x16x32_bf16(Bt[n][k], At[m][k], acc[ai][bj][m][n], 0, 0, 0); __builtin_amdgcn_s_setprio(0); } while (0)
#define PG8_WAIT_V(n) asm volatile("s_waitcnt vmcnt(" #n ")" ::: "memory")
#define PG8_WAIT_L(n) asm volatile("s_waitcnt lgkmcnt(" #n ")" ::: "memory")
#define PG8_BAR __builtin_amdgcn_s_barrier()
#define PG8_SCHED __builtin_amdgcn_sched_barrier(0)
    Unit cur, nxt; int ui = 0;
    if (!S.next(0, cur)) return;
    f32x4 acc[2][2][4][2];
#pragma unroll
    for (int a = 0; a < 2; ++a)
#pragma unroll
        for (int b = 0; b < 2; ++b)
#pragma unroll
            for (int m = 0; m < 4; ++m)
#pragma unroll
                for (int n = 0; n < 2; ++n) acc[a][b][m][n] = (f32x4){0.f, 0.f, 0.f, 0.f};
    bf16x8 At[4][2], B0[2][2], B1[2][2];
    const char* cA = (const char*)g.A + (size_t)cur.pm * tstep + (size_t)cur.kb * kstep; const char* cB = (const char*)g.Bt + (size_t)cur.pn * tstep + (size_t)cur.kb * kstep;
    S.a_ready(cur);
    PG8_STAGE(PG8_SB(0, 0), cB, voffB); PG8_STAGE(PG8_SA(0, 0), cA, voffA); PG8_STAGE(PG8_SB(0, 1), cB + hstep, voffB); PG8_STAGE(PG8_SA(0, 1), cA + hstep, voffA);
    if (wr == 1) PG8_BAR;
    PG8_WAIT_V(4); PG8_BAR;
    PG8_STAGE(PG8_SB(1, 0), cB + kstep, voffB); PG8_STAGE(PG8_SA(1, 0), cA + kstep, voffA); PG8_STAGE(PG8_SB(1, 1), cB + hstep + kstep, voffB);
    PG8_WAIT_V(6); PG8_BAR;
    for (;;) {
        const bool has_next = S.next(ui + 1, nxt);
        const char* nA = has_next ? (const char*)g.A + (size_t)nxt.pm * tstep + (size_t)nxt.kb * kstep : cA; const char* nB = has_next ? (const char*)g.Bt + (size_t)nxt.pn * tstep + (size_t)nxt.kb * kstep : cB;
        const int cnk = cur.nk ? cur.nk : nt;
        for (int t = 0; t < cnk; t += 2) {
            const bool last = (t == cnk - 2);
            const char* a1 = cA + (size_t)(t + 1) * kstep;
            const char* a2 = last ? nA : cA + (size_t)(t + 2) * kstep; const char* b2 = last ? nB : cB + (size_t)(t + 2) * kstep;
            const char* a3 = a2 + kstep; const char* b3 = b2 + kstep;
            if (last && has_next) S.a_ready(nxt);
            PG8_LDB(B0, 0, 0); PG8_SCHED; PG8_LDA(At, 0, 0); PG8_STAGE(PG8_SA(1, 1), a1 + hstep, voffA);
            PG8_WAIT_L(8); PG8_BAR; PG8_WAIT_L(0); PG8_MMA(0, 0, At, B0); PG8_BAR; PG8_SCHED;
            PG8_LDB(B1, 0, 1); PG8_STAGE(PG8_SB(0, 0), b2, voffB);
            PG8_BAR; PG8_WAIT_L(0); PG8_MMA(0, 1, At, B1); PG8_BAR;
            PG8_LDA(At, 0, 1); PG8_STAGE(PG8_SA(0, 0), a2, voffA);
            PG8_BAR; PG8_WAIT_L(0); PG8_MMA(1, 0, At, B0); PG8_BAR; PG8_SCHED;
            PG8_STAGE(PG8_SB(0, 1), b2 + hstep, voffB);
            PG8_WAIT_V(6); PG8_BAR; PG8_MMA(1, 1, At, B1); PG8_BAR;
            PG8_LDB(B0, 1, 0); PG8_SCHED; PG8_LDA(At, 1, 0); PG8_STAGE(PG8_SA(0, 1), a2 + hstep, voffA);
            PG8_WAIT_L(8); PG8_BAR; PG8_WAIT_L(0); PG8_MMA(0, 0, At, B0); PG8_BAR; PG8_SCHED;
            PG8_LDB(B1, 1, 1); PG8_STAGE(PG8_SB(1, 0), b3, voffB);
            PG8_BAR; PG8_WAIT_L(0); PG8_MMA(0, 1, At, B1); PG8_BAR;
            PG8_LDA(At, 1, 1); PG8_STAGE(PG8_SA(1, 0), a3, voffA);
            PG8_BAR; PG8_WAIT_L(0); PG8_MMA(1, 0, At, B0); PG8_BAR; PG8_SCHED;
            PG8_STAGE(PG8_SB(1, 1), b3 + hstep, voffB);
            PG8_WAIT_V(6); PG8_BAR; PG8_MMA(1, 1, At, B1); PG8_BAR;
        }
        if constexpr (!Epi::AFTER_DRAIN) {
            if (cur.part < 0) E(acc, cur, wr, wc, fr, fq);
            else { f32x4* pp = (f32x4*)g.part + (size_t)cur.part * 32 * 512 + tid;
#pragma unroll
                for (int a = 0; a < 2; ++a)
#pragma unroll
                    for (int b = 0; b < 2; ++b)
#pragma unroll
                        for (int m = 0; m < 4; ++m)
#pragma unroll
                            for (int n = 0; n < 2; ++n) pp[(size_t)(((a * 2 + b) * 4 + m) * 2 + n) * 512] = acc[a][b][m][n]; }
            S.done(cur); }
        if (!has_next) break;
#pragma unroll
        for (int a = 0; a < 2; ++a)
#pragma unroll
            for (int b = 0; b < 2; ++b)
#pragma unroll
                for (int m = 0; m < 4; ++m)
#pragma unroll
                    for (int n = 0; n < 2; ++n) acc[a][b][m][n] = (f32x4){0.f, 0.f, 0.f, 0.f};
        cur = nxt; cA = nA; cB = nB; ++ui;
    }
    PG8_WAIT_V(0);
    if (wr == 0) PG8_BAR;
    PG8_BAR;
    if constexpr (Epi::AFTER_DRAIN) { E.fused(acc, cur, wr, wc, fr, fq, lds, wid, lane); S.done(cur); }
#undef PG8_SA
#undef PG8_SB
#undef PG8_STAGE
#undef PG8_LDA
#undef PG8_LDB
#undef PG8_MMA
#undef PG8_WAIT_V
#undef PG8_WAIT_L
#undef PG8_BAR
#undef PG8_SCHED
}
}
using pg8::bf16_t; using pg8::bf16x8; using pg8::f32x4; using pg8::Unit;
typedef float f32x16 __attribute__((ext_vector_type(16)));
typedef float f32x2v __attribute__((ext_vector_type(2)));
typedef unsigned u32x2 __attribute__((ext_vector_type(2)));
typedef unsigned u32x4v __attribute__((ext_vector_type(4)));
#define LAS __attribute__((address_space(3)))
#define DI __device__ __forceinline__

constexpr int DM = 1024, TP = 4112, NTP = 8 * TP  , NTS = 512, NT = NTP + NTS  , MP = 33536  ;
constexpr int NITEM_H = 2112;
constexpr int NCOL = NT / 16;
constexpr float EPSN = 1e-6f;
constexpr size_t O_YP = 0, O_YS = O_YP + (size_t)8 * 4096 * 1024, O_HGP = O_YS + 524288, O_HGS = O_HGP + 524288, O_SRP = O_HGS + 524288, O_SIP = O_SRP + 16384,
                 O_SRS = O_SIP + 16384, O_SIS = O_SRS + 16384, O_KP = O_SIS + 16384, O_VP = O_KP + (size_t)NTP * 1024, O_KS = O_VP + (size_t)NTP * 1024, O_VS = O_KS + 524288, O_END = O_VS + 524288;

struct Prm {
    const float *x_prompt, *x_sample, *state_hgrn, *ssm_re0, *ssm_im0, *cache_k, *cache_v, *meta, *ln_mix, *ln_mlp, *ln_final, *w_in_even, *hgrn_lb, *hgrn_norm,
        *a_re, *a_im, *log_dt, *b_re, *b_im, *c_re, *c_im, *ssm_d, *w_glu, *w_out_even, *w_in_odd, *w_out_odd, *w_up, *w_down;
    float* out;
    bf16_t *Wt1, *Wglu, *Wo0, *Wup0, *Wdn0, *Wqkv, *Wo1, *Wup1, *Wdn1;
    bf16_t* XB; float* SSQ; float* LB; float* KTAB; bf16_t* TG; bf16_t* HT; float* A16;
    bf16_t *Qh, *IV, *GS, *U; unsigned short* LOGF; bf16_t* UT; float* AL; float* XLOC; bf16_t* XPREV; bf16_t* YG; bf16_t* CAT;
    bf16_t* H;
    bf16_t *Q, *KP, *KS, *VTP, *VTS, *O; unsigned* BAR;
};

DI unsigned pk2(float lo, float hi) { unsigned r; asm volatile("v_cvt_pk_bf16_f32 %0, %1, %2" : "=v"(r) : "v"(lo), "v"(hi)); return r; }
DI float bflo(unsigned u) { return __uint_as_float(u << 16); }
DI float bfhi(unsigned u) { return __uint_as_float(u & 0xffff0000u); }
DI float bf2f(unsigned short b) { return __uint_as_float(((unsigned)b) << 16); }
DI unsigned short f2bf(float f) { return (unsigned short)(pk2(f, 0.f) & 0xffffu); }
DI unsigned pkh2(float lo, float hi) { union { _Float16 h[2]; unsigned u; } x; x.h[0] = (_Float16)lo; x.h[1] = (_Float16)hi; return x.u; }
DI float h2f(unsigned short h) { union { unsigned short s; _Float16 h; } x; x.s = h; return (float)x.h; }
DI float wave_sum(float v) {
#pragma unroll
    for (int o = 1; o < 64; o <<= 1) v += __shfl_xor(v, o);
    return v;
}
DI float fexp(float x) { return __expf(x); }
DI float sigm(float x) { return __builtin_amdgcn_rcpf(1.f + __expf(-x)); }
DI float row_rinv(const float* SSQ, int row) {
    const f32x4* s = (const f32x4*)(SSQ + (size_t)row * 16); f32x4 a = s[0] + s[1] + s[2] + s[3];
    return rsqrtf(((a.x + a.y) + (a.z + a.w)) * (1.f / 1024.f) + EPSN);
}
#define LDS_WAIT() asm volatile("s_waitcnt lgkmcnt(0)" ::: "memory")

struct EpiIn0 {
    static constexpr bool PERM = false, AFTER_DRAIN = false;
    const float* SSQ; const float* LB; bf16_t *Qh, *IV, *GS, *U; unsigned short* LOGF;
    DI void operator()(const f32x4 (&acc)[2][2][4][2], const Unit& u, int wr, int wc, int fr, int fq) const {
        const int seg = u.pn >> 1, cb = (u.pn & 1) * 256 + wc * 32 + 4 * fq, row0 = u.pm * 256 + wr * 64 + fr;
        unsigned short* dst = seg == 0 ? Qh : seg == 1 ? LOGF : seg == 2 ? IV : seg == 3 ? GS : U;
#pragma unroll
        for (int ai = 0; ai < 2; ++ai)
#pragma unroll
            for (int m = 0; m < 4; ++m) { const int row = row0 + ai * 128 + m * 16; const float r = row_rinv(SSQ, row);
#pragma unroll
                for (int bj = 0; bj < 2; ++bj)
#pragma unroll
                    for (int n = 0; n < 2; ++n) { const int cs = cb + bj * 128 + n * 16; f32x4 v = acc[ai][bj][m][n] * r; u32x2 o;
                        if (seg == 1) { const f32x4 lb = *(const f32x4*)(LB + cs); f32x4 f;
#pragma unroll
                            for (int e = 0; e < 4; ++e) f[e] = __logf(lb[e] + (1.f - lb[e]) * sigm(v[e]));
                            o.x = pkh2(f[0], f[1]); o.y = pkh2(f[2], f[3]); }
                        else { if (seg == 3) {
#pragma unroll
                                for (int e = 0; e < 4; ++e) v[e] = v[e] * sigm(v[e]); }
                            o.x = pk2(v[0], v[1]); o.y = pk2(v[2], v[3]); }
                        *(u32x2*)(dst + (size_t)row * 512 + cs) = o; } }
    }
};
struct EpiGlu {
    static constexpr bool PERM = false, AFTER_DRAIN = false;
    const bf16_t* YG; bf16_t* CAT;
    DI void operator()(const f32x4 (&acc)[2][2][4][2], const Unit& u, int wr, int wc, int fr, int fq) const {
        const int cb = u.pn * 256 + wc * 32 + 4 * fq, row0 = u.pm * 256 + wr * 64 + fr;
#pragma unroll
        for (int ai = 0; ai < 2; ++ai)
#pragma unroll
            for (int m = 0; m < 4; ++m) { const int row = row0 + ai * 128 + m * 16;
#pragma unroll
                for (int bj = 0; bj < 2; ++bj)
#pragma unroll
                    for (int n = 0; n < 2; ++n) { const int cs = cb + bj * 128 + n * 16; const f32x4 v = acc[ai][bj][m][n];
                        const u32x2 y = *(const u32x2*)(YG + (size_t)row * 512 + cs); u32x2 o;
                        o.x = pk2(bflo(y.x) * sigm(v[0]), bfhi(y.x) * sigm(v[1])); o.y = pk2(bflo(y.y) * sigm(v[2]), bfhi(y.y) * sigm(v[3]));
                        *(u32x2*)(CAT + (size_t)row * 1024 + 512 + cs) = o; } }
    }
};
struct EpiRes {
    static constexpr bool PERM = false, AFTER_DRAIN = false;
    bf16_t* XB; float* SSQ;
    DI void row(const f32x4 (&a4)[2][2], const Unit& u, int ai, int m, int wr, int wc, int fr, int fq) const {
        const int cb = u.pn * 256 + wc * 32 + 4 * fq, row = u.pm * 256 + wr * 64 + fr + ai * 128 + m * 16; float ss = 0.f;
#pragma unroll
        for (int bj = 0; bj < 2; ++bj)
#pragma unroll
            for (int n = 0; n < 2; ++n) { const int cs = cb + bj * 128 + n * 16; const f32x4 v = a4[bj][n];
                u32x2* px = (u32x2*)(XB + (size_t)row * 1024 + cs); const u32x2 x = *px; u32x2 o;
                o.x = pk2(bflo(x.x) + v[0], bfhi(x.x) + v[1]); o.y = pk2(bflo(x.y) + v[2], bfhi(x.y) + v[3]); *px = o;
                const float a0 = bflo(o.x), a1 = bfhi(o.x), a2 = bflo(o.y), a3 = bfhi(o.y); ss += (a0 * a0 + a1 * a1) + (a2 * a2 + a3 * a3); }
        ss += __shfl_xor(ss, 16); ss += __shfl_xor(ss, 32);
        if (fq == 0) SSQ[(size_t)row * 16 + u.pn * 4 + wc] = ss;
    }
    DI void operator()(const f32x4 (&acc)[2][2][4][2], const Unit& u, int wr, int wc, int fr, int fq) const {
#pragma unroll
        for (int ai = 0; ai < 2; ++ai)
#pragma unroll
            for (int m = 0; m < 4; ++m) { const f32x4 a4[2][2] = {{acc[ai][0][m][0], acc[ai][0][m][1]}, {acc[ai][1][m][0], acc[ai][1][m][1]}}; row(a4, u, ai, m, wr, wc, fr, fq); }
    }
};
struct EpiUp {
    static constexpr bool PERM = false, AFTER_DRAIN = false;
    const float* SSQ; bf16_t* H;
    DI void operator()(const f32x4 (&acc)[2][2][4][2], const Unit& u, int wr, int wc, int fr, int fq) const {
        const int cb = u.pn * 256 + wc * 32 + 4 * fq, row0 = u.pm * 256 + wr * 64 + fr;
#pragma unroll
        for (int ai = 0; ai < 2; ++ai)
#pragma unroll
            for (int m = 0; m < 4; ++m) { const int row = row0 + ai * 128 + m * 16; const float r = row_rinv(SSQ, row);
#pragma unroll
                for (int bj = 0; bj < 2; ++bj)
#pragma unroll
                    for (int n = 0; n < 2; ++n) { const int cs = cb + bj * 128 + n * 16; f32x4 v = acc[ai][bj][m][n] * r;
#pragma unroll
                        for (int e = 0; e < 4; ++e) { const float t = fmaxf(v[e], 0.f); v[e] = t * t; }
                        u32x2 o; o.x = pk2(v[0], v[1]); o.y = pk2(v[2], v[3]); *(u32x2*)(H + (size_t)row * 4096 + cs) = o; } }
    }
};
DI size_t kf_index(int seqh, int nkt, int key, int d) { return ((((size_t)seqh * nkt + (key >> 5)) * 8 + (d >> 4)) * 64 + ((key & 31) + 32 * ((d >> 3) & 1))) * 8 + (d & 7); }
DI size_t vf_index(int seqh, int nkt, int key, int d) { const int kk = key & 31;
    return ((((size_t)seqh * nkt + (key >> 5)) * 8 + (kk >> 4) * 4 + (d >> 5)) * 64 + ((d & 31) + 32 * ((kk >> 2) & 1))) * 8 + ((kk >> 3) & 1) * 4 + (kk & 3); }
struct EpiQkv {
    static constexpr bool PERM = false, AFTER_DRAIN = false;
    const float* SSQ; float* out; bf16_t *Q, *KP, *KS, *VTP, *VTS;
    DI void operator()(const f32x4 (&acc)[2][2][4][2], const Unit& u, int wr, int wc, int fr, int fq) const {
        const int third = u.pn >> 2, cb = (u.pn & 3) * 256 + wc * 32 + 4 * fq, row0 = u.pm * 256 + wr * 64 + fr;
#pragma unroll
        for (int ai = 0; ai < 2; ++ai)
#pragma unroll
            for (int m = 0; m < 4; ++m) { const int row = row0 + ai * 128 + m * 16; const float r = row_rinv(SSQ, row);
                const bool smp = row >= NTP; const int s = row - NTP; const int b = smp ? (s >> 6) : row / TP, key = smp ? 1024 + (s & 63) : row - b * TP, nkt = smp ? 34 : 129;
#pragma unroll
                for (int bj = 0; bj < 2; ++bj)
#pragma unroll
                    for (int n = 0; n < 2; ++n) { const int cs = cb + bj * 128 + n * 16; const f32x4 v = acc[ai][bj][m][n] * r;
                        u32x2 o; o.x = pk2(v[0], v[1]); o.y = pk2(v[2], v[3]);
                        if (third == 0) { *(u32x2*)(Q + (size_t)row * 1024 + cs) = o; }
                        else if (row < NT) { const int h = cs >> 7, d = cs & 127;
                            if (third == 1) { *(f32x4*)(out + (smp ? O_KS + (size_t)s * 1024 : O_KP + (size_t)row * 1024) + cs) = v;
                                *(u32x2*)((smp ? KS : KP) + kf_index(b * 8 + h, nkt, key, d)) = o; }
                            else { *(f32x4*)(out + (smp ? O_VS + (size_t)s * 1024 : O_VP + (size_t)row * 1024) + cs) = v;
                                bf16_t* vt = (smp ? VTS : VTP) + vf_index(b * 8 + h, nkt, key, d);
                                vt[0] = (bf16_t)(o.x & 0xffffu); vt[8] = (bf16_t)(o.x >> 16); vt[16] = (bf16_t)(o.y & 0xffffu); vt[24] = (bf16_t)(o.y >> 16); } } } }
    }
};
struct EpiFin {
    static constexpr bool PERM = false, AFTER_DRAIN = false;
    const bf16_t* XB; float* SSQ; float* out;
    DI void row(const f32x4 (&a4)[2][2], const Unit& u, int ai, int m, int wr, int wc, int fr, int fq) const {
        const int cb = u.pn * 256 + wc * 32 + 4 * fq, row = u.pm * 256 + wr * 64 + fr + ai * 128 + m * 16; float ss = 0.f;
        const int b = row / TP, t = row - b * TP; const bool ok = row < NT && (row >= NTP || t >= 16);
        float* dst = out + (row >= NTP ? O_YS + (size_t)(row - NTP) * 1024 : O_YP + ((size_t)b * 4096 + (t - 16)) * 1024);
#pragma unroll
        for (int bj = 0; bj < 2; ++bj)
#pragma unroll
            for (int n = 0; n < 2; ++n) { const int cs = cb + bj * 128 + n * 16; f32x4 v = a4[bj][n];
                const u32x2 x = *(const u32x2*)(XB + (size_t)row * 1024 + cs);
                v[0] += bflo(x.x); v[1] += bfhi(x.x); v[2] += bflo(x.y); v[3] += bfhi(x.y);
                if (ok) *(f32x4*)(dst + cs) = v;
                ss += (v[0] * v[0] + v[1] * v[1]) + (v[2] * v[2] + v[3] * v[3]); }
        ss += __shfl_xor(ss, 16); ss += __shfl_xor(ss, 32);
        if (fq == 0) SSQ[(size_t)row * 16 + u.pn * 4 + wc] = ss;
    }
    DI void operator()(const f32x4 (&acc)[2][2][4][2], const Unit& u, int wr, int wc, int fr, int fq) const {
#pragma unroll
        for (int ai = 0; ai < 2; ++ai)
#pragma unroll
            for (int m = 0; m < 4; ++m) { const f32x4 a4[2][2] = {{acc[ai][0][m][0], acc[ai][0][m][1]}, {acc[ai][1][m][0], acc[ai][1][m][1]}}; row(a4, u, ai, m, wr, wc, fr, fq); }
    }
};
template <class Epi> DI void run_gemm(LAS unsigned char* lds, const bf16_t* A, const bf16_t* Bt, int N, int K, const Epi& E) {
    pg8::Gemm g; g.A = A; g.Bt = Bt; g.M = MP; g.N = N; g.K = K; g.part = nullptr;
    pg8::StaticOrder S; S.init(MP, N, (int)gridDim.x, (int)blockIdx.x);
    pg8::gemm_phase<Epi, pg8::StaticOrder>(lds, g, S, E);
}
struct SplitOrder : pg8::StaticOrder {
    int nwhole, ntail, S, nks;
    DI void init2(int N, int K) { init(MP, N, (int)gridDim.x, (int)blockIdx.x); nwhole = nwg / G; ntail = nwg - nwhole * G; S = 0; nks = 0;
        if (ntail > 0) { int s = G / ntail; const int nkt = K / 64; while (s > 1 && (nkt % s != 0 || (nkt / s) < 4 || ((nkt / s) & 1))) --s; if (s > 1) { S = s; nks = nkt / s; } } }
    DI bool next(int i, Unit& u) const {
        if (S == 0) return pg8::StaticOrder::next(i, u);
        if (i < nwhole) { map(i * G + c, u); return true; }
        if (i == nwhole && c < ntail * S) { map(nwhole * G + c / S, u); u.kb = (c % S) * nks; u.nk = nks; u.part = c; return true; }
        return false;
    }
};
template <class Epi> DI void run_gemm_split(LAS unsigned char* lds, const bf16_t* A, const bf16_t* Bt, int N, int K, const Epi& E, float* part) {
    pg8::Gemm g; g.A = A; g.Bt = Bt; g.M = MP; g.N = N; g.K = K; g.part = part;
    SplitOrder S; S.init2(N, K);
    pg8::gemm_phase<Epi, SplitOrder>(lds, g, S, E);
}
template <class Epi> DI void gemm_fixup(int N, int K, const Epi& E, const float* part, int tid) {
    SplitOrder S; S.init2(N, K); if (S.S == 0) return;
    const int wid = tid >> 6, lane = tid & 63, wr = wid >> 2, wc = wid & 3, fr = lane & 15, fq = lane >> 4;
    for (int it = blockIdx.x; it < S.ntail * 8; it += gridDim.x) { const int j = it >> 3, ai = (it >> 2) & 1, m = it & 3; Unit u; S.map(S.nwhole * S.G + j, u);
        f32x4 a4[2][2];
#pragma unroll
        for (int b = 0; b < 2; ++b)
#pragma unroll
            for (int n = 0; n < 2; ++n) { const f32x4* pp = (const f32x4*)part + ((size_t)(j * S.S) * 32 + (((ai * 2 + b) * 4 + m) * 2 + n)) * 512 + tid;
                f32x4 v0 = {0.f, 0.f, 0.f, 0.f}, v1 = v0, v2 = v0, v3 = v0;
                for (int sl = 0; sl + 3 < S.S; sl += 4) { v0 += pp[(size_t)sl * 16384]; v1 += pp[(size_t)(sl + 1) * 16384]; v2 += pp[(size_t)(sl + 2) * 16384]; v3 += pp[(size_t)(sl + 3) * 16384]; }
                for (int sl = S.S & ~3; sl < S.S; ++sl) v0 += pp[(size_t)sl * 16384];
                a4[b][n] = (v0 + v1) + (v2 + v3); }
        E.row(a4, u, ai, m, wr, wc, fr, fq); }
}
DI void transpose_item(const float* W, int N, bf16_t* WT, size_t ldo, const float* sc, LAS float* scr, int item, int lane) {
    const int nblk = N / 32, kb = item / nblk, nb = item % nblk, k0 = 64 * kb, n0 = 32 * nb;
#pragma unroll 8
    for (int i = 0; i < 32; ++i) { const int kk = 2 * i + (lane >> 5); float w = W[(size_t)(k0 + kk) * N + n0 + (lane & 31)]; if (sc) w *= sc[k0 + kk]; scr[kk * 33 + (lane & 31)] = w; }
    LDS_WAIT();
    const int c = lane & 7;
#pragma unroll
    for (int j = 0; j < 4; ++j) { const int n = (lane >> 3) + 8 * j; const LAS float* s = scr + (8 * c) * 33 + n;
        u32x4v o; o.x = pk2(s[0 * 33], s[1 * 33]); o.y = pk2(s[2 * 33], s[3 * 33]); o.z = pk2(s[4 * 33], s[5 * 33]); o.w = pk2(s[6 * 33], s[7 * 33]);
        *(u32x4v*)(WT + (size_t)(n0 + n) * ldo + k0 + 8 * c) = o; }
    LDS_WAIT();
}
DI void s5_pow(const Prm& p, int g, int n, float k, float& re, float& im) {
    const float dt = __expf(p.log_dt[g]), ar = p.a_re[g * 64 + n], ai = p.a_im[g * 64 + n];
    const float mag = __expf(k * dt * ar); float rev = k * dt * ai * 0.15915494309189535f; rev -= rintf(rev);
    re = mag * __builtin_amdgcn_cosf(rev); im = mag * __builtin_amdgcn_sinf(rev);
}
DI void s5_bbar(const Prm& p, int g, int n, int pp, float& re, float& im) {
    const float ar = p.a_re[g * 64 + n], ai = p.a_im[g * 64 + n]; float abr, abi; s5_pow(p, g, n, 1.f, abr, abi);
    const float den = ar * ar + ai * ai, zr = ((abr - 1.f) * ar + abi * ai) / den, zi = (abi * ar - (abr - 1.f) * ai) / den;
    const float br = p.b_re[(g * 64 + n) * 16 + pp], bi = p.b_im[(g * 64 + n) * 16 + pp];
    re = zr * br - zi * bi; im = zr * bi + zi * br;
}
DI void phase_prologue(const Prm& p, LAS unsigned char* lds, int tid, int lane, int wave) {
    const int gw = blockIdx.x * 8 + wave, NGW = gridDim.x * 8, gtid = blockIdx.x * 512 + tid, GT = gridDim.x * 512;
    LAS float* scr = (LAS float*)(lds + wave * 16384);
    constexpr int I1 = 16 * 80, I2 = 8 * 16, I3 = 16 * 32, I4 = 16 * 128, I5 = 64 * 32, I6 = 16 * 96;
    constexpr int NITEMS = I1 + I2 + I3 + I4 + I5 + I6 + I3 + I4 + I5;
    for (int it = gw; it < NITEMS; it += NGW) {
        int r = it;
        if (r < I1) { transpose_item(p.w_in_even, 2560, p.Wt1, 1024, p.ln_mix, scr, r, lane); continue; } r -= I1;
        if (r < I2) { transpose_item(p.w_glu, 512, p.Wglu, 512, nullptr, scr, r, lane); continue; } r -= I2;
        if (r < I3) { transpose_item(p.w_out_even, 1024, p.Wo0, 1024, nullptr, scr, r, lane); continue; } r -= I3;
        if (r < I4) { transpose_item(p.w_up, 4096, p.Wup0, 1024, p.ln_mlp, scr, r, lane); continue; } r -= I4;
        if (r < I5) { transpose_item(p.w_down, 1024, p.Wdn0, 4096, nullptr, scr, r, lane); continue; } r -= I5;
        if (r < I6) { transpose_item(p.w_in_odd, 3072, p.Wqkv, 1024, p.ln_mix + 1024, scr, r, lane); continue; } r -= I6;
        if (r < I3) { transpose_item(p.w_out_odd, 1024, p.Wo1, 1024, nullptr, scr, r, lane); continue; } r -= I3;
        if (r < I4) { transpose_item(p.w_up + (size_t)1024 * 4096, 4096, p.Wup1, 1024, p.ln_mlp + 1024, scr, r, lane); continue; } r -= I4;
        transpose_item(p.w_down + (size_t)4096 * 1024, 1024, p.Wdn1, 4096, nullptr, scr, r, lane);
    }
    for (int row = gw; row < NT; row += NGW) {
        const float* src;
        if (row < NTP) { const int b = row / TP, t = row - b * TP; src = t < 16 ? p.meta + (size_t)t * 1024 : p.x_prompt + ((size_t)b * 4096 + (t - 16)) * 1024; }
        else src = p.x_sample + (size_t)(row - NTP) * 1024;
        float ss = 0.f;
#pragma unroll
        for (int j = 0; j < 4; ++j) { const f32x4 v = ((const f32x4*)src)[lane + 64 * j]; u32x2 o; o.x = pk2(v.x, v.y); o.y = pk2(v.z, v.w);
            const float a0 = bflo(o.x), a1 = bfhi(o.x), a2 = bflo(o.y), a3 = bfhi(o.y); ss += (a0 * a0 + a1 * a1) + (a2 * a2 + a3 * a3);
            ((u32x2*)(p.XB + (size_t)row * 1024))[lane + 64 * j] = o; }
        ss = wave_sum(ss);
        if (lane < 16) p.SSQ[(size_t)row * 16 + lane] = lane == 0 ? ss : 0.f;
    }
    if (gtid < 512) p.LB[gtid] = 1.f / (1.f + __expf(p.hgrn_lb[512 + gtid] - p.hgrn_lb[gtid]));
    __syncthreads();
    {
        LAS float* zr_ = (LAS float*)lds; LAS float* zi_ = zr_ + 64; LAS float* wr_ = zi_ + 64; LAS float* wi_ = wr_ + 64;
        LAS float* bbr = wi_ + 64; LAS float* bbi = bbr + 1024; LAS float* cwr = bbi + 1024; LAS float* cwi = cwr + 16 * 65;
        for (int pair = blockIdx.x; pair < 512; pair += gridDim.x) { const int g = pair >> 4, tau = pair & 15;
            if (tid < 64) { const int n = tid; const float ar = p.a_re[g * 64 + n], ai = p.a_im[g * 64 + n]; float abr, abi; s5_pow(p, g, n, 1.f, abr, abi);
                const float den = ar * ar + ai * ai; zr_[n] = ((abr - 1.f) * ar + abi * ai) / den; zi_[n] = (abi * ar - (abr - 1.f) * ai) / den;
                float a, b; s5_pow(p, g, n, (float)tau, a, b); wr_[n] = a; wi_[n] = b; }
            __syncthreads();
#pragma unroll
            for (int k = 0; k < 2; ++k) { const int e = tid + 512 * k;
                { const int n = e >> 4; const float br = p.b_re[g * 1024 + e], bi = p.b_im[g * 1024 + e]; bbr[e] = zr_[n] * br - zi_[n] * bi; bbi[e] = zr_[n] * bi + zi_[n] * br; }
                { const int pch = e >> 6, n = e & 63; const float cr = p.c_re[g * 1024 + e], ci = p.c_im[g * 1024 + e]; cwr[pch * 65 + n] = cr * wr_[n] - ci * wi_[n]; cwi[pch * 65 + n] = cr * wi_[n] + ci * wr_[n]; } }
            __syncthreads();
            if (tid < 256) { const int pch = tid >> 4, pp = tid & 15; float acc = 0.f;
#pragma unroll 8
                for (int n = 0; n < 64; ++n) acc += cwr[pch * 65 + n] * bbr[n * 16 + pp] - cwi[pch * 65 + n] * bbi[n * 16 + pp];
                if (tau == 0 && pch == pp) acc += p.ssm_d[g * 16 + pch];
                const bf16_t kv = f2bf(acc);
                p.TG[((g * 16 + tau) * 16 + pch) * 16 + pp] = kv; }
            __syncthreads(); }
    }
    for (int i = gtid; i < 32 * 256 * 64; i += GT) {
        const int g = i >> 14, t = (i >> 10) & 15, pch = (i >> 6) & 15, n = i & 63; float wr_, wi_; s5_pow(p, g, n, (float)(t + 1), wr_, wi_);
        const float cr = p.c_re[(g * 16 + pch) * 64 + n], ci = p.c_im[(g * 16 + pch) * 64 + n];
        *(unsigned*)(p.TG + 131072 + ((size_t)(g * 256 + t * 16 + pch)) * 128 + 2 * n) = pk2(cr * wr_ - ci * wi_, -(cr * wi_ + ci * wr_)); }
    for (int i = gtid; i < 32 * 64 * 256; i += GT) {
        const int g = i >> 14, n = (i >> 8) & 63, s = (i >> 4) & 15, pp = i & 15; float wr_, wi_, br_, bi_; s5_pow(p, g, n, (float)(15 - s), wr_, wi_); s5_bbar(p, g, n, pp, br_, bi_);
        p.HT[((size_t)(g * 128 + 2 * n)) * 256 + s * 16 + pp] = f2bf(wr_ * br_ - wi_ * bi_);
        p.HT[((size_t)(g * 128 + 2 * n + 1)) * 256 + s * 16 + pp] = f2bf(wr_ * bi_ + wi_ * br_); }
    if (gtid < 2048) { float wr_, wi_; s5_pow(p, gtid >> 6, gtid & 63, 16.f, wr_, wi_); p.A16[2 * gtid] = wr_; p.A16[2 * gtid + 1] = wi_; }
}

constexpr int HP = 136, TPI = 72;
constexpr int L_QT = 0, L_QH = 17408, L_KT = 34816, L_KTT = 52224, L_IVT = 70656, L_ATT = 89088, L_SUM = 98304, L_VEC = 100352, L_OB = 0  ;
struct HItem { int row0, L, h, bh; };
DI HItem hgrn_item(int item) {
    HItem it;
    if (item < 2080) { const int bh = item / 65, c = item - bh * 65, b = bh >> 2; it.h = bh & 3; it.bh = bh; it.L = c == 0 ? 16 : 64; it.row0 = b * TP + (c == 0 ? 0 : 16 + 64 * (c - 1)); }
    else { const int s = item - 2080, b = s >> 2; it.h = s & 3; it.bh = 32 + s; it.L = 64; it.row0 = NTP + b * 64; }
    return it;
}
template <bool FULL> DI void hgrn_prep(const Prm& p, const HItem& it, LAS unsigned char* lds, int tid) {
    const int d = tid & 127, tq = tid >> 7, t0 = 16 * tq, col = it.h * 128 + d;
    LAS float* sums = (LAS float*)(lds + L_SUM); LAS float* vec = (LAS float*)(lds + L_VEC);
    float cs[16], lf[16];
    float run = 0.f;
#pragma unroll
    for (int j = 0; j < 16; ++j) { const int t = t0 + j; lf[j] = t < it.L ? h2f(p.LOGF[(size_t)(it.row0 + t) * 512 + col]) : 0.f; run += lf[j]; cs[j] = run; }
    sums[tq * 128 + d] = run;
    unsigned ivp[8];
#pragma unroll
    for (int j = 0; j < 8; ++j) { const int t = t0 + 2 * j;
        const unsigned lo = t < it.L ? p.IV[(size_t)(it.row0 + t) * 512 + col] : 0u, hi = t + 1 < it.L ? p.IV[(size_t)(it.row0 + t + 1) * 512 + col] : 0u; ivp[j] = lo | (hi << 16); }
    { LAS u32x4v* dst = (LAS u32x4v*)(lds + L_IVT + (d * TPI + t0) * 2); u32x4v a, b; a.x = ivp[0]; a.y = ivp[1]; a.z = ivp[2]; a.w = ivp[3]; b.x = ivp[4]; b.y = ivp[5]; b.z = ivp[6]; b.w = ivp[7]; dst[0] = a; dst[1] = b; }
    __syncthreads();
    const float s0 = sums[d], s1 = sums[128 + d], s2 = sums[256 + d], s3 = sums[384 + d];
    const float off = tq == 0 ? 0.f : tq == 1 ? s0 : tq == 2 ? s0 + s1 : s0 + s1 + s2, r = s0 + s1, bL = r + s2 + s3;
    if (tq == 0) { vec[d] = r; vec[128 + d] = bL; }
    unsigned ktp[8]; float kprev = 0.f;
#pragma unroll
    for (int j = 0; j < 16; ++j) { const int t = t0 + j; const bool valid = t < it.L; const float b = off + cs[j];
        const float kt = valid ? (1.f - __expf(lf[j])) * __expf(r - b) : 0.f;
        if (j & 1) ktp[j >> 1] = pk2(kprev, kt); else kprev = kt;
        if (FULL) { const float qv = valid ? bf2f(p.Qh[(size_t)(it.row0 + t) * 512 + col]) : 0.f;
            *(LAS unsigned short*)(lds + L_KT + (t * HP + d) * 2) = f2bf(kt);
            *(LAS unsigned short*)(lds + L_QT + (t * HP + d) * 2) = f2bf(qv * __expf(b - r));
            *(LAS unsigned short*)(lds + L_QH + (t * HP + d) * 2) = f2bf(qv * __expf(b)); } }
    if (!FULL) { LAS u32x4v* dst = (LAS u32x4v*)(lds + L_KTT + (d * TPI + t0) * 2); u32x4v a, b; a.x = ktp[0]; a.y = ktp[1]; a.z = ktp[2]; a.w = ktp[3]; b.x = ktp[4]; b.y = ktp[5]; b.z = ktp[6]; b.w = ktp[7]; dst[0] = a; dst[1] = b; }
    __syncthreads();
}
#define MFMA16(a, b, c) __builtin_amdgcn_mfma_f32_16x16x32_bf16((a), (b), (c), 0, 0, 0)
#define MFMA32(a, b, c) __builtin_amdgcn_mfma_f32_32x32x16_bf16((a), (b), (c), 0, 0, 0)
DI void hgrn_b1(const Prm& p, int item, LAS unsigned char* lds, int tid, int lane, int wave) {
    const HItem it = hgrn_item(item);
    hgrn_prep<false>(p, it, lds, tid);
    const LAS float* vec = (const LAS float*)(lds + L_VEC);
    const int fr = lane & 15, fq = lane >> 4;
    bf16x8 a[2];
#pragma unroll
    for (int ks = 0; ks < 2; ++ks) a[ks] = *(const LAS bf16x8*)(lds + L_KTT + ((16 * wave + fr) * TPI + 32 * ks + 8 * fq) * 2);
    float e2[4];
#pragma unroll
    for (int j = 0; j < 4; ++j) { const int d = 16 * wave + 4 * fq + j; e2[j] = __expf(vec[128 + d] - vec[d]); }
#pragma unroll
    for (int vt = 0; vt < 8; ++vt) { f32x4 acc = {0.f, 0.f, 0.f, 0.f};
#pragma unroll
        for (int ks = 0; ks < 2; ++ks) { const bf16x8 b = *(const LAS bf16x8*)(lds + L_IVT + ((16 * vt + fr) * TPI + 32 * ks + 8 * fq) * 2); acc = MFMA16(a[ks], b, acc); }
        u32x2 o; o.x = pk2(acc[0] * e2[0], acc[1] * e2[1]); o.y = pk2(acc[2] * e2[2], acc[3] * e2[3]);
        *(u32x2*)(p.UT + (size_t)item * 16384 + (16 * vt + fr) * 128 + 16 * wave + 4 * fq) = o; }
    if (tid < 128) p.AL[(size_t)item * 128 + tid] = __expf(vec[128 + tid]);
    __syncthreads();
}
DI void hgrn_b2(const Prm& p, int gtid, int GT) {
    for (int idx = gtid; idx < 64 * 4096; idx += GT) {
        const int bhx = idx >> 12, e = idx & 4095, v = e >> 5, d4 = (e & 31) * 4; const bool smp = bhx >= 32;
        const int item0 = smp ? 2080 + (bhx - 32) : bhx * 65, nch = smp ? 1 : 65;
        float S[4] = {0.f, 0.f, 0.f, 0.f};
        if (smp) {
#pragma unroll
            for (int j = 0; j < 4; ++j) S[j] = p.state_hgrn[((size_t)(bhx - 32) * 128 + d4 + j) * 128 + v]; }
        for (int c0 = 0; c0 < nch; c0 += 5) {
            u32x2 uu[5]; f32x4 al[5];
#pragma unroll
            for (int i = 0; i < 5; ++i) if (c0 + i < nch) { uu[i] = *(const u32x2*)(p.UT + (size_t)(item0 + c0 + i) * 16384 + v * 128 + d4); al[i] = *(const f32x4*)(p.AL + (size_t)(item0 + c0 + i) * 128 + d4); }
#pragma unroll
            for (int i = 0; i < 5; ++i) if (c0 + i < nch) { u32x2 o; o.x = pk2(S[0], S[1]); o.y = pk2(S[2], S[3]);
                *(u32x2*)(p.UT + (size_t)(item0 + c0 + i) * 16384 + v * 128 + d4) = o;
                S[0] = al[i][0] * S[0] + bflo(uu[i].x); S[1] = al[i][1] * S[1] + bfhi(uu[i].x); S[2] = al[i][2] * S[2] + bflo(uu[i].y); S[3] = al[i][3] * S[3] + bfhi(uu[i].y); } }
        float* dst = p.out + (smp ? O_HGS + (size_t)(bhx - 32) * 16384 : O_HGP + (size_t)bhx * 16384);
#pragma unroll
        for (int j = 0; j < 4; ++j) dst[(d4 + j) * 128 + v] = S[j];
    }
}
DI void hgrn_b3(const Prm& p, int item, LAS unsigned char* lds, int tid, int lane, int wave) {
    const HItem it = hgrn_item(item);
    hgrn_prep<true>(p, it, lds, tid);
    const int fr = lane & 15, fq = lane >> 4;
    {
        const int tt = wave >> 1;
#pragma unroll
        for (int i = 0; i < 2; ++i) { const int st = 2 * (wave & 1) + i; f32x4 acc = {0.f, 0.f, 0.f, 0.f};
#pragma unroll
            for (int ks = 0; ks < 4; ++ks) { const bf16x8 a = *(const LAS bf16x8*)(lds + L_KT + ((16 * st + fr) * HP + 32 * ks + 8 * fq) * 2);
                const bf16x8 b = *(const LAS bf16x8*)(lds + L_QT + ((16 * tt + fr) * HP + 32 * ks + 8 * fq) * 2); acc = MFMA16(a, b, acc); }
            const int t = 16 * tt + fr, s0 = 16 * st + 4 * fq;
            u32x2 o; o.x = pk2(s0 <= t ? acc[0] : 0.f, s0 + 1 <= t ? acc[1] : 0.f); o.y = pk2(s0 + 2 <= t ? acc[2] : 0.f, s0 + 3 <= t ? acc[3] : 0.f);
            *(LAS u32x2*)(lds + L_ATT + (t * TPI + s0) * 2) = o; }
    }
    __syncthreads();
    f32x4 oacc[4];
    {   const int tt = wave & 3;
        bf16x8 aa[2], aq[4];
#pragma unroll
        for (int ks = 0; ks < 2; ++ks) aa[ks] = *(const LAS bf16x8*)(lds + L_ATT + ((16 * tt + fr) * TPI + 32 * ks + 8 * fq) * 2);
#pragma unroll
        for (int ks = 0; ks < 4; ++ks) aq[ks] = *(const LAS bf16x8*)(lds + L_QH + ((16 * tt + fr) * HP + 32 * ks + 8 * fq) * 2);
#pragma unroll
        for (int i = 0; i < 4; ++i) { const int vt = 4 * (wave >> 2) + i; f32x4 acc = {0.f, 0.f, 0.f, 0.f};
#pragma unroll
            for (int ks = 0; ks < 2; ++ks) { const bf16x8 b = *(const LAS bf16x8*)(lds + L_IVT + ((16 * vt + fr) * TPI + 32 * ks + 8 * fq) * 2); acc = MFMA16(aa[ks], b, acc); }
#pragma unroll
            for (int ks = 0; ks < 4; ++ks) { const bf16x8 b = *(const bf16x8*)(p.UT + (size_t)item * 16384 + (16 * vt + fr) * 128 + 32 * ks + 8 * fq); acc = MFMA16(aq[ks], b, acc); }
            oacc[i] = acc; }
    }
    __syncthreads();
    {   const int tt = wave & 3; LAS float* ob = (LAS float*)(lds + L_OB);
#pragma unroll
        for (int i = 0; i < 4; ++i) { const int v = 16 * (4 * (wave >> 2) + i) + fr;
#pragma unroll
            for (int j = 0; j < 4; ++j) ob[(16 * tt + 4 * fq + j) * 132 + v] = oacc[i][j]; }
    }
    __syncthreads();
    {   const int t = tid >> 3, sg = tid & 7; const LAS float* ob = (const LAS float*)(lds + L_OB) + t * 132 + 16 * sg;
        f32x4 x[4]; float ss = 0.f;
#pragma unroll
        for (int j = 0; j < 4; ++j) { x[j] = ((const LAS f32x4*)ob)[j]; ss += (x[j].x * x[j].x + x[j].y * x[j].y) + (x[j].z * x[j].z + x[j].w * x[j].w); }
        ss += __shfl_xor(ss, 1); ss += __shfl_xor(ss, 2); ss += __shfl_xor(ss, 4);
        const float rr = rsqrtf(ss * (1.f / 128.f) + EPSN);
        if (t < it.L) { const size_t row = it.row0 + t; const int c0 = it.h * 128 + 16 * sg;
            const u32x4v g0 = *(const u32x4v*)(p.GS + row * 512 + c0), g1 = *(const u32x4v*)(p.GS + row * 512 + c0 + 8);
            const f32x4* gn = (const f32x4*)(p.hgrn_norm + 16 * sg);
            const f32x4 n0 = gn[0], n1 = gn[1], n2 = gn[2], n3 = gn[3];
            u32x4v o0, o1;
            o0.x = pk2(x[0].x * rr * n0.x * bflo(g0.x), x[0].y * rr * n0.y * bfhi(g0.x)); o0.y = pk2(x[0].z * rr * n0.z * bflo(g0.y), x[0].w * rr * n0.w * bfhi(g0.y));
            o0.z = pk2(x[1].x * rr * n1.x * bflo(g0.z), x[1].y * rr * n1.y * bfhi(g0.z)); o0.w = pk2(x[1].z * rr * n1.z * bflo(g0.w), x[1].w * rr * n1.w * bfhi(g0.w));
            o1.x = pk2(x[2].x * rr * n2.x * bflo(g1.x), x[2].y * rr * n2.y * bfhi(g1.x)); o1.y = pk2(x[2].z * rr * n2.z * bflo(g1.y), x[2].w * rr * n2.w * bfhi(g1.y));
            o1.z = pk2(x[3].x * rr * n3.x * bflo(g1.z), x[3].y * rr * n3.y * bfhi(g1.z)); o1.w = pk2(x[3].z * rr * n3.z * bflo(g1.w), x[3].w * rr * n3.w * bfhi(g1.w));
            *(u32x4v*)(p.CAT + row * 1024 + c0) = o0; *(u32x4v*)(p.CAT + row * 1024 + c0 + 8) = o1; }
    }
    __syncthreads();
}
DI void s5_load_u(const Prm& p, int mt, int g, int lane, bf16x8 (&uf)[8]) {
    const int fr = lane & 15, fq = lane >> 4; int col = 16 * mt + fr; if (col >= NCOL) col = NCOL - 1;
#pragma unroll
    for (int ks = 0; ks < 8; ++ks) uf[ks] = *(const bf16x8*)(p.U + ((size_t)(16 * col + 2 * ks + (fq >> 1))) * 512 + 16 * g + 8 * (fq & 1));
}
DI void s5_b(const Prm& p, int gw, int NGW, int lane) {
    const int fr = lane & 15, fq = lane >> 4;
    for (int task = gw; task < 131 * 32; task += NGW) { const int mt = task >> 5, g = task & 31;
        bf16x8 uf[8]; s5_load_u(p, mt, g, lane, uf);
#pragma unroll
        for (int nt = 0; nt < 8; ++nt) { f32x4 acc = {0.f, 0.f, 0.f, 0.f};
#pragma unroll
            for (int ks = 0; ks < 8; ++ks) { const bf16x8 b = *(const bf16x8*)(p.HT + ((size_t)(g * 128 + 16 * nt + fr)) * 256 + 32 * ks + 8 * fq); acc = MFMA16(uf[ks], b, acc); }
#pragma unroll
            for (int j = 0; j < 4; ++j) { const int col = 16 * mt + 4 * fq + j; if (col < NCOL) p.XLOC[(size_t)col * 4096 + g * 128 + 16 * nt + fr] = acc[j]; } }
    }
}
DI void s5_c(const Prm& p, int gtid) {
    if (gtid >= 16 * 2048) return;
    const int seq = gtid >> 11, g = (gtid >> 6) & 31, n = gtid & 63; const bool smp = seq >= 8; const int b = seq & 7;
    const int col0 = smp ? 2056 + 4 * b : 257 * b, nch = smp ? 4 : 257;
    float xr = 0.f, xi = 0.f; if (smp) { xr = p.ssm_re0[(b * 32 + g) * 64 + n]; xi = p.ssm_im0[(b * 32 + g) * 64 + n]; }
    const float ar = p.A16[2 * (g * 64 + n)], ai = p.A16[2 * (g * 64 + n) + 1];
    const size_t base = (size_t)g * 128 + 2 * n;
    for (int c0 = 0; c0 < nch; c0 += 8) {
        f32x2v xl[8];
#pragma unroll
        for (int i = 0; i < 8; ++i) if (c0 + i < nch) xl[i] = *(const f32x2v*)(p.XLOC + (size_t)(col0 + c0 + i) * 4096 + base);
#pragma unroll
        for (int i = 0; i < 8; ++i) if (c0 + i < nch) { *(unsigned*)(p.XPREV + (size_t)(col0 + c0 + i) * 4096 + base) = pk2(xr, xi);
            const float nr = ar * xr - ai * xi + xl[i].x, ni = ar * xi + ai * xr + xl[i].y; xr = nr; xi = ni; } }
    const size_t o = (size_t)(b * 32 + g) * 64 + n;
    p.out[(smp ? O_SRS : O_SRP) + o] = xr; p.out[(smp ? O_SIS : O_SIP) + o] = xi;
}
DI f32x2v gelu_pk(f32x2v v) {
    const f32x2v av = __builtin_elementwise_abs(v), d = av * 0.2316418882f + 1.0f;
    f32x2v t; t.x = __builtin_amdgcn_rcpf(d.x); t.y = __builtin_amdgcn_rcpf(d.y);
    f32x2v q = t * 0.5307027145f + (-0.7265760135f); q = q * t + 0.7107068705f; q = q * t + (-0.142248368f); q = q * t + 0.127414796f; q = q * t;
    const f32x2v s = (v * v) * (-0.72134752044f);
    f32x2v e; e.x = __builtin_amdgcn_exp2f(s.x); e.y = __builtin_amdgcn_exp2f(s.y);
    const f32x2v m = v * (q * e), r = v - m;
    f32x2v o; o.x = v.x < 0.f ? m.x : r.x; o.y = v.y < 0.f ? m.y : r.y; return o;
}
DI void s5_d(const Prm& p, int gw, int NGW, int lane) {
    const int fr = lane & 15, fq = lane >> 4;
    for (int task = gw; task < 131 * 32; task += NGW) { const int mt = task >> 5, g = task & 31;
        bf16x8 uf[8], xf[4]; s5_load_u(p, mt, g, lane, uf);
        int colc = 16 * mt + fr; if (colc >= NCOL) colc = NCOL - 1;
#pragma unroll
        for (int ks = 0; ks < 4; ++ks) xf[ks] = *(const bf16x8*)(p.XPREV + (size_t)colc * 4096 + g * 128 + 32 * ks + 8 * fq);
        const bf16_t* tg = p.TG + ((size_t)(g * 256 + fr)) * 384 + 8 * fq;
        const bool ok = 16 * mt + fr < NCOL;
#pragma unroll
        for (int t = 0; t < 16; ++t) { f32x4 acc = {0.f, 0.f, 0.f, 0.f};
#pragma unroll
            for (int ks = 0; ks < 8; ++ks) if (ks <= (t >> 1)) { const bf16x8 a = *(const bf16x8*)(tg + (size_t)t * 16 * 384 + 32 * ks); acc = MFMA16(a, uf[ks], acc); }
#pragma unroll
            for (int ks = 0; ks < 4; ++ks) { const bf16x8 a = *(const bf16x8*)(tg + (size_t)t * 16 * 384 + 256 + 32 * ks); acc = MFMA16(a, xf[ks], acc); }
            const f32x2v y0 = gelu_pk((f32x2v){acc[0], acc[1]}), y1 = gelu_pk((f32x2v){acc[2], acc[3]});
            u32x2 o; o.x = pk2(y0.x, y0.y); o.y = pk2(y1.x, y1.y);
            if (ok) *(u32x2*)(p.YG + ((size_t)(16 * (16 * mt + fr) + t)) * 512 + 16 * g + 4 * fq) = o; }
    }
}

DI void s5_b_lds(const Prm& p, LAS unsigned char* lds, int tid, int lane, int wave) {
    const int fr = lane & 15, fq = lane >> 4;
    for (int gp = blockIdx.x; gp < 256; gp += gridDim.x) { const int g = gp & 31, part = gp >> 5;
        for (int i = tid; i < 128 * 32; i += 512) { const int row = i >> 5, ch = i & 31;
            *(LAS u32x4v*)(lds + row * 528 + ch * 16) = *(const u32x4v*)(p.HT + ((size_t)(g * 128 + row)) * 256 + ch * 8); }
        __syncthreads();
        for (int mt = part + 8 * wave; mt < 131; mt += 64) {
            bf16x8 uf[8]; s5_load_u(p, mt, g, lane, uf);
#pragma unroll 1
            for (int nt = 0; nt < 8; ++nt) { f32x4 acc = {0.f, 0.f, 0.f, 0.f};
#pragma unroll
                for (int ks = 0; ks < 8; ++ks) { const bf16x8 b = *(const LAS bf16x8*)(lds + (16 * nt + fr) * 528 + 64 * ks + 16 * fq); acc = MFMA16(uf[ks], b, acc); }
#pragma unroll
                for (int j = 0; j < 4; ++j) { const int col = 16 * mt + 4 * fq + j; if (col < NCOL) p.XLOC[(size_t)col * 4096 + g * 128 + 16 * nt + fr] = acc[j]; } }
        }
        __syncthreads(); }
}
DI void s5_d_lds(const Prm& p, LAS unsigned char* lds, int tid, int lane, int wave) {
    const int fr = lane & 15, fq = lane >> 4;
    for (int gp = blockIdx.x; gp < 256; gp += gridDim.x) { const int g = gp & 31, part = gp >> 5;
        { const int row = tid >> 1, hf = tid & 1;
            *(LAS u32x4v*)(lds + row * 48 + hf * 16) = *(const u32x4v*)(p.TG + ((size_t)(g * 256 + row)) * 16 + hf * 8); }
        for (int i = tid; i < 256 * 16; i += 512) { const int row = i >> 4, ch = i & 15;
            *(LAS u32x4v*)(lds + 12288 + row * 272 + ch * 16) = *(const u32x4v*)(p.TG + 131072 + ((size_t)(g * 256 + row)) * 128 + ch * 8); }
        __syncthreads();
        const int lb = fr * 48 + (fq & 1) * 16, hi = fq >> 1;
        for (int mt = part + 8 * wave; mt < 131; mt += 64) {
            bf16x8 uf[8], xf[4]; s5_load_u(p, mt, g, lane, uf);
            int colc = 16 * mt + fr; if (colc >= NCOL) colc = NCOL - 1;
#pragma unroll
            for (int ks = 0; ks < 4; ++ks) xf[ks] = *(const bf16x8*)(p.XPREV + (size_t)colc * 4096 + g * 128 + 32 * ks + 8 * fq);
            const bool ok = 16 * mt + fr < NCOL;
#pragma unroll 1
            for (int t = 0; t < 16; ++t) { f32x4 acc = {0.f, 0.f, 0.f, 0.f};
#pragma unroll
                for (int ks = 0; ks < 8; ++ks) if (ks <= (t >> 1)) {
                    const int tau = t - 2 * ks - hi;
                    union { bf16x8 v; u32x4v u; } a; a.v = *(const LAS bf16x8*)(lds + (tau < 0 ? 0 : tau) * 768 + lb);
                    if (tau < 0) a.u = (u32x4v){0u, 0u, 0u, 0u};
                    acc = MFMA16(a.v, uf[ks], acc); }
#pragma unroll
                for (int ks = 0; ks < 4; ++ks) { const bf16x8 a = *(const LAS bf16x8*)(lds + 12288 + (t * 16 + fr) * 272 + 64 * ks + 16 * fq); acc = MFMA16(a, xf[ks], acc); }
                const f32x2v y0 = gelu_pk((f32x2v){acc[0], acc[1]}), y1 = gelu_pk((f32x2v){acc[2], acc[3]});
                u32x2 o; o.x = pk2(y0.x, y0.y); o.y = pk2(y1.x, y1.y);
                if (ok) *(u32x2*)(p.YG + ((size_t)(16 * (16 * mt + fr) + t)) * 512 + 16 * g + 4 * fq) = o; }
        }
        __syncthreads(); }
}
DI void cache_convert(const Prm& p, int gtid, int GT) {
    for (size_t i = (size_t)gtid; i < (size_t)8 * 1024 * 256; i += (size_t)GT) {
        const size_t row = i >> 8; const int c4 = (int)(i & 255) * 4, b = (int)(row >> 10), pos = (int)(row & 1023), h = c4 >> 7, d = c4 & 127;
        const f32x4 k = *(const f32x4*)(p.cache_k + row * 1024 + c4); u32x2 o; o.x = pk2(k.x, k.y); o.y = pk2(k.z, k.w);
        *(u32x2*)(p.KS + kf_index(b * 8 + h, 34, pos, d)) = o;
        const f32x4 v = *(const f32x4*)(p.cache_v + row * 1024 + c4); bf16_t* vt = p.VTS + vf_index(b * 8 + h, 34, pos, d);
        vt[0] = f2bf(v.x); vt[8] = f2bf(v.y); vt[16] = f2bf(v.z); vt[24] = f2bf(v.w); }
}
DI void attn_phase(const Prm& p, int gw, int NGW, int lane) {
    const int q = lane & 31, half = lane >> 5;
    for (int it = gw; it < 8256 + 128; it += NGW) {
        bool smp; int b, h, qb;
        if (it < 8064) { smp = false; b = it / 1008; const int rem = it - b * 1008; h = rem / 126; qb = 3 + rem - h * 126; }
        else if (it < 8192) { const int s = it - 8064; smp = true; b = s >> 4; h = (s >> 1) & 7; qb = s & 1; }
        else { const int s = it - 8192; smp = false; b = s / 24; const int rem = s - b * 24; h = rem / 3; qb = rem - h * 3; }
        const size_t tbase = (size_t)(b * 8 + h) * (smp ? 34 : 129) * 4096 + lane * 8;
        const bf16_t* Kb = (smp ? p.KS : p.KP) + tbase; const bf16_t* Vb = (smp ? p.VTS : p.VTP) + tbase;
        const int qpos0 = (smp ? 1024 : 0) + 32 * qb, qrow0 = smp ? NTP + b * 64 + 32 * qb : b * TP + 32 * qb;
        const int qpos = qpos0 + q; const bool qvalid = smp || qpos < TP; const size_t qrow = qvalid ? qrow0 + q : qrow0;
        bf16x8 qf[8];
#pragma unroll
        for (int ks = 0; ks < 8; ++ks) qf[ks] = *(const bf16x8*)(p.Q + qrow * 1024 + h * 128 + 16 * ks + 8 * half);
        f32x16 o[4];
#pragma unroll
        for (int db = 0; db < 4; ++db)
#pragma unroll
            for (int e = 0; e < 16; ++e) o[db][e] = 0.f;
        float C = 1.f;
        for (int kt = (qpos0 + 30) >> 5; kt >= 0; --kt) {
            f32x16 s;
#pragma unroll
            for (int e = 0; e < 16; ++e) s[e] = 0.f;
            const bf16_t* kr = Kb + (size_t)kt * 4096; const bf16_t* vr = Vb + (size_t)kt * 4096;
            bf16x8 kf[8], vf[8];
#pragma unroll
            for (int ks = 0; ks < 8; ++ks) kf[ks] = *(const bf16x8*)(kr + ks * 512);
#pragma unroll
            for (int ks = 0; ks < 8; ++ks) vf[ks] = *(const bf16x8*)(vr + ks * 512);
#pragma unroll
            for (int ks = 0; ks < 8; ++ks) s = MFMA32(kf[ks], qf[ks], s);
            float pr[16], be[16], G[4], Gp[4];
#pragma unroll
            for (int i = 0; i < 4; ++i) {
#pragma unroll
                for (int j = 0; j < 4; ++j) { const int key = 32 * kt + 8 * i + 4 * half + j; const bool valid = key < qpos;
                    float z = s[4 * i + j] * 0.08838834764831845f; z = fminf(fmaxf(z, -80.f), 80.f);
                    const float e = __expf(z), pp = __builtin_amdgcn_rcpf(1.f + e); pr[4 * i + j] = valid ? pp : 1.f; be[4 * i + j] = valid ? e * pp : 0.f; }
                G[i] = (pr[4 * i] * pr[4 * i + 1]) * (pr[4 * i + 2] * pr[4 * i + 3]); }
#pragma unroll
            for (int i = 0; i < 4; ++i) Gp[i] = __shfl_xor(G[i], 32);
            float w[16]; float E1 = 1.f;
#pragma unroll
            for (int i = 3; i >= 0; --i) { const float Glo = half ? Gp[i] : G[i], Ghi = half ? G[i] : Gp[i];
                float suf = C * (half ? E1 : E1 * Ghi);
#pragma unroll
                for (int j = 3; j >= 0; --j) { w[4 * i + j] = be[4 * i + j] * suf; suf *= pr[4 * i + j]; }
                E1 *= Glo * Ghi; }
            C *= E1;
#pragma unroll
            for (int c = 0; c < 2; ++c) { union { bf16x8 v; unsigned u[4]; } wf;
#pragma unroll
                for (int e = 0; e < 4; ++e) wf.u[e] = pk2(w[8 * c + 2 * e], w[8 * c + 2 * e + 1]);
#pragma unroll
                for (int db = 0; db < 4; ++db) o[db] = MFMA32(vf[4 * c + db], wf.v, o[db]); }
            if (__all(C < 1e-24f)) break;
        }
        if (qvalid) {
#pragma unroll
            for (int db = 0; db < 4; ++db)
#pragma unroll
                for (int i = 0; i < 4; ++i) { u32x2 ov; ov.x = pk2(o[db][4 * i], o[db][4 * i + 1]); ov.y = pk2(o[db][4 * i + 2], o[db][4 * i + 3]);
                    *(u32x2*)(p.O + qrow * 1024 + h * 128 + 32 * db + 8 * i + 4 * half) = ov; } }
    }
}
DI void final_norm(const Prm& p, int gw, int NGW, int lane) {
    for (int r = gw; r < 32768 + 512; r += NGW) {
        int grow; float* dst;
        if (r < 32768) { const int b = r >> 12, t = r & 4095; grow = b * TP + 16 + t; dst = p.out + O_YP + (size_t)r * 1024; } else { grow = NTP + (r - 32768); dst = p.out + O_YS + (size_t)(r - 32768) * 1024; }
        const float rr = row_rinv(p.SSQ, grow);
#pragma unroll
        for (int j = 0; j < 4; ++j) { f32x4 v = ((f32x4*)dst)[lane + 64 * j]; const f32x4 g = ((const f32x4*)p.ln_final)[lane + 64 * j]; v = v * rr * g; ((f32x4*)dst)[lane + 64 * j] = v; }
    }
}

#define XB_TMO      128
#define XB_XCNT(j)  (256  + 64 * (j))
#define XB_XSUB(j)  (1280 + 64 * (j))
#define XB_XGEN(j)  (2304 + 64 * (j))
#define XB_TOP      3328
#define XB_TOPGEN   3392
#define XCD_BAR_WORDS 3456
#define XB_SPIN_CAP (1u << 18)
DI unsigned xb_ld(unsigned* p) { return __hip_atomic_load(p, __ATOMIC_RELAXED, __HIP_MEMORY_SCOPE_AGENT); }
DI unsigned xb_add(unsigned* p, unsigned v) { return __hip_atomic_fetch_add(p, v, __ATOMIC_RELAXED, __HIP_MEMORY_SCOPE_AGENT); }
DI unsigned xb_xcc_id() { return (unsigned)__builtin_amdgcn_s_getreg((3 << 11) | 20) & 0xFu; }
#define XB_SPIN(cond, bar) do { unsigned _sp = 0; while (cond) { __builtin_amdgcn_s_sleep(1); \
    if ((++_sp & 255u) == 0u) { if (xb_ld(&(bar)[XB_TMO])) break; if (_sp > XB_SPIN_CAP) { atomicAdd(&(bar)[XB_TMO], 1u); break; } } } } while (0)
struct XcdBarrier { unsigned* bar; unsigned x; volatile LAS unsigned* st; };
DI XcdBarrier xcd_barrier_post(unsigned* bar, volatile LAS unsigned* st) {
    XcdBarrier b; b.bar = bar; b.x = xb_xcc_id(); b.st = st;
    if (threadIdx.x == 0) (void)xb_add(&bar[XB_XCNT(b.x)], 1u);
    return b;
}
DI void xcd_barrier_complete(unsigned* bar, unsigned x, unsigned& nloc, unsigned& nx) {
    const unsigned G = gridDim.x * gridDim.y * gridDim.z;
    unsigned sum, cnt, mine, sp = 0u;
    for (;;) {
        sum = 0u; cnt = 0u; mine = 0u;
#pragma unroll
        for (unsigned j = 0; j < 16; ++j) { const unsigned c = xb_ld(&bar[XB_XCNT(j)]); sum += c; cnt += (c > 0u) ? 1u : 0u; mine = (j == x) ? c : mine; }
        if (sum == G) break;
        __builtin_amdgcn_s_sleep(1);
        if ((++sp & 255u) == 0u) { if (xb_ld(&bar[XB_TMO])) break; if (sp > XB_SPIN_CAP) { atomicAdd(&bar[XB_TMO], 1u); break; } }
    }
    nloc = mine > 0u ? mine : 1u; nx = cnt > 0u ? cnt : 1u;
}
DI void xcd_barrier(const XcdBarrier& b) {
    asm volatile("s_waitcnt vmcnt(0)" ::: "memory");
    __syncthreads();
    if (threadIdx.x == 0) {
        unsigned* bar = b.bar;
        __builtin_amdgcn_s_waitcnt(0);
        unsigned nloc = b.st[0], nx = b.st[1];
        if (nloc == 0u) { xcd_barrier_complete(bar, b.x, nloc, nx); b.st[0] = nloc; b.st[1] = nx; }
        const unsigned old = xb_add(&bar[XB_XSUB(b.x)], 1u);
        const unsigned gen = old / nloc;
        if (old + 1u == (gen + 1u) * nloc) {
            __builtin_amdgcn_fence(__ATOMIC_RELEASE, "agent");
            asm volatile("s_waitcnt vmcnt(0)" ::: "memory");
            const unsigned og = xb_add(&bar[XB_TOP], 1u);
            const unsigned tg = og / nx;
            if (og + 1u == (tg + 1u) * nx) xb_add(&bar[XB_TOPGEN], 1u);
            else XB_SPIN(xb_ld(&bar[XB_TOPGEN]) == tg, bar);
            __builtin_amdgcn_fence(__ATOMIC_ACQUIRE, "agent");
            xb_add(&bar[XB_XGEN(b.x)], 1u);
            asm volatile("s_waitcnt vmcnt(0)" ::: "memory");
        } else {
            XB_SPIN(xb_ld(&bar[XB_XGEN(b.x)]) == gen, bar);
            __builtin_amdgcn_fence(__ATOMIC_ACQUIRE, "agent");
            asm volatile("s_waitcnt vmcnt(0)" ::: "memory");
        }
    }
    __syncthreads();
}
constexpr int LDS_BYTES = 131072 + 256;
__global__ void __launch_bounds__(512, 2) fwd_megakernel(Prm p) {
    extern __shared__ __attribute__((aligned(16))) unsigned char shm[];
    LAS unsigned char* lds = (LAS unsigned char*)shm;
    cg::grid_group grid = cg::this_grid();
    const int tid = threadIdx.x, lane = tid & 63, wave = __builtin_amdgcn_readfirstlane(tid >> 6);
    const int gw = blockIdx.x * 8 + wave, NGW = gridDim.x * 8, gtid = blockIdx.x * 512 + tid, GT = gridDim.x * 512;
    volatile LAS unsigned* xst = (volatile LAS unsigned*)(lds + 131072);
    if (tid == 0) { xst[0] = 0u; xst[1] = 0u; }
    __syncthreads();
    const XcdBarrier xb = xcd_barrier_post(p.BAR, xst);
    phase_prologue(p, lds, tid, lane, wave);
    grid.sync();
    { EpiIn0 E; E.SSQ = p.SSQ; E.LB = p.LB; E.Qh = p.Qh; E.IV = p.IV; E.GS = p.GS; E.U = p.U; E.LOGF = p.LOGF; run_gemm(lds, p.XB, p.Wt1, 2560, 1024, E); }
    xcd_barrier(xb);
    for (int item = blockIdx.x; item < NITEM_H; item += gridDim.x) hgrn_b1(p, item, lds, tid, lane, wave);
    s5_b_lds(p, lds, tid, lane, wave);
    xcd_barrier(xb);
    hgrn_b2(p, gtid, GT);
    s5_c(p, gtid);
    xcd_barrier(xb);
    for (int item = blockIdx.x; item < NITEM_H; item += gridDim.x) hgrn_b3(p, item, lds, tid, lane, wave);
    s5_d_lds(p, lds, tid, lane, wave);
    xcd_barrier(xb);
    { EpiGlu E; E.YG = p.YG; E.CAT = p.CAT; run_gemm(lds, p.YG, p.Wglu, 512, 512, E); }
    xcd_barrier(xb);
    { EpiRes E; E.XB = p.XB; E.SSQ = p.SSQ; run_gemm_split(lds, p.CAT, p.Wo0, 1024, 1024, E, (float*)p.H); xcd_barrier(xb); gemm_fixup(1024, 1024, E, (const float*)p.H, tid); }
    xcd_barrier(xb);
    { EpiUp E; E.SSQ = p.SSQ; E.H = p.H; run_gemm(lds, p.XB, p.Wup0, 4096, 1024, E); }
    xcd_barrier(xb);
    { EpiRes E; E.XB = p.XB; E.SSQ = p.SSQ; run_gemm_split(lds, p.H, p.Wdn0, 1024, 4096, E, (float*)p.CAT); xcd_barrier(xb); gemm_fixup(1024, 4096, E, (const float*)p.CAT, tid); }
    xcd_barrier(xb);
    { EpiQkv E; E.SSQ = p.SSQ; E.out = p.out; E.Q = p.Q; E.KP = p.KP; E.KS = p.KS; E.VTP = p.VTP; E.VTS = p.VTS; run_gemm(lds, p.XB, p.Wqkv, 3072, 1024, E); }
    if (gridDim.x > 36) { if (blockIdx.x >= 36) cache_convert(p, (blockIdx.x - 36) * 512 + tid, (gridDim.x - 36) * 512); } else cache_convert(p, gtid, GT);
    xcd_barrier(xb);
    attn_phase(p, gw, NGW, lane);
    xcd_barrier(xb);
    { EpiRes E; E.XB = p.XB; E.SSQ = p.SSQ; run_gemm_split(lds, p.O, p.Wo1, 1024, 1024, E, (float*)p.H); xcd_barrier(xb); gemm_fixup(1024, 1024, E, (const float*)p.H, tid); }
    xcd_barrier(xb);
    { EpiUp E; E.SSQ = p.SSQ; E.H = p.H; run_gemm(lds, p.XB, p.Wup1, 4096, 1024, E); }
    xcd_barrier(xb);
    { EpiFin E; E.XB = p.XB; E.SSQ = p.SSQ; E.out = p.out; run_gemm_split(lds, p.H, p.Wdn1, 1024, 4096, E, (float*)p.CAT); xcd_barrier(xb); gemm_fixup(1024, 4096, E, (const float*)p.CAT, tid); }
    xcd_barrier(xb);
    final_norm(p, gw, NGW, lane);
}

extern "C" void kernel_launch(void* const* d_in, const int* in_sizes, int n_in, void* d_out, int out_size, void* d_ws, size_t ws_size, hipStream_t stream) {
    static int grid_blocks = 0;
    if (grid_blocks == 0) {
        int dev = 0, cus = 0, per_cu = 0;
        hipGetDevice(&dev); hipDeviceGetAttribute(&cus, hipDeviceAttributeMultiprocessorCount, dev);
        if (hipFuncSetAttribute((const void*)fwd_megakernel, hipFuncAttributeMaxDynamicSharedMemorySize, LDS_BYTES) != hipSuccess) fprintf(stderr, "kernel_launch: hipFuncSetAttribute failed\n");
        if (hipOccupancyMaxActiveBlocksPerMultiprocessor(&per_cu, (const void*)fwd_megakernel, 512, LDS_BYTES) != hipSuccess || per_cu < 1) { fprintf(stderr, "kernel_launch: occupancy query says %d\n", per_cu); per_cu = 1; }
        (void)hipGetLastError();
        grid_blocks = cus > 0 ? cus : 256;
    }
    Prm p{};
    const float* const* in = (const float* const*)d_in;
    p.x_prompt = in[0]; p.x_sample = in[1]; p.state_hgrn = in[2]; p.ssm_re0 = in[3]; p.ssm_im0 = in[4]; p.cache_k = in[5]; p.cache_v = in[6]; p.meta = in[7]; p.ln_mix = in[8]; p.ln_mlp = in[9];
    p.ln_final = in[10]; p.w_in_even = in[11]; p.hgrn_lb = in[12]; p.hgrn_norm = in[13]; p.a_re = in[14]; p.a_im = in[15]; p.log_dt = in[16]; p.b_re = in[17]; p.b_im = in[18]; p.c_re = in[19];
    p.c_im = in[20]; p.ssm_d = in[21]; p.w_glu = in[22]; p.w_out_even = in[23]; p.w_in_odd = in[24]; p.w_out_odd = in[25]; p.w_up = in[26]; p.w_down = in[27];
    p.out = (float*)d_out;
    unsigned char* ws = (unsigned char*)d_ws; size_t off = 0;
    auto take = [&](size_t bytes) { unsigned char* r = ws + off; off += (bytes + 255) & ~(size_t)255; return r; };
    p.Wt1 = (bf16_t*)take((size_t)2560 * 1024 * 2); p.Wglu = (bf16_t*)take((size_t)512 * 512 * 2); p.Wo0 = (bf16_t*)take((size_t)1024 * 1024 * 2); p.Wup0 = (bf16_t*)take((size_t)4096 * 1024 * 2);
    p.Wdn0 = (bf16_t*)take((size_t)4096 * 1024 * 2); p.Wqkv = (bf16_t*)take((size_t)3072 * 1024 * 2); p.Wo1 = (bf16_t*)take((size_t)1024 * 1024 * 2); p.Wup1 = (bf16_t*)take((size_t)4096 * 1024 * 2);
    p.Wdn1 = (bf16_t*)take((size_t)4096 * 1024 * 2);
    p.XB = (bf16_t*)take((size_t)MP * 1024 * 2); p.SSQ = (float*)take((size_t)MP * 16 * 4); p.LB = (float*)take(2048); p.KTAB = (float*)take((size_t)32 * 16 * 256 * 4);
    p.TG = (bf16_t*)take((size_t)32 * 256 * 384 * 2); p.HT = (bf16_t*)take((size_t)32 * 128 * 256 * 2); p.A16 = (float*)take(32 * 64 * 2 * 4); p.BAR = (unsigned*)take(XCD_BAR_WORDS * 4);
    const size_t S0 = off; constexpr size_t SZ512 = (size_t)MP * 512 * 2;
    p.Qh = (bf16_t*)take(SZ512); p.LOGF = (unsigned short*)take(SZ512); p.IV = (bf16_t*)take(SZ512); p.GS = (bf16_t*)take(SZ512); p.U = (bf16_t*)take(SZ512);
    p.UT = (bf16_t*)take((size_t)NITEM_H * 16384 * 2); p.AL = (float*)take((size_t)NITEM_H * 128 * 4);
    p.XLOC = (float*)take(SZ512); p.YG = (bf16_t*)p.XLOC;
    p.XPREV = (bf16_t*)take((size_t)NCOL * 4096 * 2); p.CAT = (bf16_t*)take((size_t)MP * 1024 * 2);
    size_t end = off;
    off = S0; p.H = (bf16_t*)take((size_t)MP * 4096 * 2); if (off > end) end = off;
    off = S0; p.Q = (bf16_t*)take((size_t)MP * 1024 * 2); p.KP = (bf16_t*)take((size_t)64 * 129 * 4096 * 2); p.KS = (bf16_t*)take((size_t)64 * 34 * 4096 * 2);
    p.VTP = (bf16_t*)take((size_t)64 * 129 * 4096 * 2); p.VTS = (bf16_t*)take((size_t)64 * 34 * 4096 * 2); p.O = (bf16_t*)take((size_t)MP * 1024 * 2); if (off > end) end = off;
    if (end > ws_size || n_in != 28 || (size_t)out_size != O_END) { fprintf(stderr, "kernel_launch: workspace/shape mismatch: need %zu have %zu, n_in %d, out %d\n", end, ws_size, n_in, out_size); return; }
    (void)hipMemsetAsync(p.BAR, 0, XCD_BAR_WORDS * 4, stream);
    void* args[] = {&p};
    hipError_t e = hipLaunchCooperativeKernel((const void*)fwd_megakernel, dim3(grid_blocks), dim3(512), args, LDS_BYTES, stream);
    if (e != hipSuccess) fprintf(stderr, "cooperative launch failed: %s (grid %d)\n", hipGetErrorString(e), grid_blocks);
}
```

```cpp
#include <hip/hip_runtime.h>
#include <hip/hip_cooperative_groups.h>
#include <cstdio>
#include <cstdint>
namespace cg = cooperative_groups;
namespace pg8 {
#define PG8_LAS __attribute__((address_space(3)))
typedef unsigned short bf16_t;
typedef short bf16x8 __attribute__((ext_vector_type(8)));
typedef float f32x4 __attribute__((ext_vector_type(4)));
typedef unsigned u32x4 __attribute__((ext_vector_type(4)));
constexpr int BM = 256, BK = 64, HALF = 128, HTB = HALF * BK * 2  , STAGE_BYTES = 8 * HTB, NXCD = 8, WGM = 8;

__host__ __device__ __forceinline__ int lds_byte(int r, int c) { const int st = (r >> 4) * 2 + (c >> 5), rr = r & 15, cc = c & 31, ob = rr * 64 + cc * 2; return st * 1024 + (ob ^ (((ob >> 9) & 1) << 5)); }
__host__ __device__ __forceinline__ void stage_rc(int b, int& R, int& C) { const int st = b / 1024, sb = b % 1024, swz = sb ^ (((sb >> 9) & 1) << 5); R = (st >> 1) * 16 + swz / 64; C = (st & 1) * 32 + (swz % 64) / 2; }
__host__ __device__ __forceinline__ int perm32(int rho) { const int n = rho >> 4, i = rho & 15; return 8 * (i >> 2) + 4 * n + (i & 3); }

struct Unit { int pm, pn, kb, nk, part; };
struct Gemm { const bf16_t* A; const bf16_t* Bt; int M, N, K; float* part; };

struct StaticOrder {
    int nM, nN, nwg, G, c;
    __host__ __device__ void init(int M, int N, int G_, int c_) { nM = M / BM; nN = N / BM; nwg = nM * nN; G = G_; c = c_; }
    __host__ __device__ void map(int L, Unit& u) const {
        int wgid = L; { const int q = nwg / NXCD, r = nwg % NXCD, xcd = wgid % NXCD, off = wgid / NXCD; wgid = (xcd < r ? xcd * (q + 1) : r * (q + 1) + (xcd - r) * q) + off; }
        const int nig = WGM * nN, gid = wgid / nig, fm = gid * WGM, gsz = (nM - fm) < WGM ? (nM - fm) : WGM;
        u.pm = fm + ((wgid % nig) % gsz); u.pn = (wgid % nig) / gsz; u.kb = 0; u.nk = 0; u.part = -1;
    }
    __host__ __device__ bool next(int i, Unit& u) const {
        const long L = (long)i * G + c; if (L >= nwg) return false;
        map((int)L, u); return true;
    }
    __device__ __forceinline__ void a_ready(const Unit&) const {}
    __device__ __forceinline__ void done(const Unit&) const {}
};
template <class Epi, class Sched>
__device__ __forceinline__ void gemm_phase(PG8_LAS unsigned char* lds, const Gemm g, const Sched& S, const Epi& E) {
    const int tid = threadIdx.x, wid = __builtin_amdgcn_readfirstlane(tid >> 6), lane = tid & 63, wr = wid >> 2, wc = wid & 3, fr = lane & 15, fq = lane >> 4;
    const int K = g.K, nt = K / BK;
    unsigned voffA[2], voffB[2];
#pragma unroll
    for (int i = 0; i < 2; ++i) { int R, C; stage_rc(tid * 16 + i * 8192, R, C); const int Rb = Epi::PERM ? ((R & ~31) + perm32(R & 31)) : R;
        voffA[i] = (unsigned)(R * K + C) * 2u; voffB[i] = (unsigned)(Rb * K + C) * 2u; }
    const size_t kstep = (size_t)(BK * 2);
    const size_t hstep = (size_t)HALF * K * 2;
    const size_t tstep = 2 * hstep;
    const unsigned ldsw = (unsigned)wid * 1024u;
    const int aoff = lds_byte(wr * 64 + fr, fq * 8), boff = lds_byte(wc * 32 + fr, fq * 8);
#define PG8_SA(b, h) (((b) * 2 + (h)) * HTB)
#define PG8_SB(b, h) ((4 + (b) * 2 + (h)) * HTB)
#define PG8_STAGE(bufoff, gbase, voff) do { _Pragma("unroll") for (int _i = 0; _i < 2; ++_i) \
        __builtin_amdgcn_global_load_lds((const unsigned*)((const char*)(gbase) + (voff)[_i]), (PG8_LAS unsigned*)(lds + (bufoff) + ldsw + _i * 8192), 16, 0, 0); } while (0)
#define PG8_LDA(dst, b, h) do { _Pragma("unroll") for (int m = 0; m < 4; ++m) _Pragma("unroll") for (int k = 0; k < 2; ++k) dst[m][k] = *(const PG8_LAS bf16x8*)(lds + PG8_SA(b, h) + aoff + m * 2048 + k * 1024); } while (0)
#define PG8_LDB(dst, b, h) do { _Pragma("unroll") for (int n = 0; n < 2; ++n) _Pragma("unroll") for (int k = 0; k < 2; ++k) dst[n][k] = *(const PG8_LAS bf16x8*)(lds + PG8_SB(b, h) + boff + n * 2048 + k * 1024); } while (0)
#define PG8_MMA(ai, bj, At, Bt) do { __builtin_amdgcn_s_setprio(1); _Pragma("unroll") for (int m = 0; m < 4; ++m) _Pragma("unroll") for (int n = 0; n < 2; ++n) _Pragma("unroll") for (int k = 0; k < 2; ++k) \
        acc[ai][bj][m][n] = __builtin_amdgcn_mfma_f32_16x16x32_bf16(Bt[n][k], At[m][k], acc[ai][bj][m][n], 0, 0, 0); __builtin_amdgcn_s_setprio(0); } while (0)
#define PG8_WAIT_V(n) asm volatile("s_waitcnt vmcnt(" #n ")" ::: "memory")
#define PG8_WAIT_L(n) asm volatile("s_waitcnt lgkmcnt(" #n ")" ::: "memory")
#define PG8_BAR __builtin_amdgcn_s_barrier()
#define PG8_SCHED __builtin_amdgcn_sched_barrier(0)
    Unit cur, nxt; int ui = 0;
    if (!S.next(0, cur)) return;
    f32x4 acc[2][2][4][2];
#pragma unroll
    for (int a = 0; a < 2; ++a)
#pragma unroll
        for (int b = 0; b < 2; ++b)
#pragma unroll
            for (int m = 0; m < 4; ++m)
#pragma unroll
                for (int n = 0; n < 2; ++n) acc[a][b][m][n] = (f32x4){0.f, 0.f, 0.f, 0.f};
    bf16x8 At[4][2], B0[2][2], B1[2][2];
    const char* cA = (const char*)g.A + (size_t)cur.pm * tstep + (size_t)cur.kb * kstep; const char* cB = (const char*)g.Bt + (size_t)cur.pn * tstep + (size_t)cur.kb * kstep;
    S.a_ready(cur);
    PG8_STAGE(PG8_SB(0, 0), cB, voffB); PG8_STAGE(PG8_SA(0, 0), cA, voffA); PG8_STAGE(PG8_SB(0, 1), cB + hstep, voffB); PG8_STAGE(PG8_SA(0, 1), cA + hstep, voffA);
    if (wr == 1) PG8_BAR;
    PG8_WAIT_V(4); PG8_BAR;
    PG8_STAGE(PG8_SB(1, 0), cB + kstep, voffB); PG8_STAGE(PG8_SA(1, 0), cA + kstep, voffA); PG8_STAGE(PG8_SB(1, 1), cB + hstep + kstep, voffB);
    PG8_WAIT_V(6); PG8_BAR;
    for (;;) {
        const bool has_next = S.next(ui + 1, nxt);
        const char* nA = has_next ? (const char*)g.A + (size_t)nxt.pm * tstep + (size_t)nxt.kb * kstep : cA; const char* nB = has_next ? (const char*)g.Bt + (size_t)nxt.pn * tstep + (size_t)nxt.kb * kstep : cB;
        const int cnk = cur.nk ? cur.nk : nt;
        for (int t = 0; t < cnk; t += 2) {
            const bool last = (t == cnk - 2);
            const char* a1 = cA + (size_t)(t + 1) * kstep;
            const char* a2 = last ? nA : cA + (size_t)(t + 2) * kstep; const char* b2 = last ? nB : cB + (size_t)(t + 2) * kstep;
            const char* a3 = a2 + kstep; const char* b3 = b2 + kstep;
            if (last && has_next) S.a_ready(nxt);
            PG8_LDB(B0, 0, 0); PG8_SCHED; PG8_LDA(At, 0, 0); PG8_STAGE(PG8_SA(1, 1), a1 + hstep, voffA);
            PG8_WAIT_L(8); PG8_BAR; PG8_WAIT_L(0); PG8_MMA(0, 0, At, B0); PG8_BAR; PG8_SCHED;
            PG8_LDB(B1, 0, 1); PG8_STAGE(PG8_SB(0, 0), b2, voffB);
            PG8_BAR; PG8_WAIT_L(0); PG8_MMA(0, 1, At, B1); PG8_BAR;
            PG8_LDA(At, 0, 1); PG8_STAGE(PG8_SA(0, 0), a2, voffA);
            PG8_BAR; PG8_WAIT_L(0); PG8_MMA(1, 0, At, B0); PG8_BAR; PG8_SCHED;
            PG8_STAGE(PG8_SB(0, 1), b2 + hstep, voffB);
            PG8_WAIT_V(6); PG8_BAR; PG8_MMA(1, 1, At, B1); PG8_BAR;
            PG8_LDB(B0, 1, 0); PG8_SCHED; PG8_LDA(At, 1, 0); PG8_STAGE(PG8_SA(0, 1), a2 + hstep, voffA);
            PG8_WAIT_L(8); PG8_BAR; PG8_WAIT_L(0); PG8_MMA(0, 0, At, B0); PG8_BAR; PG8_SCHED;
            PG8_LDB(B1, 1, 1); PG8_STAGE(PG8_SB(1, 0), b3, voffB);
            PG8_BAR; PG8_WAIT_L(0); PG8_MMA(0, 1, At, B1); PG8_BAR;
            PG8_LDA(At, 1, 1); PG8_STAGE(PG8_SA(1, 0), a3, voffA);
            PG8_BAR; PG8_WAIT_L(0); PG8_MMA(1, 0, At, B0); PG8_BAR; PG8_SCHED;
            PG8_STAGE(PG8_SB(1, 1), b3 + hstep, voffB);
            PG8_WAIT_V(6); PG8_BAR; PG8_MMA(1, 1, At, B1); PG8_BAR;
        }
        if constexpr (!Epi::AFTER_DRAIN) {
            if (cur.part < 0) E(acc, cur, wr, wc, fr, fq);
            else { f32x4* pp = (f32x4*)g.part + (size_t)cur.part * 32 * 512 + tid;
#pragma unroll
                for (int a = 0; a < 2; ++a)
#pragma unroll
                    for (int b = 0; b < 2; ++b)
#pragma unroll
                        for (int m = 0; m < 4; ++m)
#pragma unroll
                            for (int n = 0; n < 2; ++n) pp[(size_t)(((a * 2 + b) * 4 + m) * 2 + n) * 512] = acc[a][b][m][n]; }
            S.done(cur); }
        if (!has_next) break;
#pragma unroll
        for (int a = 0; a < 2; ++a)
#pragma unroll
            for (int b = 0; b < 2; ++b)
#pragma unroll
                for (int m = 0; m < 4; ++m)
#pragma unroll
                    for (int n = 0; n < 2; ++n) acc[a][b][m][n] = (f32x4){0.f, 0.f, 0.f, 0.f};
        cur = nxt; cA = nA; cB = nB; ++ui;
    }
    PG8_WAIT_V(0);
    if (wr == 0) PG8_BAR;
    PG8_BAR;
    if constexpr (Epi::AFTER_DRAIN) { E.fused(acc, cur, wr, wc, fr, fq, lds, wid, lane); S.done(cur); }
#undef PG8_SA
#undef PG8_SB
#undef PG8_STAGE
#undef PG8_LDA
#undef PG8_LDB
#undef PG8_MMA
#undef PG8_WAIT_V
#undef PG8_WAIT_L
#undef PG8_BAR
#undef PG8_SCHED
}
}
using pg8::bf16_t; using pg8::bf16x8; using pg8::f32x4; using pg8::Unit;
typedef float f32x16 __attribute__((ext_vector_type(16)));
typedef float f32x2v __attribute__((ext_vector_type(2)));
typedef unsigned u32x2 __attribute__((ext_vector_type(2)));
typedef unsigned u32x4v __attribute__((ext_vector_type(4)));
#define LAS __attribute__((address_space(3)))
#define DI __device__ __forceinline__

constexpr int DM = 1024, TP = 4112, NTP = 8 * TP  , NTS = 512, NT = NTP + NTS  , MP = 33536  ;
constexpr int NITEM_H = 2112;
constexpr int NCOL = NT / 16;
constexpr float EPSN = 1e-6f;
constexpr size_t O_YP = 0, O_YS = O_YP + (size_t)8 * 4096 * 1024, O_HGP = O_YS + 524288, O_HGS = O_HGP + 524288, O_SRP = O_HGS + 524288, O_SIP = O_SRP + 16384,
                 O_SRS = O_SIP + 16384, O_SIS = O_SRS + 16384, O_KP = O_SIS + 16384, O_VP = O_KP + (size_t)NTP * 1024, O_KS = O_VP + (size_t)NTP * 1024, O_VS = O_KS + 524288, O_END = O_VS + 524288;

struct Prm {
    const float *x_prompt, *x_sample, *state_hgrn, *ssm_re0, *ssm_im0, *cache_k, *cache_v, *meta, *ln_mix, *ln_mlp, *ln_final, *w_in_even, *hgrn_lb, *hgrn_norm,
        *a_re, *a_im, *log_dt, *b_re, *b_im, *c_re, *c_im, *ssm_d, *w_glu, *w_out_even, *w_in_odd, *w_out_odd, *w_up, *w_down;
    float* out;
    bf16_t *Wt1, *Wglu, *Wo0, *Wup0, *Wdn0, *Wqkv, *Wo1, *Wup1, *Wdn1;
    bf16_t* XB; float* SSQ; float* LB; float* KTAB; bf16_t* TG; bf16_t* HT; float* A16;
    bf16_t *Qh, *IV, *GS, *U; unsigned short* LOGF; bf16_t* UT; float* AL; float* XLOC; bf16_t* XPREV; bf16_t* YG; bf16_t* CAT;
    bf16_t* H;
    bf16_t *Q, *KP, *KS, *VTP, *VTS, *O; unsigned* BAR;
};

DI unsigned pk2(float lo, float hi) { unsigned r; asm volatile("v_cvt_pk_bf16_f32 %0, %1, %2" : "=v"(r) : "v"(lo), "v"(hi)); return r; }
DI float bflo(unsigned u) { return __uint_as_float(u << 16); }
DI float bfhi(unsigned u) { return __uint_as_float(u & 0xffff0000u); }
DI float bf2f(unsigned short b) { return __uint_as_float(((unsigned)b) << 16); }
DI unsigned short f2bf(float f) { return (unsigned short)(pk2(f, 0.f) & 0xffffu); }
DI unsigned pkh2(float lo, float hi) { union { _Float16 h[2]; unsigned u; } x; x.h[0] = (_Float16)lo; x.h[1] = (_Float16)hi; return x.u; }
DI float h2f(unsigned short h) { union { unsigned short s; _Float16 h; } x; x.s = h; return (float)x.h; }
DI float wave_sum(float v) {
#pragma unroll
    for (int o = 1; o < 64; o <<= 1) v += __shfl_xor(v, o);
    return v;
}
DI float fexp(float x) { return __expf(x); }
DI float sigm(float x) { return __builtin_amdgcn_rcpf(1.f + __expf(-x)); }
DI float row_rinv(const float* SSQ, int row) {
    const f32x4* s = (const f32x4*)(SSQ + (size_t)row * 16); f32x4 a = s[0] + s[1] + s[2] + s[3];
    return rsqrtf(((a.x + a.y) + (a.z + a.w)) * (1.f / 1024.f) + EPSN);
}
#define LDS_WAIT() asm volatile("s_waitcnt lgkmcnt(0)" ::: "memory")

struct EpiIn0 {
    static constexpr bool PERM = false, AFTER_DRAIN = false;
    const float* SSQ; const float* LB; bf16_t *Qh, *IV, *GS, *U; unsigned short* LOGF;
    DI void operator()(const f32x4 (&acc)[2][2][4][2], const Unit& u, int wr, int wc, int fr, int fq) const {
        const int seg = u.pn >> 1, cb = (u.pn & 1) * 256 + wc * 32 + 4 * fq, row0 = u.pm * 256 + wr * 64 + fr;
        unsigned short* dst = seg == 0 ? Qh : seg == 1 ? LOGF : seg == 2 ? IV : seg == 3 ? GS : U;
#pragma unroll
        for (int ai = 0; ai < 2; ++ai)
#pragma unroll
            for (int m = 0; m < 4; ++m) { const int row = row0 + ai * 128 + m * 16; const float r = row_rinv(SSQ, row);
#pragma unroll
                for (int bj = 0; bj < 2; ++bj)
#pragma unroll
                    for (int n = 0; n < 2; ++n) { const int cs = cb + bj * 128 + n * 16; f32x4 v = acc[ai][bj][m][n] * r; u32x2 o;
                        if (seg == 1) { const f32x4 lb = *(const f32x4*)(LB + cs); f32x4 f;
#pragma unroll
                            for (int e = 0; e < 4; ++e) f[e] = __logf(lb[e] + (1.f - lb[e]) * sigm(v[e]));
                            o.x = pkh2(f[0], f[1]); o.y = pkh2(f[2], f[3]); }
                        else { if (seg == 3) {
#pragma unroll
                                for (int e = 0; e < 4; ++e) v[e] = v[e] * sigm(v[e]); }
                            o.x = pk2(v[0], v[1]); o.y = pk2(v[2], v[3]); }
                        *(u32x2*)(dst + (size_t)row * 512 + cs) = o; } }
    }
};
struct EpiGlu {
    static constexpr bool PERM = false, AFTER_DRAIN = false;
    const bf16_t* YG; bf16_t* CAT;
    DI void operator()(const f32x4 (&acc)[2][2][4][2], const Unit& u, int wr, int wc, int fr, int fq) const {
        const int cb = u.pn * 256 + wc * 32 + 4 * fq, row0 = u.pm * 256 + wr * 64 + fr;
#pragma unroll
        for (int ai = 0; ai < 2; ++ai)
#pragma unroll
            for (int m = 0; m < 4; ++m) { const int row = row0 + ai * 128 + m * 16;
#pragma unroll
                for (int bj = 0; bj < 2; ++bj)
#pragma unroll
                    for (int n = 0; n < 2; ++n) { const int cs = cb + bj * 128 + n * 16; const f32x4 v = acc[ai][bj][m][n];
                        const u32x2 y = *(const u32x2*)(YG + (size_t)row * 512 + cs); u32x2 o;
                        o.x = pk2(bflo(y.x) * sigm(v[0]), bfhi(y.x) * sigm(v[1])); o.y = pk2(bflo(y.y) * sigm(v[2]), bfhi(y.y) * sigm(v[3]));
                        *(u32x2*)(CAT + (size_t)row * 1024 + 512 + cs) = o; } }
    }
};
struct EpiRes {
    static constexpr bool PERM = false, AFTER_DRAIN = false;
    bf16_t* XB; float* SSQ;
    DI void row(const f32x4 (&a4)[2][2], const Unit& u, int ai, int m, int wr, int wc, int fr, int fq) const {
        const int cb = u.pn * 256 + wc * 32 + 4 * fq, row = u.pm * 256 + wr * 64 + fr + ai * 128 + m * 16; float ss = 0.f;
#pragma unroll
        for (int bj = 0; bj < 2; ++bj)
#pragma unroll
            for (int n = 0; n < 2; ++n) { const int cs = cb + bj * 128 + n * 16; const f32x4 v = a4[bj][n];
                u32x2* px = (u32x2*)(XB + (size_t)row * 1024 + cs); const u32x2 x = *px; u32x2 o;
                o.x = pk2(bflo(x.x) + v[0], bfhi(x.x) + v[1]); o.y = pk2(bflo(x.y) + v[2], bfhi(x.y) + v[3]); *px = o;
                const float a0 = bflo(o.x), a1 = bfhi(o.x), a2 = bflo(o.y), a3 = bfhi(o.y); ss += (a0 * a0 + a1 * a1) + (a2 * a2 + a3 * a3); }
        ss += __shfl_xor(ss, 16); ss += __shfl_xor(ss, 32);
        if (fq == 0) SSQ[(size_t)row * 16 + u.pn * 4 + wc] = ss;
    }
    DI void operator()(const f32x4 (&acc)[2][2][4][2], const Unit& u, int wr, int wc, int fr, int fq) const {
#pragma unroll
        for (int ai = 0; ai < 2; ++ai)
#pragma unroll
            for (int m = 0; m < 4; ++m) { const f32x4 a4[2][2] = {{acc[ai][0][m][0], acc[ai][0][m][1]}, {acc[ai][1][m][0], acc[ai][1][m][1]}}; row(a4, u, ai, m, wr, wc, fr, fq); }
    }
};
struct EpiUp {
    static constexpr bool PERM = false, AFTER_DRAIN = false;
    const float* SSQ; bf16_t* H;
    DI void operator()(const f32x4 (&acc)[2][2][4][2], const Unit& u, int wr, int wc, int fr, int fq) const {
        const int cb = u.pn * 256 + wc * 32 + 4 * fq, row0 = u.pm * 256 + wr * 64 + fr;
#pragma unroll
        for (int ai = 0; ai < 2; ++ai)
#pragma unroll
            for (int m = 0; m < 4; ++m) { const int row = row0 + ai * 128 + m * 16; const float r = row_rinv(SSQ, row);
#pragma unroll
                for (int bj = 0; bj < 2; ++bj)
#pragma unroll
                    for (int n = 0; n < 2; ++n) { const int cs = cb + bj * 128 + n * 16; f32x4 v = acc[ai][bj][m][n] * r;
#pragma unroll
                        for (int e = 0; e < 4; ++e) { const float t = fmaxf(v[e], 0.f); v[e] = t * t; }
                        u32x2 o; o.x = pk2(v[0], v[1]); o.y = pk2(v[2], v[3]); *(u32x2*)(H + (size_t)row * 4096 + cs) = o; } }
    }
};
DI size_t kf_index(int seqh, int nkt, int key, int d) { return ((((size_t)seqh * nkt + (key >> 5)) * 8 + (d >> 4)) * 64 + ((key & 31) + 32 * ((d >> 3) & 1))) * 8 + (d & 7); }
DI size_t vf_index(int seqh, int nkt, int key, int d) { const int kk = key & 31;
    return ((((size_t)seqh * nkt + (key >> 5)) * 8 + (kk >> 4) * 4 + (d >> 5)) * 64 + ((d & 31) + 32 * ((kk >> 2) & 1))) * 8 + ((kk >> 3) & 1) * 4 + (kk & 3); }
struct EpiQkv {
    static constexpr bool PERM = false, AFTER_DRAIN = false;
    const float* SSQ; float* out; bf16_t *Q, *KP, *KS, *VTP, *VTS;
    DI void operator()(const f32x4 (&acc)[2][2][4][2], const Unit& u, int wr, int wc, int fr, int fq) const {
        const int third = u.pn >> 2, cb = (u.pn & 3) * 256 + wc * 32 + 4 * fq, row0 = u.pm * 256 + wr * 64 + fr;
#pragma unroll
        for (int ai = 0; ai < 2; ++ai)
#pragma unroll
            for (int m = 0; m < 4; ++m) { const int row = row0 + ai * 128 + m * 16; const float r = row_rinv(SSQ, row);
                const bool smp = row >= NTP; const int s = row - NTP; const int b = smp ? (s >> 6) : row / TP, key = smp ? 1024 + (s & 63) : row - b * TP, nkt = smp ? 34 : 129;
#pragma unroll
                for (int bj = 0; bj < 2; ++bj)
#pragma unroll
                    for (int n = 0; n < 2; ++n) { const int cs = cb + bj * 128 + n * 16; const f32x4 v = acc[ai][bj][m][n] * r;
                        u32x2 o; o.x = pk2(v[0], v[1]); o.y = pk2(v[2], v[3]);
                        if (third == 0) { *(u32x2*)(Q + (size_t)row * 1024 + cs) = o; }
                        else if (row < NT) { const int h = cs >> 7, d = cs & 127;
                            if (third == 1) { *(f32x4*)(out + (smp ? O_KS + (size_t)s * 1024 : O_KP + (size_t)row * 1024) + cs) = v;
                                *(u32x2*)((smp ? KS : KP) + kf_index(b * 8 + h, nkt, key, d)) = o; }
                            else { *(f32x4*)(out + (smp ? O_VS + (size_t)s * 1024 : O_VP + (size_t)row * 1024) + cs) = v;
                                bf16_t* vt = (smp ? VTS : VTP) + vf_index(b * 8 + h, nkt, key, d);
                                vt[0] = (bf16_t)(o.x & 0xffffu); vt[8] = (bf16_t)(o.x >> 16); vt[16] = (bf16_t)(o.y & 0xffffu); vt[24] = (bf16_t)(o.y >> 16); } } } }
    }
};
struct EpiFin {
    static constexpr bool PERM = false, AFTER_DRAIN = false;
    const bf16_t* XB; float* SSQ; float* out;
    DI void row(const f32x4 (&a4)[2][2], const Unit& u, int ai, int m, int wr, int wc, int fr, int fq) const {
        const int cb = u.pn * 256 + wc * 32 + 4 * fq, row = u.pm * 256 + wr * 64 + fr + ai * 128 + m * 16; float ss = 0.f;
        const int b = row / TP, t = row - b * TP; const bool ok = row < NT && (row >= NTP || t >= 16);
        float* dst = out + (row >= NTP ? O_YS + (size_t)(row - NTP) * 1024 : O_YP + ((size_t)b * 4096 + (t - 16)) * 1024);
#pragma unroll
        for (int bj = 0; bj < 2; ++bj)
#pragma unroll
            for (int n = 0; n < 2; ++n) { const int cs = cb + bj * 128 + n * 16; f32x4 v = a4[bj][n];
                const u32x2 x = *(const u32x2*)(XB + (size_t)row * 1024 + cs);
                v[0] += bflo(x.x); v[1] += bfhi(x.x); v[2] += bflo(x.y); v[3] += bfhi(x.y);
                if (ok) *(f32x4*)(dst + cs) = v;
                ss += (v[0] * v[0] + v[1] * v[1]) + (v[2] * v[2] + v[3] * v[3]); }
        ss += __shfl_xor(ss, 16); ss += __shfl_xor(ss, 32);
        if (fq == 0) SSQ[(size_t)row * 16 + u.pn * 4 + wc] = ss;
    }
    DI void operator()(const f32x4 (&acc)[2][2][4][2], const Unit& u, int wr, int wc, int fr, int fq) const {
#pragma unroll
        for (int ai = 0; ai < 2; ++ai)
#pragma unroll
            for (int m = 0; m < 4; ++m) { const f32x4 a4[2][2] = {{acc[ai][0][m][0], acc[ai][0][m][1]}, {acc[ai][1][m][0], acc[ai][1][m][1]}}; row(a4, u, ai, m, wr, wc, fr, fq); }
    }
};
template <class Epi> DI void run_gemm(LAS unsigned char* lds, const bf16_t* A, const bf16_t* Bt, int N, int K, const Epi& E) {
    pg8::Gemm g; g.A = A; g.Bt = Bt; g.M = MP; g.N = N; g.K = K; g.part = nullptr;
    pg8::StaticOrder S; S.init(MP, N, (int)gridDim.x, (int)blockIdx.x);
    pg8::gemm_phase<Epi, pg8::StaticOrder>(lds, g, S, E);
}
struct SplitOrder : pg8::StaticOrder {
    int nwhole, ntail, S, nks;
    DI void init2(int N, int K) { init(MP, N, (int)gridDim.x, (int)blockIdx.x); nwhole = nwg / G; ntail = nwg - nwhole * G; S = 0; nks = 0;
        if (ntail > 0) { int s = G / ntail; const int nkt = K / 64; while (s > 1 && (nkt % s != 0 || (nkt / s) < 4 || ((nkt / s) & 1))) --s; if (s > 1) { S = s; nks = nkt / s; } } }
    DI bool next(int i, Unit& u) const {
        if (S == 0) return pg8::StaticOrder::next(i, u);
        if (i < nwhole) { map(i * G + c, u); return true; }
        if (i == nwhole && c < ntail * S) { map(nwhole * G + c / S, u); u.kb = (c % S) * nks; u.nk = nks; u.part = c; return true; }
        return false;
    }
};
template <class Epi> DI void run_gemm_split(LAS unsigned char* lds, const bf16_t* A, const bf16_t* Bt, int N, int K, const Epi& E, float* part) {
    pg8::Gemm g; g.A = A; g.Bt = Bt; g.M = MP; g.N = N; g.K = K; g.part = part;
    SplitOrder S; S.init2(N, K);
    pg8::gemm_phase<Epi, SplitOrder>(lds, g, S, E);
}
template <class Epi> DI void gemm_fixup(int N, int K, const Epi& E, const float* part, int tid) {
    SplitOrder S; S.init2(N, K); if (S.S == 0) return;
    const int wid = tid >> 6, lane = tid & 63, wr = wid >> 2, wc = wid & 3, fr = lane & 15, fq = lane >> 4;
    for (int it = blockIdx.x; it < S.ntail * 8; it += gridDim.x) { const int j = it >> 3, ai = (it >> 2) & 1, m = it & 3; Unit u; S.map(S.nwhole * S.G + j, u);
        f32x4 a4[2][2];
#pragma unroll
        for (int b = 0; b < 2; ++b)
#pragma unroll
            for (int n = 0; n < 2; ++n) { const f32x4* pp = (const f32x4*)part + ((size_t)(j * S.S) * 32 + (((ai * 2 + b) * 4 + m) * 2 + n)) * 512 + tid;
                f32x4 v0 = {0.f, 0.f, 0.f, 0.f}, v1 = v0, v2 = v0, v3 = v0;
                for (int sl = 0; sl + 3 < S.S; sl += 4) { v0 += pp[(size_t)sl * 16384]; v1 += pp[(size_t)(sl + 1) * 16384]; v2 += pp[(size_t)(sl + 2) * 16384]; v3 += pp[(size_t)(sl + 3) * 16384]; }
                for (int sl = S.S & ~3; sl < S.S; ++sl) v0 += pp[(size_t)sl * 16384];
                a4[b][n] = (v0 + v1) + (v2 + v3); }
        E.row(a4, u, ai, m, wr, wc, fr, fq); }
}
DI void transpose_item(const float* W, int N, bf16_t* WT, size_t ldo, const float* sc, LAS float* scr, int item, int lane) {
    const int nblk = N / 32, kb = item / nblk, nb = item % nblk, k0 = 64 * kb, n0 = 32 * nb;
#pragma unroll 8
    for (int i = 0; i < 32; ++i) { const int kk = 2 * i + (lane >> 5); float w = W[(size_t)(k0 + kk) * N + n0 + (lane & 31)]; if (sc) w *= sc[k0 + kk]; scr[kk * 33 + (lane & 31)] = w; }
    LDS_WAIT();
    const int c = lane & 7;
#pragma unroll
    for (int j = 0; j < 4; ++j) { const int n = (lane >> 3) + 8 * j; const LAS float* s = scr + (8 * c) * 33 + n;
        u32x4v o; o.x = pk2(s[0 * 33], s[1 * 33]); o.y = pk2(s[2 * 33], s[3 * 33]); o.z = pk2(s[4 * 33], s[5 * 33]); o.w = pk2(s[6 * 33], s[7 * 33]);
        *(u32x4v*)(WT + (size_t)(n0 + n) * ldo + k0 + 8 * c) = o; }
    LDS_WAIT();
}
DI void s5_pow(const Prm& p, int g, int n, float k, float& re, float& im) {
    const float dt = __expf(p.log_dt[g]), ar = p.a_re[g * 64 + n], ai = p.a_im[g * 64 + n];
    const float mag = __expf(k * dt * ar); float rev = k * dt * ai * 0.15915494309189535f; rev -= rintf(rev);
    re = mag * __builtin_amdgcn_cosf(rev); im = mag * __builtin_amdgcn_sinf(rev);
}
DI void s5_bbar(const Prm& p, int g, int n, int pp, float& re, float& im) {
    const float ar = p.a_re[g * 64 + n], ai = p.a_im[g * 64 + n]; float abr, abi; s5_pow(p, g, n, 1.f, abr, abi);
    const float den = ar * ar + ai * ai, zr = ((abr - 1.f) * ar + abi * ai) / den, zi = (abi * ar - (abr - 1.f) * ai) / den;
    const float br = p.b_re[(g * 64 + n) * 16 + pp], bi = p.b_im[(g * 64 + n) * 16 + pp];
    re = zr * br - zi * bi; im = zr * bi + zi * br;
}
DI void phase_prologue(const Prm& p, LAS unsigned char* lds, int tid, int lane, int wave) {
    const int gw = blockIdx.x * 8 + wave, NGW = gridDim.x * 8, gtid = blockIdx.x * 512 + tid, GT = gridDim.x * 512;
    LAS float* scr = (LAS float*)(lds + wave * 16384);
    constexpr int I1 = 16 * 80, I2 = 8 * 16, I3 = 16 * 32, I4 = 16 * 128, I5 = 64 * 32, I6 = 16 * 96;
    constexpr int NITEMS = I1 + I2 + I3 + I4 + I5 + I6 + I3 + I4 + I5;
    for (int it = gw; it < NITEMS; it += NGW) {
        int r = it;
        if (r < I1) { transpose_item(p.w_in_even, 2560, p.Wt1, 1024, p.ln_mix, scr, r, lane); continue; } r -= I1;
        if (r < I2) { transpose_item(p.w_glu, 512, p.Wglu, 512, nullptr, scr, r, lane); continue; } r -= I2;
        if (r < I3) { transpose_item(p.w_out_even, 1024, p.Wo0, 1024, nullptr, scr, r, lane); continue; } r -= I3;
        if (r < I4) { transpose_item(p.w_up, 4096, p.Wup0, 1024, p.ln_mlp, scr, r, lane); continue; } r -= I4;
        if (r < I5) { transpose_item(p.w_down, 1024, p.Wdn0, 4096, nullptr, scr, r, lane); continue; } r -= I5;
        if (r < I6) { transpose_item(p.w_in_odd, 3072, p.Wqkv, 1024, p.ln_mix + 1024, scr, r, lane); continue; } r -= I6;
        if (r < I3) { transpose_item(p.w_out_odd, 1024, p.Wo1, 1024, nullptr, scr, r, lane); continue; } r -= I3;
        if (r < I4) { transpose_item(p.w_up + (size_t)1024 * 4096, 4096, p.Wup1, 1024, p.ln_mlp + 1024, scr, r, lane); continue; } r -= I4;
        transpose_item(p.w_down + (size_t)4096 * 1024, 1024, p.Wdn1, 4096, nullptr, scr, r, lane);
    }
    for (int row = gw; row < NT; row += NGW) {
        const float* src;
        if (row < NTP) { const int b = row / TP, t = row - b * TP; src = t < 16 ? p.meta + (size_t)t * 1024 : p.x_prompt + ((size_t)b * 4096 + (t - 16)) * 1024; }
        else src = p.x_sample + (size_t)(row - NTP) * 1024;
        float ss = 0.f;
#pragma unroll
        for (int j = 0; j < 4; ++j) { const f32x4 v = ((const f32x4*)src)[lane + 64 * j]; u32x2 o; o.x = pk2(v.x, v.y); o.y = pk2(v.z, v.w);
            const float a0 = bflo(o.x), a1 = bfhi(o.x), a2 = bflo(o.y), a3 = bfhi(o.y); ss += (a0 * a0 + a1 * a1) + (a2 * a2 + a3 * a3);
            ((u32x2*)(p.XB + (size_t)row * 1024))[lane + 64 * j] = o; }
        ss = wave_sum(ss);
        if (lane < 16) p.SSQ[(size_t)row * 16 + lane] = lane == 0 ? ss : 0.f;
    }
    if (gtid < 512) p.LB[gtid] = 1.f / (1.f + __expf(p.hgrn_lb[512 + gtid] - p.hgrn_lb[gtid]));
    __syncthreads();
    {
        LAS float* zr_ = (LAS float*)lds; LAS float* zi_ = zr_ + 64; LAS float* wr_ = zi_ + 64; LAS float* wi_ = wr_ + 64;
        LAS float* bbr = wi_ + 64; LAS float* bbi = bbr + 1024; LAS float* cwr = bbi + 1024; LAS float* cwi = cwr + 16 * 65;
        for (int pair = blockIdx.x; pair < 512; pair += gridDim.x) { const int g = pair >> 4, tau = pair & 15;
            if (tid < 64) { const int n = tid; const float ar = p.a_re[g * 64 + n], ai = p.a_im[g * 64 + n]; float abr, abi; s5_pow(p, g, n, 1.f, abr, abi);
                const float den = ar * ar + ai * ai; zr_[n] = ((abr - 1.f) * ar + abi * ai) / den; zi_[n] = (abi * ar - (abr - 1.f) * ai) / den;
                float a, b; s5_pow(p, g, n, (float)tau, a, b); wr_[n] = a; wi_[n] = b; }
            __syncthreads();
#pragma unroll
            for (int k = 0; k < 2; ++k) { const int e = tid + 512 * k;
                { const int n = e >> 4; const float br = p.b_re[g * 1024 + e], bi = p.b_im[g * 1024 + e]; bbr[e] = zr_[n] * br - zi_[n] * bi; bbi[e] = zr_[n] * bi + zi_[n] * br; }
                { const int pch = e >> 6, n = e & 63; const float cr = p.c_re[g * 1024 + e], ci = p.c_im[g * 1024 + e]; cwr[pch * 65 + n] = cr * wr_[n] - ci * wi_[n]; cwi[pch * 65 + n] = cr * wi_[n] + ci * wr_[n]; } }
            __syncthreads();
            if (tid < 256) { const int pch = tid >> 4, pp = tid & 15; float acc = 0.f;
#pragma unroll 8
                for (int n = 0; n < 64; ++n) acc += cwr[pch * 65 + n] * bbr[n * 16 + pp] - cwi[pch * 65 + n] * bbi[n * 16 + pp];
                if (tau == 0 && pch == pp) acc += p.ssm_d[g * 16 + pch];
                const bf16_t kv = f2bf(acc);
                p.TG[((g * 16 + tau) * 16 + pch) * 16 + pp] = kv; }
            __syncthreads(); }
    }
    for (int i = gtid; i < 32 * 256 * 64; i += GT) {
        const int g = i >> 14, t = (i >> 10) & 15, pch = (i >> 6) & 15, n = i & 63; float wr_, wi_; s5_pow(p, g, n, (float)(t + 1), wr_, wi_);
        const float cr = p.c_re[(g * 16 + pch) * 64 + n], ci = p.c_im[(g * 16 + pch) * 64 + n];
        *(unsigned*)(p.TG + 131072 + ((size_t)(g * 256 + t * 16 + pch)) * 128 + 2 * n) = pk2(cr * wr_ - ci * wi_, -(cr * wi_ + ci * wr_)); }
    for (int i = gtid; i < 32 * 64 * 256; i += GT) {
        const int g = i >> 14, n = (i >> 8) & 63, s = (i >> 4) & 15, pp = i & 15; float wr_, wi_, br_, bi_; s5_pow(p, g, n, (float)(15 - s), wr_, wi_); s5_bbar(p, g, n, pp, br_, bi_);
        p.HT[((size_t)(g * 128 + 2 * n)) * 256 + s * 16 + pp] = f2bf(wr_ * br_ - wi_ * bi_);
        p.HT[((size_t)(g * 128 + 2 * n + 1)) * 256 + s * 16 + pp] = f2bf(wr_ * bi_ + wi_ * br_); }
    if (gtid < 2048) { float wr_, wi_; s5_pow(p, gtid >> 6, gtid & 63, 16.f, wr_, wi_); p.A16[2 * gtid] = wr_; p.A16[2 * gtid + 1] = wi_; }
}

constexpr int HP = 136, TPI = 72;
constexpr int L_QT = 0, L_QH = 17408, L_KT = 34816, L_KTT = 52224, L_IVT = 70656, L_ATT = 89088, L_SUM = 98304, L_VEC = 100352, L_OB = 0  ;
struct HItem { int row0, L, h, bh; };
DI HItem hgrn_item(int item) {
    HItem it;
    if (item < 2080) { const int bh = item / 65, c = item - bh * 65, b = bh >> 2; it.h = bh & 3; it.bh = bh; it.L = c == 0 ? 16 : 64; it.row0 = b * TP + (c == 0 ? 0 : 16 + 64 * (c - 1)); }
    else { const int s = item - 2080, b = s >> 2; it.h = s & 3; it.bh = 32 + s; it.L = 64; it.row0 = NTP + b * 64; }
    return it;
}
template <bool FULL> DI void hgrn_loadraw(const Prm& p, const HItem& it, int tid, unsigned (&rl)[16], unsigned (&rv)[16], unsigned (&rq)[16]) {
    const int d = tid & 127, t0 = 16 * (tid >> 7), col = it.h * 128 + d;
#pragma unroll
    for (int j = 0; j < 16; ++j) { const int t = t0 + j; const bool valid = t < it.L; const size_t o = (size_t)(it.row0 + t) * 512 + col;
        rl[j] = valid ? (unsigned)p.LOGF[o] : 0u; rv[j] = valid ? (unsigned)p.IV[o] : 0u; if (FULL) rq[j] = valid ? (unsigned)p.Qh[o] : 0u; }
}
template <bool FULL> DI void hgrn_prep(const HItem& it, LAS unsigned char* lds, int tid, const unsigned (&rl)[16], const unsigned (&rv)[16], const unsigned (&rq)[16]) {
    const int d = tid & 127, tq = tid >> 7, t0 = 16 * tq;
    LAS float* sums = (LAS float*)(lds + L_SUM); LAS float* vec = (LAS float*)(lds + L_VEC);
    float cs[16], lf[16];
    float run = 0.f;
#pragma unroll
    for (int j = 0; j < 16; ++j) { lf[j] = h2f((unsigned short)rl[j]); run += lf[j]; cs[j] = run; }
    sums[tq * 128 + d] = run;
    { LAS u32x4v* dst = (LAS u32x4v*)(lds + L_IVT + (d * TPI + t0) * 2); u32x4v a, b;
        a.x = rv[0] | (rv[1] << 16); a.y = rv[2] | (rv[3] << 16); a.z = rv[4] | (rv[5] << 16); a.w = rv[6] | (rv[7] << 16);
        b.x = rv[8] | (rv[9] << 16); b.y = rv[10] | (rv[11] << 16); b.z = rv[12] | (rv[13] << 16); b.w = rv[14] | (rv[15] << 16); dst[0] = a; dst[1] = b; }
    __syncthreads();
    const float s0 = sums[d], s1 = sums[128 + d], s2 = sums[256 + d], s3 = sums[384 + d];
    const float off = tq == 0 ? 0.f : tq == 1 ? s0 : tq == 2 ? s0 + s1 : s0 + s1 + s2, r = s0 + s1, bL = r + s2 + s3;
    if (tq == 0) { vec[d] = r; vec[128 + d] = bL; }
    unsigned ktp[8]; float kprev = 0.f;
#pragma unroll
    for (int j = 0; j < 16; ++j) { const int t = t0 + j; const bool valid = t < it.L; const float b = off + cs[j];
        const float kt = valid ? (1.f - __expf(lf[j])) * __expf(r - b) : 0.f;
        if (j & 1) ktp[j >> 1] = pk2(kprev, kt); else kprev = kt;
        if (FULL) { const float qv = bf2f((unsigned short)rq[j]);
            *(LAS unsigned short*)(lds + L_KT + (t * HP + d) * 2) = f2bf(kt);
            *(LAS unsigned short*)(lds + L_QT + (t * HP + d) * 2) = f2bf(qv * __expf(b - r));
            *(LAS unsigned short*)(lds + L_QH + (t * HP + d) * 2) = f2bf(qv * __expf(b)); } }
    if (!FULL) { LAS u32x4v* dst = (LAS u32x4v*)(lds + L_KTT + (d * TPI + t0) * 2); u32x4v a, b; a.x = ktp[0]; a.y = ktp[1]; a.z = ktp[2]; a.w = ktp[3]; b.x = ktp[4]; b.y = ktp[5]; b.z = ktp[6]; b.w = ktp[7]; dst[0] = a; dst[1] = b; }
    __syncthreads();
}
#define MFMA16(a, b, c) __builtin_amdgcn_mfma_f32_16x16x32_bf16((a), (b), (c), 0, 0, 0)
#define MFMA32(a, b, c) __builtin_amdgcn_mfma_f32_32x32x16_bf16((a), (b), (c), 0, 0, 0)
DI void hgrn_b1_all(const Prm& p, LAS unsigned char* lds, int tid, int lane, int wave) {
    const int fr = lane & 15, fq = lane >> 4;
    int item = blockIdx.x; if (item >= NITEM_H) return;
    unsigned rl[16], rv[16], rq[16];
    hgrn_loadraw<false>(p, hgrn_item(item), tid, rl, rv, rq);
    while (item < NITEM_H) {
        const HItem it = hgrn_item(item);
        hgrn_prep<false>(it, lds, tid, rl, rv, rq);
        const int next = item + gridDim.x;
        if (next < NITEM_H) hgrn_loadraw<false>(p, hgrn_item(next), tid, rl, rv, rq);
        const LAS float* vec = (const LAS float*)(lds + L_VEC);
        bf16x8 a[2];
#pragma unroll
        for (int ks = 0; ks < 2; ++ks) a[ks] = *(const LAS bf16x8*)(lds + L_KTT + ((16 * wave + fr) * TPI + 32 * ks + 8 * fq) * 2);
        float e2[4];
#pragma unroll
        for (int j = 0; j < 4; ++j) { const int d = 16 * wave + 4 * fq + j; e2[j] = __expf(vec[128 + d] - vec[d]); }
#pragma unroll
        for (int vt = 0; vt < 8; ++vt) { f32x4 acc = {0.f, 0.f, 0.f, 0.f};
#pragma unroll
            for (int ks = 0; ks < 2; ++ks) { const bf16x8 b = *(const LAS bf16x8*)(lds + L_IVT + ((16 * vt + fr) * TPI + 32 * ks + 8 * fq) * 2); acc = MFMA16(a[ks], b, acc); }
            u32x2 o; o.x = pk2(acc[0] * e2[0], acc[1] * e2[1]); o.y = pk2(acc[2] * e2[2], acc[3] * e2[3]);
            *(u32x2*)(p.UT + (size_t)item * 16384 + (16 * vt + fr) * 128 + 16 * wave + 4 * fq) = o; }
        if (tid < 128) p.AL[(size_t)item * 128 + tid] = __expf(vec[128 + tid]);
        __syncthreads();
        item = next;
    }
}
DI void hgrn_b2(const Prm& p, int gtid, int GT) {
    for (int idx = gtid; idx < 64 * 4096; idx += GT) {
        const int bhx = idx >> 12, e = idx & 4095, v = e >> 5, d4 = (e & 31) * 4; const bool smp = bhx >= 32;
        const int item0 = smp ? 2080 + (bhx - 32) : bhx * 65, nch = smp ? 1 : 65;
        float S[4] = {0.f, 0.f, 0.f, 0.f};
        if (smp) {
#pragma unroll
            for (int j = 0; j < 4; ++j) S[j] = p.state_hgrn[((size_t)(bhx - 32) * 128 + d4 + j) * 128 + v]; }
        for (int c0 = 0; c0 < nch; c0 += 5) {
            u32x2 uu[5]; f32x4 al[5];
#pragma unroll
            for (int i = 0; i < 5; ++i) if (c0 + i < nch) { uu[i] = *(const u32x2*)(p.UT + (size_t)(item0 + c0 + i) * 16384 + v * 128 + d4); al[i] = *(const f32x4*)(p.AL + (size_t)(item0 + c0 + i) * 128 + d4); }
#pragma unroll
            for (int i = 0; i < 5; ++i) if (c0 + i < nch) { u32x2 o; o.x = pk2(S[0], S[1]); o.y = pk2(S[2], S[3]);
                *(u32x2*)(p.UT + (size_t)(item0 + c0 + i) * 16384 + v * 128 + d4) = o;
                S[0] = al[i][0] * S[0] + bflo(uu[i].x); S[1] = al[i][1] * S[1] + bfhi(uu[i].x); S[2] = al[i][2] * S[2] + bflo(uu[i].y); S[3] = al[i][3] * S[3] + bfhi(uu[i].y); } }
        float* dst = p.out + (smp ? O_HGS + (size_t)(bhx - 32) * 16384 : O_HGP + (size_t)bhx * 16384);
#pragma unroll
        for (int j = 0; j < 4; ++j) dst[(d4 + j) * 128 + v] = S[j];
    }
}
DI void hgrn_b3_all(const Prm& p, LAS unsigned char* lds, int tid, int lane, int wave) {
    const int fr = lane & 15, fq = lane >> 4;
    int item = blockIdx.x; if (item >= NITEM_H) return;
    unsigned rl[16], rv[16], rq[16];
    hgrn_loadraw<true>(p, hgrn_item(item), tid, rl, rv, rq);
    const int nt_ = tid >> 3, nsg = tid & 7;
    while (item < NITEM_H) {
        const HItem it = hgrn_item(item);
        bf16x8 sf[4][4];
#pragma unroll
        for (int i = 0; i < 4; ++i)
#pragma unroll
            for (int ks = 0; ks < 4; ++ks) sf[i][ks] = *(const bf16x8*)(p.UT + (size_t)item * 16384 + (16 * (4 * (wave >> 2) + i) + fr) * 128 + 32 * ks + 8 * fq);
        const size_t grow = (size_t)(it.row0 + (nt_ < it.L ? nt_ : 0)); const int gc0 = it.h * 128 + 16 * nsg;
        const u32x4v g0 = *(const u32x4v*)(p.GS + grow * 512 + gc0), g1 = *(const u32x4v*)(p.GS + grow * 512 + gc0 + 8);
        hgrn_prep<true>(it, lds, tid, rl, rv, rq);
        const int next = item + gridDim.x;
        if (next < NITEM_H) hgrn_loadraw<true>(p, hgrn_item(next), tid, rl, rv, rq);
        {
            const int tt = wave >> 1;
#pragma unroll
            for (int i = 0; i < 2; ++i) { const int st = 2 * (wave & 1) + i; f32x4 acc = {0.f, 0.f, 0.f, 0.f};
#pragma unroll
                for (int ks = 0; ks < 4; ++ks) { const bf16x8 a = *(const LAS bf16x8*)(lds + L_KT + ((16 * st + fr) * HP + 32 * ks + 8 * fq) * 2);
                    const bf16x8 b = *(const LAS bf16x8*)(lds + L_QT + ((16 * tt + fr) * HP + 32 * ks + 8 * fq) * 2); acc = MFMA16(a, b, acc); }
                const int t = 16 * tt + fr, s0 = 16 * st + 4 * fq;
                u32x2 o; o.x = pk2(s0 <= t ? acc[0] : 0.f, s0 + 1 <= t ? acc[1] : 0.f); o.y = pk2(s0 + 2 <= t ? acc[2] : 0.f, s0 + 3 <= t ? acc[3] : 0.f);
                *(LAS u32x2*)(lds + L_ATT + (t * TPI + s0) * 2) = o; }
        }
        __syncthreads();
        f32x4 oacc[4];
        {   const int tt = wave & 3;
            bf16x8 aa[2], aq[4];
#pragma unroll
            for (int ks = 0; ks < 2; ++ks) aa[ks] = *(const LAS bf16x8*)(lds + L_ATT + ((16 * tt + fr) * TPI + 32 * ks + 8 * fq) * 2);
#pragma unroll
            for (int ks = 0; ks < 4; ++ks) aq[ks] = *(const LAS bf16x8*)(lds + L_QH + ((16 * tt + fr) * HP + 32 * ks + 8 * fq) * 2);
#pragma unroll
            for (int i = 0; i < 4; ++i) { const int vt = 4 * (wave >> 2) + i; f32x4 acc = {0.f, 0.f, 0.f, 0.f};
#pragma unroll
                for (int ks = 0; ks < 2; ++ks) { const bf16x8 b = *(const LAS bf16x8*)(lds + L_IVT + ((16 * vt + fr) * TPI + 32 * ks + 8 * fq) * 2); acc = MFMA16(aa[ks], b, acc); }
#pragma unroll
                for (int ks = 0; ks < 4; ++ks) acc = MFMA16(aq[ks], sf[i][ks], acc);
                oacc[i] = acc; }
        }
        f32x4 gn[4];
#pragma unroll
        for (int j = 0; j < 4; ++j) gn[j] = ((const f32x4*)(p.hgrn_norm + 16 * nsg))[j];
        __syncthreads();
        {   const int tt = wave & 3; LAS float* ob = (LAS float*)(lds + L_OB);
#pragma unroll
            for (int i = 0; i < 4; ++i) { const int v = 16 * (4 * (wave >> 2) + i) + fr;
#pragma unroll
                for (int j = 0; j < 4; ++j) ob[(16 * tt + 4 * fq + j) * 132 + v] = oacc[i][j]; }
        }
        __syncthreads();
        {   const int t = nt_, sg = nsg; const LAS float* ob = (const LAS float*)(lds + L_OB) + t * 132 + 16 * sg;
            f32x4 x[4]; float ss = 0.f;
#pragma unroll
            for (int j = 0; j < 4; ++j) { x[j] = ((const LAS f32x4*)ob)[j]; ss += (x[j].x * x[j].x + x[j].y * x[j].y) + (x[j].z * x[j].z + x[j].w * x[j].w); }
            ss += __shfl_xor(ss, 1); ss += __shfl_xor(ss, 2); ss += __shfl_xor(ss, 4);
            const float rr = rsqrtf(ss * (1.f / 128.f) + EPSN);
            if (t < it.L) { const size_t row = it.row0 + t; const int c0 = it.h * 128 + 16 * sg;
                const f32x4 n0 = gn[0], n1 = gn[1], n2 = gn[2], n3 = gn[3];
                u32x4v o0, o1;
                o0.x = pk2(x[0].x * rr * n0.x * bflo(g0.x), x[0].y * rr * n0.y * bfhi(g0.x)); o0.y = pk2(x[0].z * rr * n0.z * bflo(g0.y), x[0].w * rr * n0.w * bfhi(g0.y));
                o0.z = pk2(x[1].x * rr * n1.x * bflo(g0.z), x[1].y * rr * n1.y * bfhi(g0.z)); o0.w = pk2(x[1].z * rr * n1.z * bflo(g0.w), x[1].w * rr * n1.w * bfhi(g0.w));
                o1.x = pk2(x[2].x * rr * n2.x * bflo(g1.x), x[2].y * rr * n2.y * bfhi(g1.x)); o1.y = pk2(x[2].z * rr * n2.z * bflo(g1.y), x[2].w * rr * n2.w * bfhi(g1.y));
                o1.z = pk2(x[3].x * rr * n3.x * bflo(g1.z), x[3].y * rr * n3.y * bfhi(g1.z)); o1.w = pk2(x[3].z * rr * n3.z * bflo(g1.w), x[3].w * rr * n3.w * bfhi(g1.w));
                *(u32x4v*)(p.CAT + row * 1024 + c0) = o0; *(u32x4v*)(p.CAT + row * 1024 + c0 + 8) = o1; }
        }
        __syncthreads();
        item = next;
    }
}
DI void s5_load_u(const Prm& p, int mt, int g, int lane, bf16x8 (&uf)[8]) {
    const int fr = lane & 15, fq = lane >> 4; int col = 16 * mt + fr; if (col >= NCOL) col = NCOL - 1;
#pragma unroll
    for (int ks = 0; ks < 8; ++ks) uf[ks] = *(const bf16x8*)(p.U + ((size_t)(16 * col + 2 * ks + (fq >> 1))) * 512 + 16 * g + 8 * (fq & 1));
}
DI void s5_b(const Prm& p, int gw, int NGW, int lane) {
    const int fr = lane & 15, fq = lane >> 4;
    for (int task = gw; task < 131 * 32; task += NGW) { const int mt = task >> 5, g = task & 31;
        bf16x8 uf[8]; s5_load_u(p, mt, g, lane, uf);
#pragma unroll
        for (int nt = 0; nt < 8; ++nt) { f32x4 acc = {0.f, 0.f, 0.f, 0.f};
#pragma unroll
            for (int ks = 0; ks < 8; ++ks) { const bf16x8 b = *(const bf16x8*)(p.HT + ((size_t)(g * 128 + 16 * nt + fr)) * 256 + 32 * ks + 8 * fq); acc = MFMA16(uf[ks], b, acc); }
#pragma unroll
            for (int j = 0; j < 4; ++j) { const int col = 16 * mt + 4 * fq + j; if (col < NCOL) p.XLOC[(size_t)col * 4096 + g * 128 + 16 * nt + fr] = acc[j]; } }
    }
}
DI void s5_c(const Prm& p, int gtid) {
    if (gtid >= 16 * 2048) return;
    const int seq = gtid >> 11, g = (gtid >> 6) & 31, n = gtid & 63; const bool smp = seq >= 8; const int b = seq & 7;
    const int col0 = smp ? 2056 + 4 * b : 257 * b, nch = smp ? 4 : 257;
    float xr = 0.f, xi = 0.f; if (smp) { xr = p.ssm_re0[(b * 32 + g) * 64 + n]; xi = p.ssm_im0[(b * 32 + g) * 64 + n]; }
    const float ar = p.A16[2 * (g * 64 + n)], ai = p.A16[2 * (g * 64 + n) + 1];
    const size_t base = (size_t)g * 128 + 2 * n;
    for (int c0 = 0; c0 < nch; c0 += 8) {
        f32x2v xl[8];
#pragma unroll
        for (int i = 0; i < 8; ++i) if (c0 + i < nch) xl[i] = *(const f32x2v*)(p.XLOC + (size_t)(col0 + c0 + i) * 4096 + base);
#pragma unroll
        for (int i = 0; i < 8; ++i) if (c0 + i < nch) { *(unsigned*)(p.XPREV + (size_t)(col0 + c0 + i) * 4096 + base) = pk2(xr, xi);
            const float nr = ar * xr - ai * xi + xl[i].x, ni = ar * xi + ai * xr + xl[i].y; xr = nr; xi = ni; } }
    const size_t o = (size_t)(b * 32 + g) * 64 + n;
    p.out[(smp ? O_SRS : O_SRP) + o] = xr; p.out[(smp ? O_SIS : O_SIP) + o] = xi;
}
DI f32x2v gelu_pk(f32x2v v) {
    const f32x2v av = __builtin_elementwise_abs(v), d = av * 0.2316418882f + 1.0f;
    f32x2v t; t.x = __builtin_amdgcn_rcpf(d.x); t.y = __builtin_amdgcn_rcpf(d.y);
    f32x2v q = t * 0.5307027145f + (-0.7265760135f); q = q * t + 0.7107068705f; q = q * t + (-0.142248368f); q = q * t + 0.127414796f; q = q * t;
    const f32x2v s = (v * v) * (-0.72134752044f);
    f32x2v e; e.x = __builtin_amdgcn_exp2f(s.x); e.y = __builtin_amdgcn_exp2f(s.y);
    const f32x2v m = v * (q * e), r = v - m;
    f32x2v o; o.x = v.x < 0.f ? m.x : r.x; o.y = v.y < 0.f ? m.y : r.y; return o;
}
DI void s5_d(const Prm& p, int gw, int NGW, int lane) {
    const int fr = lane & 15, fq = lane >> 4;
    for (int task = gw; task < 131 * 32; task += NGW) { const int mt = task >> 5, g = task & 31;
        bf16x8 uf[8], xf[4]; s5_load_u(p, mt, g, lane, uf);
        int colc = 16 * mt + fr; if (colc >= NCOL) colc = NCOL - 1;
#pragma unroll
        for (int ks = 0; ks < 4; ++ks) xf[ks] = *(const bf16x8*)(p.XPREV + (size_t)colc * 4096 + g * 128 + 32 * ks + 8 * fq);
        const bf16_t* tg = p.TG + ((size_t)(g * 256 + fr)) * 384 + 8 * fq;
        const bool ok = 16 * mt + fr < NCOL;
#pragma unroll
        for (int t = 0; t < 16; ++t) { f32x4 acc = {0.f, 0.f, 0.f, 0.f};
#pragma unroll
            for (int ks = 0; ks < 8; ++ks) if (ks <= (t >> 1)) { const bf16x8 a = *(const bf16x8*)(tg + (size_t)t * 16 * 384 + 32 * ks); acc = MFMA16(a, uf[ks], acc); }
#pragma unroll
            for (int ks = 0; ks < 4; ++ks) { const bf16x8 a = *(const bf16x8*)(tg + (size_t)t * 16 * 384 + 256 + 32 * ks); acc = MFMA16(a, xf[ks], acc); }
            const f32x2v y0 = gelu_pk((f32x2v){acc[0], acc[1]}), y1 = gelu_pk((f32x2v){acc[2], acc[3]});
            u32x2 o; o.x = pk2(y0.x, y0.y); o.y = pk2(y1.x, y1.y);
            if (ok) *(u32x2*)(p.YG + ((size_t)(16 * (16 * mt + fr) + t)) * 512 + 16 * g + 4 * fq) = o; }
    }
}

DI void s5_b_lds(const Prm& p, LAS unsigned char* lds, int tid, int lane, int wave) {
    const int fr = lane & 15, fq = lane >> 4;
    for (int gp = blockIdx.x; gp < 256; gp += gridDim.x) { const int g = gp & 31, part = gp >> 5;
        for (int i = tid; i < 128 * 32; i += 512) { const int row = i >> 5, ch = i & 31;
            *(LAS u32x4v*)(lds + row * 528 + ch * 16) = *(const u32x4v*)(p.HT + ((size_t)(g * 128 + row)) * 256 + ch * 8); }
        __syncthreads();
        for (int mt = part + 8 * wave; mt < 131; mt += 64) {
            bf16x8 uf[8]; s5_load_u(p, mt, g, lane, uf);
#pragma unroll 1
            for (int nt = 0; nt < 8; ++nt) { f32x4 acc = {0.f, 0.f, 0.f, 0.f};
#pragma unroll
                for (int ks = 0; ks < 8; ++ks) { const bf16x8 b = *(const LAS bf16x8*)(lds + (16 * nt + fr) * 528 + 64 * ks + 16 * fq); acc = MFMA16(uf[ks], b, acc); }
#pragma unroll
                for (int j = 0; j < 4; ++j) { const int col = 16 * mt + 4 * fq + j; if (col < NCOL) p.XLOC[(size_t)col * 4096 + g * 128 + 16 * nt + fr] = acc[j]; } }
        }
        __syncthreads(); }
}
DI void s5_d_lds(const Prm& p, LAS unsigned char* lds, int tid, int lane, int wave) {
    const int fr = lane & 15, fq = lane >> 4;
    for (int gp = blockIdx.x; gp < 256; gp += gridDim.x) { const int g = gp & 31, part = gp >> 5;
        { const int row = tid >> 1, hf = tid & 1;
            *(LAS u32x4v*)(lds + row * 48 + hf * 16) = *(const u32x4v*)(p.TG + ((size_t)(g * 256 + row)) * 16 + hf * 8); }
        for (int i = tid; i < 256 * 16; i += 512) { const int row = i >> 4, ch = i & 15;
            *(LAS u32x4v*)(lds + 12288 + row * 272 + ch * 16) = *(const u32x4v*)(p.TG + 131072 + ((size_t)(g * 256 + row)) * 128 + ch * 8); }
        __syncthreads();
        const int lb = fr * 48 + (fq & 1) * 16, hi = fq >> 1;
        for (int mt = part + 8 * wave; mt < 131; mt += 64) {
            bf16x8 uf[8], xf[4]; s5_load_u(p, mt, g, lane, uf);
            int colc = 16 * mt + fr; if (colc >= NCOL) colc = NCOL - 1;
#pragma unroll
            for (int ks = 0; ks < 4; ++ks) xf[ks] = *(const bf16x8*)(p.XPREV + (size_t)colc * 4096 + g * 128 + 32 * ks + 8 * fq);
            const bool ok = 16 * mt + fr < NCOL;
#pragma unroll 1
            for (int t = 0; t < 16; ++t) { f32x4 acc = {0.f, 0.f, 0.f, 0.f};
#pragma unroll
                for (int ks = 0; ks < 8; ++ks) if (ks <= (t >> 1)) {
                    const int tau = t - 2 * ks - hi;
                    union { bf16x8 v; u32x4v u; } a; a.v = *(const LAS bf16x8*)(lds + (tau < 0 ? 0 : tau) * 768 + lb);
                    if (tau < 0) a.u = (u32x4v){0u, 0u, 0u, 0u};
                    acc = MFMA16(a.v, uf[ks], acc); }
#pragma unroll
                for (int ks = 0; ks < 4; ++ks) { const bf16x8 a = *(const LAS bf16x8*)(lds + 12288 + (t * 16 + fr) * 272 + 64 * ks + 16 * fq); acc = MFMA16(a, xf[ks], acc); }
                const f32x2v y0 = gelu_pk((f32x2v){acc[0], acc[1]}), y1 = gelu_pk((f32x2v){acc[2], acc[3]});
                u32x2 o; o.x = pk2(y0.x, y0.y); o.y = pk2(y1.x, y1.y);
                if (ok) *(u32x2*)(p.YG + ((size_t)(16 * (16 * mt + fr) + t)) * 512 + 16 * g + 4 * fq) = o; }
        }
        __syncthreads(); }
}
DI void cache_convert(const Prm& p, int gtid, int GT) {
    for (size_t i = (size_t)gtid; i < (size_t)8 * 1024 * 256; i += (size_t)GT) {
        const size_t row = i >> 8; const int c4 = (int)(i & 255) * 4, b = (int)(row >> 10), pos = (int)(row & 1023), h = c4 >> 7, d = c4 & 127;
        const f32x4 k = *(const f32x4*)(p.cache_k + row * 1024 + c4); u32x2 o; o.x = pk2(k.x, k.y); o.y = pk2(k.z, k.w);
        *(u32x2*)(p.KS + kf_index(b * 8 + h, 34, pos, d)) = o;
        const f32x4 v = *(const f32x4*)(p.cache_v + row * 1024 + c4); bf16_t* vt = p.VTS + vf_index(b * 8 + h, 34, pos, d);
        vt[0] = f2bf(v.x); vt[8] = f2bf(v.y); vt[16] = f2bf(v.z); vt[24] = f2bf(v.w); }
}
DI void attn_phase(const Prm& p, int gw, int NGW, int lane) {
    const int q = lane & 31, half = lane >> 5;
    for (int it = gw; it < 8256 + 128; it += NGW) {
        bool smp; int b, h, qb;
        if (it < 8064) { smp = false; b = it / 1008; const int rem = it - b * 1008; h = rem / 126; qb = 3 + rem - h * 126; }
        else if (it < 8192) { const int s = it - 8064; smp = true; b = s >> 4; h = (s >> 1) & 7; qb = s & 1; }
        else { const int s = it - 8192; smp = false; b = s / 24; const int rem = s - b * 24; h = rem / 3; qb = rem - h * 3; }
        const size_t tbase = (size_t)(b * 8 + h) * (smp ? 34 : 129) * 4096 + lane * 8;
        const bf16_t* Kb = (smp ? p.KS : p.KP) + tbase; const bf16_t* Vb = (smp ? p.VTS : p.VTP) + tbase;
        const int qpos0 = (smp ? 1024 : 0) + 32 * qb, qrow0 = smp ? NTP + b * 64 + 32 * qb : b * TP + 32 * qb;
        const int qpos = qpos0 + q; const bool qvalid = smp || qpos < TP; const size_t qrow = qvalid ? qrow0 + q : qrow0;
        bf16x8 qf[8];
#pragma unroll
        for (int ks = 0; ks < 8; ++ks) qf[ks] = *(const bf16x8*)(p.Q + qrow * 1024 + h * 128 + 16 * ks + 8 * half);
        f32x16 o[4];
#pragma unroll
        for (int db = 0; db < 4; ++db)
#pragma unroll
            for (int e = 0; e < 16; ++e) o[db][e] = 0.f;
        float C = 1.f;
        for (int kt = (qpos0 + 30) >> 5; kt >= 0; --kt) {
            f32x16 s;
#pragma unroll
            for (int e = 0; e < 16; ++e) s[e] = 0.f;
            const bf16_t* kr = Kb + (size_t)kt * 4096; const bf16_t* vr = Vb + (size_t)kt * 4096;
            bf16x8 kf[8], vf[8];
#pragma unroll
            for (int ks = 0; ks < 8; ++ks) kf[ks] = *(const bf16x8*)(kr + ks * 512);
#pragma unroll
            for (int ks = 0; ks < 8; ++ks) vf[ks] = *(const bf16x8*)(vr + ks * 512);
#pragma unroll
            for (int ks = 0; ks < 8; ++ks) s = MFMA32(kf[ks], qf[ks], s);
            float pr[16], be[16], G[4], Gp[4];
#pragma unroll
            for (int i = 0; i < 4; ++i) {
#pragma unroll
                for (int j = 0; j < 4; ++j) { const int key = 32 * kt + 8 * i + 4 * half + j; const bool valid = key < qpos;
                    float z = s[4 * i + j] * 0.08838834764831845f; z = fminf(fmaxf(z, -80.f), 80.f);
                    const float e = __expf(z), pp = __builtin_amdgcn_rcpf(1.f + e); pr[4 * i + j] = valid ? pp : 1.f; be[4 * i + j] = valid ? e * pp : 0.f; }
                G[i] = (pr[4 * i] * pr[4 * i + 1]) * (pr[4 * i + 2] * pr[4 * i + 3]); }
#pragma unroll
            for (int i = 0; i < 4; ++i) Gp[i] = __shfl_xor(G[i], 32);
            float w[16]; float E1 = 1.f;
#pragma unroll
            for (int i = 3; i >= 0; --i) { const float Glo = half ? Gp[i] : G[i], Ghi = half ? G[i] : Gp[i];
                float suf = C * (half ? E1 : E1 * Ghi);
#pragma unroll
                for (int j = 3; j >= 0; --j) { w[4 * i + j] = be[4 * i + j] * suf; suf *= pr[4 * i + j]; }
                E1 *= Glo * Ghi; }
            C *= E1;
#pragma unroll
            for (int c = 0; c < 2; ++c) { union { bf16x8 v; unsigned u[4]; } wf;
#pragma unroll
                for (int e = 0; e < 4; ++e) wf.u[e] = pk2(w[8 * c + 2 * e], w[8 * c + 2 * e + 1]);
#pragma unroll
                for (int db = 0; db < 4; ++db) o[db] = MFMA32(vf[4 * c + db], wf.v, o[db]); }
            if (__all(C < 1e-24f)) break;
        }
        if (qvalid) {
#pragma unroll
            for (int db = 0; db < 4; ++db)
#pragma unroll
                for (int i = 0; i < 4; ++i) { u32x2 ov; ov.x = pk2(o[db][4 * i], o[db][4 * i + 1]); ov.y = pk2(o[db][4 * i + 2], o[db][4 * i + 3]);
                    *(u32x2*)(p.O + qrow * 1024 + h * 128 + 32 * db + 8 * i + 4 * half) = ov; } }
    }
}
DI void final_norm(const Prm& p, int gw, int NGW, int lane) {
    for (int r = gw; r < 32768 + 512; r += NGW) {
        int grow; float* dst;
        if (r < 32768) { const int b = r >> 12, t = r & 4095; grow = b * TP + 16 + t; dst = p.out + O_YP + (size_t)r * 1024; } else { grow = NTP + (r - 32768); dst = p.out + O_YS + (size_t)(r - 32768) * 1024; }
        const float rr = row_rinv(p.SSQ, grow);
#pragma unroll
        for (int j = 0; j < 4; ++j) { f32x4 v = ((f32x4*)dst)[lane + 64 * j]; const f32x4 g = ((const f32x4*)p.ln_final)[lane + 64 * j]; v = v * rr * g; ((f32x4*)dst)[lane + 64 * j] = v; }
    }
}

#define XB_TMO      128
#define XB_XCNT(j)  (256  + 64 * (j))
#define XB_XSUB(j)  (1280 + 64 * (j))
#define XB_XGEN(j)  (2304 + 64 * (j))
#define XB_TOP      3328
#define XB_TOPGEN   3392
#define XCD_BAR_WORDS 3456
#define XB_SPIN_CAP (1u << 18)
DI unsigned xb_ld(unsigned* p) { return __hip_atomic_load(p, __ATOMIC_RELAXED, __HIP_MEMORY_SCOPE_AGENT); }
DI unsigned xb_add(unsigned* p, unsigned v) { return __hip_atomic_fetch_add(p, v, __ATOMIC_RELAXED, __HIP_MEMORY_SCOPE_AGENT); }
DI unsigned xb_xcc_id() { return (unsigned)__builtin_amdgcn_s_getreg((3 << 11) | 20) & 0xFu; }
#define XB_SPIN(cond, bar) do { unsigned _sp = 0; while (cond) { __builtin_amdgcn_s_sleep(1); \
    if ((++_sp & 255u) == 0u) { if (xb_ld(&(bar)[XB_TMO])) break; if (_sp > XB_SPIN_CAP) { atomicAdd(&(bar)[XB_TMO], 1u); break; } } } } while (0)
struct XcdBarrier { unsigned* bar; unsigned x; volatile LAS unsigned* st; };
DI XcdBarrier xcd_barrier_post(unsigned* bar, volatile LAS unsigned* st) {
    XcdBarrier b; b.bar = bar; b.x = xb_xcc_id(); b.st = st;
    if (threadIdx.x == 0) (void)xb_add(&bar[XB_XCNT(b.x)], 1u);
    return b;
}
DI void xcd_barrier_complete(unsigned* bar, unsigned x, unsigned& nloc, unsigned& nx) {
    const unsigned G = gridDim.x * gridDim.y * gridDim.z;
    unsigned sum, cnt, mine, sp = 0u;
    for (;;) {
        sum = 0u; cnt = 0u; mine = 0u;
#pragma unroll
        for (unsigned j = 0; j < 16; ++j) { const unsigned c = xb_ld(&bar[XB_XCNT(j)]); sum += c; cnt += (c > 0u) ? 1u : 0u; mine = (j == x) ? c : mine; }
        if (sum == G) break;
        __builtin_amdgcn_s_sleep(1);
        if ((++sp & 255u) == 0u) { if (xb_ld(&bar[XB_TMO])) break; if (sp > XB_SPIN_CAP) { atomicAdd(&bar[XB_TMO], 1u); break; } }
    }
    nloc = mine > 0u ? mine : 1u; nx = cnt > 0u ? cnt : 1u;
}
DI void xcd_barrier(const XcdBarrier& b) {
    asm volatile("s_waitcnt vmcnt(0)" ::: "memory");
    __syncthreads();
    if (threadIdx.x == 0) {
        unsigned* bar = b.bar;
        __builtin_amdgcn_s_waitcnt(0);
        unsigned nloc = b.st[0], nx = b.st[1];
        if (nloc == 0u) { xcd_barrier_complete(bar, b.x, nloc, nx); b.st[0] = nloc; b.st[1] = nx; }
        const unsigned old = xb_add(&bar[XB_XSUB(b.x)], 1u);
        const unsigned gen = old / nloc;
        if (old + 1u == (gen + 1u) * nloc) {
            __builtin_amdgcn_fence(__ATOMIC_RELEASE, "agent");
            asm volatile("s_waitcnt vmcnt(0)" ::: "memory");
            const unsigned og = xb_add(&bar[XB_TOP], 1u);
            const unsigned tg = og / nx;
            if (og + 1u == (tg + 1u) * nx) xb_add(&bar[XB_TOPGEN], 1u);
            else XB_SPIN(xb_ld(&bar[XB_TOPGEN]) == tg, bar);
            __builtin_amdgcn_fence(__ATOMIC_ACQUIRE, "agent");
            xb_add(&bar[XB_XGEN(b.x)], 1u);
            asm volatile("s_waitcnt vmcnt(0)" ::: "memory");
        } else {
            XB_SPIN(xb_ld(&bar[XB_XGEN(b.x)]) == gen, bar);
            __builtin_amdgcn_fence(__ATOMIC_ACQUIRE, "agent");
            asm volatile("s_waitcnt vmcnt(0)" ::: "memory");
        }
    }
    __syncthreads();
}
constexpr int LDS_BYTES = 131072 + 256;
__global__ void __launch_bounds__(512, 2) fwd_megakernel(Prm p) {
    extern __shared__ __attribute__((aligned(16))) unsigned char shm[];
    LAS unsigned char* lds = (LAS unsigned char*)shm;
    cg::grid_group grid = cg::this_grid();
    const int tid = threadIdx.x, lane = tid & 63, wave = __builtin_amdgcn_readfirstlane(tid >> 6);
    const int gw = blockIdx.x * 8 + wave, NGW = gridDim.x * 8, gtid = blockIdx.x * 512 + tid, GT = gridDim.x * 512;
    volatile LAS unsigned* xst = (volatile LAS unsigned*)(lds + 131072);
    if (tid == 0) { xst[0] = 0u; xst[1] = 0u; }
    __syncthreads();
    const XcdBarrier xb = xcd_barrier_post(p.BAR, xst);
    phase_prologue(p, lds, tid, lane, wave);
    grid.sync();
    { EpiIn0 E; E.SSQ = p.SSQ; E.LB = p.LB; E.Qh = p.Qh; E.IV = p.IV; E.GS = p.GS; E.U = p.U; E.LOGF = p.LOGF; run_gemm(lds, p.XB, p.Wt1, 2560, 1024, E); }
    xcd_barrier(xb);
    hgrn_b1_all(p, lds, tid, lane, wave);
    s5_b_lds(p, lds, tid, lane, wave);
    xcd_barrier(xb);
    hgrn_b2(p, gtid, GT);
    s5_c(p, gtid);
    xcd_barrier(xb);
    hgrn_b3_all(p, lds, tid, lane, wave);
    s5_d_lds(p, lds, tid, lane, wave);
    xcd_barrier(xb);
    { EpiGlu E; E.YG = p.YG; E.CAT = p.CAT; run_gemm(lds, p.YG, p.Wglu, 512, 512, E); }
    xcd_barrier(xb);
    { EpiRes E; E.XB = p.XB; E.SSQ = p.SSQ; run_gemm_split(lds, p.CAT, p.Wo0, 1024, 1024, E, (float*)p.H); xcd_barrier(xb); gemm_fixup(1024, 1024, E, (const float*)p.H, tid); }
    xcd_barrier(xb);
    { EpiUp E; E.SSQ = p.SSQ; E.H = p.H; run_gemm(lds, p.XB, p.Wup0, 4096, 1024, E); }
    xcd_barrier(xb);
    { EpiRes E; E.XB = p.XB; E.SSQ = p.SSQ; run_gemm_split(lds, p.H, p.Wdn0, 1024, 4096, E, (float*)p.CAT); xcd_barrier(xb); gemm_fixup(1024, 4096, E, (const float*)p.CAT, tid); }
    xcd_barrier(xb);
    { EpiQkv E; E.SSQ = p.SSQ; E.out = p.out; E.Q = p.Q; E.KP = p.KP; E.KS = p.KS; E.VTP = p.VTP; E.VTS = p.VTS; run_gemm(lds, p.XB, p.Wqkv, 3072, 1024, E); }
    if (gridDim.x > 36) { if (blockIdx.x >= 36) cache_convert(p, (blockIdx.x - 36) * 512 + tid, (gridDim.x - 36) * 512); } else cache_convert(p, gtid, GT);
    xcd_barrier(xb);
    attn_phase(p, gw, NGW, lane);
    xcd_barrier(xb);
    { EpiRes E; E.XB = p.XB; E.SSQ = p.SSQ; run_gemm_split(lds, p.O, p.Wo1, 1024, 1024, E, (float*)p.H); xcd_barrier(xb); gemm_fixup(1024, 1024, E, (const float*)p.H, tid); }
    xcd_barrier(xb);
    { EpiUp E; E.SSQ = p.SSQ; E.H = p.H; run_gemm(lds, p.XB, p.Wup1, 4096, 1024, E); }
    xcd_barrier(xb);
    { EpiFin E; E.XB = p.XB; E.SSQ = p.SSQ; E.out = p.out; run_gemm_split(lds, p.H, p.Wdn1, 1024, 4096, E, (float*)p.CAT); xcd_barrier(xb); gemm_fixup(1024, 4096, E, (const float*)p.CAT, tid); }
    xcd_barrier(xb);
    final_norm(p, gw, NGW, lane);
}

extern "C" void kernel_launch(void* const* d_in, const int* in_sizes, int n_in, void* d_out, int out_size, void* d_ws, size_t ws_size, hipStream_t stream) {
    static int grid_blocks = 0;
    if (grid_blocks == 0) {
        int dev = 0, cus = 0, per_cu = 0;
        hipGetDevice(&dev); hipDeviceGetAttribute(&cus, hipDeviceAttributeMultiprocessorCount, dev);
        if (hipFuncSetAttribute((const void*)fwd_megakernel, hipFuncAttributeMaxDynamicSharedMemorySize, LDS_BYTES) != hipSuccess) fprintf(stderr, "kernel_launch: hipFuncSetAttribute failed\n");
        if (hipOccupancyMaxActiveBlocksPerMultiprocessor(&per_cu, (const void*)fwd_megakernel, 512, LDS_BYTES) != hipSuccess || per_cu < 1) { fprintf(stderr, "kernel_launch: occupancy query says %d\n", per_cu); per_cu = 1; }
        (void)hipGetLastError();
        grid_blocks = cus > 0 ? cus : 256;
    }
    Prm p{};
    const float* const* in = (const float* const*)d_in;
    p.x_prompt = in[0]; p.x_sample = in[1]; p.state_hgrn = in[2]; p.ssm_re0 = in[3]; p.ssm_im0 = in[4]; p.cache_k = in[5]; p.cache_v = in[6]; p.meta = in[7]; p.ln_mix = in[8]; p.ln_mlp = in[9];
    p.ln_final = in[10]; p.w_in_even = in[11]; p.hgrn_lb = in[12]; p.hgrn_norm = in[13]; p.a_re = in[14]; p.a_im = in[15]; p.log_dt = in[16]; p.b_re = in[17]; p.b_im = in[18]; p.c_re = in[19];
    p.c_im = in[20]; p.ssm_d = in[21]; p.w_glu = in[22]; p.w_out_even = in[23]; p.w_in_odd = in[24]; p.w_out_odd = in[25]; p.w_up = in[26]; p.w_down = in[27];
    p.out = (float*)d_out;
    unsigned char* ws = (unsigned char*)d_ws; size_t off = 0;
    auto take = [&](size_t bytes) { unsigned char* r = ws + off; off += (bytes + 255) & ~(size_t)255; return r; };
    p.Wt1 = (bf16_t*)take((size_t)2560 * 1024 * 2); p.Wglu = (bf16_t*)take((size_t)512 * 512 * 2); p.Wo0 = (bf16_t*)take((size_t)1024 * 1024 * 2); p.Wup0 = (bf16_t*)take((size_t)4096 * 1024 * 2);
    p.Wdn0 = (bf16_t*)take((size_t)4096 * 1024 * 2); p.Wqkv = (bf16_t*)take((size_t)3072 * 1024 * 2); p.Wo1 = (bf16_t*)take((size_t)1024 * 1024 * 2); p.Wup1 = (bf16_t*)take((size_t)4096 * 1024 * 2);
    p.Wdn1 = (bf16_t*)take((size_t)4096 * 1024 * 2);
    p.XB = (bf16_t*)take((size_t)MP * 1024 * 2); p.SSQ = (float*)take((size_t)MP * 16 * 4); p.LB = (float*)take(2048); p.KTAB = (float*)take((size_t)32 * 16 * 256 * 4);
    p.TG = (bf16_t*)take((size_t)32 * 256 * 384 * 2); p.HT = (bf16_t*)take((size_t)32 * 128 * 256 * 2); p.A16 = (float*)take(32 * 64 * 2 * 4); p.BAR = (unsigned*)take(XCD_BAR_WORDS * 4);
    const size_t S0 = off; constexpr size_t SZ512 = (size_t)MP * 512 * 2;
    p.Qh = (bf16_t*)take(SZ512); p.LOGF = (unsigned short*)take(SZ512); p.IV = (bf16_t*)take(SZ512); p.GS = (bf16_t*)take(SZ512); p.U = (bf16_t*)take(SZ512);
    p.UT = (bf16_t*)take((size_t)NITEM_H * 16384 * 2); p.AL = (float*)take((size_t)NITEM_H * 128 * 4);
    p.XLOC = (float*)take(SZ512); p.YG = (bf16_t*)p.XLOC;
    p.XPREV = (bf16_t*)take((size_t)NCOL * 4096 * 2); p.CAT = (bf16_t*)take((size_t)MP * 1024 * 2);
    size_t end = off;
    off = S0; p.H = (bf16_t*)take((size_t)MP * 4096 * 2); if (off > end) end = off;
    off = S0; p.Q = (bf16_t*)take((size_t)MP * 1024 * 2); p.KP = (bf16_t*)take((size_t)64 * 129 * 4096 * 2); p.KS = (bf16_t*)take((size_t)64 * 34 * 4096 * 2);
    p.VTP = (bf16_t*)take((size_t)64 * 129 * 4096 * 2); p.VTS = (bf16_t*)take((size_t)64 * 34 * 4096 * 2); p.O = (bf16_t*)take((size_t)MP * 1024 * 2); if (off > end) end = off;
    if (end > ws_size || n_in != 28 || (size_t)out_size != O_END) { fprintf(stderr, "kernel_launch: workspace/shape mismatch: need %zu have %zu, n_in %d, out %d\n", end, ws_size, n_in, out_size); return; }
    (void)hipMemsetAsync(p.BAR, 0, XCD_BAR_WORDS * 4, stream);
    void* args[] = {&p};
    hipError_t e = hipLaunchCooperativeKernel((const void*)fwd_megakernel, dim3(grid_blocks), dim3(512), args, LDS_BYTES, stream);
    if (e != hipSuccess) fprintf(stderr, "cooperative launch failed: %s (grid %d)\n", hipGetErrorString(e), grid_blocks);
}
```

```cpp
#include <hip/hip_runtime.h>
#include <hip/hip_cooperative_groups.h>
#include <cstdio>
#include <cstdint>
namespace cg = cooperative_groups;
namespace pg8 {
#define PG8_LAS __attribute__((address_space(3)))
typedef unsigned short bf16_t;
typedef short bf16x8 __attribute__((ext_vector_type(8)));
typedef float f32x4 __attribute__((ext_vector_type(4)));
typedef unsigned u32x4 __attribute__((ext_vector_type(4)));
constexpr int BM = 256, BK = 64, HALF = 128, HTB = HALF * BK * 2  , STAGE_BYTES = 8 * HTB, NXCD = 8, WGM = 8;

__host__ __device__ __forceinline__ int lds_byte(int r, int c) { const int st = (r >> 4) * 2 + (c >> 5), rr = r & 15, cc = c & 31, ob = rr * 64 + cc * 2; return st * 1024 + (ob ^ (((ob >> 9) & 1) << 5)); }
__host__ __device__ __forceinline__ void stage_rc(int b, int& R, int& C) { const int st = b / 1024, sb = b % 1024, swz = sb ^ (((sb >> 9) & 1) << 5); R = (st >> 1) * 16 + swz / 64; C = (st & 1) * 32 + (swz % 64) / 2; }
__host__ __device__ __forceinline__ int perm32(int rho) { const int n = rho >> 4, i = rho & 15; return 8 * (i >> 2) + 4 * n + (i & 3); }

struct Unit { int pm, pn, kb, nk, part; };
struct Gemm { const bf16_t* A; const bf16_t* Bt; int M, N, K; float* part; };

struct StaticOrder {
    int nM, nN, nwg, G, c;
    __host__ __device__ void init(int M, int N, int G_, int c_) { nM = M / BM; nN = N / BM; nwg = nM * nN; G = G_; c = c_; }
    __host__ __device__ void map(int L, Unit& u) const {
        int wgid = L; { const int q = nwg / NXCD, r = nwg % NXCD, xcd = wgid % NXCD, off = wgid / NXCD; wgid = (xcd < r ? xcd * (q + 1) : r * (q + 1) + (xcd - r) * q) + off; }
        const int nig = WGM * nN, gid = wgid / nig, fm = gid * WGM, gsz = (nM - fm) < WGM ? (nM - fm) : WGM;
        u.pm = fm + ((wgid % nig) % gsz); u.pn = (wgid % nig) / gsz; u.kb = 0; u.nk = 0; u.part = -1;
    }
    __host__ __device__ bool next(int i, Unit& u) const {
        const long L = (long)i * G + c; if (L >= nwg) return false;
        map((int)L, u); return true;
    }
    __device__ __forceinline__ void a_ready(const Unit&) const {}
    __device__ __forceinline__ void done(const Unit&) const {}
};
template <class Epi, class Sched>
__device__ __forceinline__ void gemm_phase(PG8_LAS unsigned char* lds, const Gemm g, const Sched& S, const Epi& E) {
    const int tid = threadIdx.x, wid = __builtin_amdgcn_readfirstlane(tid >> 6), lane = tid & 63, wr = wid >> 2, wc = wid & 3, fr = lane & 15, fq = lane >> 4;
    const int K = g.K, nt = K / BK;
    unsigned voffA[2], voffB[2];
#pragma unroll
    for (int i = 0; i < 2; ++i) { int R, C; stage_rc(tid * 16 + i * 8192, R, C); const int Rb = Epi::PERM ? ((R & ~31) + perm32(R & 31)) : R;
        voffA[i] = (unsigned)(R * K + C) * 2u; voffB[i] = (unsigned)(Rb * K + C) * 2u; }
    const size_t kstep = (size_t)(BK * 2);
    const size_t hstep = (size_t)HALF * K * 2;
    const size_t tstep = 2 * hstep;
    const unsigned ldsw = (unsigned)wid * 1024u;
    const int aoff = lds_byte(wr * 64 + fr, fq * 8), boff = lds_byte(wc * 32 + fr, fq * 8);
#define PG8_SA(b, h) (((b) * 2 + (h)) * HTB)
#define PG8_SB(b, h) ((4 + (b) * 2 + (h)) * HTB)
#define PG8_STAGE(bufoff, gbase, voff) do { _Pragma("unroll") for (int _i = 0; _i < 2; ++_i) \
        __builtin_amdgcn_global_load_lds((const unsigned*)((const char*)(gbase) + (voff)[_i]), (PG8_LAS unsigned*)(lds + (bufoff) + ldsw + _i * 8192), 16, 0, 0); } while (0)
#define PG8_LDA(dst, b, h) do { _Pragma("unroll") for (int m = 0; m < 4; ++m) _Pragma("unroll") for (int k = 0; k < 2; ++k) dst[m][k] = *(const PG8_LAS bf16x8*)(lds + PG8_SA(b, h) + aoff + m * 2048 + k * 1024); } while (0)
#define PG8_LDB(dst, b, h) do { _Pragma("unroll") for (int n = 0; n < 2; ++n) _Pragma("unroll") for (int k = 0; k < 2; ++k) dst[n][k] = *(const PG8_LAS bf16x8*)(lds + PG8_SB(b, h) + boff + n * 2048 + k * 1024); } while (0)
#define PG8_MMA(ai, bj, At, Bt) do { __builtin_amdgcn_s_setprio(1); _Pragma("unroll") for (int m = 0; m < 4; ++m) _Pragma("unroll") for (int n = 0; n < 2; ++n) _Pragma("unroll") for (int k = 0; k < 2; ++k) \
        acc[ai][bj][m][n] = __builtin_amdgcn_mfma_f32_16x16x32_bf16(Bt[n][k], At[m][k], acc[ai][bj][m][n], 0, 0, 0); __builtin_amdgcn_s_setprio(0); } while (0)
#define PG8_WAIT_V(n) asm volatile("s_waitcnt vmcnt(" #n ")" ::: "memory")
#define PG8_WAIT_L(n) asm volatile("s_waitcnt lgkmcnt(" #n ")" ::: "memory")
#define PG8_BAR __builtin_amdgcn_s_barrier()
#define PG8_SCHED __builtin_amdgcn_sched_barrier(0)
    Unit cur, nxt; int ui = 0;
    if (!S.next(0, cur)) return;
    f32x4 acc[2][2][4][2];
#pragma unroll
    for (int a = 0; a < 2; ++a)
#pragma unroll
        for (int b = 0; b < 2; ++b)
#pragma unroll
            for (int m = 0; m < 4; ++m)
#pragma unroll
                for (int n = 0; n < 2; ++n) acc[a][b][m][n] = (f32x4){0.f, 0.f, 0.f, 0.f};
    bf16x8 At[4][2], B0[2][2], B1[2][2];
    const char* cA = (const char*)g.A + (size_t)cur.pm * tstep + (size_t)cur.kb * kstep; const char* cB = (const char*)g.Bt + (size_t)cur.pn * tstep + (size_t)cur.kb * kstep;
    S.a_ready(cur);
    PG8_STAGE(PG8_SB(0, 0), cB, voffB); PG8_STAGE(PG8_SA(0, 0), cA, voffA); PG8_STAGE(PG8_SB(0, 1), cB + hstep, voffB); PG8_STAGE(PG8_SA(0, 1), cA + hstep, voffA);
    if (wr == 1) PG8_BAR;
    PG8_WAIT_V(4); PG8_BAR;
    PG8_STAGE(PG8_SB(1, 0), cB + kstep, voffB); PG8_STAGE(PG8_SA(1, 0), cA + kstep, voffA); PG8_STAGE(PG8_SB(1, 1), cB + hstep + kstep, voffB);
    PG8_WAIT_V(6); PG8_BAR;
    for (;;) {
        const bool has_next = S.next(ui + 1, nxt);
        const char* nA = has_next ? (const char*)g.A + (size_t)nxt.pm * tstep + (size_t)nxt.kb * kstep : cA; const char* nB = has_next ? (const char*)g.Bt + (size_t)nxt.pn * tstep + (size_t)nxt.kb * kstep : cB;
        const int cnk = cur.nk ? cur.nk : nt;
        for (int t = 0; t < cnk; t += 2) {
            const bool last = (t == cnk - 2);
            const char* a1 = cA + (size_t)(t + 1) * kstep;
            const char* a2 = last ? nA : cA + (size_t)(t + 2) * kstep; const char* b2 = last ? nB : cB + (size_t)(t + 2) * kstep;
            const char* a3 = a2 + kstep; const char* b3 = b2 + kstep;
            if (last && has_next) S.a_ready(nxt);
            PG8_LDB(B0, 0, 0); PG8_SCHED; PG8_LDA(At, 0, 0); PG8_STAGE(PG8_SA(1, 1), a1 + hstep, voffA);
            PG8_WAIT_L(8); PG8_BAR; PG8_WAIT_L(0); PG8_MMA(0, 0, At, B0); PG8_BAR; PG8_SCHED;
            PG8_LDB(B1, 0, 1); PG8_STAGE(PG8_SB(0, 0), b2, voffB);
            PG8_BAR; PG8_WAIT_L(0); PG8_MMA(0, 1, At, B1); PG8_BAR;
            PG8_LDA(At, 0, 1); PG8_STAGE(PG8_SA(0, 0), a2, voffA);
            PG8_BAR; PG8_WAIT_L(0); PG8_MMA(1, 0, At, B0); PG8_BAR; PG8_SCHED;
            PG8_STAGE(PG8_SB(0, 1), b2 + hstep, voffB);
            PG8_WAIT_V(6); PG8_BAR; PG8_MMA(1, 1, At, B1); PG8_BAR;
            PG8_LDB(B0, 1, 0); PG8_SCHED; PG8_LDA(At, 1, 0); PG8_STAGE(PG8_SA(0, 1), a2 + hstep, voffA);
            PG8_WAIT_L(8); PG8_BAR; PG8_WAIT_L(0); PG8_MMA(0, 0, At, B0); PG8_BAR; PG8_SCHED;
            PG8_LDB(B1, 1, 1); PG8_STAGE(PG8_SB(1, 0), b3, voffB);
            PG8_BAR; PG8_WAIT_L(0); PG8_MMA(0, 1, At, B1); PG8_BAR;
            PG8_LDA(At, 1, 1); PG8_STAGE(PG8_SA(1, 0), a3, voffA);
            PG8_BAR; PG8_WAIT_L(0); PG8_MMA(1, 0, At, B0); PG8_BAR; PG8_SCHED;
            PG8_STAGE(PG8_SB(1, 1), b3 + hstep, voffB);
            PG8_WAIT_V(6); PG8_BAR; PG8_MMA(1, 1, At, B1); PG8_BAR;
        }
        if constexpr (!Epi::AFTER_DRAIN) {
            if (cur.part < 0) E(acc, cur, wr, wc, fr, fq);
            else { f32x4* pp = (f32x4*)g.part + (size_t)cur.part * 32 * 512 + tid;
#pragma unroll
                for (int a = 0; a < 2; ++a)
#pragma unroll
                    for (int b = 0; b < 2; ++b)
#pragma unroll
                        for (int m = 0; m < 4; ++m)
#pragma unroll
                            for (int n = 0; n < 2; ++n) pp[(size_t)(((a * 2 + b) * 4 + m) * 2 + n) * 512] = acc[a][b][m][n]; }
            S.done(cur); }
        if (!has_next) break;
#pragma unroll
        for (int a = 0; a < 2; ++a)
#pragma unroll
            for (int b = 0; b < 2; ++b)
#pragma unroll
                for (int m = 0; m < 4; ++m)
#pragma unroll
                    for (int n = 0; n < 2; ++n) acc[a][b][m][n] = (f32x4){0.f, 0.f, 0.f, 0.f};
        cur = nxt; cA = nA; cB = nB; ++ui;
    }
    PG8_WAIT_V(0);
    if (wr == 0) PG8_BAR;
    PG8_BAR;
    if constexpr (Epi::AFTER_DRAIN) { E.fused(acc, cur, wr, wc, fr, fq, lds, wid, lane); S.done(cur); }
#undef PG8_SA
#undef PG8_SB
#undef PG8_STAGE
#undef PG8_LDA
#undef PG8_LDB
#undef PG8_MMA
#undef PG8_WAIT_V
#undef PG8_WAIT_L
#undef PG8_BAR
#undef PG8_SCHED
}
}
using pg8::bf16_t; using pg8::bf16x8; using pg8::f32x4; using pg8::Unit;
typedef float f32x16 __attribute__((ext_vector_type(16)));
typedef float f32x2v __attribute__((ext_vector_type(2)));
typedef unsigned u32x2 __attribute__((ext_vector_type(2)));
typedef unsigned u32x4v __attribute__((ext_vector_type(4)));
#define LAS __attribute__((address_space(3)))
#define DI __device__ __forceinline__

constexpr int DM = 1024, TP = 4112, NTP = 8 * TP  , NTS = 512, NT = NTP + NTS  , MP = 33536  ;
constexpr int NITEM_H = 2112;
constexpr int NCOL = NT / 16;
constexpr float EPSN = 1e-6f;
constexpr size_t O_YP = 0, O_YS = O_YP + (size_t)8 * 4096 * 1024, O_HGP = O_YS + 524288, O_HGS = O_HGP + 524288, O_SRP = O_HGS + 524288, O_SIP = O_SRP + 16384,
                 O_SRS = O_SIP + 16384, O_SIS = O_SRS + 16384, O_KP = O_SIS + 16384, O_VP = O_KP + (size_t)NTP * 1024, O_KS = O_VP + (size_t)NTP * 1024, O_VS = O_KS + 524288, O_END = O_VS + 524288;

struct Prm {
    const float *x_prompt, *x_sample, *state_hgrn, *ssm_re0, *ssm_im0, *cache_k, *cache_v, *meta, *ln_mix, *ln_mlp, *ln_final, *w_in_even, *hgrn_lb, *hgrn_norm,
        *a_re, *a_im, *log_dt, *b_re, *b_im, *c_re, *c_im, *ssm_d, *w_glu, *w_out_even, *w_in_odd, *w_out_odd, *w_up, *w_down;
    float* out;
    bf16_t *Wt1, *Wglu, *Wo0, *Wup0, *Wdn0, *Wqkv, *Wo1, *Wup1, *Wdn1;
    bf16_t* XB; float* SSQ; float* LB; float* KTAB; bf16_t* TG; bf16_t* HT; float* A16;
    bf16_t *Qh, *IV, *GS, *U; unsigned short* LOGF; bf16_t* UT; float* AL; float* XLOC; bf16_t* XPREV; bf16_t* YG; bf16_t* CAT;
    bf16_t* H;
    bf16_t *Q, *KP, *KS, *VTP, *VTS, *O; unsigned* BAR;
};

DI unsigned pk2(float lo, float hi) { unsigned r; asm volatile("v_cvt_pk_bf16_f32 %0, %1, %2" : "=v"(r) : "v"(lo), "v"(hi)); return r; }
DI float bflo(unsigned u) { return __uint_as_float(u << 16); }
DI float bfhi(unsigned u) { return __uint_as_float(u & 0xffff0000u); }
DI float bf2f(unsigned short b) { return __uint_as_float(((unsigned)b) << 16); }
DI unsigned short f2bf(float f) { return (unsigned short)(pk2(f, 0.f) & 0xffffu); }
DI unsigned pkh2(float lo, float hi) { union { _Float16 h[2]; unsigned u; } x; x.h[0] = (_Float16)lo; x.h[1] = (_Float16)hi; return x.u; }
DI float h2f(unsigned short h) { union { unsigned short s; _Float16 h; } x; x.s = h; return (float)x.h; }
DI float wave_sum(float v) {
#pragma unroll
    for (int o = 1; o < 64; o <<= 1) v += __shfl_xor(v, o);
    return v;
}
DI float fexp(float x) { return __expf(x); }
DI float sigm(float x) { return __builtin_amdgcn_rcpf(1.f + __expf(-x)); }
DI float row_rinv(const float* SSQ, int row) {
    const f32x4* s = (const f32x4*)(SSQ + (size_t)row * 16); f32x4 a = s[0] + s[1] + s[2] + s[3];
    return rsqrtf(((a.x + a.y) + (a.z + a.w)) * (1.f / 1024.f) + EPSN);
}
DI void rinv8(const float* SSQ, int row0, int fq, float (&r)[2][4]) {
    f32x4 v[2][4];
#pragma unroll
    for (int ai = 0; ai < 2; ++ai)
#pragma unroll
        for (int m = 0; m < 4; ++m) v[ai][m] = *(const f32x4*)(SSQ + (size_t)(row0 + ai * 128 + m * 16) * 16 + 4 * fq);
#pragma unroll
    for (int ai = 0; ai < 2; ++ai)
#pragma unroll
        for (int m = 0; m < 4; ++m) { float s = (v[ai][m].x + v[ai][m].y) + (v[ai][m].z + v[ai][m].w); s += __shfl_xor(s, 16); s += __shfl_xor(s, 32); r[ai][m] = rsqrtf(s * (1.f / 1024.f) + EPSN); }
}
#define LDS_WAIT() asm volatile("s_waitcnt lgkmcnt(0)" ::: "memory")

struct EpiIn0 {
    static constexpr bool PERM = false, AFTER_DRAIN = false;
    const float* SSQ; const float* LB; bf16_t *Qh, *IV, *GS, *U; unsigned short* LOGF;
    DI void operator()(const f32x4 (&acc)[2][2][4][2], const Unit& u, int wr, int wc, int fr, int fq) const {
        const int seg = u.pn >> 1, cb = (u.pn & 1) * 256 + wc * 32 + 4 * fq, row0 = u.pm * 256 + wr * 64 + fr;
        unsigned short* dst = seg == 0 ? Qh : seg == 1 ? LOGF : seg == 2 ? IV : seg == 3 ? GS : U;
        float rs[2][4]; rinv8(SSQ, row0, fq, rs);
        f32x4 lbv[2][2];
#pragma unroll
        for (int bj = 0; bj < 2; ++bj)
#pragma unroll
            for (int n = 0; n < 2; ++n) lbv[bj][n] = *(const f32x4*)(LB + cb + bj * 128 + n * 16);
#pragma unroll
        for (int ai = 0; ai < 2; ++ai)
#pragma unroll
            for (int m = 0; m < 4; ++m) { const int row = row0 + ai * 128 + m * 16; const float r = rs[ai][m];
#pragma unroll
                for (int bj = 0; bj < 2; ++bj)
#pragma unroll
                    for (int n = 0; n < 2; ++n) { const int cs = cb + bj * 128 + n * 16; f32x4 v = acc[ai][bj][m][n] * r; u32x2 o;
                        if (seg == 1) { const f32x4 lb = lbv[bj][n]; f32x4 f;
#pragma unroll
                            for (int e = 0; e < 4; ++e) f[e] = __logf(lb[e] + (1.f - lb[e]) * sigm(v[e]));
                            o.x = pkh2(f[0], f[1]); o.y = pkh2(f[2], f[3]); }
                        else { if (seg == 3) {
#pragma unroll
                                for (int e = 0; e < 4; ++e) v[e] = v[e] * sigm(v[e]); }
                            o.x = pk2(v[0], v[1]); o.y = pk2(v[2], v[3]); }
                        *(u32x2*)(dst + (size_t)row * 512 + cs) = o; } }
    }
};
struct EpiGlu {
    static constexpr bool PERM = false, AFTER_DRAIN = false;
    const bf16_t* YG; bf16_t* CAT;
    DI void operator()(const f32x4 (&acc)[2][2][4][2], const Unit& u, int wr, int wc, int fr, int fq) const {
        const int cb = u.pn * 256 + wc * 32 + 4 * fq, row0 = u.pm * 256 + wr * 64 + fr;
#pragma unroll
        for (int ai = 0; ai < 2; ++ai) {
            u32x2 y[4][2][2];
#pragma unroll
            for (int m = 0; m < 4; ++m)
#pragma unroll
                for (int bj = 0; bj < 2; ++bj)
#pragma unroll
                    for (int n = 0; n < 2; ++n) y[m][bj][n] = *(const u32x2*)(YG + (size_t)(row0 + ai * 128 + m * 16) * 512 + cb + bj * 128 + n * 16);
#pragma unroll
            for (int m = 0; m < 4; ++m) { const int row = row0 + ai * 128 + m * 16;
#pragma unroll
                for (int bj = 0; bj < 2; ++bj)
#pragma unroll
                    for (int n = 0; n < 2; ++n) { const int cs = cb + bj * 128 + n * 16; const f32x4 v = acc[ai][bj][m][n]; const u32x2 yy = y[m][bj][n]; u32x2 o;
                        o.x = pk2(bflo(yy.x) * sigm(v[0]), bfhi(yy.x) * sigm(v[1])); o.y = pk2(bflo(yy.y) * sigm(v[2]), bfhi(yy.y) * sigm(v[3]));
                        *(u32x2*)(CAT + (size_t)row * 1024 + 512 + cs) = o; } } }
    }
};
struct EpiRes {
    static constexpr bool PERM = false, AFTER_DRAIN = false;
    bf16_t* XB; float* SSQ;
    DI void row(const f32x4 (&a4)[2][2], const Unit& u, int ai, int m, int wr, int wc, int fr, int fq) const {
        const int cb = u.pn * 256 + wc * 32 + 4 * fq, row = u.pm * 256 + wr * 64 + fr + ai * 128 + m * 16; float ss = 0.f;
#pragma unroll
        for (int bj = 0; bj < 2; ++bj)
#pragma unroll
            for (int n = 0; n < 2; ++n) { const int cs = cb + bj * 128 + n * 16; const f32x4 v = a4[bj][n];
                u32x2* px = (u32x2*)(XB + (size_t)row * 1024 + cs); const u32x2 x = *px; u32x2 o;
                o.x = pk2(bflo(x.x) + v[0], bfhi(x.x) + v[1]); o.y = pk2(bflo(x.y) + v[2], bfhi(x.y) + v[3]); *px = o;
                const float a0 = bflo(o.x), a1 = bfhi(o.x), a2 = bflo(o.y), a3 = bfhi(o.y); ss += (a0 * a0 + a1 * a1) + (a2 * a2 + a3 * a3); }
        ss += __shfl_xor(ss, 16); ss += __shfl_xor(ss, 32);
        if (fq == 0) SSQ[(size_t)row * 16 + u.pn * 4 + wc] = ss;
    }
    DI void operator()(const f32x4 (&acc)[2][2][4][2], const Unit& u, int wr, int wc, int fr, int fq) const {
        const int cb = u.pn * 256 + wc * 32 + 4 * fq, row0 = u.pm * 256 + wr * 64 + fr;
#pragma unroll
        for (int ai = 0; ai < 2; ++ai) {
            u32x2 x[4][2][2];
#pragma unroll
            for (int m = 0; m < 4; ++m)
#pragma unroll
                for (int bj = 0; bj < 2; ++bj)
#pragma unroll
                    for (int n = 0; n < 2; ++n) x[m][bj][n] = *(const u32x2*)(XB + (size_t)(row0 + ai * 128 + m * 16) * 1024 + cb + bj * 128 + n * 16);
#pragma unroll
            for (int m = 0; m < 4; ++m) { const int row = row0 + ai * 128 + m * 16; float ss = 0.f;
#pragma unroll
                for (int bj = 0; bj < 2; ++bj)
#pragma unroll
                    for (int n = 0; n < 2; ++n) { const int cs = cb + bj * 128 + n * 16; const f32x4 v = acc[ai][bj][m][n]; const u32x2 xx = x[m][bj][n]; u32x2 o;
                        o.x = pk2(bflo(xx.x) + v[0], bfhi(xx.x) + v[1]); o.y = pk2(bflo(xx.y) + v[2], bfhi(xx.y) + v[3]); *(u32x2*)(XB + (size_t)row * 1024 + cs) = o;
                        const float a0 = bflo(o.x), a1 = bfhi(o.x), a2 = bflo(o.y), a3 = bfhi(o.y); ss += (a0 * a0 + a1 * a1) + (a2 * a2 + a3 * a3); }
                ss += __shfl_xor(ss, 16); ss += __shfl_xor(ss, 32);
                if (fq == 0) SSQ[(size_t)row * 16 + u.pn * 4 + wc] = ss; } }
    }
};
struct EpiUp {
    static constexpr bool PERM = false, AFTER_DRAIN = false;
    const float* SSQ; bf16_t* H;
    DI void operator()(const f32x4 (&acc)[2][2][4][2], const Unit& u, int wr, int wc, int fr, int fq) const {
        const int cb = u.pn * 256 + wc * 32 + 4 * fq, row0 = u.pm * 256 + wr * 64 + fr;
        float rs[2][4]; rinv8(SSQ, row0, fq, rs);
#pragma unroll
        for (int ai = 0; ai < 2; ++ai)
#pragma unroll
            for (int m = 0; m < 4; ++m) { const int row = row0 + ai * 128 + m * 16; const float r = rs[ai][m];
#pragma unroll
                for (int bj = 0; bj < 2; ++bj)
#pragma unroll
                    for (int n = 0; n < 2; ++n) { const int cs = cb + bj * 128 + n * 16; f32x4 v = acc[ai][bj][m][n] * r;
#pragma unroll
                        for (int e = 0; e < 4; ++e) { const float t = fmaxf(v[e], 0.f); v[e] = t * t; }
                        u32x2 o; o.x = pk2(v[0], v[1]); o.y = pk2(v[2], v[3]); *(u32x2*)(H + (size_t)row * 4096 + cs) = o; } }
    }
};
DI size_t kf_index(int seqh, int nkt, int key, int d) { return ((((size_t)seqh * nkt + (key >> 5)) * 8 + (d >> 4)) * 64 + ((key & 31) + 32 * ((d >> 3) & 1))) * 8 + (d & 7); }
DI size_t vf_index(int seqh, int nkt, int key, int d) { const int kk = key & 31;
    return ((((size_t)seqh * nkt + (key >> 5)) * 8 + (kk >> 4) * 4 + (d >> 5)) * 64 + ((d & 31) + 32 * ((kk >> 2) & 1))) * 8 + ((kk >> 3) & 1) * 4 + (kk & 3); }
struct EpiQkv {
    static constexpr bool PERM = false, AFTER_DRAIN = false;
    const float* SSQ; float* out; bf16_t *Q, *KP, *KS, *VTP, *VTS;
    DI void operator()(const f32x4 (&acc)[2][2][4][2], const Unit& u, int wr, int wc, int fr, int fq) const {
        const int third = u.pn >> 2, cb = (u.pn & 3) * 256 + wc * 32 + 4 * fq, row0 = u.pm * 256 + wr * 64 + fr;
        float rs[2][4]; rinv8(SSQ, row0, fq, rs);
#pragma unroll
        for (int ai = 0; ai < 2; ++ai)
#pragma unroll
            for (int m = 0; m < 4; ++m) { const int row = row0 + ai * 128 + m * 16; const float r = rs[ai][m];
                const bool smp = row >= NTP; const int s = row - NTP; const int b = smp ? (s >> 6) : row / TP, key = smp ? 1024 + (s & 63) : row - b * TP, nkt = smp ? 34 : 129;
#pragma unroll
                for (int bj = 0; bj < 2; ++bj)
#pragma unroll
                    for (int n = 0; n < 2; ++n) { const int cs = cb + bj * 128 + n * 16; const f32x4 v = acc[ai][bj][m][n] * r;
                        u32x2 o; o.x = pk2(v[0], v[1]); o.y = pk2(v[2], v[3]);
                        if (third == 0) { *(u32x2*)(Q + (size_t)row * 1024 + cs) = o; }
                        else if (row < NT) { const int h = cs >> 7, d = cs & 127;
                            if (third == 1) { *(f32x4*)(out + (smp ? O_KS + (size_t)s * 1024 : O_KP + (size_t)row * 1024) + cs) = v;
                                *(u32x2*)((smp ? KS : KP) + kf_index(b * 8 + h, nkt, key, d)) = o; }
                            else { *(f32x4*)(out + (smp ? O_VS + (size_t)s * 1024 : O_VP + (size_t)row * 1024) + cs) = v;
                                bf16_t* vt = (smp ? VTS : VTP) + vf_index(b * 8 + h, nkt, key, d);
                                vt[0] = (bf16_t)(o.x & 0xffffu); vt[8] = (bf16_t)(o.x >> 16); vt[16] = (bf16_t)(o.y & 0xffffu); vt[24] = (bf16_t)(o.y >> 16); } } } }
    }
};
struct EpiFin {
    static constexpr bool PERM = false, AFTER_DRAIN = false;
    const bf16_t* XB; float* SSQ; float* out;
    DI void row(const f32x4 (&a4)[2][2], const Unit& u, int ai, int m, int wr, int wc, int fr, int fq) const {
        const int cb = u.pn * 256 + wc * 32 + 4 * fq, row = u.pm * 256 + wr * 64 + fr + ai * 128 + m * 16; float ss = 0.f;
        const int b = row / TP, t = row - b * TP; const bool ok = row < NT && (row >= NTP || t >= 16);
        float* dst = out + (row >= NTP ? O_YS + (size_t)(row - NTP) * 1024 : O_YP + ((size_t)b * 4096 + (t - 16)) * 1024);
#pragma unroll
        for (int bj = 0; bj < 2; ++bj)
#pragma unroll
            for (int n = 0; n < 2; ++n) { const int cs = cb + bj * 128 + n * 16; f32x4 v = a4[bj][n];
                const u32x2 x = *(const u32x2*)(XB + (size_t)row * 1024 + cs);
                v[0] += bflo(x.x); v[1] += bfhi(x.x); v[2] += bflo(x.y); v[3] += bfhi(x.y);
                if (ok) *(f32x4*)(dst + cs) = v;
                ss += (v[0] * v[0] + v[1] * v[1]) + (v[2] * v[2] + v[3] * v[3]); }
        ss += __shfl_xor(ss, 16); ss += __shfl_xor(ss, 32);
        if (fq == 0) SSQ[(size_t)row * 16 + u.pn * 4 + wc] = ss;
    }
    DI void operator()(const f32x4 (&acc)[2][2][4][2], const Unit& u, int wr, int wc, int fr, int fq) const {
        const int cb = u.pn * 256 + wc * 32 + 4 * fq, row0 = u.pm * 256 + wr * 64 + fr;
#pragma unroll
        for (int ai = 0; ai < 2; ++ai) {
            u32x2 x[4][2][2];
#pragma unroll
            for (int m = 0; m < 4; ++m)
#pragma unroll
                for (int bj = 0; bj < 2; ++bj)
#pragma unroll
                    for (int n = 0; n < 2; ++n) x[m][bj][n] = *(const u32x2*)(XB + (size_t)(row0 + ai * 128 + m * 16) * 1024 + cb + bj * 128 + n * 16);
#pragma unroll
            for (int m = 0; m < 4; ++m) { const int row = row0 + ai * 128 + m * 16; float ss = 0.f;
                const int b = row / TP, t = row - b * TP; const bool ok = row < NT && (row >= NTP || t >= 16);
                float* dst = out + (row >= NTP ? O_YS + (size_t)(row - NTP) * 1024 : O_YP + ((size_t)b * 4096 + (t - 16)) * 1024);
#pragma unroll
                for (int bj = 0; bj < 2; ++bj)
#pragma unroll
                    for (int n = 0; n < 2; ++n) { const int cs = cb + bj * 128 + n * 16; f32x4 v = acc[ai][bj][m][n]; const u32x2 xx = x[m][bj][n];
                        v[0] += bflo(xx.x); v[1] += bfhi(xx.x); v[2] += bflo(xx.y); v[3] += bfhi(xx.y);
                        if (ok) *(f32x4*)(dst + cs) = v;
                        ss += (v[0] * v[0] + v[1] * v[1]) + (v[2] * v[2] + v[3] * v[3]); }
                ss += __shfl_xor(ss, 16); ss += __shfl_xor(ss, 32);
                if (fq == 0) SSQ[(size_t)row * 16 + u.pn * 4 + wc] = ss; } }
    }
};
template <class Epi> DI void run_gemm(LAS unsigned char* lds, const bf16_t* A, const bf16_t* Bt, int N, int K, const Epi& E) {
    pg8::Gemm g; g.A = A; g.Bt = Bt; g.M = MP; g.N = N; g.K = K; g.part = nullptr;
    pg8::StaticOrder S; S.init(MP, N, (int)gridDim.x, (int)blockIdx.x);
    pg8::gemm_phase<Epi, pg8::StaticOrder>(lds, g, S, E);
}
struct SplitOrder : pg8::StaticOrder {
    int nwhole, ntail, S, nks;
    DI void init2(int N, int K) { init(MP, N, (int)gridDim.x, (int)blockIdx.x); nwhole = nwg / G; ntail = nwg - nwhole * G; S = 0; nks = 0;
        if (ntail > 0) { int s = G / ntail; const int nkt = K / 64; while (s > 1 && (nkt % s != 0 || (nkt / s) < 4 || ((nkt / s) & 1))) --s; if (s > 1) { S = s; nks = nkt / s; } } }
    DI bool next(int i, Unit& u) const {
        if (S == 0) return pg8::StaticOrder::next(i, u);
        if (i < nwhole) { map(i * G + c, u); return true; }
        if (i == nwhole && c < ntail * S) { map(nwhole * G + c / S, u); u.kb = (c % S) * nks; u.nk = nks; u.part = c; return true; }
        return false;
    }
};
template <class Epi> DI void run_gemm_split(LAS unsigned char* lds, const bf16_t* A, const bf16_t* Bt, int N, int K, const Epi& E, float* part) {
    pg8::Gemm g; g.A = A; g.Bt = Bt; g.M = MP; g.N = N; g.K = K; g.part = part;
    SplitOrder S; S.init2(N, K);
    pg8::gemm_phase<Epi, SplitOrder>(lds, g, S, E);
}
template <class Epi> DI void gemm_fixup(int N, int K, const Epi& E, const float* part, int tid) {
    SplitOrder S; S.init2(N, K); if (S.S == 0) return;
    const int wid = tid >> 6, lane = tid & 63, wr = wid >> 2, wc = wid & 3, fr = lane & 15, fq = lane >> 4;
    for (int it = blockIdx.x; it < S.ntail * 8; it += gridDim.x) { const int j = it >> 3, ai = (it >> 2) & 1, m = it & 3; Unit u; S.map(S.nwhole * S.G + j, u);
        f32x4 a4[2][2];
#pragma unroll
        for (int b = 0; b < 2; ++b)
#pragma unroll
            for (int n = 0; n < 2; ++n) { const f32x4* pp = (const f32x4*)part + ((size_t)(j * S.S) * 32 + (((ai * 2 + b) * 4 + m) * 2 + n)) * 512 + tid;
                f32x4 v0 = {0.f, 0.f, 0.f, 0.f}, v1 = v0, v2 = v0, v3 = v0;
                for (int sl = 0; sl + 3 < S.S; sl += 4) { v0 += pp[(size_t)sl * 16384]; v1 += pp[(size_t)(sl + 1) * 16384]; v2 += pp[(size_t)(sl + 2) * 16384]; v3 += pp[(size_t)(sl + 3) * 16384]; }
                for (int sl = S.S & ~3; sl < S.S; ++sl) v0 += pp[(size_t)sl * 16384];
                a4[b][n] = (v0 + v1) + (v2 + v3); }
        E.row(a4, u, ai, m, wr, wc, fr, fq); }
}
DI void transpose_item(const float* W, int N, bf16_t* WT, size_t ldo, const float* sc, LAS float* scr, int item, int lane) {
    const int nblk = N / 32, kb = item / nblk, nb = item % nblk, k0 = 64 * kb, n0 = 32 * nb;
#pragma unroll 8
    for (int i = 0; i < 32; ++i) { const int kk = 2 * i + (lane >> 5); float w = W[(size_t)(k0 + kk) * N + n0 + (lane & 31)]; if (sc) w *= sc[k0 + kk]; scr[kk * 33 + (lane & 31)] = w; }
    LDS_WAIT();
    const int c = lane & 7;
#pragma unroll
    for (int j = 0; j < 4; ++j) { const int n = (lane >> 3) + 8 * j; const LAS float* s = scr + (8 * c) * 33 + n;
        u32x4v o; o.x = pk2(s[0 * 33], s[1 * 33]); o.y = pk2(s[2 * 33], s[3 * 33]); o.z = pk2(s[4 * 33], s[5 * 33]); o.w = pk2(s[6 * 33], s[7 * 33]);
        *(u32x4v*)(WT + (size_t)(n0 + n) * ldo + k0 + 8 * c) = o; }
    LDS_WAIT();
}
DI void s5_pow(const Prm& p, int g, int n, float k, float& re, float& im) {
    const float dt = __expf(p.log_dt[g]), ar = p.a_re[g * 64 + n], ai = p.a_im[g * 64 + n];
    const float mag = __expf(k * dt * ar); float rev = k * dt * ai * 0.15915494309189535f; rev -= rintf(rev);
    re = mag * __builtin_amdgcn_cosf(rev); im = mag * __builtin_amdgcn_sinf(rev);
}
DI void s5_bbar(const Prm& p, int g, int n, int pp, float& re, float& im) {
    const float ar = p.a_re[g * 64 + n], ai = p.a_im[g * 64 + n]; float abr, abi; s5_pow(p, g, n, 1.f, abr, abi);
    const float den = ar * ar + ai * ai, zr = ((abr - 1.f) * ar + abi * ai) / den, zi = (abi * ar - (abr - 1.f) * ai) / den;
    const float br = p.b_re[(g * 64 + n) * 16 + pp], bi = p.b_im[(g * 64 + n) * 16 + pp];
    re = zr * br - zi * bi; im = zr * bi + zi * br;
}
DI void phase_prologue(const Prm& p, LAS unsigned char* lds, int tid, int lane, int wave) {
    const int gw = blockIdx.x * 8 + wave, NGW = gridDim.x * 8, gtid = blockIdx.x * 512 + tid, GT = gridDim.x * 512;
    LAS float* scr = (LAS float*)(lds + wave * 16384);
    constexpr int I1 = 16 * 80, I2 = 8 * 16, I3 = 16 * 32, I4 = 16 * 128, I5 = 64 * 32, I6 = 16 * 96;
    constexpr int NITEMS = I1 + I2 + I3 + I4 + I5 + I6 + I3 + I4 + I5;
    for (int it = gw; it < NITEMS; it += NGW) {
        int r = it;
        if (r < I1) { transpose_item(p.w_in_even, 2560, p.Wt1, 1024, p.ln_mix, scr, r, lane); continue; } r -= I1;
        if (r < I2) { transpose_item(p.w_glu, 512, p.Wglu, 512, nullptr, scr, r, lane); continue; } r -= I2;
        if (r < I3) { transpose_item(p.w_out_even, 1024, p.Wo0, 1024, nullptr, scr, r, lane); continue; } r -= I3;
        if (r < I4) { transpose_item(p.w_up, 4096, p.Wup0, 1024, p.ln_mlp, scr, r, lane); continue; } r -= I4;
        if (r < I5) { transpose_item(p.w_down, 1024, p.Wdn0, 4096, nullptr, scr, r, lane); continue; } r -= I5;
        if (r < I6) { transpose_item(p.w_in_odd, 3072, p.Wqkv, 1024, p.ln_mix + 1024, scr, r, lane); continue; } r -= I6;
        if (r < I3) { transpose_item(p.w_out_odd, 1024, p.Wo1, 1024, nullptr, scr, r, lane); continue; } r -= I3;
        if (r < I4) { transpose_item(p.w_up + (size_t)1024 * 4096, 4096, p.Wup1, 1024, p.ln_mlp + 1024, scr, r, lane); continue; } r -= I4;
        transpose_item(p.w_down + (size_t)4096 * 1024, 1024, p.Wdn1, 4096, nullptr, scr, r, lane);
    }
    for (int row = gw; row < NT; row += NGW) {
        const float* src;
        if (row < NTP) { const int b = row / TP, t = row - b * TP; src = t < 16 ? p.meta + (size_t)t * 1024 : p.x_prompt + ((size_t)b * 4096 + (t - 16)) * 1024; }
        else src = p.x_sample + (size_t)(row - NTP) * 1024;
        float ss = 0.f;
#pragma unroll
        for (int j = 0; j < 4; ++j) { const f32x4 v = ((const f32x4*)src)[lane + 64 * j]; u32x2 o; o.x = pk2(v.x, v.y); o.y = pk2(v.z, v.w);
            const float a0 = bflo(o.x), a1 = bfhi(o.x), a2 = bflo(o.y), a3 = bfhi(o.y); ss += (a0 * a0 + a1 * a1) + (a2 * a2 + a3 * a3);
            ((u32x2*)(p.XB + (size_t)row * 1024))[lane + 64 * j] = o; }
        ss = wave_sum(ss);
        if (lane < 16) p.SSQ[(size_t)row * 16 + lane] = lane == 0 ? ss : 0.f;
    }
    if (gtid < 512) p.LB[gtid] = 1.f / (1.f + __expf(p.hgrn_lb[512 + gtid] - p.hgrn_lb[gtid]));
    __syncthreads();
    {
        LAS float* zr_ = (LAS float*)lds; LAS float* zi_ = zr_ + 64; LAS float* wr_ = zi_ + 64; LAS float* wi_ = wr_ + 64;
        LAS float* bbr = wi_ + 64; LAS float* bbi = bbr + 1024; LAS float* cwr = bbi + 1024; LAS float* cwi = cwr + 16 * 65;
        for (int pair = blockIdx.x; pair < 512; pair += gridDim.x) { const int g = pair >> 4, tau = pair & 15;
            if (tid < 64) { const int n = tid; const float ar = p.a_re[g * 64 + n], ai = p.a_im[g * 64 + n]; float abr, abi; s5_pow(p, g, n, 1.f, abr, abi);
                const float den = ar * ar + ai * ai; zr_[n] = ((abr - 1.f) * ar + abi * ai) / den; zi_[n] = (abi * ar - (abr - 1.f) * ai) / den;
                float a, b; s5_pow(p, g, n, (float)tau, a, b); wr_[n] = a; wi_[n] = b; }
            __syncthreads();
#pragma unroll
            for (int k = 0; k < 2; ++k) { const int e = tid + 512 * k;
                { const int n = e >> 4; const float br = p.b_re[g * 1024 + e], bi = p.b_im[g * 1024 + e]; bbr[e] = zr_[n] * br - zi_[n] * bi; bbi[e] = zr_[n] * bi + zi_[n] * br; }
                { const int pch = e >> 6, n = e & 63; const float cr = p.c_re[g * 1024 + e], ci = p.c_im[g * 1024 + e]; cwr[pch * 65 + n] = cr * wr_[n] - ci * wi_[n]; cwi[pch * 65 + n] = cr * wi_[n] + ci * wr_[n]; } }
            __syncthreads();
            if (tid < 256) { const int pch = tid >> 4, pp = tid & 15; float acc = 0.f;
#pragma unroll 8
                for (int n = 0; n < 64; ++n) acc += cwr[pch * 65 + n] * bbr[n * 16 + pp] - cwi[pch * 65 + n] * bbi[n * 16 + pp];
                if (tau == 0 && pch == pp) acc += p.ssm_d[g * 16 + pch];
                const bf16_t kv = f2bf(acc);
                p.TG[((g * 16 + tau) * 16 + pch) * 16 + pp] = kv; }
            __syncthreads(); }
    }
    for (int i = gtid; i < 32 * 256 * 64; i += GT) {
        const int g = i >> 14, t = (i >> 10) & 15, pch = (i >> 6) & 15, n = i & 63; float wr_, wi_; s5_pow(p, g, n, (float)(t + 1), wr_, wi_);
        const float cr = p.c_re[(g * 16 + pch) * 64 + n], ci = p.c_im[(g * 16 + pch) * 64 + n];
        *(unsigned*)(p.TG + 131072 + ((size_t)(g * 256 + t * 16 + pch)) * 128 + 2 * n) = pk2(cr * wr_ - ci * wi_, -(cr * wi_ + ci * wr_)); }
    for (int i = gtid; i < 32 * 64 * 256; i += GT) {
        const int g = i >> 14, n = (i >> 8) & 63, s = (i >> 4) & 15, pp = i & 15; float wr_, wi_, br_, bi_; s5_pow(p, g, n, (float)(15 - s), wr_, wi_); s5_bbar(p, g, n, pp, br_, bi_);
        p.HT[((size_t)(g * 128 + 2 * n)) * 256 + s * 16 + pp] = f2bf(wr_ * br_ - wi_ * bi_);
        p.HT[((size_t)(g * 128 + 2 * n + 1)) * 256 + s * 16 + pp] = f2bf(wr_ * bi_ + wi_ * br_); }
    if (gtid < 2048) { float wr_, wi_; s5_pow(p, gtid >> 6, gtid & 63, 16.f, wr_, wi_); p.A16[2 * gtid] = wr_; p.A16[2 * gtid + 1] = wi_; }
}

constexpr int HP = 136, TPI = 72;
constexpr int L_QT = 0, L_QH = 17408, L_KT = 34816, L_KTT = 52224, L_IVT = 70656, L_ATT = 89088, L_SUM = 98304, L_VEC = 100352, L_OB = 0  ;
struct HItem { int row0, L, h, bh; };
DI HItem hgrn_item(int item) {
    HItem it;
    if (item < 2080) { const int bh = item / 65, c = item - bh * 65, b = bh >> 2; it.h = bh & 3; it.bh = bh; it.L = c == 0 ? 16 : 64; it.row0 = b * TP + (c == 0 ? 0 : 16 + 64 * (c - 1)); }
    else { const int s = item - 2080, b = s >> 2; it.h = s & 3; it.bh = 32 + s; it.L = 64; it.row0 = NTP + b * 64; }
    return it;
}
template <bool FULL> DI void hgrn_loadraw(const Prm& p, const HItem& it, int tid, unsigned (&rl)[16], unsigned (&rv)[16], unsigned (&rq)[16]) {
    const int d = tid & 127, t0 = 16 * (tid >> 7), col = it.h * 128 + d;
#pragma unroll
    for (int j = 0; j < 16; ++j) { const int t = t0 + j; const bool valid = t < it.L; const size_t o = (size_t)(it.row0 + t) * 512 + col;
        rl[j] = valid ? (unsigned)p.LOGF[o] : 0u; rv[j] = valid ? (unsigned)p.IV[o] : 0u; if (FULL) rq[j] = valid ? (unsigned)p.Qh[o] : 0u; }
}
template <bool FULL> DI void hgrn_prep(const HItem& it, LAS unsigned char* lds, int tid, const unsigned (&rl)[16], const unsigned (&rv)[16], const unsigned (&rq)[16]) {
    const int d = tid & 127, tq = tid >> 7, t0 = 16 * tq;
    LAS float* sums = (LAS float*)(lds + L_SUM); LAS float* vec = (LAS float*)(lds + L_VEC);
    float cs[16], lf[16];
    float run = 0.f;
#pragma unroll
    for (int j = 0; j < 16; ++j) { lf[j] = h2f((unsigned short)rl[j]); run += lf[j]; cs[j] = run; }
    sums[tq * 128 + d] = run;
    { LAS u32x4v* dst = (LAS u32x4v*)(lds + L_IVT + (d * TPI + t0) * 2); u32x4v a, b;
        a.x = rv[0] | (rv[1] << 16); a.y = rv[2] | (rv[3] << 16); a.z = rv[4] | (rv[5] << 16); a.w = rv[6] | (rv[7] << 16);
        b.x = rv[8] | (rv[9] << 16); b.y = rv[10] | (rv[11] << 16); b.z = rv[12] | (rv[13] << 16); b.w = rv[14] | (rv[15] << 16); dst[0] = a; dst[1] = b; }
    __syncthreads();
    const float s0 = sums[d], s1 = sums[128 + d], s2 = sums[256 + d], s3 = sums[384 + d];
    const float off = tq == 0 ? 0.f : tq == 1 ? s0 : tq == 2 ? s0 + s1 : s0 + s1 + s2, r = s0 + s1, bL = r + s2 + s3;
    if (tq == 0) { vec[d] = r; vec[128 + d] = bL; }
    unsigned ktp[8]; float kprev = 0.f;
#pragma unroll
    for (int j = 0; j < 16; ++j) { const int t = t0 + j; const bool valid = t < it.L; const float b = off + cs[j];
        const float kt = valid ? (1.f - __expf(lf[j])) * __expf(r - b) : 0.f;
        if (j & 1) ktp[j >> 1] = pk2(kprev, kt); else kprev = kt;
        if (FULL) { const float qv = bf2f((unsigned short)rq[j]);
            *(LAS unsigned short*)(lds + L_KT + (t * HP + d) * 2) = f2bf(kt);
            *(LAS unsigned short*)(lds + L_QT + (t * HP + d) * 2) = f2bf(qv * __expf(b - r));
            *(LAS unsigned short*)(lds + L_QH + (t * HP + d) * 2) = f2bf(qv * __expf(b)); } }
    if (!FULL) { LAS u32x4v* dst = (LAS u32x4v*)(lds + L_KTT + (d * TPI + t0) * 2); u32x4v a, b; a.x = ktp[0]; a.y = ktp[1]; a.z = ktp[2]; a.w = ktp[3]; b.x = ktp[4]; b.y = ktp[5]; b.z = ktp[6]; b.w = ktp[7]; dst[0] = a; dst[1] = b; }
    __syncthreads();
}
#define MFMA16(a, b, c) __builtin_amdgcn_mfma_f32_16x16x32_bf16((a), (b), (c), 0, 0, 0)
#define MFMA32(a, b, c) __builtin_amdgcn_mfma_f32_32x32x16_bf16((a), (b), (c), 0, 0, 0)
DI void hgrn_b1_all(const Prm& p, LAS unsigned char* lds, int tid, int lane, int wave) {
    const int fr = lane & 15, fq = lane >> 4;
    int item = blockIdx.x; if (item >= NITEM_H) return;
    unsigned rl[16], rv[16], rq[16];
    hgrn_loadraw<false>(p, hgrn_item(item), tid, rl, rv, rq);
    while (item < NITEM_H) {
        const HItem it = hgrn_item(item);
        hgrn_prep<false>(it, lds, tid, rl, rv, rq);
        const int next = item + gridDim.x;
        if (next < NITEM_H) hgrn_loadraw<false>(p, hgrn_item(next), tid, rl, rv, rq);
        const LAS float* vec = (const LAS float*)(lds + L_VEC);
        bf16x8 a[2];
#pragma unroll
        for (int ks = 0; ks < 2; ++ks) a[ks] = *(const LAS bf16x8*)(lds + L_KTT + ((16 * wave + fr) * TPI + 32 * ks + 8 * fq) * 2);
        float e2[4];
#pragma unroll
        for (int j = 0; j < 4; ++j) { const int d = 16 * wave + 4 * fq + j; e2[j] = __expf(vec[128 + d] - vec[d]); }
#pragma unroll
        for (int vt = 0; vt < 8; ++vt) { f32x4 acc = {0.f, 0.f, 0.f, 0.f};
#pragma unroll
            for (int ks = 0; ks < 2; ++ks) { const bf16x8 b = *(const LAS bf16x8*)(lds + L_IVT + ((16 * vt + fr) * TPI + 32 * ks + 8 * fq) * 2); acc = MFMA16(a[ks], b, acc); }
            u32x2 o; o.x = pk2(acc[0] * e2[0], acc[1] * e2[1]); o.y = pk2(acc[2] * e2[2], acc[3] * e2[3]);
            *(u32x2*)(p.UT + (size_t)item * 16384 + (16 * vt + fr) * 128 + 16 * wave + 4 * fq) = o; }
        if (tid < 128) p.AL[(size_t)item * 128 + tid] = __expf(vec[128 + tid]);
        __syncthreads();
        item = next;
    }
}
DI void hgrn_b2(const Prm& p, int gtid, int GT) {
    for (int idx = gtid; idx < 64 * 4096; idx += GT) {
        const int bhx = idx >> 12, e = idx & 4095, v = e >> 5, d4 = (e & 31) * 4; const bool smp = bhx >= 32;
        const int item0 = smp ? 2080 + (bhx - 32) : bhx * 65, nch = smp ? 1 : 65;
        float S[4] = {0.f, 0.f, 0.f, 0.f};
        if (smp) {
#pragma unroll
            for (int j = 0; j < 4; ++j) S[j] = p.state_hgrn[((size_t)(bhx - 32) * 128 + d4 + j) * 128 + v]; }
        for (int c0 = 0; c0 < nch; c0 += 5) {
            u32x2 uu[5]; f32x4 al[5];
#pragma unroll
            for (int i = 0; i < 5; ++i) if (c0 + i < nch) { uu[i] = *(const u32x2*)(p.UT + (size_t)(item0 + c0 + i) * 16384 + v * 128 + d4); al[i] = *(const f32x4*)(p.AL + (size_t)(item0 + c0 + i) * 128 + d4); }
#pragma unroll
            for (int i = 0; i < 5; ++i) if (c0 + i < nch) { u32x2 o; o.x = pk2(S[0], S[1]); o.y = pk2(S[2], S[3]);
                *(u32x2*)(p.UT + (size_t)(item0 + c0 + i) * 16384 + v * 128 + d4) = o;
                S[0] = al[i][0] * S[0] + bflo(uu[i].x); S[1] = al[i][1] * S[1] + bfhi(uu[i].x); S[2] = al[i][2] * S[2] + bflo(uu[i].y); S[3] = al[i][3] * S[3] + bfhi(uu[i].y); } }
        float* dst = p.out + (smp ? O_HGS + (size_t)(bhx - 32) * 16384 : O_HGP + (size_t)bhx * 16384);
#pragma unroll
        for (int j = 0; j < 4; ++j) dst[(d4 + j) * 128 + v] = S[j];
    }
}
DI void hgrn_b3_all(const Prm& p, LAS unsigned char* lds, int tid, int lane, int wave) {
    const int fr = lane & 15, fq = lane >> 4;
    int item = blockIdx.x; if (item >= NITEM_H) return;
    unsigned rl[16], rv[16], rq[16];
    hgrn_loadraw<true>(p, hgrn_item(item), tid, rl, rv, rq);
    const int nt_ = tid >> 3, nsg = tid & 7;
    while (item < NITEM_H) {
        const HItem it = hgrn_item(item);
        bf16x8 sf[4][4];
#pragma unroll
        for (int i = 0; i < 4; ++i)
#pragma unroll
            for (int ks = 0; ks < 4; ++ks) sf[i][ks] = *(const bf16x8*)(p.UT + (size_t)item * 16384 + (16 * (4 * (wave >> 2) + i) + fr) * 128 + 32 * ks + 8 * fq);
        const size_t grow = (size_t)(it.row0 + (nt_ < it.L ? nt_ : 0)); const int gc0 = it.h * 128 + 16 * nsg;
        const u32x4v g0 = *(const u32x4v*)(p.GS + grow * 512 + gc0), g1 = *(const u32x4v*)(p.GS + grow * 512 + gc0 + 8);
        hgrn_prep<true>(it, lds, tid, rl, rv, rq);
        const int next = item + gridDim.x;
        if (next < NITEM_H) hgrn_loadraw<true>(p, hgrn_item(next), tid, rl, rv, rq);
        {
            const int tt = wave >> 1;
#pragma unroll
            for (int i = 0; i < 2; ++i) { const int st = 2 * (wave & 1) + i; f32x4 acc = {0.f, 0.f, 0.f, 0.f};
#pragma unroll
                for (int ks = 0; ks < 4; ++ks) { const bf16x8 a = *(const LAS bf16x8*)(lds + L_KT + ((16 * st + fr) * HP + 32 * ks + 8 * fq) * 2);
                    const bf16x8 b = *(const LAS bf16x8*)(lds + L_QT + ((16 * tt + fr) * HP + 32 * ks + 8 * fq) * 2); acc = MFMA16(a, b, acc); }
                const int t = 16 * tt + fr, s0 = 16 * st + 4 * fq;
                u32x2 o; o.x = pk2(s0 <= t ? acc[0] : 0.f, s0 + 1 <= t ? acc[1] : 0.f); o.y = pk2(s0 + 2 <= t ? acc[2] : 0.f, s0 + 3 <= t ? acc[3] : 0.f);
                *(LAS u32x2*)(lds + L_ATT + (t * TPI + s0) * 2) = o; }
        }
        __syncthreads();
        f32x4 oacc[4];
        {   const int tt = wave & 3;
            bf16x8 aa[2], aq[4];
#pragma unroll
            for (int ks = 0; ks < 2; ++ks) aa[ks] = *(const LAS bf16x8*)(lds + L_ATT + ((16 * tt + fr) * TPI + 32 * ks + 8 * fq) * 2);
#pragma unroll
            for (int ks = 0; ks < 4; ++ks) aq[ks] = *(const LAS bf16x8*)(lds + L_QH + ((16 * tt + fr) * HP + 32 * ks + 8 * fq) * 2);
#pragma unroll
            for (int i = 0; i < 4; ++i) { const int vt = 4 * (wave >> 2) + i; f32x4 acc = {0.f, 0.f, 0.f, 0.f};
#pragma unroll
                for (int ks = 0; ks < 2; ++ks) { const bf16x8 b = *(const LAS bf16x8*)(lds + L_IVT + ((16 * vt + fr) * TPI + 32 * ks + 8 * fq) * 2); acc = MFMA16(aa[ks], b, acc); }
#pragma unroll
                for (int ks = 0; ks < 4; ++ks) acc = MFMA16(aq[ks], sf[i][ks], acc);
                oacc[i] = acc; }
        }
        f32x4 gn[4];
#pragma unroll
        for (int j = 0; j < 4; ++j) gn[j] = ((const f32x4*)(p.hgrn_norm + 16 * nsg))[j];
        __syncthreads();
        {   const int tt = wave & 3; LAS float* ob = (LAS float*)(lds + L_OB);
#pragma unroll
            for (int i = 0; i < 4; ++i) { const int v = 16 * (4 * (wave >> 2) + i) + fr;
#pragma unroll
                for (int j = 0; j < 4; ++j) ob[(16 * tt + 4 * fq + j) * 132 + v] = oacc[i][j]; }
        }
        __syncthreads();
        {   const int t = nt_, sg = nsg; const LAS float* ob = (const LAS float*)(lds + L_OB) + t * 132 + 16 * sg;
            f32x4 x[4]; float ss = 0.f;
#pragma unroll
            for (int j = 0; j < 4; ++j) { x[j] = ((const LAS f32x4*)ob)[j]; ss += (x[j].x * x[j].x + x[j].y * x[j].y) + (x[j].z * x[j].z + x[j].w * x[j].w); }
            ss += __shfl_xor(ss, 1); ss += __shfl_xor(ss, 2); ss += __shfl_xor(ss, 4);
            const float rr = rsqrtf(ss * (1.f / 128.f) + EPSN);
            if (t < it.L) { const size_t row = it.row0 + t; const int c0 = it.h * 128 + 16 * sg;
                const f32x4 n0 = gn[0], n1 = gn[1], n2 = gn[2], n3 = gn[3];
                u32x4v o0, o1;
                o0.x = pk2(x[0].x * rr * n0.x * bflo(g0.x), x[0].y * rr * n0.y * bfhi(g0.x)); o0.y = pk2(x[0].z * rr * n0.z * bflo(g0.y), x[0].w * rr * n0.w * bfhi(g0.y));
                o0.z = pk2(x[1].x * rr * n1.x * bflo(g0.z), x[1].y * rr * n1.y * bfhi(g0.z)); o0.w = pk2(x[1].z * rr * n1.z * bflo(g0.w), x[1].w * rr * n1.w * bfhi(g0.w));
                o1.x = pk2(x[2].x * rr * n2.x * bflo(g1.x), x[2].y * rr * n2.y * bfhi(g1.x)); o1.y = pk2(x[2].z * rr * n2.z * bflo(g1.y), x[2].w * rr * n2.w * bfhi(g1.y));
                o1.z = pk2(x[3].x * rr * n3.x * bflo(g1.z), x[3].y * rr * n3.y * bfhi(g1.z)); o1.w = pk2(x[3].z * rr * n3.z * bflo(g1.w), x[3].w * rr * n3.w * bfhi(g1.w));
                *(u32x4v*)(p.CAT + row * 1024 + c0) = o0; *(u32x4v*)(p.CAT + row * 1024 + c0 + 8) = o1; }
        }
        __syncthreads();
        item = next;
    }
}
DI void s5_load_u(const Prm& p, int mt, int g, int lane, bf16x8 (&uf)[8]) {
    const int fr = lane & 15, fq = lane >> 4; int col = 16 * mt + fr; if (col >= NCOL) col = NCOL - 1;
#pragma unroll
    for (int ks = 0; ks < 8; ++ks) uf[ks] = *(const bf16x8*)(p.U + ((size_t)(16 * col + 2 * ks + (fq >> 1))) * 512 + 16 * g + 8 * (fq & 1));
}
DI void s5_b(const Prm& p, int gw, int NGW, int lane) {
    const int fr = lane & 15, fq = lane >> 4;
    for (int task = gw; task < 131 * 32; task += NGW) { const int mt = task >> 5, g = task & 31;
        bf16x8 uf[8]; s5_load_u(p, mt, g, lane, uf);
#pragma unroll
        for (int nt = 0; nt < 8; ++nt) { f32x4 acc = {0.f, 0.f, 0.f, 0.f};
#pragma unroll
            for (int ks = 0; ks < 8; ++ks) { const bf16x8 b = *(const bf16x8*)(p.HT + ((size_t)(g * 128 + 16 * nt + fr)) * 256 + 32 * ks + 8 * fq); acc = MFMA16(uf[ks], b, acc); }
#pragma unroll
            for (int j = 0; j < 4; ++j) { const int col = 16 * mt + 4 * fq + j; if (col < NCOL) p.XLOC[(size_t)col * 4096 + g * 128 + 16 * nt + fr] = acc[j]; } }
    }
}
DI void s5_c(const Prm& p, int gtid) {
    if (gtid >= 16 * 2048) return;
    const int seq = gtid >> 11, g = (gtid >> 6) & 31, n = gtid & 63; const bool smp = seq >= 8; const int b = seq & 7;
    const int col0 = smp ? 2056 + 4 * b : 257 * b, nch = smp ? 4 : 257;
    float xr = 0.f, xi = 0.f; if (smp) { xr = p.ssm_re0[(b * 32 + g) * 64 + n]; xi = p.ssm_im0[(b * 32 + g) * 64 + n]; }
    const float ar = p.A16[2 * (g * 64 + n)], ai = p.A16[2 * (g * 64 + n) + 1];
    const size_t base = (size_t)g * 128 + 2 * n;
    for (int c0 = 0; c0 < nch; c0 += 8) {
        f32x2v xl[8];
#pragma unroll
        for (int i = 0; i < 8; ++i) if (c0 + i < nch) xl[i] = *(const f32x2v*)(p.XLOC + (size_t)(col0 + c0 + i) * 4096 + base);
#pragma unroll
        for (int i = 0; i < 8; ++i) if (c0 + i < nch) { *(unsigned*)(p.XPREV + (size_t)(col0 + c0 + i) * 4096 + base) = pk2(xr, xi);
            const float nr = ar * xr - ai * xi + xl[i].x, ni = ar * xi + ai * xr + xl[i].y; xr = nr; xi = ni; } }
    const size_t o = (size_t)(b * 32 + g) * 64 + n;
    p.out[(smp ? O_SRS : O_SRP) + o] = xr; p.out[(smp ? O_SIS : O_SIP) + o] = xi;
}
DI f32x2v gelu_pk(f32x2v v) {
    const f32x2v av = __builtin_elementwise_abs(v), d = av * 0.2316418882f + 1.0f;
    f32x2v t; t.x = __builtin_amdgcn_rcpf(d.x); t.y = __builtin_amdgcn_rcpf(d.y);
    f32x2v q = t * 0.5307027145f + (-0.7265760135f); q = q * t + 0.7107068705f; q = q * t + (-0.142248368f); q = q * t + 0.127414796f; q = q * t;
    const f32x2v s = (v * v) * (-0.72134752044f);
    f32x2v e; e.x = __builtin_amdgcn_exp2f(s.x); e.y = __builtin_amdgcn_exp2f(s.y);
    const f32x2v m = v * (q * e), r = v - m;
    f32x2v o; o.x = v.x < 0.f ? m.x : r.x; o.y = v.y < 0.f ? m.y : r.y; return o;
}
DI void s5_d(const Prm& p, int gw, int NGW, int lane) {
    const int fr = lane & 15, fq = lane >> 4;
    for (int task = gw; task < 131 * 32; task += NGW) { const int mt = task >> 5, g = task & 31;
        bf16x8 uf[8], xf[4]; s5_load_u(p, mt, g, lane, uf);
        int colc = 16 * mt + fr; if (colc >= NCOL) colc = NCOL - 1;
#pragma unroll
        for (int ks = 0; ks < 4; ++ks) xf[ks] = *(const bf16x8*)(p.XPREV + (size_t)colc * 4096 + g * 128 + 32 * ks + 8 * fq);
        const bf16_t* tg = p.TG + ((size_t)(g * 256 + fr)) * 384 + 8 * fq;
        const bool ok = 16 * mt + fr < NCOL;
#pragma unroll
        for (int t = 0; t < 16; ++t) { f32x4 acc = {0.f, 0.f, 0.f, 0.f};
#pragma unroll
            for (int ks = 0; ks < 8; ++ks) if (ks <= (t >> 1)) { const bf16x8 a = *(const bf16x8*)(tg + (size_t)t * 16 * 384 + 32 * ks); acc = MFMA16(a, uf[ks], acc); }
#pragma unroll
            for (int ks = 0; ks < 4; ++ks) { const bf16x8 a = *(const bf16x8*)(tg + (size_t)t * 16 * 384 + 256 + 32 * ks); acc = MFMA16(a, xf[ks], acc); }
            const f32x2v y0 = gelu_pk((f32x2v){acc[0], acc[1]}), y1 = gelu_pk((f32x2v){acc[2], acc[3]});
            u32x2 o; o.x = pk2(y0.x, y0.y); o.y = pk2(y1.x, y1.y);
            if (ok) *(u32x2*)(p.YG + ((size_t)(16 * (16 * mt + fr) + t)) * 512 + 16 * g + 4 * fq) = o; }
    }
}

DI void s5_b_lds(const Prm& p, LAS unsigned char* lds, int tid, int lane, int wave) {
    const int fr = lane & 15, fq = lane >> 4;
    for (int gp = blockIdx.x; gp < 256; gp += gridDim.x) { const int g = gp & 31, part = gp >> 5;
        for (int i = tid; i < 128 * 32; i += 512) { const int row = i >> 5, ch = i & 31;
            *(LAS u32x4v*)(lds + row * 528 + ch * 16) = *(const u32x4v*)(p.HT + ((size_t)(g * 128 + row)) * 256 + ch * 8); }
        __syncthreads();
        for (int mt = part + 8 * wave; mt < 131; mt += 64) {
            bf16x8 uf[8]; s5_load_u(p, mt, g, lane, uf);
#pragma unroll 1
            for (int nt = 0; nt < 8; ++nt) { f32x4 acc = {0.f, 0.f, 0.f, 0.f};
#pragma unroll
                for (int ks = 0; ks < 8; ++ks) { const bf16x8 b = *(const LAS bf16x8*)(lds + (16 * nt + fr) * 528 + 64 * ks + 16 * fq); acc = MFMA16(uf[ks], b, acc); }
#pragma unroll
                for (int j = 0; j < 4; ++j) { const int col = 16 * mt + 4 * fq + j; if (col < NCOL) p.XLOC[(size_t)col * 4096 + g * 128 + 16 * nt + fr] = acc[j]; } }
        }
        __syncthreads(); }
}
DI void s5_d_lds(const Prm& p, LAS unsigned char* lds, int tid, int lane, int wave) {
    const int fr = lane & 15, fq = lane >> 4;
    for (int gp = blockIdx.x; gp < 256; gp += gridDim.x) { const int g = gp & 31, part = gp >> 5;
        { const int row = tid >> 1, hf = tid & 1;
            *(LAS u32x4v*)(lds + row * 48 + hf * 16) = *(const u32x4v*)(p.TG + ((size_t)(g * 256 + row)) * 16 + hf * 8); }
        for (int i = tid; i < 256 * 16; i += 512) { const int row = i >> 4, ch = i & 15;
            *(LAS u32x4v*)(lds + 12288 + row * 272 + ch * 16) = *(const u32x4v*)(p.TG + 131072 + ((size_t)(g * 256 + row)) * 128 + ch * 8); }
        __syncthreads();
        const int lb = fr * 48 + (fq & 1) * 16, hi = fq >> 1;
        for (int mt = part + 8 * wave; mt < 131; mt += 64) {
            bf16x8 uf[8], xf[4]; s5_load_u(p, mt, g, lane, uf);
            int colc = 16 * mt + fr; if (colc >= NCOL) colc = NCOL - 1;
#pragma unroll
            for (int ks = 0; ks < 4; ++ks) xf[ks] = *(const bf16x8*)(p.XPREV + (size_t)colc * 4096 + g * 128 + 32 * ks + 8 * fq);
            const bool ok = 16 * mt + fr < NCOL;
#pragma unroll 1
            for (int t = 0; t < 16; ++t) { f32x4 acc = {0.f, 0.f, 0.f, 0.f};
#pragma unroll
                for (int ks = 0; ks < 8; ++ks) if (ks <= (t >> 1)) {
                    const int tau = t - 2 * ks - hi;
                    union { bf16x8 v; u32x4v u; } a; a.v = *(const LAS bf16x8*)(lds + (tau < 0 ? 0 : tau) * 768 + lb);
                    if (tau < 0) a.u = (u32x4v){0u, 0u, 0u, 0u};
                    acc = MFMA16(a.v, uf[ks], acc); }
#pragma unroll
                for (int ks = 0; ks < 4; ++ks) { const bf16x8 a = *(const LAS bf16x8*)(lds + 12288 + (t * 16 + fr) * 272 + 64 * ks + 16 * fq); acc = MFMA16(a, xf[ks], acc); }
                const f32x2v y0 = gelu_pk((f32x2v){acc[0], acc[1]}), y1 = gelu_pk((f32x2v){acc[2], acc[3]});
                u32x2 o; o.x = pk2(y0.x, y0.y); o.y = pk2(y1.x, y1.y);
                if (ok) *(u32x2*)(p.YG + ((size_t)(16 * (16 * mt + fr) + t)) * 512 + 16 * g + 4 * fq) = o; }
        }
        __syncthreads(); }
}
DI void cache_convert(const Prm& p, int gtid, int GT) {
    for (size_t i = (size_t)gtid; i < (size_t)8 * 1024 * 256; i += (size_t)GT) {
        const size_t row = i >> 8; const int c4 = (int)(i & 255) * 4, b = (int)(row >> 10), pos = (int)(row & 1023), h = c4 >> 7, d = c4 & 127;
        const f32x4 k = *(const f32x4*)(p.cache_k + row * 1024 + c4); u32x2 o; o.x = pk2(k.x, k.y); o.y = pk2(k.z, k.w);
        *(u32x2*)(p.KS + kf_index(b * 8 + h, 34, pos, d)) = o;
        const f32x4 v = *(const f32x4*)(p.cache_v + row * 1024 + c4); bf16_t* vt = p.VTS + vf_index(b * 8 + h, 34, pos, d);
        vt[0] = f2bf(v.x); vt[8] = f2bf(v.y); vt[16] = f2bf(v.z); vt[24] = f2bf(v.w); }
}
DI void attn_phase(const Prm& p, int gw, int NGW, int lane) {
    const int q = lane & 31, half = lane >> 5;
    for (int it = gw; it < 8256 + 128; it += NGW) {
        bool smp; int b, h, qb;
        if (it < 8064) { smp = false; b = it / 1008; const int rem = it - b * 1008; h = rem / 126; qb = 3 + rem - h * 126; }
        else if (it < 8192) { const int s = it - 8064; smp = true; b = s >> 4; h = (s >> 1) & 7; qb = s & 1; }
        else { const int s = it - 8192; smp = false; b = s / 24; const int rem = s - b * 24; h = rem / 3; qb = rem - h * 3; }
        const size_t tbase = (size_t)(b * 8 + h) * (smp ? 34 : 129) * 4096 + lane * 8;
        const bf16_t* Kb = (smp ? p.KS : p.KP) + tbase; const bf16_t* Vb = (smp ? p.VTS : p.VTP) + tbase;
        const int qpos0 = (smp ? 1024 : 0) + 32 * qb, qrow0 = smp ? NTP + b * 64 + 32 * qb : b * TP + 32 * qb;
        const int qpos = qpos0 + q; const bool qvalid = smp || qpos < TP; const size_t qrow = qvalid ? qrow0 + q : qrow0;
        bf16x8 qf[8];
#pragma unroll
        for (int ks = 0; ks < 8; ++ks) qf[ks] = *(const bf16x8*)(p.Q + qrow * 1024 + h * 128 + 16 * ks + 8 * half);
        f32x16 o[4];
#pragma unroll
        for (int db = 0; db < 4; ++db)
#pragma unroll
            for (int e = 0; e < 16; ++e) o[db][e] = 0.f;
        float C = 1.f;
        for (int kt = (qpos0 + 30) >> 5; kt >= 0; --kt) {
            f32x16 s;
#pragma unroll
            for (int e = 0; e < 16; ++e) s[e] = 0.f;
            const bf16_t* kr = Kb + (size_t)kt * 4096; const bf16_t* vr = Vb + (size_t)kt * 4096;
            bf16x8 kf[8], vf[8];
#pragma unroll
            for (int ks = 0; ks < 8; ++ks) kf[ks] = *(const bf16x8*)(kr + ks * 512);
#pragma unroll
            for (int ks = 0; ks < 8; ++ks) vf[ks] = *(const bf16x8*)(vr + ks * 512);
#pragma unroll
            for (int ks = 0; ks < 8; ++ks) s = MFMA32(kf[ks], qf[ks], s);
            float pr[16], be[16], G[4], Gp[4];
#pragma unroll
            for (int i = 0; i < 4; ++i) {
#pragma unroll
                for (int j = 0; j < 4; ++j) { const int key = 32 * kt + 8 * i + 4 * half + j; const bool valid = key < qpos;
                    float z = s[4 * i + j] * 0.08838834764831845f; z = fminf(fmaxf(z, -80.f), 80.f);
                    const float e = __expf(z), pp = __builtin_amdgcn_rcpf(1.f + e); pr[4 * i + j] = valid ? pp : 1.f; be[4 * i + j] = valid ? e * pp : 0.f; }
                G[i] = (pr[4 * i] * pr[4 * i + 1]) * (pr[4 * i + 2] * pr[4 * i + 3]); }
#pragma unroll
            for (int i = 0; i < 4; ++i) Gp[i] = __shfl_xor(G[i], 32);
            float w[16]; float E1 = 1.f;
#pragma unroll
            for (int i = 3; i >= 0; --i) { const float Glo = half ? Gp[i] : G[i], Ghi = half ? G[i] : Gp[i];
                float suf = C * (half ? E1 : E1 * Ghi);
#pragma unroll
                for (int j = 3; j >= 0; --j) { w[4 * i + j] = be[4 * i + j] * suf; suf *= pr[4 * i + j]; }
                E1 *= Glo * Ghi; }
            C *= E1;
#pragma unroll
            for (int c = 0; c < 2; ++c) { union { bf16x8 v; unsigned u[4]; } wf;
#pragma unroll
                for (int e = 0; e < 4; ++e) wf.u[e] = pk2(w[8 * c + 2 * e], w[8 * c + 2 * e + 1]);
#pragma unroll
                for (int db = 0; db < 4; ++db) o[db] = MFMA32(vf[4 * c + db], wf.v, o[db]); }
            if (__all(C < 1e-24f)) break;
        }
        if (qvalid) {
#pragma unroll
            for (int db = 0; db < 4; ++db)
#pragma unroll
                for (int i = 0; i < 4; ++i) { u32x2 ov; ov.x = pk2(o[db][4 * i], o[db][4 * i + 1]); ov.y = pk2(o[db][4 * i + 2], o[db][4 * i + 3]);
                    *(u32x2*)(p.O + qrow * 1024 + h * 128 + 32 * db + 8 * i + 4 * half) = ov; } }
    }
}
DI void final_norm(const Prm& p, int gw, int NGW, int lane) {
    for (int r = gw; r < 32768 + 512; r += NGW) {
        int grow; float* dst;
        if (r < 32768) { const int b = r >> 12, t = r & 4095; grow = b * TP + 16 + t; dst = p.out + O_YP + (size_t)r * 1024; } else { grow = NTP + (r - 32768); dst = p.out + O_YS + (size_t)(r - 32768) * 1024; }
        const float rr = row_rinv(p.SSQ, grow);
#pragma unroll
        for (int j = 0; j < 4; ++j) { f32x4 v = ((f32x4*)dst)[lane + 64 * j]; const f32x4 g = ((const f32x4*)p.ln_final)[lane + 64 * j]; v = v * rr * g; ((f32x4*)dst)[lane + 64 * j] = v; }
    }
}

#define XB_TMO      128
#define XB_XCNT(j)  (256  + 64 * (j))
#define XB_XSUB(j)  (1280 + 64 * (j))
#define XB_XGEN(j)  (2304 + 64 * (j))
#define XB_TOP      3328
#define XB_TOPGEN   3392
#define XCD_BAR_WORDS 3456
#define XB_SPIN_CAP (1u << 18)
DI unsigned xb_ld(unsigned* p) { return __hip_atomic_load(p, __ATOMIC_RELAXED, __HIP_MEMORY_SCOPE_AGENT); }
DI unsigned xb_add(unsigned* p, unsigned v) { return __hip_atomic_fetch_add(p, v, __ATOMIC_RELAXED, __HIP_MEMORY_SCOPE_AGENT); }
DI unsigned xb_xcc_id() { return (unsigned)__builtin_amdgcn_s_getreg((3 << 11) | 20) & 0xFu; }
#define XB_SPIN(cond, bar) do { unsigned _sp = 0; while (cond) { __builtin_amdgcn_s_sleep(1); \
    if ((++_sp & 255u) == 0u) { if (xb_ld(&(bar)[XB_TMO])) break; if (_sp > XB_SPIN_CAP) { atomicAdd(&(bar)[XB_TMO], 1u); break; } } } } while (0)
struct XcdBarrier { unsigned* bar; unsigned x; volatile LAS unsigned* st; };
DI XcdBarrier xcd_barrier_post(unsigned* bar, volatile LAS unsigned* st) {
    XcdBarrier b; b.bar = bar; b.x = xb_xcc_id(); b.st = st;
    if (threadIdx.x == 0) (void)xb_add(&bar[XB_XCNT(b.x)], 1u);
    return b;
}
DI void xcd_barrier_complete(unsigned* bar, unsigned x, unsigned& nloc, unsigned& nx) {
    const unsigned G = gridDim.x * gridDim.y * gridDim.z;
    unsigned sum, cnt, mine, sp = 0u;
    for (;;) {
        sum = 0u; cnt = 0u; mine = 0u;
#pragma unroll
        for (unsigned j = 0; j < 16; ++j) { const unsigned c = xb_ld(&bar[XB_XCNT(j)]); sum += c; cnt += (c > 0u) ? 1u : 0u; mine = (j == x) ? c : mine; }
        if (sum == G) break;
        __builtin_amdgcn_s_sleep(1);
        if ((++sp & 255u) == 0u) { if (xb_ld(&bar[XB_TMO])) break; if (sp > XB_SPIN_CAP) { atomicAdd(&bar[XB_TMO], 1u); break; } }
    }
    nloc = mine > 0u ? mine : 1u; nx = cnt > 0u ? cnt : 1u;
}
DI void xcd_barrier(const XcdBarrier& b) {
    asm volatile("s_waitcnt vmcnt(0)" ::: "memory");
    __syncthreads();
    if (threadIdx.x == 0) {
        unsigned* bar = b.bar;
        __builtin_amdgcn_s_waitcnt(0);
        unsigned nloc = b.st[0], nx = b.st[1];
        if (nloc == 0u) { xcd_barrier_complete(bar, b.x, nloc, nx); b.st[0] = nloc; b.st[1] = nx; }
        const unsigned old = xb_add(&bar[XB_XSUB(b.x)], 1u);
        const unsigned gen = old / nloc;
        if (old + 1u == (gen + 1u) * nloc) {
            __builtin_amdgcn_fence(__ATOMIC_RELEASE, "agent");
            asm volatile("s_waitcnt vmcnt(0)" ::: "memory");
            const unsigned og = xb_add(&bar[XB_TOP], 1u);
            const unsigned tg = og / nx;
            if (og + 1u == (tg + 1u) * nx) xb_add(&bar[XB_TOPGEN], 1u);
            else XB_SPIN(xb_ld(&bar[XB_TOPGEN]) == tg, bar);
            __builtin_amdgcn_fence(__ATOMIC_ACQUIRE, "agent");
            xb_add(&bar[XB_XGEN(b.x)], 1u);
            asm volatile("s_waitcnt vmcnt(0)" ::: "memory");
        } else {
            XB_SPIN(xb_ld(&bar[XB_XGEN(b.x)]) == gen, bar);
            __builtin_amdgcn_fence(__ATOMIC_ACQUIRE, "agent");
            asm volatile("s_waitcnt vmcnt(0)" ::: "memory");
        }
    }
    __syncthreads();
}
constexpr int LDS_BYTES = 131072 + 256;
__global__ void __launch_bounds__(512, 2) fwd_megakernel(Prm p) {
    extern __shared__ __attribute__((aligned(16))) unsigned char shm[];
    LAS unsigned char* lds = (LAS unsigned char*)shm;
    cg::grid_group grid = cg::this_grid();
    const int tid = threadIdx.x, lane = tid & 63, wave = __builtin_amdgcn_readfirstlane(tid >> 6);
    const int gw = blockIdx.x * 8 + wave, NGW = gridDim.x * 8, gtid = blockIdx.x * 512 + tid, GT = gridDim.x * 512;
    volatile LAS unsigned* xst = (volatile LAS unsigned*)(lds + 131072);
    if (tid == 0) { xst[0] = 0u; xst[1] = 0u; }
    __syncthreads();
    const XcdBarrier xb = xcd_barrier_post(p.BAR, xst);
    phase_prologue(p, lds, tid, lane, wave);
    grid.sync();
    { EpiIn0 E; E.SSQ = p.SSQ; E.LB = p.LB; E.Qh = p.Qh; E.IV = p.IV; E.GS = p.GS; E.U = p.U; E.LOGF = p.LOGF; run_gemm(lds, p.XB, p.Wt1, 2560, 1024, E); }
    xcd_barrier(xb);
    hgrn_b1_all(p, lds, tid, lane, wave);
    s5_b_lds(p, lds, tid, lane, wave);
    xcd_barrier(xb);
    hgrn_b2(p, gtid, GT);
    s5_c(p, gtid);
    xcd_barrier(xb);
    hgrn_b3_all(p, lds, tid, lane, wave);
    s5_d_lds(p, lds, tid, lane, wave);
    xcd_barrier(xb);
    { EpiGlu E; E.YG = p.YG; E.CAT = p.CAT; run_gemm(lds, p.YG, p.Wglu, 512, 512, E); }
    xcd_barrier(xb);
    { EpiRes E; E.XB = p.XB; E.SSQ = p.SSQ; run_gemm_split(lds, p.CAT, p.Wo0, 1024, 1024, E, (float*)p.H); xcd_barrier(xb); gemm_fixup(1024, 1024, E, (const float*)p.H, tid); }
    xcd_barrier(xb);
    { EpiUp E; E.SSQ = p.SSQ; E.H = p.H; run_gemm(lds, p.XB, p.Wup0, 4096, 1024, E); }
    xcd_barrier(xb);
    { EpiRes E; E.XB = p.XB; E.SSQ = p.SSQ; run_gemm_split(lds, p.H, p.Wdn0, 1024, 4096, E, (float*)p.CAT); xcd_barrier(xb); gemm_fixup(1024, 4096, E, (const float*)p.CAT, tid); }
    xcd_barrier(xb);
    { EpiQkv E; E.SSQ = p.SSQ; E.out = p.out; E.Q = p.Q; E.KP = p.KP; E.KS = p.KS; E.VTP = p.VTP; E.VTS = p.VTS; run_gemm(lds, p.XB, p.Wqkv, 3072, 1024, E); }
    if (gridDim.x > 36) { if (blockIdx.x >= 36) cache_convert(p, (blockIdx.x - 36) * 512 + tid, (gridDim.x - 36) * 512); } else cache_convert(p, gtid, GT);
    xcd_barrier(xb);
    attn_phase(p, gw, NGW, lane);
    xcd_barrier(xb);
    { EpiRes E; E.XB = p.XB; E.SSQ = p.SSQ; run_gemm_split(lds, p.O, p.Wo1, 1024, 1024, E, (float*)p.H); xcd_barrier(xb); gemm_fixup(1024, 1024, E, (const float*)p.H, tid); }
    xcd_barrier(xb);
    { EpiUp E; E.SSQ = p.SSQ; E.H = p.H; run_gemm(lds, p.XB, p.Wup1, 4096, 1024, E); }
    xcd_barrier(xb);
    { EpiFin E; E.XB = p.XB; E.SSQ = p.SSQ; E.out = p.out; run_gemm_split(lds, p.H, p.Wdn1, 1024, 4096, E, (float*)p.CAT); xcd_barrier(xb); gemm_fixup(1024, 4096, E, (const float*)p.CAT, tid); }
    xcd_barrier(xb);
    final_norm(p, gw, NGW, lane);
}

extern "C" void kernel_launch(void* const* d_in, const int* in_sizes, int n_in, void* d_out, int out_size, void* d_ws, size_t ws_size, hipStream_t stream) {
    static int grid_blocks = 0;
    if (grid_blocks == 0) {
        int dev = 0, cus = 0, per_cu = 0;
        hipGetDevice(&dev); hipDeviceGetAttribute(&cus, hipDeviceAttributeMultiprocessorCount, dev);
        if (hipFuncSetAttribute((const void*)fwd_megakernel, hipFuncAttributeMaxDynamicSharedMemorySize, LDS_BYTES) != hipSuccess) fprintf(stderr, "kernel_launch: hipFuncSetAttribute failed\n");
        if (hipOccupancyMaxActiveBlocksPerMultiprocessor(&per_cu, (const void*)fwd_megakernel, 512, LDS_BYTES) != hipSuccess || per_cu < 1) { fprintf(stderr, "kernel_launch: occupancy query says %d\n", per_cu); per_cu = 1; }
        (void)hipGetLastError();
        grid_blocks = cus > 0 ? cus : 256;
    }
    Prm p{};
    const float* const* in = (const float* const*)d_in;
    p.x_prompt = in[0]; p.x_sample = in[1]; p.state_hgrn = in[2]; p.ssm_re0 = in[3]; p.ssm_im0 = in[4]; p.cache_k = in[5]; p.cache_v = in[6]; p.meta = in[7]; p.ln_mix = in[8]; p.ln_mlp = in[9];
    p.ln_final = in[10]; p.w_in_even = in[11]; p.hgrn_lb = in[12]; p.hgrn_norm = in[13]; p.a_re = in[14]; p.a_im = in[15]; p.log_dt = in[16]; p.b_re = in[17]; p.b_im = in[18]; p.c_re = in[19];
    p.c_im = in[20]; p.ssm_d = in[21]; p.w_glu = in[22]; p.w_out_even = in[23]; p.w_in_odd = in[24]; p.w_out_odd = in[25]; p.w_up = in[26]; p.w_down = in[27];
    p.out = (float*)d_out;
    unsigned char* ws = (unsigned char*)d_ws; size_t off = 0;
    auto take = [&](size_t bytes) { unsigned char* r = ws + off; off += (bytes + 255) & ~(size_t)255; return r; };
    p.Wt1 = (bf16_t*)take((size_t)2560 * 1024 * 2); p.Wglu = (bf16_t*)take((size_t)512 * 512 * 2); p.Wo0 = (bf16_t*)take((size_t)1024 * 1024 * 2); p.Wup0 = (bf16_t*)take((size_t)4096 * 1024 * 2);
    p.Wdn0 = (bf16_t*)take((size_t)4096 * 1024 * 2); p.Wqkv = (bf16_t*)take((size_t)3072 * 1024 * 2); p.Wo1 = (bf16_t*)take((size_t)1024 * 1024 * 2); p.Wup1 = (bf16_t*)take((size_t)4096 * 1024 * 2);
    p.Wdn1 = (bf16_t*)take((size_t)4096 * 1024 * 2);
    p.XB = (bf16_t*)take((size_t)MP * 1024 * 2); p.SSQ = (float*)take((size_t)MP * 16 * 4); p.LB = (float*)take(2048); p.KTAB = (float*)take((size_t)32 * 16 * 256 * 4);
    p.TG = (bf16_t*)take((size_t)32 * 256 * 384 * 2); p.HT = (bf16_t*)take((size_t)32 * 128 * 256 * 2); p.A16 = (float*)take(32 * 64 * 2 * 4); p.BAR = (unsigned*)take(XCD_BAR_WORDS * 4);
    const size_t S0 = off; constexpr size_t SZ512 = (size_t)MP * 512 * 2;
    p.Qh = (bf16_t*)take(SZ512); p.LOGF = (unsigned short*)take(SZ512); p.IV = (bf16_t*)take(SZ512); p.GS = (bf16_t*)take(SZ512); p.U = (bf16_t*)take(SZ512);
    p.UT = (bf16_t*)take((size_t)NITEM_H * 16384 * 2); p.AL = (float*)take((size_t)NITEM_H * 128 * 4);
    p.XLOC = (float*)take(SZ512); p.YG = (bf16_t*)p.XLOC;
    p.XPREV = (bf16_t*)take((size_t)NCOL * 4096 * 2); p.CAT = (bf16_t*)take((size_t)MP * 1024 * 2);
    size_t end = off;
    off = S0; p.H = (bf16_t*)take((size_t)MP * 4096 * 2); if (off > end) end = off;
    off = S0; p.Q = (bf16_t*)take((size_t)MP * 1024 * 2); p.KP = (bf16_t*)take((size_t)64 * 129 * 4096 * 2); p.KS = (bf16_t*)take((size_t)64 * 34 * 4096 * 2);
    p.VTP = (bf16_t*)take((size_t)64 * 129 * 4096 * 2); p.VTS = (bf16_t*)take((size_t)64 * 34 * 4096 * 2); p.O = (bf16_t*)take((size_t)MP * 1024 * 2); if (off > end) end = off;
    if (end > ws_size || n_in != 28 || (size_t)out_size != O_END) { fprintf(stderr, "kernel_launch: workspace/shape mismatch: need %zu have %zu, n_in %d, out %d\n", end, ws_size, n_in, out_size); return; }
    (void)hipMemsetAsync(p.BAR, 0, XCD_BAR_WORDS * 4, stream);
    void* args[] = {&p};
    hipError_t e = hipLaunchCooperativeKernel((const void*)fwd_megakernel, dim3(grid_blocks), dim3(512), args, LDS_BYTES, stream);
    if (e != hipSuccess) fprintf(stderr, "cooperative launch failed: %s (grid %d)\n", hipGetErrorString(e), grid_blocks);
}
```

```cpp
#include <hip/hip_runtime.h>
#include <hip/hip_cooperative_groups.h>
#include <cstdio>
#include <cstdint>
namespace cg = cooperative_groups;
namespace pg8 {
#define PG8_LAS __attribute__((address_space(3)))
typedef unsigned short bf16_t;
typedef short bf16x8 __attribute__((ext_vector_type(8)));
typedef float f32x4 __attribute__((ext_vector_type(4)));
typedef unsigned u32x4 __attribute__((ext_vector_type(4)));
constexpr int BM = 256, BK = 64, HALF = 128, HTB = HALF * BK * 2  , STAGE_BYTES = 8 * HTB, NXCD = 8, WGM = 8;

__host__ __device__ __forceinline__ int lds_byte(int r, int c) { const int st = (r >> 4) * 2 + (c >> 5), rr = r & 15, cc = c & 31, ob = rr * 64 + cc * 2; return st * 1024 + (ob ^ (((ob >> 9) & 1) << 5)); }
__host__ __device__ __forceinline__ void stage_rc(int b, int& R, int& C) { const int st = b / 1024, sb = b % 1024, swz = sb ^ (((sb >> 9) & 1) << 5); R = (st >> 1) * 16 + swz / 64; C = (st & 1) * 32 + (swz % 64) / 2; }
__host__ __device__ __forceinline__ int perm32(int rho) { const int n = rho >> 4, i = rho & 15; return 8 * (i >> 2) + 4 * n + (i & 3); }

struct Unit { int pm, pn, kb, nk, part; };
struct Gemm { const bf16_t* A; const bf16_t* Bt; int M, N, K; float* part; };

struct StaticOrder {
    int nM, nN, nwg, G, c;
    __host__ __device__ void init(int M, int N, int G_, int c_) { nM = M / BM; nN = N / BM; nwg = nM * nN; G = G_; c = c_; }
    __host__ __device__ void map(int L, Unit& u) const {
        int wgid = L; { const int q = nwg / NXCD, r = nwg % NXCD, xcd = wgid % NXCD, off = wgid / NXCD; wgid = (xcd < r ? xcd * (q + 1) : r * (q + 1) + (xcd - r) * q) + off; }
        const int nig = WGM * nN, gid = wgid / nig, fm = gid * WGM, gsz = (nM - fm) < WGM ? (nM - fm) : WGM;
        u.pm = fm + ((wgid % nig) % gsz); u.pn = (wgid % nig) / gsz; u.kb = 0; u.nk = 0; u.part = -1;
    }
    __host__ __device__ bool next(int i, Unit& u) const {
        const long L = (long)i * G + c; if (L >= nwg) return false;
        map((int)L, u); return true;
    }
    __device__ __forceinline__ void a_ready(const Unit&) const {}
    __device__ __forceinline__ void done(const Unit&) const {}
};
template <class Epi, class Sched>
__device__ __forceinline__ void gemm_phase(PG8_LAS unsigned char* lds, const Gemm g, const Sched& S, const Epi& E) {
    const int tid = threadIdx.x, wid = __builtin_amdgcn_readfirstlane(tid >> 6), lane = tid & 63, wr = wid >> 2, wc = wid & 3, fr = lane & 15, fq = lane >> 4;
    const int K = g.K, nt = K / BK;
    unsigned voffA[2], voffB[2];
#pragma unroll
    for (int i = 0; i < 2; ++i) { int R, C; stage_rc(tid * 16 + i * 8192, R, C); const int Rb = Epi::PERM ? ((R & ~31) + perm32(R & 31)) : R;
        voffA[i] = (unsigned)(R * K + C) * 2u; voffB[i] = (unsigned)(Rb * K + C) * 2u; }
    const size_t kstep = (size_t)(BK * 2);
    const size_t hstep = (size_t)HALF * K * 2;
    const size_t tstep = 2 * hstep;
    const unsigned ldsw = (unsigned)wid * 1024u;
    const int aoff = lds_byte(wr * 64 + fr, fq * 8), boff = lds_byte(wc * 32 + fr, fq * 8);
#define PG8_SA(b, h) (((b) * 2 + (h)) * HTB)
#define PG8_SB(b, h) ((4 + (b) * 2 + (h)) * HTB)
#define PG8_STAGE(bufoff, gbase, voff) do { _Pragma("unroll") for (int _i = 0; _i < 2; ++_i) \
        __builtin_amdgcn_global_load_lds((const unsigned*)((const char*)(gbase) + (voff)[_i]), (PG8_LAS unsigned*)(lds + (bufoff) + ldsw + _i * 8192), 16, 0, 0); } while (0)
#define PG8_LDA(dst, b, h) do { _Pragma("unroll") for (int m = 0; m < 4; ++m) _Pragma("unroll") for (int k = 0; k < 2; ++k) dst[m][k] = *(const PG8_LAS bf16x8*)(lds + PG8_SA(b, h) + aoff + m * 2048 + k * 1024); } while (0)
#define PG8_LDB(dst, b, h) do { _Pragma("unroll") for (int n = 0; n < 2; ++n) _Pragma("unroll") for (int k = 0; k < 2; ++k) dst[n][k] = *(const PG8_LAS bf16x8*)(lds + PG8_SB(b, h) + boff + n * 2048 + k * 1024); } while (0)
#define PG8_MMA(ai, bj, At, Bt) do { __builtin_amdgcn_s_setprio(1); _Pragma("unroll") for (int m = 0; m < 4; ++m) _Pragma("unroll") for (int n = 0; n < 2; ++n) _Pragma("unroll") for (int k = 0; k < 2; ++k) \
        acc[ai][bj][m][n] = __builtin_amdgcn_mfma_f32_16x16x32_bf16(Bt[n][k], At[m][k], acc[ai][bj][m][n], 0, 0, 0); __builtin_amdgcn_s_setprio(0); } while (0)
#define PG8_WAIT_V(n) asm volatile("s_waitcnt vmcnt(" #n ")" ::: "memory")
#define PG8_WAIT_L(n) asm volatile("s_waitcnt lgkmcnt(" #n ")" ::: "memory")
#define PG8_BAR __builtin_amdgcn_s_barrier()
#define PG8_SCHED __builtin_amdgcn_sched_barrier(0)
    Unit cur, nxt; int ui = 0; typename Epi::Pre pre;
    if (!S.next(0, cur)) return;
    f32x4 acc[2][2][4][2];
#pragma unroll
    for (int a = 0; a < 2; ++a)
#pragma unroll
        for (int b = 0; b < 2; ++b)
#pragma unroll
            for (int m = 0; m < 4; ++m)
#pragma unroll
                for (int n = 0; n < 2; ++n) acc[a][b][m][n] = (f32x4){0.f, 0.f, 0.f, 0.f};
    bf16x8 At[4][2], B0[2][2], B1[2][2];
    const char* cA = (const char*)g.A + (size_t)cur.pm * tstep + (size_t)cur.kb * kstep; const char* cB = (const char*)g.Bt + (size_t)cur.pn * tstep + (size_t)cur.kb * kstep;
    S.a_ready(cur);
    PG8_STAGE(PG8_SB(0, 0), cB, voffB); PG8_STAGE(PG8_SA(0, 0), cA, voffA); PG8_STAGE(PG8_SB(0, 1), cB + hstep, voffB); PG8_STAGE(PG8_SA(0, 1), cA + hstep, voffA);
    if (wr == 1) PG8_BAR;
    PG8_WAIT_V(4); PG8_BAR;
    PG8_STAGE(PG8_SB(1, 0), cB + kstep, voffB); PG8_STAGE(PG8_SA(1, 0), cA + kstep, voffA); PG8_STAGE(PG8_SB(1, 1), cB + hstep + kstep, voffB);
    PG8_WAIT_V(6); PG8_BAR;
    for (;;) {
        const bool has_next = S.next(ui + 1, nxt);
        const char* nA = has_next ? (const char*)g.A + (size_t)nxt.pm * tstep + (size_t)nxt.kb * kstep : cA; const char* nB = has_next ? (const char*)g.Bt + (size_t)nxt.pn * tstep + (size_t)nxt.kb * kstep : cB;
        const int cnk = cur.nk ? cur.nk : nt;
        for (int t = 0; t < cnk; t += 2) {
            const bool last = (t == cnk - 2);
            const char* a1 = cA + (size_t)(t + 1) * kstep;
            const char* a2 = last ? nA : cA + (size_t)(t + 2) * kstep; const char* b2 = last ? nB : cB + (size_t)(t + 2) * kstep;
            const char* a3 = a2 + kstep; const char* b3 = b2 + kstep;
            if (last && has_next) S.a_ready(nxt);
            if (last) E.prefetch(pre, cur, wr, fr);
            PG8_LDB(B0, 0, 0); PG8_SCHED; PG8_LDA(At, 0, 0); PG8_STAGE(PG8_SA(1, 1), a1 + hstep, voffA);
            PG8_WAIT_L(8); PG8_BAR; PG8_WAIT_L(0); PG8_MMA(0, 0, At, B0); PG8_BAR; PG8_SCHED;
            PG8_LDB(B1, 0, 1); PG8_STAGE(PG8_SB(0, 0), b2, voffB);
            PG8_BAR; PG8_WAIT_L(0); PG8_MMA(0, 1, At, B1); PG8_BAR;
            PG8_LDA(At, 0, 1); PG8_STAGE(PG8_SA(0, 0), a2, voffA);
            PG8_BAR; PG8_WAIT_L(0); PG8_MMA(1, 0, At, B0); PG8_BAR; PG8_SCHED;
            PG8_STAGE(PG8_SB(0, 1), b2 + hstep, voffB);
            PG8_WAIT_V(6); PG8_BAR; PG8_MMA(1, 1, At, B1); PG8_BAR;
            PG8_LDB(B0, 1, 0); PG8_SCHED; PG8_LDA(At, 1, 0); PG8_STAGE(PG8_SA(0, 1), a2 + hstep, voffA);
            PG8_WAIT_L(8); PG8_BAR; PG8_WAIT_L(0); PG8_MMA(0, 0, At, B0); PG8_BAR; PG8_SCHED;
            PG8_LDB(B1, 1, 1); PG8_STAGE(PG8_SB(1, 0), b3, voffB);
            PG8_BAR; PG8_WAIT_L(0); PG8_MMA(0, 1, At, B1); PG8_BAR;
            PG8_LDA(At, 1, 1); PG8_STAGE(PG8_SA(1, 0), a3, voffA);
            PG8_BAR; PG8_WAIT_L(0); PG8_MMA(1, 0, At, B0); PG8_BAR; PG8_SCHED;
            PG8_STAGE(PG8_SB(1, 1), b3 + hstep, voffB);
            PG8_WAIT_V(6); PG8_BAR; PG8_MMA(1, 1, At, B1); PG8_BAR;
        }
        if constexpr (!Epi::AFTER_DRAIN) {
            if (cur.part < 0) E(acc, cur, wr, wc, fr, fq, pre);
            else { f32x4* pp = (f32x4*)g.part + (size_t)cur.part * 32 * 512 + tid;
#pragma unroll
                for (int a = 0; a < 2; ++a)
#pragma unroll
                    for (int b = 0; b < 2; ++b)
#pragma unroll
                        for (int m = 0; m < 4; ++m)
#pragma unroll
                            for (int n = 0; n < 2; ++n) pp[(size_t)(((a * 2 + b) * 4 + m) * 2 + n) * 512] = acc[a][b][m][n]; }
            S.done(cur); }
        if (!has_next) break;
#pragma unroll
        for (int a = 0; a < 2; ++a)
#pragma unroll
            for (int b = 0; b < 2; ++b)
#pragma unroll
                for (int m = 0; m < 4; ++m)
#pragma unroll
                    for (int n = 0; n < 2; ++n) acc[a][b][m][n] = (f32x4){0.f, 0.f, 0.f, 0.f};
        cur = nxt; cA = nA; cB = nB; ++ui;
    }
    PG8_WAIT_V(0);
    if (wr == 0) PG8_BAR;
    PG8_BAR;
    if constexpr (Epi::AFTER_DRAIN) { E.fused(acc, cur, wr, wc, fr, fq, lds, wid, lane); S.done(cur); }
#undef PG8_SA
#undef PG8_SB
#undef PG8_STAGE
#undef PG8_LDA
#undef PG8_LDB
#undef PG8_MMA
#undef PG8_WAIT_V
#undef PG8_WAIT_L
#undef PG8_BAR
#undef PG8_SCHED
}
}
using pg8::bf16_t; using pg8::bf16x8; using pg8::f32x4; using pg8::Unit;
typedef float f32x16 __attribute__((ext_vector_type(16)));
typedef float f32x2v __attribute__((ext_vector_type(2)));
typedef unsigned u32x2 __attribute__((ext_vector_type(2)));
typedef unsigned u32x4v __attribute__((ext_vector_type(4)));
#define LAS __attribute__((address_space(3)))
#define DI __device__ __forceinline__

constexpr int DM = 1024, TP = 4112, NTP = 8 * TP  , NTS = 512, NT = NTP + NTS  , MP = 33536  ;
constexpr int NITEM_H = 2112;
constexpr int NCOL = NT / 16;
constexpr float EPSN = 1e-6f;
constexpr size_t O_YP = 0, O_YS = O_YP + (size_t)8 * 4096 * 1024, O_HGP = O_YS + 524288, O_HGS = O_HGP + 524288, O_SRP = O_HGS + 524288, O_SIP = O_SRP + 16384,
                 O_SRS = O_SIP + 16384, O_SIS = O_SRS + 16384, O_KP = O_SIS + 16384, O_VP = O_KP + (size_t)NTP * 1024, O_KS = O_VP + (size_t)NTP * 1024, O_VS = O_KS + 524288, O_END = O_VS + 524288;

struct Prm {
    const float *x_prompt, *x_sample, *state_hgrn, *ssm_re0, *ssm_im0, *cache_k, *cache_v, *meta, *ln_mix, *ln_mlp, *ln_final, *w_in_even, *hgrn_lb, *hgrn_norm,
        *a_re, *a_im, *log_dt, *b_re, *b_im, *c_re, *c_im, *ssm_d, *w_glu, *w_out_even, *w_in_odd, *w_out_odd, *w_up, *w_down;
    float* out;
    bf16_t *Wt1, *Wglu, *Wo0, *Wup0, *Wdn0, *Wqkv, *Wo1, *Wup1, *Wdn1;
    bf16_t* XB; float* SSQ; float* RINV; float* LB; float* KTAB; bf16_t* TG; bf16_t* HT; float* A16;
    bf16_t *Qh, *IV, *GS, *U; unsigned short* LOGF; bf16_t* UT; float* AL; float* XLOC; bf16_t* XPREV; bf16_t* YG; bf16_t* CAT;
    bf16_t* H;
    bf16_t *Q, *KP, *KS, *VTP, *VTS, *O; unsigned* BAR;
};

DI unsigned pk2(float lo, float hi) { unsigned r; asm volatile("v_cvt_pk_bf16_f32 %0, %1, %2" : "=v"(r) : "v"(lo), "v"(hi)); return r; }
DI float bflo(unsigned u) { return __uint_as_float(u << 16); }
DI float bfhi(unsigned u) { return __uint_as_float(u & 0xffff0000u); }
DI float bf2f(unsigned short b) { return __uint_as_float(((unsigned)b) << 16); }
DI unsigned short f2bf(float f) { return (unsigned short)(pk2(f, 0.f) & 0xffffu); }
DI unsigned pkh2(float lo, float hi) { union { _Float16 h[2]; unsigned u; } x; x.h[0] = (_Float16)lo; x.h[1] = (_Float16)hi; return x.u; }
DI float h2f(unsigned short h) { union { unsigned short s; _Float16 h; } x; x.s = h; return (float)x.h; }
DI float wave_sum(float v) {
#pragma unroll
    for (int o = 1; o < 64; o <<= 1) v += __shfl_xor(v, o);
    return v;
}
DI float fexp(float x) { return __expf(x); }
DI float sigm(float x) { return __builtin_amdgcn_rcpf(1.f + __expf(-x)); }
DI float row_rinv(const float* SSQ, int row) {
    const f32x4* s = (const f32x4*)(SSQ + (size_t)row * 16); f32x4 a = s[0] + s[1] + s[2] + s[3];
    return rsqrtf(((a.x + a.y) + (a.z + a.w)) * (1.f / 1024.f) + EPSN);
}
DI void rinv8(const float* SSQ, int row0, int fq, float (&r)[2][4]) {
    f32x4 v[2][4];
#pragma unroll
    for (int ai = 0; ai < 2; ++ai)
#pragma unroll
        for (int m = 0; m < 4; ++m) v[ai][m] = *(const f32x4*)(SSQ + (size_t)(row0 + ai * 128 + m * 16) * 16 + 4 * fq);
#pragma unroll
    for (int ai = 0; ai < 2; ++ai)
#pragma unroll
        for (int m = 0; m < 4; ++m) { float s = (v[ai][m].x + v[ai][m].y) + (v[ai][m].z + v[ai][m].w); s += __shfl_xor(s, 16); s += __shfl_xor(s, 32); r[ai][m] = rsqrtf(s * (1.f / 1024.f) + EPSN); }
}
#define LDS_WAIT() asm volatile("s_waitcnt lgkmcnt(0)" ::: "memory")

struct EpiIn0 {
    struct Pre { float r[2][4]; };
    DI void prefetch(Pre& pre, const Unit& u, int wr, int fr) const { const int row0 = u.pm * 256 + wr * 64 + fr;
#pragma unroll
        for (int ai = 0; ai < 2; ++ai)
#pragma unroll
            for (int m = 0; m < 4; ++m) pre.r[ai][m] = RINV[row0 + ai * 128 + m * 16]; }
    DI void scales(const Pre& pre, int row0, int fq, float (&rs)[2][4]) const {
        if (pre.r[0][0] > 0.f) {
#pragma unroll
            for (int ai = 0; ai < 2; ++ai)
#pragma unroll
                for (int m = 0; m < 4; ++m) rs[ai][m] = pre.r[ai][m]; }
        else rinv8(SSQ, row0, fq, rs);
    }
    static constexpr bool PERM = false, AFTER_DRAIN = false;
    const float* SSQ; const float* RINV; const float* LB; bf16_t *Qh, *IV, *GS, *U; unsigned short* LOGF;
    DI void operator()(const f32x4 (&acc)[2][2][4][2], const Unit& u, int wr, int wc, int fr, int fq, const Pre& pre) const {
        const int seg = u.pn >> 1, cb = (u.pn & 1) * 256 + wc * 32 + 4 * fq, row0 = u.pm * 256 + wr * 64 + fr;
        unsigned short* dst = seg == 0 ? Qh : seg == 1 ? LOGF : seg == 2 ? IV : seg == 3 ? GS : U;
        float rs[2][4]; scales(pre, row0, fq, rs);
        f32x4 lbv[2][2];
#pragma unroll
        for (int bj = 0; bj < 2; ++bj)
#pragma unroll
            for (int n = 0; n < 2; ++n) lbv[bj][n] = *(const f32x4*)(LB + cb + bj * 128 + n * 16);
#pragma unroll
        for (int ai = 0; ai < 2; ++ai)
#pragma unroll
            for (int m = 0; m < 4; ++m) { const int row = row0 + ai * 128 + m * 16; const float r = rs[ai][m];
#pragma unroll
                for (int bj = 0; bj < 2; ++bj)
#pragma unroll
                    for (int n = 0; n < 2; ++n) { const int cs = cb + bj * 128 + n * 16; f32x4 v = acc[ai][bj][m][n] * r; u32x2 o;
                        if (seg == 1) { const f32x4 lb = lbv[bj][n]; f32x4 f;
#pragma unroll
                            for (int e = 0; e < 4; ++e) f[e] = __logf(lb[e] + (1.f - lb[e]) * sigm(v[e]));
                            o.x = pkh2(f[0], f[1]); o.y = pkh2(f[2], f[3]); }
                        else { if (seg == 3) {
#pragma unroll
                                for (int e = 0; e < 4; ++e) v[e] = v[e] * sigm(v[e]); }
                            o.x = pk2(v[0], v[1]); o.y = pk2(v[2], v[3]); }
                        *(u32x2*)(dst + (size_t)row * 512 + cs) = o; } }
    }
};
struct EpiGlu {
    struct Pre {}; DI void prefetch(Pre&, const Unit&, int, int) const {}
    static constexpr bool PERM = false, AFTER_DRAIN = false;
    const bf16_t* YG; bf16_t* CAT;
    DI void operator()(const f32x4 (&acc)[2][2][4][2], const Unit& u, int wr, int wc, int fr, int fq, const Pre& pre) const {
        const int cb = u.pn * 256 + wc * 32 + 4 * fq, row0 = u.pm * 256 + wr * 64 + fr;
#pragma unroll
        for (int ai = 0; ai < 2; ++ai) {
            u32x2 y[4][2][2];
#pragma unroll
            for (int m = 0; m < 4; ++m)
#pragma unroll
                for (int bj = 0; bj < 2; ++bj)
#pragma unroll
                    for (int n = 0; n < 2; ++n) y[m][bj][n] = *(const u32x2*)(YG + (size_t)(row0 + ai * 128 + m * 16) * 512 + cb + bj * 128 + n * 16);
#pragma unroll
            for (int m = 0; m < 4; ++m) { const int row = row0 + ai * 128 + m * 16;
#pragma unroll
                for (int bj = 0; bj < 2; ++bj)
#pragma unroll
                    for (int n = 0; n < 2; ++n) { const int cs = cb + bj * 128 + n * 16; const f32x4 v = acc[ai][bj][m][n]; const u32x2 yy = y[m][bj][n]; u32x2 o;
                        o.x = pk2(bflo(yy.x) * sigm(v[0]), bfhi(yy.x) * sigm(v[1])); o.y = pk2(bflo(yy.y) * sigm(v[2]), bfhi(yy.y) * sigm(v[3]));
                        *(u32x2*)(CAT + (size_t)row * 1024 + 512 + cs) = o; } } }
    }
};
struct EpiRes {
    struct Pre {}; DI void prefetch(Pre&, const Unit&, int, int) const {}
    static constexpr bool PERM = false, AFTER_DRAIN = false;
    bf16_t* XB; float* SSQ;
    DI void row(const f32x4 (&a4)[2][2], const Unit& u, int ai, int m, int wr, int wc, int fr, int fq) const {
        const int cb = u.pn * 256 + wc * 32 + 4 * fq, row = u.pm * 256 + wr * 64 + fr + ai * 128 + m * 16; float ss = 0.f;
#pragma unroll
        for (int bj = 0; bj < 2; ++bj)
#pragma unroll
            for (int n = 0; n < 2; ++n) { const int cs = cb + bj * 128 + n * 16; const f32x4 v = a4[bj][n];
                u32x2* px = (u32x2*)(XB + (size_t)row * 1024 + cs); const u32x2 x = *px; u32x2 o;
                o.x = pk2(bflo(x.x) + v[0], bfhi(x.x) + v[1]); o.y = pk2(bflo(x.y) + v[2], bfhi(x.y) + v[3]); *px = o;
                const float a0 = bflo(o.x), a1 = bfhi(o.x), a2 = bflo(o.y), a3 = bfhi(o.y); ss += (a0 * a0 + a1 * a1) + (a2 * a2 + a3 * a3); }
        ss += __shfl_xor(ss, 16); ss += __shfl_xor(ss, 32);
        if (fq == 0) SSQ[(size_t)row * 16 + u.pn * 4 + wc] = ss;
    }
    DI void operator()(const f32x4 (&acc)[2][2][4][2], const Unit& u, int wr, int wc, int fr, int fq, const Pre& pre) const {
        const int cb = u.pn * 256 + wc * 32 + 4 * fq, row0 = u.pm * 256 + wr * 64 + fr;
#pragma unroll
        for (int ai = 0; ai < 2; ++ai) {
            u32x2 x[4][2][2];
#pragma unroll
            for (int m = 0; m < 4; ++m)
#pragma unroll
                for (int bj = 0; bj < 2; ++bj)
#pragma unroll
                    for (int n = 0; n < 2; ++n) x[m][bj][n] = *(const u32x2*)(XB + (size_t)(row0 + ai * 128 + m * 16) * 1024 + cb + bj * 128 + n * 16);
#pragma unroll
            for (int m = 0; m < 4; ++m) { const int row = row0 + ai * 128 + m * 16; float ss = 0.f;
#pragma unroll
                for (int bj = 0; bj < 2; ++bj)
#pragma unroll
                    for (int n = 0; n < 2; ++n) { const int cs = cb + bj * 128 + n * 16; const f32x4 v = acc[ai][bj][m][n]; const u32x2 xx = x[m][bj][n]; u32x2 o;
                        o.x = pk2(bflo(xx.x) + v[0], bfhi(xx.x) + v[1]); o.y = pk2(bflo(xx.y) + v[2], bfhi(xx.y) + v[3]); *(u32x2*)(XB + (size_t)row * 1024 + cs) = o;
                        const float a0 = bflo(o.x), a1 = bfhi(o.x), a2 = bflo(o.y), a3 = bfhi(o.y); ss += (a0 * a0 + a1 * a1) + (a2 * a2 + a3 * a3); }
                ss += __shfl_xor(ss, 16); ss += __shfl_xor(ss, 32);
                if (fq == 0) SSQ[(size_t)row * 16 + u.pn * 4 + wc] = ss; } }
    }
};
struct EpiUp {
    struct Pre { float r[2][4]; };
    DI void prefetch(Pre& pre, const Unit& u, int wr, int fr) const { const int row0 = u.pm * 256 + wr * 64 + fr;
#pragma unroll
        for (int ai = 0; ai < 2; ++ai)
#pragma unroll
            for (int m = 0; m < 4; ++m) pre.r[ai][m] = RINV[row0 + ai * 128 + m * 16]; }
    DI void scales(const Pre& pre, int row0, int fq, float (&rs)[2][4]) const {
        if (pre.r[0][0] > 0.f) {
#pragma unroll
            for (int ai = 0; ai < 2; ++ai)
#pragma unroll
                for (int m = 0; m < 4; ++m) rs[ai][m] = pre.r[ai][m]; }
        else rinv8(SSQ, row0, fq, rs);
    }
    static constexpr bool PERM = false, AFTER_DRAIN = false;
    const float* SSQ; const float* RINV; bf16_t* H;
    DI void operator()(const f32x4 (&acc)[2][2][4][2], const Unit& u, int wr, int wc, int fr, int fq, const Pre& pre) const {
        const int cb = u.pn * 256 + wc * 32 + 4 * fq, row0 = u.pm * 256 + wr * 64 + fr;
        float rs[2][4]; scales(pre, row0, fq, rs);
#pragma unroll
        for (int ai = 0; ai < 2; ++ai)
#pragma unroll
            for (int m = 0; m < 4; ++m) { const int row = row0 + ai * 128 + m * 16; const float r = rs[ai][m];
#pragma unroll
                for (int bj = 0; bj < 2; ++bj)
#pragma unroll
                    for (int n = 0; n < 2; ++n) { const int cs = cb + bj * 128 + n * 16; f32x4 v = acc[ai][bj][m][n] * r;
#pragma unroll
                        for (int e = 0; e < 4; ++e) { const float t = fmaxf(v[e], 0.f); v[e] = t * t; }
                        u32x2 o; o.x = pk2(v[0], v[1]); o.y = pk2(v[2], v[3]); *(u32x2*)(H + (size_t)row * 4096 + cs) = o; } }
    }
};
DI size_t kf_index(int seqh, int nkt, int key, int d) { return ((((size_t)seqh * nkt + (key >> 5)) * 8 + (d >> 4)) * 64 + ((key & 31) + 32 * ((d >> 3) & 1))) * 8 + (d & 7); }
DI size_t vf_index(int seqh, int nkt, int key, int d) { const int kk = key & 31;
    return ((((size_t)seqh * nkt + (key >> 5)) * 8 + (kk >> 4) * 4 + (d >> 5)) * 64 + ((d & 31) + 32 * ((kk >> 2) & 1))) * 8 + ((kk >> 3) & 1) * 4 + (kk & 3); }
struct EpiQkv {
    struct Pre { float r[2][4]; };
    DI void prefetch(Pre& pre, const Unit& u, int wr, int fr) const { const int row0 = u.pm * 256 + wr * 64 + fr;
#pragma unroll
        for (int ai = 0; ai < 2; ++ai)
#pragma unroll
            for (int m = 0; m < 4; ++m) pre.r[ai][m] = RINV[row0 + ai * 128 + m * 16]; }
    DI void scales(const Pre& pre, int row0, int fq, float (&rs)[2][4]) const {
        if (pre.r[0][0] > 0.f) {
#pragma unroll
            for (int ai = 0; ai < 2; ++ai)
#pragma unroll
                for (int m = 0; m < 4; ++m) rs[ai][m] = pre.r[ai][m]; }
        else rinv8(SSQ, row0, fq, rs);
    }
    static constexpr bool PERM = false, AFTER_DRAIN = false;
    const float* SSQ; const float* RINV; float* out; bf16_t *Q, *KP, *KS, *VTP, *VTS;
    DI void operator()(const f32x4 (&acc)[2][2][4][2], const Unit& u, int wr, int wc, int fr, int fq, const Pre& pre) const {
        const int third = u.pn >> 2, cb = (u.pn & 3) * 256 + wc * 32 + 4 * fq, row0 = u.pm * 256 + wr * 64 + fr;
        float rs[2][4]; scales(pre, row0, fq, rs);
#pragma unroll
        for (int ai = 0; ai < 2; ++ai)
#pragma unroll
            for (int m = 0; m < 4; ++m) { const int row = row0 + ai * 128 + m * 16; const float r = rs[ai][m];
                const bool smp = row >= NTP; const int s = row - NTP; const int b = smp ? (s >> 6) : row / TP, key = smp ? 1024 + (s & 63) : row - b * TP, nkt = smp ? 34 : 129;
#pragma unroll
                for (int bj = 0; bj < 2; ++bj)
#pragma unroll
                    for (int n = 0; n < 2; ++n) { const int cs = cb + bj * 128 + n * 16; const f32x4 v = acc[ai][bj][m][n] * r;
                        u32x2 o; o.x = pk2(v[0], v[1]); o.y = pk2(v[2], v[3]);
                        if (third == 0) { *(u32x2*)(Q + (size_t)row * 1024 + cs) = o; }
                        else if (row < NT) { const int h = cs >> 7, d = cs & 127;
                            if (third == 1) { *(f32x4*)(out + (smp ? O_KS + (size_t)s * 1024 : O_KP + (size_t)row * 1024) + cs) = v;
                                *(u32x2*)((smp ? KS : KP) + kf_index(b * 8 + h, nkt, key, d)) = o; }
                            else { *(f32x4*)(out + (smp ? O_VS + (size_t)s * 1024 : O_VP + (size_t)row * 1024) + cs) = v;
                                bf16_t* vt = (smp ? VTS : VTP) + vf_index(b * 8 + h, nkt, key, d);
                                vt[0] = (bf16_t)(o.x & 0xffffu); vt[8] = (bf16_t)(o.x >> 16); vt[16] = (bf16_t)(o.y & 0xffffu); vt[24] = (bf16_t)(o.y >> 16); } } } }
    }
};
struct EpiFin {
    struct Pre {}; DI void prefetch(Pre&, const Unit&, int, int) const {}
    static constexpr bool PERM = false, AFTER_DRAIN = false;
    const bf16_t* XB; float* SSQ; float* out;
    DI void row(const f32x4 (&a4)[2][2], const Unit& u, int ai, int m, int wr, int wc, int fr, int fq) const {
        const int cb = u.pn * 256 + wc * 32 + 4 * fq, row = u.pm * 256 + wr * 64 + fr + ai * 128 + m * 16; float ss = 0.f;
        const int b = row / TP, t = row - b * TP; const bool ok = row < NT && (row >= NTP || t >= 16);
        float* dst = out + (row >= NTP ? O_YS + (size_t)(row - NTP) * 1024 : O_YP + ((size_t)b * 4096 + (t - 16)) * 1024);
#pragma unroll
        for (int bj = 0; bj < 2; ++bj)
#pragma unroll
            for (int n = 0; n < 2; ++n) { const int cs = cb + bj * 128 + n * 16; f32x4 v = a4[bj][n];
                const u32x2 x = *(const u32x2*)(XB + (size_t)row * 1024 + cs);
                v[0] += bflo(x.x); v[1] += bfhi(x.x); v[2] += bflo(x.y); v[3] += bfhi(x.y);
                if (ok) *(f32x4*)(dst + cs) = v;
                ss += (v[0] * v[0] + v[1] * v[1]) + (v[2] * v[2] + v[3] * v[3]); }
        ss += __shfl_xor(ss, 16); ss += __shfl_xor(ss, 32);
        if (fq == 0) SSQ[(size_t)row * 16 + u.pn * 4 + wc] = ss;
    }
    DI void operator()(const f32x4 (&acc)[2][2][4][2], const Unit& u, int wr, int wc, int fr, int fq, const Pre& pre) const {
        const int cb = u.pn * 256 + wc * 32 + 4 * fq, row0 = u.pm * 256 + wr * 64 + fr;
#pragma unroll
        for (int ai = 0; ai < 2; ++ai) {
            u32x2 x[4][2][2];
#pragma unroll
            for (int m = 0; m < 4; ++m)
#pragma unroll
                for (int bj = 0; bj < 2; ++bj)
#pragma unroll
                    for (int n = 0; n < 2; ++n) x[m][bj][n] = *(const u32x2*)(XB + (size_t)(row0 + ai * 128 + m * 16) * 1024 + cb + bj * 128 + n * 16);
#pragma unroll
            for (int m = 0; m < 4; ++m) { const int row = row0 + ai * 128 + m * 16; float ss = 0.f;
                const int b = row / TP, t = row - b * TP; const bool ok = row < NT && (row >= NTP || t >= 16);
                float* dst = out + (row >= NTP ? O_YS + (size_t)(row - NTP) * 1024 : O_YP + ((size_t)b * 4096 + (t - 16)) * 1024);
#pragma unroll
                for (int bj = 0; bj < 2; ++bj)
#pragma unroll
                    for (int n = 0; n < 2; ++n) { const int cs = cb + bj * 128 + n * 16; f32x4 v = acc[ai][bj][m][n]; const u32x2 xx = x[m][bj][n];
                        v[0] += bflo(xx.x); v[1] += bfhi(xx.x); v[2] += bflo(xx.y); v[3] += bfhi(xx.y);
                        if (ok) *(f32x4*)(dst + cs) = v;
                        ss += (v[0] * v[0] + v[1] * v[1]) + (v[2] * v[2] + v[3] * v[3]); }
                ss += __shfl_xor(ss, 16); ss += __shfl_xor(ss, 32);
                if (fq == 0) SSQ[(size_t)row * 16 + u.pn * 4 + wc] = ss; } }
    }
};
template <class Epi> DI void run_gemm(LAS unsigned char* lds, const bf16_t* A, const bf16_t* Bt, int N, int K, const Epi& E) {
    pg8::Gemm g; g.A = A; g.Bt = Bt; g.M = MP; g.N = N; g.K = K; g.part = nullptr;
    pg8::StaticOrder S; S.init(MP, N, (int)gridDim.x, (int)blockIdx.x);
    pg8::gemm_phase<Epi, pg8::StaticOrder>(lds, g, S, E);
}
struct SplitOrder : pg8::StaticOrder {
    int nwhole, ntail, S, nks;
    DI void init2(int N, int K) { init(MP, N, (int)gridDim.x, (int)blockIdx.x); nwhole = nwg / G; ntail = nwg - nwhole * G; S = 0; nks = 0;
        if (ntail > 0) { int s = G / ntail; const int nkt = K / 64; while (s > 1 && (nkt % s != 0 || (nkt / s) < 4 || ((nkt / s) & 1))) --s; if (s > 1) { S = s; nks = nkt / s; } } }
    DI bool next(int i, Unit& u) const {
        if (S == 0) return pg8::StaticOrder::next(i, u);
        if (i < nwhole) { map(i * G + c, u); return true; }
        if (i == nwhole && c < ntail * S) { map(nwhole * G + c / S, u); u.kb = (c % S) * nks; u.nk = nks; u.part = c; return true; }
        return false;
    }
};
template <class Epi> DI void run_gemm_split(LAS unsigned char* lds, const bf16_t* A, const bf16_t* Bt, int N, int K, const Epi& E, float* part) {
    pg8::Gemm g; g.A = A; g.Bt = Bt; g.M = MP; g.N = N; g.K = K; g.part = part;
    SplitOrder S; S.init2(N, K);
    pg8::gemm_phase<Epi, SplitOrder>(lds, g, S, E);
}
template <class Epi> DI void gemm_fixup(int N, int K, const Epi& E, const float* part, int tid) {
    SplitOrder S; S.init2(N, K); if (S.S == 0) return;
    const int wid = tid >> 6, lane = tid & 63, wr = wid >> 2, wc = wid & 3, fr = lane & 15, fq = lane >> 4;
    for (int it = blockIdx.x; it < S.ntail * 8; it += gridDim.x) { const int j = it >> 3, ai = (it >> 2) & 1, m = it & 3; Unit u; S.map(S.nwhole * S.G + j, u);
        f32x4 a4[2][2];
#pragma unroll
        for (int b = 0; b < 2; ++b)
#pragma unroll
            for (int n = 0; n < 2; ++n) { const f32x4* pp = (const f32x4*)part + ((size_t)(j * S.S) * 32 + (((ai * 2 + b) * 4 + m) * 2 + n)) * 512 + tid;
                f32x4 v0 = {0.f, 0.f, 0.f, 0.f}, v1 = v0, v2 = v0, v3 = v0;
                for (int sl = 0; sl + 3 < S.S; sl += 4) { v0 += pp[(size_t)sl * 16384]; v1 += pp[(size_t)(sl + 1) * 16384]; v2 += pp[(size_t)(sl + 2) * 16384]; v3 += pp[(size_t)(sl + 3) * 16384]; }
                for (int sl = S.S & ~3; sl < S.S; ++sl) v0 += pp[(size_t)sl * 16384];
                a4[b][n] = (v0 + v1) + (v2 + v3); }
        E.row(a4, u, ai, m, wr, wc, fr, fq); }
}
DI void rinv_pass(const Prm& p, int K, int tid) {
    SplitOrder S; S.init2(1024, K);
    for (int pm = blockIdx.x; pm < MP / 256; pm += gridDim.x) {
        bool tail = false;
        if (S.S) for (int j = 0; j < S.ntail; ++j) { Unit u; S.map(S.nwhole * S.G + j, u); tail = tail || (u.pm == pm); }
        if (tid < 256) { const int row = pm * 256 + tid; float v = -1.f;
            if (!tail) { const f32x4* q = (const f32x4*)(p.SSQ + (size_t)row * 16); const f32x4 a = q[0] + q[1] + q[2] + q[3]; v = rsqrtf(((a.x + a.y) + (a.z + a.w)) * (1.f / 1024.f) + EPSN); }
            if (row >= NT) v = 1.f;
            p.RINV[row] = v; }
    }
}
DI void transpose_item(const float* W, int N, bf16_t* WT, size_t ldo, const float* sc, LAS float* scr, int item, int lane) {
    const int nblk = N / 32, kb = item / nblk, nb = item % nblk, k0 = 64 * kb, n0 = 32 * nb;
#pragma unroll 8
    for (int i = 0; i < 32; ++i) { const int kk = 2 * i + (lane >> 5); float w = W[(size_t)(k0 + kk) * N + n0 + (lane & 31)]; if (sc) w *= sc[k0 + kk]; scr[kk * 33 + (lane & 31)] = w; }
    LDS_WAIT();
    const int c = lane & 7;
#pragma unroll
    for (int j = 0; j < 4; ++j) { const int n = (lane >> 3) + 8 * j; const LAS float* s = scr + (8 * c) * 33 + n;
        u32x4v o; o.x = pk2(s[0 * 33], s[1 * 33]); o.y = pk2(s[2 * 33], s[3 * 33]); o.z = pk2(s[4 * 33], s[5 * 33]); o.w = pk2(s[6 * 33], s[7 * 33]);
        *(u32x4v*)(WT + (size_t)(n0 + n) * ldo + k0 + 8 * c) = o; }
    LDS_WAIT();
}
DI void s5_pow(const Prm& p, int g, int n, float k, float& re, float& im) {
    const float dt = __expf(p.log_dt[g]), ar = p.a_re[g * 64 + n], ai = p.a_im[g * 64 + n];
    const float mag = __expf(k * dt * ar); float rev = k * dt * ai * 0.15915494309189535f; rev -= rintf(rev);
    re = mag * __builtin_amdgcn_cosf(rev); im = mag * __builtin_amdgcn_sinf(rev);
}
DI void s5_bbar(const Prm& p, int g, int n, int pp, float& re, float& im) {
    const float ar = p.a_re[g * 64 + n], ai = p.a_im[g * 64 + n]; float abr, abi; s5_pow(p, g, n, 1.f, abr, abi);
    const float den = ar * ar + ai * ai, zr = ((abr - 1.f) * ar + abi * ai) / den, zi = (abi * ar - (abr - 1.f) * ai) / den;
    const float br = p.b_re[(g * 64 + n) * 16 + pp], bi = p.b_im[(g * 64 + n) * 16 + pp];
    re = zr * br - zi * bi; im = zr * bi + zi * br;
}
DI void phase_prologue(const Prm& p, LAS unsigned char* lds, int tid, int lane, int wave) {
    const int gw = blockIdx.x * 8 + wave, NGW = gridDim.x * 8, gtid = blockIdx.x * 512 + tid, GT = gridDim.x * 512;
    LAS float* scr = (LAS float*)(lds + wave * 16384);
    constexpr int I1 = 16 * 80, I2 = 8 * 16, I3 = 16 * 32, I4 = 16 * 128, I5 = 64 * 32, I6 = 16 * 96;
    constexpr int NITEMS = I1 + I2 + I3 + I4 + I5 + I6 + I3 + I4 + I5;
    for (int it = gw; it < NITEMS; it += NGW) {
        int r = it;
        if (r < I1) { transpose_item(p.w_in_even, 2560, p.Wt1, 1024, p.ln_mix, scr, r, lane); continue; } r -= I1;
        if (r < I2) { transpose_item(p.w_glu, 512, p.Wglu, 512, nullptr, scr, r, lane); continue; } r -= I2;
        if (r < I3) { transpose_item(p.w_out_even, 1024, p.Wo0, 1024, nullptr, scr, r, lane); continue; } r -= I3;
        if (r < I4) { transpose_item(p.w_up, 4096, p.Wup0, 1024, p.ln_mlp, scr, r, lane); continue; } r -= I4;
        if (r < I5) { transpose_item(p.w_down, 1024, p.Wdn0, 4096, nullptr, scr, r, lane); continue; } r -= I5;
        if (r < I6) { transpose_item(p.w_in_odd, 3072, p.Wqkv, 1024, p.ln_mix + 1024, scr, r, lane); continue; } r -= I6;
        if (r < I3) { transpose_item(p.w_out_odd, 1024, p.Wo1, 1024, nullptr, scr, r, lane); continue; } r -= I3;
        if (r < I4) { transpose_item(p.w_up + (size_t)1024 * 4096, 4096, p.Wup1, 1024, p.ln_mlp + 1024, scr, r, lane); continue; } r -= I4;
        transpose_item(p.w_down + (size_t)4096 * 1024, 1024, p.Wdn1, 4096, nullptr, scr, r, lane);
    }
    for (int row = gw; row < NT; row += NGW) {
        const float* src;
        if (row < NTP) { const int b = row / TP, t = row - b * TP; src = t < 16 ? p.meta + (size_t)t * 1024 : p.x_prompt + ((size_t)b * 4096 + (t - 16)) * 1024; }
        else src = p.x_sample + (size_t)(row - NTP) * 1024;
        float ss = 0.f;
#pragma unroll
        for (int j = 0; j < 4; ++j) { const f32x4 v = ((const f32x4*)src)[lane + 64 * j]; u32x2 o; o.x = pk2(v.x, v.y); o.y = pk2(v.z, v.w);
            const float a0 = bflo(o.x), a1 = bfhi(o.x), a2 = bflo(o.y), a3 = bfhi(o.y); ss += (a0 * a0 + a1 * a1) + (a2 * a2 + a3 * a3);
            ((u32x2*)(p.XB + (size_t)row * 1024))[lane + 64 * j] = o; }
        ss = wave_sum(ss);
        if (lane < 16) p.SSQ[(size_t)row * 16 + lane] = lane == 0 ? ss : 0.f;
        if (lane == 0) p.RINV[row] = rsqrtf(ss * (1.f / 1024.f) + EPSN);
    }
    if (gtid < MP - NT) p.RINV[NT + gtid] = 1.f;
    if (gtid < 512) p.LB[gtid] = 1.f / (1.f + __expf(p.hgrn_lb[512 + gtid] - p.hgrn_lb[gtid]));
    __syncthreads();
    {
        LAS float* zr_ = (LAS float*)lds; LAS float* zi_ = zr_ + 64; LAS float* wr_ = zi_ + 64; LAS float* wi_ = wr_ + 64;
        LAS float* bbr = wi_ + 64; LAS float* bbi = bbr + 1024; LAS float* cwr = bbi + 1024; LAS float* cwi = cwr + 16 * 65;
        for (int pair = blockIdx.x; pair < 512; pair += gridDim.x) { const int g = pair >> 4, tau = pair & 15;
            if (tid < 64) { const int n = tid; const float ar = p.a_re[g * 64 + n], ai = p.a_im[g * 64 + n]; float abr, abi; s5_pow(p, g, n, 1.f, abr, abi);
                const float den = ar * ar + ai * ai; zr_[n] = ((abr - 1.f) * ar + abi * ai) / den; zi_[n] = (abi * ar - (abr - 1.f) * ai) / den;
                float a, b; s5_pow(p, g, n, (float)tau, a, b); wr_[n] = a; wi_[n] = b; }
            __syncthreads();
#pragma unroll
            for (int k = 0; k < 2; ++k) { const int e = tid + 512 * k;
                { const int n = e >> 4; const float br = p.b_re[g * 1024 + e], bi = p.b_im[g * 1024 + e]; bbr[e] = zr_[n] * br - zi_[n] * bi; bbi[e] = zr_[n] * bi + zi_[n] * br; }
                { const int pch = e >> 6, n = e & 63; const float cr = p.c_re[g * 1024 + e], ci = p.c_im[g * 1024 + e]; cwr[pch * 65 + n] = cr * wr_[n] - ci * wi_[n]; cwi[pch * 65 + n] = cr * wi_[n] + ci * wr_[n]; } }
            __syncthreads();
            if (tid < 256) { const int pch = tid >> 4, pp = tid & 15; float acc = 0.f;
#pragma unroll 8
                for (int n = 0; n < 64; ++n) acc += cwr[pch * 65 + n] * bbr[n * 16 + pp] - cwi[pch * 65 + n] * bbi[n * 16 + pp];
                if (tau == 0 && pch == pp) acc += p.ssm_d[g * 16 + pch];
                const bf16_t kv = f2bf(acc);
                p.TG[((g * 16 + tau) * 16 + pch) * 16 + pp] = kv; }
            __syncthreads(); }
    }
    for (int i = gtid; i < 32 * 256 * 64; i += GT) {
        const int g = i >> 14, t = (i >> 10) & 15, pch = (i >> 6) & 15, n = i & 63; float wr_, wi_; s5_pow(p, g, n, (float)(t + 1), wr_, wi_);
        const float cr = p.c_re[(g * 16 + pch) * 64 + n], ci = p.c_im[(g * 16 + pch) * 64 + n];
        *(unsigned*)(p.TG + 131072 + ((size_t)(g * 256 + t * 16 + pch)) * 128 + 2 * n) = pk2(cr * wr_ - ci * wi_, -(cr * wi_ + ci * wr_)); }
    for (int i = gtid; i < 32 * 64 * 256; i += GT) {
        const int g = i >> 14, n = (i >> 8) & 63, s = (i >> 4) & 15, pp = i & 15; float wr_, wi_, br_, bi_; s5_pow(p, g, n, (float)(15 - s), wr_, wi_); s5_bbar(p, g, n, pp, br_, bi_);
        p.HT[((size_t)(g * 128 + 2 * n)) * 256 + s * 16 + pp] = f2bf(wr_ * br_ - wi_ * bi_);
        p.HT[((size_t)(g * 128 + 2 * n + 1)) * 256 + s * 16 + pp] = f2bf(wr_ * bi_ + wi_ * br_); }
    if (gtid < 2048) { float wr_, wi_; s5_pow(p, gtid >> 6, gtid & 63, 16.f, wr_, wi_); p.A16[2 * gtid] = wr_; p.A16[2 * gtid + 1] = wi_; }
}

constexpr int HP = 136, TPI = 72;
constexpr int L_QT = 0, L_QH = 17408, L_KT = 34816, L_KTT = 52224, L_IVT = 70656, L_ATT = 89088, L_SUM = 98304, L_VEC = 100352, L_OB = 0  ;
struct HItem { int row0, L, h, bh; };
DI HItem hgrn_item(int item) {
    HItem it;
    if (item < 2080) { const int bh = item / 65, c = item - bh * 65, b = bh >> 2; it.h = bh & 3; it.bh = bh; it.L = c == 0 ? 16 : 64; it.row0 = b * TP + (c == 0 ? 0 : 16 + 64 * (c - 1)); }
    else { const int s = item - 2080, b = s >> 2; it.h = s & 3; it.bh = 32 + s; it.L = 64; it.row0 = NTP + b * 64; }
    return it;
}
template <bool FULL> DI void hgrn_loadraw(const Prm& p, const HItem& it, int tid, unsigned (&rl)[16], unsigned (&rv)[16], unsigned (&rq)[16]) {
    const int d = tid & 127, t0 = 16 * (tid >> 7), col = it.h * 128 + d;
#pragma unroll
    for (int j = 0; j < 16; ++j) { const int t = t0 + j; const bool valid = t < it.L; const size_t o = (size_t)(it.row0 + t) * 512 + col;
        rl[j] = valid ? (unsigned)p.LOGF[o] : 0u; rv[j] = valid ? (unsigned)p.IV[o] : 0u; if (FULL) rq[j] = valid ? (unsigned)p.Qh[o] : 0u; }
}
template <bool FULL> DI void hgrn_prep(const HItem& it, LAS unsigned char* lds, int tid, const unsigned (&rl)[16], const unsigned (&rv)[16], const unsigned (&rq)[16]) {
    const int d = tid & 127, tq = tid >> 7, t0 = 16 * tq;
    LAS float* sums = (LAS float*)(lds + L_SUM); LAS float* vec = (LAS float*)(lds + L_VEC);
    float cs[16], lf[16];
    float run = 0.f;
#pragma unroll
    for (int j = 0; j < 16; ++j) { lf[j] = h2f((unsigned short)rl[j]); run += lf[j]; cs[j] = run; }
    sums[tq * 128 + d] = run;
    { LAS u32x4v* dst = (LAS u32x4v*)(lds + L_IVT + (d * TPI + t0) * 2); u32x4v a, b;
        a.x = rv[0] | (rv[1] << 16); a.y = rv[2] | (rv[3] << 16); a.z = rv[4] | (rv[5] << 16); a.w = rv[6] | (rv[7] << 16);
        b.x = rv[8] | (rv[9] << 16); b.y = rv[10] | (rv[11] << 16); b.z = rv[12] | (rv[13] << 16); b.w = rv[14] | (rv[15] << 16); dst[0] = a; dst[1] = b; }
    __syncthreads();
    const float s0 = sums[d], s1 = sums[128 + d], s2 = sums[256 + d], s3 = sums[384 + d];
    const float off = tq == 0 ? 0.f : tq == 1 ? s0 : tq == 2 ? s0 + s1 : s0 + s1 + s2, r = s0 + s1, bL = r + s2 + s3;
    if (tq == 0) { vec[d] = r; vec[128 + d] = bL; }
    unsigned ktp[8]; float kprev = 0.f;
#pragma unroll
    for (int j = 0; j < 16; ++j) { const int t = t0 + j; const bool valid = t < it.L; const float b = off + cs[j];
        const float kt = valid ? (1.f - __expf(lf[j])) * __expf(r - b) : 0.f;
        if (j & 1) ktp[j >> 1] = pk2(kprev, kt); else kprev = kt;
        if (FULL) { const float qv = bf2f((unsigned short)rq[j]);
            *(LAS unsigned short*)(lds + L_KT + (t * HP + d) * 2) = f2bf(kt);
            *(LAS unsigned short*)(lds + L_QT + (t * HP + d) * 2) = f2bf(qv * __expf(b - r));
            *(LAS unsigned short*)(lds + L_QH + (t * HP + d) * 2) = f2bf(qv * __expf(b)); } }
    if (!FULL) { LAS u32x4v* dst = (LAS u32x4v*)(lds + L_KTT + (d * TPI + t0) * 2); u32x4v a, b; a.x = ktp[0]; a.y = ktp[1]; a.z = ktp[2]; a.w = ktp[3]; b.x = ktp[4]; b.y = ktp[5]; b.z = ktp[6]; b.w = ktp[7]; dst[0] = a; dst[1] = b; }
    __syncthreads();
}
#define MFMA16(a, b, c) __builtin_amdgcn_mfma_f32_16x16x32_bf16((a), (b), (c), 0, 0, 0)
#define MFMA32(a, b, c) __builtin_amdgcn_mfma_f32_32x32x16_bf16((a), (b), (c), 0, 0, 0)
DI void hgrn_b1_all(const Prm& p, LAS unsigned char* lds, int tid, int lane, int wave) {
    const int fr = lane & 15, fq = lane >> 4;
    int item = blockIdx.x; if (item >= NITEM_H) return;
    unsigned rl[16], rv[16], rq[16];
    hgrn_loadraw<false>(p, hgrn_item(item), tid, rl, rv, rq);
    while (item < NITEM_H) {
        const HItem it = hgrn_item(item);
        hgrn_prep<false>(it, lds, tid, rl, rv, rq);
        const int next = item + gridDim.x;
        if (next < NITEM_H) hgrn_loadraw<false>(p, hgrn_item(next), tid, rl, rv, rq);
        const LAS float* vec = (const LAS float*)(lds + L_VEC);
        bf16x8 a[2];
#pragma unroll
        for (int ks = 0; ks < 2; ++ks) a[ks] = *(const LAS bf16x8*)(lds + L_KTT + ((16 * wave + fr) * TPI + 32 * ks + 8 * fq) * 2);
        float e2[4];
#pragma unroll
        for (int j = 0; j < 4; ++j) { const int d = 16 * wave + 4 * fq + j; e2[j] = __expf(vec[128 + d] - vec[d]); }
#pragma unroll
        for (int vt = 0; vt < 8; ++vt) { f32x4 acc = {0.f, 0.f, 0.f, 0.f};
#pragma unroll
            for (int ks = 0; ks < 2; ++ks) { const bf16x8 b = *(const LAS bf16x8*)(lds + L_IVT + ((16 * vt + fr) * TPI + 32 * ks + 8 * fq) * 2); acc = MFMA16(a[ks], b, acc); }
            u32x2 o; o.x = pk2(acc[0] * e2[0], acc[1] * e2[1]); o.y = pk2(acc[2] * e2[2], acc[3] * e2[3]);
            *(u32x2*)(p.UT + (size_t)item * 16384 + (16 * vt + fr) * 128 + 16 * wave + 4 * fq) = o; }
        if (tid < 128) p.AL[(size_t)item * 128 + tid] = __expf(vec[128 + tid]);
        __syncthreads();
        item = next;
    }
}
template <int NB> DI void hgrn_b2_steps(const Prm& p, int item, int v, int d4, float (&S)[4]) {
    u32x2 uu[NB]; f32x4 al[NB];
#pragma unroll
    for (int i = 0; i < NB; ++i) { uu[i] = *(const u32x2*)(p.UT + (size_t)(item + i) * 16384 + v * 128 + d4); al[i] = *(const f32x4*)(p.AL + (size_t)(item + i) * 128 + d4); }
#pragma unroll
    for (int i = 0; i < NB; ++i) { u32x2 o; o.x = pk2(S[0], S[1]); o.y = pk2(S[2], S[3]);
        *(u32x2*)(p.UT + (size_t)(item + i) * 16384 + v * 128 + d4) = o;
        S[0] = al[i][0] * S[0] + bflo(uu[i].x); S[1] = al[i][1] * S[1] + bfhi(uu[i].x); S[2] = al[i][2] * S[2] + bflo(uu[i].y); S[3] = al[i][3] * S[3] + bfhi(uu[i].y); }
}
DI void hgrn_b2(const Prm& p, int gtid, int GT) {
    for (int idx = gtid; idx < 64 * 4096; idx += GT) {
        const int bhx = idx >> 12, e = idx & 4095, v = e >> 5, d4 = (e & 31) * 4; const bool smp = bhx >= 32;
        float S[4] = {0.f, 0.f, 0.f, 0.f};
        if (smp) {
#pragma unroll
            for (int j = 0; j < 4; ++j) S[j] = p.state_hgrn[((size_t)(bhx - 32) * 128 + d4 + j) * 128 + v];
            hgrn_b2_steps<1>(p, 2080 + (bhx - 32), v, d4, S); }
        else { for (int c0 = 0; c0 < 65; c0 += 13) hgrn_b2_steps<13>(p, bhx * 65 + c0, v, d4, S); }
        float* dst = p.out + (smp ? O_HGS + (size_t)(bhx - 32) * 16384 : O_HGP + (size_t)bhx * 16384);
#pragma unroll
        for (int j = 0; j < 4; ++j) dst[(d4 + j) * 128 + v] = S[j];
    }
}
DI void hgrn_b3_all(const Prm& p, LAS unsigned char* lds, int tid, int lane, int wave) {
    const int fr = lane & 15, fq = lane >> 4;
    int item = blockIdx.x; if (item >= NITEM_H) return;
    unsigned rl[16], rv[16], rq[16];
    hgrn_loadraw<true>(p, hgrn_item(item), tid, rl, rv, rq);
    const int nt_ = tid >> 3, nsg = tid & 7;
    while (item < NITEM_H) {
        const HItem it = hgrn_item(item);
        bf16x8 sf[4][4];
#pragma unroll
        for (int i = 0; i < 4; ++i)
#pragma unroll
            for (int ks = 0; ks < 4; ++ks) sf[i][ks] = *(const bf16x8*)(p.UT + (size_t)item * 16384 + (16 * (4 * (wave >> 2) + i) + fr) * 128 + 32 * ks + 8 * fq);
        const size_t grow = (size_t)(it.row0 + (nt_ < it.L ? nt_ : 0)); const int gc0 = it.h * 128 + 16 * nsg;
        const u32x4v g0 = *(const u32x4v*)(p.GS + grow * 512 + gc0), g1 = *(const u32x4v*)(p.GS + grow * 512 + gc0 + 8);
        hgrn_prep<true>(it, lds, tid, rl, rv, rq);
        const int next = item + gridDim.x;
        if (next < NITEM_H) hgrn_loadraw<true>(p, hgrn_item(next), tid, rl, rv, rq);
        {
            const int tt = wave >> 1;
#pragma unroll
            for (int i = 0; i < 2; ++i) { const int st = 2 * (wave & 1) + i; f32x4 acc = {0.f, 0.f, 0.f, 0.f};
#pragma unroll
                for (int ks = 0; ks < 4; ++ks) { const bf16x8 a = *(const LAS bf16x8*)(lds + L_KT + ((16 * st + fr) * HP + 32 * ks + 8 * fq) * 2);
                    const bf16x8 b = *(const LAS bf16x8*)(lds + L_QT + ((16 * tt + fr) * HP + 32 * ks + 8 * fq) * 2); acc = MFMA16(a, b, acc); }
                const int t = 16 * tt + fr, s0 = 16 * st + 4 * fq;
                u32x2 o; o.x = pk2(s0 <= t ? acc[0] : 0.f, s0 + 1 <= t ? acc[1] : 0.f); o.y = pk2(s0 + 2 <= t ? acc[2] : 0.f, s0 + 3 <= t ? acc[3] : 0.f);
                *(LAS u32x2*)(lds + L_ATT + (t * TPI + s0) * 2) = o; }
        }
        __syncthreads();
        f32x4 oacc[4];
        {   const int tt = wave & 3;
            bf16x8 aa[2], aq[4];
#pragma unroll
            for (int ks = 0; ks < 2; ++ks) aa[ks] = *(const LAS bf16x8*)(lds + L_ATT + ((16 * tt + fr) * TPI + 32 * ks + 8 * fq) * 2);
#pragma unroll
            for (int ks = 0; ks < 4; ++ks) aq[ks] = *(const LAS bf16x8*)(lds + L_QH + ((16 * tt + fr) * HP + 32 * ks + 8 * fq) * 2);
#pragma unroll
            for (int i = 0; i < 4; ++i) { const int vt = 4 * (wave >> 2) + i; f32x4 acc = {0.f, 0.f, 0.f, 0.f};
#pragma unroll
                for (int ks = 0; ks < 2; ++ks) { const bf16x8 b = *(const LAS bf16x8*)(lds + L_IVT + ((16 * vt + fr) * TPI + 32 * ks + 8 * fq) * 2); acc = MFMA16(aa[ks], b, acc); }
#pragma unroll
                for (int ks = 0; ks < 4; ++ks) acc = MFMA16(aq[ks], sf[i][ks], acc);
                oacc[i] = acc; }
        }
        f32x4 gn[4];
#pragma unroll
        for (int j = 0; j < 4; ++j) gn[j] = ((const f32x4*)(p.hgrn_norm + 16 * nsg))[j];
        __syncthreads();
        {   const int tt = wave & 3; LAS float* ob = (LAS float*)(lds + L_OB);
#pragma unroll
            for (int i = 0; i < 4; ++i) { const int v = 16 * (4 * (wave >> 2) + i) + fr;
#pragma unroll
                for (int j = 0; j < 4; ++j) ob[(16 * tt + 4 * fq + j) * 132 + v] = oacc[i][j]; }
        }
        __syncthreads();
        {   const int t = nt_, sg = nsg; const LAS float* ob = (const LAS float*)(lds + L_OB) + t * 132 + 16 * sg;
            f32x4 x[4]; float ss = 0.f;
#pragma unroll
            for (int j = 0; j < 4; ++j) { x[j] = ((const LAS f32x4*)ob)[j]; ss += (x[j].x * x[j].x + x[j].y * x[j].y) + (x[j].z * x[j].z + x[j].w * x[j].w); }
            ss += __shfl_xor(ss, 1); ss += __shfl_xor(ss, 2); ss += __shfl_xor(ss, 4);
            const float rr = rsqrtf(ss * (1.f / 128.f) + EPSN);
            if (t < it.L) { const size_t row = it.row0 + t; const int c0 = it.h * 128 + 16 * sg;
                const f32x4 n0 = gn[0], n1 = gn[1], n2 = gn[2], n3 = gn[3];
                u32x4v o0, o1;
                o0.x = pk2(x[0].x * rr * n0.x * bflo(g0.x), x[0].y * rr * n0.y * bfhi(g0.x)); o0.y = pk2(x[0].z * rr * n0.z * bflo(g0.y), x[0].w * rr * n0.w * bfhi(g0.y));
                o0.z = pk2(x[1].x * rr * n1.x * bflo(g0.z), x[1].y * rr * n1.y * bfhi(g0.z)); o0.w = pk2(x[1].z * rr * n1.z * bflo(g0.w), x[1].w * rr * n1.w * bfhi(g0.w));
                o1.x = pk2(x[2].x * rr * n2.x * bflo(g1.x), x[2].y * rr * n2.y * bfhi(g1.x)); o1.y = pk2(x[2].z * rr * n2.z * bflo(g1.y), x[2].w * rr * n2.w * bfhi(g1.y));
                o1.z = pk2(x[3].x * rr * n3.x * bflo(g1.z), x[3].y * rr * n3.y * bfhi(g1.z)); o1.w = pk2(x[3].z * rr * n3.z * bflo(g1.w), x[3].w * rr * n3.w * bfhi(g1.w));
                *(u32x4v*)(p.CAT + row * 1024 + c0) = o0; *(u32x4v*)(p.CAT + row * 1024 + c0 + 8) = o1; }
        }
        __syncthreads();
        item = next;
    }
}
DI void s5_load_u(const Prm& p, int mt, int g, int lane, bf16x8 (&uf)[8]) {
    const int fr = lane & 15, fq = lane >> 4; int col = 16 * mt + fr; if (col >= NCOL) col = NCOL - 1;
#pragma unroll
    for (int ks = 0; ks < 8; ++ks) uf[ks] = *(const bf16x8*)(p.U + ((size_t)(16 * col + 2 * ks + (fq >> 1))) * 512 + 16 * g + 8 * (fq & 1));
}
DI void s5_b(const Prm& p, int gw, int NGW, int lane) {
    const int fr = lane & 15, fq = lane >> 4;
    for (int task = gw; task < 131 * 32; task += NGW) { const int mt = task >> 5, g = task & 31;
        bf16x8 uf[8]; s5_load_u(p, mt, g, lane, uf);
#pragma unroll
        for (int nt = 0; nt < 8; ++nt) { f32x4 acc = {0.f, 0.f, 0.f, 0.f};
#pragma unroll
            for (int ks = 0; ks < 8; ++ks) { const bf16x8 b = *(const bf16x8*)(p.HT + ((size_t)(g * 128 + 16 * nt + fr)) * 256 + 32 * ks + 8 * fq); acc = MFMA16(uf[ks], b, acc); }
#pragma unroll
            for (int j = 0; j < 4; ++j) { const int col = 16 * mt + 4 * fq + j; if (col < NCOL) p.XLOC[(size_t)col * 4096 + g * 128 + 16 * nt + fr] = acc[j]; } }
    }
}
template <int NB> DI void s5_c_steps(const Prm& p, int col, size_t base, float ar, float ai, float& xr, float& xi) {
    f32x2v xl[NB];
#pragma unroll
    for (int i = 0; i < NB; ++i) xl[i] = *(const f32x2v*)(p.XLOC + (size_t)(col + i) * 4096 + base);
#pragma unroll
    for (int i = 0; i < NB; ++i) { *(unsigned*)(p.XPREV + (size_t)(col + i) * 4096 + base) = pk2(xr, xi);
        const float nr = ar * xr - ai * xi + xl[i].x, ni = ar * xi + ai * xr + xl[i].y; xr = nr; xi = ni; }
}
DI void s5_c(const Prm& p, int gtid) {
    if (gtid >= 16 * 2048) return;
    const int seq = gtid >> 11, g = (gtid >> 6) & 31, n = gtid & 63; const bool smp = seq >= 8; const int b = seq & 7;
    float xr = 0.f, xi = 0.f; if (smp) { xr = p.ssm_re0[(b * 32 + g) * 64 + n]; xi = p.ssm_im0[(b * 32 + g) * 64 + n]; }
    const float ar = p.A16[2 * (g * 64 + n)], ai = p.A16[2 * (g * 64 + n) + 1];
    const size_t base = (size_t)g * 128 + 2 * n;
    if (smp) s5_c_steps<4>(p, 2056 + 4 * b, base, ar, ai, xr, xi);
    else { for (int c0 = 0; c0 < 256; c0 += 16) s5_c_steps<16>(p, 257 * b + c0, base, ar, ai, xr, xi); s5_c_steps<1>(p, 257 * b + 256, base, ar, ai, xr, xi); }
    const size_t o = (size_t)(b * 32 + g) * 64 + n;
    p.out[(smp ? O_SRS : O_SRP) + o] = xr; p.out[(smp ? O_SIS : O_SIP) + o] = xi;
}
DI f32x2v gelu_pk(f32x2v v) {
    const f32x2v av = __builtin_elementwise_abs(v), d = av * 0.2316418882f + 1.0f;
    f32x2v t; t.x = __builtin_amdgcn_rcpf(d.x); t.y = __builtin_amdgcn_rcpf(d.y);
    f32x2v q = t * 0.5307027145f + (-0.7265760135f); q = q * t + 0.7107068705f; q = q * t + (-0.142248368f); q = q * t + 0.127414796f; q = q * t;
    const f32x2v s = (v * v) * (-0.72134752044f);
    f32x2v e; e.x = __builtin_amdgcn_exp2f(s.x); e.y = __builtin_amdgcn_exp2f(s.y);
    const f32x2v m = v * (q * e), r = v - m;
    f32x2v o; o.x = v.x < 0.f ? m.x : r.x; o.y = v.y < 0.f ? m.y : r.y; return o;
}
DI void s5_d(const Prm& p, int gw, int NGW, int lane) {
    const int fr = lane & 15, fq = lane >> 4;
    for (int task = gw; task < 131 * 32; task += NGW) { const int mt = task >> 5, g = task & 31;
        bf16x8 uf[8], xf[4]; s5_load_u(p, mt, g, lane, uf);
        int colc = 16 * mt + fr; if (colc >= NCOL) colc = NCOL - 1;
#pragma unroll
        for (int ks = 0; ks < 4; ++ks) xf[ks] = *(const bf16x8*)(p.XPREV + (size_t)colc * 4096 + g * 128 + 32 * ks + 8 * fq);
        const bf16_t* tg = p.TG + ((size_t)(g * 256 + fr)) * 384 + 8 * fq;
        const bool ok = 16 * mt + fr < NCOL;
#pragma unroll
        for (int t = 0; t < 16; ++t) { f32x4 acc = {0.f, 0.f, 0.f, 0.f};
#pragma unroll
            for (int ks = 0; ks < 8; ++ks) if (ks <= (t >> 1)) { const bf16x8 a = *(const bf16x8*)(tg + (size_t)t * 16 * 384 + 32 * ks); acc = MFMA16(a, uf[ks], acc); }
#pragma unroll
            for (int ks = 0; ks < 4; ++ks) { const bf16x8 a = *(const bf16x8*)(tg + (size_t)t * 16 * 384 + 256 + 32 * ks); acc = MFMA16(a, xf[ks], acc); }
            const f32x2v y0 = gelu_pk((f32x2v){acc[0], acc[1]}), y1 = gelu_pk((f32x2v){acc[2], acc[3]});
            u32x2 o; o.x = pk2(y0.x, y0.y); o.y = pk2(y1.x, y1.y);
            if (ok) *(u32x2*)(p.YG + ((size_t)(16 * (16 * mt + fr) + t)) * 512 + 16 * g + 4 * fq) = o; }
    }
}

DI void s5_b_lds(const Prm& p, LAS unsigned char* lds, int tid, int lane, int wave) {
    const int fr = lane & 15, fq = lane >> 4;
    for (int gp = blockIdx.x; gp < 256; gp += gridDim.x) { const int g = gp & 31, part = gp >> 5;
        for (int i = tid; i < 128 * 32; i += 512) { const int row = i >> 5, ch = i & 31;
            *(LAS u32x4v*)(lds + row * 528 + ch * 16) = *(const u32x4v*)(p.HT + ((size_t)(g * 128 + row)) * 256 + ch * 8); }
        __syncthreads();
        for (int mt = part + 8 * wave; mt < 131; mt += 64) {
            bf16x8 uf[8]; s5_load_u(p, mt, g, lane, uf);
#pragma unroll 1
            for (int nt = 0; nt < 8; ++nt) { f32x4 acc = {0.f, 0.f, 0.f, 0.f};
#pragma unroll
                for (int ks = 0; ks < 8; ++ks) { const bf16x8 b = *(const LAS bf16x8*)(lds + (16 * nt + fr) * 528 + 64 * ks + 16 * fq); acc = MFMA16(uf[ks], b, acc); }
#pragma unroll
                for (int j = 0; j < 4; ++j) { const int col = 16 * mt + 4 * fq + j; if (col < NCOL) p.XLOC[(size_t)col * 4096 + g * 128 + 16 * nt + fr] = acc[j]; } }
        }
        __syncthreads(); }
}
DI void s5_d_lds(const Prm& p, LAS unsigned char* lds, int tid, int lane, int wave) {
    const int fr = lane & 15, fq = lane >> 4;
    for (int gp = blockIdx.x; gp < 256; gp += gridDim.x) { const int g = gp & 31, part = gp >> 5;
        { const int row = tid >> 1, hf = tid & 1;
            *(LAS u32x4v*)(lds + row * 48 + hf * 16) = *(const u32x4v*)(p.TG + ((size_t)(g * 256 + row)) * 16 + hf * 8); }
        for (int i = tid; i < 256 * 16; i += 512) { const int row = i >> 4, ch = i & 15;
            *(LAS u32x4v*)(lds + 12288 + row * 272 + ch * 16) = *(const u32x4v*)(p.TG + 131072 + ((size_t)(g * 256 + row)) * 128 + ch * 8); }
        __syncthreads();
        const int lb = fr * 48 + (fq & 1) * 16, hi = fq >> 1;
        for (int mt = part + 8 * wave; mt < 131; mt += 64) {
            bf16x8 uf[8], xf[4]; s5_load_u(p, mt, g, lane, uf);
            int colc = 16 * mt + fr; if (colc >= NCOL) colc = NCOL - 1;
#pragma unroll
            for (int ks = 0; ks < 4; ++ks) xf[ks] = *(const bf16x8*)(p.XPREV + (size_t)colc * 4096 + g * 128 + 32 * ks + 8 * fq);
            const bool ok = 16 * mt + fr < NCOL;
#pragma unroll 1
            for (int t = 0; t < 16; ++t) { f32x4 acc = {0.f, 0.f, 0.f, 0.f};
#pragma unroll
                for (int ks = 0; ks < 8; ++ks) if (ks <= (t >> 1)) {
                    const int tau = t - 2 * ks - hi;
                    union { bf16x8 v; u32x4v u; } a; a.v = *(const LAS bf16x8*)(lds + (tau < 0 ? 0 : tau) * 768 + lb);
                    if (tau < 0) a.u = (u32x4v){0u, 0u, 0u, 0u};
                    acc = MFMA16(a.v, uf[ks], acc); }
#pragma unroll
                for (int ks = 0; ks < 4; ++ks) { const bf16x8 a = *(const LAS bf16x8*)(lds + 12288 + (t * 16 + fr) * 272 + 64 * ks + 16 * fq); acc = MFMA16(a, xf[ks], acc); }
                const f32x2v y0 = gelu_pk((f32x2v){acc[0], acc[1]}), y1 = gelu_pk((f32x2v){acc[2], acc[3]});
                u32x2 o; o.x = pk2(y0.x, y0.y); o.y = pk2(y1.x, y1.y);
                if (ok) *(u32x2*)(p.YG + ((size_t)(16 * (16 * mt + fr) + t)) * 512 + 16 * g + 4 * fq) = o; }
        }
        __syncthreads(); }
}
DI void cache_convert(const Prm& p, int gtid, int GT) {
    for (size_t i = (size_t)gtid; i < (size_t)8 * 1024 * 256; i += (size_t)GT) {
        const size_t row = i >> 8; const int c4 = (int)(i & 255) * 4, b = (int)(row >> 10), pos = (int)(row & 1023), h = c4 >> 7, d = c4 & 127;
        const f32x4 k = *(const f32x4*)(p.cache_k + row * 1024 + c4); u32x2 o; o.x = pk2(k.x, k.y); o.y = pk2(k.z, k.w);
        *(u32x2*)(p.KS + kf_index(b * 8 + h, 34, pos, d)) = o;
        const f32x4 v = *(const f32x4*)(p.cache_v + row * 1024 + c4); bf16_t* vt = p.VTS + vf_index(b * 8 + h, 34, pos, d);
        vt[0] = f2bf(v.x); vt[8] = f2bf(v.y); vt[16] = f2bf(v.z); vt[24] = f2bf(v.w); }
}
DI void attn_phase(const Prm& p, int gw, int NGW, int lane) {
    const int q = lane & 31, half = lane >> 5;
    for (int it = gw; it < 8256 + 128; it += NGW) {
        bool smp; int b, h, qb;
        if (it < 8064) { smp = false; b = it / 1008; const int rem = it - b * 1008; h = rem / 126; qb = 3 + rem - h * 126; }
        else if (it < 8192) { const int s = it - 8064; smp = true; b = s >> 4; h = (s >> 1) & 7; qb = s & 1; }
        else { const int s = it - 8192; smp = false; b = s / 24; const int rem = s - b * 24; h = rem / 3; qb = rem - h * 3; }
        const size_t tbase = (size_t)(b * 8 + h) * (smp ? 34 : 129) * 4096 + lane * 8;
        const bf16_t* Kb = (smp ? p.KS : p.KP) + tbase; const bf16_t* Vb = (smp ? p.VTS : p.VTP) + tbase;
        const int qpos0 = (smp ? 1024 : 0) + 32 * qb, qrow0 = smp ? NTP + b * 64 + 32 * qb : b * TP + 32 * qb;
        const int qpos = qpos0 + q; const bool qvalid = smp || qpos < TP; const size_t qrow = qvalid ? qrow0 + q : qrow0;
        bf16x8 qf[8];
#pragma unroll
        for (int ks = 0; ks < 8; ++ks) qf[ks] = *(const bf16x8*)(p.Q + qrow * 1024 + h * 128 + 16 * ks + 8 * half);
        f32x16 o[4];
#pragma unroll
        for (int db = 0; db < 4; ++db)
#pragma unroll
            for (int e = 0; e < 16; ++e) o[db][e] = 0.f;
        float C = 1.f;
        for (int kt = (qpos0 + 30) >> 5; kt >= 0; --kt) {
            f32x16 s;
#pragma unroll
            for (int e = 0; e < 16; ++e) s[e] = 0.f;
            const bf16_t* kr = Kb + (size_t)kt * 4096; const bf16_t* vr = Vb + (size_t)kt * 4096;
            bf16x8 kf[8], vf[8];
#pragma unroll
            for (int ks = 0; ks < 8; ++ks) kf[ks] = *(const bf16x8*)(kr + ks * 512);
#pragma unroll
            for (int ks = 0; ks < 8; ++ks) vf[ks] = *(const bf16x8*)(vr + ks * 512);
#pragma unroll
            for (int ks = 0; ks < 8; ++ks) s = MFMA32(kf[ks], qf[ks], s);
            float pr[16], be[16], G[4], Gp[4];
#pragma unroll
            for (int i = 0; i < 4; ++i) {
#pragma unroll
                for (int j = 0; j < 4; ++j) { const int key = 32 * kt + 8 * i + 4 * half + j; const bool valid = key < qpos;
                    float z = s[4 * i + j] * 0.08838834764831845f; z = fminf(fmaxf(z, -80.f), 80.f);
                    const float e = __expf(z), pp = __builtin_amdgcn_rcpf(1.f + e); pr[4 * i + j] = valid ? pp : 1.f; be[4 * i + j] = valid ? e * pp : 0.f; }
                G[i] = (pr[4 * i] * pr[4 * i + 1]) * (pr[4 * i + 2] * pr[4 * i + 3]); }
#pragma unroll
            for (int i = 0; i < 4; ++i) Gp[i] = __shfl_xor(G[i], 32);
            float w[16]; float E1 = 1.f;
#pragma unroll
            for (int i = 3; i >= 0; --i) { const float Glo = half ? Gp[i] : G[i], Ghi = half ? G[i] : Gp[i];
                float suf = C * (half ? E1 : E1 * Ghi);
#pragma unroll
                for (int j = 3; j >= 0; --j) { w[4 * i + j] = be[4 * i + j] * suf; suf *= pr[4 * i + j]; }
                E1 *= Glo * Ghi; }
            C *= E1;
#pragma unroll
            for (int c = 0; c < 2; ++c) { union { bf16x8 v; unsigned u[4]; } wf;
#pragma unroll
                for (int e = 0; e < 4; ++e) wf.u[e] = pk2(w[8 * c + 2 * e], w[8 * c + 2 * e + 1]);
#pragma unroll
                for (int db = 0; db < 4; ++db) o[db] = MFMA32(vf[4 * c + db], wf.v, o[db]); }
            if (__all(C < 1e-24f)) break;
        }
        if (qvalid) {
#pragma unroll
            for (int db = 0; db < 4; ++db)
#pragma unroll
                for (int i = 0; i < 4; ++i) { u32x2 ov; ov.x = pk2(o[db][4 * i], o[db][4 * i + 1]); ov.y = pk2(o[db][4 * i + 2], o[db][4 * i + 3]);
                    *(u32x2*)(p.O + qrow * 1024 + h * 128 + 32 * db + 8 * i + 4 * half) = ov; } }
    }
}
DI void final_norm(const Prm& p, int gw, int NGW, int lane) {
    for (int r = gw; r < 32768 + 512; r += NGW) {
        int grow; float* dst;
        if (r < 32768) { const int b = r >> 12, t = r & 4095; grow = b * TP + 16 + t; dst = p.out + O_YP + (size_t)r * 1024; } else { grow = NTP + (r - 32768); dst = p.out + O_YS + (size_t)(r - 32768) * 1024; }
        const float rr = row_rinv(p.SSQ, grow);
#pragma unroll
        for (int j = 0; j < 4; ++j) { f32x4 v = ((f32x4*)dst)[lane + 64 * j]; const f32x4 g = ((const f32x4*)p.ln_final)[lane + 64 * j]; v = v * rr * g; ((f32x4*)dst)[lane + 64 * j] = v; }
    }
}

#define XB_TMO      128
#define XB_XCNT(j)  (256  + 64 * (j))
#define XB_XSUB(j)  (1280 + 64 * (j))
#define XB_XGEN(j)  (2304 + 64 * (j))
#define XB_TOP      3328
#define XB_TOPGEN   3392
#define XCD_BAR_WORDS 3456
#define XB_SPIN_CAP (1u << 18)
DI unsigned xb_ld(unsigned* p) { return __hip_atomic_load(p, __ATOMIC_RELAXED, __HIP_MEMORY_SCOPE_AGENT); }
DI unsigned xb_add(unsigned* p, unsigned v) { return __hip_atomic_fetch_add(p, v, __ATOMIC_RELAXED, __HIP_MEMORY_SCOPE_AGENT); }
DI unsigned xb_xcc_id() { return (unsigned)__builtin_amdgcn_s_getreg((3 << 11) | 20) & 0xFu; }
#define XB_SPIN(cond, bar) do { unsigned _sp = 0; while (cond) { __builtin_amdgcn_s_sleep(1); \
    if ((++_sp & 255u) == 0u) { if (xb_ld(&(bar)[XB_TMO])) break; if (_sp > XB_SPIN_CAP) { atomicAdd(&(bar)[XB_TMO], 1u); break; } } } } while (0)
struct XcdBarrier { unsigned* bar; unsigned x; volatile LAS unsigned* st; };
DI XcdBarrier xcd_barrier_post(unsigned* bar, volatile LAS unsigned* st) {
    XcdBarrier b; b.bar = bar; b.x = xb_xcc_id(); b.st = st;
    if (threadIdx.x == 0) (void)xb_add(&bar[XB_XCNT(b.x)], 1u);
    return b;
}
DI void xcd_barrier_complete(unsigned* bar, unsigned x, unsigned& nloc, unsigned& nx) {
    const unsigned G = gridDim.x * gridDim.y * gridDim.z;
    unsigned sum, cnt, mine, sp = 0u;
    for (;;) {
        sum = 0u; cnt = 0u; mine = 0u;
#pragma unroll
        for (unsigned j = 0; j < 16; ++j) { const unsigned c = xb_ld(&bar[XB_XCNT(j)]); sum += c; cnt += (c > 0u) ? 1u : 0u; mine = (j == x) ? c : mine; }
        if (sum == G) break;
        __builtin_amdgcn_s_sleep(1);
        if ((++sp & 255u) == 0u) { if (xb_ld(&bar[XB_TMO])) break; if (sp > XB_SPIN_CAP) { atomicAdd(&bar[XB_TMO], 1u); break; } }
    }
    nloc = mine > 0u ? mine : 1u; nx = cnt > 0u ? cnt : 1u;
}
DI void xcd_barrier(const XcdBarrier& b) {
    asm volatile("s_waitcnt vmcnt(0)" ::: "memory");
    __syncthreads();
    if (threadIdx.x == 0) {
        unsigned* bar = b.bar;
        __builtin_amdgcn_s_waitcnt(0);
        unsigned nloc = b.st[0], nx = b.st[1];
        if (nloc == 0u) { xcd_barrier_complete(bar, b.x, nloc, nx); b.st[0] = nloc; b.st[1] = nx; }
        const unsigned old = xb_add(&bar[XB_XSUB(b.x)], 1u);
        const unsigned gen = old / nloc;
        if (old + 1u == (gen + 1u) * nloc) {
            __builtin_amdgcn_fence(__ATOMIC_RELEASE, "agent");
            asm volatile("s_waitcnt vmcnt(0)" ::: "memory");
            const unsigned og = xb_add(&bar[XB_TOP], 1u);
            const unsigned tg = og / nx;
            if (og + 1u == (tg + 1u) * nx) xb_add(&bar[XB_TOPGEN], 1u);
            else XB_SPIN(xb_ld(&bar[XB_TOPGEN]) == tg, bar);
            __builtin_amdgcn_fence(__ATOMIC_ACQUIRE, "agent");
            xb_add(&bar[XB_XGEN(b.x)], 1u);
            asm volatile("s_waitcnt vmcnt(0)" ::: "memory");
        } else {
            XB_SPIN(xb_ld(&bar[XB_XGEN(b.x)]) == gen, bar);
            __builtin_amdgcn_fence(__ATOMIC_ACQUIRE, "agent");
            asm volatile("s_waitcnt vmcnt(0)" ::: "memory");
        }
    }
    __syncthreads();
}
constexpr int LDS_BYTES = 131072 + 256;
__global__ void __launch_bounds__(512, 2) fwd_megakernel(Prm p) {
    extern __shared__ __attribute__((aligned(16))) unsigned char shm[];
    LAS unsigned char* lds = (LAS unsigned char*)shm;
    cg::grid_group grid = cg::this_grid();
    const int tid = threadIdx.x, lane = tid & 63, wave = __builtin_amdgcn_readfirstlane(tid >> 6);
    const int gw = blockIdx.x * 8 + wave, NGW = gridDim.x * 8, gtid = blockIdx.x * 512 + tid, GT = gridDim.x * 512;
    volatile LAS unsigned* xst = (volatile LAS unsigned*)(lds + 131072);
    if (tid == 0) { xst[0] = 0u; xst[1] = 0u; }
    __syncthreads();
    const XcdBarrier xb = xcd_barrier_post(p.BAR, xst);
    phase_prologue(p, lds, tid, lane, wave);
    grid.sync();
    { EpiIn0 E; E.SSQ = p.SSQ; E.RINV = p.RINV; E.LB = p.LB; E.Qh = p.Qh; E.IV = p.IV; E.GS = p.GS; E.U = p.U; E.LOGF = p.LOGF; run_gemm(lds, p.XB, p.Wt1, 2560, 1024, E); }
    xcd_barrier(xb);
    hgrn_b1_all(p, lds, tid, lane, wave);
    s5_b_lds(p, lds, tid, lane, wave);
    xcd_barrier(xb);
    hgrn_b2(p, gtid, GT);
    s5_c(p, gtid);
    xcd_barrier(xb);
    hgrn_b3_all(p, lds, tid, lane, wave);
    s5_d_lds(p, lds, tid, lane, wave);
    xcd_barrier(xb);
    { EpiGlu E; E.YG = p.YG; E.CAT = p.CAT; run_gemm(lds, p.YG, p.Wglu, 512, 512, E); }
    xcd_barrier(xb);
    { EpiRes E; E.XB = p.XB; E.SSQ = p.SSQ; run_gemm_split(lds, p.CAT, p.Wo0, 1024, 1024, E, (float*)p.H); xcd_barrier(xb); gemm_fixup(1024, 1024, E, (const float*)p.H, tid); rinv_pass(p, 1024, tid); }
    xcd_barrier(xb);
    { EpiUp E; E.SSQ = p.SSQ; E.RINV = p.RINV; E.H = p.H; run_gemm(lds, p.XB, p.Wup0, 4096, 1024, E); }
    xcd_barrier(xb);
    { EpiRes E; E.XB = p.XB; E.SSQ = p.SSQ; run_gemm_split(lds, p.H, p.Wdn0, 1024, 4096, E, (float*)p.CAT); xcd_barrier(xb); gemm_fixup(1024, 4096, E, (const float*)p.CAT, tid); rinv_pass(p, 4096, tid); }
    xcd_barrier(xb);
    { EpiQkv E; E.SSQ = p.SSQ; E.RINV = p.RINV; E.out = p.out; E.Q = p.Q; E.KP = p.KP; E.KS = p.KS; E.VTP = p.VTP; E.VTS = p.VTS; run_gemm(lds, p.XB, p.Wqkv, 3072, 1024, E); }
    if (gridDim.x > 36) { if (blockIdx.x >= 36) cache_convert(p, (blockIdx.x - 36) * 512 + tid, (gridDim.x - 36) * 512); } else cache_convert(p, gtid, GT);
    xcd_barrier(xb);
    attn_phase(p, gw, NGW, lane);
    xcd_barrier(xb);
    { EpiRes E; E.XB = p.XB; E.SSQ = p.SSQ; run_gemm_split(lds, p.O, p.Wo1, 1024, 1024, E, (float*)p.H); xcd_barrier(xb); gemm_fixup(1024, 1024, E, (const float*)p.H, tid); rinv_pass(p, 1024, tid); }
    xcd_barrier(xb);
    { EpiUp E; E.SSQ = p.SSQ; E.RINV = p.RINV; E.H = p.H; run_gemm(lds, p.XB, p.Wup1, 4096, 1024, E); }
    xcd_barrier(xb);
    { EpiFin E; E.XB = p.XB; E.SSQ = p.SSQ; E.out = p.out; run_gemm_split(lds, p.H, p.Wdn1, 1024, 4096, E, (float*)p.CAT); xcd_barrier(xb); gemm_fixup(1024, 4096, E, (const float*)p.CAT, tid); }
    xcd_barrier(xb);
    final_norm(p, gw, NGW, lane);
}

extern "C" void kernel_launch(void* const* d_in, const int* in_sizes, int n_in, void* d_out, int out_size, void* d_ws, size_t ws_size, hipStream_t stream) {
    static int grid_blocks = 0;
    if (grid_blocks == 0) {
        int dev = 0, cus = 0, per_cu = 0;
        hipGetDevice(&dev); hipDeviceGetAttribute(&cus, hipDeviceAttributeMultiprocessorCount, dev);
        if (hipFuncSetAttribute((const void*)fwd_megakernel, hipFuncAttributeMaxDynamicSharedMemorySize, LDS_BYTES) != hipSuccess) fprintf(stderr, "kernel_launch: hipFuncSetAttribute failed\n");
        if (hipOccupancyMaxActiveBlocksPerMultiprocessor(&per_cu, (const void*)fwd_megakernel, 512, LDS_BYTES) != hipSuccess || per_cu < 1) { fprintf(stderr, "kernel_launch: occupancy query says %d\n", per_cu); per_cu = 1; }
        (void)hipGetLastError();
        grid_blocks = cus > 0 ? cus : 256;
    }
    Prm p{};
    const float* const* in = (const float* const*)d_in;
    p.x_prompt = in[0]; p.x_sample = in[1]; p.state_hgrn = in[2]; p.ssm_re0 = in[3]; p.ssm_im0 = in[4]; p.cache_k = in[5]; p.cache_v = in[6]; p.meta = in[7]; p.ln_mix = in[8]; p.ln_mlp = in[9];
    p.ln_final = in[10]; p.w_in_even = in[11]; p.hgrn_lb = in[12]; p.hgrn_norm = in[13]; p.a_re = in[14]; p.a_im = in[15]; p.log_dt = in[16]; p.b_re = in[17]; p.b_im = in[18]; p.c_re = in[19];
    p.c_im = in[20]; p.ssm_d = in[21]; p.w_glu = in[22]; p.w_out_even = in[23]; p.w_in_odd = in[24]; p.w_out_odd = in[25]; p.w_up = in[26]; p.w_down = in[27];
    p.out = (float*)d_out;
    unsigned char* ws = (unsigned char*)d_ws; size_t off = 0;
    auto take = [&](size_t bytes) { unsigned char* r = ws + off; off += (bytes + 255) & ~(size_t)255; return r; };
    p.Wt1 = (bf16_t*)take((size_t)2560 * 1024 * 2); p.Wglu = (bf16_t*)take((size_t)512 * 512 * 2); p.Wo0 = (bf16_t*)take((size_t)1024 * 1024 * 2); p.Wup0 = (bf16_t*)take((size_t)4096 * 1024 * 2);
    p.Wdn0 = (bf16_t*)take((size_t)4096 * 1024 * 2); p.Wqkv = (bf16_t*)take((size_t)3072 * 1024 * 2); p.Wo1 = (bf16_t*)take((size_t)1024 * 1024 * 2); p.Wup1 = (bf16_t*)take((size_t)4096 * 1024 * 2);
    p.Wdn1 = (bf16_t*)take((size_t)4096 * 1024 * 2);
    p.XB = (bf16_t*)take((size_t)MP * 1024 * 2); p.SSQ = (float*)take((size_t)MP * 16 * 4); p.RINV = (float*)take((size_t)MP * 4); p.LB = (float*)take(2048); p.KTAB = (float*)take((size_t)32 * 16 * 256 * 4);
    p.TG = (bf16_t*)take((size_t)32 * 256 * 384 * 2); p.HT = (bf16_t*)take((size_t)32 * 128 * 256 * 2); p.A16 = (float*)take(32 * 64 * 2 * 4); p.BAR = (unsigned*)take(XCD_BAR_WORDS * 4);
    const size_t S0 = off; constexpr size_t SZ512 = (size_t)MP * 512 * 2;
    p.Qh = (bf16_t*)take(SZ512); p.LOGF = (unsigned short*)take(SZ512); p.IV = (bf16_t*)take(SZ512); p.GS = (bf16_t*)take(SZ512); p.U = (bf16_t*)take(SZ512);
    p.UT = (bf16_t*)take((size_t)NITEM_H * 16384 * 2); p.AL = (float*)take((size_t)NITEM_H * 128 * 4);
    p.XLOC = (float*)take(SZ512); p.YG = (bf16_t*)p.XLOC;
    p.XPREV = (bf16_t*)take((size_t)NCOL * 4096 * 2); p.CAT = (bf16_t*)take((size_t)MP * 1024 * 2);
    size_t end = off;
    off = S0; p.H = (bf16_t*)take((size_t)MP * 4096 * 2); if (off > end) end = off;
    off = S0; p.Q = (bf16_t*)take((size_t)MP * 1024 * 2); p.KP = (bf16_t*)take((size_t)64 * 129 * 4096 * 2); p.KS = (bf16_t*)take((size_t)64 * 34 * 4096 * 2);
    p.VTP = (bf16_t*)take((size_t)64 * 129 * 4096 * 2); p.VTS = (bf16_t*)take((size_t)64 * 34 * 4096 * 2); p.O = (bf16_t*)take((size_t)MP * 1024 * 2); if (off > end) end = off;
    if (end > ws_size || n_in != 28 || (size_t)out_size != O_END) { fprintf(stderr, "kernel_launch: workspace/shape mismatch: need %zu have %zu, n_in %d, out %d\n", end, ws_size, n_in, out_size); return; }
    (void)hipMemsetAsync(p.BAR, 0, XCD_BAR_WORDS * 4, stream);
    void* args[] = {&p};
    hipError_t e = hipLaunchCooperativeKernel((const void*)fwd_megakernel, dim3(grid_blocks), dim3(512), args, LDS_BYTES, stream);
    if (e != hipSuccess) fprintf(stderr, "cooperative launch failed: %s (grid %d)\n", hipGetErrorString(e), grid_blocks);
}
```

```cpp
#include <hip/hip_runtime.h>
#include <hip/hip_cooperative_groups.h>
#include <cstdio>
#include <cstdint>
namespace cg = cooperative_groups;
namespace pg8 {
#define PG8_LAS __attribute__((address_space(3)))
typedef unsigned short bf16_t;
typedef short bf16x8 __attribute__((ext_vector_type(8)));
typedef float f32x4 __attribute__((ext_vector_type(4)));
typedef unsigned u32x4 __attribute__((ext_vector_type(4)));
constexpr int BM = 256, BK = 64, HALF = 128, HTB = HALF * BK * 2  , STAGE_BYTES = 8 * HTB, NXCD = 8, WGM = 8;

__host__ __device__ __forceinline__ int lds_byte(int r, int c) { const int st = (r >> 4) * 2 + (c >> 5), rr = r & 15, cc = c & 31, ob = rr * 64 + cc * 2; return st * 1024 + (ob ^ (((ob >> 9) & 1) << 5)); }
__host__ __device__ __forceinline__ void stage_rc(int b, int& R, int& C) { const int st = b / 1024, sb = b % 1024, swz = sb ^ (((sb >> 9) & 1) << 5); R = (st >> 1) * 16 + swz / 64; C = (st & 1) * 32 + (swz % 64) / 2; }
__host__ __device__ __forceinline__ int perm32(int rho) { const int n = rho >> 4, i = rho & 15; return 8 * (i >> 2) + 4 * n + (i & 3); }

struct Unit { int pm, pn, kb, nk, part; };
struct Gemm { const bf16_t* A; const bf16_t* Bt; int M, N, K; float* part; };

struct StaticOrder {
    int nM, nN, nwg, G, c;
    __host__ __device__ void init(int M, int N, int G_, int c_) { nM = M / BM; nN = N / BM; nwg = nM * nN; G = G_; c = c_; }
    __host__ __device__ void map(int L, Unit& u) const {
        int wgid = L; { const int q = nwg / NXCD, r = nwg % NXCD, xcd = wgid % NXCD, off = wgid / NXCD; wgid = (xcd < r ? xcd * (q + 1) : r * (q + 1) + (xcd - r) * q) + off; }
        const int nig = WGM * nN, gid = wgid / nig, fm = gid * WGM, gsz = (nM - fm) < WGM ? (nM - fm) : WGM;
        u.pm = fm + ((wgid % nig) % gsz); u.pn = (wgid % nig) / gsz; u.kb = 0; u.nk = 0; u.part = -1;
    }
    __host__ __device__ bool next(int i, Unit& u) const {
        const long L = (long)i * G + c; if (L >= nwg) return false;
        map((int)L, u); return true;
    }
    __device__ __forceinline__ void a_ready(const Unit&) const {}
    __device__ __forceinline__ void done(const Unit&) const {}
};
template <class Epi, class Sched>
__device__ __forceinline__ void gemm_phase(PG8_LAS unsigned char* lds, const Gemm g, const Sched& S, const Epi& E) {
    int tid_ = threadIdx.x; asm volatile("" : "+v"(tid_));
    const int tid = tid_, wid = __builtin_amdgcn_readfirstlane(tid >> 6), lane = tid & 63, wr = wid >> 2, wc = wid & 3, fr = lane & 15, fq = lane >> 4;
    const int K = g.K, nt = K / BK;
    unsigned voffA[2], voffB[2];
#pragma unroll
    for (int i = 0; i < 2; ++i) { int R, C; stage_rc(tid * 16 + i * 8192, R, C); const int Rb = Epi::PERM ? ((R & ~31) + perm32(R & 31)) : R;
        voffA[i] = (unsigned)(R * K + C) * 2u; voffB[i] = (unsigned)(Rb * K + C) * 2u; }
    const size_t kstep = (size_t)(BK * 2);
    const size_t hstep = (size_t)HALF * K * 2;
    const size_t tstep = 2 * hstep;
    const unsigned ldsw = (unsigned)wid * 1024u;
    const int aoff = lds_byte(wr * 64 + fr, fq * 8), boff = lds_byte(wc * 32 + fr, fq * 8);
#define PG8_SA(b, h) (((b) * 2 + (h)) * HTB)
#define PG8_SB(b, h) ((4 + (b) * 2 + (h)) * HTB)
#define PG8_STAGE(bufoff, gbase, voff) do { _Pragma("unroll") for (int _i = 0; _i < 2; ++_i) \
        __builtin_amdgcn_global_load_lds((const unsigned*)((const char*)(gbase) + (voff)[_i]), (PG8_LAS unsigned*)(lds + (bufoff) + ldsw + _i * 8192), 16, 0, 0); } while (0)
#define PG8_LDA(dst, b, h) do { _Pragma("unroll") for (int m = 0; m < 4; ++m) _Pragma("unroll") for (int k = 0; k < 2; ++k) dst[m][k] = *(const PG8_LAS bf16x8*)(lds + PG8_SA(b, h) + aoff + m * 2048 + k * 1024); } while (0)
#define PG8_LDB(dst, b, h) do { _Pragma("unroll") for (int n = 0; n < 2; ++n) _Pragma("unroll") for (int k = 0; k < 2; ++k) dst[n][k] = *(const PG8_LAS bf16x8*)(lds + PG8_SB(b, h) + boff + n * 2048 + k * 1024); } while (0)
#define PG8_MMA(ai, bj, At, Bt) do { __builtin_amdgcn_s_setprio(1); _Pragma("unroll") for (int m = 0; m < 4; ++m) _Pragma("unroll") for (int n = 0; n < 2; ++n) _Pragma("unroll") for (int k = 0; k < 2; ++k) \
        acc[ai][bj][m][n] = __builtin_amdgcn_mfma_f32_16x16x32_bf16(Bt[n][k], At[m][k], acc[ai][bj][m][n], 0, 0, 0); __builtin_amdgcn_s_setprio(0); } while (0)
#define PG8_WAIT_V(n) asm volatile("s_waitcnt vmcnt(" #n ")" ::: "memory")
#define PG8_WAIT_L(n) asm volatile("s_waitcnt lgkmcnt(" #n ")" ::: "memory")
#define PG8_BAR __builtin_amdgcn_s_barrier()
#define PG8_SCHED __builtin_amdgcn_sched_barrier(0)
    Unit cur, nxt; int ui = 0; typename Epi::Pre pre;
    if (!S.next(0, cur)) return;
    f32x4 acc[2][2][4][2];
#pragma unroll
    for (int a = 0; a < 2; ++a)
#pragma unroll
        for (int b = 0; b < 2; ++b)
#pragma unroll
            for (int m = 0; m < 4; ++m)
#pragma unroll
                for (int n = 0; n < 2; ++n) acc[a][b][m][n] = (f32x4){0.f, 0.f, 0.f, 0.f};
    bf16x8 At[4][2], B0[2][2], B1[2][2];
    const char* cA = (const char*)g.A + (size_t)cur.pm * tstep + (size_t)cur.kb * kstep; const char* cB = (const char*)g.Bt + (size_t)cur.pn * tstep + (size_t)cur.kb * kstep;
    S.a_ready(cur);
    PG8_STAGE(PG8_SB(0, 0), cB, voffB); PG8_STAGE(PG8_SA(0, 0), cA, voffA); PG8_STAGE(PG8_SB(0, 1), cB + hstep, voffB); PG8_STAGE(PG8_SA(0, 1), cA + hstep, voffA);
    if (wr == 1) PG8_BAR;
    PG8_WAIT_V(4); PG8_BAR;
    PG8_STAGE(PG8_SB(1, 0), cB + kstep, voffB); PG8_STAGE(PG8_SA(1, 0), cA + kstep, voffA); PG8_STAGE(PG8_SB(1, 1), cB + hstep + kstep, voffB);
    PG8_WAIT_V(6); PG8_BAR;
    for (;;) {
        const bool has_next = S.next(ui + 1, nxt);
        const char* nA = has_next ? (const char*)g.A + (size_t)nxt.pm * tstep + (size_t)nxt.kb * kstep : cA; const char* nB = has_next ? (const char*)g.Bt + (size_t)nxt.pn * tstep + (size_t)nxt.kb * kstep : cB;
        const int cnk = cur.nk ? cur.nk : nt;
        for (int t = 0; t < cnk; t += 2) {
            const bool last = (t == cnk - 2);
            const char* a1 = cA + (size_t)(t + 1) * kstep;
            const char* a2 = last ? nA : cA + (size_t)(t + 2) * kstep; const char* b2 = last ? nB : cB + (size_t)(t + 2) * kstep;
            const char* a3 = a2 + kstep; const char* b3 = b2 + kstep;
            if (last && has_next) S.a_ready(nxt);
            if (last) E.prefetch(pre, cur, wr, fr);
            PG8_LDB(B0, 0, 0); PG8_SCHED; PG8_LDA(At, 0, 0); PG8_STAGE(PG8_SA(1, 1), a1 + hstep, voffA);
            PG8_WAIT_L(8); PG8_BAR; PG8_WAIT_L(0); PG8_MMA(0, 0, At, B0); PG8_BAR; PG8_SCHED;
            PG8_LDB(B1, 0, 1); PG8_STAGE(PG8_SB(0, 0), b2, voffB);
            PG8_BAR; PG8_WAIT_L(0); PG8_MMA(0, 1, At, B1); PG8_BAR;
            PG8_LDA(At, 0, 1); PG8_STAGE(PG8_SA(0, 0), a2, voffA);
            PG8_BAR; PG8_WAIT_L(0); PG8_MMA(1, 0, At, B0); PG8_BAR; PG8_SCHED;
            PG8_STAGE(PG8_SB(0, 1), b2 + hstep, voffB);
            PG8_WAIT_V(6); PG8_BAR; PG8_MMA(1, 1, At, B1); PG8_BAR;
            PG8_LDB(B0, 1, 0); PG8_SCHED; PG8_LDA(At, 1, 0); PG8_STAGE(PG8_SA(0, 1), a2 + hstep, voffA);
            PG8_WAIT_L(8); PG8_BAR; PG8_WAIT_L(0); PG8_MMA(0, 0, At, B0); PG8_BAR; PG8_SCHED;
            PG8_LDB(B1, 1, 1); PG8_STAGE(PG8_SB(1, 0), b3, voffB);
            PG8_BAR; PG8_WAIT_L(0); PG8_MMA(0, 1, At, B1); PG8_BAR;
            PG8_LDA(At, 1, 1); PG8_STAGE(PG8_SA(1, 0), a3, voffA);
            PG8_BAR; PG8_WAIT_L(0); PG8_MMA(1, 0, At, B0); PG8_BAR; PG8_SCHED;
            PG8_STAGE(PG8_SB(1, 1), b3 + hstep, voffB);
            PG8_WAIT_V(6); PG8_BAR; PG8_MMA(1, 1, At, B1); PG8_BAR;
        }
        if constexpr (!Epi::AFTER_DRAIN) {
            if (cur.part < 0) E(acc, cur, wr, wc, fr, fq, pre);
            else { f32x4* pp = (f32x4*)g.part + (size_t)cur.part * 32 * 512 + tid;
#pragma unroll
                for (int a = 0; a < 2; ++a)
#pragma unroll
                    for (int b = 0; b < 2; ++b)
#pragma unroll
                        for (int m = 0; m < 4; ++m)
#pragma unroll
                            for (int n = 0; n < 2; ++n) pp[(size_t)(((a * 2 + b) * 4 + m) * 2 + n) * 512] = acc[a][b][m][n]; }
            S.done(cur); }
        if (!has_next) break;
#pragma unroll
        for (int a = 0; a < 2; ++a)
#pragma unroll
            for (int b = 0; b < 2; ++b)
#pragma unroll
                for (int m = 0; m < 4; ++m)
#pragma unroll
                    for (int n = 0; n < 2; ++n) acc[a][b][m][n] = (f32x4){0.f, 0.f, 0.f, 0.f};
        cur = nxt; cA = nA; cB = nB; ++ui;
    }
    PG8_WAIT_V(0);
    if (wr == 0) PG8_BAR;
    PG8_BAR;
    if constexpr (Epi::AFTER_DRAIN) { E.fused(acc, cur, wr, wc, fr, fq, lds, wid, lane); S.done(cur); }
#undef PG8_SA
#undef PG8_SB
#undef PG8_STAGE
#undef PG8_LDA
#undef PG8_LDB
#undef PG8_MMA
#undef PG8_WAIT_V
#undef PG8_WAIT_L
#undef PG8_BAR
#undef PG8_SCHED
}
}
using pg8::bf16_t; using pg8::bf16x8; using pg8::f32x4; using pg8::Unit;
typedef float f32x16 __attribute__((ext_vector_type(16)));
typedef float f32x2v __attribute__((ext_vector_type(2)));
typedef unsigned u32x2 __attribute__((ext_vector_type(2)));
typedef unsigned u32x4v __attribute__((ext_vector_type(4)));
#define LAS __attribute__((address_space(3)))
#define DI __device__ __forceinline__

constexpr int DM = 1024, TP = 4112, NTP = 8 * TP  , NTS = 512, NT = NTP + NTS  , MP = 33536  ;
constexpr int NITEM_H = 2112;
constexpr int NCOL = NT / 16;
constexpr float EPSN = 1e-6f;
constexpr size_t O_YP = 0, O_YS = O_YP + (size_t)8 * 4096 * 1024, O_HGP = O_YS + 524288, O_HGS = O_HGP + 524288, O_SRP = O_HGS + 524288, O_SIP = O_SRP + 16384,
                 O_SRS = O_SIP + 16384, O_SIS = O_SRS + 16384, O_KP = O_SIS + 16384, O_VP = O_KP + (size_t)NTP * 1024, O_KS = O_VP + (size_t)NTP * 1024, O_VS = O_KS + 524288, O_END = O_VS + 524288;

struct Prm {
    const float *x_prompt, *x_sample, *state_hgrn, *ssm_re0, *ssm_im0, *cache_k, *cache_v, *meta, *ln_mix, *ln_mlp, *ln_final, *w_in_even, *hgrn_lb, *hgrn_norm,
        *a_re, *a_im, *log_dt, *b_re, *b_im, *c_re, *c_im, *ssm_d, *w_glu, *w_out_even, *w_in_odd, *w_out_odd, *w_up, *w_down;
    float* out;
    bf16_t *Wt1, *Wglu, *Wo0, *Wup0, *Wdn0, *Wqkv, *Wo1, *Wup1, *Wdn1;
    bf16_t* XB; float* SSQ; float* RINV; float* LB; float* KTAB; bf16_t* TG; bf16_t* HT; float* A16;
    bf16_t *Qh, *IV, *GS, *U; unsigned short* LOGF; bf16_t* UT; float* AL; float* XLOC; bf16_t* XPREV; bf16_t* YG; bf16_t* CAT;
    bf16_t* H;
    bf16_t *Q, *KP, *KS, *VTP, *VTS, *O; unsigned* BAR;
};

DI unsigned pk2(float lo, float hi) { unsigned r; asm volatile("v_cvt_pk_bf16_f32 %0, %1, %2" : "=v"(r) : "v"(lo), "v"(hi)); return r; }
DI float bflo(unsigned u) { return __uint_as_float(u << 16); }
DI float bfhi(unsigned u) { return __uint_as_float(u & 0xffff0000u); }
DI float bf2f(unsigned short b) { return __uint_as_float(((unsigned)b) << 16); }
DI unsigned short f2bf(float f) { return (unsigned short)(pk2(f, 0.f) & 0xffffu); }
DI unsigned pkh2(float lo, float hi) { union { _Float16 h[2]; unsigned u; } x; x.h[0] = (_Float16)lo; x.h[1] = (_Float16)hi; return x.u; }
DI float h2f(unsigned short h) { union { unsigned short s; _Float16 h; } x; x.s = h; return (float)x.h; }
DI float wave_sum(float v) {
#pragma unroll
    for (int o = 1; o < 64; o <<= 1) v += __shfl_xor(v, o);
    return v;
}
DI float fexp(float x) { return __expf(x); }
DI float sigm(float x) { return __builtin_amdgcn_rcpf(1.f + __expf(-x)); }
DI float row_rinv(const float* SSQ, int row) {
    const f32x4* s = (const f32x4*)(SSQ + (size_t)row * 16); f32x4 a = s[0] + s[1] + s[2] + s[3];
    return rsqrtf(((a.x + a.y) + (a.z + a.w)) * (1.f / 1024.f) + EPSN);
}
DI void rinv8(const float* SSQ, int row0, int fq, float (&r)[2][4]) {
    f32x4 v[2][4];
#pragma unroll
    for (int ai = 0; ai < 2; ++ai)
#pragma unroll
        for (int m = 0; m < 4; ++m) v[ai][m] = *(const f32x4*)(SSQ + (size_t)(row0 + ai * 128 + m * 16) * 16 + 4 * fq);
#pragma unroll
    for (int ai = 0; ai < 2; ++ai)
#pragma unroll
        for (int m = 0; m < 4; ++m) { float s = (v[ai][m].x + v[ai][m].y) + (v[ai][m].z + v[ai][m].w); s += __shfl_xor(s, 16); s += __shfl_xor(s, 32); r[ai][m] = rsqrtf(s * (1.f / 1024.f) + EPSN); }
}
#define LDS_WAIT() asm volatile("s_waitcnt lgkmcnt(0)" ::: "memory")

struct EpiIn0 {
    struct Pre { float r[2][4]; };
    DI void prefetch(Pre& pre, const Unit& u, int wr, int fr) const { const int row0 = u.pm * 256 + wr * 64 + fr;
#pragma unroll
        for (int ai = 0; ai < 2; ++ai)
#pragma unroll
            for (int m = 0; m < 4; ++m) pre.r[ai][m] = RINV[row0 + ai * 128 + m * 16]; }
    DI void scales(const Pre& pre, int row0, int fq, float (&rs)[2][4]) const {
        if (pre.r[0][0] > 0.f) {
#pragma unroll
            for (int ai = 0; ai < 2; ++ai)
#pragma unroll
                for (int m = 0; m < 4; ++m) rs[ai][m] = pre.r[ai][m]; }
        else rinv8(SSQ, row0, fq, rs);
    }
    static constexpr bool PERM = false, AFTER_DRAIN = false;
    const float* SSQ; const float* RINV; const float* LB; bf16_t *Qh, *IV, *GS, *U; unsigned short* LOGF;
    DI void operator()(const f32x4 (&acc)[2][2][4][2], const Unit& u, int wr, int wc, int fr, int fq, const Pre& pre) const {
        const int seg = u.pn >> 1, cb = (u.pn & 1) * 256 + wc * 32 + 4 * fq, row0 = u.pm * 256 + wr * 64 + fr;
        unsigned short* dst = seg == 0 ? Qh : seg == 1 ? LOGF : seg == 2 ? IV : seg == 3 ? GS : U;
        float rs[2][4]; scales(pre, row0, fq, rs);
        f32x4 lbv[2][2];
#pragma unroll
        for (int bj = 0; bj < 2; ++bj)
#pragma unroll
            for (int n = 0; n < 2; ++n) lbv[bj][n] = *(const f32x4*)(LB + cb + bj * 128 + n * 16);
#pragma unroll
        for (int ai = 0; ai < 2; ++ai)
#pragma unroll
            for (int m = 0; m < 4; ++m) { const int row = row0 + ai * 128 + m * 16; const float r = rs[ai][m];
#pragma unroll
                for (int bj = 0; bj < 2; ++bj)
#pragma unroll
                    for (int n = 0; n < 2; ++n) { const int cs = cb + bj * 128 + n * 16; f32x4 v = acc[ai][bj][m][n] * r; u32x2 o;
                        if (seg == 1) { const f32x4 lb = lbv[bj][n]; f32x4 f;
#pragma unroll
                            for (int e = 0; e < 4; ++e) f[e] = __logf(lb[e] + (1.f - lb[e]) * sigm(v[e]));
                            o.x = pkh2(f[0], f[1]); o.y = pkh2(f[2], f[3]); }
                        else { if (seg == 3) {
#pragma unroll
                                for (int e = 0; e < 4; ++e) v[e] = v[e] * sigm(v[e]); }
                            o.x = pk2(v[0], v[1]); o.y = pk2(v[2], v[3]); }
                        *(u32x2*)(dst + (size_t)row * 512 + cs) = o; } }
    }
};
struct EpiGlu {
    struct Pre {}; DI void prefetch(Pre&, const Unit&, int, int) const {}
    static constexpr bool PERM = false, AFTER_DRAIN = false;
    const bf16_t* YG; bf16_t* CAT;
    DI void operator()(const f32x4 (&acc)[2][2][4][2], const Unit& u, int wr, int wc, int fr, int fq, const Pre& pre) const {
        const int cb = u.pn * 256 + wc * 32 + 4 * fq, row0 = u.pm * 256 + wr * 64 + fr;
#pragma unroll
        for (int ai = 0; ai < 2; ++ai) {
            u32x2 y[4][2][2];
#pragma unroll
            for (int m = 0; m < 4; ++m)
#pragma unroll
                for (int bj = 0; bj < 2; ++bj)
#pragma unroll
                    for (int n = 0; n < 2; ++n) y[m][bj][n] = *(const u32x2*)(YG + (size_t)(row0 + ai * 128 + m * 16) * 512 + cb + bj * 128 + n * 16);
#pragma unroll
            for (int m = 0; m < 4; ++m) { const int row = row0 + ai * 128 + m * 16;
#pragma unroll
                for (int bj = 0; bj < 2; ++bj)
#pragma unroll
                    for (int n = 0; n < 2; ++n) { const int cs = cb + bj * 128 + n * 16; const f32x4 v = acc[ai][bj][m][n]; const u32x2 yy = y[m][bj][n]; u32x2 o;
                        o.x = pk2(bflo(yy.x) * sigm(v[0]), bfhi(yy.x) * sigm(v[1])); o.y = pk2(bflo(yy.y) * sigm(v[2]), bfhi(yy.y) * sigm(v[3]));
                        *(u32x2*)(CAT + (size_t)row * 1024 + 512 + cs) = o; } } }
    }
};
struct EpiRes {
    struct Pre {}; DI void prefetch(Pre&, const Unit&, int, int) const {}
    static constexpr bool PERM = false, AFTER_DRAIN = false;
    bf16_t* XB; float* SSQ;
    DI void row(const f32x4 (&a4)[2][2], const Unit& u, int ai, int m, int wr, int wc, int fr, int fq) const {
        const int cb = u.pn * 256 + wc * 32 + 4 * fq, row = u.pm * 256 + wr * 64 + fr + ai * 128 + m * 16; float ss = 0.f;
#pragma unroll
        for (int bj = 0; bj < 2; ++bj)
#pragma unroll
            for (int n = 0; n < 2; ++n) { const int cs = cb + bj * 128 + n * 16; const f32x4 v = a4[bj][n];
                u32x2* px = (u32x2*)(XB + (size_t)row * 1024 + cs); const u32x2 x = *px; u32x2 o;
                o.x = pk2(bflo(x.x) + v[0], bfhi(x.x) + v[1]); o.y = pk2(bflo(x.y) + v[2], bfhi(x.y) + v[3]); *px = o;
                const float a0 = bflo(o.x), a1 = bfhi(o.x), a2 = bflo(o.y), a3 = bfhi(o.y); ss += (a0 * a0 + a1 * a1) + (a2 * a2 + a3 * a3); }
        ss += __shfl_xor(ss, 16); ss += __shfl_xor(ss, 32);
        if (fq == 0) SSQ[(size_t)row * 16 + u.pn * 4 + wc] = ss;
    }
    DI void operator()(const f32x4 (&acc)[2][2][4][2], const Unit& u, int wr, int wc, int fr, int fq, const Pre& pre) const {
        const int cb = u.pn * 256 + wc * 32 + 4 * fq, row0 = u.pm * 256 + wr * 64 + fr;
#pragma unroll
        for (int ai = 0; ai < 2; ++ai) {
            u32x2 x[4][2][2];
#pragma unroll
            for (int m = 0; m < 4; ++m)
#pragma unroll
                for (int bj = 0; bj < 2; ++bj)
#pragma unroll
                    for (int n = 0; n < 2; ++n) x[m][bj][n] = *(const u32x2*)(XB + (size_t)(row0 + ai * 128 + m * 16) * 1024 + cb + bj * 128 + n * 16);
#pragma unroll
            for (int m = 0; m < 4; ++m) { const int row = row0 + ai * 128 + m * 16; float ss = 0.f;
#pragma unroll
                for (int bj = 0; bj < 2; ++bj)
#pragma unroll
                    for (int n = 0; n < 2; ++n) { const int cs = cb + bj * 128 + n * 16; const f32x4 v = acc[ai][bj][m][n]; const u32x2 xx = x[m][bj][n]; u32x2 o;
                        o.x = pk2(bflo(xx.x) + v[0], bfhi(xx.x) + v[1]); o.y = pk2(bflo(xx.y) + v[2], bfhi(xx.y) + v[3]); *(u32x2*)(XB + (size_t)row * 1024 + cs) = o;
                        const float a0 = bflo(o.x), a1 = bfhi(o.x), a2 = bflo(o.y), a3 = bfhi(o.y); ss += (a0 * a0 + a1 * a1) + (a2 * a2 + a3 * a3); }
                ss += __shfl_xor(ss, 16); ss += __shfl_xor(ss, 32);
                if (fq == 0) SSQ[(size_t)row * 16 + u.pn * 4 + wc] = ss; } }
    }
};
struct EpiUp {
    struct Pre { float r[2][4]; };
    DI void prefetch(Pre& pre, const Unit& u, int wr, int fr) const { const int row0 = u.pm * 256 + wr * 64 + fr;
#pragma unroll
        for (int ai = 0; ai < 2; ++ai)
#pragma unroll
            for (int m = 0; m < 4; ++m) pre.r[ai][m] = RINV[row0 + ai * 128 + m * 16]; }
    DI void scales(const Pre& pre, int row0, int fq, float (&rs)[2][4]) const {
        if (pre.r[0][0] > 0.f) {
#pragma unroll
            for (int ai = 0; ai < 2; ++ai)
#pragma unroll
                for (int m = 0; m < 4; ++m) rs[ai][m] = pre.r[ai][m]; }
        else rinv8(SSQ, row0, fq, rs);
    }
    static constexpr bool PERM = false, AFTER_DRAIN = false;
    const float* SSQ; const float* RINV; bf16_t* H;
    DI void operator()(const f32x4 (&acc)[2][2][4][2], const Unit& u, int wr, int wc, int fr, int fq, const Pre& pre) const {
        const int cb = u.pn * 256 + wc * 32 + 4 * fq, row0 = u.pm * 256 + wr * 64 + fr;
        float rs[2][4]; scales(pre, row0, fq, rs);
#pragma unroll
        for (int ai = 0; ai < 2; ++ai)
#pragma unroll
            for (int m = 0; m < 4; ++m) { const int row = row0 + ai * 128 + m * 16; const float r = rs[ai][m];
#pragma unroll
                for (int bj = 0; bj < 2; ++bj)
#pragma unroll
                    for (int n = 0; n < 2; ++n) { const int cs = cb + bj * 128 + n * 16; f32x4 v = acc[ai][bj][m][n] * r;
#pragma unroll
                        for (int e = 0; e < 4; ++e) { const float t = fmaxf(v[e], 0.f); v[e] = t * t; }
                        u32x2 o; o.x = pk2(v[0], v[1]); o.y = pk2(v[2], v[3]); *(u32x2*)(H + (size_t)row * 4096 + cs) = o; } }
    }
};
DI size_t kf_index(int seqh, int nkt, int key, int d) { return ((((size_t)seqh * nkt + (key >> 5)) * 8 + (d >> 4)) * 64 + ((key & 31) + 32 * ((d >> 3) & 1))) * 8 + (d & 7); }
DI size_t vf_index(int seqh, int nkt, int key, int d) { const int kk = key & 31;
    return ((((size_t)seqh * nkt + (key >> 5)) * 8 + (kk >> 4) * 4 + (d >> 5)) * 64 + ((d & 31) + 32 * ((kk >> 2) & 1))) * 8 + ((kk >> 3) & 1) * 4 + (kk & 3); }
struct EpiQkv {
    struct Pre { float r[2][4]; };
    DI void prefetch(Pre& pre, const Unit& u, int wr, int fr) const { const int row0 = u.pm * 256 + wr * 64 + fr;
#pragma unroll
        for (int ai = 0; ai < 2; ++ai)
#pragma unroll
            for (int m = 0; m < 4; ++m) pre.r[ai][m] = RINV[row0 + ai * 128 + m * 16]; }
    DI void scales(const Pre& pre, int row0, int fq, float (&rs)[2][4]) const {
        if (pre.r[0][0] > 0.f) {
#pragma unroll
            for (int ai = 0; ai < 2; ++ai)
#pragma unroll
                for (int m = 0; m < 4; ++m) rs[ai][m] = pre.r[ai][m]; }
        else rinv8(SSQ, row0, fq, rs);
    }
    static constexpr bool PERM = false, AFTER_DRAIN = false;
    const float* SSQ; const float* RINV; float* out; bf16_t *Q, *KP, *KS, *VTP, *VTS;
    DI void operator()(const f32x4 (&acc)[2][2][4][2], const Unit& u, int wr, int wc, int fr, int fq, const Pre& pre) const {
        const int third = u.pn >> 2, cb = (u.pn & 3) * 256 + wc * 32 + 4 * fq, row0 = u.pm * 256 + wr * 64 + fr;
        float rs[2][4]; scales(pre, row0, fq, rs);
#pragma unroll
        for (int ai = 0; ai < 2; ++ai)
#pragma unroll
            for (int m = 0; m < 4; ++m) { const int row = row0 + ai * 128 + m * 16; const float r = rs[ai][m];
                const bool smp = row >= NTP; const int s = row - NTP; const int b = smp ? (s >> 6) : row / TP, key = smp ? 1024 + (s & 63) : row - b * TP, nkt = smp ? 34 : 129;
#pragma unroll
                for (int bj = 0; bj < 2; ++bj)
#pragma unroll
                    for (int n = 0; n < 2; ++n) { const int cs = cb + bj * 128 + n * 16; const f32x4 v = acc[ai][bj][m][n] * r;
                        u32x2 o; o.x = pk2(v[0], v[1]); o.y = pk2(v[2], v[3]);
                        if (third == 0) { *(u32x2*)(Q + (size_t)row * 1024 + cs) = o; }
                        else if (row < NT) { const int h = cs >> 7, d = cs & 127;
                            if (third == 1) { *(f32x4*)(out + (smp ? O_KS + (size_t)s * 1024 : O_KP + (size_t)row * 1024) + cs) = v;
                                *(u32x2*)((smp ? KS : KP) + kf_index(b * 8 + h, nkt, key, d)) = o; }
                            else { *(f32x4*)(out + (smp ? O_VS + (size_t)s * 1024 : O_VP + (size_t)row * 1024) + cs) = v;
                                bf16_t* vt = (smp ? VTS : VTP) + vf_index(b * 8 + h, nkt, key, d);
                                vt[0] = (bf16_t)(o.x & 0xffffu); vt[8] = (bf16_t)(o.x >> 16); vt[16] = (bf16_t)(o.y & 0xffffu); vt[24] = (bf16_t)(o.y >> 16); } } } }
    }
};
struct EpiFin {
    struct Pre {}; DI void prefetch(Pre&, const Unit&, int, int) const {}
    static constexpr bool PERM = false, AFTER_DRAIN = false;
    const bf16_t* XB; float* SSQ; float* out;
    DI void row(const f32x4 (&a4)[2][2], const Unit& u, int ai, int m, int wr, int wc, int fr, int fq) const {
        const int cb = u.pn * 256 + wc * 32 + 4 * fq, row = u.pm * 256 + wr * 64 + fr + ai * 128 + m * 16; float ss = 0.f;
        const int b = row / TP, t = row - b * TP; const bool ok = row < NT && (row >= NTP || t >= 16);
        float* dst = out + (row >= NTP ? O_YS + (size_t)(row - NTP) * 1024 : O_YP + ((size_t)b * 4096 + (t - 16)) * 1024);
#pragma unroll
        for (int bj = 0; bj < 2; ++bj)
#pragma unroll
            for (int n = 0; n < 2; ++n) { const int cs = cb + bj * 128 + n * 16; f32x4 v = a4[bj][n];
                const u32x2 x = *(const u32x2*)(XB + (size_t)row * 1024 + cs);
                v[0] += bflo(x.x); v[1] += bfhi(x.x); v[2] += bflo(x.y); v[3] += bfhi(x.y);
                if (ok) *(f32x4*)(dst + cs) = v;
                ss += (v[0] * v[0] + v[1] * v[1]) + (v[2] * v[2] + v[3] * v[3]); }
        ss += __shfl_xor(ss, 16); ss += __shfl_xor(ss, 32);
        if (fq == 0) SSQ[(size_t)row * 16 + u.pn * 4 + wc] = ss;
    }
    DI void operator()(const f32x4 (&acc)[2][2][4][2], const Unit& u, int wr, int wc, int fr, int fq, const Pre& pre) const {
        const int cb = u.pn * 256 + wc * 32 + 4 * fq, row0 = u.pm * 256 + wr * 64 + fr;
#pragma unroll
        for (int ai = 0; ai < 2; ++ai) {
            u32x2 x[4][2][2];
#pragma unroll
            for (int m = 0; m < 4; ++m)
#pragma unroll
                for (int bj = 0; bj < 2; ++bj)
#pragma unroll
                    for (int n = 0; n < 2; ++n) x[m][bj][n] = *(const u32x2*)(XB + (size_t)(row0 + ai * 128 + m * 16) * 1024 + cb + bj * 128 + n * 16);
#pragma unroll
            for (int m = 0; m < 4; ++m) { const int row = row0 + ai * 128 + m * 16; float ss = 0.f;
                const int b = row / TP, t = row - b * TP; const bool ok = row < NT && (row >= NTP || t >= 16);
                float* dst = out + (row >= NTP ? O_YS + (size_t)(row - NTP) * 1024 : O_YP + ((size_t)b * 4096 + (t - 16)) * 1024);
#pragma unroll
                for (int bj = 0; bj < 2; ++bj)
#pragma unroll
                    for (int n = 0; n < 2; ++n) { const int cs = cb + bj * 128 + n * 16; f32x4 v = acc[ai][bj][m][n]; const u32x2 xx = x[m][bj][n];
                        v[0] += bflo(xx.x); v[1] += bfhi(xx.x); v[2] += bflo(xx.y); v[3] += bfhi(xx.y);
                        if (ok) *(f32x4*)(dst + cs) = v;
                        ss += (v[0] * v[0] + v[1] * v[1]) + (v[2] * v[2] + v[3] * v[3]); }
                ss += __shfl_xor(ss, 16); ss += __shfl_xor(ss, 32);
                if (fq == 0) SSQ[(size_t)row * 16 + u.pn * 4 + wc] = ss; } }
    }
};
template <class Epi> DI void run_gemm(LAS unsigned char* lds, const bf16_t* A, const bf16_t* Bt, int N, int K, const Epi& E) {
    pg8::Gemm g; g.A = A; g.Bt = Bt; g.M = MP; g.N = N; g.K = K; g.part = nullptr;
    pg8::StaticOrder S; S.init(MP, N, (int)gridDim.x, (int)blockIdx.x);
    pg8::gemm_phase<Epi, pg8::StaticOrder>(lds, g, S, E);
}
struct SplitOrder : pg8::StaticOrder {
    int nwhole, ntail, S, nks;
    DI void init2(int N, int K) { init(MP, N, (int)gridDim.x, (int)blockIdx.x); nwhole = nwg / G; ntail = nwg - nwhole * G; S = 0; nks = 0;
        if (ntail > 0) { int s = G / ntail; const int nkt = K / 64; while (s > 1 && (nkt % s != 0 || (nkt / s) < 4 || ((nkt / s) & 1))) --s; if (s > 1) { S = s; nks = nkt / s; } } }
    DI bool next(int i, Unit& u) const {
        if (S == 0) return pg8::StaticOrder::next(i, u);
        if (i < nwhole) { map(i * G + c, u); return true; }
        if (i == nwhole && c < ntail * S) { map(nwhole * G + c / S, u); u.kb = (c % S) * nks; u.nk = nks; u.part = c; return true; }
        return false;
    }
};
template <class Epi> DI void run_gemm_split(LAS unsigned char* lds, const bf16_t* A, const bf16_t* Bt, int N, int K, const Epi& E, float* part) {
    pg8::Gemm g; g.A = A; g.Bt = Bt; g.M = MP; g.N = N; g.K = K; g.part = part;
    SplitOrder S; S.init2(N, K);
    pg8::gemm_phase<Epi, SplitOrder>(lds, g, S, E);
}
template <class Epi> DI void gemm_fixup(int N, int K, const Epi& E, const float* part, int tid) {
    SplitOrder S; S.init2(N, K); if (S.S == 0) return;
    asm volatile("" : "+v"(tid));
    const int wid = tid >> 6, lane = tid & 63, wr = wid >> 2, wc = wid & 3, fr = lane & 15, fq = lane >> 4;
    for (int it = blockIdx.x; it < S.ntail * 8; it += gridDim.x) { const int j = it >> 3, ai = (it >> 2) & 1, m = it & 3; Unit u; S.map(S.nwhole * S.G + j, u);
        f32x4 a4[2][2];
#pragma unroll
        for (int b = 0; b < 2; ++b)
#pragma unroll
            for (int n = 0; n < 2; ++n) { const f32x4* pp = (const f32x4*)part + ((size_t)(j * S.S) * 32 + (((ai * 2 + b) * 4 + m) * 2 + n)) * 512 + tid;
                f32x4 v0 = {0.f, 0.f, 0.f, 0.f}, v1 = v0, v2 = v0, v3 = v0;
                for (int sl = 0; sl + 3 < S.S; sl += 4) { v0 += pp[(size_t)sl * 16384]; v1 += pp[(size_t)(sl + 1) * 16384]; v2 += pp[(size_t)(sl + 2) * 16384]; v3 += pp[(size_t)(sl + 3) * 16384]; }
                for (int sl = S.S & ~3; sl < S.S; ++sl) v0 += pp[(size_t)sl * 16384];
                a4[b][n] = (v0 + v1) + (v2 + v3); }
        E.row(a4, u, ai, m, wr, wc, fr, fq); }
}
DI void rinv_pass(const Prm& p, int K, int tid) {
    SplitOrder S; S.init2(1024, K);
    for (int pm = blockIdx.x; pm < MP / 256; pm += gridDim.x) {
        bool tail = false;
        if (S.S) for (int j = 0; j < S.ntail; ++j) { Unit u; S.map(S.nwhole * S.G + j, u); tail = tail || (u.pm == pm); }
        if (tid < 256) { const int row = pm * 256 + tid; float v = -1.f;
            if (!tail) { const f32x4* q = (const f32x4*)(p.SSQ + (size_t)row * 16); const f32x4 a = q[0] + q[1] + q[2] + q[3]; v = rsqrtf(((a.x + a.y) + (a.z + a.w)) * (1.f / 1024.f) + EPSN); }
            if (row >= NT) v = 1.f;
            p.RINV[row] = v; }
    }
}
DI void transpose_item(const float* W, int N, bf16_t* WT, size_t ldo, const float* sc, LAS float* scr, int item, int lane) {
    const int nblk = N / 32, kb = item / nblk, nb = item % nblk, k0 = 64 * kb, n0 = 32 * nb;
#pragma unroll 8
    for (int i = 0; i < 32; ++i) { const int kk = 2 * i + (lane >> 5); float w = W[(size_t)(k0 + kk) * N + n0 + (lane & 31)]; if (sc) w *= sc[k0 + kk]; scr[kk * 33 + (lane & 31)] = w; }
    LDS_WAIT();
    const int c = lane & 7;
#pragma unroll
    for (int j = 0; j < 4; ++j) { const int n = (lane >> 3) + 8 * j; const LAS float* s = scr + (8 * c) * 33 + n;
        u32x4v o; o.x = pk2(s[0 * 33], s[1 * 33]); o.y = pk2(s[2 * 33], s[3 * 33]); o.z = pk2(s[4 * 33], s[5 * 33]); o.w = pk2(s[6 * 33], s[7 * 33]);
        *(u32x4v*)(WT + (size_t)(n0 + n) * ldo + k0 + 8 * c) = o; }
    LDS_WAIT();
}
DI void s5_pow(const Prm& p, int g, int n, float k, float& re, float& im) {
    const float dt = __expf(p.log_dt[g]), ar = p.a_re[g * 64 + n], ai = p.a_im[g * 64 + n];
    const float mag = __expf(k * dt * ar); float rev = k * dt * ai * 0.15915494309189535f; rev -= rintf(rev);
    re = mag * __builtin_amdgcn_cosf(rev); im = mag * __builtin_amdgcn_sinf(rev);
}
DI void s5_bbar(const Prm& p, int g, int n, int pp, float& re, float& im) {
    const float ar = p.a_re[g * 64 + n], ai = p.a_im[g * 64 + n]; float abr, abi; s5_pow(p, g, n, 1.f, abr, abi);
    const float den = ar * ar + ai * ai, zr = ((abr - 1.f) * ar + abi * ai) / den, zi = (abi * ar - (abr - 1.f) * ai) / den;
    const float br = p.b_re[(g * 64 + n) * 16 + pp], bi = p.b_im[(g * 64 + n) * 16 + pp];
    re = zr * br - zi * bi; im = zr * bi + zi * br;
}
DI void phase_prologue(const Prm& p, LAS unsigned char* lds, int tid, int lane, int wave) {
    const int gw = blockIdx.x * 8 + wave, NGW = gridDim.x * 8, gtid = blockIdx.x * 512 + tid, GT = gridDim.x * 512;
    LAS float* scr = (LAS float*)(lds + wave * 16384);
    constexpr int I1 = 16 * 80, I2 = 8 * 16, I3 = 16 * 32, I4 = 16 * 128, I5 = 64 * 32, I6 = 16 * 96;
    constexpr int NITEMS = I1 + I2 + I3 + I4 + I5 + I6 + I3 + I4 + I5;
    for (int it = gw; it < NITEMS; it += NGW) {
        int r = it;
        if (r < I1) { transpose_item(p.w_in_even, 2560, p.Wt1, 1024, p.ln_mix, scr, r, lane); continue; } r -= I1;
        if (r < I2) { transpose_item(p.w_glu, 512, p.Wglu, 512, nullptr, scr, r, lane); continue; } r -= I2;
        if (r < I3) { transpose_item(p.w_out_even, 1024, p.Wo0, 1024, nullptr, scr, r, lane); continue; } r -= I3;
        if (r < I4) { transpose_item(p.w_up, 4096, p.Wup0, 1024, p.ln_mlp, scr, r, lane); continue; } r -= I4;
        if (r < I5) { transpose_item(p.w_down, 1024, p.Wdn0, 4096, nullptr, scr, r, lane); continue; } r -= I5;
        if (r < I6) { transpose_item(p.w_in_odd, 3072, p.Wqkv, 1024, p.ln_mix + 1024, scr, r, lane); continue; } r -= I6;
        if (r < I3) { transpose_item(p.w_out_odd, 1024, p.Wo1, 1024, nullptr, scr, r, lane); continue; } r -= I3;
        if (r < I4) { transpose_item(p.w_up + (size_t)1024 * 4096, 4096, p.Wup1, 1024, p.ln_mlp + 1024, scr, r, lane); continue; } r -= I4;
        transpose_item(p.w_down + (size_t)4096 * 1024, 1024, p.Wdn1, 4096, nullptr, scr, r, lane);
    }
    for (int row = gw; row < NT; row += NGW) {
        const float* src;
        if (row < NTP) { const int b = row / TP, t = row - b * TP; src = t < 16 ? p.meta + (size_t)t * 1024 : p.x_prompt + ((size_t)b * 4096 + (t - 16)) * 1024; }
        else src = p.x_sample + (size_t)(row - NTP) * 1024;
        float ss = 0.f;
#pragma unroll
        for (int j = 0; j < 4; ++j) { const f32x4 v = ((const f32x4*)src)[lane + 64 * j]; u32x2 o; o.x = pk2(v.x, v.y); o.y = pk2(v.z, v.w);
            const float a0 = bflo(o.x), a1 = bfhi(o.x), a2 = bflo(o.y), a3 = bfhi(o.y); ss += (a0 * a0 + a1 * a1) + (a2 * a2 + a3 * a3);
            ((u32x2*)(p.XB + (size_t)row * 1024))[lane + 64 * j] = o; }
        ss = wave_sum(ss);
        if (lane < 16) p.SSQ[(size_t)row * 16 + lane] = lane == 0 ? ss : 0.f;
        if (lane == 0) p.RINV[row] = rsqrtf(ss * (1.f / 1024.f) + EPSN);
    }
    if (gtid < MP - NT) p.RINV[NT + gtid] = 1.f;
    if (gtid < 512) p.LB[gtid] = 1.f / (1.f + __expf(p.hgrn_lb[512 + gtid] - p.hgrn_lb[gtid]));
    __syncthreads();
    {
        LAS float* zr_ = (LAS float*)lds; LAS float* zi_ = zr_ + 64; LAS float* wr_ = zi_ + 64; LAS float* wi_ = wr_ + 64;
        LAS float* bbr = wi_ + 64; LAS float* bbi = bbr + 1024; LAS float* cwr = bbi + 1024; LAS float* cwi = cwr + 16 * 65;
        for (int pair = blockIdx.x; pair < 512; pair += gridDim.x) { const int g = pair >> 4, tau = pair & 15;
            if (tid < 64) { const int n = tid; const float ar = p.a_re[g * 64 + n], ai = p.a_im[g * 64 + n]; float abr, abi; s5_pow(p, g, n, 1.f, abr, abi);
                const float den = ar * ar + ai * ai; zr_[n] = ((abr - 1.f) * ar + abi * ai) / den; zi_[n] = (abi * ar - (abr - 1.f) * ai) / den;
                float a, b; s5_pow(p, g, n, (float)tau, a, b); wr_[n] = a; wi_[n] = b; }
            __syncthreads();
#pragma unroll
            for (int k = 0; k < 2; ++k) { const int e = tid + 512 * k;
                { const int n = e >> 4; const float br = p.b_re[g * 1024 + e], bi = p.b_im[g * 1024 + e]; bbr[e] = zr_[n] * br - zi_[n] * bi; bbi[e] = zr_[n] * bi + zi_[n] * br; }
                { const int pch = e >> 6, n = e & 63; const float cr = p.c_re[g * 1024 + e], ci = p.c_im[g * 1024 + e]; cwr[pch * 65 + n] = cr * wr_[n] - ci * wi_[n]; cwi[pch * 65 + n] = cr * wi_[n] + ci * wr_[n]; } }
            __syncthreads();
            if (tid < 256) { const int pch = tid >> 4, pp = tid & 15; float acc = 0.f;
#pragma unroll 8
                for (int n = 0; n < 64; ++n) acc += cwr[pch * 65 + n] * bbr[n * 16 + pp] - cwi[pch * 65 + n] * bbi[n * 16 + pp];
                if (tau == 0 && pch == pp) acc += p.ssm_d[g * 16 + pch];
                const bf16_t kv = f2bf(acc);
                p.TG[((g * 16 + tau) * 16 + pch) * 16 + pp] = kv; }
            __syncthreads(); }
    }
    for (int i = gtid; i < 32 * 256 * 64; i += GT) {
        const int g = i >> 14, t = (i >> 10) & 15, pch = (i >> 6) & 15, n = i & 63; float wr_, wi_; s5_pow(p, g, n, (float)(t + 1), wr_, wi_);
        const float cr = p.c_re[(g * 16 + pch) * 64 + n], ci = p.c_im[(g * 16 + pch) * 64 + n];
        *(unsigned*)(p.TG + 131072 + ((size_t)(g * 256 + t * 16 + pch)) * 128 + 2 * n) = pk2(cr * wr_ - ci * wi_, -(cr * wi_ + ci * wr_)); }
    for (int i = gtid; i < 32 * 64 * 256; i += GT) {
        const int g = i >> 14, n = (i >> 8) & 63, s = (i >> 4) & 15, pp = i & 15; float wr_, wi_, br_, bi_; s5_pow(p, g, n, (float)(15 - s), wr_, wi_); s5_bbar(p, g, n, pp, br_, bi_);
        p.HT[((size_t)(g * 128 + 2 * n)) * 256 + s * 16 + pp] = f2bf(wr_ * br_ - wi_ * bi_);
        p.HT[((size_t)(g * 128 + 2 * n + 1)) * 256 + s * 16 + pp] = f2bf(wr_ * bi_ + wi_ * br_); }
    if (gtid < 2048) { float wr_, wi_; s5_pow(p, gtid >> 6, gtid & 63, 16.f, wr_, wi_); p.A16[2 * gtid] = wr_; p.A16[2 * gtid + 1] = wi_; }
}

constexpr int HP = 136, TPI = 72;
constexpr int L_QT = 0, L_QH = 17408, L_KT = 34816, L_KTT = 52224, L_IVT = 70656, L_ATT = 89088, L_SUM = 98304, L_VEC = 100352, L_OB = 0  ;
struct HItem { int row0, L, h, bh; };
DI HItem hgrn_item(int item) {
    HItem it;
    if (item < 2080) { const int bh = item / 65, c = item - bh * 65, b = bh >> 2; it.h = bh & 3; it.bh = bh; it.L = c == 0 ? 16 : 64; it.row0 = b * TP + (c == 0 ? 0 : 16 + 64 * (c - 1)); }
    else { const int s = item - 2080, b = s >> 2; it.h = s & 3; it.bh = 32 + s; it.L = 64; it.row0 = NTP + b * 64; }
    return it;
}
template <bool FULL> DI void hgrn_loadraw(const Prm& p, const HItem& it, int tid, unsigned (&rl)[16], unsigned (&rv)[16], unsigned (&rq)[16]) {
    const int d = tid & 127, t0 = 16 * (tid >> 7), col = it.h * 128 + d;
#pragma unroll
    for (int j = 0; j < 16; ++j) { const int t = t0 + j; const bool valid = t < it.L; const size_t o = (size_t)(it.row0 + t) * 512 + col;
        rl[j] = valid ? (unsigned)p.LOGF[o] : 0u; rv[j] = valid ? (unsigned)p.IV[o] : 0u; if (FULL) rq[j] = valid ? (unsigned)p.Qh[o] : 0u; }
}
template <bool FULL> DI void hgrn_prep(const HItem& it, LAS unsigned char* lds, int tid, const unsigned (&rl)[16], const unsigned (&rv)[16], const unsigned (&rq)[16]) {
    const int d = tid & 127, tq = tid >> 7, t0 = 16 * tq;
    LAS float* sums = (LAS float*)(lds + L_SUM); LAS float* vec = (LAS float*)(lds + L_VEC);
    float cs[16], lf[16];
    float run = 0.f;
#pragma unroll
    for (int j = 0; j < 16; ++j) { lf[j] = h2f((unsigned short)rl[j]); run += lf[j]; cs[j] = run; }
    sums[tq * 128 + d] = run;
    { LAS u32x4v* dst = (LAS u32x4v*)(lds + L_IVT + (d * TPI + t0) * 2); u32x4v a, b;
        a.x = rv[0] | (rv[1] << 16); a.y = rv[2] | (rv[3] << 16); a.z = rv[4] | (rv[5] << 16); a.w = rv[6] | (rv[7] << 16);
        b.x = rv[8] | (rv[9] << 16); b.y = rv[10] | (rv[11] << 16); b.z = rv[12] | (rv[13] << 16); b.w = rv[14] | (rv[15] << 16); dst[0] = a; dst[1] = b; }
    __syncthreads();
    const float s0 = sums[d], s1 = sums[128 + d], s2 = sums[256 + d], s3 = sums[384 + d];
    const float off = tq == 0 ? 0.f : tq == 1 ? s0 : tq == 2 ? s0 + s1 : s0 + s1 + s2, r = s0 + s1, bL = r + s2 + s3;
    if (tq == 0) { vec[d] = r; vec[128 + d] = bL; }
    unsigned ktp[8]; float kprev = 0.f;
#pragma unroll
    for (int j = 0; j < 16; ++j) { const int t = t0 + j; const bool valid = t < it.L; const float b = off + cs[j];
        const float kt = valid ? (1.f - __expf(lf[j])) * __expf(r - b) : 0.f;
        if (j & 1) ktp[j >> 1] = pk2(kprev, kt); else kprev = kt;
        if (FULL) { const float qv = bf2f((unsigned short)rq[j]);
            *(LAS unsigned short*)(lds + L_KT + (t * HP + d) * 2) = f2bf(kt);
            *(LAS unsigned short*)(lds + L_QT + (t * HP + d) * 2) = f2bf(qv * __expf(b - r));
            *(LAS unsigned short*)(lds + L_QH + (t * HP + d) * 2) = f2bf(qv * __expf(b)); } }
    if (!FULL) { LAS u32x4v* dst = (LAS u32x4v*)(lds + L_KTT + (d * TPI + t0) * 2); u32x4v a, b; a.x = ktp[0]; a.y = ktp[1]; a.z = ktp[2]; a.w = ktp[3]; b.x = ktp[4]; b.y = ktp[5]; b.z = ktp[6]; b.w = ktp[7]; dst[0] = a; dst[1] = b; }
    __syncthreads();
}
#define MFMA16(a, b, c) __builtin_amdgcn_mfma_f32_16x16x32_bf16((a), (b), (c), 0, 0, 0)
#define MFMA32(a, b, c) __builtin_amdgcn_mfma_f32_32x32x16_bf16((a), (b), (c), 0, 0, 0)
DI void hgrn_b1_all(const Prm& p, LAS unsigned char* lds, int tid, int lane, int wave) {
    const int fr = lane & 15, fq = lane >> 4;
    int item = blockIdx.x; if (item >= NITEM_H) return;
    unsigned rl[16], rv[16], rq[16];
    hgrn_loadraw<false>(p, hgrn_item(item), tid, rl, rv, rq);
    while (item < NITEM_H) {
        const HItem it = hgrn_item(item);
        hgrn_prep<false>(it, lds, tid, rl, rv, rq);
        const int next = item + gridDim.x;
        if (next < NITEM_H) hgrn_loadraw<false>(p, hgrn_item(next), tid, rl, rv, rq);
        const LAS float* vec = (const LAS float*)(lds + L_VEC);
        bf16x8 a[2];
#pragma unroll
        for (int ks = 0; ks < 2; ++ks) a[ks] = *(const LAS bf16x8*)(lds + L_KTT + ((16 * wave + fr) * TPI + 32 * ks + 8 * fq) * 2);
        float e2[4];
#pragma unroll
        for (int j = 0; j < 4; ++j) { const int d = 16 * wave + 4 * fq + j; e2[j] = __expf(vec[128 + d] - vec[d]); }
#pragma unroll
        for (int vt = 0; vt < 8; ++vt) { f32x4 acc = {0.f, 0.f, 0.f, 0.f};
#pragma unroll
            for (int ks = 0; ks < 2; ++ks) { const bf16x8 b = *(const LAS bf16x8*)(lds + L_IVT + ((16 * vt + fr) * TPI + 32 * ks + 8 * fq) * 2); acc = MFMA16(a[ks], b, acc); }
            u32x2 o; o.x = pk2(acc[0] * e2[0], acc[1] * e2[1]); o.y = pk2(acc[2] * e2[2], acc[3] * e2[3]);
            *(u32x2*)(p.UT + (size_t)item * 16384 + (16 * vt + fr) * 128 + 16 * wave + 4 * fq) = o; }
        if (tid < 128) p.AL[(size_t)item * 128 + tid] = __expf(vec[128 + tid]);
        __syncthreads();
        item = next;
    }
}
template <int NB> DI void hgrn_b2_steps(const Prm& p, int item, int v, int d4, float (&S)[4]) {
    u32x2 uu[NB]; f32x4 al[NB];
#pragma unroll
    for (int i = 0; i < NB; ++i) { uu[i] = *(const u32x2*)(p.UT + (size_t)(item + i) * 16384 + v * 128 + d4); al[i] = *(const f32x4*)(p.AL + (size_t)(item + i) * 128 + d4); }
#pragma unroll
    for (int i = 0; i < NB; ++i) { u32x2 o; o.x = pk2(S[0], S[1]); o.y = pk2(S[2], S[3]);
        *(u32x2*)(p.UT + (size_t)(item + i) * 16384 + v * 128 + d4) = o;
        S[0] = al[i][0] * S[0] + bflo(uu[i].x); S[1] = al[i][1] * S[1] + bfhi(uu[i].x); S[2] = al[i][2] * S[2] + bflo(uu[i].y); S[3] = al[i][3] * S[3] + bfhi(uu[i].y); }
}
DI void hgrn_b2(const Prm& p, int gtid, int GT) {
    for (int idx = gtid; idx < 64 * 4096; idx += GT) {
        const int bhx = idx >> 12, e = idx & 4095, v = e >> 5, d4 = (e & 31) * 4; const bool smp = bhx >= 32;
        float S[4] = {0.f, 0.f, 0.f, 0.f};
        if (smp) {
#pragma unroll
            for (int j = 0; j < 4; ++j) S[j] = p.state_hgrn[((size_t)(bhx - 32) * 128 + d4 + j) * 128 + v];
            hgrn_b2_steps<1>(p, 2080 + (bhx - 32), v, d4, S); }
        else { for (int c0 = 0; c0 < 65; c0 += 13) hgrn_b2_steps<13>(p, bhx * 65 + c0, v, d4, S); }
        float* dst = p.out + (smp ? O_HGS + (size_t)(bhx - 32) * 16384 : O_HGP + (size_t)bhx * 16384);
#pragma unroll
        for (int j = 0; j < 4; ++j) dst[(d4 + j) * 128 + v] = S[j];
    }
}
DI void hgrn_b3_all(const Prm& p, LAS unsigned char* lds, int tid, int lane, int wave) {
    const int fr = lane & 15, fq = lane >> 4;
    int item = blockIdx.x; if (item >= NITEM_H) return;
    unsigned rl[16], rv[16], rq[16];
    hgrn_loadraw<true>(p, hgrn_item(item), tid, rl, rv, rq);
    const int nt_ = tid >> 3, nsg = tid & 7;
    while (item < NITEM_H) {
        const HItem it = hgrn_item(item);
        bf16x8 sf[4][4];
#pragma unroll
        for (int i = 0; i < 4; ++i)
#pragma unroll
            for (int ks = 0; ks < 4; ++ks) sf[i][ks] = *(const bf16x8*)(p.UT + (size_t)item * 16384 + (16 * (4 * (wave >> 2) + i) + fr) * 128 + 32 * ks + 8 * fq);
        const size_t grow = (size_t)(it.row0 + (nt_ < it.L ? nt_ : 0)); const int gc0 = it.h * 128 + 16 * nsg;
        const u32x4v g0 = *(const u32x4v*)(p.GS + grow * 512 + gc0), g1 = *(const u32x4v*)(p.GS + grow * 512 + gc0 + 8);
        hgrn_prep<true>(it, lds, tid, rl, rv, rq);
        const int next = item + gridDim.x;
        if (next < NITEM_H) hgrn_loadraw<true>(p, hgrn_item(next), tid, rl, rv, rq);
        {
            const int tt = wave >> 1;
#pragma unroll
            for (int i = 0; i < 2; ++i) { const int st = 2 * (wave & 1) + i; f32x4 acc = {0.f, 0.f, 0.f, 0.f};
#pragma unroll
                for (int ks = 0; ks < 4; ++ks) { const bf16x8 a = *(const LAS bf16x8*)(lds + L_KT + ((16 * st + fr) * HP + 32 * ks + 8 * fq) * 2);
                    const bf16x8 b = *(const LAS bf16x8*)(lds + L_QT + ((16 * tt + fr) * HP + 32 * ks + 8 * fq) * 2); acc = MFMA16(a, b, acc); }
                const int t = 16 * tt + fr, s0 = 16 * st + 4 * fq;
                u32x2 o; o.x = pk2(s0 <= t ? acc[0] : 0.f, s0 + 1 <= t ? acc[1] : 0.f); o.y = pk2(s0 + 2 <= t ? acc[2] : 0.f, s0 + 3 <= t ? acc[3] : 0.f);
                *(LAS u32x2*)(lds + L_ATT + (t * TPI + s0) * 2) = o; }
        }
        __syncthreads();
        f32x4 oacc[4];
        {   const int tt = wave & 3;
            bf16x8 aa[2], aq[4];
#pragma unroll
            for (int ks = 0; ks < 2; ++ks) aa[ks] = *(const LAS bf16x8*)(lds + L_ATT + ((16 * tt + fr) * TPI + 32 * ks + 8 * fq) * 2);
#pragma unroll
            for (int ks = 0; ks < 4; ++ks) aq[ks] = *(const LAS bf16x8*)(lds + L_QH + ((16 * tt + fr) * HP + 32 * ks + 8 * fq) * 2);
#pragma unroll
            for (int i = 0; i < 4; ++i) { const int vt = 4 * (wave >> 2) + i; f32x4 acc = {0.f, 0.f, 0.f, 0.f};
#pragma unroll
                for (int ks = 0; ks < 2; ++ks) { const bf16x8 b = *(const LAS bf16x8*)(lds + L_IVT + ((16 * vt + fr) * TPI + 32 * ks + 8 * fq) * 2); acc = MFMA16(aa[ks], b, acc); }
#pragma unroll
                for (int ks = 0; ks < 4; ++ks) acc = MFMA16(aq[ks], sf[i][ks], acc);
                oacc[i] = acc; }
        }
        f32x4 gn[4];
#pragma unroll
        for (int j = 0; j < 4; ++j) gn[j] = ((const f32x4*)(p.hgrn_norm + 16 * nsg))[j];
        __syncthreads();
        {   const int tt = wave & 3; LAS float* ob = (LAS float*)(lds + L_OB);
#pragma unroll
            for (int i = 0; i < 4; ++i) { const int v = 16 * (4 * (wave >> 2) + i) + fr;
#pragma unroll
                for (int j = 0; j < 4; ++j) ob[(16 * tt + 4 * fq + j) * 132 + v] = oacc[i][j]; }
        }
        __syncthreads();
        {   const int t = nt_, sg = nsg; const LAS float* ob = (const LAS float*)(lds + L_OB) + t * 132 + 16 * sg;
            f32x4 x[4]; float ss = 0.f;
#pragma unroll
            for (int j = 0; j < 4; ++j) { x[j] = ((const LAS f32x4*)ob)[j]; ss += (x[j].x * x[j].x + x[j].y * x[j].y) + (x[j].z * x[j].z + x[j].w * x[j].w); }
            ss += __shfl_xor(ss, 1); ss += __shfl_xor(ss, 2); ss += __shfl_xor(ss, 4);
            const float rr = rsqrtf(ss * (1.f / 128.f) + EPSN);
            if (t < it.L) { const size_t row = it.row0 + t; const int c0 = it.h * 128 + 16 * sg;
                const f32x4 n0 = gn[0], n1 = gn[1], n2 = gn[2], n3 = gn[3];
                u32x4v o0, o1;
                o0.x = pk2(x[0].x * rr * n0.x * bflo(g0.x), x[0].y * rr * n0.y * bfhi(g0.x)); o0.y = pk2(x[0].z * rr * n0.z * bflo(g0.y), x[0].w * rr * n0.w * bfhi(g0.y));
                o0.z = pk2(x[1].x * rr * n1.x * bflo(g0.z), x[1].y * rr * n1.y * bfhi(g0.z)); o0.w = pk2(x[1].z * rr * n1.z * bflo(g0.w), x[1].w * rr * n1.w * bfhi(g0.w));
                o1.x = pk2(x[2].x * rr * n2.x * bflo(g1.x), x[2].y * rr * n2.y * bfhi(g1.x)); o1.y = pk2(x[2].z * rr * n2.z * bflo(g1.y), x[2].w * rr * n2.w * bfhi(g1.y));
                o1.z = pk2(x[3].x * rr * n3.x * bflo(g1.z), x[3].y * rr * n3.y * bfhi(g1.z)); o1.w = pk2(x[3].z * rr * n3.z * bflo(g1.w), x[3].w * rr * n3.w * bfhi(g1.w));
                *(u32x4v*)(p.CAT + row * 1024 + c0) = o0; *(u32x4v*)(p.CAT + row * 1024 + c0 + 8) = o1; }
        }
        __syncthreads();
        item = next;
    }
}
DI void s5_load_u(const Prm& p, int mt, int g, int lane, bf16x8 (&uf)[8]) {
    const int fr = lane & 15, fq = lane >> 4; int col = 16 * mt + fr; if (col >= NCOL) col = NCOL - 1;
#pragma unroll
    for (int ks = 0; ks < 8; ++ks) uf[ks] = *(const bf16x8*)(p.U + ((size_t)(16 * col + 2 * ks + (fq >> 1))) * 512 + 16 * g + 8 * (fq & 1));
}
DI void s5_b(const Prm& p, int gw, int NGW, int lane) {
    const int fr = lane & 15, fq = lane >> 4;
    for (int task = gw; task < 131 * 32; task += NGW) { const int mt = task >> 5, g = task & 31;
        bf16x8 uf[8]; s5_load_u(p, mt, g, lane, uf);
#pragma unroll
        for (int nt = 0; nt < 8; ++nt) { f32x4 acc = {0.f, 0.f, 0.f, 0.f};
#pragma unroll
            for (int ks = 0; ks < 8; ++ks) { const bf16x8 b = *(const bf16x8*)(p.HT + ((size_t)(g * 128 + 16 * nt + fr)) * 256 + 32 * ks + 8 * fq); acc = MFMA16(uf[ks], b, acc); }
#pragma unroll
            for (int j = 0; j < 4; ++j) { const int col = 16 * mt + 4 * fq + j; if (col < NCOL) p.XLOC[(size_t)col * 4096 + g * 128 + 16 * nt + fr] = acc[j]; } }
    }
}
template <int NB> DI void s5_c_steps(const Prm& p, int col, size_t base, float ar, float ai, float& xr, float& xi) {
    f32x2v xl[NB];
#pragma unroll
    for (int i = 0; i < NB; ++i) xl[i] = *(const f32x2v*)(p.XLOC + (size_t)(col + i) * 4096 + base);
#pragma unroll
    for (int i = 0; i < NB; ++i) { *(unsigned*)(p.XPREV + (size_t)(col + i) * 4096 + base) = pk2(xr, xi);
        const float nr = ar * xr - ai * xi + xl[i].x, ni = ar * xi + ai * xr + xl[i].y; xr = nr; xi = ni; }
}
DI void s5_c(const Prm& p, int gtid) {
    if (gtid >= 16 * 2048) return;
    const int seq = gtid >> 11, g = (gtid >> 6) & 31, n = gtid & 63; const bool smp = seq >= 8; const int b = seq & 7;
    float xr = 0.f, xi = 0.f; if (smp) { xr = p.ssm_re0[(b * 32 + g) * 64 + n]; xi = p.ssm_im0[(b * 32 + g) * 64 + n]; }
    const float ar = p.A16[2 * (g * 64 + n)], ai = p.A16[2 * (g * 64 + n) + 1];
    const size_t base = (size_t)g * 128 + 2 * n;
    if (smp) s5_c_steps<4>(p, 2056 + 4 * b, base, ar, ai, xr, xi);
    else { for (int c0 = 0; c0 < 256; c0 += 16) s5_c_steps<16>(p, 257 * b + c0, base, ar, ai, xr, xi); s5_c_steps<1>(p, 257 * b + 256, base, ar, ai, xr, xi); }
    const size_t o = (size_t)(b * 32 + g) * 64 + n;
    p.out[(smp ? O_SRS : O_SRP) + o] = xr; p.out[(smp ? O_SIS : O_SIP) + o] = xi;
}
DI f32x2v gelu_pk(f32x2v v) {
    const f32x2v av = __builtin_elementwise_abs(v), d = av * 0.2316418882f + 1.0f;
    f32x2v t; t.x = __builtin_amdgcn_rcpf(d.x); t.y = __builtin_amdgcn_rcpf(d.y);
    f32x2v q = t * 0.5307027145f + (-0.7265760135f); q = q * t + 0.7107068705f; q = q * t + (-0.142248368f); q = q * t + 0.127414796f; q = q * t;
    const f32x2v s = (v * v) * (-0.72134752044f);
    f32x2v e; e.x = __builtin_amdgcn_exp2f(s.x); e.y = __builtin_amdgcn_exp2f(s.y);
    const f32x2v m = v * (q * e), r = v - m;
    f32x2v o; o.x = v.x < 0.f ? m.x : r.x; o.y = v.y < 0.f ? m.y : r.y; return o;
}
DI void s5_d(const Prm& p, int gw, int NGW, int lane) {
    const int fr = lane & 15, fq = lane >> 4;
    for (int task = gw; task < 131 * 32; task += NGW) { const int mt = task >> 5, g = task & 31;
        bf16x8 uf[8], xf[4]; s5_load_u(p, mt, g, lane, uf);
        int colc = 16 * mt + fr; if (colc >= NCOL) colc = NCOL - 1;
#pragma unroll
        for (int ks = 0; ks < 4; ++ks) xf[ks] = *(const bf16x8*)(p.XPREV + (size_t)colc * 4096 + g * 128 + 32 * ks + 8 * fq);
        const bf16_t* tg = p.TG + ((size_t)(g * 256 + fr)) * 384 + 8 * fq;
        const bool ok = 16 * mt + fr < NCOL;
#pragma unroll
        for (int t = 0; t < 16; ++t) { f32x4 acc = {0.f, 0.f, 0.f, 0.f};
#pragma unroll
            for (int ks = 0; ks < 8; ++ks) if (ks <= (t >> 1)) { const bf16x8 a = *(const bf16x8*)(tg + (size_t)t * 16 * 384 + 32 * ks); acc = MFMA16(a, uf[ks], acc); }
#pragma unroll
            for (int ks = 0; ks < 4; ++ks) { const bf16x8 a = *(const bf16x8*)(tg + (size_t)t * 16 * 384 + 256 + 32 * ks); acc = MFMA16(a, xf[ks], acc); }
            const f32x2v y0 = gelu_pk((f32x2v){acc[0], acc[1]}), y1 = gelu_pk((f32x2v){acc[2], acc[3]});
            u32x2 o; o.x = pk2(y0.x, y0.y); o.y = pk2(y1.x, y1.y);
            if (ok) *(u32x2*)(p.YG + ((size_t)(16 * (16 * mt + fr) + t)) * 512 + 16 * g + 4 * fq) = o; }
    }
}

DI void s5_b_lds(const Prm& p, LAS unsigned char* lds, int tid, int lane, int wave) {
    const int fr = lane & 15, fq = lane >> 4;
    for (int gp = blockIdx.x; gp < 256; gp += gridDim.x) { const int g = gp & 31, part = gp >> 5;
        for (int i = tid; i < 128 * 32; i += 512) { const int row = i >> 5, ch = i & 31;
            *(LAS u32x4v*)(lds + row * 528 + ch * 16) = *(const u32x4v*)(p.HT + ((size_t)(g * 128 + row)) * 256 + ch * 8); }
        __syncthreads();
        for (int mt = part + 8 * wave; mt < 131; mt += 64) {
            bf16x8 uf[8]; s5_load_u(p, mt, g, lane, uf);
#pragma unroll 1
            for (int nt = 0; nt < 8; ++nt) { f32x4 acc = {0.f, 0.f, 0.f, 0.f};
#pragma unroll
                for (int ks = 0; ks < 8; ++ks) { const bf16x8 b = *(const LAS bf16x8*)(lds + (16 * nt + fr) * 528 + 64 * ks + 16 * fq); acc = MFMA16(uf[ks], b, acc); }
#pragma unroll
                for (int j = 0; j < 4; ++j) { const int col = 16 * mt + 4 * fq + j; if (col < NCOL) p.XLOC[(size_t)col * 4096 + g * 128 + 16 * nt + fr] = acc[j]; } }
        }
        __syncthreads(); }
}
DI void s5_d_lds(const Prm& p, LAS unsigned char* lds, int tid, int lane, int wave) {
    const int fr = lane & 15, fq = lane >> 4;
    for (int gp = blockIdx.x; gp < 256; gp += gridDim.x) { const int g = gp & 31, part = gp >> 5;
        { const int row = tid >> 1, hf = tid & 1;
            *(LAS u32x4v*)(lds + row * 48 + hf * 16) = *(const u32x4v*)(p.TG + ((size_t)(g * 256 + row)) * 16 + hf * 8); }
        for (int i = tid; i < 256 * 16; i += 512) { const int row = i >> 4, ch = i & 15;
            *(LAS u32x4v*)(lds + 12288 + row * 272 + ch * 16) = *(const u32x4v*)(p.TG + 131072 + ((size_t)(g * 256 + row)) * 128 + ch * 8); }
        __syncthreads();
        const int lb = fr * 48 + (fq & 1) * 16, hi = fq >> 1;
        for (int mt = part + 8 * wave; mt < 131; mt += 64) {
            bf16x8 uf[8], xf[4]; s5_load_u(p, mt, g, lane, uf);
            int colc = 16 * mt + fr; if (colc >= NCOL) colc = NCOL - 1;
#pragma unroll
            for (int ks = 0; ks < 4; ++ks) xf[ks] = *(const bf16x8*)(p.XPREV + (size_t)colc * 4096 + g * 128 + 32 * ks + 8 * fq);
            const bool ok = 16 * mt + fr < NCOL;
#pragma unroll 1
            for (int t = 0; t < 16; ++t) { f32x4 acc = {0.f, 0.f, 0.f, 0.f};
#pragma unroll
                for (int ks = 0; ks < 8; ++ks) if (ks <= (t >> 1)) {
                    const int tau = t - 2 * ks - hi;
                    union { bf16x8 v; u32x4v u; } a; a.v = *(const LAS bf16x8*)(lds + (tau < 0 ? 0 : tau) * 768 + lb);
                    if (tau < 0) a.u = (u32x4v){0u, 0u, 0u, 0u};
                    acc = MFMA16(a.v, uf[ks], acc); }
#pragma unroll
                for (int ks = 0; ks < 4; ++ks) { const bf16x8 a = *(const LAS bf16x8*)(lds + 12288 + (t * 16 + fr) * 272 + 64 * ks + 16 * fq); acc = MFMA16(a, xf[ks], acc); }
                const f32x2v y0 = gelu_pk((f32x2v){acc[0], acc[1]}), y1 = gelu_pk((f32x2v){acc[2], acc[3]});
                u32x2 o; o.x = pk2(y0.x, y0.y); o.y = pk2(y1.x, y1.y);
                if (ok) *(u32x2*)(p.YG + ((size_t)(16 * (16 * mt + fr) + t)) * 512 + 16 * g + 4 * fq) = o; }
        }
        __syncthreads(); }
}
DI void cache_convert(const Prm& p, int gtid, int GT) {
    for (size_t i = (size_t)gtid; i < (size_t)8 * 1024 * 256; i += (size_t)GT) {
        const size_t row = i >> 8; const int c4 = (int)(i & 255) * 4, b = (int)(row >> 10), pos = (int)(row & 1023), h = c4 >> 7, d = c4 & 127;
        const f32x4 k = *(const f32x4*)(p.cache_k + row * 1024 + c4); u32x2 o; o.x = pk2(k.x, k.y); o.y = pk2(k.z, k.w);
        *(u32x2*)(p.KS + kf_index(b * 8 + h, 34, pos, d)) = o;
        const f32x4 v = *(const f32x4*)(p.cache_v + row * 1024 + c4); bf16_t* vt = p.VTS + vf_index(b * 8 + h, 34, pos, d);
        vt[0] = f2bf(v.x); vt[8] = f2bf(v.y); vt[16] = f2bf(v.z); vt[24] = f2bf(v.w); }
}
DI void attn_phase(const Prm& p, int gw, int NGW, int lane) {
    const int q = lane & 31, half = lane >> 5;
    for (int it = gw; it < 8256 + 128; it += NGW) {
        bool smp; int b, h, qb;
        if (it < 8064) { smp = false; b = it / 1008; const int rem = it - b * 1008; h = rem / 126; qb = 3 + rem - h * 126; }
        else if (it < 8192) { const int s = it - 8064; smp = true; b = s >> 4; h = (s >> 1) & 7; qb = s & 1; }
        else { const int s = it - 8192; smp = false; b = s / 24; const int rem = s - b * 24; h = rem / 3; qb = rem - h * 3; }
        const size_t tbase = (size_t)(b * 8 + h) * (smp ? 34 : 129) * 4096 + lane * 8;
        const bf16_t* Kb = (smp ? p.KS : p.KP) + tbase; const bf16_t* Vb = (smp ? p.VTS : p.VTP) + tbase;
        const int qpos0 = (smp ? 1024 : 0) + 32 * qb, qrow0 = smp ? NTP + b * 64 + 32 * qb : b * TP + 32 * qb;
        const int qpos = qpos0 + q; const bool qvalid = smp || qpos < TP; const size_t qrow = qvalid ? qrow0 + q : qrow0;
        bf16x8 qf[8];
#pragma unroll
        for (int ks = 0; ks < 8; ++ks) qf[ks] = *(const bf16x8*)(p.Q + qrow * 1024 + h * 128 + 16 * ks + 8 * half);
        f32x16 o[4];
#pragma unroll
        for (int db = 0; db < 4; ++db)
#pragma unroll
            for (int e = 0; e < 16; ++e) o[db][e] = 0.f;
        float C = 1.f;
        for (int kt = (qpos0 + 30) >> 5; kt >= 0; --kt) {
            f32x16 s;
#pragma unroll
            for (int e = 0; e < 16; ++e) s[e] = 0.f;
            const bf16_t* kr = Kb + (size_t)kt * 4096; const bf16_t* vr = Vb + (size_t)kt * 4096;
            bf16x8 kf[8], vf[8];
#pragma unroll
            for (int ks = 0; ks < 8; ++ks) kf[ks] = *(const bf16x8*)(kr + ks * 512);
#pragma unroll
            for (int ks = 0; ks < 8; ++ks) vf[ks] = *(const bf16x8*)(vr + ks * 512);
#pragma unroll
            for (int ks = 0; ks < 8; ++ks) s = MFMA32(kf[ks], qf[ks], s);
            float pr[16], be[16], G[4], Gp[4];
#pragma unroll
            for (int i = 0; i < 4; ++i) {
#pragma unroll
                for (int j = 0; j < 4; ++j) { const int key = 32 * kt + 8 * i + 4 * half + j; const bool valid = key < qpos;
                    float z = s[4 * i + j] * 0.08838834764831845f; z = fminf(fmaxf(z, -80.f), 80.f);
                    const float e = __expf(z), pp = __builtin_amdgcn_rcpf(1.f + e); pr[4 * i + j] = valid ? pp : 1.f; be[4 * i + j] = valid ? e * pp : 0.f; }
                G[i] = (pr[4 * i] * pr[4 * i + 1]) * (pr[4 * i + 2] * pr[4 * i + 3]); }
#pragma unroll
            for (int i = 0; i < 4; ++i) Gp[i] = __shfl_xor(G[i], 32);
            float w[16]; float E1 = 1.f;
#pragma unroll
            for (int i = 3; i >= 0; --i) { const float Glo = half ? Gp[i] : G[i], Ghi = half ? G[i] : Gp[i];
                float suf = C * (half ? E1 : E1 * Ghi);
#pragma unroll
                for (int j = 3; j >= 0; --j) { w[4 * i + j] = be[4 * i + j] * suf; suf *= pr[4 * i + j]; }
                E1 *= Glo * Ghi; }
            C *= E1;
#pragma unroll
            for (int c = 0; c < 2; ++c) { union { bf16x8 v; unsigned u[4]; } wf;
#pragma unroll
                for (int e = 0; e < 4; ++e) wf.u[e] = pk2(w[8 * c + 2 * e], w[8 * c + 2 * e + 1]);
#pragma unroll
                for (int db = 0; db < 4; ++db) o[db] = MFMA32(vf[4 * c + db], wf.v, o[db]); }
            if (__all(C < 1e-24f)) break;
        }
        if (qvalid) {
#pragma unroll
            for (int db = 0; db < 4; ++db)
#pragma unroll
                for (int i = 0; i < 4; ++i) { u32x2 ov; ov.x = pk2(o[db][4 * i], o[db][4 * i + 1]); ov.y = pk2(o[db][4 * i + 2], o[db][4 * i + 3]);
                    *(u32x2*)(p.O + qrow * 1024 + h * 128 + 32 * db + 8 * i + 4 * half) = ov; } }
    }
}
DI void final_norm(const Prm& p, int gw, int NGW, int lane) {
    for (int r = gw; r < 32768 + 512; r += NGW) {
        int grow; float* dst;
        if (r < 32768) { const int b = r >> 12, t = r & 4095; grow = b * TP + 16 + t; dst = p.out + O_YP + (size_t)r * 1024; } else { grow = NTP + (r - 32768); dst = p.out + O_YS + (size_t)(r - 32768) * 1024; }
        u32x2 x[4];
#pragma unroll
        for (int j = 0; j < 4; ++j) x[j] = ((const u32x2*)(p.XB + (size_t)grow * 1024))[lane + 64 * j];
        const float rr = row_rinv(p.SSQ, grow);
#pragma unroll
        for (int j = 0; j < 4; ++j) { f32x4 v; v.x = bflo(x[j].x); v.y = bfhi(x[j].x); v.z = bflo(x[j].y); v.w = bfhi(x[j].y); ((f32x4*)dst)[lane + 64 * j] = v * rr * ((const f32x4*)p.ln_final)[lane + 64 * j]; }
    }
}

#define XB_TMO      128
#define XB_XCNT(j)  (256  + 64 * (j))
#define XB_XSUB(j)  (1280 + 64 * (j))
#define XB_XGEN(j)  (2304 + 64 * (j))
#define XB_TOP      3328
#define XB_TOPGEN   3392
#define XCD_BAR_WORDS 3456
#define XB_SPIN_CAP (1u << 18)
DI unsigned xb_ld(unsigned* p) { return __hip_atomic_load(p, __ATOMIC_RELAXED, __HIP_MEMORY_SCOPE_AGENT); }
DI unsigned xb_add(unsigned* p, unsigned v) { return __hip_atomic_fetch_add(p, v, __ATOMIC_RELAXED, __HIP_MEMORY_SCOPE_AGENT); }
DI unsigned xb_xcc_id() { return (unsigned)__builtin_amdgcn_s_getreg((3 << 11) | 20) & 0xFu; }
#define XB_SPIN(cond, bar) do { unsigned _sp = 0; while (cond) { __builtin_amdgcn_s_sleep(1); \
    if ((++_sp & 255u) == 0u) { if (xb_ld(&(bar)[XB_TMO])) break; if (_sp > XB_SPIN_CAP) { atomicAdd(&(bar)[XB_TMO], 1u); break; } } } } while (0)
struct XcdBarrier { unsigned* bar; unsigned x; volatile LAS unsigned* st; };
DI XcdBarrier xcd_barrier_post(unsigned* bar, volatile LAS unsigned* st) {
    XcdBarrier b; b.bar = bar; b.x = xb_xcc_id(); b.st = st;
    if (threadIdx.x == 0) (void)xb_add(&bar[XB_XCNT(b.x)], 1u);
    return b;
}
DI void xcd_barrier_complete(unsigned* bar, unsigned x, unsigned& nloc, unsigned& nx) {
    const unsigned G = gridDim.x * gridDim.y * gridDim.z;
    unsigned sum, cnt, mine, sp = 0u;
    for (;;) {
        sum = 0u; cnt = 0u; mine = 0u;
#pragma unroll
        for (unsigned j = 0; j < 16; ++j) { const unsigned c = xb_ld(&bar[XB_XCNT(j)]); sum += c; cnt += (c > 0u) ? 1u : 0u; mine = (j == x) ? c : mine; }
        if (sum == G) break;
        __builtin_amdgcn_s_sleep(1);
        if ((++sp & 255u) == 0u) { if (xb_ld(&bar[XB_TMO])) break; if (sp > XB_SPIN_CAP) { atomicAdd(&bar[XB_TMO], 1u); break; } }
    }
    nloc = mine > 0u ? mine : 1u; nx = cnt > 0u ? cnt : 1u;
}
DI void xcd_barrier(const XcdBarrier& b) {
    asm volatile("s_waitcnt vmcnt(0)" ::: "memory");
    __syncthreads();
    if (threadIdx.x == 0) {
        unsigned* bar = b.bar;
        __builtin_amdgcn_s_waitcnt(0);
        unsigned nloc = b.st[0], nx = b.st[1];
        if (nloc == 0u) { xcd_barrier_complete(bar, b.x, nloc, nx); b.st[0] = nloc; b.st[1] = nx; }
        const unsigned old = xb_add(&bar[XB_XSUB(b.x)], 1u);
        const unsigned gen = old / nloc;
        if (old + 1u == (gen + 1u) * nloc) {
            __builtin_amdgcn_fence(__ATOMIC_RELEASE, "agent");
            asm volatile("s_waitcnt vmcnt(0)" ::: "memory");
            const unsigned og = xb_add(&bar[XB_TOP], 1u);
            const unsigned tg = og / nx;
            if (og + 1u == (tg + 1u) * nx) xb_add(&bar[XB_TOPGEN], 1u);
            else XB_SPIN(xb_ld(&bar[XB_TOPGEN]) == tg, bar);
            __builtin_amdgcn_fence(__ATOMIC_ACQUIRE, "agent");
            xb_add(&bar[XB_XGEN(b.x)], 1u);
            asm volatile("s_waitcnt vmcnt(0)" ::: "memory");
        } else {
            XB_SPIN(xb_ld(&bar[XB_XGEN(b.x)]) == gen, bar);
            __builtin_amdgcn_fence(__ATOMIC_ACQUIRE, "agent");
            asm volatile("s_waitcnt vmcnt(0)" ::: "memory");
        }
    }
    __syncthreads();
}
constexpr int LDS_BYTES = 131072 + 256;
__global__ void __launch_bounds__(512, 2) fwd_megakernel(Prm p) {
    extern __shared__ __attribute__((aligned(16))) unsigned char shm[];
    LAS unsigned char* lds = (LAS unsigned char*)shm;
    cg::grid_group grid = cg::this_grid();
    const int tid = threadIdx.x, lane = tid & 63, wave = __builtin_amdgcn_readfirstlane(tid >> 6);
    const int gw = blockIdx.x * 8 + wave, NGW = gridDim.x * 8, gtid = blockIdx.x * 512 + tid, GT = gridDim.x * 512;
    volatile LAS unsigned* xst = (volatile LAS unsigned*)(lds + 131072);
    if (tid == 0) { xst[0] = 0u; xst[1] = 0u; }
    __syncthreads();
    const XcdBarrier xb = xcd_barrier_post(p.BAR, xst);
    phase_prologue(p, lds, tid, lane, wave);
    grid.sync();
    { EpiIn0 E; E.SSQ = p.SSQ; E.RINV = p.RINV; E.LB = p.LB; E.Qh = p.Qh; E.IV = p.IV; E.GS = p.GS; E.U = p.U; E.LOGF = p.LOGF; run_gemm(lds, p.XB, p.Wt1, 2560, 1024, E); }
    xcd_barrier(xb);
    hgrn_b1_all(p, lds, tid, lane, wave);
    s5_b_lds(p, lds, tid, lane, wave);
    xcd_barrier(xb);
    hgrn_b2(p, gtid, GT);
    s5_c(p, gtid);
    xcd_barrier(xb);
    hgrn_b3_all(p, lds, tid, lane, wave);
    s5_d_lds(p, lds, tid, lane, wave);
    xcd_barrier(xb);
    { EpiGlu E; E.YG = p.YG; E.CAT = p.CAT; run_gemm(lds, p.YG, p.Wglu, 512, 512, E); }
    xcd_barrier(xb);
    { EpiRes E; E.XB = p.XB; E.SSQ = p.SSQ; run_gemm_split(lds, p.CAT, p.Wo0, 1024, 1024, E, (float*)p.H); xcd_barrier(xb); gemm_fixup(1024, 1024, E, (const float*)p.H, tid); rinv_pass(p, 1024, tid); }
    xcd_barrier(xb);
    { EpiUp E; E.SSQ = p.SSQ; E.RINV = p.RINV; E.H = p.H; run_gemm(lds, p.XB, p.Wup0, 4096, 1024, E); }
    xcd_barrier(xb);
    { EpiRes E; E.XB = p.XB; E.SSQ = p.SSQ; run_gemm_split(lds, p.H, p.Wdn0, 1024, 4096, E, (float*)p.CAT); xcd_barrier(xb); gemm_fixup(1024, 4096, E, (const float*)p.CAT, tid); rinv_pass(p, 4096, tid); }
    xcd_barrier(xb);
    { EpiQkv E; E.SSQ = p.SSQ; E.RINV = p.RINV; E.out = p.out; E.Q = p.Q; E.KP = p.KP; E.KS = p.KS; E.VTP = p.VTP; E.VTS = p.VTS; run_gemm(lds, p.XB, p.Wqkv, 3072, 1024, E); }
    if (gridDim.x > 36) { if (blockIdx.x >= 36) cache_convert(p, (blockIdx.x - 36) * 512 + tid, (gridDim.x - 36) * 512); } else cache_convert(p, gtid, GT);
    xcd_barrier(xb);
    attn_phase(p, gw, NGW, lane);
    xcd_barrier(xb);
    { EpiRes E; E.XB = p.XB; E.SSQ = p.SSQ; run_gemm_split(lds, p.O, p.Wo1, 1024, 1024, E, (float*)p.H); xcd_barrier(xb); gemm_fixup(1024, 1024, E, (const float*)p.H, tid); rinv_pass(p, 1024, tid); }
    xcd_barrier(xb);
    { EpiUp E; E.SSQ = p.SSQ; E.RINV = p.RINV; E.H = p.H; run_gemm(lds, p.XB, p.Wup1, 4096, 1024, E); }
    xcd_barrier(xb);
    { EpiRes E; E.XB = p.XB; E.SSQ = p.SSQ; run_gemm_split(lds, p.H, p.Wdn1, 1024, 4096, E, (float*)p.CAT); xcd_barrier(xb); gemm_fixup(1024, 4096, E, (const float*)p.CAT, tid); }
    xcd_barrier(xb);
    final_norm(p, gw, NGW, lane);
}

extern "C" void kernel_launch(void* const* d_in, const int* in_sizes, int n_in, void* d_out, int out_size, void* d_ws, size_t ws_size, hipStream_t stream) {
    static int grid_blocks = 0;
    if (grid_blocks == 0) {
        int dev = 0, cus = 0, per_cu = 0;
        hipGetDevice(&dev); hipDeviceGetAttribute(&cus, hipDeviceAttributeMultiprocessorCount, dev);
        if (hipFuncSetAttribute((const void*)fwd_megakernel, hipFuncAttributeMaxDynamicSharedMemorySize, LDS_BYTES) != hipSuccess) fprintf(stderr, "kernel_launch: hipFuncSetAttribute failed\n");
        if (hipOccupancyMaxActiveBlocksPerMultiprocessor(&per_cu, (const void*)fwd_megakernel, 512, LDS_BYTES) != hipSuccess || per_cu < 1) { fprintf(stderr, "kernel_launch: occupancy query says %d\n", per_cu); per_cu = 1; }
        (void)hipGetLastError();
        grid_blocks = cus > 0 ? cus : 256;
    }
    Prm p{};
    const float* const* in = (const float* const*)d_in;
    p.x_prompt = in[0]; p.x_sample = in[1]; p.state_hgrn = in[2]; p.ssm_re0 = in[3]; p.ssm_im0 = in[4]; p.cache_k = in[5]; p.cache_v = in[6]; p.meta = in[7]; p.ln_mix = in[8]; p.ln_mlp = in[9];
    p.ln_final = in[10]; p.w_in_even = in[11]; p.hgrn_lb = in[12]; p.hgrn_norm = in[13]; p.a_re = in[14]; p.a_im = in[15]; p.log_dt = in[16]; p.b_re = in[17]; p.b_im = in[18]; p.c_re = in[19];
    p.c_im = in[20]; p.ssm_d = in[21]; p.w_glu = in[22]; p.w_out_even = in[23]; p.w_in_odd = in[24]; p.w_out_odd = in[25]; p.w_up = in[26]; p.w_down = in[27];
    p.out = (float*)d_out;
    unsigned char* ws = (unsigned char*)d_ws; size_t off = 0;
    auto take = [&](size_t bytes) { unsigned char* r = ws + off; off += (bytes + 255) & ~(size_t)255; return r; };
    p.Wt1 = (bf16_t*)take((size_t)2560 * 1024 * 2); p.Wglu = (bf16_t*)take((size_t)512 * 512 * 2); p.Wo0 = (bf16_t*)take((size_t)1024 * 1024 * 2); p.Wup0 = (bf16_t*)take((size_t)4096 * 1024 * 2);
    p.Wdn0 = (bf16_t*)take((size_t)4096 * 1024 * 2); p.Wqkv = (bf16_t*)take((size_t)3072 * 1024 * 2); p.Wo1 = (bf16_t*)take((size_t)1024 * 1024 * 2); p.Wup1 = (bf16_t*)take((size_t)4096 * 1024 * 2);
    p.Wdn1 = (bf16_t*)take((size_t)4096 * 1024 * 2);
    p.XB = (bf16_t*)take((size_t)MP * 1024 * 2); p.SSQ = (float*)take((size_t)MP * 16 * 4); p.RINV = (float*)take((size_t)MP * 4); p.LB = (float*)take(2048); p.KTAB = (float*)take((size_t)32 * 16 * 256 * 4);
    p.TG = (bf16_t*)take((size_t)32 * 256 * 384 * 2); p.HT = (bf16_t*)take((size_t)32 * 128 * 256 * 2); p.A16 = (float*)take(32 * 64 * 2 * 4); p.BAR = (unsigned*)take(XCD_BAR_WORDS * 4);
    const size_t S0 = off; constexpr size_t SZ512 = (size_t)MP * 512 * 2;
    p.Qh = (bf16_t*)take(SZ512); p.LOGF = (unsigned short*)take(SZ512); p.IV = (bf16_t*)take(SZ512); p.GS = (bf16_t*)take(SZ512); p.U = (bf16_t*)take(SZ512);
    p.UT = (bf16_t*)take((size_t)NITEM_H * 16384 * 2); p.AL = (float*)take((size_t)NITEM_H * 128 * 4);
    p.XLOC = (float*)take(SZ512); p.YG = (bf16_t*)p.XLOC;
    p.XPREV = (bf16_t*)take((size_t)NCOL * 4096 * 2); p.CAT = (bf16_t*)take((size_t)MP * 1024 * 2);
    size_t end = off;
    off = S0; p.H = (bf16_t*)take((size_t)MP * 4096 * 2); if (off > end) end = off;
    off = S0; p.Q = (bf16_t*)take((size_t)MP * 1024 * 2); p.KP = (bf16_t*)take((size_t)64 * 129 * 4096 * 2); p.KS = (bf16_t*)take((size_t)64 * 34 * 4096 * 2);
    p.VTP = (bf16_t*)take((size_t)64 * 129 * 4096 * 2); p.VTS = (bf16_t*)take((size_t)64 * 34 * 4096 * 2); p.O = (bf16_t*)take((size_t)MP * 1024 * 2); if (off > end) end = off;
    if (end > ws_size || n_in != 28 || (size_t)out_size != O_END) { fprintf(stderr, "kernel_launch: workspace/shape mismatch: need %zu have %zu, n_in %d, out %d\n", end, ws_size, n_in, out_size); return; }
    (void)hipMemsetAsync(p.BAR, 0, XCD_BAR_WORDS * 4, stream);
    void* args[] = {&p};
    hipError_t e = hipLaunchCooperativeKernel((const void*)fwd_megakernel, dim3(grid_blocks), dim3(512), args, LDS_BYTES, stream);
    if (e != hipSuccess) fprintf(stderr, "cooperative launch failed: %s (grid %d)\n", hipGetErrorString(e), grid_blocks);
}
```

```cpp
#include <hip/hip_runtime.h>
#include <hip/hip_cooperative_groups.h>
#include <cstdio>
#include <cstdint>
namespace cg = cooperative_groups;
namespace pg8 {
#define PG8_LAS __attribute__((address_space(3)))
typedef unsigned short bf16_t;
typedef short bf16x8 __attribute__((ext_vector_type(8)));
typedef float f32x4 __attribute__((ext_vector_type(4)));
typedef unsigned u32x4 __attribute__((ext_vector_type(4)));
constexpr int BM = 256, BK = 64, HALF = 128, HTB = HALF * BK * 2  , STAGE_BYTES = 8 * HTB, NXCD = 8, WGM = 8;

__host__ __device__ __forceinline__ int lds_byte(int r, int c) { const int st = (r >> 4) * 2 + (c >> 5), rr = r & 15, cc = c & 31, ob = rr * 64 + cc * 2; return st * 1024 + (ob ^ (((ob >> 9) & 1) << 5)); }
__host__ __device__ __forceinline__ void stage_rc(int b, int& R, int& C) { const int st = b / 1024, sb = b % 1024, swz = sb ^ (((sb >> 9) & 1) << 5); R = (st >> 1) * 16 + swz / 64; C = (st & 1) * 32 + (swz % 64) / 2; }
__host__ __device__ __forceinline__ int perm32(int rho) { const int n = rho >> 4, i = rho & 15; return 8 * (i >> 2) + 4 * n + (i & 3); }

struct Unit { int pm, pn, kb, nk, part; };
struct Gemm { const bf16_t* A; const bf16_t* Bt; int M, N, K; float* part; };

struct StaticOrder {
    int nM, nN, nwg, G, c;
    __host__ __device__ void init(int M, int N, int G_, int c_) { nM = M / BM; nN = N / BM; nwg = nM * nN; G = G_; c = c_; }
    __host__ __device__ void map(int L, Unit& u) const {
        int wgid = L; { const int q = nwg / NXCD, r = nwg % NXCD, xcd = wgid % NXCD, off = wgid / NXCD; wgid = (xcd < r ? xcd * (q + 1) : r * (q + 1) + (xcd - r) * q) + off; }
        const int nig = WGM * nN, gid = wgid / nig, fm = gid * WGM, gsz = (nM - fm) < WGM ? (nM - fm) : WGM;
        u.pm = fm + ((wgid % nig) % gsz); u.pn = (wgid % nig) / gsz; u.kb = 0; u.nk = 0; u.part = -1;
    }
    __host__ __device__ bool next(int i, Unit& u) const {
        const long L = (long)i * G + c; if (L >= nwg) return false;
        map((int)L, u); return true;
    }
    __device__ __forceinline__ void a_ready(const Unit&) const {}
    __device__ __forceinline__ void done(const Unit&) const {}
};
template <class Epi, class Sched>
__device__ __forceinline__ void gemm_phase(PG8_LAS unsigned char* lds, const Gemm g, const Sched& S, const Epi& E) {
    int tid_ = threadIdx.x; asm volatile("" : "+v"(tid_));
    const int tid = tid_, wid = __builtin_amdgcn_readfirstlane(tid >> 6), lane = tid & 63, wr = wid >> 2, wc = wid & 3, fr = lane & 15, fq = lane >> 4;
    const int K = g.K, nt = K / BK;
    unsigned voffA[2], voffB[2];
#pragma unroll
    for (int i = 0; i < 2; ++i) { int R, C; stage_rc(tid * 16 + i * 8192, R, C); const int Rb = Epi::PERM ? ((R & ~31) + perm32(R & 31)) : R;
        voffA[i] = (unsigned)(R * K + C) * 2u; voffB[i] = (unsigned)(Rb * K + C) * 2u; }
    const size_t kstep = (size_t)(BK * 2);
    const size_t hstep = (size_t)HALF * K * 2;
    const size_t tstep = 2 * hstep;
    const unsigned ldsw = (unsigned)wid * 1024u;
    const int aoff = lds_byte(wr * 64 + fr, fq * 8), boff = lds_byte(wc * 32 + fr, fq * 8);
#define PG8_SA(b, h) (((b) * 2 + (h)) * HTB)
#define PG8_SB(b, h) ((4 + (b) * 2 + (h)) * HTB)
#define PG8_STAGE(bufoff, gbase, voff) do { _Pragma("unroll") for (int _i = 0; _i < 2; ++_i) \
        __builtin_amdgcn_global_load_lds((const unsigned*)((const char*)(gbase) + (voff)[_i]), (PG8_LAS unsigned*)(lds + (bufoff) + ldsw + _i * 8192), 16, 0, 0); } while (0)
#define PG8_LDA(dst, b, h) do { _Pragma("unroll") for (int m = 0; m < 4; ++m) _Pragma("unroll") for (int k = 0; k < 2; ++k) dst[m][k] = *(const PG8_LAS bf16x8*)(lds + PG8_SA(b, h) + aoff + m * 2048 + k * 1024); } while (0)
#define PG8_LDB(dst, b, h) do { _Pragma("unroll") for (int n = 0; n < 2; ++n) _Pragma("unroll") for (int k = 0; k < 2; ++k) dst[n][k] = *(const PG8_LAS bf16x8*)(lds + PG8_SB(b, h) + boff + n * 2048 + k * 1024); } while (0)
#define PG8_MMA(ai, bj, At, Bt) do { __builtin_amdgcn_s_setprio(1); _Pragma("unroll") for (int m = 0; m < 4; ++m) _Pragma("unroll") for (int n = 0; n < 2; ++n) _Pragma("unroll") for (int k = 0; k < 2; ++k) \
        acc[ai][bj][m][n] = __builtin_amdgcn_mfma_f32_16x16x32_bf16(Bt[n][k], At[m][k], acc[ai][bj][m][n], 0, 0, 0); __builtin_amdgcn_s_setprio(0); } while (0)
#define PG8_WAIT_V(n) asm volatile("s_waitcnt vmcnt(" #n ")" ::: "memory")
#define PG8_WAIT_L(n) asm volatile("s_waitcnt lgkmcnt(" #n ")" ::: "memory")
#define PG8_BAR __builtin_amdgcn_s_barrier()
#define PG8_SCHED __builtin_amdgcn_sched_barrier(0)
    Unit cur, nxt; int ui = 0; typename Epi::Pre pre;
    if (!S.next(0, cur)) return;
    f32x4 acc[2][2][4][2];
#pragma unroll
    for (int a = 0; a < 2; ++a)
#pragma unroll
        for (int b = 0; b < 2; ++b)
#pragma unroll
            for (int m = 0; m < 4; ++m)
#pragma unroll
                for (int n = 0; n < 2; ++n) acc[a][b][m][n] = (f32x4){0.f, 0.f, 0.f, 0.f};
    bf16x8 At[4][2], B0[2][2], B1[2][2];
    const char* cA = (const char*)g.A + (size_t)cur.pm * tstep + (size_t)cur.kb * kstep; const char* cB = (const char*)g.Bt + (size_t)cur.pn * tstep + (size_t)cur.kb * kstep;
    S.a_ready(cur);
    PG8_STAGE(PG8_SB(0, 0), cB, voffB); PG8_STAGE(PG8_SA(0, 0), cA, voffA); PG8_STAGE(PG8_SB(0, 1), cB + hstep, voffB); PG8_STAGE(PG8_SA(0, 1), cA + hstep, voffA);
    if (wr == 1) PG8_BAR;
    PG8_WAIT_V(4); PG8_BAR;
    PG8_STAGE(PG8_SB(1, 0), cB + kstep, voffB); PG8_STAGE(PG8_SA(1, 0), cA + kstep, voffA); PG8_STAGE(PG8_SB(1, 1), cB + hstep + kstep, voffB);
    PG8_WAIT_V(6); PG8_BAR;
    for (;;) {
        const bool has_next = S.next(ui + 1, nxt);
        const char* nA = has_next ? (const char*)g.A + (size_t)nxt.pm * tstep + (size_t)nxt.kb * kstep : cA; const char* nB = has_next ? (const char*)g.Bt + (size_t)nxt.pn * tstep + (size_t)nxt.kb * kstep : cB;
        const int cnk = cur.nk ? cur.nk : nt;
        for (int t = 0; t < cnk; t += 2) {
            const bool last = (t == cnk - 2);
            const char* a1 = cA + (size_t)(t + 1) * kstep;
            const char* a2 = last ? nA : cA + (size_t)(t + 2) * kstep; const char* b2 = last ? nB : cB + (size_t)(t + 2) * kstep;
            const char* a3 = a2 + kstep; const char* b3 = b2 + kstep;
            if (last && has_next) S.a_ready(nxt);
            if (last) E.prefetch(pre, cur, wr, fr);
            PG8_LDB(B0, 0, 0); PG8_SCHED; PG8_LDA(At, 0, 0); PG8_STAGE(PG8_SA(1, 1), a1 + hstep, voffA);
            PG8_WAIT_L(8); PG8_BAR; PG8_WAIT_L(0); PG8_MMA(0, 0, At, B0); PG8_BAR; PG8_SCHED;
            PG8_LDB(B1, 0, 1); PG8_STAGE(PG8_SB(0, 0), b2, voffB);
            PG8_BAR; PG8_WAIT_L(0); PG8_MMA(0, 1, At, B1); PG8_BAR;
            PG8_LDA(At, 0, 1); PG8_STAGE(PG8_SA(0, 0), a2, voffA);
            PG8_BAR; PG8_WAIT_L(0); PG8_MMA(1, 0, At, B0); PG8_BAR; PG8_SCHED;
            PG8_STAGE(PG8_SB(0, 1), b2 + hstep, voffB);
            PG8_WAIT_V(6); PG8_BAR; PG8_MMA(1, 1, At, B1); PG8_BAR;
            PG8_LDB(B0, 1, 0); PG8_SCHED; PG8_LDA(At, 1, 0); PG8_STAGE(PG8_SA(0, 1), a2 + hstep, voffA);
            PG8_WAIT_L(8); PG8_BAR; PG8_WAIT_L(0); PG8_MMA(0, 0, At, B0); PG8_BAR; PG8_SCHED;
            PG8_LDB(B1, 1, 1); PG8_STAGE(PG8_SB(1, 0), b3, voffB);
            PG8_BAR; PG8_WAIT_L(0); PG8_MMA(0, 1, At, B1); PG8_BAR;
            PG8_LDA(At, 1, 1); PG8_STAGE(PG8_SA(1, 0), a3, voffA);
            PG8_BAR; PG8_WAIT_L(0); PG8_MMA(1, 0, At, B0); PG8_BAR; PG8_SCHED;
            PG8_STAGE(PG8_SB(1, 1), b3 + hstep, voffB);
            PG8_WAIT_V(6); PG8_BAR; PG8_MMA(1, 1, At, B1); PG8_BAR;
        }
        if constexpr (!Epi::AFTER_DRAIN) {
            if (cur.part < 0) E(acc, cur, wr, wc, fr, fq, pre);
            else { f32x4* pp = (f32x4*)g.part + (size_t)cur.part * 32 * 512 + tid;
#pragma unroll
                for (int a = 0; a < 2; ++a)
#pragma unroll
                    for (int b = 0; b < 2; ++b)
#pragma unroll
                        for (int m = 0; m < 4; ++m)
#pragma unroll
                            for (int n = 0; n < 2; ++n) pp[(size_t)(((a * 2 + b) * 4 + m) * 2 + n) * 512] = acc[a][b][m][n]; }
            S.done(cur); }
        if (!has_next) break;
#pragma unroll
        for (int a = 0; a < 2; ++a)
#pragma unroll
            for (int b = 0; b < 2; ++b)
#pragma unroll
                for (int m = 0; m < 4; ++m)
#pragma unroll
                    for (int n = 0; n < 2; ++n) acc[a][b][m][n] = (f32x4){0.f, 0.f, 0.f, 0.f};
        cur = nxt; cA = nA; cB = nB; ++ui;
    }
    PG8_WAIT_V(0);
    if (wr == 0) PG8_BAR;
    PG8_BAR;
    if constexpr (Epi::AFTER_DRAIN) { E.fused(acc, cur, wr, wc, fr, fq, lds, wid, lane); S.done(cur); }
#undef PG8_SA
#undef PG8_SB
#undef PG8_STAGE
#undef PG8_LDA
#undef PG8_LDB
#undef PG8_MMA
#undef PG8_WAIT_V
#undef PG8_WAIT_L
#undef PG8_BAR
#undef PG8_SCHED
}
}
using pg8::bf16_t; using pg8::bf16x8; using pg8::f32x4; using pg8::Unit;
typedef float f32x16 __attribute__((ext_vector_type(16)));
typedef float f32x2v __attribute__((ext_vector_type(2)));
typedef unsigned u32x2 __attribute__((ext_vector_type(2)));
typedef unsigned u32x4v __attribute__((ext_vector_type(4)));
#define LAS __attribute__((address_space(3)))
#define DI __device__ __forceinline__

constexpr int DM = 1024, TP = 4112, NTP = 8 * TP  , NTS = 512, NT = NTP + NTS  , MP = 33536  ;
constexpr int NITEM_H = 2112;
constexpr int NCOL = NT / 16;
constexpr float EPSN = 1e-6f;
constexpr size_t O_YP = 0, O_YS = O_YP + (size_t)8 * 4096 * 1024, O_HGP = O_YS + 524288, O_HGS = O_HGP + 524288, O_SRP = O_HGS + 524288, O_SIP = O_SRP + 16384,
                 O_SRS = O_SIP + 16384, O_SIS = O_SRS + 16384, O_KP = O_SIS + 16384, O_VP = O_KP + (size_t)NTP * 1024, O_KS = O_VP + (size_t)NTP * 1024, O_VS = O_KS + 524288, O_END = O_VS + 524288;

struct Prm {
    const float *x_prompt, *x_sample, *state_hgrn, *ssm_re0, *ssm_im0, *cache_k, *cache_v, *meta, *ln_mix, *ln_mlp, *ln_final, *w_in_even, *hgrn_lb, *hgrn_norm,
        *a_re, *a_im, *log_dt, *b_re, *b_im, *c_re, *c_im, *ssm_d, *w_glu, *w_out_even, *w_in_odd, *w_out_odd, *w_up, *w_down;
    float* out;
    bf16_t *Wt1, *Wglu, *Wo0, *Wup0, *Wdn0, *Wqkv, *Wo1, *Wup1, *Wdn1;
    bf16_t* XB; float* SSQ; float* RINV; float* LB; float* KTAB; bf16_t* TG; bf16_t* HT; float* A16;
    bf16_t *Qh, *IV, *GS, *U; unsigned short* LOGF; bf16_t* UT; float* AL; float* XLOC; bf16_t* XPREV; bf16_t* YG; bf16_t* CAT;
    bf16_t* H;
    bf16_t *Q, *KP, *KS, *VTP, *VTS, *O; unsigned* BAR;
};

DI unsigned pk2(float lo, float hi) { unsigned r; asm volatile("v_cvt_pk_bf16_f32 %0, %1, %2" : "=v"(r) : "v"(lo), "v"(hi)); return r; }
DI float bflo(unsigned u) { return __uint_as_float(u << 16); }
DI float bfhi(unsigned u) { return __uint_as_float(u & 0xffff0000u); }
DI float bf2f(unsigned short b) { return __uint_as_float(((unsigned)b) << 16); }
DI unsigned short f2bf(float f) { return (unsigned short)(pk2(f, 0.f) & 0xffffu); }
DI unsigned pkh2(float lo, float hi) { union { _Float16 h[2]; unsigned u; } x; x.h[0] = (_Float16)lo; x.h[1] = (_Float16)hi; return x.u; }
DI float h2f(unsigned short h) { union { unsigned short s; _Float16 h; } x; x.s = h; return (float)x.h; }
DI float wave_sum(float v) {
#pragma unroll
    for (int o = 1; o < 64; o <<= 1) v += __shfl_xor(v, o);
    return v;
}
DI float fexp(float x) { return __expf(x); }
DI float sigm(float x) { return __builtin_amdgcn_rcpf(1.f + __expf(-x)); }
DI float row_rinv(const float* SSQ, int row) {
    const f32x4* s = (const f32x4*)(SSQ + (size_t)row * 16); f32x4 a = s[0] + s[1] + s[2] + s[3];
    return rsqrtf(((a.x + a.y) + (a.z + a.w)) * (1.f / 1024.f) + EPSN);
}
DI void rinv8(const float* SSQ, int row0, int fq, float (&r)[2][4]) {
    f32x4 v[2][4];
#pragma unroll
    for (int ai = 0; ai < 2; ++ai)
#pragma unroll
        for (int m = 0; m < 4; ++m) v[ai][m] = *(const f32x4*)(SSQ + (size_t)(row0 + ai * 128 + m * 16) * 16 + 4 * fq);
#pragma unroll
    for (int ai = 0; ai < 2; ++ai)
#pragma unroll
        for (int m = 0; m < 4; ++m) { float s = (v[ai][m].x + v[ai][m].y) + (v[ai][m].z + v[ai][m].w); s += __shfl_xor(s, 16); s += __shfl_xor(s, 32); r[ai][m] = rsqrtf(s * (1.f / 1024.f) + EPSN); }
}
#define LDS_WAIT() asm volatile("s_waitcnt lgkmcnt(0)" ::: "memory")

struct EpiIn0 {
    struct Pre { float r[2][4]; };
    DI void prefetch(Pre& pre, const Unit& u, int wr, int fr) const { const int row0 = u.pm * 256 + wr * 64 + fr;
#pragma unroll
        for (int ai = 0; ai < 2; ++ai)
#pragma unroll
            for (int m = 0; m < 4; ++m) pre.r[ai][m] = RINV[row0 + ai * 128 + m * 16]; }
    DI void scales(const Pre& pre, int row0, int fq, float (&rs)[2][4]) const {
        if (pre.r[0][0] > 0.f) {
#pragma unroll
            for (int ai = 0; ai < 2; ++ai)
#pragma unroll
                for (int m = 0; m < 4; ++m) rs[ai][m] = pre.r[ai][m]; }
        else rinv8(SSQ, row0, fq, rs);
    }
    static constexpr bool PERM = false, AFTER_DRAIN = false;
    const float* SSQ; const float* RINV; const float* LB; bf16_t *Qh, *IV, *GS, *U; unsigned short* LOGF;
    DI void operator()(const f32x4 (&acc)[2][2][4][2], const Unit& u, int wr, int wc, int fr, int fq, const Pre& pre) const {
        const int seg = u.pn >> 1, cb = (u.pn & 1) * 256 + wc * 32 + 4 * fq, row0 = u.pm * 256 + wr * 64 + fr;
        unsigned short* dst = seg == 0 ? Qh : seg == 1 ? LOGF : seg == 2 ? IV : seg == 3 ? GS : U;
        float rs[2][4]; scales(pre, row0, fq, rs);
        f32x4 lbv[2][2];
#pragma unroll
        for (int bj = 0; bj < 2; ++bj)
#pragma unroll
            for (int n = 0; n < 2; ++n) lbv[bj][n] = *(const f32x4*)(LB + cb + bj * 128 + n * 16);
#pragma unroll
        for (int ai = 0; ai < 2; ++ai)
#pragma unroll
            for (int m = 0; m < 4; ++m) { const int row = row0 + ai * 128 + m * 16; const float r = rs[ai][m];
#pragma unroll
                for (int bj = 0; bj < 2; ++bj)
#pragma unroll
                    for (int n = 0; n < 2; ++n) { const int cs = cb + bj * 128 + n * 16; f32x4 v = acc[ai][bj][m][n] * r; u32x2 o;
                        if (seg == 1) { const f32x4 lb = lbv[bj][n]; f32x4 f;
#pragma unroll
                            for (int e = 0; e < 4; ++e) f[e] = __logf(lb[e] + (1.f - lb[e]) * sigm(v[e]));
                            o.x = pkh2(f[0], f[1]); o.y = pkh2(f[2], f[3]); }
                        else { if (seg == 3) {
#pragma unroll
                                for (int e = 0; e < 4; ++e) v[e] = v[e] * sigm(v[e]); }
                            o.x = pk2(v[0], v[1]); o.y = pk2(v[2], v[3]); }
                        *(u32x2*)(dst + (size_t)row * 512 + cs) = o; } }
    }
};
struct EpiGlu {
    struct Pre {}; DI void prefetch(Pre&, const Unit&, int, int) const {}
    static constexpr bool PERM = false, AFTER_DRAIN = false;
    const bf16_t* YG; bf16_t* CAT;
    DI void operator()(const f32x4 (&acc)[2][2][4][2], const Unit& u, int wr, int wc, int fr, int fq, const Pre& pre) const {
        const int cb = u.pn * 256 + wc * 32 + 4 * fq, row0 = u.pm * 256 + wr * 64 + fr;
#pragma unroll
        for (int ai = 0; ai < 2; ++ai) {
            u32x2 y[4][2][2];
#pragma unroll
            for (int m = 0; m < 4; ++m)
#pragma unroll
                for (int bj = 0; bj < 2; ++bj)
#pragma unroll
                    for (int n = 0; n < 2; ++n) y[m][bj][n] = *(const u32x2*)(YG + (size_t)(row0 + ai * 128 + m * 16) * 512 + cb + bj * 128 + n * 16);
#pragma unroll
            for (int m = 0; m < 4; ++m) { const int row = row0 + ai * 128 + m * 16;
#pragma unroll
                for (int bj = 0; bj < 2; ++bj)
#pragma unroll
                    for (int n = 0; n < 2; ++n) { const int cs = cb + bj * 128 + n * 16; const f32x4 v = acc[ai][bj][m][n]; const u32x2 yy = y[m][bj][n]; u32x2 o;
                        o.x = pk2(bflo(yy.x) * sigm(v[0]), bfhi(yy.x) * sigm(v[1])); o.y = pk2(bflo(yy.y) * sigm(v[2]), bfhi(yy.y) * sigm(v[3]));
                        *(u32x2*)(CAT + (size_t)row * 1024 + 512 + cs) = o; } } }
    }
};
struct EpiRes {
    struct Pre {}; DI void prefetch(Pre&, const Unit&, int, int) const {}
    static constexpr bool PERM = false, AFTER_DRAIN = false;
    bf16_t* XB; float* SSQ;
    DI void row(const f32x4 (&a4)[2][2], const Unit& u, int ai, int m, int wr, int wc, int fr, int fq) const {
        const int cb = u.pn * 256 + wc * 32 + 4 * fq, row = u.pm * 256 + wr * 64 + fr + ai * 128 + m * 16; float ss = 0.f;
#pragma unroll
        for (int bj = 0; bj < 2; ++bj)
#pragma unroll
            for (int n = 0; n < 2; ++n) { const int cs = cb + bj * 128 + n * 16; const f32x4 v = a4[bj][n];
                u32x2* px = (u32x2*)(XB + (size_t)row * 1024 + cs); const u32x2 x = *px; u32x2 o;
                o.x = pk2(bflo(x.x) + v[0], bfhi(x.x) + v[1]); o.y = pk2(bflo(x.y) + v[2], bfhi(x.y) + v[3]); *px = o;
                const float a0 = bflo(o.x), a1 = bfhi(o.x), a2 = bflo(o.y), a3 = bfhi(o.y); ss += (a0 * a0 + a1 * a1) + (a2 * a2 + a3 * a3); }
        ss += __shfl_xor(ss, 16); ss += __shfl_xor(ss, 32);
        if (fq == 0) SSQ[(size_t)row * 16 + u.pn * 4 + wc] = ss;
    }
    DI void operator()(const f32x4 (&acc)[2][2][4][2], const Unit& u, int wr, int wc, int fr, int fq, const Pre& pre) const {
        const int cb = u.pn * 256 + wc * 32 + 4 * fq, row0 = u.pm * 256 + wr * 64 + fr;
#pragma unroll
        for (int ai = 0; ai < 2; ++ai) {
            u32x2 x[4][2][2];
#pragma unroll
            for (int m = 0; m < 4; ++m)
#pragma unroll
                for (int bj = 0; bj < 2; ++bj)
#pragma unroll
                    for (int n = 0; n < 2; ++n) x[m][bj][n] = *(const u32x2*)(XB + (size_t)(row0 + ai * 128 + m * 16) * 1024 + cb + bj * 128 + n * 16);
#pragma unroll
            for (int m = 0; m < 4; ++m) { const int row = row0 + ai * 128 + m * 16; float ss = 0.f;
#pragma unroll
                for (int bj = 0; bj < 2; ++bj)
#pragma unroll
                    for (int n = 0; n < 2; ++n) { const int cs = cb + bj * 128 + n * 16; const f32x4 v = acc[ai][bj][m][n]; const u32x2 xx = x[m][bj][n]; u32x2 o;
                        o.x = pk2(bflo(xx.x) + v[0], bfhi(xx.x) + v[1]); o.y = pk2(bflo(xx.y) + v[2], bfhi(xx.y) + v[3]); *(u32x2*)(XB + (size_t)row * 1024 + cs) = o;
                        const float a0 = bflo(o.x), a1 = bfhi(o.x), a2 = bflo(o.y), a3 = bfhi(o.y); ss += (a0 * a0 + a1 * a1) + (a2 * a2 + a3 * a3); }
                ss += __shfl_xor(ss, 16); ss += __shfl_xor(ss, 32);
                if (fq == 0) SSQ[(size_t)row * 16 + u.pn * 4 + wc] = ss; } }
    }
};
struct EpiUp {
    struct Pre { float r[2][4]; };
    DI void prefetch(Pre& pre, const Unit& u, int wr, int fr) const { const int row0 = u.pm * 256 + wr * 64 + fr;
#pragma unroll
        for (int ai = 0; ai < 2; ++ai)
#pragma unroll
            for (int m = 0; m < 4; ++m) pre.r[ai][m] = RINV[row0 + ai * 128 + m * 16]; }
    DI void scales(const Pre& pre, int row0, int fq, float (&rs)[2][4]) const {
        if (pre.r[0][0] > 0.f) {
#pragma unroll
            for (int ai = 0; ai < 2; ++ai)
#pragma unroll
                for (int m = 0; m < 4; ++m) rs[ai][m] = pre.r[ai][m]; }
        else rinv8(SSQ, row0, fq, rs);
    }
    static constexpr bool PERM = true, AFTER_DRAIN = false;
    const float* SSQ; const float* RINV; bf16_t* H;
    DI void operator()(const f32x4 (&acc)[2][2][4][2], const Unit& u, int wr, int wc, int fr, int fq, const Pre& pre) const {
        const int cb = u.pn * 256 + wc * 32 + 8 * fq, row0 = u.pm * 256 + wr * 64 + fr;
        float rs[2][4]; scales(pre, row0, fq, rs);
#pragma unroll
        for (int ai = 0; ai < 2; ++ai)
#pragma unroll
            for (int m = 0; m < 4; ++m) { const int row = row0 + ai * 128 + m * 16; const float r = rs[ai][m];
#pragma unroll
                for (int bj = 0; bj < 2; ++bj) { f32x4 v0 = acc[ai][bj][m][0] * r, v1 = acc[ai][bj][m][1] * r;
#pragma unroll
                    for (int e = 0; e < 4; ++e) { const float t0 = fmaxf(v0[e], 0.f), t1 = fmaxf(v1[e], 0.f); v0[e] = t0 * t0; v1[e] = t1 * t1; }
                    u32x4v o; o.x = pk2(v0[0], v0[1]); o.y = pk2(v0[2], v0[3]); o.z = pk2(v1[0], v1[1]); o.w = pk2(v1[2], v1[3]);
                    *(u32x4v*)(H + (size_t)row * 4096 + cb + bj * 128) = o; } }
    }
};
DI size_t kf_index(int seqh, int nkt, int key, int d) { return ((((size_t)seqh * nkt + (key >> 5)) * 8 + (d >> 4)) * 64 + ((key & 31) + 32 * ((d >> 3) & 1))) * 8 + (d & 7); }
DI size_t vf_index(int seqh, int nkt, int key, int d) { const int kk = key & 31;
    return ((((size_t)seqh * nkt + (key >> 5)) * 8 + (kk >> 4) * 4 + (d >> 5)) * 64 + ((d & 31) + 32 * ((kk >> 2) & 1))) * 8 + ((kk >> 3) & 1) * 4 + (kk & 3); }
struct EpiQkv {
    struct Pre { float r[2][4]; };
    DI void prefetch(Pre& pre, const Unit& u, int wr, int fr) const { const int row0 = u.pm * 256 + wr * 64 + fr;
#pragma unroll
        for (int ai = 0; ai < 2; ++ai)
#pragma unroll
            for (int m = 0; m < 4; ++m) pre.r[ai][m] = RINV[row0 + ai * 128 + m * 16]; }
    DI void scales(const Pre& pre, int row0, int fq, float (&rs)[2][4]) const {
        if (pre.r[0][0] > 0.f) {
#pragma unroll
            for (int ai = 0; ai < 2; ++ai)
#pragma unroll
                for (int m = 0; m < 4; ++m) rs[ai][m] = pre.r[ai][m]; }
        else rinv8(SSQ, row0, fq, rs);
    }
    static constexpr bool PERM = false, AFTER_DRAIN = false;
    const float* SSQ; const float* RINV; float* out; bf16_t *Q, *KP, *KS, *VTP, *VTS;
    DI void operator()(const f32x4 (&acc)[2][2][4][2], const Unit& u, int wr, int wc, int fr, int fq, const Pre& pre) const {
        const int third = u.pn >> 2, cb = (u.pn & 3) * 256 + wc * 32 + 4 * fq, row0 = u.pm * 256 + wr * 64 + fr;
        float rs[2][4]; scales(pre, row0, fq, rs);
#pragma unroll
        for (int ai = 0; ai < 2; ++ai)
#pragma unroll
            for (int m = 0; m < 4; ++m) { const int row = row0 + ai * 128 + m * 16; const float r = rs[ai][m];
                const bool smp = row >= NTP; const int s = row - NTP; const int b = smp ? (s >> 6) : row / TP, key = smp ? 1024 + (s & 63) : row - b * TP, nkt = smp ? 34 : 129;
#pragma unroll
                for (int bj = 0; bj < 2; ++bj)
#pragma unroll
                    for (int n = 0; n < 2; ++n) { const int cs = cb + bj * 128 + n * 16; const f32x4 v = acc[ai][bj][m][n] * r;
                        u32x2 o; o.x = pk2(v[0], v[1]); o.y = pk2(v[2], v[3]);
                        if (third == 0) { *(u32x2*)(Q + (size_t)row * 1024 + cs) = o; }
                        else if (row < NT) { const int h = cs >> 7, d = cs & 127;
                            if (third == 1) { *(f32x4*)(out + (smp ? O_KS + (size_t)s * 1024 : O_KP + (size_t)row * 1024) + cs) = v;
                                *(u32x2*)((smp ? KS : KP) + kf_index(b * 8 + h, nkt, key, d)) = o; }
                            else { *(f32x4*)(out + (smp ? O_VS + (size_t)s * 1024 : O_VP + (size_t)row * 1024) + cs) = v;
                                bf16_t* vt = (smp ? VTS : VTP) + vf_index(b * 8 + h, nkt, key, d);
                                vt[0] = (bf16_t)(o.x & 0xffffu); vt[8] = (bf16_t)(o.x >> 16); vt[16] = (bf16_t)(o.y & 0xffffu); vt[24] = (bf16_t)(o.y >> 16); } } } }
    }
};
struct EpiFin {
    struct Pre {}; DI void prefetch(Pre&, const Unit&, int, int) const {}
    static constexpr bool PERM = false, AFTER_DRAIN = false;
    const bf16_t* XB; float* SSQ; float* out;
    DI void row(const f32x4 (&a4)[2][2], const Unit& u, int ai, int m, int wr, int wc, int fr, int fq) const {
        const int cb = u.pn * 256 + wc * 32 + 4 * fq, row = u.pm * 256 + wr * 64 + fr + ai * 128 + m * 16; float ss = 0.f;
        const int b = row / TP, t = row - b * TP; const bool ok = row < NT && (row >= NTP || t >= 16);
        float* dst = out + (row >= NTP ? O_YS + (size_t)(row - NTP) * 1024 : O_YP + ((size_t)b * 4096 + (t - 16)) * 1024);
#pragma unroll
        for (int bj = 0; bj < 2; ++bj)
#pragma unroll
            for (int n = 0; n < 2; ++n) { const int cs = cb + bj * 128 + n * 16; f32x4 v = a4[bj][n];
                const u32x2 x = *(const u32x2*)(XB + (size_t)row * 1024 + cs);
                v[0] += bflo(x.x); v[1] += bfhi(x.x); v[2] += bflo(x.y); v[3] += bfhi(x.y);
                if (ok) *(f32x4*)(dst + cs) = v;
                ss += (v[0] * v[0] + v[1] * v[1]) + (v[2] * v[2] + v[3] * v[3]); }
        ss += __shfl_xor(ss, 16); ss += __shfl_xor(ss, 32);
        if (fq == 0) SSQ[(size_t)row * 16 + u.pn * 4 + wc] = ss;
    }
    DI void operator()(const f32x4 (&acc)[2][2][4][2], const Unit& u, int wr, int wc, int fr, int fq, const Pre& pre) const {
        const int cb = u.pn * 256 + wc * 32 + 4 * fq, row0 = u.pm * 256 + wr * 64 + fr;
#pragma unroll
        for (int ai = 0; ai < 2; ++ai) {
            u32x2 x[4][2][2];
#pragma unroll
            for (int m = 0; m < 4; ++m)
#pragma unroll
                for (int bj = 0; bj < 2; ++bj)
#pragma unroll
                    for (int n = 0; n < 2; ++n) x[m][bj][n] = *(const u32x2*)(XB + (size_t)(row0 + ai * 128 + m * 16) * 1024 + cb + bj * 128 + n * 16);
#pragma unroll
            for (int m = 0; m < 4; ++m) { const int row = row0 + ai * 128 + m * 16; float ss = 0.f;
                const int b = row / TP, t = row - b * TP; const bool ok = row < NT && (row >= NTP || t >= 16);
                float* dst = out + (row >= NTP ? O_YS + (size_t)(row - NTP) * 1024 : O_YP + ((size_t)b * 4096 + (t - 16)) * 1024);
#pragma unroll
                for (int bj = 0; bj < 2; ++bj)
#pragma unroll
                    for (int n = 0; n < 2; ++n) { const int cs = cb + bj * 128 + n * 16; f32x4 v = acc[ai][bj][m][n]; const u32x2 xx = x[m][bj][n];
                        v[0] += bflo(xx.x); v[1] += bfhi(xx.x); v[2] += bflo(xx.y); v[3] += bfhi(xx.y);
                        if (ok) *(f32x4*)(dst + cs) = v;
                        ss += (v[0] * v[0] + v[1] * v[1]) + (v[2] * v[2] + v[3] * v[3]); }
                ss += __shfl_xor(ss, 16); ss += __shfl_xor(ss, 32);
                if (fq == 0) SSQ[(size_t)row * 16 + u.pn * 4 + wc] = ss; } }
    }
};
template <class Epi> DI void run_gemm(LAS unsigned char* lds, const bf16_t* A, const bf16_t* Bt, int N, int K, const Epi& E) {
    pg8::Gemm g; g.A = A; g.Bt = Bt; g.M = MP; g.N = N; g.K = K; g.part = nullptr;
    pg8::StaticOrder S; S.init(MP, N, (int)gridDim.x, (int)blockIdx.x);
    pg8::gemm_phase<Epi, pg8::StaticOrder>(lds, g, S, E);
}
struct SplitOrder : pg8::StaticOrder {
    int nwhole, ntail, S, nks;
    DI void init2(int N, int K) { init(MP, N, (int)gridDim.x, (int)blockIdx.x); nwhole = nwg / G; ntail = nwg - nwhole * G; S = 0; nks = 0;
        if (ntail > 0) { int s = G / ntail; const int nkt = K / 64; while (s > 1 && (nkt % s != 0 || (nkt / s) < 4 || ((nkt / s) & 1))) --s; if (s > 1) { S = s; nks = nkt / s; } } }
    DI bool next(int i, Unit& u) const {
        if (S == 0) return pg8::StaticOrder::next(i, u);
        if (i < nwhole) { map(i * G + c, u); return true; }
        if (i == nwhole && c < ntail * S) { map(nwhole * G + c / S, u); u.kb = (c % S) * nks; u.nk = nks; u.part = c; return true; }
        return false;
    }
};
template <class Epi> DI void run_gemm_split(LAS unsigned char* lds, const bf16_t* A, const bf16_t* Bt, int N, int K, const Epi& E, float* part) {
    pg8::Gemm g; g.A = A; g.Bt = Bt; g.M = MP; g.N = N; g.K = K; g.part = part;
    SplitOrder S; S.init2(N, K);
    pg8::gemm_phase<Epi, SplitOrder>(lds, g, S, E);
}
template <class Epi> DI void gemm_fixup(int N, int K, const Epi& E, const float* part, int tid) {
    SplitOrder S; S.init2(N, K); if (S.S == 0) return;
    asm volatile("" : "+v"(tid));
    const int wid = tid >> 6, lane = tid & 63, wr = wid >> 2, wc = wid & 3, fr = lane & 15, fq = lane >> 4;
    for (int it = blockIdx.x; it < S.ntail * 8; it += gridDim.x) { const int j = it >> 3, ai = (it >> 2) & 1, m = it & 3; Unit u; S.map(S.nwhole * S.G + j, u);
        f32x4 a4[2][2];
#pragma unroll
        for (int b = 0; b < 2; ++b)
#pragma unroll
            for (int n = 0; n < 2; ++n) { const f32x4* pp = (const f32x4*)part + ((size_t)(j * S.S) * 32 + (((ai * 2 + b) * 4 + m) * 2 + n)) * 512 + tid;
                f32x4 v0 = {0.f, 0.f, 0.f, 0.f}, v1 = v0, v2 = v0, v3 = v0;
                for (int sl = 0; sl + 3 < S.S; sl += 4) { v0 += pp[(size_t)sl * 16384]; v1 += pp[(size_t)(sl + 1) * 16384]; v2 += pp[(size_t)(sl + 2) * 16384]; v3 += pp[(size_t)(sl + 3) * 16384]; }
                for (int sl = S.S & ~3; sl < S.S; ++sl) v0 += pp[(size_t)sl * 16384];
                a4[b][n] = (v0 + v1) + (v2 + v3); }
        E.row(a4, u, ai, m, wr, wc, fr, fq); }
}
DI void rinv_pass(const Prm& p, int K, int tid) {
    SplitOrder S; S.init2(1024, K);
    for (int pm = blockIdx.x; pm < MP / 256; pm += gridDim.x) {
        bool tail = false;
        if (S.S) for (int j = 0; j < S.ntail; ++j) { Unit u; S.map(S.nwhole * S.G + j, u); tail = tail || (u.pm == pm); }
        if (tid < 256) { const int row = pm * 256 + tid; float v = -1.f;
            if (!tail) { const f32x4* q = (const f32x4*)(p.SSQ + (size_t)row * 16); const f32x4 a = q[0] + q[1] + q[2] + q[3]; v = rsqrtf(((a.x + a.y) + (a.z + a.w)) * (1.f / 1024.f) + EPSN); }
            if (row >= NT) v = 1.f;
            p.RINV[row] = v; }
    }
}
DI void transpose_item(const float* W, int N, bf16_t* WT, size_t ldo, const float* sc, LAS float* scr, int item, int lane) {
    const int nblk = N / 32, kb = item / nblk, nb = item % nblk, k0 = 64 * kb, n0 = 32 * nb;
#pragma unroll 8
    for (int i = 0; i < 32; ++i) { const int kk = 2 * i + (lane >> 5); float w = W[(size_t)(k0 + kk) * N + n0 + (lane & 31)]; if (sc) w *= sc[k0 + kk]; scr[kk * 33 + (lane & 31)] = w; }
    LDS_WAIT();
    const int c = lane & 7;
#pragma unroll
    for (int j = 0; j < 4; ++j) { const int n = (lane >> 3) + 8 * j; const LAS float* s = scr + (8 * c) * 33 + n;
        u32x4v o; o.x = pk2(s[0 * 33], s[1 * 33]); o.y = pk2(s[2 * 33], s[3 * 33]); o.z = pk2(s[4 * 33], s[5 * 33]); o.w = pk2(s[6 * 33], s[7 * 33]);
        *(u32x4v*)(WT + (size_t)(n0 + n) * ldo + k0 + 8 * c) = o; }
    LDS_WAIT();
}
DI void s5_pow(const Prm& p, int g, int n, float k, float& re, float& im) {
    const float dt = __expf(p.log_dt[g]), ar = p.a_re[g * 64 + n], ai = p.a_im[g * 64 + n];
    const float mag = __expf(k * dt * ar); float rev = k * dt * ai * 0.15915494309189535f; rev -= rintf(rev);
    re = mag * __builtin_amdgcn_cosf(rev); im = mag * __builtin_amdgcn_sinf(rev);
}
DI void s5_bbar(const Prm& p, int g, int n, int pp, float& re, float& im) {
    const float ar = p.a_re[g * 64 + n], ai = p.a_im[g * 64 + n]; float abr, abi; s5_pow(p, g, n, 1.f, abr, abi);
    const float den = ar * ar + ai * ai, zr = ((abr - 1.f) * ar + abi * ai) / den, zi = (abi * ar - (abr - 1.f) * ai) / den;
    const float br = p.b_re[(g * 64 + n) * 16 + pp], bi = p.b_im[(g * 64 + n) * 16 + pp];
    re = zr * br - zi * bi; im = zr * bi + zi * br;
}
DI void phase_prologue(const Prm& p, LAS unsigned char* lds, int tid, int lane, int wave) {
    const int gw = blockIdx.x * 8 + wave, NGW = gridDim.x * 8, gtid = blockIdx.x * 512 + tid, GT = gridDim.x * 512;
    LAS float* scr = (LAS float*)(lds + wave * 16384);
    constexpr int I1 = 16 * 80, I2 = 8 * 16, I3 = 16 * 32, I4 = 16 * 128, I5 = 64 * 32, I6 = 16 * 96;
    constexpr int NITEMS = I1 + I2 + I3 + I4 + I5 + I6 + I3 + I4 + I5;
    for (int it = gw; it < NITEMS; it += NGW) {
        int r = it;
        if (r < I1) { transpose_item(p.w_in_even, 2560, p.Wt1, 1024, p.ln_mix, scr, r, lane); continue; } r -= I1;
        if (r < I2) { transpose_item(p.w_glu, 512, p.Wglu, 512, nullptr, scr, r, lane); continue; } r -= I2;
        if (r < I3) { transpose_item(p.w_out_even, 1024, p.Wo0, 1024, nullptr, scr, r, lane); continue; } r -= I3;
        if (r < I4) { transpose_item(p.w_up, 4096, p.Wup0, 1024, p.ln_mlp, scr, r, lane); continue; } r -= I4;
        if (r < I5) { transpose_item(p.w_down, 1024, p.Wdn0, 4096, nullptr, scr, r, lane); continue; } r -= I5;
        if (r < I6) { transpose_item(p.w_in_odd, 3072, p.Wqkv, 1024, p.ln_mix + 1024, scr, r, lane); continue; } r -= I6;
        if (r < I3) { transpose_item(p.w_out_odd, 1024, p.Wo1, 1024, nullptr, scr, r, lane); continue; } r -= I3;
        if (r < I4) { transpose_item(p.w_up + (size_t)1024 * 4096, 4096, p.Wup1, 1024, p.ln_mlp + 1024, scr, r, lane); continue; } r -= I4;
        transpose_item(p.w_down + (size_t)4096 * 1024, 1024, p.Wdn1, 4096, nullptr, scr, r, lane);
    }
    for (int row = gw; row < NT; row += NGW) {
        const float* src;
        if (row < NTP) { const int b = row / TP, t = row - b * TP; src = t < 16 ? p.meta + (size_t)t * 1024 : p.x_prompt + ((size_t)b * 4096 + (t - 16)) * 1024; }
        else src = p.x_sample + (size_t)(row - NTP) * 1024;
        float ss = 0.f;
#pragma unroll
        for (int j = 0; j < 4; ++j) { const f32x4 v = ((const f32x4*)src)[lane + 64 * j]; u32x2 o; o.x = pk2(v.x, v.y); o.y = pk2(v.z, v.w);
            const float a0 = bflo(o.x), a1 = bfhi(o.x), a2 = bflo(o.y), a3 = bfhi(o.y); ss += (a0 * a0 + a1 * a1) + (a2 * a2 + a3 * a3);
            ((u32x2*)(p.XB + (size_t)row * 1024))[lane + 64 * j] = o; }
        ss = wave_sum(ss);
        if (lane < 16) p.SSQ[(size_t)row * 16 + lane] = lane == 0 ? ss : 0.f;
        if (lane == 0) p.RINV[row] = rsqrtf(ss * (1.f / 1024.f) + EPSN);
    }
    if (gtid < MP - NT) p.RINV[NT + gtid] = 1.f;
    if (gtid < 512) p.LB[gtid] = 1.f / (1.f + __expf(p.hgrn_lb[512 + gtid] - p.hgrn_lb[gtid]));
    __syncthreads();
    {
        LAS float* zr_ = (LAS float*)lds; LAS float* zi_ = zr_ + 64; LAS float* wr_ = zi_ + 64; LAS float* wi_ = wr_ + 64;
        LAS float* bbr = wi_ + 64; LAS float* bbi = bbr + 1024; LAS float* cwr = bbi + 1024; LAS float* cwi = cwr + 16 * 65;
        for (int pair = blockIdx.x; pair < 512; pair += gridDim.x) { const int g = pair >> 4, tau = pair & 15;
            if (tid < 64) { const int n = tid; const float ar = p.a_re[g * 64 + n], ai = p.a_im[g * 64 + n]; float abr, abi; s5_pow(p, g, n, 1.f, abr, abi);
                const float den = ar * ar + ai * ai; zr_[n] = ((abr - 1.f) * ar + abi * ai) / den; zi_[n] = (abi * ar - (abr - 1.f) * ai) / den;
                float a, b; s5_pow(p, g, n, (float)tau, a, b); wr_[n] = a; wi_[n] = b; }
            __syncthreads();
#pragma unroll
            for (int k = 0; k < 2; ++k) { const int e = tid + 512 * k;
                { const int n = e >> 4; const float br = p.b_re[g * 1024 + e], bi = p.b_im[g * 1024 + e]; bbr[e] = zr_[n] * br - zi_[n] * bi; bbi[e] = zr_[n] * bi + zi_[n] * br; }
                { const int pch = e >> 6, n = e & 63; const float cr = p.c_re[g * 1024 + e], ci = p.c_im[g * 1024 + e]; cwr[pch * 65 + n] = cr * wr_[n] - ci * wi_[n]; cwi[pch * 65 + n] = cr * wi_[n] + ci * wr_[n]; } }
            __syncthreads();
            if (tid < 256) { const int pch = tid >> 4, pp = tid & 15; float acc = 0.f;
#pragma unroll 8
                for (int n = 0; n < 64; ++n) acc += cwr[pch * 65 + n] * bbr[n * 16 + pp] - cwi[pch * 65 + n] * bbi[n * 16 + pp];
                if (tau == 0 && pch == pp) acc += p.ssm_d[g * 16 + pch];
                const bf16_t kv = f2bf(acc);
                p.TG[((g * 16 + tau) * 16 + pch) * 16 + pp] = kv; }
            __syncthreads(); }
    }
    for (int i = gtid; i < 32 * 256 * 64; i += GT) {
        const int g = i >> 14, t = (i >> 10) & 15, pch = (i >> 6) & 15, n = i & 63; float wr_, wi_; s5_pow(p, g, n, (float)(t + 1), wr_, wi_);
        const float cr = p.c_re[(g * 16 + pch) * 64 + n], ci = p.c_im[(g * 16 + pch) * 64 + n];
        *(unsigned*)(p.TG + 131072 + ((size_t)(g * 256 + t * 16 + pch)) * 128 + 2 * n) = pk2(cr * wr_ - ci * wi_, -(cr * wi_ + ci * wr_)); }
    for (int i = gtid; i < 32 * 64 * 256; i += GT) {
        const int g = i >> 14, n = (i >> 8) & 63, s = (i >> 4) & 15, pp = i & 15; float wr_, wi_, br_, bi_; s5_pow(p, g, n, (float)(15 - s), wr_, wi_); s5_bbar(p, g, n, pp, br_, bi_);
        p.HT[((size_t)(g * 128 + 2 * n)) * 256 + s * 16 + pp] = f2bf(wr_ * br_ - wi_ * bi_);
        p.HT[((size_t)(g * 128 + 2 * n + 1)) * 256 + s * 16 + pp] = f2bf(wr_ * bi_ + wi_ * br_); }
    if (gtid < 2048) { float wr_, wi_; s5_pow(p, gtid >> 6, gtid & 63, 16.f, wr_, wi_); p.A16[2 * gtid] = wr_; p.A16[2 * gtid + 1] = wi_; }
}

constexpr int HP = 136, TPI = 72;
constexpr int L_QT = 0, L_QH = 17408, L_KT = 34816, L_KTT = 52224, L_IVT = 70656, L_ATT = 89088, L_SUM = 98304, L_VEC = 100352, L_OB = 0  ;
struct HItem { int row0, L, h, bh; };
DI HItem hgrn_item(int item) {
    HItem it;
    if (item < 2080) { const int bh = item / 65, c = item - bh * 65, b = bh >> 2; it.h = bh & 3; it.bh = bh; it.L = c == 0 ? 16 : 64; it.row0 = b * TP + (c == 0 ? 0 : 16 + 64 * (c - 1)); }
    else { const int s = item - 2080, b = s >> 2; it.h = s & 3; it.bh = 32 + s; it.L = 64; it.row0 = NTP + b * 64; }
    return it;
}
template <bool FULL> DI void hgrn_loadraw(const Prm& p, const HItem& it, int tid, unsigned (&rl)[16], unsigned (&rv)[16], unsigned (&rq)[16]) {
    const int d = tid & 127, t0 = 16 * (tid >> 7), col = it.h * 128 + d;
#pragma unroll
    for (int j = 0; j < 16; ++j) { const int t = t0 + j; const bool valid = t < it.L; const size_t o = (size_t)(it.row0 + t) * 512 + col;
        rl[j] = valid ? (unsigned)p.LOGF[o] : 0u; rv[j] = valid ? (unsigned)p.IV[o] : 0u; if (FULL) rq[j] = valid ? (unsigned)p.Qh[o] : 0u; }
}
template <bool FULL> DI void hgrn_prep(const HItem& it, LAS unsigned char* lds, int tid, const unsigned (&rl)[16], const unsigned (&rv)[16], const unsigned (&rq)[16]) {
    const int d = tid & 127, tq = tid >> 7, t0 = 16 * tq;
    LAS float* sums = (LAS float*)(lds + L_SUM); LAS float* vec = (LAS float*)(lds + L_VEC);
    float cs[16], lf[16];
    float run = 0.f;
#pragma unroll
    for (int j = 0; j < 16; ++j) { lf[j] = h2f((unsigned short)rl[j]); run += lf[j]; cs[j] = run; }
    sums[tq * 128 + d] = run;
    { LAS u32x4v* dst = (LAS u32x4v*)(lds + L_IVT + (d * TPI + t0) * 2); u32x4v a, b;
        a.x = rv[0] | (rv[1] << 16); a.y = rv[2] | (rv[3] << 16); a.z = rv[4] | (rv[5] << 16); a.w = rv[6] | (rv[7] << 16);
        b.x = rv[8] | (rv[9] << 16); b.y = rv[10] | (rv[11] << 16); b.z = rv[12] | (rv[13] << 16); b.w = rv[14] | (rv[15] << 16); dst[0] = a; dst[1] = b; }
    __syncthreads();
    const float s0 = sums[d], s1 = sums[128 + d], s2 = sums[256 + d], s3 = sums[384 + d];
    const float off = tq == 0 ? 0.f : tq == 1 ? s0 : tq == 2 ? s0 + s1 : s0 + s1 + s2, r = s0 + s1, bL = r + s2 + s3;
    if (tq == 0) { vec[d] = r; vec[128 + d] = bL; }
    unsigned ktp[8]; float kprev = 0.f;
#pragma unroll
    for (int j = 0; j < 16; ++j) { const int t = t0 + j; const bool valid = t < it.L; const float b = off + cs[j];
        const float kt = valid ? (1.f - __expf(lf[j])) * __expf(r - b) : 0.f;
        if (j & 1) ktp[j >> 1] = pk2(kprev, kt); else kprev = kt;
        if (FULL) { const float qv = bf2f((unsigned short)rq[j]);
            *(LAS unsigned short*)(lds + L_KT + (t * HP + d) * 2) = f2bf(kt);
            *(LAS unsigned short*)(lds + L_QT + (t * HP + d) * 2) = f2bf(qv * __expf(b - r));
            *(LAS unsigned short*)(lds + L_QH + (t * HP + d) * 2) = f2bf(qv * __expf(b)); } }
    if (!FULL) { LAS u32x4v* dst = (LAS u32x4v*)(lds + L_KTT + (d * TPI + t0) * 2); u32x4v a, b; a.x = ktp[0]; a.y = ktp[1]; a.z = ktp[2]; a.w = ktp[3]; b.x = ktp[4]; b.y = ktp[5]; b.z = ktp[6]; b.w = ktp[7]; dst[0] = a; dst[1] = b; }
    __syncthreads();
}
#define MFMA16(a, b, c) __builtin_amdgcn_mfma_f32_16x16x32_bf16((a), (b), (c), 0, 0, 0)
#define MFMA32(a, b, c) __builtin_amdgcn_mfma_f32_32x32x16_bf16((a), (b), (c), 0, 0, 0)
DI void hgrn_b1_all(const Prm& p, LAS unsigned char* lds, int tid, int lane, int wave) {
    const int fr = lane & 15, fq = lane >> 4;
    int item = blockIdx.x; if (item >= NITEM_H) return;
    unsigned rl[16], rv[16], rq[16];
    hgrn_loadraw<false>(p, hgrn_item(item), tid, rl, rv, rq);
    while (item < NITEM_H) {
        const HItem it = hgrn_item(item);
        hgrn_prep<false>(it, lds, tid, rl, rv, rq);
        const int next = item + gridDim.x;
        if (next < NITEM_H) hgrn_loadraw<false>(p, hgrn_item(next), tid, rl, rv, rq);
        const LAS float* vec = (const LAS float*)(lds + L_VEC);
        bf16x8 a[2];
#pragma unroll
        for (int ks = 0; ks < 2; ++ks) a[ks] = *(const LAS bf16x8*)(lds + L_KTT + ((16 * wave + fr) * TPI + 32 * ks + 8 * fq) * 2);
        float e2[4];
#pragma unroll
        for (int j = 0; j < 4; ++j) { const int d = 16 * wave + 4 * fq + j; e2[j] = __expf(vec[128 + d] - vec[d]); }
#pragma unroll
        for (int vt = 0; vt < 8; ++vt) { f32x4 acc = {0.f, 0.f, 0.f, 0.f};
#pragma unroll
            for (int ks = 0; ks < 2; ++ks) { const bf16x8 b = *(const LAS bf16x8*)(lds + L_IVT + ((16 * vt + fr) * TPI + 32 * ks + 8 * fq) * 2); acc = MFMA16(a[ks], b, acc); }
            u32x2 o; o.x = pk2(acc[0] * e2[0], acc[1] * e2[1]); o.y = pk2(acc[2] * e2[2], acc[3] * e2[3]);
            *(u32x2*)(p.UT + (size_t)item * 16384 + (16 * vt + fr) * 128 + 16 * wave + 4 * fq) = o; }
        if (tid < 128) p.AL[(size_t)item * 128 + tid] = __expf(vec[128 + tid]);
        __syncthreads();
        item = next;
    }
}
template <int NB> DI void hgrn_b2_steps(const Prm& p, int item, int v, int d4, float (&S)[4]) {
    u32x2 uu[NB]; f32x4 al[NB];
#pragma unroll
    for (int i = 0; i < NB; ++i) { uu[i] = *(const u32x2*)(p.UT + (size_t)(item + i) * 16384 + v * 128 + d4); al[i] = *(const f32x4*)(p.AL + (size_t)(item + i) * 128 + d4); }
#pragma unroll
    for (int i = 0; i < NB; ++i) { u32x2 o; o.x = pk2(S[0], S[1]); o.y = pk2(S[2], S[3]);
        *(u32x2*)(p.UT + (size_t)(item + i) * 16384 + v * 128 + d4) = o;
        S[0] = al[i][0] * S[0] + bflo(uu[i].x); S[1] = al[i][1] * S[1] + bfhi(uu[i].x); S[2] = al[i][2] * S[2] + bflo(uu[i].y); S[3] = al[i][3] * S[3] + bfhi(uu[i].y); }
}
DI void hgrn_b2(const Prm& p, int gtid, int GT) {
    for (int idx = gtid; idx < 64 * 4096; idx += GT) {
        const int bhx = idx >> 12, e = idx & 4095, v = e >> 5, d4 = (e & 31) * 4; const bool smp = bhx >= 32;
        float S[4] = {0.f, 0.f, 0.f, 0.f};
        if (smp) {
#pragma unroll
            for (int j = 0; j < 4; ++j) S[j] = p.state_hgrn[((size_t)(bhx - 32) * 128 + d4 + j) * 128 + v];
            hgrn_b2_steps<1>(p, 2080 + (bhx - 32), v, d4, S); }
        else { for (int c0 = 0; c0 < 65; c0 += 13) hgrn_b2_steps<13>(p, bhx * 65 + c0, v, d4, S); }
        float* dst = p.out + (smp ? O_HGS + (size_t)(bhx - 32) * 16384 : O_HGP + (size_t)bhx * 16384);
#pragma unroll
        for (int j = 0; j < 4; ++j) dst[(d4 + j) * 128 + v] = S[j];
    }
}
DI void hgrn_b3_all(const Prm& p, LAS unsigned char* lds, int tid, int lane, int wave) {
    const int fr = lane & 15, fq = lane >> 4;
    int item = blockIdx.x; if (item >= NITEM_H) return;
    unsigned rl[16], rv[16], rq[16];
    hgrn_loadraw<true>(p, hgrn_item(item), tid, rl, rv, rq);
    const int nt_ = tid >> 3, nsg = tid & 7;
    while (item < NITEM_H) {
        const HItem it = hgrn_item(item);
        bf16x8 sf[4][4];
#pragma unroll
        for (int i = 0; i < 4; ++i)
#pragma unroll
            for (int ks = 0; ks < 4; ++ks) sf[i][ks] = *(const bf16x8*)(p.UT + (size_t)item * 16384 + (16 * (4 * (wave >> 2) + i) + fr) * 128 + 32 * ks + 8 * fq);
        const size_t grow = (size_t)(it.row0 + (nt_ < it.L ? nt_ : 0)); const int gc0 = it.h * 128 + 16 * nsg;
        const u32x4v g0 = *(const u32x4v*)(p.GS + grow * 512 + gc0), g1 = *(const u32x4v*)(p.GS + grow * 512 + gc0 + 8);
        hgrn_prep<true>(it, lds, tid, rl, rv, rq);
        const int next = item + gridDim.x;
        if (next < NITEM_H) hgrn_loadraw<true>(p, hgrn_item(next), tid, rl, rv, rq);
        {
            const int tt = wave >> 1;
#pragma unroll
            for (int i = 0; i < 2; ++i) { const int st = 2 * (wave & 1) + i; f32x4 acc = {0.f, 0.f, 0.f, 0.f};
#pragma unroll
                for (int ks = 0; ks < 4; ++ks) { const bf16x8 a = *(const LAS bf16x8*)(lds + L_KT + ((16 * st + fr) * HP + 32 * ks + 8 * fq) * 2);
                    const bf16x8 b = *(const LAS bf16x8*)(lds + L_QT + ((16 * tt + fr) * HP + 32 * ks + 8 * fq) * 2); acc = MFMA16(a, b, acc); }
                const int t = 16 * tt + fr, s0 = 16 * st + 4 * fq;
                u32x2 o; o.x = pk2(s0 <= t ? acc[0] : 0.f, s0 + 1 <= t ? acc[1] : 0.f); o.y = pk2(s0 + 2 <= t ? acc[2] : 0.f, s0 + 3 <= t ? acc[3] : 0.f);
                *(LAS u32x2*)(lds + L_ATT + (t * TPI + s0) * 2) = o; }
        }
        __syncthreads();
        f32x4 oacc[4];
        {   const int tt = wave & 3;
            bf16x8 aa[2], aq[4];
#pragma unroll
            for (int ks = 0; ks < 2; ++ks) aa[ks] = *(const LAS bf16x8*)(lds + L_ATT + ((16 * tt + fr) * TPI + 32 * ks + 8 * fq) * 2);
#pragma unroll
            for (int ks = 0; ks < 4; ++ks) aq[ks] = *(const LAS bf16x8*)(lds + L_QH + ((16 * tt + fr) * HP + 32 * ks + 8 * fq) * 2);
#pragma unroll
            for (int i = 0; i < 4; ++i) { const int vt = 4 * (wave >> 2) + i; f32x4 acc = {0.f, 0.f, 0.f, 0.f};
#pragma unroll
                for (int ks = 0; ks < 2; ++ks) { const bf16x8 b = *(const LAS bf16x8*)(lds + L_IVT + ((16 * vt + fr) * TPI + 32 * ks + 8 * fq) * 2); acc = MFMA16(aa[ks], b, acc); }
#pragma unroll
                for (int ks = 0; ks < 4; ++ks) acc = MFMA16(aq[ks], sf[i][ks], acc);
                oacc[i] = acc; }
        }
        f32x4 gn[4];
#pragma unroll
        for (int j = 0; j < 4; ++j) gn[j] = ((const f32x4*)(p.hgrn_norm + 16 * nsg))[j];
        __syncthreads();
        {   const int tt = wave & 3; LAS float* ob = (LAS float*)(lds + L_OB);
#pragma unroll
            for (int i = 0; i < 4; ++i) { const int v = 16 * (4 * (wave >> 2) + i) + fr;
#pragma unroll
                for (int j = 0; j < 4; ++j) ob[(16 * tt + 4 * fq + j) * 132 + v] = oacc[i][j]; }
        }
        __syncthreads();
        {   const int t = nt_, sg = nsg; const LAS float* ob = (const LAS float*)(lds + L_OB) + t * 132 + 16 * sg;
            f32x4 x[4]; float ss = 0.f;
#pragma unroll
            for (int j = 0; j < 4; ++j) { x[j] = ((const LAS f32x4*)ob)[j]; ss += (x[j].x * x[j].x + x[j].y * x[j].y) + (x[j].z * x[j].z + x[j].w * x[j].w); }
            ss += __shfl_xor(ss, 1); ss += __shfl_xor(ss, 2); ss += __shfl_xor(ss, 4);
            const float rr = rsqrtf(ss * (1.f / 128.f) + EPSN);
            if (t < it.L) { const size_t row = it.row0 + t; const int c0 = it.h * 128 + 16 * sg;
                const f32x4 n0 = gn[0], n1 = gn[1], n2 = gn[2], n3 = gn[3];
                u32x4v o0, o1;
                o0.x = pk2(x[0].x * rr * n0.x * bflo(g0.x), x[0].y * rr * n0.y * bfhi(g0.x)); o0.y = pk2(x[0].z * rr * n0.z * bflo(g0.y), x[0].w * rr * n0.w * bfhi(g0.y));
                o0.z = pk2(x[1].x * rr * n1.x * bflo(g0.z), x[1].y * rr * n1.y * bfhi(g0.z)); o0.w = pk2(x[1].z * rr * n1.z * bflo(g0.w), x[1].w * rr * n1.w * bfhi(g0.w));
                o1.x = pk2(x[2].x * rr * n2.x * bflo(g1.x), x[2].y * rr * n2.y * bfhi(g1.x)); o1.y = pk2(x[2].z * rr * n2.z * bflo(g1.y), x[2].w * rr * n2.w * bfhi(g1.y));
                o1.z = pk2(x[3].x * rr * n3.x * bflo(g1.z), x[3].y * rr * n3.y * bfhi(g1.z)); o1.w = pk2(x[3].z * rr * n3.z * bflo(g1.w), x[3].w * rr * n3.w * bfhi(g1.w));
                *(u32x4v*)(p.CAT + row * 1024 + c0) = o0; *(u32x4v*)(p.CAT + row * 1024 + c0 + 8) = o1; }
        }
        __syncthreads();
        item = next;
    }
}
DI void s5_load_u(const Prm& p, int mt, int g, int lane, bf16x8 (&uf)[8]) {
    const int fr = lane & 15, fq = lane >> 4; int col = 16 * mt + fr; if (col >= NCOL) col = NCOL - 1;
#pragma unroll
    for (int ks = 0; ks < 8; ++ks) uf[ks] = *(const bf16x8*)(p.U + ((size_t)(16 * col + 2 * ks + (fq >> 1))) * 512 + 16 * g + 8 * (fq & 1));
}
DI void s5_b(const Prm& p, int gw, int NGW, int lane) {
    const int fr = lane & 15, fq = lane >> 4;
    for (int task = gw; task < 131 * 32; task += NGW) { const int mt = task >> 5, g = task & 31;
        bf16x8 uf[8]; s5_load_u(p, mt, g, lane, uf);
#pragma unroll
        for (int nt = 0; nt < 8; ++nt) { f32x4 acc = {0.f, 0.f, 0.f, 0.f};
#pragma unroll
            for (int ks = 0; ks < 8; ++ks) { const bf16x8 b = *(const bf16x8*)(p.HT + ((size_t)(g * 128 + 16 * nt + fr)) * 256 + 32 * ks + 8 * fq); acc = MFMA16(uf[ks], b, acc); }
#pragma unroll
            for (int j = 0; j < 4; ++j) { const int col = 16 * mt + 4 * fq + j; if (col < NCOL) p.XLOC[(size_t)col * 4096 + g * 128 + 16 * nt + fr] = acc[j]; } }
    }
}
template <int NB> DI void s5_c_steps(const Prm& p, int col, size_t base, float ar, float ai, float& xr, float& xi) {
    f32x2v xl[NB];
#pragma unroll
    for (int i = 0; i < NB; ++i) xl[i] = *(const f32x2v*)(p.XLOC + (size_t)(col + i) * 4096 + base);
#pragma unroll
    for (int i = 0; i < NB; ++i) { *(unsigned*)(p.XPREV + (size_t)(col + i) * 4096 + base) = pk2(xr, xi);
        const float nr = ar * xr - ai * xi + xl[i].x, ni = ar * xi + ai * xr + xl[i].y; xr = nr; xi = ni; }
}
DI void s5_c(const Prm& p, int gtid) {
    if (gtid >= 16 * 2048) return;
    const int seq = gtid >> 11, g = (gtid >> 6) & 31, n = gtid & 63; const bool smp = seq >= 8; const int b = seq & 7;
    float xr = 0.f, xi = 0.f; if (smp) { xr = p.ssm_re0[(b * 32 + g) * 64 + n]; xi = p.ssm_im0[(b * 32 + g) * 64 + n]; }
    const float ar = p.A16[2 * (g * 64 + n)], ai = p.A16[2 * (g * 64 + n) + 1];
    const size_t base = (size_t)g * 128 + 2 * n;
    if (smp) s5_c_steps<4>(p, 2056 + 4 * b, base, ar, ai, xr, xi);
    else { for (int c0 = 0; c0 < 256; c0 += 16) s5_c_steps<16>(p, 257 * b + c0, base, ar, ai, xr, xi); s5_c_steps<1>(p, 257 * b + 256, base, ar, ai, xr, xi); }
    const size_t o = (size_t)(b * 32 + g) * 64 + n;
    p.out[(smp ? O_SRS : O_SRP) + o] = xr; p.out[(smp ? O_SIS : O_SIP) + o] = xi;
}
DI f32x2v gelu_pk(f32x2v v) {
    const f32x2v av = __builtin_elementwise_abs(v), d = av * 0.2316418882f + 1.0f;
    f32x2v t; t.x = __builtin_amdgcn_rcpf(d.x); t.y = __builtin_amdgcn_rcpf(d.y);
    f32x2v q = t * 0.5307027145f + (-0.7265760135f); q = q * t + 0.7107068705f; q = q * t + (-0.142248368f); q = q * t + 0.127414796f; q = q * t;
    const f32x2v s = (v * v) * (-0.72134752044f);
    f32x2v e; e.x = __builtin_amdgcn_exp2f(s.x); e.y = __builtin_amdgcn_exp2f(s.y);
    const f32x2v m = v * (q * e), r = v - m;
    f32x2v o; o.x = v.x < 0.f ? m.x : r.x; o.y = v.y < 0.f ? m.y : r.y; return o;
}
DI void s5_d(const Prm& p, int gw, int NGW, int lane) {
    const int fr = lane & 15, fq = lane >> 4;
    for (int task = gw; task < 131 * 32; task += NGW) { const int mt = task >> 5, g = task & 31;
        bf16x8 uf[8], xf[4]; s5_load_u(p, mt, g, lane, uf);
        int colc = 16 * mt + fr; if (colc >= NCOL) colc = NCOL - 1;
#pragma unroll
        for (int ks = 0; ks < 4; ++ks) xf[ks] = *(const bf16x8*)(p.XPREV + (size_t)colc * 4096 + g * 128 + 32 * ks + 8 * fq);
        const bf16_t* tg = p.TG + ((size_t)(g * 256 + fr)) * 384 + 8 * fq;
        const bool ok = 16 * mt + fr < NCOL;
#pragma unroll
        for (int t = 0; t < 16; ++t) { f32x4 acc = {0.f, 0.f, 0.f, 0.f};
#pragma unroll
            for (int ks = 0; ks < 8; ++ks) if (ks <= (t >> 1)) { const bf16x8 a = *(const bf16x8*)(tg + (size_t)t * 16 * 384 + 32 * ks); acc = MFMA16(a, uf[ks], acc); }
#pragma unroll
            for (int ks = 0; ks < 4; ++ks) { const bf16x8 a = *(const bf16x8*)(tg + (size_t)t * 16 * 384 + 256 + 32 * ks); acc = MFMA16(a, xf[ks], acc); }
            const f32x2v y0 = gelu_pk((f32x2v){acc[0], acc[1]}), y1 = gelu_pk((f32x2v){acc[2], acc[3]});
            u32x2 o; o.x = pk2(y0.x, y0.y); o.y = pk2(y1.x, y1.y);
            if (ok) *(u32x2*)(p.YG + ((size_t)(16 * (16 * mt + fr) + t)) * 512 + 16 * g + 4 * fq) = o; }
    }
}

DI void s5_b_lds(const Prm& p, LAS unsigned char* lds, int tid, int lane, int wave) {
    const int fr = lane & 15, fq = lane >> 4;
    for (int gp = blockIdx.x; gp < 256; gp += gridDim.x) { const int g = gp & 31, part = gp >> 5;
        for (int i = tid; i < 128 * 32; i += 512) { const int row = i >> 5, ch = i & 31;
            *(LAS u32x4v*)(lds + row * 528 + ch * 16) = *(const u32x4v*)(p.HT + ((size_t)(g * 128 + row)) * 256 + ch * 8); }
        __syncthreads();
        for (int mt = part + 8 * wave; mt < 131; mt += 64) {
            bf16x8 uf[8]; s5_load_u(p, mt, g, lane, uf);
#pragma unroll 1
            for (int nt = 0; nt < 8; ++nt) { f32x4 acc = {0.f, 0.f, 0.f, 0.f};
#pragma unroll
                for (int ks = 0; ks < 8; ++ks) { const bf16x8 b = *(const LAS bf16x8*)(lds + (16 * nt + fr) * 528 + 64 * ks + 16 * fq); acc = MFMA16(uf[ks], b, acc); }
#pragma unroll
                for (int j = 0; j < 4; ++j) { const int col = 16 * mt + 4 * fq + j; if (col < NCOL) p.XLOC[(size_t)col * 4096 + g * 128 + 16 * nt + fr] = acc[j]; } }
        }
        __syncthreads(); }
}
DI void s5_d_lds(const Prm& p, LAS unsigned char* lds, int tid, int lane, int wave) {
    const int fr = lane & 15, fq = lane >> 4;
    for (int gp = blockIdx.x; gp < 256; gp += gridDim.x) { const int g = gp & 31, part = gp >> 5;
        { const int row = tid >> 1, hf = tid & 1;
            *(LAS u32x4v*)(lds + row * 48 + hf * 16) = *(const u32x4v*)(p.TG + ((size_t)(g * 256 + row)) * 16 + hf * 8); }
        for (int i = tid; i < 256 * 16; i += 512) { const int row = i >> 4, ch = i & 15;
            *(LAS u32x4v*)(lds + 12288 + row * 272 + ch * 16) = *(const u32x4v*)(p.TG + 131072 + ((size_t)(g * 256 + row)) * 128 + ch * 8); }
        __syncthreads();
        const int lb = fr * 48 + (fq & 1) * 16, hi = fq >> 1;
        for (int mt = part + 8 * wave; mt < 131; mt += 64) {
            bf16x8 uf[8], xf[4]; s5_load_u(p, mt, g, lane, uf);
            int colc = 16 * mt + fr; if (colc >= NCOL) colc = NCOL - 1;
#pragma unroll
            for (int ks = 0; ks < 4; ++ks) xf[ks] = *(const bf16x8*)(p.XPREV + (size_t)colc * 4096 + g * 128 + 32 * ks + 8 * fq);
            const bool ok = 16 * mt + fr < NCOL;
#pragma unroll 1
            for (int t = 0; t < 16; ++t) { f32x4 acc = {0.f, 0.f, 0.f, 0.f};
#pragma unroll
                for (int ks = 0; ks < 8; ++ks) if (ks <= (t >> 1)) {
                    const int tau = t - 2 * ks - hi;
                    union { bf16x8 v; u32x4v u; } a; a.v = *(const LAS bf16x8*)(lds + (tau < 0 ? 0 : tau) * 768 + lb);
                    if (tau < 0) a.u = (u32x4v){0u, 0u, 0u, 0u};
                    acc = MFMA16(a.v, uf[ks], acc); }
#pragma unroll
                for (int ks = 0; ks < 4; ++ks) { const bf16x8 a = *(const LAS bf16x8*)(lds + 12288 + (t * 16 + fr) * 272 + 64 * ks + 16 * fq); acc = MFMA16(a, xf[ks], acc); }
                const f32x2v y0 = gelu_pk((f32x2v){acc[0], acc[1]}), y1 = gelu_pk((f32x2v){acc[2], acc[3]});
                u32x2 o; o.x = pk2(y0.x, y0.y); o.y = pk2(y1.x, y1.y);
                if (ok) *(u32x2*)(p.YG + ((size_t)(16 * (16 * mt + fr) + t)) * 512 + 16 * g + 4 * fq) = o; }
        }
        __syncthreads(); }
}
DI void cache_convert(const Prm& p, int gtid, int GT) {
    for (size_t i = (size_t)gtid; i < (size_t)8 * 1024 * 256; i += (size_t)GT) {
        const size_t row = i >> 8; const int c4 = (int)(i & 255) * 4, b = (int)(row >> 10), pos = (int)(row & 1023), h = c4 >> 7, d = c4 & 127;
        const f32x4 k = *(const f32x4*)(p.cache_k + row * 1024 + c4); u32x2 o; o.x = pk2(k.x, k.y); o.y = pk2(k.z, k.w);
        *(u32x2*)(p.KS + kf_index(b * 8 + h, 34, pos, d)) = o;
        const f32x4 v = *(const f32x4*)(p.cache_v + row * 1024 + c4); bf16_t* vt = p.VTS + vf_index(b * 8 + h, 34, pos, d);
        vt[0] = f2bf(v.x); vt[8] = f2bf(v.y); vt[16] = f2bf(v.z); vt[24] = f2bf(v.w); }
}
DI void attn_phase(const Prm& p, int gw, int NGW, int lane) {
    const int q = lane & 31, half = lane >> 5;
    for (int it = gw; it < 8256 + 128; it += NGW) {
        bool smp; int b, h, qb;
        if (it < 8064) { smp = false; b = it / 1008; const int rem = it - b * 1008; h = rem / 126; qb = 3 + rem - h * 126; }
        else if (it < 8192) { const int s = it - 8064; smp = true; b = s >> 4; h = (s >> 1) & 7; qb = s & 1; }
        else { const int s = it - 8192; smp = false; b = s / 24; const int rem = s - b * 24; h = rem / 3; qb = rem - h * 3; }
        const size_t tbase = (size_t)(b * 8 + h) * (smp ? 34 : 129) * 4096 + lane * 8;
        const bf16_t* Kb = (smp ? p.KS : p.KP) + tbase; const bf16_t* Vb = (smp ? p.VTS : p.VTP) + tbase;
        const int qpos0 = (smp ? 1024 : 0) + 32 * qb, qrow0 = smp ? NTP + b * 64 + 32 * qb : b * TP + 32 * qb;
        const int qpos = qpos0 + q; const bool qvalid = smp || qpos < TP; const size_t qrow = qvalid ? qrow0 + q : qrow0;
        bf16x8 qf[8];
#pragma unroll
        for (int ks = 0; ks < 8; ++ks) qf[ks] = *(const bf16x8*)(p.Q + qrow * 1024 + h * 128 + 16 * ks + 8 * half);
        f32x16 o[4];
#pragma unroll
        for (int db = 0; db < 4; ++db)
#pragma unroll
            for (int e = 0; e < 16; ++e) o[db][e] = 0.f;
        float C = 1.f;
        for (int kt = (qpos0 + 30) >> 5; kt >= 0; --kt) {
            f32x16 s;
#pragma unroll
            for (int e = 0; e < 16; ++e) s[e] = 0.f;
            const bf16_t* kr = Kb + (size_t)kt * 4096; const bf16_t* vr = Vb + (size_t)kt * 4096;
            bf16x8 kf[8], vf[8];
#pragma unroll
            for (int ks = 0; ks < 8; ++ks) kf[ks] = *(const bf16x8*)(kr + ks * 512);
#pragma unroll
            for (int ks = 0; ks < 8; ++ks) vf[ks] = *(const bf16x8*)(vr + ks * 512);
#pragma unroll
            for (int ks = 0; ks < 8; ++ks) s = MFMA32(kf[ks], qf[ks], s);
            float pr[16], be[16], G[4], Gp[4];
#pragma unroll
            for (int i = 0; i < 4; ++i) {
#pragma unroll
                for (int j = 0; j < 4; ++j) { const int key = 32 * kt + 8 * i + 4 * half + j; const bool valid = key < qpos;
                    float z = s[4 * i + j] * 0.08838834764831845f; z = fminf(fmaxf(z, -80.f), 80.f);
                    const float e = __expf(z), pp = __builtin_amdgcn_rcpf(1.f + e); pr[4 * i + j] = valid ? pp : 1.f; be[4 * i + j] = valid ? e * pp : 0.f; }
                G[i] = (pr[4 * i] * pr[4 * i + 1]) * (pr[4 * i + 2] * pr[4 * i + 3]); }
#pragma unroll
            for (int i = 0; i < 4; ++i) Gp[i] = __shfl_xor(G[i], 32);
            float w[16]; float E1 = 1.f;
#pragma unroll
            for (int i = 3; i >= 0; --i) { const float Glo = half ? Gp[i] : G[i], Ghi = half ? G[i] : Gp[i];
                float suf = C * (half ? E1 : E1 * Ghi);
#pragma unroll
                for (int j = 3; j >= 0; --j) { w[4 * i + j] = be[4 * i + j] * suf; suf *= pr[4 * i + j]; }
                E1 *= Glo * Ghi; }
            C *= E1;
#pragma unroll
            for (int c = 0; c < 2; ++c) { union { bf16x8 v; unsigned u[4]; } wf;
#pragma unroll
                for (int e = 0; e < 4; ++e) wf.u[e] = pk2(w[8 * c + 2 * e], w[8 * c + 2 * e + 1]);
#pragma unroll
                for (int db = 0; db < 4; ++db) o[db] = MFMA32(vf[4 * c + db], wf.v, o[db]); }
            if (__all(C < 1e-24f)) break;
        }
        if (qvalid) {
#pragma unroll
            for (int db = 0; db < 4; ++db)
#pragma unroll
                for (int i = 0; i < 4; ++i) { u32x2 ov; ov.x = pk2(o[db][4 * i], o[db][4 * i + 1]); ov.y = pk2(o[db][4 * i + 2], o[db][4 * i + 3]);
                    *(u32x2*)(p.O + qrow * 1024 + h * 128 + 32 * db + 8 * i + 4 * half) = ov; } }
    }
}
DI void final_norm(const Prm& p, int gw, int NGW, int lane) {
    for (int r = gw; r < 32768 + 512; r += NGW) {
        int grow; float* dst;
        if (r < 32768) { const int b = r >> 12, t = r & 4095; grow = b * TP + 16 + t; dst = p.out + O_YP + (size_t)r * 1024; } else { grow = NTP + (r - 32768); dst = p.out + O_YS + (size_t)(r - 32768) * 1024; }
        u32x2 x[4];
#pragma unroll
        for (int j = 0; j < 4; ++j) x[j] = ((const u32x2*)(p.XB + (size_t)grow * 1024))[lane + 64 * j];
        const float rr = row_rinv(p.SSQ, grow);
#pragma unroll
        for (int j = 0; j < 4; ++j) { f32x4 v; v.x = bflo(x[j].x); v.y = bfhi(x[j].x); v.z = bflo(x[j].y); v.w = bfhi(x[j].y); ((f32x4*)dst)[lane + 64 * j] = v * rr * ((const f32x4*)p.ln_final)[lane + 64 * j]; }
    }
}

#define XB_TMO      128
#define XB_XCNT(j)  (256  + 64 * (j))
#define XB_XSUB(j)  (1280 + 64 * (j))
#define XB_XGEN(j)  (2304 + 64 * (j))
#define XB_TOP      3328
#define XB_TOPGEN   3392
#define XCD_BAR_WORDS 3456
#define XB_SPIN_CAP (1u << 18)
DI unsigned xb_ld(unsigned* p) { return __hip_atomic_load(p, __ATOMIC_RELAXED, __HIP_MEMORY_SCOPE_AGENT); }
DI unsigned xb_add(unsigned* p, unsigned v) { return __hip_atomic_fetch_add(p, v, __ATOMIC_RELAXED, __HIP_MEMORY_SCOPE_AGENT); }
DI unsigned xb_xcc_id() { return (unsigned)__builtin_amdgcn_s_getreg((3 << 11) | 20) & 0xFu; }
#define XB_SPIN(cond, bar) do { unsigned _sp = 0; while (cond) { __builtin_amdgcn_s_sleep(1); \
    if ((++_sp & 255u) == 0u) { if (xb_ld(&(bar)[XB_TMO])) break; if (_sp > XB_SPIN_CAP) { atomicAdd(&(bar)[XB_TMO], 1u); break; } } } } while (0)
struct XcdBarrier { unsigned* bar; unsigned x; volatile LAS unsigned* st; };
DI XcdBarrier xcd_barrier_post(unsigned* bar, volatile LAS unsigned* st) {
    XcdBarrier b; b.bar = bar; b.x = xb_xcc_id(); b.st = st;
    if (threadIdx.x == 0) (void)xb_add(&bar[XB_XCNT(b.x)], 1u);
    return b;
}
DI void xcd_barrier_complete(unsigned* bar, unsigned x, unsigned& nloc, unsigned& nx) {
    const unsigned G = gridDim.x * gridDim.y * gridDim.z;
    unsigned sum, cnt, mine, sp = 0u;
    for (;;) {
        sum = 0u; cnt = 0u; mine = 0u;
#pragma unroll
        for (unsigned j = 0; j < 16; ++j) { const unsigned c = xb_ld(&bar[XB_XCNT(j)]); sum += c; cnt += (c > 0u) ? 1u : 0u; mine = (j == x) ? c : mine; }
        if (sum == G) break;
        __builtin_amdgcn_s_sleep(1);
        if ((++sp & 255u) == 0u) { if (xb_ld(&bar[XB_TMO])) break; if (sp > XB_SPIN_CAP) { atomicAdd(&bar[XB_TMO], 1u); break; } }
    }
    nloc = mine > 0u ? mine : 1u; nx = cnt > 0u ? cnt : 1u;
}
DI void xcd_barrier(const XcdBarrier& b) {
    asm volatile("s_waitcnt vmcnt(0)" ::: "memory");
    __syncthreads();
    if (threadIdx.x == 0) {
        unsigned* bar = b.bar;
        __builtin_amdgcn_s_waitcnt(0);
        unsigned nloc = b.st[0], nx = b.st[1];
        if (nloc == 0u) { xcd_barrier_complete(bar, b.x, nloc, nx); b.st[0] = nloc; b.st[1] = nx; }
        const unsigned old = xb_add(&bar[XB_XSUB(b.x)], 1u);
        const unsigned gen = old / nloc;
        if (old + 1u == (gen + 1u) * nloc) {
            __builtin_amdgcn_fence(__ATOMIC_RELEASE, "agent");
            asm volatile("s_waitcnt vmcnt(0)" ::: "memory");
            const unsigned og = xb_add(&bar[XB_TOP], 1u);
            const unsigned tg = og / nx;
            if (og + 1u == (tg + 1u) * nx) xb_add(&bar[XB_TOPGEN], 1u);
            else XB_SPIN(xb_ld(&bar[XB_TOPGEN]) == tg, bar);
            __builtin_amdgcn_fence(__ATOMIC_ACQUIRE, "agent");
            xb_add(&bar[XB_XGEN(b.x)], 1u);
            asm volatile("s_waitcnt vmcnt(0)" ::: "memory");
        } else {
            XB_SPIN(xb_ld(&bar[XB_XGEN(b.x)]) == gen, bar);
            __builtin_amdgcn_fence(__ATOMIC_ACQUIRE, "agent");
            asm volatile("s_waitcnt vmcnt(0)" ::: "memory");
        }
    }
    __syncthreads();
}
constexpr int LDS_BYTES = 131072 + 256;
__global__ void __launch_bounds__(512, 2) fwd_megakernel(Prm p) {
    extern __shared__ __attribute__((aligned(16))) unsigned char shm[];
    LAS unsigned char* lds = (LAS unsigned char*)shm;
    cg::grid_group grid = cg::this_grid();
    const int tid = threadIdx.x, lane = tid & 63, wave = __builtin_amdgcn_readfirstlane(tid >> 6);
    const int gw = blockIdx.x * 8 + wave, NGW = gridDim.x * 8, gtid = blockIdx.x * 512 + tid, GT = gridDim.x * 512;
    volatile LAS unsigned* xst = (volatile LAS unsigned*)(lds + 131072);
    if (tid == 0) { xst[0] = 0u; xst[1] = 0u; }
    __syncthreads();
    const XcdBarrier xb = xcd_barrier_post(p.BAR, xst);
    phase_prologue(p, lds, tid, lane, wave);
    grid.sync();
    { EpiIn0 E; E.SSQ = p.SSQ; E.RINV = p.RINV; E.LB = p.LB; E.Qh = p.Qh; E.IV = p.IV; E.GS = p.GS; E.U = p.U; E.LOGF = p.LOGF; run_gemm(lds, p.XB, p.Wt1, 2560, 1024, E); }
    xcd_barrier(xb);
    hgrn_b1_all(p, lds, tid, lane, wave);
    s5_b_lds(p, lds, tid, lane, wave);
    xcd_barrier(xb);
    hgrn_b2(p, gtid, GT);
    s5_c(p, gtid);
    xcd_barrier(xb);
    hgrn_b3_all(p, lds, tid, lane, wave);
    s5_d_lds(p, lds, tid, lane, wave);
    xcd_barrier(xb);
    { EpiGlu E; E.YG = p.YG; E.CAT = p.CAT; run_gemm(lds, p.YG, p.Wglu, 512, 512, E); }
    xcd_barrier(xb);
    { EpiRes E; E.XB = p.XB; E.SSQ = p.SSQ; run_gemm_split(lds, p.CAT, p.Wo0, 1024, 1024, E, (float*)p.H); xcd_barrier(xb); gemm_fixup(1024, 1024, E, (const float*)p.H, tid); rinv_pass(p, 1024, tid); }
    xcd_barrier(xb);
    { EpiUp E; E.SSQ = p.SSQ; E.RINV = p.RINV; E.H = p.H; run_gemm(lds, p.XB, p.Wup0, 4096, 1024, E); }
    xcd_barrier(xb);
    { EpiRes E; E.XB = p.XB; E.SSQ = p.SSQ; run_gemm_split(lds, p.H, p.Wdn0, 1024, 4096, E, (float*)p.CAT); xcd_barrier(xb); gemm_fixup(1024, 4096, E, (const float*)p.CAT, tid); rinv_pass(p, 4096, tid); }
    xcd_barrier(xb);
    { EpiQkv E; E.SSQ = p.SSQ; E.RINV = p.RINV; E.out = p.out; E.Q = p.Q; E.KP = p.KP; E.KS = p.KS; E.VTP = p.VTP; E.VTS = p.VTS; run_gemm(lds, p.XB, p.Wqkv, 3072, 1024, E); }
    if (gridDim.x > 36) { if (blockIdx.x >= 36) cache_convert(p, (blockIdx.x - 36) * 512 + tid, (gridDim.x - 36) * 512); } else cache_convert(p, gtid, GT);
    xcd_barrier(xb);
    attn_phase(p, gw, NGW, lane);
    xcd_barrier(xb);
    { EpiRes E; E.XB = p.XB; E.SSQ = p.SSQ; run_gemm_split(lds, p.O, p.Wo1, 1024, 1024, E, (float*)p.H); xcd_barrier(xb); gemm_fixup(1024, 1024, E, (const float*)p.H, tid); rinv_pass(p, 1024, tid); }
    xcd_barrier(xb);
    { EpiUp E; E.SSQ = p.SSQ; E.RINV = p.RINV; E.H = p.H; run_gemm(lds, p.XB, p.Wup1, 4096, 1024, E); }
    xcd_barrier(xb);
    { EpiRes E; E.XB = p.XB; E.SSQ = p.SSQ; run_gemm_split(lds, p.H, p.Wdn1, 1024, 4096, E, (float*)p.CAT); xcd_barrier(xb); gemm_fixup(1024, 4096, E, (const float*)p.CAT, tid); }
    xcd_barrier(xb);
    final_norm(p, gw, NGW, lane);
}

extern "C" void kernel_launch(void* const* d_in, const int* in_sizes, int n_in, void* d_out, int out_size, void* d_ws, size_t ws_size, hipStream_t stream) {
    static int grid_blocks = 0;
    if (grid_blocks == 0) {
        int dev = 0, cus = 0, per_cu = 0;
        hipGetDevice(&dev); hipDeviceGetAttribute(&cus, hipDeviceAttributeMultiprocessorCount, dev);
        if (hipFuncSetAttribute((const void*)fwd_megakernel, hipFuncAttributeMaxDynamicSharedMemorySize, LDS_BYTES) != hipSuccess) fprintf(stderr, "kernel_launch: hipFuncSetAttribute failed\n");
        if (hipOccupancyMaxActiveBlocksPerMultiprocessor(&per_cu, (const void*)fwd_megakernel, 512, LDS_BYTES) != hipSuccess || per_cu < 1) { fprintf(stderr, "kernel_launch: occupancy query says %d\n", per_cu); per_cu = 1; }
        (void)hipGetLastError();
        grid_blocks = cus > 0 ? cus : 256;
    }
    Prm p{};
    const float* const* in = (const float* const*)d_in;
    p.x_prompt = in[0]; p.x_sample = in[1]; p.state_hgrn = in[2]; p.ssm_re0 = in[3]; p.ssm_im0 = in[4]; p.cache_k = in[5]; p.cache_v = in[6]; p.meta = in[7]; p.ln_mix = in[8]; p.ln_mlp = in[9];
    p.ln_final = in[10]; p.w_in_even = in[11]; p.hgrn_lb = in[12]; p.hgrn_norm = in[13]; p.a_re = in[14]; p.a_im = in[15]; p.log_dt = in[16]; p.b_re = in[17]; p.b_im = in[18]; p.c_re = in[19];
    p.c_im = in[20]; p.ssm_d = in[21]; p.w_glu = in[22]; p.w_out_even = in[23]; p.w_in_odd = in[24]; p.w_out_odd = in[25]; p.w_up = in[26]; p.w_down = in[27];
    p.out = (float*)d_out;
    unsigned char* ws = (unsigned char*)d_ws; size_t off = 0;
    auto take = [&](size_t bytes) { unsigned char* r = ws + off; off += (bytes + 255) & ~(size_t)255; return r; };
    p.Wt1 = (bf16_t*)take((size_t)2560 * 1024 * 2); p.Wglu = (bf16_t*)take((size_t)512 * 512 * 2); p.Wo0 = (bf16_t*)take((size_t)1024 * 1024 * 2); p.Wup0 = (bf16_t*)take((size_t)4096 * 1024 * 2);
    p.Wdn0 = (bf16_t*)take((size_t)4096 * 1024 * 2); p.Wqkv = (bf16_t*)take((size_t)3072 * 1024 * 2); p.Wo1 = (bf16_t*)take((size_t)1024 * 1024 * 2); p.Wup1 = (bf16_t*)take((size_t)4096 * 1024 * 2);
    p.Wdn1 = (bf16_t*)take((size_t)4096 * 1024 * 2);
    p.XB = (bf16_t*)take((size_t)MP * 1024 * 2); p.SSQ = (float*)take((size_t)MP * 16 * 4); p.RINV = (float*)take((size_t)MP * 4); p.LB = (float*)take(2048); p.KTAB = (float*)take((size_t)32 * 16 * 256 * 4);
    p.TG = (bf16_t*)take((size_t)32 * 256 * 384 * 2); p.HT = (bf16_t*)take((size_t)32 * 128 * 256 * 2); p.A16 = (float*)take(32 * 64 * 2 * 4); p.BAR = (unsigned*)take(XCD_BAR_WORDS * 4);
    const size_t S0 = off; constexpr size_t SZ512 = (size_t)MP * 512 * 2;
    p.Qh = (bf16_t*)take(SZ512); p.LOGF = (unsigned short*)take(SZ512); p.IV = (bf16_t*)take(SZ512); p.GS = (bf16_t*)take(SZ512); p.U = (bf16_t*)take(SZ512);
    p.UT = (bf16_t*)take((size_t)NITEM_H * 16384 * 2); p.AL = (float*)take((size_t)NITEM_H * 128 * 4);
    p.XLOC = (float*)take(SZ512); p.YG = (bf16_t*)p.XLOC;
    p.XPREV = (bf16_t*)take((size_t)NCOL * 4096 * 2); p.CAT = (bf16_t*)take((size_t)MP * 1024 * 2);
    size_t end = off;
    off = S0; p.H = (bf16_t*)take((size_t)MP * 4096 * 2); if (off > end) end = off;
    off = S0; p.Q = (bf16_t*)take((size_t)MP * 1024 * 2); p.KP = (bf16_t*)take((size_t)64 * 129 * 4096 * 2); p.KS = (bf16_t*)take((size_t)64 * 34 * 4096 * 2);
    p.VTP = (bf16_t*)take((size_t)64 * 129 * 4096 * 2); p.VTS = (bf16_t*)take((size_t)64 * 34 * 4096 * 2); p.O = (bf16_t*)take((size_t)MP * 1024 * 2); if (off > end) end = off;
    if (end > ws_size || n_in != 28 || (size_t)out_size != O_END) { fprintf(stderr, "kernel_launch: workspace/shape mismatch: need %zu have %zu, n_in %d, out %d\n", end, ws_size, n_in, out_size); return; }
    (void)hipMemsetAsync(p.BAR, 0, XCD_BAR_WORDS * 4, stream);
    void* args[] = {&p};
    hipError_t e = hipLaunchCooperativeKernel((const void*)fwd_megakernel, dim3(grid_blocks), dim3(512), args, LDS_BYTES, stream);
    if (e != hipSuccess) fprintf(stderr, "cooperative launch failed: %s (grid %d)\n", hipGetErrorString(e), grid_blocks);
}
```

```cpp
#include <hip/hip_runtime.h>
#include <hip/hip_cooperative_groups.h>
#include <cstdio>
#include <cstdint>
namespace cg = cooperative_groups;
namespace pg8 {
#define PG8_LAS __attribute__((address_space(3)))
typedef unsigned short bf16_t;
typedef short bf16x8 __attribute__((ext_vector_type(8)));
typedef float f32x4 __attribute__((ext_vector_type(4)));
typedef unsigned u32x4 __attribute__((ext_vector_type(4)));
constexpr int BM = 256, BK = 64, HALF = 128, HTB = HALF * BK * 2  , STAGE_BYTES = 8 * HTB, NXCD = 8, WGM = 8;

__host__ __device__ __forceinline__ int lds_byte(int r, int c) { const int st = (r >> 4) * 2 + (c >> 5), rr = r & 15, cc = c & 31, ob = rr * 64 + cc * 2; return st * 1024 + (ob ^ (((ob >> 9) & 1) << 5)); }
__host__ __device__ __forceinline__ void stage_rc(int b, int& R, int& C) { const int st = b / 1024, sb = b % 1024, swz = sb ^ (((sb >> 9) & 1) << 5); R = (st >> 1) * 16 + swz / 64; C = (st & 1) * 32 + (swz % 64) / 2; }
__host__ __device__ __forceinline__ int perm32(int rho) { const int n = rho >> 4, i = rho & 15; return 8 * (i >> 2) + 4 * n + (i & 3); }

struct Unit { int pm, pn, kb, nk, part; };
struct Gemm { const bf16_t* A; const bf16_t* Bt; int M, N, K; float* part; };

struct StaticOrder {
    int nM, nN, nwg, G, c;
    __host__ __device__ void init(int M, int N, int G_, int c_) { nM = M / BM; nN = N / BM; nwg = nM * nN; G = G_; c = c_; }
    __host__ __device__ void map(int L, Unit& u) const {
        int wgid = L; { const int q = nwg / NXCD, r = nwg % NXCD, xcd = wgid % NXCD, off = wgid / NXCD; wgid = (xcd < r ? xcd * (q + 1) : r * (q + 1) + (xcd - r) * q) + off; }
        const int nig = WGM * nN, gid = wgid / nig, fm = gid * WGM, gsz = (nM - fm) < WGM ? (nM - fm) : WGM;
        u.pm = fm + ((wgid % nig) % gsz); u.pn = (wgid % nig) / gsz; u.kb = 0; u.nk = 0; u.part = -1;
    }
    __host__ __device__ bool next(int i, Unit& u) const {
        const long L = (long)i * G + c; if (L >= nwg) return false;
        map((int)L, u); return true;
    }
    __device__ __forceinline__ void a_ready(const Unit&) const {}
    __device__ __forceinline__ void done(const Unit&) const {}
};
template <class Epi, class Sched>
__device__ __forceinline__ void gemm_phase(PG8_LAS unsigned char* lds, const Gemm g, const Sched& S, const Epi& E) {
    int tid_ = threadIdx.x; asm volatile("" : "+v"(tid_));
    const int tid = tid_, wid = __builtin_amdgcn_readfirstlane(tid >> 6), lane = tid & 63, wr = wid >> 2, wc = wid & 3, fr = lane & 15, fq = lane >> 4;
    const int K = g.K, nt = K / BK;
    unsigned voffA[2], voffB[2];
#pragma unroll
    for (int i = 0; i < 2; ++i) { int R, C; stage_rc(tid * 16 + i * 8192, R, C); const int Rb = Epi::PERM ? ((R & ~31) + perm32(R & 31)) : R;
        voffA[i] = (unsigned)(R * K + C) * 2u; voffB[i] = (unsigned)(Rb * K + C) * 2u; }
    const size_t kstep = (size_t)(BK * 2);
    const size_t hstep = (size_t)HALF * K * 2;
    const size_t tstep = 2 * hstep;
    const unsigned ldsw = (unsigned)wid * 1024u;
    const int aoff = lds_byte(wr * 64 + fr, fq * 8), boff = lds_byte(wc * 32 + fr, fq * 8);
#define PG8_SA(b, h) (((b) * 2 + (h)) * HTB)
#define PG8_SB(b, h) ((4 + (b) * 2 + (h)) * HTB)
#define PG8_STAGE(bufoff, gbase, voff) do { _Pragma("unroll") for (int _i = 0; _i < 2; ++_i) \
        __builtin_amdgcn_global_load_lds((const unsigned*)((const char*)(gbase) + (voff)[_i]), (PG8_LAS unsigned*)(lds + (bufoff) + ldsw + _i * 8192), 16, 0, 0); } while (0)
#define PG8_LDA(dst, b, h) do { _Pragma("unroll") for (int m = 0; m < 4; ++m) _Pragma("unroll") for (int k = 0; k < 2; ++k) dst[m][k] = *(const PG8_LAS bf16x8*)(lds + PG8_SA(b, h) + aoff + m * 2048 + k * 1024); } while (0)
#define PG8_LDB(dst, b, h) do { _Pragma("unroll") for (int n = 0; n < 2; ++n) _Pragma("unroll") for (int k = 0; k < 2; ++k) dst[n][k] = *(const PG8_LAS bf16x8*)(lds + PG8_SB(b, h) + boff + n * 2048 + k * 1024); } while (0)
#define PG8_MMA(ai, bj, At, Bt) do { __builtin_amdgcn_s_setprio(1); _Pragma("unroll") for (int m = 0; m < 4; ++m) _Pragma("unroll") for (int n = 0; n < 2; ++n) _Pragma("unroll") for (int k = 0; k < 2; ++k) \
        acc[ai][bj][m][n] = __builtin_amdgcn_mfma_f32_16x16x32_bf16(Bt[n][k], At[m][k], acc[ai][bj][m][n], 0, 0, 0); __builtin_amdgcn_s_setprio(0); } while (0)
#define PG8_WAIT_V(n) asm volatile("s_waitcnt vmcnt(" #n ")" ::: "memory")
#define PG8_WAIT_L(n) asm volatile("s_waitcnt lgkmcnt(" #n ")" ::: "memory")
#define PG8_BAR __builtin_amdgcn_s_barrier()
#define PG8_SCHED __builtin_amdgcn_sched_barrier(0)
    Unit cur, nxt; int ui = 0; typename Epi::Pre pre;
    if (!S.next(0, cur)) return;
    f32x4 acc[2][2][4][2];
#pragma unroll
    for (int a = 0; a < 2; ++a)
#pragma unroll
        for (int b = 0; b < 2; ++b)
#pragma unroll
            for (int m = 0; m < 4; ++m)
#pragma unroll
                for (int n = 0; n < 2; ++n) acc[a][b][m][n] = (f32x4){0.f, 0.f, 0.f, 0.f};
    bf16x8 At[4][2], B0[2][2], B1[2][2];
    const char* cA = (const char*)g.A + (size_t)cur.pm * tstep + (size_t)cur.kb * kstep; const char* cB = (const char*)g.Bt + (size_t)cur.pn * tstep + (size_t)cur.kb * kstep;
    S.a_ready(cur);
    PG8_STAGE(PG8_SB(0, 0), cB, voffB); PG8_STAGE(PG8_SA(0, 0), cA, voffA); PG8_STAGE(PG8_SB(0, 1), cB + hstep, voffB); PG8_STAGE(PG8_SA(0, 1), cA + hstep, voffA);
    if (wr == 1) PG8_BAR;
    PG8_WAIT_V(4); PG8_BAR;
    PG8_STAGE(PG8_SB(1, 0), cB + kstep, voffB); PG8_STAGE(PG8_SA(1, 0), cA + kstep, voffA); PG8_STAGE(PG8_SB(1, 1), cB + hstep + kstep, voffB);
    PG8_WAIT_V(6); PG8_BAR;
    for (;;) {
        const bool has_next = S.next(ui + 1, nxt);
        const char* nA = has_next ? (const char*)g.A + (size_t)nxt.pm * tstep + (size_t)nxt.kb * kstep : cA; const char* nB = has_next ? (const char*)g.Bt + (size_t)nxt.pn * tstep + (size_t)nxt.kb * kstep : cB;
        const int cnk = cur.nk ? cur.nk : nt;
        for (int t = 0; t < cnk; t += 2) {
            const bool last = (t == cnk - 2);
            const char* a1 = cA + (size_t)(t + 1) * kstep;
            const char* a2 = last ? nA : cA + (size_t)(t + 2) * kstep; const char* b2 = last ? nB : cB + (size_t)(t + 2) * kstep;
            const char* a3 = a2 + kstep; const char* b3 = b2 + kstep;
            if (last && has_next) S.a_ready(nxt);
            if (last) E.prefetch(pre, cur, wr, fr);
            PG8_LDB(B0, 0, 0); PG8_SCHED; PG8_LDA(At, 0, 0); PG8_STAGE(PG8_SA(1, 1), a1 + hstep, voffA);
            PG8_WAIT_L(8); PG8_BAR; PG8_WAIT_L(0); PG8_MMA(0, 0, At, B0); PG8_BAR; PG8_SCHED;
            PG8_LDB(B1, 0, 1); PG8_STAGE(PG8_SB(0, 0), b2, voffB);
            PG8_BAR; PG8_WAIT_L(0); PG8_MMA(0, 1, At, B1); PG8_BAR;
            PG8_LDA(At, 0, 1); PG8_STAGE(PG8_SA(0, 0), a2, voffA);
            PG8_BAR; PG8_WAIT_L(0); PG8_MMA(1, 0, At, B0); PG8_BAR; PG8_SCHED;
            PG8_STAGE(PG8_SB(0, 1), b2 + hstep, voffB);
            PG8_WAIT_V(6); PG8_BAR; PG8_MMA(1, 1, At, B1); PG8_BAR;
            PG8_LDB(B0, 1, 0); PG8_SCHED; PG8_LDA(At, 1, 0); PG8_STAGE(PG8_SA(0, 1), a2 + hstep, voffA);
            PG8_WAIT_L(8); PG8_BAR; PG8_WAIT_L(0); PG8_MMA(0, 0, At, B0); PG8_BAR; PG8_SCHED;
            PG8_LDB(B1, 1, 1); PG8_STAGE(PG8_SB(1, 0), b3, voffB);
            PG8_BAR; PG8_WAIT_L(0); PG8_MMA(0, 1, At, B1); PG8_BAR;
            PG8_LDA(At, 1, 1); PG8_STAGE(PG8_SA(1, 0), a3, voffA);
            PG8_BAR; PG8_WAIT_L(0); PG8_MMA(1, 0, At, B0); PG8_BAR; PG8_SCHED;
            PG8_STAGE(PG8_SB(1, 1), b3 + hstep, voffB);
            PG8_WAIT_V(6); PG8_BAR; PG8_MMA(1, 1, At, B1); PG8_BAR;
        }
        if constexpr (!Epi::AFTER_DRAIN) {
            if (cur.part < 0) E(acc, cur, wr, wc, fr, fq, pre);
            else { f32x4* pp = (f32x4*)g.part + (size_t)cur.part * 32 * 512 + tid;
#pragma unroll
                for (int a = 0; a < 2; ++a)
#pragma unroll
                    for (int b = 0; b < 2; ++b)
#pragma unroll
                        for (int m = 0; m < 4; ++m)
#pragma unroll
                            for (int n = 0; n < 2; ++n) pp[(size_t)(((a * 2 + b) * 4 + m) * 2 + n) * 512] = acc[a][b][m][n]; }
            S.done(cur); }
        if (!has_next) break;
#pragma unroll
        for (int a = 0; a < 2; ++a)
#pragma unroll
            for (int b = 0; b < 2; ++b)
#pragma unroll
                for (int m = 0; m < 4; ++m)
#pragma unroll
                    for (int n = 0; n < 2; ++n) acc[a][b][m][n] = (f32x4){0.f, 0.f, 0.f, 0.f};
        cur = nxt; cA = nA; cB = nB; ++ui;
    }
    PG8_WAIT_V(0);
    if (wr == 0) PG8_BAR;
    PG8_BAR;
    if constexpr (Epi::AFTER_DRAIN) { E.fused(acc, cur, wr, wc, fr, fq, lds, wid, lane); S.done(cur); }
#undef PG8_SA
#undef PG8_SB
#undef PG8_STAGE
#undef PG8_LDA
#undef PG8_LDB
#undef PG8_MMA
#undef PG8_WAIT_V
#undef PG8_WAIT_L
#undef PG8_BAR
#undef PG8_SCHED
}
}
using pg8::bf16_t; using pg8::bf16x8; using pg8::f32x4; using pg8::Unit;
typedef float f32x16 __attribute__((ext_vector_type(16)));
typedef float f32x2v __attribute__((ext_vector_type(2)));
typedef unsigned u32x2 __attribute__((ext_vector_type(2)));
typedef unsigned u32x4v __attribute__((ext_vector_type(4)));
#define LAS __attribute__((address_space(3)))
#define DI __device__ __forceinline__

constexpr int DM = 1024, TP = 4112, NTP = 8 * TP  , NTS = 512, NT = NTP + NTS  , MP = 33536  ;
constexpr int NITEM_H = 2112;
constexpr int NCOL = NT / 16;
constexpr float EPSN = 1e-6f;
constexpr size_t O_YP = 0, O_YS = O_YP + (size_t)8 * 4096 * 1024, O_HGP = O_YS + 524288, O_HGS = O_HGP + 524288, O_SRP = O_HGS + 524288, O_SIP = O_SRP + 16384,
                 O_SRS = O_SIP + 16384, O_SIS = O_SRS + 16384, O_KP = O_SIS + 16384, O_VP = O_KP + (size_t)NTP * 1024, O_KS = O_VP + (size_t)NTP * 1024, O_VS = O_KS + 524288, O_END = O_VS + 524288;

struct Prm {
    const float *x_prompt, *x_sample, *state_hgrn, *ssm_re0, *ssm_im0, *cache_k, *cache_v, *meta, *ln_mix, *ln_mlp, *ln_final, *w_in_even, *hgrn_lb, *hgrn_norm,
        *a_re, *a_im, *log_dt, *b_re, *b_im, *c_re, *c_im, *ssm_d, *w_glu, *w_out_even, *w_in_odd, *w_out_odd, *w_up, *w_down;
    float* out;
    bf16_t *Wt1, *Wglu, *Wo0, *Wup0, *Wdn0, *Wqkv, *Wo1, *Wup1, *Wdn1;
    bf16_t* XB; float* SSQ; float* RINV; float* LB; float* KTAB; bf16_t* TG; bf16_t* HT; float* A16;
    bf16_t *Qh, *IV, *GS, *U; unsigned short* LOGF; bf16_t* UT; float* AL; float* XLOC; bf16_t* XPREV; bf16_t* YG; bf16_t* CAT;
    bf16_t* H;
    bf16_t *Q, *KP, *KS, *VTP, *VTS, *O; unsigned* BAR;
};

DI unsigned pk2(float lo, float hi) { unsigned r; asm volatile("v_cvt_pk_bf16_f32 %0, %1, %2" : "=v"(r) : "v"(lo), "v"(hi)); return r; }
DI float bflo(unsigned u) { return __uint_as_float(u << 16); }
DI float bfhi(unsigned u) { return __uint_as_float(u & 0xffff0000u); }
DI float bf2f(unsigned short b) { return __uint_as_float(((unsigned)b) << 16); }
DI unsigned short f2bf(float f) { return (unsigned short)(pk2(f, 0.f) & 0xffffu); }
DI unsigned pkh2(float lo, float hi) { union { _Float16 h[2]; unsigned u; } x; x.h[0] = (_Float16)lo; x.h[1] = (_Float16)hi; return x.u; }
DI float h2f(unsigned short h) { union { unsigned short s; _Float16 h; } x; x.s = h; return (float)x.h; }
DI float wave_sum(float v) {
#pragma unroll
    for (int o = 1; o < 64; o <<= 1) v += __shfl_xor(v, o);
    return v;
}
DI float fexp(float x) { return __expf(x); }
DI float sigm(float x) { return __builtin_amdgcn_rcpf(1.f + __expf(-x)); }
DI float row_rinv(const float* SSQ, int row) {
    const f32x4* s = (const f32x4*)(SSQ + (size_t)row * 16); f32x4 a = s[0] + s[1] + s[2] + s[3];
    return rsqrtf(((a.x + a.y) + (a.z + a.w)) * (1.f / 1024.f) + EPSN);
}
DI void rinv8(const float* SSQ, int row0, int fq, float (&r)[2][4]) {
    f32x4 v[2][4];
#pragma unroll
    for (int ai = 0; ai < 2; ++ai)
#pragma unroll
        for (int m = 0; m < 4; ++m) v[ai][m] = *(const f32x4*)(SSQ + (size_t)(row0 + ai * 128 + m * 16) * 16 + 4 * fq);
#pragma unroll
    for (int ai = 0; ai < 2; ++ai)
#pragma unroll
        for (int m = 0; m < 4; ++m) { float s = (v[ai][m].x + v[ai][m].y) + (v[ai][m].z + v[ai][m].w); s += __shfl_xor(s, 16); s += __shfl_xor(s, 32); r[ai][m] = rsqrtf(s * (1.f / 1024.f) + EPSN); }
}
#define LDS_WAIT() asm volatile("s_waitcnt lgkmcnt(0)" ::: "memory")

struct EpiIn0 {
    struct Pre { float r[2][4]; };
    DI void prefetch(Pre& pre, const Unit& u, int wr, int fr) const { const int row0 = u.pm * 256 + wr * 64 + fr;
#pragma unroll
        for (int ai = 0; ai < 2; ++ai)
#pragma unroll
            for (int m = 0; m < 4; ++m) pre.r[ai][m] = RINV[row0 + ai * 128 + m * 16]; }
    DI void scales(const Pre& pre, int row0, int fq, float (&rs)[2][4]) const {
        if (pre.r[0][0] > 0.f) {
#pragma unroll
            for (int ai = 0; ai < 2; ++ai)
#pragma unroll
                for (int m = 0; m < 4; ++m) rs[ai][m] = pre.r[ai][m]; }
        else rinv8(SSQ, row0, fq, rs);
    }
    static constexpr bool PERM = true, AFTER_DRAIN = false;
    const float* SSQ; const float* RINV; const float* LB; bf16_t *Qh, *IV, *GS, *U; unsigned short* LOGF;
    DI void operator()(const f32x4 (&acc)[2][2][4][2], const Unit& u, int wr, int wc, int fr, int fq, const Pre& pre) const {
        const int seg = u.pn >> 1, cb = (u.pn & 1) * 256 + wc * 32 + 8 * fq, row0 = u.pm * 256 + wr * 64 + fr;
        unsigned short* dst = seg == 0 ? Qh : seg == 1 ? LOGF : seg == 2 ? IV : seg == 3 ? GS : U;
        float rs[2][4]; scales(pre, row0, fq, rs);
        f32x4 lbv[2][2];
#pragma unroll
        for (int bj = 0; bj < 2; ++bj)
#pragma unroll
            for (int n = 0; n < 2; ++n) lbv[bj][n] = *(const f32x4*)(LB + cb + bj * 128 + 4 * n);
#pragma unroll
        for (int ai = 0; ai < 2; ++ai)
#pragma unroll
            for (int m = 0; m < 4; ++m) { const int row = row0 + ai * 128 + m * 16; const float r = rs[ai][m];
#pragma unroll
                for (int bj = 0; bj < 2; ++bj) { u32x4v o; unsigned w[4];
#pragma unroll
                    for (int n = 0; n < 2; ++n) { f32x4 v = acc[ai][bj][m][n] * r;
                        if (seg == 1) { const f32x4 lb = lbv[bj][n]; f32x4 f;
#pragma unroll
                            for (int e = 0; e < 4; ++e) f[e] = __logf(lb[e] + (1.f - lb[e]) * sigm(v[e]));
                            w[2 * n] = pkh2(f[0], f[1]); w[2 * n + 1] = pkh2(f[2], f[3]); }
                        else { if (seg == 3) {
#pragma unroll
                                for (int e = 0; e < 4; ++e) v[e] = v[e] * sigm(v[e]); }
                            w[2 * n] = pk2(v[0], v[1]); w[2 * n + 1] = pk2(v[2], v[3]); } }
                    o.x = w[0]; o.y = w[1]; o.z = w[2]; o.w = w[3];
                    *(u32x4v*)(dst + (size_t)row * 512 + cb + bj * 128) = o; } }
    }
};
struct EpiGlu {
    struct Pre {}; DI void prefetch(Pre&, const Unit&, int, int) const {}
    static constexpr bool PERM = true, AFTER_DRAIN = false;
    const bf16_t* YG; bf16_t* CAT;
    DI void operator()(const f32x4 (&acc)[2][2][4][2], const Unit& u, int wr, int wc, int fr, int fq, const Pre& pre) const {
        const int cb = u.pn * 256 + wc * 32 + 8 * fq, row0 = u.pm * 256 + wr * 64 + fr;
#pragma unroll
        for (int ai = 0; ai < 2; ++ai) {
            u32x4v y[4][2];
#pragma unroll
            for (int m = 0; m < 4; ++m)
#pragma unroll
                for (int bj = 0; bj < 2; ++bj) y[m][bj] = *(const u32x4v*)(YG + (size_t)(row0 + ai * 128 + m * 16) * 512 + cb + bj * 128);
#pragma unroll
            for (int m = 0; m < 4; ++m) { const int row = row0 + ai * 128 + m * 16;
#pragma unroll
                for (int bj = 0; bj < 2; ++bj) { const f32x4 v0 = acc[ai][bj][m][0], v1 = acc[ai][bj][m][1]; const u32x4v yy = y[m][bj]; u32x4v o;
                    o.x = pk2(bflo(yy.x) * sigm(v0[0]), bfhi(yy.x) * sigm(v0[1])); o.y = pk2(bflo(yy.y) * sigm(v0[2]), bfhi(yy.y) * sigm(v0[3]));
                    o.z = pk2(bflo(yy.z) * sigm(v1[0]), bfhi(yy.z) * sigm(v1[1])); o.w = pk2(bflo(yy.w) * sigm(v1[2]), bfhi(yy.w) * sigm(v1[3]));
                    *(u32x4v*)(CAT + (size_t)row * 1024 + 512 + cb + bj * 128) = o; } } }
    }
};
struct EpiRes {
    struct Pre {}; DI void prefetch(Pre&, const Unit&, int, int) const {}
    static constexpr bool PERM = true, AFTER_DRAIN = false;
    bf16_t* XB; float* SSQ;
    DI float upd(u32x4v* px, const u32x4v x, const f32x4 v0, const f32x4 v1) const {
        u32x4v o; o.x = pk2(bflo(x.x) + v0[0], bfhi(x.x) + v0[1]); o.y = pk2(bflo(x.y) + v0[2], bfhi(x.y) + v0[3]);
        o.z = pk2(bflo(x.z) + v1[0], bfhi(x.z) + v1[1]); o.w = pk2(bflo(x.w) + v1[2], bfhi(x.w) + v1[3]); *px = o;
        const float a0 = bflo(o.x), a1 = bfhi(o.x), a2 = bflo(o.y), a3 = bfhi(o.y), a4 = bflo(o.z), a5 = bfhi(o.z), a6 = bflo(o.w), a7 = bfhi(o.w);
        return ((a0 * a0 + a1 * a1) + (a2 * a2 + a3 * a3)) + ((a4 * a4 + a5 * a5) + (a6 * a6 + a7 * a7));
    }
    DI void row(const f32x4 (&a4)[2][2], const Unit& u, int ai, int m, int wr, int wc, int fr, int fq) const {
        const int cb = u.pn * 256 + wc * 32 + 8 * fq, row = u.pm * 256 + wr * 64 + fr + ai * 128 + m * 16;
        u32x4v* p0 = (u32x4v*)(XB + (size_t)row * 1024 + cb); u32x4v* p1 = (u32x4v*)(XB + (size_t)row * 1024 + cb + 128);
        const u32x4v x0 = *p0, x1 = *p1;
        float ss = upd(p0, x0, a4[0][0], a4[0][1]) + upd(p1, x1, a4[1][0], a4[1][1]);
        ss += __shfl_xor(ss, 16); ss += __shfl_xor(ss, 32);
        if (fq == 0) SSQ[(size_t)row * 16 + u.pn * 4 + wc] = ss;
    }
    DI void operator()(const f32x4 (&acc)[2][2][4][2], const Unit& u, int wr, int wc, int fr, int fq, const Pre& pre) const {
        const int cb = u.pn * 256 + wc * 32 + 8 * fq, row0 = u.pm * 256 + wr * 64 + fr;
#pragma unroll
        for (int ai = 0; ai < 2; ++ai) {
            u32x4v x[4][2];
#pragma unroll
            for (int m = 0; m < 4; ++m)
#pragma unroll
                for (int bj = 0; bj < 2; ++bj) x[m][bj] = *(const u32x4v*)(XB + (size_t)(row0 + ai * 128 + m * 16) * 1024 + cb + bj * 128);
#pragma unroll
            for (int m = 0; m < 4; ++m) { const int row = row0 + ai * 128 + m * 16;
                float ss = upd((u32x4v*)(XB + (size_t)row * 1024 + cb), x[m][0], acc[ai][0][m][0], acc[ai][0][m][1])
                         + upd((u32x4v*)(XB + (size_t)row * 1024 + cb + 128), x[m][1], acc[ai][1][m][0], acc[ai][1][m][1]);
                ss += __shfl_xor(ss, 16); ss += __shfl_xor(ss, 32);
                if (fq == 0) SSQ[(size_t)row * 16 + u.pn * 4 + wc] = ss; } }
    }
};
struct EpiUp {
    struct Pre { float r[2][4]; };
    DI void prefetch(Pre& pre, const Unit& u, int wr, int fr) const { const int row0 = u.pm * 256 + wr * 64 + fr;
#pragma unroll
        for (int ai = 0; ai < 2; ++ai)
#pragma unroll
            for (int m = 0; m < 4; ++m) pre.r[ai][m] = RINV[row0 + ai * 128 + m * 16]; }
    DI void scales(const Pre& pre, int row0, int fq, float (&rs)[2][4]) const {
        if (pre.r[0][0] > 0.f) {
#pragma unroll
            for (int ai = 0; ai < 2; ++ai)
#pragma unroll
                for (int m = 0; m < 4; ++m) rs[ai][m] = pre.r[ai][m]; }
        else rinv8(SSQ, row0, fq, rs);
    }
    static constexpr bool PERM = true, AFTER_DRAIN = false;
    const float* SSQ; const float* RINV; bf16_t* H;
    DI void operator()(const f32x4 (&acc)[2][2][4][2], const Unit& u, int wr, int wc, int fr, int fq, const Pre& pre) const {
        const int cb = u.pn * 256 + wc * 32 + 8 * fq, row0 = u.pm * 256 + wr * 64 + fr;
        float rs[2][4]; scales(pre, row0, fq, rs);
#pragma unroll
        for (int ai = 0; ai < 2; ++ai)
#pragma unroll
            for (int m = 0; m < 4; ++m) { const int row = row0 + ai * 128 + m * 16; const float r = rs[ai][m];
#pragma unroll
                for (int bj = 0; bj < 2; ++bj) { f32x4 v0 = acc[ai][bj][m][0] * r, v1 = acc[ai][bj][m][1] * r;
#pragma unroll
                    for (int e = 0; e < 4; ++e) { const float t0 = fmaxf(v0[e], 0.f), t1 = fmaxf(v1[e], 0.f); v0[e] = t0 * t0; v1[e] = t1 * t1; }
                    u32x4v o; o.x = pk2(v0[0], v0[1]); o.y = pk2(v0[2], v0[3]); o.z = pk2(v1[0], v1[1]); o.w = pk2(v1[2], v1[3]);
                    *(u32x4v*)(H + (size_t)row * 4096 + cb + bj * 128) = o; } }
    }
};
DI size_t kf_index(int seqh, int nkt, int key, int d) { return ((((size_t)seqh * nkt + (key >> 5)) * 8 + (d >> 4)) * 64 + ((key & 31) + 32 * ((d >> 3) & 1))) * 8 + (d & 7); }
DI size_t vf_index(int seqh, int nkt, int key, int d) { const int kk = key & 31;
    return ((((size_t)seqh * nkt + (key >> 5)) * 8 + (kk >> 4) * 4 + (d >> 5)) * 64 + ((d & 31) + 32 * ((kk >> 2) & 1))) * 8 + ((kk >> 3) & 1) * 4 + (kk & 3); }
struct EpiQkv {
    struct Pre { float r[2][4]; };
    DI void prefetch(Pre& pre, const Unit& u, int wr, int fr) const { const int row0 = u.pm * 256 + wr * 64 + fr;
#pragma unroll
        for (int ai = 0; ai < 2; ++ai)
#pragma unroll
            for (int m = 0; m < 4; ++m) pre.r[ai][m] = RINV[row0 + ai * 128 + m * 16]; }
    DI void scales(const Pre& pre, int row0, int fq, float (&rs)[2][4]) const {
        if (pre.r[0][0] > 0.f) {
#pragma unroll
            for (int ai = 0; ai < 2; ++ai)
#pragma unroll
                for (int m = 0; m < 4; ++m) rs[ai][m] = pre.r[ai][m]; }
        else rinv8(SSQ, row0, fq, rs);
    }
    static constexpr bool PERM = true, AFTER_DRAIN = false;
    const float* SSQ; const float* RINV; float* out; bf16_t *Q, *KP, *KS, *VTP, *VTS;
    DI void operator()(const f32x4 (&acc)[2][2][4][2], const Unit& u, int wr, int wc, int fr, int fq, const Pre& pre) const {
        const int third = u.pn >> 2, cb = (u.pn & 3) * 256 + wc * 32 + 8 * fq, row0 = u.pm * 256 + wr * 64 + fr;
        float rs[2][4]; scales(pre, row0, fq, rs);
#pragma unroll
        for (int ai = 0; ai < 2; ++ai)
#pragma unroll
            for (int m = 0; m < 4; ++m) { const int row = row0 + ai * 128 + m * 16; const float r = rs[ai][m];
                const bool smp = row >= NTP; const int s = row - NTP; const int b = smp ? (s >> 6) : row / TP, key = smp ? 1024 + (s & 63) : row - b * TP, nkt = smp ? 34 : 129;
#pragma unroll
                for (int bj = 0; bj < 2; ++bj) { const int cs = cb + bj * 128; const f32x4 v0 = acc[ai][bj][m][0] * r, v1 = acc[ai][bj][m][1] * r;
                    u32x4v o; o.x = pk2(v0[0], v0[1]); o.y = pk2(v0[2], v0[3]); o.z = pk2(v1[0], v1[1]); o.w = pk2(v1[2], v1[3]);
                    if (third == 0) { *(u32x4v*)(Q + (size_t)row * 1024 + cs) = o; }
                    else if (row < NT) { const int h = cs >> 7, d = cs & 127;
                        if (third == 1) { float* ok = out + (smp ? O_KS + (size_t)s * 1024 : O_KP + (size_t)row * 1024) + cs; *(f32x4*)ok = v0; *(f32x4*)(ok + 4) = v1;
                            *(u32x4v*)((smp ? KS : KP) + kf_index(b * 8 + h, nkt, key, d)) = o; }
                        else { float* ov = out + (smp ? O_VS + (size_t)s * 1024 : O_VP + (size_t)row * 1024) + cs; *(f32x4*)ov = v0; *(f32x4*)(ov + 4) = v1;
                            bf16_t* vt = (smp ? VTS : VTP) + vf_index(b * 8 + h, nkt, key, d);
                            vt[0] = (bf16_t)(o.x & 0xffffu); vt[8] = (bf16_t)(o.x >> 16); vt[16] = (bf16_t)(o.y & 0xffffu); vt[24] = (bf16_t)(o.y >> 16);
                            vt[32] = (bf16_t)(o.z & 0xffffu); vt[40] = (bf16_t)(o.z >> 16); vt[48] = (bf16_t)(o.w & 0xffffu); vt[56] = (bf16_t)(o.w >> 16); } } } }
    }
};
struct EpiFin {
    struct Pre {}; DI void prefetch(Pre&, const Unit&, int, int) const {}
    static constexpr bool PERM = false, AFTER_DRAIN = false;
    const bf16_t* XB; float* SSQ; float* out;
    DI void row(const f32x4 (&a4)[2][2], const Unit& u, int ai, int m, int wr, int wc, int fr, int fq) const {
        const int cb = u.pn * 256 + wc * 32 + 4 * fq, row = u.pm * 256 + wr * 64 + fr + ai * 128 + m * 16; float ss = 0.f;
        const int b = row / TP, t = row - b * TP; const bool ok = row < NT && (row >= NTP || t >= 16);
        float* dst = out + (row >= NTP ? O_YS + (size_t)(row - NTP) * 1024 : O_YP + ((size_t)b * 4096 + (t - 16)) * 1024);
#pragma unroll
        for (int bj = 0; bj < 2; ++bj)
#pragma unroll
            for (int n = 0; n < 2; ++n) { const int cs = cb + bj * 128 + n * 16; f32x4 v = a4[bj][n];
                const u32x2 x = *(const u32x2*)(XB + (size_t)row * 1024 + cs);
                v[0] += bflo(x.x); v[1] += bfhi(x.x); v[2] += bflo(x.y); v[3] += bfhi(x.y);
                if (ok) *(f32x4*)(dst + cs) = v;
                ss += (v[0] * v[0] + v[1] * v[1]) + (v[2] * v[2] + v[3] * v[3]); }
        ss += __shfl_xor(ss, 16); ss += __shfl_xor(ss, 32);
        if (fq == 0) SSQ[(size_t)row * 16 + u.pn * 4 + wc] = ss;
    }
    DI void operator()(const f32x4 (&acc)[2][2][4][2], const Unit& u, int wr, int wc, int fr, int fq, const Pre& pre) const {
        const int cb = u.pn * 256 + wc * 32 + 4 * fq, row0 = u.pm * 256 + wr * 64 + fr;
#pragma unroll
        for (int ai = 0; ai < 2; ++ai) {
            u32x2 x[4][2][2];
#pragma unroll
            for (int m = 0; m < 4; ++m)
#pragma unroll
                for (int bj = 0; bj < 2; ++bj)
#pragma unroll
                    for (int n = 0; n < 2; ++n) x[m][bj][n] = *(const u32x2*)(XB + (size_t)(row0 + ai * 128 + m * 16) * 1024 + cb + bj * 128 + n * 16);
#pragma unroll
            for (int m = 0; m < 4; ++m) { const int row = row0 + ai * 128 + m * 16; float ss = 0.f;
                const int b = row / TP, t = row - b * TP; const bool ok = row < NT && (row >= NTP || t >= 16);
                float* dst = out + (row >= NTP ? O_YS + (size_t)(row - NTP) * 1024 : O_YP + ((size_t)b * 4096 + (t - 16)) * 1024);
#pragma unroll
                for (int bj = 0; bj < 2; ++bj)
#pragma unroll
                    for (int n = 0; n < 2; ++n) { const int cs = cb + bj * 128 + n * 16; f32x4 v = acc[ai][bj][m][n]; const u32x2 xx = x[m][bj][n];
                        v[0] += bflo(xx.x); v[1] += bfhi(xx.x); v[2] += bflo(xx.y); v[3] += bfhi(xx.y);
                        if (ok) *(f32x4*)(dst + cs) = v;
                        ss += (v[0] * v[0] + v[1] * v[1]) + (v[2] * v[2] + v[3] * v[3]); }
                ss += __shfl_xor(ss, 16); ss += __shfl_xor(ss, 32);
                if (fq == 0) SSQ[(size_t)row * 16 + u.pn * 4 + wc] = ss; } }
    }
};
template <class Epi> DI void run_gemm(LAS unsigned char* lds, const bf16_t* A, const bf16_t* Bt, int N, int K, const Epi& E) {
    pg8::Gemm g; g.A = A; g.Bt = Bt; g.M = MP; g.N = N; g.K = K; g.part = nullptr;
    pg8::StaticOrder S; S.init(MP, N, (int)gridDim.x, (int)blockIdx.x);
    pg8::gemm_phase<Epi, pg8::StaticOrder>(lds, g, S, E);
}
struct SplitOrder : pg8::StaticOrder {
    int nwhole, ntail, S, nks;
    DI void init2(int N, int K) { init(MP, N, (int)gridDim.x, (int)blockIdx.x); nwhole = nwg / G; ntail = nwg - nwhole * G; S = 0; nks = 0;
        if (ntail > 0) { int s = G / ntail; const int nkt = K / 64; while (s > 1 && (nkt % s != 0 || (nkt / s) < 4 || ((nkt / s) & 1))) --s; if (s > 1) { S = s; nks = nkt / s; } } }
    DI bool next(int i, Unit& u) const {
        if (S == 0) return pg8::StaticOrder::next(i, u);
        if (i < nwhole) { map(i * G + c, u); return true; }
        if (i == nwhole && c < ntail * S) { map(nwhole * G + c / S, u); u.kb = (c % S) * nks; u.nk = nks; u.part = c; return true; }
        return false;
    }
};
template <class Epi> DI void run_gemm_split(LAS unsigned char* lds, const bf16_t* A, const bf16_t* Bt, int N, int K, const Epi& E, float* part) {
    pg8::Gemm g; g.A = A; g.Bt = Bt; g.M = MP; g.N = N; g.K = K; g.part = part;
    SplitOrder S; S.init2(N, K);
    pg8::gemm_phase<Epi, SplitOrder>(lds, g, S, E);
}
template <class Epi> DI void gemm_fixup(int N, int K, const Epi& E, const float* part, int tid) {
    SplitOrder S; S.init2(N, K); if (S.S == 0) return;
    asm volatile("" : "+v"(tid));
    const int wid = tid >> 6, lane = tid & 63, wr = wid >> 2, wc = wid & 3, fr = lane & 15, fq = lane >> 4;
    for (int it = blockIdx.x; it < S.ntail * 8; it += gridDim.x) { const int j = it >> 3, ai = (it >> 2) & 1, m = it & 3; Unit u; S.map(S.nwhole * S.G + j, u);
        f32x4 a4[2][2];
#pragma unroll
        for (int b = 0; b < 2; ++b)
#pragma unroll
            for (int n = 0; n < 2; ++n) { const f32x4* pp = (const f32x4*)part + ((size_t)(j * S.S) * 32 + (((ai * 2 + b) * 4 + m) * 2 + n)) * 512 + tid;
                f32x4 v0 = {0.f, 0.f, 0.f, 0.f}, v1 = v0, v2 = v0, v3 = v0;
                for (int sl = 0; sl + 3 < S.S; sl += 4) { v0 += pp[(size_t)sl * 16384]; v1 += pp[(size_t)(sl + 1) * 16384]; v2 += pp[(size_t)(sl + 2) * 16384]; v3 += pp[(size_t)(sl + 3) * 16384]; }
                for (int sl = S.S & ~3; sl < S.S; ++sl) v0 += pp[(size_t)sl * 16384];
                a4[b][n] = (v0 + v1) + (v2 + v3); }
        E.row(a4, u, ai, m, wr, wc, fr, fq); }
}
DI void rinv_pass(const Prm& p, int K, int tid) {
    SplitOrder S; S.init2(1024, K);
    for (int pm = blockIdx.x; pm < MP / 256; pm += gridDim.x) {
        bool tail = false;
        if (S.S) for (int j = 0; j < S.ntail; ++j) { Unit u; S.map(S.nwhole * S.G + j, u); tail = tail || (u.pm == pm); }
        if (tid < 256) { const int row = pm * 256 + tid; float v = -1.f;
            if (!tail) { const f32x4* q = (const f32x4*)(p.SSQ + (size_t)row * 16); const f32x4 a = q[0] + q[1] + q[2] + q[3]; v = rsqrtf(((a.x + a.y) + (a.z + a.w)) * (1.f / 1024.f) + EPSN); }
            if (row >= NT) v = 1.f;
            p.RINV[row] = v; }
    }
}
DI void transpose_item(const float* W, int N, bf16_t* WT, size_t ldo, const float* sc, LAS float* scr, int item, int lane) {
    const int nblk = N / 32, kb = item / nblk, nb = item % nblk, k0 = 64 * kb, n0 = 32 * nb;
#pragma unroll 8
    for (int i = 0; i < 32; ++i) { const int kk = 2 * i + (lane >> 5); float w = W[(size_t)(k0 + kk) * N + n0 + (lane & 31)]; if (sc) w *= sc[k0 + kk]; scr[kk * 33 + (lane & 31)] = w; }
    LDS_WAIT();
    const int c = lane & 7;
#pragma unroll
    for (int j = 0; j < 4; ++j) { const int n = (lane >> 3) + 8 * j; const LAS float* s = scr + (8 * c) * 33 + n;
        u32x4v o; o.x = pk2(s[0 * 33], s[1 * 33]); o.y = pk2(s[2 * 33], s[3 * 33]); o.z = pk2(s[4 * 33], s[5 * 33]); o.w = pk2(s[6 * 33], s[7 * 33]);
        *(u32x4v*)(WT + (size_t)(n0 + n) * ldo + k0 + 8 * c) = o; }
    LDS_WAIT();
}
DI void s5_pow(const Prm& p, int g, int n, float k, float& re, float& im) {
    const float dt = __expf(p.log_dt[g]), ar = p.a_re[g * 64 + n], ai = p.a_im[g * 64 + n];
    const float mag = __expf(k * dt * ar); float rev = k * dt * ai * 0.15915494309189535f; rev -= rintf(rev);
    re = mag * __builtin_amdgcn_cosf(rev); im = mag * __builtin_amdgcn_sinf(rev);
}
DI void s5_bbar(const Prm& p, int g, int n, int pp, float& re, float& im) {
    const float ar = p.a_re[g * 64 + n], ai = p.a_im[g * 64 + n]; float abr, abi; s5_pow(p, g, n, 1.f, abr, abi);
    const float den = ar * ar + ai * ai, zr = ((abr - 1.f) * ar + abi * ai) / den, zi = (abi * ar - (abr - 1.f) * ai) / den;
    const float br = p.b_re[(g * 64 + n) * 16 + pp], bi = p.b_im[(g * 64 + n) * 16 + pp];
    re = zr * br - zi * bi; im = zr * bi + zi * br;
}
DI void phase_prologue(const Prm& p, LAS unsigned char* lds, int tid, int lane, int wave) {
    const int gw = blockIdx.x * 8 + wave, NGW = gridDim.x * 8, gtid = blockIdx.x * 512 + tid, GT = gridDim.x * 512;
    LAS float* scr = (LAS float*)(lds + wave * 16384);
    constexpr int I1 = 16 * 80, I2 = 8 * 16, I3 = 16 * 32, I4 = 16 * 128, I5 = 64 * 32, I6 = 16 * 96;
    constexpr int NITEMS = I1 + I2 + I3 + I4 + I5 + I6 + I3 + I4 + I5;
    for (int it = gw; it < NITEMS; it += NGW) {
        int r = it;
        if (r < I1) { transpose_item(p.w_in_even, 2560, p.Wt1, 1024, p.ln_mix, scr, r, lane); continue; } r -= I1;
        if (r < I2) { transpose_item(p.w_glu, 512, p.Wglu, 512, nullptr, scr, r, lane); continue; } r -= I2;
        if (r < I3) { transpose_item(p.w_out_even, 1024, p.Wo0, 1024, nullptr, scr, r, lane); continue; } r -= I3;
        if (r < I4) { transpose_item(p.w_up, 4096, p.Wup0, 1024, p.ln_mlp, scr, r, lane); continue; } r -= I4;
        if (r < I5) { transpose_item(p.w_down, 1024, p.Wdn0, 4096, nullptr, scr, r, lane); continue; } r -= I5;
        if (r < I6) { transpose_item(p.w_in_odd, 3072, p.Wqkv, 1024, p.ln_mix + 1024, scr, r, lane); continue; } r -= I6;
        if (r < I3) { transpose_item(p.w_out_odd, 1024, p.Wo1, 1024, nullptr, scr, r, lane); continue; } r -= I3;
        if (r < I4) { transpose_item(p.w_up + (size_t)1024 * 4096, 4096, p.Wup1, 1024, p.ln_mlp + 1024, scr, r, lane); continue; } r -= I4;
        transpose_item(p.w_down + (size_t)4096 * 1024, 1024, p.Wdn1, 4096, nullptr, scr, r, lane);
    }
    for (int row = gw; row < NT; row += NGW) {
        const float* src;
        if (row < NTP) { const int b = row / TP, t = row - b * TP; src = t < 16 ? p.meta + (size_t)t * 1024 : p.x_prompt + ((size_t)b * 4096 + (t - 16)) * 1024; }
        else src = p.x_sample + (size_t)(row - NTP) * 1024;
        float ss = 0.f;
#pragma unroll
        for (int j = 0; j < 4; ++j) { const f32x4 v = ((const f32x4*)src)[lane + 64 * j]; u32x2 o; o.x = pk2(v.x, v.y); o.y = pk2(v.z, v.w);
            const float a0 = bflo(o.x), a1 = bfhi(o.x), a2 = bflo(o.y), a3 = bfhi(o.y); ss += (a0 * a0 + a1 * a1) + (a2 * a2 + a3 * a3);
            ((u32x2*)(p.XB + (size_t)row * 1024))[lane + 64 * j] = o; }
        ss = wave_sum(ss);
        if (lane < 16) p.SSQ[(size_t)row * 16 + lane] = lane == 0 ? ss : 0.f;
        if (lane == 0) p.RINV[row] = rsqrtf(ss * (1.f / 1024.f) + EPSN);
    }
    if (gtid < MP - NT) p.RINV[NT + gtid] = 1.f;
    if (gtid < 512) p.LB[gtid] = 1.f / (1.f + __expf(p.hgrn_lb[512 + gtid] - p.hgrn_lb[gtid]));
    __syncthreads();
    {
        LAS float* zr_ = (LAS float*)lds; LAS float* zi_ = zr_ + 64; LAS float* wr_ = zi_ + 64; LAS float* wi_ = wr_ + 64;
        LAS float* bbr = wi_ + 64; LAS float* bbi = bbr + 1024; LAS float* cwr = bbi + 1024; LAS float* cwi = cwr + 16 * 65;
        for (int pair = blockIdx.x; pair < 512; pair += gridDim.x) { const int g = pair >> 4, tau = pair & 15;
            if (tid < 64) { const int n = tid; const float ar = p.a_re[g * 64 + n], ai = p.a_im[g * 64 + n]; float abr, abi; s5_pow(p, g, n, 1.f, abr, abi);
                const float den = ar * ar + ai * ai; zr_[n] = ((abr - 1.f) * ar + abi * ai) / den; zi_[n] = (abi * ar - (abr - 1.f) * ai) / den;
                float a, b; s5_pow(p, g, n, (float)tau, a, b); wr_[n] = a; wi_[n] = b; }
            __syncthreads();
#pragma unroll
            for (int k = 0; k < 2; ++k) { const int e = tid + 512 * k;
                { const int n = e >> 4; const float br = p.b_re[g * 1024 + e], bi = p.b_im[g * 1024 + e]; bbr[e] = zr_[n] * br - zi_[n] * bi; bbi[e] = zr_[n] * bi + zi_[n] * br; }
                { const int pch = e >> 6, n = e & 63; const float cr = p.c_re[g * 1024 + e], ci = p.c_im[g * 1024 + e]; cwr[pch * 65 + n] = cr * wr_[n] - ci * wi_[n]; cwi[pch * 65 + n] = cr * wi_[n] + ci * wr_[n]; } }
            __syncthreads();
            if (tid < 256) { const int pch = tid >> 4, pp = tid & 15; float acc = 0.f;
#pragma unroll 8
                for (int n = 0; n < 64; ++n) acc += cwr[pch * 65 + n] * bbr[n * 16 + pp] - cwi[pch * 65 + n] * bbi[n * 16 + pp];
                if (tau == 0 && pch == pp) acc += p.ssm_d[g * 16 + pch];
                const bf16_t kv = f2bf(acc);
                p.TG[((g * 16 + tau) * 16 + pch) * 16 + pp] = kv; }
            __syncthreads(); }
    }
    for (int i = gtid; i < 32 * 256 * 64; i += GT) {
        const int g = i >> 14, t = (i >> 10) & 15, pch = (i >> 6) & 15, n = i & 63; float wr_, wi_; s5_pow(p, g, n, (float)(t + 1), wr_, wi_);
        const float cr = p.c_re[(g * 16 + pch) * 64 + n], ci = p.c_im[(g * 16 + pch) * 64 + n];
        *(unsigned*)(p.TG + 131072 + ((size_t)(g * 256 + t * 16 + pch)) * 128 + 2 * n) = pk2(cr * wr_ - ci * wi_, -(cr * wi_ + ci * wr_)); }
    for (int i = gtid; i < 32 * 64 * 256; i += GT) {
        const int g = i >> 14, n = (i >> 8) & 63, s = (i >> 4) & 15, pp = i & 15; float wr_, wi_, br_, bi_; s5_pow(p, g, n, (float)(15 - s), wr_, wi_); s5_bbar(p, g, n, pp, br_, bi_);
        p.HT[((size_t)(g * 128 + 2 * n)) * 256 + s * 16 + pp] = f2bf(wr_ * br_ - wi_ * bi_);
        p.HT[((size_t)(g * 128 + 2 * n + 1)) * 256 + s * 16 + pp] = f2bf(wr_ * bi_ + wi_ * br_); }
    if (gtid < 2048) { float wr_, wi_; s5_pow(p, gtid >> 6, gtid & 63, 16.f, wr_, wi_); p.A16[2 * gtid] = wr_; p.A16[2 * gtid + 1] = wi_; }
}

constexpr int HP = 136, TPI = 72;
constexpr int L_QT = 0, L_QH = 17408, L_KT = 34816, L_KTT = 52224, L_IVT = 70656, L_ATT = 89088, L_SUM = 98304, L_VEC = 100352, L_OB = 0  ;
struct HItem { int row0, L, h, bh; };
DI HItem hgrn_item(int item) {
    HItem it;
    if (item < 2080) { const int bh = item / 65, c = item - bh * 65, b = bh >> 2; it.h = bh & 3; it.bh = bh; it.L = c == 0 ? 16 : 64; it.row0 = b * TP + (c == 0 ? 0 : 16 + 64 * (c - 1)); }
    else { const int s = item - 2080, b = s >> 2; it.h = s & 3; it.bh = 32 + s; it.L = 64; it.row0 = NTP + b * 64; }
    return it;
}
template <bool FULL> DI void hgrn_loadraw(const Prm& p, const HItem& it, int tid, unsigned (&rl)[16], unsigned (&rv)[16], unsigned (&rq)[16]) {
    const int d = tid & 127, t0 = 16 * (tid >> 7), col = it.h * 128 + d;
#pragma unroll
    for (int j = 0; j < 16; ++j) { const int t = t0 + j; const bool valid = t < it.L; const size_t o = (size_t)(it.row0 + t) * 512 + col;
        rl[j] = valid ? (unsigned)p.LOGF[o] : 0u; rv[j] = valid ? (unsigned)p.IV[o] : 0u; if (FULL) rq[j] = valid ? (unsigned)p.Qh[o] : 0u; }
}
template <bool FULL> DI void hgrn_prep(const HItem& it, LAS unsigned char* lds, int tid, const unsigned (&rl)[16], const unsigned (&rv)[16], const unsigned (&rq)[16]) {
    const int d = tid & 127, tq = tid >> 7, t0 = 16 * tq;
    LAS float* sums = (LAS float*)(lds + L_SUM); LAS float* vec = (LAS float*)(lds + L_VEC);
    float cs[16], lf[16];
    float run = 0.f;
#pragma unroll
    for (int j = 0; j < 16; ++j) { lf[j] = h2f((unsigned short)rl[j]); run += lf[j]; cs[j] = run; }
    sums[tq * 128 + d] = run;
    { LAS u32x4v* dst = (LAS u32x4v*)(lds + L_IVT + (d * TPI + t0) * 2); u32x4v a, b;
        a.x = rv[0] | (rv[1] << 16); a.y = rv[2] | (rv[3] << 16); a.z = rv[4] | (rv[5] << 16); a.w = rv[6] | (rv[7] << 16);
        b.x = rv[8] | (rv[9] << 16); b.y = rv[10] | (rv[11] << 16); b.z = rv[12] | (rv[13] << 16); b.w = rv[14] | (rv[15] << 16); dst[0] = a; dst[1] = b; }
    __syncthreads();
    const float s0 = sums[d], s1 = sums[128 + d], s2 = sums[256 + d], s3 = sums[384 + d];
    const float off = tq == 0 ? 0.f : tq == 1 ? s0 : tq == 2 ? s0 + s1 : s0 + s1 + s2, r = s0 + s1, bL = r + s2 + s3;
    if (tq == 0) { vec[d] = r; vec[128 + d] = bL; }
    unsigned ktp[8]; float kprev = 0.f;
#pragma unroll
    for (int j = 0; j < 16; ++j) { const int t = t0 + j; const bool valid = t < it.L; const float b = off + cs[j];
        const float kt = valid ? (1.f - __expf(lf[j])) * __expf(r - b) : 0.f;
        if (j & 1) ktp[j >> 1] = pk2(kprev, kt); else kprev = kt;
        if (FULL) { const float qv = bf2f((unsigned short)rq[j]);
            *(LAS unsigned short*)(lds + L_KT + (t * HP + d) * 2) = f2bf(kt);
            *(LAS unsigned short*)(lds + L_QT + (t * HP + d) * 2) = f2bf(qv * __expf(b - r));
            *(LAS unsigned short*)(lds + L_QH + (t * HP + d) * 2) = f2bf(qv * __expf(b)); } }
    if (!FULL) { LAS u32x4v* dst = (LAS u32x4v*)(lds + L_KTT + (d * TPI + t0) * 2); u32x4v a, b; a.x = ktp[0]; a.y = ktp[1]; a.z = ktp[2]; a.w = ktp[3]; b.x = ktp[4]; b.y = ktp[5]; b.z = ktp[6]; b.w = ktp[7]; dst[0] = a; dst[1] = b; }
    __syncthreads();
}
#define MFMA16(a, b, c) __builtin_amdgcn_mfma_f32_16x16x32_bf16((a), (b), (c), 0, 0, 0)
#define MFMA32(a, b, c) __builtin_amdgcn_mfma_f32_32x32x16_bf16((a), (b), (c), 0, 0, 0)
DI void hgrn_b1_all(const Prm& p, LAS unsigned char* lds, int tid, int lane, int wave) {
    const int fr = lane & 15, fq = lane >> 4;
    int item = blockIdx.x; if (item >= NITEM_H) return;
    unsigned rl[16], rv[16], rq[16];
    hgrn_loadraw<false>(p, hgrn_item(item), tid, rl, rv, rq);
    while (item < NITEM_H) {
        const HItem it = hgrn_item(item);
        hgrn_prep<false>(it, lds, tid, rl, rv, rq);
        const int next = item + gridDim.x;
        if (next < NITEM_H) hgrn_loadraw<false>(p, hgrn_item(next), tid, rl, rv, rq);
        const LAS float* vec = (const LAS float*)(lds + L_VEC);
        bf16x8 a[2];
#pragma unroll
        for (int ks = 0; ks < 2; ++ks) a[ks] = *(const LAS bf16x8*)(lds + L_KTT + ((16 * wave + fr) * TPI + 32 * ks + 8 * fq) * 2);
        float e2[4];
#pragma unroll
        for (int j = 0; j < 4; ++j) { const int d = 16 * wave + 4 * fq + j; e2[j] = __expf(vec[128 + d] - vec[d]); }
#pragma unroll
        for (int vt = 0; vt < 8; ++vt) { f32x4 acc = {0.f, 0.f, 0.f, 0.f};
#pragma unroll
            for (int ks = 0; ks < 2; ++ks) { const bf16x8 b = *(const LAS bf16x8*)(lds + L_IVT + ((16 * vt + fr) * TPI + 32 * ks + 8 * fq) * 2); acc = MFMA16(a[ks], b, acc); }
            u32x2 o; o.x = pk2(acc[0] * e2[0], acc[1] * e2[1]); o.y = pk2(acc[2] * e2[2], acc[3] * e2[3]);
            *(u32x2*)(p.UT + (size_t)item * 16384 + (16 * vt + fr) * 128 + 16 * wave + 4 * fq) = o; }
        if (tid < 128) p.AL[(size_t)item * 128 + tid] = __expf(vec[128 + tid]);
        __syncthreads();
        item = next;
    }
}
template <int NB> DI void hgrn_b2_steps(const Prm& p, int item, int v, int d4, float (&S)[4]) {
    u32x2 uu[NB]; f32x4 al[NB];
#pragma unroll
    for (int i = 0; i < NB; ++i) { uu[i] = *(const u32x2*)(p.UT + (size_t)(item + i) * 16384 + v * 128 + d4); al[i] = *(const f32x4*)(p.AL + (size_t)(item + i) * 128 + d4); }
#pragma unroll
    for (int i = 0; i < NB; ++i) { u32x2 o; o.x = pk2(S[0], S[1]); o.y = pk2(S[2], S[3]);
        *(u32x2*)(p.UT + (size_t)(item + i) * 16384 + v * 128 + d4) = o;
        S[0] = al[i][0] * S[0] + bflo(uu[i].x); S[1] = al[i][1] * S[1] + bfhi(uu[i].x); S[2] = al[i][2] * S[2] + bflo(uu[i].y); S[3] = al[i][3] * S[3] + bfhi(uu[i].y); }
}
DI void hgrn_b2(const Prm& p, int gtid, int GT) {
    for (int idx = gtid; idx < 64 * 4096; idx += GT) {
        const int bhx = idx >> 12, e = idx & 4095, v = e >> 5, d4 = (e & 31) * 4; const bool smp = bhx >= 32;
        float S[4] = {0.f, 0.f, 0.f, 0.f};
        if (smp) {
#pragma unroll
            for (int j = 0; j < 4; ++j) S[j] = p.state_hgrn[((size_t)(bhx - 32) * 128 + d4 + j) * 128 + v];
            hgrn_b2_steps<1>(p, 2080 + (bhx - 32), v, d4, S); }
        else { for (int c0 = 0; c0 < 65; c0 += 13) hgrn_b2_steps<13>(p, bhx * 65 + c0, v, d4, S); }
        float* dst = p.out + (smp ? O_HGS + (size_t)(bhx - 32) * 16384 : O_HGP + (size_t)bhx * 16384);
#pragma unroll
        for (int j = 0; j < 4; ++j) dst[(d4 + j) * 128 + v] = S[j];
    }
}
DI void hgrn_b3_all(const Prm& p, LAS unsigned char* lds, int tid, int lane, int wave) {
    const int fr = lane & 15, fq = lane >> 4;
    int item = blockIdx.x; if (item >= NITEM_H) return;
    unsigned rl[16], rv[16], rq[16];
    hgrn_loadraw<true>(p, hgrn_item(item), tid, rl, rv, rq);
    const int nt_ = tid >> 3, nsg = tid & 7;
    while (item < NITEM_H) {
        const HItem it = hgrn_item(item);
        bf16x8 sf[4][4];
#pragma unroll
        for (int i = 0; i < 4; ++i)
#pragma unroll
            for (int ks = 0; ks < 4; ++ks) sf[i][ks] = *(const bf16x8*)(p.UT + (size_t)item * 16384 + (16 * (4 * (wave >> 2) + i) + fr) * 128 + 32 * ks + 8 * fq);
        const size_t grow = (size_t)(it.row0 + (nt_ < it.L ? nt_ : 0)); const int gc0 = it.h * 128 + 16 * nsg;
        const u32x4v g0 = *(const u32x4v*)(p.GS + grow * 512 + gc0), g1 = *(const u32x4v*)(p.GS + grow * 512 + gc0 + 8);
        hgrn_prep<true>(it, lds, tid, rl, rv, rq);
        const int next = item + gridDim.x;
        if (next < NITEM_H) hgrn_loadraw<true>(p, hgrn_item(next), tid, rl, rv, rq);
        {
            const int tt = wave >> 1;
#pragma unroll
            for (int i = 0; i < 2; ++i) { const int st = 2 * (wave & 1) + i; f32x4 acc = {0.f, 0.f, 0.f, 0.f};
#pragma unroll
                for (int ks = 0; ks < 4; ++ks) { const bf16x8 a = *(const LAS bf16x8*)(lds + L_KT + ((16 * st + fr) * HP + 32 * ks + 8 * fq) * 2);
                    const bf16x8 b = *(const LAS bf16x8*)(lds + L_QT + ((16 * tt + fr) * HP + 32 * ks + 8 * fq) * 2); acc = MFMA16(a, b, acc); }
                const int t = 16 * tt + fr, s0 = 16 * st + 4 * fq;
                u32x2 o; o.x = pk2(s0 <= t ? acc[0] : 0.f, s0 + 1 <= t ? acc[1] : 0.f); o.y = pk2(s0 + 2 <= t ? acc[2] : 0.f, s0 + 3 <= t ? acc[3] : 0.f);
                *(LAS u32x2*)(lds + L_ATT + (t * TPI + s0) * 2) = o; }
        }
        __syncthreads();
        f32x4 oacc[4];
        {   const int tt = wave & 3;
            bf16x8 aa[2], aq[4];
#pragma unroll
            for (int ks = 0; ks < 2; ++ks) aa[ks] = *(const LAS bf16x8*)(lds + L_ATT + ((16 * tt + fr) * TPI + 32 * ks + 8 * fq) * 2);
#pragma unroll
            for (int ks = 0; ks < 4; ++ks) aq[ks] = *(const LAS bf16x8*)(lds + L_QH + ((16 * tt + fr) * HP + 32 * ks + 8 * fq) * 2);
#pragma unroll
            for (int i = 0; i < 4; ++i) { const int vt = 4 * (wave >> 2) + i; f32x4 acc = {0.f, 0.f, 0.f, 0.f};
#pragma unroll
                for (int ks = 0; ks < 2; ++ks) { const bf16x8 b = *(const LAS bf16x8*)(lds + L_IVT + ((16 * vt + fr) * TPI + 32 * ks + 8 * fq) * 2); acc = MFMA16(aa[ks], b, acc); }
#pragma unroll
                for (int ks = 0; ks < 4; ++ks) acc = MFMA16(aq[ks], sf[i][ks], acc);
                oacc[i] = acc; }
        }
        f32x4 gn[4];
#pragma unroll
        for (int j = 0; j < 4; ++j) gn[j] = ((const f32x4*)(p.hgrn_norm + 16 * nsg))[j];
        __syncthreads();
        {   const int tt = wave & 3; LAS float* ob = (LAS float*)(lds + L_OB);
#pragma unroll
            for (int i = 0; i < 4; ++i) { const int v = 16 * (4 * (wave >> 2) + i) + fr;
#pragma unroll
                for (int j = 0; j < 4; ++j) ob[(16 * tt + 4 * fq + j) * 132 + v] = oacc[i][j]; }
        }
        __syncthreads();
        {   const int t = nt_, sg = nsg; const LAS float* ob = (const LAS float*)(lds + L_OB) + t * 132 + 16 * sg;
            f32x4 x[4]; float ss = 0.f;
#pragma unroll
            for (int j = 0; j < 4; ++j) { x[j] = ((const LAS f32x4*)ob)[j]; ss += (x[j].x * x[j].x + x[j].y * x[j].y) + (x[j].z * x[j].z + x[j].w * x[j].w); }
            ss += __shfl_xor(ss, 1); ss += __shfl_xor(ss, 2); ss += __shfl_xor(ss, 4);
            const float rr = rsqrtf(ss * (1.f / 128.f) + EPSN);
            if (t < it.L) { const size_t row = it.row0 + t; const int c0 = it.h * 128 + 16 * sg;
                const f32x4 n0 = gn[0], n1 = gn[1], n2 = gn[2], n3 = gn[3];
                u32x4v o0, o1;
                o0.x = pk2(x[0].x * rr * n0.x * bflo(g0.x), x[0].y * rr * n0.y * bfhi(g0.x)); o0.y = pk2(x[0].z * rr * n0.z * bflo(g0.y), x[0].w * rr * n0.w * bfhi(g0.y));
                o0.z = pk2(x[1].x * rr * n1.x * bflo(g0.z), x[1].y * rr * n1.y * bfhi(g0.z)); o0.w = pk2(x[1].z * rr * n1.z * bflo(g0.w), x[1].w * rr * n1.w * bfhi(g0.w));
                o1.x = pk2(x[2].x * rr * n2.x * bflo(g1.x), x[2].y * rr * n2.y * bfhi(g1.x)); o1.y = pk2(x[2].z * rr * n2.z * bflo(g1.y), x[2].w * rr * n2.w * bfhi(g1.y));
                o1.z = pk2(x[3].x * rr * n3.x * bflo(g1.z), x[3].y * rr * n3.y * bfhi(g1.z)); o1.w = pk2(x[3].z * rr * n3.z * bflo(g1.w), x[3].w * rr * n3.w * bfhi(g1.w));
                *(u32x4v*)(p.CAT + row * 1024 + c0) = o0; *(u32x4v*)(p.CAT + row * 1024 + c0 + 8) = o1; }
        }
        __syncthreads();
        item = next;
    }
}
DI void s5_load_u(const Prm& p, int mt, int g, int lane, bf16x8 (&uf)[8]) {
    const int fr = lane & 15, fq = lane >> 4; int col = 16 * mt + fr; if (col >= NCOL) col = NCOL - 1;
#pragma unroll
    for (int ks = 0; ks < 8; ++ks) uf[ks] = *(const bf16x8*)(p.U + ((size_t)(16 * col + 2 * ks + (fq >> 1))) * 512 + 16 * g + 8 * (fq & 1));
}
DI void s5_b(const Prm& p, int gw, int NGW, int lane) {
    const int fr = lane & 15, fq = lane >> 4;
    for (int task = gw; task < 131 * 32; task += NGW) { const int mt = task >> 5, g = task & 31;
        bf16x8 uf[8]; s5_load_u(p, mt, g, lane, uf);
#pragma unroll
        for (int nt = 0; nt < 8; ++nt) { f32x4 acc = {0.f, 0.f, 0.f, 0.f};
#pragma unroll
            for (int ks = 0; ks < 8; ++ks) { const bf16x8 b = *(const bf16x8*)(p.HT + ((size_t)(g * 128 + 16 * nt + fr)) * 256 + 32 * ks + 8 * fq); acc = MFMA16(uf[ks], b, acc); }
#pragma unroll
            for (int j = 0; j < 4; ++j) { const int col = 16 * mt + 4 * fq + j; if (col < NCOL) p.XLOC[(size_t)col * 4096 + g * 128 + 16 * nt + fr] = acc[j]; } }
    }
}
template <int NB> DI void s5_c_steps(const Prm& p, int col, size_t base, float ar, float ai, float& xr, float& xi) {
    f32x2v xl[NB];
#pragma unroll
    for (int i = 0; i < NB; ++i) xl[i] = *(const f32x2v*)(p.XLOC + (size_t)(col + i) * 4096 + base);
#pragma unroll
    for (int i = 0; i < NB; ++i) { *(unsigned*)(p.XPREV + (size_t)(col + i) * 4096 + base) = pk2(xr, xi);
        const float nr = ar * xr - ai * xi + xl[i].x, ni = ar * xi + ai * xr + xl[i].y; xr = nr; xi = ni; }
}
DI void s5_c(const Prm& p, int gtid) {
    if (gtid >= 16 * 2048) return;
    const int seq = gtid >> 11, g = (gtid >> 6) & 31, n = gtid & 63; const bool smp = seq >= 8; const int b = seq & 7;
    float xr = 0.f, xi = 0.f; if (smp) { xr = p.ssm_re0[(b * 32 + g) * 64 + n]; xi = p.ssm_im0[(b * 32 + g) * 64 + n]; }
    const float ar = p.A16[2 * (g * 64 + n)], ai = p.A16[2 * (g * 64 + n) + 1];
    const size_t base = (size_t)g * 128 + 2 * n;
    if (smp) s5_c_steps<4>(p, 2056 + 4 * b, base, ar, ai, xr, xi);
    else { for (int c0 = 0; c0 < 256; c0 += 16) s5_c_steps<16>(p, 257 * b + c0, base, ar, ai, xr, xi); s5_c_steps<1>(p, 257 * b + 256, base, ar, ai, xr, xi); }
    const size_t o = (size_t)(b * 32 + g) * 64 + n;
    p.out[(smp ? O_SRS : O_SRP) + o] = xr; p.out[(smp ? O_SIS : O_SIP) + o] = xi;
}
DI f32x2v gelu_pk(f32x2v v) {
    const f32x2v av = __builtin_elementwise_abs(v), d = av * 0.2316418882f + 1.0f;
    f32x2v t; t.x = __builtin_amdgcn_rcpf(d.x); t.y = __builtin_amdgcn_rcpf(d.y);
    f32x2v q = t * 0.5307027145f + (-0.7265760135f); q = q * t + 0.7107068705f; q = q * t + (-0.142248368f); q = q * t + 0.127414796f; q = q * t;
    const f32x2v s = (v * v) * (-0.72134752044f);
    f32x2v e; e.x = __builtin_amdgcn_exp2f(s.x); e.y = __builtin_amdgcn_exp2f(s.y);
    const f32x2v m = v * (q * e), r = v - m;
    f32x2v o; o.x = v.x < 0.f ? m.x : r.x; o.y = v.y < 0.f ? m.y : r.y; return o;
}
DI void s5_d(const Prm& p, int gw, int NGW, int lane) {
    const int fr = lane & 15, fq = lane >> 4;
    for (int task = gw; task < 131 * 32; task += NGW) { const int mt = task >> 5, g = task & 31;
        bf16x8 uf[8], xf[4]; s5_load_u(p, mt, g, lane, uf);
        int colc = 16 * mt + fr; if (colc >= NCOL) colc = NCOL - 1;
#pragma unroll
        for (int ks = 0; ks < 4; ++ks) xf[ks] = *(const bf16x8*)(p.XPREV + (size_t)colc * 4096 + g * 128 + 32 * ks + 8 * fq);
        const bf16_t* tg = p.TG + ((size_t)(g * 256 + fr)) * 384 + 8 * fq;
        const bool ok = 16 * mt + fr < NCOL;
#pragma unroll
        for (int t = 0; t < 16; ++t) { f32x4 acc = {0.f, 0.f, 0.f, 0.f};
#pragma unroll
            for (int ks = 0; ks < 8; ++ks) if (ks <= (t >> 1)) { const bf16x8 a = *(const bf16x8*)(tg + (size_t)t * 16 * 384 + 32 * ks); acc = MFMA16(a, uf[ks], acc); }
#pragma unroll
            for (int ks = 0; ks < 4; ++ks) { const bf16x8 a = *(const bf16x8*)(tg + (size_t)t * 16 * 384 + 256 + 32 * ks); acc = MFMA16(a, xf[ks], acc); }
            const f32x2v y0 = gelu_pk((f32x2v){acc[0], acc[1]}), y1 = gelu_pk((f32x2v){acc[2], acc[3]});
            u32x2 o; o.x = pk2(y0.x, y0.y); o.y = pk2(y1.x, y1.y);
            if (ok) *(u32x2*)(p.YG + ((size_t)(16 * (16 * mt + fr) + t)) * 512 + 16 * g + 4 * fq) = o; }
    }
}

DI void s5_b_lds(const Prm& p, LAS unsigned char* lds, int tid, int lane, int wave) {
    const int fr = lane & 15, fq = lane >> 4;
    for (int gp = blockIdx.x; gp < 256; gp += gridDim.x) { const int g = gp & 31, part = gp >> 5;
        for (int i = tid; i < 128 * 32; i += 512) { const int row = i >> 5, ch = i & 31;
            *(LAS u32x4v*)(lds + row * 528 + ch * 16) = *(const u32x4v*)(p.HT + ((size_t)(g * 128 + row)) * 256 + ch * 8); }
        __syncthreads();
        for (int mt = part + 8 * wave; mt < 131; mt += 64) {
            bf16x8 uf[8]; s5_load_u(p, mt, g, lane, uf);
#pragma unroll 1
            for (int nt = 0; nt < 8; ++nt) { f32x4 acc = {0.f, 0.f, 0.f, 0.f};
#pragma unroll
                for (int ks = 0; ks < 8; ++ks) { const bf16x8 b = *(const LAS bf16x8*)(lds + (16 * nt + fr) * 528 + 64 * ks + 16 * fq); acc = MFMA16(uf[ks], b, acc); }
#pragma unroll
                for (int j = 0; j < 4; ++j) { const int col = 16 * mt + 4 * fq + j; if (col < NCOL) p.XLOC[(size_t)col * 4096 + g * 128 + 16 * nt + fr] = acc[j]; } }
        }
        __syncthreads(); }
}
DI void s5_d_lds(const Prm& p, LAS unsigned char* lds, int tid, int lane, int wave) {
    const int fr = lane & 15, fq = lane >> 4;
    for (int gp = blockIdx.x; gp < 256; gp += gridDim.x) { const int g = gp & 31, part = gp >> 5;
        { const int row = tid >> 1, hf = tid & 1;
            *(LAS u32x4v*)(lds + row * 48 + hf * 16) = *(const u32x4v*)(p.TG + ((size_t)(g * 256 + row)) * 16 + hf * 8); }
        for (int i = tid; i < 256 * 16; i += 512) { const int row = i >> 4, ch = i & 15;
            *(LAS u32x4v*)(lds + 12288 + row * 272 + ch * 16) = *(const u32x4v*)(p.TG + 131072 + ((size_t)(g * 256 + row)) * 128 + ch * 8); }
        __syncthreads();
        const int lb = fr * 48 + (fq & 1) * 16, hi = fq >> 1;
        for (int mt = part + 8 * wave; mt < 131; mt += 64) {
            bf16x8 uf[8], xf[4]; s5_load_u(p, mt, g, lane, uf);
            int colc = 16 * mt + fr; if (colc >= NCOL) colc = NCOL - 1;
#pragma unroll
            for (int ks = 0; ks < 4; ++ks) xf[ks] = *(const bf16x8*)(p.XPREV + (size_t)colc * 4096 + g * 128 + 32 * ks + 8 * fq);
            const bool ok = 16 * mt + fr < NCOL;
#pragma unroll 1
            for (int t = 0; t < 16; ++t) { f32x4 acc = {0.f, 0.f, 0.f, 0.f};
#pragma unroll
                for (int ks = 0; ks < 8; ++ks) if (ks <= (t >> 1)) {
                    const int tau = t - 2 * ks - hi;
                    union { bf16x8 v; u32x4v u; } a; a.v = *(const LAS bf16x8*)(lds + (tau < 0 ? 0 : tau) * 768 + lb);
                    if (tau < 0) a.u = (u32x4v){0u, 0u, 0u, 0u};
                    acc = MFMA16(a.v, uf[ks], acc); }
#pragma unroll
                for (int ks = 0; ks < 4; ++ks) { const bf16x8 a = *(const LAS bf16x8*)(lds + 12288 + (t * 16 + fr) * 272 + 64 * ks + 16 * fq); acc = MFMA16(a, xf[ks], acc); }
                const f32x2v y0 = gelu_pk((f32x2v){acc[0], acc[1]}), y1 = gelu_pk((f32x2v){acc[2], acc[3]});
                u32x2 o; o.x = pk2(y0.x, y0.y); o.y = pk2(y1.x, y1.y);
                if (ok) *(u32x2*)(p.YG + ((size_t)(16 * (16 * mt + fr) + t)) * 512 + 16 * g + 4 * fq) = o; }
        }
        __syncthreads(); }
}
DI void cache_convert(const Prm& p, int gtid, int GT) {
    for (size_t i = (size_t)gtid; i < (size_t)8 * 1024 * 256; i += (size_t)GT) {
        const size_t row = i >> 8; const int c4 = (int)(i & 255) * 4, b = (int)(row >> 10), pos = (int)(row & 1023), h = c4 >> 7, d = c4 & 127;
        const f32x4 k = *(const f32x4*)(p.cache_k + row * 1024 + c4); u32x2 o; o.x = pk2(k.x, k.y); o.y = pk2(k.z, k.w);
        *(u32x2*)(p.KS + kf_index(b * 8 + h, 34, pos, d)) = o;
        const f32x4 v = *(const f32x4*)(p.cache_v + row * 1024 + c4); bf16_t* vt = p.VTS + vf_index(b * 8 + h, 34, pos, d);
        vt[0] = f2bf(v.x); vt[8] = f2bf(v.y); vt[16] = f2bf(v.z); vt[24] = f2bf(v.w); }
}
DI void attn_phase(const Prm& p, int gw, int NGW, int lane) {
    const int q = lane & 31, half = lane >> 5;
    for (int it = gw; it < 8256 + 128; it += NGW) {
        bool smp; int b, h, qb;
        if (it < 8064) { smp = false; b = it / 1008; const int rem = it - b * 1008; h = rem / 126; qb = 3 + rem - h * 126; }
        else if (it < 8192) { const int s = it - 8064; smp = true; b = s >> 4; h = (s >> 1) & 7; qb = s & 1; }
        else { const int s = it - 8192; smp = false; b = s / 24; const int rem = s - b * 24; h = rem / 3; qb = rem - h * 3; }
        const size_t tbase = (size_t)(b * 8 + h) * (smp ? 34 : 129) * 4096 + lane * 8;
        const bf16_t* Kb = (smp ? p.KS : p.KP) + tbase; const bf16_t* Vb = (smp ? p.VTS : p.VTP) + tbase;
        const int qpos0 = (smp ? 1024 : 0) + 32 * qb, qrow0 = smp ? NTP + b * 64 + 32 * qb : b * TP + 32 * qb;
        const int qpos = qpos0 + q; const bool qvalid = smp || qpos < TP; const size_t qrow = qvalid ? qrow0 + q : qrow0;
        bf16x8 qf[8];
#pragma unroll
        for (int ks = 0; ks < 8; ++ks) qf[ks] = *(const bf16x8*)(p.Q + qrow * 1024 + h * 128 + 16 * ks + 8 * half);
        f32x16 o[4];
#pragma unroll
        for (int db = 0; db < 4; ++db)
#pragma unroll
            for (int e = 0; e < 16; ++e) o[db][e] = 0.f;
        float C = 1.f;
        for (int kt = (qpos0 + 30) >> 5; kt >= 0; --kt) {
            f32x16 s;
#pragma unroll
            for (int e = 0; e < 16; ++e) s[e] = 0.f;
            const bf16_t* kr = Kb + (size_t)kt * 4096; const bf16_t* vr = Vb + (size_t)kt * 4096;
            bf16x8 kf[8], vf[8];
#pragma unroll
            for (int ks = 0; ks < 8; ++ks) kf[ks] = *(const bf16x8*)(kr + ks * 512);
#pragma unroll
            for (int ks = 0; ks < 8; ++ks) vf[ks] = *(const bf16x8*)(vr + ks * 512);
#pragma unroll
            for (int ks = 0; ks < 8; ++ks) s = MFMA32(kf[ks], qf[ks], s);
            float pr[16], be[16], G[4], Gp[4];
#pragma unroll
            for (int i = 0; i < 4; ++i) {
#pragma unroll
                for (int j = 0; j < 4; ++j) { const int key = 32 * kt + 8 * i + 4 * half + j; const bool valid = key < qpos;
                    float z = s[4 * i + j] * 0.08838834764831845f; z = fminf(fmaxf(z, -80.f), 80.f);
                    const float e = __expf(z), pp = __builtin_amdgcn_rcpf(1.f + e); pr[4 * i + j] = valid ? pp : 1.f; be[4 * i + j] = valid ? e * pp : 0.f; }
                G[i] = (pr[4 * i] * pr[4 * i + 1]) * (pr[4 * i + 2] * pr[4 * i + 3]); }
#pragma unroll
            for (int i = 0; i < 4; ++i) Gp[i] = __shfl_xor(G[i], 32);
            float w[16]; float E1 = 1.f;
#pragma unroll
            for (int i = 3; i >= 0; --i) { const float Glo = half ? Gp[i] : G[i], Ghi = half ? G[i] : Gp[i];
                float suf = C * (half ? E1 : E1 * Ghi);
#pragma unroll
                for (int j = 3; j >= 0; --j) { w[4 * i + j] = be[4 * i + j] * suf; suf *= pr[4 * i + j]; }
                E1 *= Glo * Ghi; }
            C *= E1;
#pragma unroll
            for (int c = 0; c < 2; ++c) { union { bf16x8 v; unsigned u[4]; } wf;
#pragma unroll
                for (int e = 0; e < 4; ++e) wf.u[e] = pk2(w[8 * c + 2 * e], w[8 * c + 2 * e + 1]);
#pragma unroll
                for (int db = 0; db < 4; ++db) o[db] = MFMA32(vf[4 * c + db], wf.v, o[db]); }
            if (__all(C < 1e-24f)) break;
        }
        if (qvalid) {
#pragma unroll
            for (int db = 0; db < 4; ++db)
#pragma unroll
                for (int i = 0; i < 4; ++i) { u32x2 ov; ov.x = pk2(o[db][4 * i], o[db][4 * i + 1]); ov.y = pk2(o[db][4 * i + 2], o[db][4 * i + 3]);
                    *(u32x2*)(p.O + qrow * 1024 + h * 128 + 32 * db + 8 * i + 4 * half) = ov; } }
    }
}
DI void final_norm(const Prm& p, int gw, int NGW, int lane) {
    for (int r = gw; r < 32768 + 512; r += NGW) {
        int grow; float* dst;
        if (r < 32768) { const int b = r >> 12, t = r & 4095; grow = b * TP + 16 + t; dst = p.out + O_YP + (size_t)r * 1024; } else { grow = NTP + (r - 32768); dst = p.out + O_YS + (size_t)(r - 32768) * 1024; }
        u32x2 x[4];
#pragma unroll
        for (int j = 0; j < 4; ++j) x[j] = ((const u32x2*)(p.XB + (size_t)grow * 1024))[lane + 64 * j];
        const float rr = row_rinv(p.SSQ, grow);
#pragma unroll
        for (int j = 0; j < 4; ++j) { f32x4 v; v.x = bflo(x[j].x); v.y = bfhi(x[j].x); v.z = bflo(x[j].y); v.w = bfhi(x[j].y); ((f32x4*)dst)[lane + 64 * j] = v * rr * ((const f32x4*)p.ln_final)[lane + 64 * j]; }
    }
}

#define XB_TMO      128
#define XB_XCNT(j)  (256  + 64 * (j))
#define XB_XSUB(j)  (1280 + 64 * (j))
#define XB_XGEN(j)  (2304 + 64 * (j))
#define XB_TOP      3328
#define XB_TOPGEN   3392
#define XCD_BAR_WORDS 3456
#define XB_SPIN_CAP (1u << 18)
DI unsigned xb_ld(unsigned* p) { return __hip_atomic_load(p, __ATOMIC_RELAXED, __HIP_MEMORY_SCOPE_AGENT); }
DI unsigned xb_add(unsigned* p, unsigned v) { return __hip_atomic_fetch_add(p, v, __ATOMIC_RELAXED, __HIP_MEMORY_SCOPE_AGENT); }
DI unsigned xb_xcc_id() { return (unsigned)__builtin_amdgcn_s_getreg((3 << 11) | 20) & 0xFu; }
#define XB_SPIN(cond, bar) do { unsigned _sp = 0; while (cond) { __builtin_amdgcn_s_sleep(1); \
    if ((++_sp & 255u) == 0u) { if (xb_ld(&(bar)[XB_TMO])) break; if (_sp > XB_SPIN_CAP) { atomicAdd(&(bar)[XB_TMO], 1u); break; } } } } while (0)
struct XcdBarrier { unsigned* bar; unsigned x; volatile LAS unsigned* st; };
DI XcdBarrier xcd_barrier_post(unsigned* bar, volatile LAS unsigned* st) {
    XcdBarrier b; b.bar = bar; b.x = xb_xcc_id(); b.st = st;
    if (threadIdx.x == 0) (void)xb_add(&bar[XB_XCNT(b.x)], 1u);
    return b;
}
DI void xcd_barrier_complete(unsigned* bar, unsigned x, unsigned& nloc, unsigned& nx) {
    const unsigned G = gridDim.x * gridDim.y * gridDim.z;
    unsigned sum, cnt, mine, sp = 0u;
    for (;;) {
        sum = 0u; cnt = 0u; mine = 0u;
#pragma unroll
        for (unsigned j = 0; j < 16; ++j) { const unsigned c = xb_ld(&bar[XB_XCNT(j)]); sum += c; cnt += (c > 0u) ? 1u : 0u; mine = (j == x) ? c : mine; }
        if (sum == G) break;
        __builtin_amdgcn_s_sleep(1);
        if ((++sp & 255u) == 0u) { if (xb_ld(&bar[XB_TMO])) break; if (sp > XB_SPIN_CAP) { atomicAdd(&bar[XB_TMO], 1u); break; } }
    }
    nloc = mine > 0u ? mine : 1u; nx = cnt > 0u ? cnt : 1u;
}
DI void xcd_barrier(const XcdBarrier& b) {
    asm volatile("s_waitcnt vmcnt(0)" ::: "memory");
    __syncthreads();
    if (threadIdx.x == 0) {
        unsigned* bar = b.bar;
        __builtin_amdgcn_s_waitcnt(0);
        unsigned nloc = b.st[0], nx = b.st[1];
        if (nloc == 0u) { xcd_barrier_complete(bar, b.x, nloc, nx); b.st[0] = nloc; b.st[1] = nx; }
        const unsigned old = xb_add(&bar[XB_XSUB(b.x)], 1u);
        const unsigned gen = old / nloc;
        if (old + 1u == (gen + 1u) * nloc) {
            __builtin_amdgcn_fence(__ATOMIC_RELEASE, "agent");
            asm volatile("s_waitcnt vmcnt(0)" ::: "memory");
            const unsigned og = xb_add(&bar[XB_TOP], 1u);
            const unsigned tg = og / nx;
            if (og + 1u == (tg + 1u) * nx) xb_add(&bar[XB_TOPGEN], 1u);
            else XB_SPIN(xb_ld(&bar[XB_TOPGEN]) == tg, bar);
            __builtin_amdgcn_fence(__ATOMIC_ACQUIRE, "agent");
            xb_add(&bar[XB_XGEN(b.x)], 1u);
            asm volatile("s_waitcnt vmcnt(0)" ::: "memory");
        } else {
            XB_SPIN(xb_ld(&bar[XB_XGEN(b.x)]) == gen, bar);
            __builtin_amdgcn_fence(__ATOMIC_ACQUIRE, "agent");
            asm volatile("s_waitcnt vmcnt(0)" ::: "memory");
        }
    }
    __syncthreads();
}
constexpr int LDS_BYTES = 131072 + 256;
__global__ void __launch_bounds__(512, 2) fwd_megakernel(Prm p) {
    extern __shared__ __attribute__((aligned(16))) unsigned char shm[];
    LAS unsigned char* lds = (LAS unsigned char*)shm;
    cg::grid_group grid = cg::this_grid();
    const int tid = threadIdx.x, lane = tid & 63, wave = __builtin_amdgcn_readfirstlane(tid >> 6);
    const int gw = blockIdx.x * 8 + wave, NGW = gridDim.x * 8, gtid = blockIdx.x * 512 + tid, GT = gridDim.x * 512;
    volatile LAS unsigned* xst = (volatile LAS unsigned*)(lds + 131072);
    if (tid == 0) { xst[0] = 0u; xst[1] = 0u; }
    __syncthreads();
    const XcdBarrier xb = xcd_barrier_post(p.BAR, xst);
    phase_prologue(p, lds, tid, lane, wave);
    grid.sync();
    { EpiIn0 E; E.SSQ = p.SSQ; E.RINV = p.RINV; E.LB = p.LB; E.Qh = p.Qh; E.IV = p.IV; E.GS = p.GS; E.U = p.U; E.LOGF = p.LOGF; run_gemm(lds, p.XB, p.Wt1, 2560, 1024, E); }
    xcd_barrier(xb);
    hgrn_b1_all(p, lds, tid, lane, wave);
    s5_b_lds(p, lds, tid, lane, wave);
    xcd_barrier(xb);
    hgrn_b2(p, gtid, GT);
    s5_c(p, gtid);
    xcd_barrier(xb);
    hgrn_b3_all(p, lds, tid, lane, wave);
    s5_d_lds(p, lds, tid, lane, wave);
    xcd_barrier(xb);
    { EpiGlu E; E.YG = p.YG; E.CAT = p.CAT; run_gemm(lds, p.YG, p.Wglu, 512, 512, E); }
    xcd_barrier(xb);
    { EpiRes E; E.XB = p.XB; E.SSQ = p.SSQ; run_gemm_split(lds, p.CAT, p.Wo0, 1024, 1024, E, (float*)p.H); xcd_barrier(xb); gemm_fixup(1024, 1024, E, (const float*)p.H, tid); rinv_pass(p, 1024, tid); }
    xcd_barrier(xb);
    { EpiUp E; E.SSQ = p.SSQ; E.RINV = p.RINV; E.H = p.H; run_gemm(lds, p.XB, p.Wup0, 4096, 1024, E); }
    xcd_barrier(xb);
    { EpiRes E; E.XB = p.XB; E.SSQ = p.SSQ; run_gemm_split(lds, p.H, p.Wdn0, 1024, 4096, E, (float*)p.CAT); xcd_barrier(xb); gemm_fixup(1024, 4096, E, (const float*)p.CAT, tid); rinv_pass(p, 4096, tid); }
    xcd_barrier(xb);
    { EpiQkv E; E.SSQ = p.SSQ; E.RINV = p.RINV; E.out = p.out; E.Q = p.Q; E.KP = p.KP; E.KS = p.KS; E.VTP = p.VTP; E.VTS = p.VTS; run_gemm(lds, p.XB, p.Wqkv, 3072, 1024, E); }
    if (gridDim.x > 36) { if (blockIdx.x >= 36) cache_convert(p, (blockIdx.x - 36) * 512 + tid, (gridDim.x - 36) * 512); } else cache_convert(p, gtid, GT);
    xcd_barrier(xb);
    attn_phase(p, gw, NGW, lane);
    xcd_barrier(xb);
    { EpiRes E; E.XB = p.XB; E.SSQ = p.SSQ; run_gemm_split(lds, p.O, p.Wo1, 1024, 1024, E, (float*)p.H); xcd_barrier(xb); gemm_fixup(1024, 1024, E, (const float*)p.H, tid); rinv_pass(p, 1024, tid); }
    xcd_barrier(xb);
    { EpiUp E; E.SSQ = p.SSQ; E.RINV = p.RINV; E.H = p.H; run_gemm(lds, p.XB, p.Wup1, 4096, 1024, E); }
    xcd_barrier(xb);
    { EpiRes E; E.XB = p.XB; E.SSQ = p.SSQ; run_gemm_split(lds, p.H, p.Wdn1, 1024, 4096, E, (float*)p.CAT); xcd_barrier(xb); gemm_fixup(1024, 4096, E, (const float*)p.CAT, tid); }
    xcd_barrier(xb);
    final_norm(p, gw, NGW, lane);
}

extern "C" void kernel_launch(void* const* d_in, const int* in_sizes, int n_in, void* d_out, int out_size, void* d_ws, size_t ws_size, hipStream_t stream) {
    static int grid_blocks = 0;
    if (grid_blocks == 0) {
        int dev = 0, cus = 0, per_cu = 0;
        hipGetDevice(&dev); hipDeviceGetAttribute(&cus, hipDeviceAttributeMultiprocessorCount, dev);
        if (hipFuncSetAttribute((const void*)fwd_megakernel, hipFuncAttributeMaxDynamicSharedMemorySize, LDS_BYTES) != hipSuccess) fprintf(stderr, "kernel_launch: hipFuncSetAttribute failed\n");
        if (hipOccupancyMaxActiveBlocksPerMultiprocessor(&per_cu, (const void*)fwd_megakernel, 512, LDS_BYTES) != hipSuccess || per_cu < 1) { fprintf(stderr, "kernel_launch: occupancy query says %d\n", per_cu); per_cu = 1; }
        (void)hipGetLastError();
        grid_blocks = cus > 0 ? cus : 256;
    }
    Prm p{};
    const float* const* in = (const float* const*)d_in;
    p.x_prompt = in[0]; p.x_sample = in[1]; p.state_hgrn = in[2]; p.ssm_re0 = in[3]; p.ssm_im0 = in[4]; p.cache_k = in[5]; p.cache_v = in[6]; p.meta = in[7]; p.ln_mix = in[8]; p.ln_mlp = in[9];
    p.ln_final = in[10]; p.w_in_even = in[11]; p.hgrn_lb = in[12]; p.hgrn_norm = in[13]; p.a_re = in[14]; p.a_im = in[15]; p.log_dt = in[16]; p.b_re = in[17]; p.b_im = in[18]; p.c_re = in[19];
    p.c_im = in[20]; p.ssm_d = in[21]; p.w_glu = in[22]; p.w_out_even = in[23]; p.w_in_odd = in[24]; p.w_out_odd = in[25]; p.w_up = in[26]; p.w_down = in[27];
    p.out = (float*)d_out;
    unsigned char* ws = (unsigned char*)d_ws; size_t off = 0;
    auto take = [&](size_t bytes) { unsigned char* r = ws + off; off += (bytes + 255) & ~(size_t)255; return r; };
    p.Wt1 = (bf16_t*)take((size_t)2560 * 1024 * 2); p.Wglu = (bf16_t*)take((size_t)512 * 512 * 2); p.Wo0 = (bf16_t*)take((size_t)1024 * 1024 * 2); p.Wup0 = (bf16_t*)take((size_t)4096 * 1024 * 2);
    p.Wdn0 = (bf16_t*)take((size_t)4096 * 1024 * 2); p.Wqkv = (bf16_t*)take((size_t)3072 * 1024 * 2); p.Wo1 = (bf16_t*)take((size_t)1024 * 1024 * 2); p.Wup1 = (bf16_t*)take((size_t)4096 * 1024 * 2);
    p.Wdn1 = (bf16_t*)take((size_t)4096 * 1024 * 2);
    p.XB = (bf16_t*)take((size_t)MP * 1024 * 2); p.SSQ = (float*)take((size_t)MP * 16 * 4); p.RINV = (float*)take((size_t)MP * 4); p.LB = (float*)take(2048); p.KTAB = (float*)take((size_t)32 * 16 * 256 * 4);
    p.TG = (bf16_t*)take((size_t)32 * 256 * 384 * 2); p.HT = (bf16_t*)take((size_t)32 * 128 * 256 * 2); p.A16 = (float*)take(32 * 64 * 2 * 4); p.BAR = (unsigned*)take(XCD_BAR_WORDS * 4);
    const size_t S0 = off; constexpr size_t SZ512 = (size_t)MP * 512 * 2;
    p.Qh = (bf16_t*)take(SZ512); p.LOGF = (unsigned short*)take(SZ512); p.IV = (bf16_t*)take(SZ512); p.GS = (bf16_t*)take(SZ512); p.U = (bf16_t*)take(SZ512);
    p.UT = (bf16_t*)take((size_t)NITEM_H * 16384 * 2); p.AL = (float*)take((size_t)NITEM_H * 128 * 4);
    p.XLOC = (float*)take(SZ512); p.YG = (bf16_t*)p.XLOC;
    p.XPREV = (bf16_t*)take((size_t)NCOL * 4096 * 2); p.CAT = (bf16_t*)take((size_t)MP * 1024 * 2);
    size_t end = off;
    off = S0; p.H = (bf16_t*)take((size_t)MP * 4096 * 2); if (off > end) end = off;
    off = S0; p.Q = (bf16_t*)take((size_t)MP * 1024 * 2); p.KP = (bf16_t*)take((size_t)64 * 129 * 4096 * 2); p.KS = (bf16_t*)take((size_t)64 * 34 * 4096 * 2);
    p.VTP = (bf16_t*)take((size_t)64 * 129 * 4096 * 2); p.VTS = (bf16_t*)take((size_t)64 * 34 * 4096 * 2); p.O = (bf16_t*)take((size_t)MP * 1024 * 2); if (off > end) end = off;
    if (end > ws_size || n_in != 28 || (size_t)out_size != O_END) { fprintf(stderr, "kernel_launch: workspace/shape mismatch: need %zu have %zu, n_in %d, out %d\n", end, ws_size, n_in, out_size); return; }
    (void)hipMemsetAsync(p.BAR, 0, XCD_BAR_WORDS * 4, stream);
    void* args[] = {&p};
    hipError_t e = hipLaunchCooperativeKernel((const void*)fwd_megakernel, dim3(grid_blocks), dim3(512), args, LDS_BYTES, stream);
    if (e != hipSuccess) fprintf(stderr, "cooperative launch failed: %s (grid %d)\n", hipGetErrorString(e), grid_blocks);
}
```

```cpp
#include <hip/hip_runtime.h>
#include <hip/hip_cooperative_groups.h>
#include <cstdio>
#include <cstdint>
namespace cg = cooperative_groups;
namespace pg8 {
#define PG8_LAS __attribute__((address_space(3)))
typedef unsigned short bf16_t;
typedef short bf16x8 __attribute__((ext_vector_type(8)));
typedef float f32x4 __attribute__((ext_vector_type(4)));
typedef unsigned u32x4 __attribute__((ext_vector_type(4)));
constexpr int BM = 256, BK = 64, HALF = 128, HTB = HALF * BK * 2  , STAGE_BYTES = 8 * HTB, NXCD = 8, WGM = 8;

__host__ __device__ __forceinline__ int lds_byte(int r, int c) { const int st = (r >> 4) * 2 + (c >> 5), rr = r & 15, cc = c & 31, ob = rr * 64 + cc * 2; return st * 1024 + (ob ^ (((ob >> 9) & 1) << 5)); }
__host__ __device__ __forceinline__ void stage_rc(int b, int& R, int& C) { const int st = b / 1024, sb = b % 1024, swz = sb ^ (((sb >> 9) & 1) << 5); R = (st >> 1) * 16 + swz / 64; C = (st & 1) * 32 + (swz % 64) / 2; }
__host__ __device__ __forceinline__ int perm32(int rho) { const int n = rho >> 4, i = rho & 15; return 8 * (i >> 2) + 4 * n + (i & 3); }

struct Unit { int pm, pn, kb, nk, part; };
struct Gemm { const bf16_t* A; const bf16_t* Bt; int M, N, K; float* part; };

struct StaticOrder {
    int nM, nN, nwg, G, c;
    __host__ __device__ void init(int M, int N, int G_, int c_) { nM = M / BM; nN = N / BM; nwg = nM * nN; G = G_; c = c_; }
    __host__ __device__ void map(int L, Unit& u) const {
        int wgid = L; { const int q = nwg / NXCD, r = nwg % NXCD, xcd = wgid % NXCD, off = wgid / NXCD; wgid = (xcd < r ? xcd * (q + 1) : r * (q + 1) + (xcd - r) * q) + off; }
        const int nig = WGM * nN, gid = wgid / nig, fm = gid * WGM, gsz = (nM - fm) < WGM ? (nM - fm) : WGM;
        u.pm = fm + ((wgid % nig) % gsz); u.pn = (wgid % nig) / gsz; u.kb = 0; u.nk = 0; u.part = -1;
    }
    __host__ __device__ bool next(int i, Unit& u) const {
        const long L = (long)i * G + c; if (L >= nwg) return false;
        map((int)L, u); return true;
    }
    __device__ __forceinline__ void a_ready(const Unit&) const {}
    __device__ __forceinline__ void done(const Unit&) const {}
};
template <class Epi, class Sched>
__device__ __forceinline__ void gemm_phase(PG8_LAS unsigned char* lds, const Gemm g, const Sched& S, const Epi& E) {
    int tid_ = threadIdx.x; asm volatile("" : "+v"(tid_));
    const int tid = tid_, wid = __builtin_amdgcn_readfirstlane(tid >> 6), lane = tid & 63, wr = wid >> 2, wc = wid & 3, fr = lane & 15, fq = lane >> 4;
    const int K = g.K, nt = K / BK;
    unsigned voffA[2], voffB[2];
#pragma unroll
    for (int i = 0; i < 2; ++i) { int R, C; stage_rc(tid * 16 + i * 8192, R, C); const int Rb = Epi::PERM ? ((R & ~31) + perm32(R & 31)) : R;
        voffA[i] = (unsigned)(R * K + C) * 2u; voffB[i] = (unsigned)(Rb * K + C) * 2u; }
    const size_t kstep = (size_t)(BK * 2);
    const size_t hstep = (size_t)HALF * K * 2;
    const size_t tstep = 2 * hstep;
    const unsigned ldsw = (unsigned)wid * 1024u;
    const int aoff = lds_byte(wr * 64 + fr, fq * 8), boff = lds_byte(wc * 32 + fr, fq * 8);
#define PG8_SA(b, h) (((b) * 2 + (h)) * HTB)
#define PG8_SB(b, h) ((4 + (b) * 2 + (h)) * HTB)
#define PG8_STAGE(bufoff, gbase, voff) do { _Pragma("unroll") for (int _i = 0; _i < 2; ++_i) \
        __builtin_amdgcn_global_load_lds((const unsigned*)((const char*)(gbase) + (voff)[_i]), (PG8_LAS unsigned*)(lds + (bufoff) + ldsw + _i * 8192), 16, 0, 0); } while (0)
#define PG8_LDA(dst, b, h) do { _Pragma("unroll") for (int m = 0; m < 4; ++m) _Pragma("unroll") for (int k = 0; k < 2; ++k) dst[m][k] = *(const PG8_LAS bf16x8*)(lds + PG8_SA(b, h) + aoff + m * 2048 + k * 1024); } while (0)
#define PG8_LDB(dst, b, h) do { _Pragma("unroll") for (int n = 0; n < 2; ++n) _Pragma("unroll") for (int k = 0; k < 2; ++k) dst[n][k] = *(const PG8_LAS bf16x8*)(lds + PG8_SB(b, h) + boff + n * 2048 + k * 1024); } while (0)
#define PG8_MMA(ai, bj, At, Bt) do { __builtin_amdgcn_s_setprio(1); _Pragma("unroll") for (int m = 0; m < 4; ++m) _Pragma("unroll") for (int n = 0; n < 2; ++n) _Pragma("unroll") for (int k = 0; k < 2; ++k) \
        acc[ai][bj][m][n] = __builtin_amdgcn_mfma_f32_16x16x32_bf16(Bt[n][k], At[m][k], acc[ai][bj][m][n], 0, 0, 0); __builtin_amdgcn_s_setprio(0); } while (0)
#define PG8_WAIT_V(n) asm volatile("s_waitcnt vmcnt(" #n ")" ::: "memory")
#define PG8_WAIT_L(n) asm volatile("s_waitcnt lgkmcnt(" #n ")" ::: "memory")
#define PG8_BAR __builtin_amdgcn_s_barrier()
#define PG8_SCHED __builtin_amdgcn_sched_barrier(0)
    Unit cur, nxt; int ui = 0; typename Epi::Pre pre;
    if (!S.next(0, cur)) return;
    f32x4 acc[2][2][4][2];
#pragma unroll
    for (int a = 0; a < 2; ++a)
#pragma unroll
        for (int b = 0; b < 2; ++b)
#pragma unroll
            for (int m = 0; m < 4; ++m)
#pragma unroll
                for (int n = 0; n < 2; ++n) acc[a][b][m][n] = (f32x4){0.f, 0.f, 0.f, 0.f};
    bf16x8 At[4][2], B0[2][2], B1[2][2];
    const char* cA = (const char*)g.A + (size_t)cur.pm * tstep + (size_t)cur.kb * kstep; const char* cB = (const char*)g.Bt + (size_t)cur.pn * tstep + (size_t)cur.kb * kstep;
    S.a_ready(cur);
    PG8_STAGE(PG8_SB(0, 0), cB, voffB); PG8_STAGE(PG8_SA(0, 0), cA, voffA); PG8_STAGE(PG8_SB(0, 1), cB + hstep, voffB); PG8_STAGE(PG8_SA(0, 1), cA + hstep, voffA);
    if (wr == 1) PG8_BAR;
    PG8_WAIT_V(4); PG8_BAR;
    PG8_STAGE(PG8_SB(1, 0), cB + kstep, voffB); PG8_STAGE(PG8_SA(1, 0), cA + kstep, voffA); PG8_STAGE(PG8_SB(1, 1), cB + hstep + kstep, voffB);
    PG8_WAIT_V(6); PG8_BAR;
    for (;;) {
        const bool has_next = S.next(ui + 1, nxt);
        const char* nA = has_next ? (const char*)g.A + (size_t)nxt.pm * tstep + (size_t)nxt.kb * kstep : cA; const char* nB = has_next ? (const char*)g.Bt + (size_t)nxt.pn * tstep + (size_t)nxt.kb * kstep : cB;
        const int cnk = cur.nk ? cur.nk : nt;
        for (int t = 0; t < cnk; t += 2) {
            const bool last = (t == cnk - 2);
            const char* a1 = cA + (size_t)(t + 1) * kstep;
            const char* a2 = last ? nA : cA + (size_t)(t + 2) * kstep; const char* b2 = last ? nB : cB + (size_t)(t + 2) * kstep;
            const char* a3 = a2 + kstep; const char* b3 = b2 + kstep;
            if (last && has_next) S.a_ready(nxt);
            if (last) E.prefetch(pre, cur, wr, fr);
            PG8_LDB(B0, 0, 0); PG8_SCHED; PG8_LDA(At, 0, 0); PG8_STAGE(PG8_SA(1, 1), a1 + hstep, voffA);
            PG8_WAIT_L(8); PG8_BAR; PG8_WAIT_L(0); PG8_MMA(0, 0, At, B0); PG8_BAR; PG8_SCHED;
            PG8_LDB(B1, 0, 1); PG8_STAGE(PG8_SB(0, 0), b2, voffB);
            PG8_BAR; PG8_WAIT_L(0); PG8_MMA(0, 1, At, B1); PG8_BAR;
            PG8_LDA(At, 0, 1); PG8_STAGE(PG8_SA(0, 0), a2, voffA);
            PG8_BAR; PG8_WAIT_L(0); PG8_MMA(1, 0, At, B0); PG8_BAR; PG8_SCHED;
            PG8_STAGE(PG8_SB(0, 1), b2 + hstep, voffB);
            PG8_WAIT_V(6); PG8_BAR; PG8_MMA(1, 1, At, B1); PG8_BAR;
            PG8_LDB(B0, 1, 0); PG8_SCHED; PG8_LDA(At, 1, 0); PG8_STAGE(PG8_SA(0, 1), a2 + hstep, voffA);
            PG8_WAIT_L(8); PG8_BAR; PG8_WAIT_L(0); PG8_MMA(0, 0, At, B0); PG8_BAR; PG8_SCHED;
            PG8_LDB(B1, 1, 1); PG8_STAGE(PG8_SB(1, 0), b3, voffB);
            PG8_BAR; PG8_WAIT_L(0); PG8_MMA(0, 1, At, B1); PG8_BAR;
            PG8_LDA(At, 1, 1); PG8_STAGE(PG8_SA(1, 0), a3, voffA);
            PG8_BAR; PG8_WAIT_L(0); PG8_MMA(1, 0, At, B0); PG8_BAR; PG8_SCHED;
            PG8_STAGE(PG8_SB(1, 1), b3 + hstep, voffB);
            PG8_WAIT_V(6); PG8_BAR; PG8_MMA(1, 1, At, B1); PG8_BAR;
        }
        if constexpr (!Epi::AFTER_DRAIN) {
            if (cur.part < 0) E(acc, cur, wr, wc, fr, fq, pre);
            else { f32x4* pp = (f32x4*)g.part + (size_t)cur.part * 32 * 512 + tid;
#pragma unroll
                for (int a = 0; a < 2; ++a)
#pragma unroll
                    for (int b = 0; b < 2; ++b)
#pragma unroll
                        for (int m = 0; m < 4; ++m)
#pragma unroll
                            for (int n = 0; n < 2; ++n) pp[(size_t)(((a * 2 + b) * 4 + m) * 2 + n) * 512] = acc[a][b][m][n]; }
            S.done(cur); }
        if (!has_next) break;
#pragma unroll
        for (int a = 0; a < 2; ++a)
#pragma unroll
            for (int b = 0; b < 2; ++b)
#pragma unroll
                for (int m = 0; m < 4; ++m)
#pragma unroll
                    for (int n = 0; n < 2; ++n) acc[a][b][m][n] = (f32x4){0.f, 0.f, 0.f, 0.f};
        cur = nxt; cA = nA; cB = nB; ++ui;
    }
    PG8_WAIT_V(0);
    if (wr == 0) PG8_BAR;
    PG8_BAR;
    if constexpr (Epi::AFTER_DRAIN) { E.fused(acc, cur, wr, wc, fr, fq, lds, wid, lane); S.done(cur); }
#undef PG8_SA
#undef PG8_SB
#undef PG8_STAGE
#undef PG8_LDA
#undef PG8_LDB
#undef PG8_MMA
#undef PG8_WAIT_V
#undef PG8_WAIT_L
#undef PG8_BAR
#undef PG8_SCHED
}
}
using pg8::bf16_t; using pg8::bf16x8; using pg8::f32x4; using pg8::Unit;
typedef float f32x16 __attribute__((ext_vector_type(16)));
typedef float f32x2v __attribute__((ext_vector_type(2)));
typedef unsigned u32x2 __attribute__((ext_vector_type(2)));
typedef unsigned u32x4v __attribute__((ext_vector_type(4)));
#define LAS __attribute__((address_space(3)))
#define DI __device__ __forceinline__

constexpr int DM = 1024, TP = 4112, NTP = 8 * TP  , NTS = 512, NT = NTP + NTS  , MP = 33536  ;
constexpr int NITEM_H = 2112;
constexpr int NCOL = NT / 16;
constexpr float EPSN = 1e-6f;
constexpr size_t O_YP = 0, O_YS = O_YP + (size_t)8 * 4096 * 1024, O_HGP = O_YS + 524288, O_HGS = O_HGP + 524288, O_SRP = O_HGS + 524288, O_SIP = O_SRP + 16384,
                 O_SRS = O_SIP + 16384, O_SIS = O_SRS + 16384, O_KP = O_SIS + 16384, O_VP = O_KP + (size_t)NTP * 1024, O_KS = O_VP + (size_t)NTP * 1024, O_VS = O_KS + 524288, O_END = O_VS + 524288;

struct Prm {
    const float *x_prompt, *x_sample, *state_hgrn, *ssm_re0, *ssm_im0, *cache_k, *cache_v, *meta, *ln_mix, *ln_mlp, *ln_final, *w_in_even, *hgrn_lb, *hgrn_norm,
        *a_re, *a_im, *log_dt, *b_re, *b_im, *c_re, *c_im, *ssm_d, *w_glu, *w_out_even, *w_in_odd, *w_out_odd, *w_up, *w_down;
    float* out;
    bf16_t *Wt1, *Wglu, *Wo0, *Wup0, *Wdn0, *Wqkv, *Wo1, *Wup1, *Wdn1;
    bf16_t* XB; float* SSQ; float* RINV; float* LB; float* KTAB; bf16_t* TG; bf16_t* HT; float* A16;
    bf16_t *Qh, *IV, *GS, *U; unsigned short* LOGF; bf16_t* UT; float* AL; float* XLOC; bf16_t* XPREV; bf16_t* YG; bf16_t* CAT;
    bf16_t* H;
    bf16_t *Q, *KP, *KS, *VTP, *VTS, *O; unsigned* BAR;
};

DI unsigned pk2(float lo, float hi) { unsigned r; asm volatile("v_cvt_pk_bf16_f32 %0, %1, %2" : "=v"(r) : "v"(lo), "v"(hi)); return r; }
DI float bflo(unsigned u) { return __uint_as_float(u << 16); }
DI float bfhi(unsigned u) { return __uint_as_float(u & 0xffff0000u); }
DI float bf2f(unsigned short b) { return __uint_as_float(((unsigned)b) << 16); }
DI unsigned short f2bf(float f) { return (unsigned short)(pk2(f, 0.f) & 0xffffu); }
DI unsigned pkh2(float lo, float hi) { union { _Float16 h[2]; unsigned u; } x; x.h[0] = (_Float16)lo; x.h[1] = (_Float16)hi; return x.u; }
DI float h2f(unsigned short h) { union { unsigned short s; _Float16 h; } x; x.s = h; return (float)x.h; }
DI float wave_sum(float v) {
#pragma unroll
    for (int o = 1; o < 64; o <<= 1) v += __shfl_xor(v, o);
    return v;
}
DI float fexp(float x) { return __expf(x); }
DI float sigm(float x) { return __builtin_amdgcn_rcpf(1.f + __expf(-x)); }
DI float row_rinv(const float* SSQ, int row) {
    const f32x4* s = (const f32x4*)(SSQ + (size_t)row * 16); f32x4 a = s[0] + s[1] + s[2] + s[3];
    return rsqrtf(((a.x + a.y) + (a.z + a.w)) * (1.f / 1024.f) + EPSN);
}
DI void rinv8(const float* SSQ, int row0, int fq, float (&r)[2][4]) {
    f32x4 v[2][4];
#pragma unroll
    for (int ai = 0; ai < 2; ++ai)
#pragma unroll
        for (int m = 0; m < 4; ++m) v[ai][m] = *(const f32x4*)(SSQ + (size_t)(row0 + ai * 128 + m * 16) * 16 + 4 * fq);
#pragma unroll
    for (int ai = 0; ai < 2; ++ai)
#pragma unroll
        for (int m = 0; m < 4; ++m) { float s = (v[ai][m].x + v[ai][m].y) + (v[ai][m].z + v[ai][m].w); s += __shfl_xor(s, 16); s += __shfl_xor(s, 32); r[ai][m] = rsqrtf(s * (1.f / 1024.f) + EPSN); }
}
#define LDS_WAIT() asm volatile("s_waitcnt lgkmcnt(0)" ::: "memory")

struct EpiIn0 {
    struct Pre { float r[2][4]; };
    DI void prefetch(Pre& pre, const Unit& u, int wr, int fr) const { const int row0 = u.pm * 256 + wr * 64 + fr;
#pragma unroll
        for (int ai = 0; ai < 2; ++ai)
#pragma unroll
            for (int m = 0; m < 4; ++m) pre.r[ai][m] = RINV[row0 + ai * 128 + m * 16]; }
    DI void scales(const Pre& pre, int row0, int fq, float (&rs)[2][4]) const {
        if (pre.r[0][0] > 0.f) {
#pragma unroll
            for (int ai = 0; ai < 2; ++ai)
#pragma unroll
                for (int m = 0; m < 4; ++m) rs[ai][m] = pre.r[ai][m]; }
        else rinv8(SSQ, row0, fq, rs);
    }
    static constexpr bool PERM = true, AFTER_DRAIN = false;
    const float* SSQ; const float* RINV; const float* LB; bf16_t *Qh, *IV, *GS, *U; unsigned short* LOGF;
    DI void operator()(const f32x4 (&acc)[2][2][4][2], const Unit& u, int wr, int wc, int fr, int fq, const Pre& pre) const {
        const int seg = u.pn >> 1, cb = (u.pn & 1) * 256 + wc * 32 + 8 * fq, row0 = u.pm * 256 + wr * 64 + fr;
        unsigned short* dst = seg == 0 ? Qh : seg == 1 ? LOGF : seg == 2 ? IV : seg == 3 ? GS : U;
        float rs[2][4]; scales(pre, row0, fq, rs);
        f32x4 lbv[2][2];
#pragma unroll
        for (int bj = 0; bj < 2; ++bj)
#pragma unroll
            for (int n = 0; n < 2; ++n) lbv[bj][n] = *(const f32x4*)(LB + cb + bj * 128 + 4 * n);
#pragma unroll
        for (int ai = 0; ai < 2; ++ai)
#pragma unroll
            for (int m = 0; m < 4; ++m) { const int row = row0 + ai * 128 + m * 16; const float r = rs[ai][m];
#pragma unroll
                for (int bj = 0; bj < 2; ++bj) { u32x4v o; unsigned w[4];
#pragma unroll
                    for (int n = 0; n < 2; ++n) { f32x4 v = acc[ai][bj][m][n] * r;
                        if (seg == 1) { const f32x4 lb = lbv[bj][n]; f32x4 f;
#pragma unroll
                            for (int e = 0; e < 4; ++e) f[e] = __logf(lb[e] + (1.f - lb[e]) * sigm(v[e]));
                            w[2 * n] = pkh2(f[0], f[1]); w[2 * n + 1] = pkh2(f[2], f[3]); }
                        else { if (seg == 3) {
#pragma unroll
                                for (int e = 0; e < 4; ++e) v[e] = v[e] * sigm(v[e]); }
                            w[2 * n] = pk2(v[0], v[1]); w[2 * n + 1] = pk2(v[2], v[3]); } }
                    o.x = w[0]; o.y = w[1]; o.z = w[2]; o.w = w[3];
                    *(u32x4v*)(dst + (size_t)row * 512 + cb + bj * 128) = o; } }
    }
};
struct EpiGlu {
    struct Pre {}; DI void prefetch(Pre&, const Unit&, int, int) const {}
    static constexpr bool PERM = true, AFTER_DRAIN = false;
    const bf16_t* YG; bf16_t* CAT;
    DI void operator()(const f32x4 (&acc)[2][2][4][2], const Unit& u, int wr, int wc, int fr, int fq, const Pre& pre) const {
        const int cb = u.pn * 256 + wc * 32 + 8 * fq, row0 = u.pm * 256 + wr * 64 + fr;
#pragma unroll
        for (int ai = 0; ai < 2; ++ai) {
            u32x4v y[4][2];
#pragma unroll
            for (int m = 0; m < 4; ++m)
#pragma unroll
                for (int bj = 0; bj < 2; ++bj) y[m][bj] = *(const u32x4v*)(YG + (size_t)(row0 + ai * 128 + m * 16) * 512 + cb + bj * 128);
#pragma unroll
            for (int m = 0; m < 4; ++m) { const int row = row0 + ai * 128 + m * 16;
#pragma unroll
                for (int bj = 0; bj < 2; ++bj) { const f32x4 v0 = acc[ai][bj][m][0], v1 = acc[ai][bj][m][1]; const u32x4v yy = y[m][bj]; u32x4v o;
                    o.x = pk2(bflo(yy.x) * sigm(v0[0]), bfhi(yy.x) * sigm(v0[1])); o.y = pk2(bflo(yy.y) * sigm(v0[2]), bfhi(yy.y) * sigm(v0[3]));
                    o.z = pk2(bflo(yy.z) * sigm(v1[0]), bfhi(yy.z) * sigm(v1[1])); o.w = pk2(bflo(yy.w) * sigm(v1[2]), bfhi(yy.w) * sigm(v1[3]));
                    *(u32x4v*)(CAT + (size_t)row * 1024 + 512 + cb + bj * 128) = o; } } }
    }
};
struct EpiRes {
    struct Pre {}; DI void prefetch(Pre&, const Unit&, int, int) const {}
    static constexpr bool PERM = true, AFTER_DRAIN = false;
    bf16_t* XB; float* SSQ;
    DI float upd(u32x4v* px, const u32x4v x, const f32x4 v0, const f32x4 v1) const {
        u32x4v o; o.x = pk2(bflo(x.x) + v0[0], bfhi(x.x) + v0[1]); o.y = pk2(bflo(x.y) + v0[2], bfhi(x.y) + v0[3]);
        o.z = pk2(bflo(x.z) + v1[0], bfhi(x.z) + v1[1]); o.w = pk2(bflo(x.w) + v1[2], bfhi(x.w) + v1[3]); *px = o;
        const float a0 = bflo(o.x), a1 = bfhi(o.x), a2 = bflo(o.y), a3 = bfhi(o.y), a4 = bflo(o.z), a5 = bfhi(o.z), a6 = bflo(o.w), a7 = bfhi(o.w);
        return ((a0 * a0 + a1 * a1) + (a2 * a2 + a3 * a3)) + ((a4 * a4 + a5 * a5) + (a6 * a6 + a7 * a7));
    }
    DI void row(const f32x4 (&a4)[2][2], const Unit& u, int ai, int m, int wr, int wc, int fr, int fq) const {
        const int cb = u.pn * 256 + wc * 32 + 8 * fq, row = u.pm * 256 + wr * 64 + fr + ai * 128 + m * 16;
        u32x4v* p0 = (u32x4v*)(XB + (size_t)row * 1024 + cb); u32x4v* p1 = (u32x4v*)(XB + (size_t)row * 1024 + cb + 128);
        const u32x4v x0 = *p0, x1 = *p1;
        float ss = upd(p0, x0, a4[0][0], a4[0][1]) + upd(p1, x1, a4[1][0], a4[1][1]);
        ss += __shfl_xor(ss, 16); ss += __shfl_xor(ss, 32);
        if (fq == 0) SSQ[(size_t)row * 16 + u.pn * 4 + wc] = ss;
    }
    DI void operator()(const f32x4 (&acc)[2][2][4][2], const Unit& u, int wr, int wc, int fr, int fq, const Pre& pre) const {
        const int cb = u.pn * 256 + wc * 32 + 8 * fq, row0 = u.pm * 256 + wr * 64 + fr;
#pragma unroll
        for (int ai = 0; ai < 2; ++ai) {
            u32x4v x[4][2];
#pragma unroll
            for (int m = 0; m < 4; ++m)
#pragma unroll
                for (int bj = 0; bj < 2; ++bj) x[m][bj] = *(const u32x4v*)(XB + (size_t)(row0 + ai * 128 + m * 16) * 1024 + cb + bj * 128);
#pragma unroll
            for (int m = 0; m < 4; ++m) { const int row = row0 + ai * 128 + m * 16;
                float ss = upd((u32x4v*)(XB + (size_t)row * 1024 + cb), x[m][0], acc[ai][0][m][0], acc[ai][0][m][1])
                         + upd((u32x4v*)(XB + (size_t)row * 1024 + cb + 128), x[m][1], acc[ai][1][m][0], acc[ai][1][m][1]);
                ss += __shfl_xor(ss, 16); ss += __shfl_xor(ss, 32);
                if (fq == 0) SSQ[(size_t)row * 16 + u.pn * 4 + wc] = ss; } }
    }
};
struct EpiUp {
    struct Pre { float r[2][4]; };
    DI void prefetch(Pre& pre, const Unit& u, int wr, int fr) const { const int row0 = u.pm * 256 + wr * 64 + fr;
#pragma unroll
        for (int ai = 0; ai < 2; ++ai)
#pragma unroll
            for (int m = 0; m < 4; ++m) pre.r[ai][m] = RINV[row0 + ai * 128 + m * 16]; }
    DI void scales(const Pre& pre, int row0, int fq, float (&rs)[2][4]) const {
        if (pre.r[0][0] > 0.f) {
#pragma unroll
            for (int ai = 0; ai < 2; ++ai)
#pragma unroll
                for (int m = 0; m < 4; ++m) rs[ai][m] = pre.r[ai][m]; }
        else rinv8(SSQ, row0, fq, rs);
    }
    static constexpr bool PERM = true, AFTER_DRAIN = false;
    const float* SSQ; const float* RINV; bf16_t* H;
    DI void operator()(const f32x4 (&acc)[2][2][4][2], const Unit& u, int wr, int wc, int fr, int fq, const Pre& pre) const {
        const int cb = u.pn * 256 + wc * 32 + 8 * fq, row0 = u.pm * 256 + wr * 64 + fr;
        float rs[2][4]; scales(pre, row0, fq, rs);
#pragma unroll
        for (int ai = 0; ai < 2; ++ai)
#pragma unroll
            for (int m = 0; m < 4; ++m) { const int row = row0 + ai * 128 + m * 16; const float r = rs[ai][m];
#pragma unroll
                for (int bj = 0; bj < 2; ++bj) { f32x4 v0 = acc[ai][bj][m][0] * r, v1 = acc[ai][bj][m][1] * r;
#pragma unroll
                    for (int e = 0; e < 4; ++e) { const float t0 = fmaxf(v0[e], 0.f), t1 = fmaxf(v1[e], 0.f); v0[e] = t0 * t0; v1[e] = t1 * t1; }
                    u32x4v o; o.x = pk2(v0[0], v0[1]); o.y = pk2(v0[2], v0[3]); o.z = pk2(v1[0], v1[1]); o.w = pk2(v1[2], v1[3]);
                    *(u32x4v*)(H + (size_t)row * 4096 + cb + bj * 128) = o; } }
    }
};
DI size_t kf_index(int seqh, int nkt, int key, int d) { return ((((size_t)seqh * nkt + (key >> 5)) * 8 + (d >> 4)) * 64 + ((key & 31) + 32 * ((d >> 3) & 1))) * 8 + (d & 7); }
DI size_t vf_index(int seqh, int nkt, int key, int d) { const int kk = key & 31;
    return ((((size_t)seqh * nkt + (key >> 5)) * 8 + (kk >> 4) * 4 + (d >> 5)) * 64 + ((d & 31) + 32 * ((kk >> 2) & 1))) * 8 + ((kk >> 3) & 1) * 4 + (kk & 3); }
struct EpiQkv {
    struct Pre { float r[2][4]; };
    DI void prefetch(Pre& pre, const Unit& u, int wr, int fr) const { const int row0 = u.pm * 256 + wr * 64 + fr;
#pragma unroll
        for (int ai = 0; ai < 2; ++ai)
#pragma unroll
            for (int m = 0; m < 4; ++m) pre.r[ai][m] = RINV[row0 + ai * 128 + m * 16]; }
    DI void scales(const Pre& pre, int row0, int fq, float (&rs)[2][4]) const {
        if (pre.r[0][0] > 0.f) {
#pragma unroll
            for (int ai = 0; ai < 2; ++ai)
#pragma unroll
                for (int m = 0; m < 4; ++m) rs[ai][m] = pre.r[ai][m]; }
        else rinv8(SSQ, row0, fq, rs);
    }
    static constexpr bool PERM = true, AFTER_DRAIN = false;
    const float* SSQ; const float* RINV; float* out; bf16_t *Q, *KP, *KS, *VTP, *VTS;
    DI void operator()(const f32x4 (&acc)[2][2][4][2], const Unit& u, int wr, int wc, int fr, int fq, const Pre& pre) const {
        const int third = u.pn >> 2, cb = (u.pn & 3) * 256 + wc * 32 + 8 * fq, row0 = u.pm * 256 + wr * 64 + fr;
        float rs[2][4]; scales(pre, row0, fq, rs);
#pragma unroll
        for (int ai = 0; ai < 2; ++ai)
#pragma unroll
            for (int m = 0; m < 4; ++m) { const int row = row0 + ai * 128 + m * 16; const float r = rs[ai][m];
                const bool smp = row >= NTP; const int s = row - NTP; const int b = smp ? (s >> 6) : row / TP, key = smp ? 1024 + (s & 63) : row - b * TP, nkt = smp ? 34 : 129;
#pragma unroll
                for (int bj = 0; bj < 2; ++bj) { const int cs = cb + bj * 128; const f32x4 v0 = acc[ai][bj][m][0] * r, v1 = acc[ai][bj][m][1] * r;
                    u32x4v o; o.x = pk2(v0[0], v0[1]); o.y = pk2(v0[2], v0[3]); o.z = pk2(v1[0], v1[1]); o.w = pk2(v1[2], v1[3]);
                    if (third == 0) { *(u32x4v*)(Q + (size_t)row * 1024 + cs) = o; }
                    else if (row < NT) { const int h = cs >> 7, d = cs & 127;
                        if (third == 1) { float* ok = out + (smp ? O_KS + (size_t)s * 1024 : O_KP + (size_t)row * 1024) + cs; *(f32x4*)ok = v0; *(f32x4*)(ok + 4) = v1;
                            *(u32x4v*)((smp ? KS : KP) + kf_index(b * 8 + h, nkt, key, d)) = o; }
                        else { float* ov = out + (smp ? O_VS + (size_t)s * 1024 : O_VP + (size_t)row * 1024) + cs; *(f32x4*)ov = v0; *(f32x4*)(ov + 4) = v1;
                            bf16_t* vt = (smp ? VTS : VTP) + vf_index(b * 8 + h, nkt, key, d);
                            vt[0] = (bf16_t)(o.x & 0xffffu); vt[8] = (bf16_t)(o.x >> 16); vt[16] = (bf16_t)(o.y & 0xffffu); vt[24] = (bf16_t)(o.y >> 16);
                            vt[32] = (bf16_t)(o.z & 0xffffu); vt[40] = (bf16_t)(o.z >> 16); vt[48] = (bf16_t)(o.w & 0xffffu); vt[56] = (bf16_t)(o.w >> 16); } } } }
    }
};
struct EpiFin {
    struct Pre {}; DI void prefetch(Pre&, const Unit&, int, int) const {}
    static constexpr bool PERM = false, AFTER_DRAIN = false;
    const bf16_t* XB; float* SSQ; float* out;
    DI void row(const f32x4 (&a4)[2][2], const Unit& u, int ai, int m, int wr, int wc, int fr, int fq) const {
        const int cb = u.pn * 256 + wc * 32 + 4 * fq, row = u.pm * 256 + wr * 64 + fr + ai * 128 + m * 16; float ss = 0.f;
        const int b = row / TP, t = row - b * TP; const bool ok = row < NT && (row >= NTP || t >= 16);
        float* dst = out + (row >= NTP ? O_YS + (size_t)(row - NTP) * 1024 : O_YP + ((size_t)b * 4096 + (t - 16)) * 1024);
#pragma unroll
        for (int bj = 0; bj < 2; ++bj)
#pragma unroll
            for (int n = 0; n < 2; ++n) { const int cs = cb + bj * 128 + n * 16; f32x4 v = a4[bj][n];
                const u32x2 x = *(const u32x2*)(XB + (size_t)row * 1024 + cs);
                v[0] += bflo(x.x); v[1] += bfhi(x.x); v[2] += bflo(x.y); v[3] += bfhi(x.y);
                if (ok) *(f32x4*)(dst + cs) = v;
                ss += (v[0] * v[0] + v[1] * v[1]) + (v[2] * v[2] + v[3] * v[3]); }
        ss += __shfl_xor(ss, 16); ss += __shfl_xor(ss, 32);
        if (fq == 0) SSQ[(size_t)row * 16 + u.pn * 4 + wc] = ss;
    }
    DI void operator()(const f32x4 (&acc)[2][2][4][2], const Unit& u, int wr, int wc, int fr, int fq, const Pre& pre) const {
        const int cb = u.pn * 256 + wc * 32 + 4 * fq, row0 = u.pm * 256 + wr * 64 + fr;
#pragma unroll
        for (int ai = 0; ai < 2; ++ai) {
            u32x2 x[4][2][2];
#pragma unroll
            for (int m = 0; m < 4; ++m)
#pragma unroll
                for (int bj = 0; bj < 2; ++bj)
#pragma unroll
                    for (int n = 0; n < 2; ++n) x[m][bj][n] = *(const u32x2*)(XB + (size_t)(row0 + ai * 128 + m * 16) * 1024 + cb + bj * 128 + n * 16);
#pragma unroll
            for (int m = 0; m < 4; ++m) { const int row = row0 + ai * 128 + m * 16; float ss = 0.f;
                const int b = row / TP, t = row - b * TP; const bool ok = row < NT && (row >= NTP || t >= 16);
                float* dst = out + (row >= NTP ? O_YS + (size_t)(row - NTP) * 1024 : O_YP + ((size_t)b * 4096 + (t - 16)) * 1024);
#pragma unroll
                for (int bj = 0; bj < 2; ++bj)
#pragma unroll
                    for (int n = 0; n < 2; ++n) { const int cs = cb + bj * 128 + n * 16; f32x4 v = acc[ai][bj][m][n]; const u32x2 xx = x[m][bj][n];
                        v[0] += bflo(xx.x); v[1] += bfhi(xx.x); v[2] += bflo(xx.y); v[3] += bfhi(xx.y);
                        if (ok) *(f32x4*)(dst + cs) = v;
                        ss += (v[0] * v[0] + v[1] * v[1]) + (v[2] * v[2] + v[3] * v[3]); }
                ss += __shfl_xor(ss, 16); ss += __shfl_xor(ss, 32);
                if (fq == 0) SSQ[(size_t)row * 16 + u.pn * 4 + wc] = ss; } }
    }
};
template <class Epi> DI void run_gemm(LAS unsigned char* lds, const bf16_t* A, const bf16_t* Bt, int N, int K, const Epi& E) {
    pg8::Gemm g; g.A = A; g.Bt = Bt; g.M = MP; g.N = N; g.K = K; g.part = nullptr;
    pg8::StaticOrder S; S.init(MP, N, (int)gridDim.x, (int)blockIdx.x);
    pg8::gemm_phase<Epi, pg8::StaticOrder>(lds, g, S, E);
}
struct SplitOrder : pg8::StaticOrder {
    int nwhole, ntail, S, nks;
    DI void init2(int N, int K) { init(MP, N, (int)gridDim.x, (int)blockIdx.x); nwhole = nwg / G; ntail = nwg - nwhole * G; S = 0; nks = 0;
        if (ntail > 0) { int s = G / ntail; const int nkt = K / 64; while (s > 1 && (nkt % s != 0 || (nkt / s) < 4 || ((nkt / s) & 1))) --s; if (s > 1) { S = s; nks = nkt / s; } } }
    DI bool next(int i, Unit& u) const {
        if (S == 0) return pg8::StaticOrder::next(i, u);
        if (i < nwhole) { map(i * G + c, u); return true; }
        if (i == nwhole && c < ntail * S) { map(nwhole * G + c / S, u); u.kb = (c % S) * nks; u.nk = nks; u.part = c; return true; }
        return false;
    }
};
template <class Epi> DI void run_gemm_split(LAS unsigned char* lds, const bf16_t* A, const bf16_t* Bt, int N, int K, const Epi& E, float* part) {
    pg8::Gemm g; g.A = A; g.Bt = Bt; g.M = MP; g.N = N; g.K = K; g.part = part;
    SplitOrder S; S.init2(N, K);
    pg8::gemm_phase<Epi, SplitOrder>(lds, g, S, E);
}
template <class Epi> DI void gemm_fixup(int N, int K, const Epi& E, const float* part, int tid) {
    SplitOrder S; S.init2(N, K); if (S.S == 0) return;
    asm volatile("" : "+v"(tid));
    const int wid = tid >> 6, lane = tid & 63, wr = wid >> 2, wc = wid & 3, fr = lane & 15, fq = lane >> 4;
    for (int it = blockIdx.x; it < S.ntail * 8; it += gridDim.x) { const int j = it >> 3, ai = (it >> 2) & 1, m = it & 3; Unit u; S.map(S.nwhole * S.G + j, u);
        f32x4 a4[2][2];
#pragma unroll
        for (int b = 0; b < 2; ++b)
#pragma unroll
            for (int n = 0; n < 2; ++n) { const f32x4* pp = (const f32x4*)part + ((size_t)(j * S.S) * 32 + (((ai * 2 + b) * 4 + m) * 2 + n)) * 512 + tid;
                f32x4 v0 = {0.f, 0.f, 0.f, 0.f}, v1 = v0, v2 = v0, v3 = v0;
                for (int sl = 0; sl + 3 < S.S; sl += 4) { v0 += pp[(size_t)sl * 16384]; v1 += pp[(size_t)(sl + 1) * 16384]; v2 += pp[(size_t)(sl + 2) * 16384]; v3 += pp[(size_t)(sl + 3) * 16384]; }
                for (int sl = S.S & ~3; sl < S.S; ++sl) v0 += pp[(size_t)sl * 16384];
                a4[b][n] = (v0 + v1) + (v2 + v3); }
        E.row(a4, u, ai, m, wr, wc, fr, fq); }
}
DI void rinv_pass(const Prm& p, int K, int tid) {
    SplitOrder S; S.init2(1024, K);
    for (int pm = blockIdx.x; pm < MP / 256; pm += gridDim.x) {
        bool tail = false;
        if (S.S) for (int j = 0; j < S.ntail; ++j) { Unit u; S.map(S.nwhole * S.G + j, u); tail = tail || (u.pm == pm); }
        if (tid < 256) { const int row = pm * 256 + tid; float v = -1.f;
            if (!tail) { const f32x4* q = (const f32x4*)(p.SSQ + (size_t)row * 16); const f32x4 a = q[0] + q[1] + q[2] + q[3]; v = rsqrtf(((a.x + a.y) + (a.z + a.w)) * (1.f / 1024.f) + EPSN); }
            if (row >= NT) v = 1.f;
            p.RINV[row] = v; }
    }
}
DI void transpose_item(const float* W, int N, bf16_t* WT, size_t ldo, const float* sc, LAS float* scr, int item, int lane) {
    const int nblk = N / 32, kb = item / nblk, nb = item % nblk, k0 = 64 * kb, n0 = 32 * nb;
#pragma unroll 8
    for (int i = 0; i < 32; ++i) { const int kk = 2 * i + (lane >> 5); float w = W[(size_t)(k0 + kk) * N + n0 + (lane & 31)]; if (sc) w *= sc[k0 + kk]; scr[kk * 33 + (lane & 31)] = w; }
    LDS_WAIT();
    const int c = lane & 7;
#pragma unroll
    for (int j = 0; j < 4; ++j) { const int n = (lane >> 3) + 8 * j; const LAS float* s = scr + (8 * c) * 33 + n;
        u32x4v o; o.x = pk2(s[0 * 33], s[1 * 33]); o.y = pk2(s[2 * 33], s[3 * 33]); o.z = pk2(s[4 * 33], s[5 * 33]); o.w = pk2(s[6 * 33], s[7 * 33]);
        *(u32x4v*)(WT + (size_t)(n0 + n) * ldo + k0 + 8 * c) = o; }
    LDS_WAIT();
}
DI void s5_pow(const Prm& p, int g, int n, float k, float& re, float& im) {
    const float dt = __expf(p.log_dt[g]), ar = p.a_re[g * 64 + n], ai = p.a_im[g * 64 + n];
    const float mag = __expf(k * dt * ar); float rev = k * dt * ai * 0.15915494309189535f; rev -= rintf(rev);
    re = mag * __builtin_amdgcn_cosf(rev); im = mag * __builtin_amdgcn_sinf(rev);
}
DI void s5_bbar(const Prm& p, int g, int n, int pp, float& re, float& im) {
    const float ar = p.a_re[g * 64 + n], ai = p.a_im[g * 64 + n]; float abr, abi; s5_pow(p, g, n, 1.f, abr, abi);
    const float den = ar * ar + ai * ai, zr = ((abr - 1.f) * ar + abi * ai) / den, zi = (abi * ar - (abr - 1.f) * ai) / den;
    const float br = p.b_re[(g * 64 + n) * 16 + pp], bi = p.b_im[(g * 64 + n) * 16 + pp];
    re = zr * br - zi * bi; im = zr * bi + zi * br;
}
DI void phase_prologue(const Prm& p, LAS unsigned char* lds, int tid, int lane, int wave) {
    const int gw = blockIdx.x * 8 + wave, NGW = gridDim.x * 8, gtid = blockIdx.x * 512 + tid, GT = gridDim.x * 512;
    LAS float* scr = (LAS float*)(lds + wave * 16384);
    constexpr int I1 = 16 * 80, I2 = 8 * 16, I3 = 16 * 32, I4 = 16 * 128, I5 = 64 * 32, I6 = 16 * 96;
    constexpr int NITEMS = I1 + I2 + I3 + I4 + I5 + I6 + I3 + I4 + I5;
    for (int it = gw; it < NITEMS; it += NGW) {
        int r = it;
        if (r < I1) { transpose_item(p.w_in_even, 2560, p.Wt1, 1024, p.ln_mix, scr, r, lane); continue; } r -= I1;
        if (r < I2) { transpose_item(p.w_glu, 512, p.Wglu, 512, nullptr, scr, r, lane); continue; } r -= I2;
        if (r < I3) { transpose_item(p.w_out_even, 1024, p.Wo0, 1024, nullptr, scr, r, lane); continue; } r -= I3;
        if (r < I4) { transpose_item(p.w_up, 4096, p.Wup0, 1024, p.ln_mlp, scr, r, lane); continue; } r -= I4;
        if (r < I5) { transpose_item(p.w_down, 1024, p.Wdn0, 4096, nullptr, scr, r, lane); continue; } r -= I5;
        if (r < I6) { transpose_item(p.w_in_odd, 3072, p.Wqkv, 1024, p.ln_mix + 1024, scr, r, lane); continue; } r -= I6;
        if (r < I3) { transpose_item(p.w_out_odd, 1024, p.Wo1, 1024, nullptr, scr, r, lane); continue; } r -= I3;
        if (r < I4) { transpose_item(p.w_up + (size_t)1024 * 4096, 4096, p.Wup1, 1024, p.ln_mlp + 1024, scr, r, lane); continue; } r -= I4;
        transpose_item(p.w_down + (size_t)4096 * 1024, 1024, p.Wdn1, 4096, nullptr, scr, r, lane);
    }
    for (int row = gw; row < NT; row += NGW) {
        const float* src;
        if (row < NTP) { const int b = row / TP, t = row - b * TP; src = t < 16 ? p.meta + (size_t)t * 1024 : p.x_prompt + ((size_t)b * 4096 + (t - 16)) * 1024; }
        else src = p.x_sample + (size_t)(row - NTP) * 1024;
        float ss = 0.f;
#pragma unroll
        for (int j = 0; j < 4; ++j) { const f32x4 v = ((const f32x4*)src)[lane + 64 * j]; u32x2 o; o.x = pk2(v.x, v.y); o.y = pk2(v.z, v.w);
            const float a0 = bflo(o.x), a1 = bfhi(o.x), a2 = bflo(o.y), a3 = bfhi(o.y); ss += (a0 * a0 + a1 * a1) + (a2 * a2 + a3 * a3);
            ((u32x2*)(p.XB + (size_t)row * 1024))[lane + 64 * j] = o; }
        ss = wave_sum(ss);
        if (lane < 16) p.SSQ[(size_t)row * 16 + lane] = lane == 0 ? ss : 0.f;
        if (lane == 0) p.RINV[row] = rsqrtf(ss * (1.f / 1024.f) + EPSN);
    }
    if (gtid < MP - NT) p.RINV[NT + gtid] = 1.f;
    if (gtid < 512) p.LB[gtid] = 1.f / (1.f + __expf(p.hgrn_lb[512 + gtid] - p.hgrn_lb[gtid]));
    __syncthreads();
    {
        LAS float* zr_ = (LAS float*)lds; LAS float* zi_ = zr_ + 64; LAS float* wr_ = zi_ + 64; LAS float* wi_ = wr_ + 64;
        LAS float* bbr = wi_ + 64; LAS float* bbi = bbr + 1024; LAS float* cwr = bbi + 1024; LAS float* cwi = cwr + 16 * 65;
        for (int pair = blockIdx.x; pair < 512; pair += gridDim.x) { const int g = pair >> 4, tau = pair & 15;
            if (tid < 64) { const int n = tid; const float ar = p.a_re[g * 64 + n], ai = p.a_im[g * 64 + n]; float abr, abi; s5_pow(p, g, n, 1.f, abr, abi);
                const float den = ar * ar + ai * ai; zr_[n] = ((abr - 1.f) * ar + abi * ai) / den; zi_[n] = (abi * ar - (abr - 1.f) * ai) / den;
                float a, b; s5_pow(p, g, n, (float)tau, a, b); wr_[n] = a; wi_[n] = b; }
            __syncthreads();
#pragma unroll
            for (int k = 0; k < 2; ++k) { const int e = tid + 512 * k;
                { const int n = e >> 4; const float br = p.b_re[g * 1024 + e], bi = p.b_im[g * 1024 + e]; bbr[e] = zr_[n] * br - zi_[n] * bi; bbi[e] = zr_[n] * bi + zi_[n] * br; }
                { const int pch = e >> 6, n = e & 63; const float cr = p.c_re[g * 1024 + e], ci = p.c_im[g * 1024 + e]; cwr[pch * 65 + n] = cr * wr_[n] - ci * wi_[n]; cwi[pch * 65 + n] = cr * wi_[n] + ci * wr_[n]; } }
            __syncthreads();
            if (tid < 256) { const int pch = tid >> 4, pp = tid & 15; float acc = 0.f;
#pragma unroll 8
                for (int n = 0; n < 64; ++n) acc += cwr[pch * 65 + n] * bbr[n * 16 + pp] - cwi[pch * 65 + n] * bbi[n * 16 + pp];
                if (tau == 0 && pch == pp) acc += p.ssm_d[g * 16 + pch];
                const bf16_t kv = f2bf(acc);
                p.TG[((g * 16 + tau) * 16 + pch) * 16 + pp] = kv; }
            __syncthreads(); }
    }
    for (int i = gtid; i < 32 * 256 * 64; i += GT) {
        const int g = i >> 14, t = (i >> 10) & 15, pch = (i >> 6) & 15, n = i & 63; float wr_, wi_; s5_pow(p, g, n, (float)(t + 1), wr_, wi_);
        const float cr = p.c_re[(g * 16 + pch) * 64 + n], ci = p.c_im[(g * 16 + pch) * 64 + n];
        *(unsigned*)(p.TG + 131072 + ((size_t)(g * 256 + t * 16 + pch)) * 128 + 2 * n) = pk2(cr * wr_ - ci * wi_, -(cr * wi_ + ci * wr_)); }
    for (int i = gtid; i < 32 * 64 * 256; i += GT) {
        const int g = i >> 14, n = (i >> 8) & 63, s = (i >> 4) & 15, pp = i & 15; float wr_, wi_, br_, bi_; s5_pow(p, g, n, (float)(15 - s), wr_, wi_); s5_bbar(p, g, n, pp, br_, bi_);
        p.HT[((size_t)(g * 128 + 2 * n)) * 256 + s * 16 + pp] = f2bf(wr_ * br_ - wi_ * bi_);
        p.HT[((size_t)(g * 128 + 2 * n + 1)) * 256 + s * 16 + pp] = f2bf(wr_ * bi_ + wi_ * br_); }
    if (gtid < 2048) { float wr_, wi_; s5_pow(p, gtid >> 6, gtid & 63, 16.f, wr_, wi_); p.A16[2 * gtid] = wr_; p.A16[2 * gtid + 1] = wi_; }
}

constexpr int HP = 136, TPI = 72;
constexpr int L_QT = 0, L_QH = 17408, L_KT = 34816, L_KTT = 52224, L_IVT = 70656, L_ATT = 89088, L_SUM = 98304, L_VEC = 100352, L_OB = 0  ;
struct HItem { int row0, L, h, bh; };
DI HItem hgrn_item(int item) {
    HItem it;
    if (item < 2080) { const int bh = item / 65, c = item - bh * 65, b = bh >> 2; it.h = bh & 3; it.bh = bh; it.L = c == 0 ? 16 : 64; it.row0 = b * TP + (c == 0 ? 0 : 16 + 64 * (c - 1)); }
    else { const int s = item - 2080, b = s >> 2; it.h = s & 3; it.bh = 32 + s; it.L = 64; it.row0 = NTP + b * 64; }
    return it;
}
template <bool FULL> DI void hgrn_loadraw(const Prm& p, const HItem& it, int tid, unsigned (&rl)[16], unsigned (&rv)[16], unsigned (&rq)[16]) {
    const int d = tid & 127, t0 = 16 * (tid >> 7), col = it.h * 128 + d;
#pragma unroll
    for (int j = 0; j < 16; ++j) { const int t = t0 + j; const bool valid = t < it.L; const size_t o = (size_t)(it.row0 + t) * 512 + col;
        rl[j] = valid ? (unsigned)p.LOGF[o] : 0u; rv[j] = valid ? (unsigned)p.IV[o] : 0u; if (FULL) rq[j] = valid ? (unsigned)p.Qh[o] : 0u; }
}
template <bool FULL> DI void hgrn_prep(const HItem& it, LAS unsigned char* lds, int tid, const unsigned (&rl)[16], const unsigned (&rv)[16], const unsigned (&rq)[16]) {
    const int d = tid & 127, tq = tid >> 7, t0 = 16 * tq;
    LAS float* sums = (LAS float*)(lds + L_SUM); LAS float* vec = (LAS float*)(lds + L_VEC);
    float cs[16], lf[16];
    float run = 0.f;
#pragma unroll
    for (int j = 0; j < 16; ++j) { lf[j] = h2f((unsigned short)rl[j]); run += lf[j]; cs[j] = run; }
    sums[tq * 128 + d] = run;
    { LAS u32x4v* dst = (LAS u32x4v*)(lds + L_IVT + (d * TPI + t0) * 2); u32x4v a, b;
        a.x = rv[0] | (rv[1] << 16); a.y = rv[2] | (rv[3] << 16); a.z = rv[4] | (rv[5] << 16); a.w = rv[6] | (rv[7] << 16);
        b.x = rv[8] | (rv[9] << 16); b.y = rv[10] | (rv[11] << 16); b.z = rv[12] | (rv[13] << 16); b.w = rv[14] | (rv[15] << 16); dst[0] = a; dst[1] = b; }
    __syncthreads();
    const float s0 = sums[d], s1 = sums[128 + d], s2 = sums[256 + d], s3 = sums[384 + d];
    const float off = tq == 0 ? 0.f : tq == 1 ? s0 : tq == 2 ? s0 + s1 : s0 + s1 + s2, r = s0 + s1, bL = r + s2 + s3;
    if (tq == 0) { vec[d] = r; vec[128 + d] = bL; }
    unsigned ktp[8]; float kprev = 0.f;
#pragma unroll
    for (int j = 0; j < 16; ++j) { const int t = t0 + j; const bool valid = t < it.L; const float b = off + cs[j];
        const float kt = valid ? (1.f - __expf(lf[j])) * __expf(r - b) : 0.f;
        if (j & 1) ktp[j >> 1] = pk2(kprev, kt); else kprev = kt;
        if (FULL) { const float qv = bf2f((unsigned short)rq[j]);
            *(LAS unsigned short*)(lds + L_KT + (t * HP + d) * 2) = f2bf(kt);
            *(LAS unsigned short*)(lds + L_QT + (t * HP + d) * 2) = f2bf(qv * __expf(b - r));
            *(LAS unsigned short*)(lds + L_QH + (t * HP + d) * 2) = f2bf(qv * __expf(b)); } }
    if (!FULL) { LAS u32x4v* dst = (LAS u32x4v*)(lds + L_KTT + (d * TPI + t0) * 2); u32x4v a, b; a.x = ktp[0]; a.y = ktp[1]; a.z = ktp[2]; a.w = ktp[3]; b.x = ktp[4]; b.y = ktp[5]; b.z = ktp[6]; b.w = ktp[7]; dst[0] = a; dst[1] = b; }
    __syncthreads();
}
#define MFMA16(a, b, c) __builtin_amdgcn_mfma_f32_16x16x32_bf16((a), (b), (c), 0, 0, 0)
#define MFMA32(a, b, c) __builtin_amdgcn_mfma_f32_32x32x16_bf16((a), (b), (c), 0, 0, 0)
DI void hgrn_b1_all(const Prm& p, LAS unsigned char* lds, int tid, int lane, int wave) {
    const int fr = lane & 15, fq = lane >> 4;
    int item = blockIdx.x; if (item >= NITEM_H) return;
    unsigned rl[16], rv[16], rq[16];
    hgrn_loadraw<false>(p, hgrn_item(item), tid, rl, rv, rq);
    while (item < NITEM_H) {
        const HItem it = hgrn_item(item);
        hgrn_prep<false>(it, lds, tid, rl, rv, rq);
        const int next = item + gridDim.x;
        if (next < NITEM_H) hgrn_loadraw<false>(p, hgrn_item(next), tid, rl, rv, rq);
        const LAS float* vec = (const LAS float*)(lds + L_VEC);
        bf16x8 a[2];
#pragma unroll
        for (int ks = 0; ks < 2; ++ks) a[ks] = *(const LAS bf16x8*)(lds + L_KTT + ((16 * wave + fr) * TPI + 32 * ks + 8 * fq) * 2);
        float e2[4];
#pragma unroll
        for (int j = 0; j < 4; ++j) { const int d = 16 * wave + 4 * fq + j; e2[j] = __expf(vec[128 + d] - vec[d]); }
#pragma unroll
        for (int vt = 0; vt < 8; ++vt) { f32x4 acc = {0.f, 0.f, 0.f, 0.f};
#pragma unroll
            for (int ks = 0; ks < 2; ++ks) { const bf16x8 b = *(const LAS bf16x8*)(lds + L_IVT + ((16 * vt + fr) * TPI + 32 * ks + 8 * fq) * 2); acc = MFMA16(a[ks], b, acc); }
            u32x2 o; o.x = pk2(acc[0] * e2[0], acc[1] * e2[1]); o.y = pk2(acc[2] * e2[2], acc[3] * e2[3]);
            *(u32x2*)(p.UT + (size_t)item * 16384 + (16 * vt + fr) * 128 + 16 * wave + 4 * fq) = o; }
        if (tid < 128) p.AL[(size_t)item * 128 + tid] = __expf(vec[128 + tid]);
        __syncthreads();
        item = next;
    }
}
template <int NB> DI void hgrn_b2_steps(const Prm& p, int item, int v, int d4, float (&S)[4]) {
    u32x2 uu[NB]; f32x4 al[NB];
#pragma unroll
    for (int i = 0; i < NB; ++i) { uu[i] = *(const u32x2*)(p.UT + (size_t)(item + i) * 16384 + v * 128 + d4); al[i] = *(const f32x4*)(p.AL + (size_t)(item + i) * 128 + d4); }
#pragma unroll
    for (int i = 0; i < NB; ++i) { u32x2 o; o.x = pk2(S[0], S[1]); o.y = pk2(S[2], S[3]);
        *(u32x2*)(p.UT + (size_t)(item + i) * 16384 + v * 128 + d4) = o;
        S[0] = al[i][0] * S[0] + bflo(uu[i].x); S[1] = al[i][1] * S[1] + bfhi(uu[i].x); S[2] = al[i][2] * S[2] + bflo(uu[i].y); S[3] = al[i][3] * S[3] + bfhi(uu[i].y); }
}
DI void hgrn_b2(const Prm& p, int gtid, int GT) {
    for (int idx = gtid; idx < 64 * 4096; idx += GT) {
        const int bhx = idx >> 12, e = idx & 4095, v = e >> 5, d4 = (e & 31) * 4; const bool smp = bhx >= 32;
        float S[4] = {0.f, 0.f, 0.f, 0.f};
        if (smp) {
#pragma unroll
            for (int j = 0; j < 4; ++j) S[j] = p.state_hgrn[((size_t)(bhx - 32) * 128 + d4 + j) * 128 + v];
            hgrn_b2_steps<1>(p, 2080 + (bhx - 32), v, d4, S); }
        else { for (int c0 = 0; c0 < 65; c0 += 13) hgrn_b2_steps<13>(p, bhx * 65 + c0, v, d4, S); }
        float* dst = p.out + (smp ? O_HGS + (size_t)(bhx - 32) * 16384 : O_HGP + (size_t)bhx * 16384);
#pragma unroll
        for (int j = 0; j < 4; ++j) dst[(d4 + j) * 128 + v] = S[j];
    }
}
DI void hgrn_b3_all(const Prm& p, LAS unsigned char* lds, int tid, int lane, int wave) {
    const int fr = lane & 15, fq = lane >> 4;
    int item = blockIdx.x; if (item >= NITEM_H) return;
    unsigned rl[16], rv[16], rq[16];
    hgrn_loadraw<true>(p, hgrn_item(item), tid, rl, rv, rq);
    const int nt_ = tid >> 3, nsg = tid & 7;
    while (item < NITEM_H) {
        const HItem it = hgrn_item(item);
        bf16x8 sf[4][4];
#pragma unroll
        for (int i = 0; i < 4; ++i)
#pragma unroll
            for (int ks = 0; ks < 4; ++ks) sf[i][ks] = *(const bf16x8*)(p.UT + (size_t)item * 16384 + (16 * (4 * (wave >> 2) + i) + fr) * 128 + 32 * ks + 8 * fq);
        const size_t grow = (size_t)(it.row0 + (nt_ < it.L ? nt_ : 0)); const int gc0 = it.h * 128 + 16 * nsg;
        const u32x4v g0 = *(const u32x4v*)(p.GS + grow * 512 + gc0), g1 = *(const u32x4v*)(p.GS + grow * 512 + gc0 + 8);
        hgrn_prep<true>(it, lds, tid, rl, rv, rq);
        const int next = item + gridDim.x;
        if (next < NITEM_H) hgrn_loadraw<true>(p, hgrn_item(next), tid, rl, rv, rq);
        {
            const int tt = wave >> 1;
#pragma unroll
            for (int i = 0; i < 2; ++i) { const int st = 2 * (wave & 1) + i; f32x4 acc = {0.f, 0.f, 0.f, 0.f};
#pragma unroll
                for (int ks = 0; ks < 4; ++ks) { const bf16x8 a = *(const LAS bf16x8*)(lds + L_KT + ((16 * st + fr) * HP + 32 * ks + 8 * fq) * 2);
                    const bf16x8 b = *(const LAS bf16x8*)(lds + L_QT + ((16 * tt + fr) * HP + 32 * ks + 8 * fq) * 2); acc = MFMA16(a, b, acc); }
                const int t = 16 * tt + fr, s0 = 16 * st + 4 * fq;
                u32x2 o; o.x = pk2(s0 <= t ? acc[0] : 0.f, s0 + 1 <= t ? acc[1] : 0.f); o.y = pk2(s0 + 2 <= t ? acc[2] : 0.f, s0 + 3 <= t ? acc[3] : 0.f);
                *(LAS u32x2*)(lds + L_ATT + (t * TPI + s0) * 2) = o; }
        }
        __syncthreads();
        f32x4 oacc[4];
        {   const int tt = wave & 3;
            bf16x8 aa[2], aq[4];
#pragma unroll
            for (int ks = 0; ks < 2; ++ks) aa[ks] = *(const LAS bf16x8*)(lds + L_ATT + ((16 * tt + fr) * TPI + 32 * ks + 8 * fq) * 2);
#pragma unroll
            for (int ks = 0; ks < 4; ++ks) aq[ks] = *(const LAS bf16x8*)(lds + L_QH + ((16 * tt + fr) * HP + 32 * ks + 8 * fq) * 2);
#pragma unroll
            for (int i = 0; i < 4; ++i) { const int vt = 4 * (wave >> 2) + i; f32x4 acc = {0.f, 0.f, 0.f, 0.f};
#pragma unroll
                for (int ks = 0; ks < 2; ++ks) { const bf16x8 b = *(const LAS bf16x8*)(lds + L_IVT + ((16 * vt + fr) * TPI + 32 * ks + 8 * fq) * 2); acc = MFMA16(aa[ks], b, acc); }
#pragma unroll
                for (int ks = 0; ks < 4; ++ks) acc = MFMA16(aq[ks], sf[i][ks], acc);
                oacc[i] = acc; }
        }
        f32x4 gn[4];
#pragma unroll
        for (int j = 0; j < 4; ++j) gn[j] = ((const f32x4*)(p.hgrn_norm + 16 * nsg))[j];
        __syncthreads();
        {   const int tt = wave & 3; LAS float* ob = (LAS float*)(lds + L_OB);
#pragma unroll
            for (int i = 0; i < 4; ++i) { const int v = 16 * (4 * (wave >> 2) + i) + fr;
#pragma unroll
                for (int j = 0; j < 4; ++j) ob[(16 * tt + 4 * fq + j) * 132 + v] = oacc[i][j]; }
        }
        __syncthreads();
        {   const int t = nt_, sg = nsg; const LAS float* ob = (const LAS float*)(lds + L_OB) + t * 132 + 16 * sg;
            f32x4 x[4]; float ss = 0.f;
#pragma unroll
            for (int j = 0; j < 4; ++j) { x[j] = ((const LAS f32x4*)ob)[j]; ss += (x[j].x * x[j].x + x[j].y * x[j].y) + (x[j].z * x[j].z + x[j].w * x[j].w); }
            ss += __shfl_xor(ss, 1); ss += __shfl_xor(ss, 2); ss += __shfl_xor(ss, 4);
            const float rr = rsqrtf(ss * (1.f / 128.f) + EPSN);
            if (t < it.L) { const size_t row = it.row0 + t; const int c0 = it.h * 128 + 16 * sg;
                const f32x4 n0 = gn[0], n1 = gn[1], n2 = gn[2], n3 = gn[3];
                u32x4v o0, o1;
                o0.x = pk2(x[0].x * rr * n0.x * bflo(g0.x), x[0].y * rr * n0.y * bfhi(g0.x)); o0.y = pk2(x[0].z * rr * n0.z * bflo(g0.y), x[0].w * rr * n0.w * bfhi(g0.y));
                o0.z = pk2(x[1].x * rr * n1.x * bflo(g0.z), x[1].y * rr * n1.y * bfhi(g0.z)); o0.w = pk2(x[1].z * rr * n1.z * bflo(g0.w), x[1].w * rr * n1.w * bfhi(g0.w));
                o1.x = pk2(x[2].x * rr * n2.x * bflo(g1.x), x[2].y * rr * n2.y * bfhi(g1.x)); o1.y = pk2(x[2].z * rr * n2.z * bflo(g1.y), x[2].w * rr * n2.w * bfhi(g1.y));
                o1.z = pk2(x[3].x * rr * n3.x * bflo(g1.z), x[3].y * rr * n3.y * bfhi(g1.z)); o1.w = pk2(x[3].z * rr * n3.z * bflo(g1.w), x[3].w * rr * n3.w * bfhi(g1.w));
                *(u32x4v*)(p.CAT + row * 1024 + c0) = o0; *(u32x4v*)(p.CAT + row * 1024 + c0 + 8) = o1; }
        }
        __syncthreads();
        item = next;
    }
}
DI void s5_load_u(const Prm& p, int mt, int g, int lane, bf16x8 (&uf)[8]) {
    const int fr = lane & 15, fq = lane >> 4; int col = 16 * mt + fr; if (col >= NCOL) col = NCOL - 1;
#pragma unroll
    for (int ks = 0; ks < 8; ++ks) uf[ks] = *(const bf16x8*)(p.U + ((size_t)(16 * col + 2 * ks + (fq >> 1))) * 512 + 16 * g + 8 * (fq & 1));
}
DI void s5_b(const Prm& p, int gw, int NGW, int lane) {
    const int fr = lane & 15, fq = lane >> 4;
    for (int task = gw; task < 131 * 32; task += NGW) { const int mt = task >> 5, g = task & 31;
        bf16x8 uf[8]; s5_load_u(p, mt, g, lane, uf);
#pragma unroll
        for (int nt = 0; nt < 8; ++nt) { f32x4 acc = {0.f, 0.f, 0.f, 0.f};
#pragma unroll
            for (int ks = 0; ks < 8; ++ks) { const bf16x8 b = *(const bf16x8*)(p.HT + ((size_t)(g * 128 + 16 * nt + fr)) * 256 + 32 * ks + 8 * fq); acc = MFMA16(uf[ks], b, acc); }
#pragma unroll
            for (int j = 0; j < 4; ++j) { const int col = 16 * mt + 4 * fq + j; if (col < NCOL) p.XLOC[(size_t)col * 4096 + g * 128 + 16 * nt + fr] = acc[j]; } }
    }
}
template <int NB> DI void s5_c_steps(const Prm& p, int col, size_t base, float ar, float ai, float& xr, float& xi) {
    f32x2v xl[NB];
#pragma unroll
    for (int i = 0; i < NB; ++i) xl[i] = *(const f32x2v*)(p.XLOC + (size_t)(col + i) * 4096 + base);
#pragma unroll
    for (int i = 0; i < NB; ++i) { *(unsigned*)(p.XPREV + (size_t)(col + i) * 4096 + base) = pk2(xr, xi);
        const float nr = ar * xr - ai * xi + xl[i].x, ni = ar * xi + ai * xr + xl[i].y; xr = nr; xi = ni; }
}
DI void s5_c(const Prm& p, int gtid) {
    if (gtid >= 16 * 2048) return;
    const int seq = gtid >> 11, g = (gtid >> 6) & 31, n = gtid & 63; const bool smp = seq >= 8; const int b = seq & 7;
    float xr = 0.f, xi = 0.f; if (smp) { xr = p.ssm_re0[(b * 32 + g) * 64 + n]; xi = p.ssm_im0[(b * 32 + g) * 64 + n]; }
    const float ar = p.A16[2 * (g * 64 + n)], ai = p.A16[2 * (g * 64 + n) + 1];
    const size_t base = (size_t)g * 128 + 2 * n;
    if (smp) s5_c_steps<4>(p, 2056 + 4 * b, base, ar, ai, xr, xi);
    else { for (int c0 = 0; c0 < 256; c0 += 16) s5_c_steps<16>(p, 257 * b + c0, base, ar, ai, xr, xi); s5_c_steps<1>(p, 257 * b + 256, base, ar, ai, xr, xi); }
    const size_t o = (size_t)(b * 32 + g) * 64 + n;
    p.out[(smp ? O_SRS : O_SRP) + o] = xr; p.out[(smp ? O_SIS : O_SIP) + o] = xi;
}
DI f32x2v gelu_pk(f32x2v v) {
    const f32x2v av = __builtin_elementwise_abs(v), d = av * 0.2316418882f + 1.0f;
    f32x2v t; t.x = __builtin_amdgcn_rcpf(d.x); t.y = __builtin_amdgcn_rcpf(d.y);
    f32x2v q = t * 0.5307027145f + (-0.7265760135f); q = q * t + 0.7107068705f; q = q * t + (-0.142248368f); q = q * t + 0.127414796f; q = q * t;
    const f32x2v s = (v * v) * (-0.72134752044f);
    f32x2v e; e.x = __builtin_amdgcn_exp2f(s.x); e.y = __builtin_amdgcn_exp2f(s.y);
    const f32x2v m = v * (q * e), r = v - m;
    f32x2v o; o.x = v.x < 0.f ? m.x : r.x; o.y = v.y < 0.f ? m.y : r.y; return o;
}
DI void s5_d(const Prm& p, int gw, int NGW, int lane) {
    const int fr = lane & 15, fq = lane >> 4;
    for (int task = gw; task < 131 * 32; task += NGW) { const int mt = task >> 5, g = task & 31;
        bf16x8 uf[8], xf[4]; s5_load_u(p, mt, g, lane, uf);
        int colc = 16 * mt + fr; if (colc >= NCOL) colc = NCOL - 1;
#pragma unroll
        for (int ks = 0; ks < 4; ++ks) xf[ks] = *(const bf16x8*)(p.XPREV + (size_t)colc * 4096 + g * 128 + 32 * ks + 8 * fq);
        const bf16_t* tg = p.TG + ((size_t)(g * 256 + fr)) * 384 + 8 * fq;
        const bool ok = 16 * mt + fr < NCOL;
#pragma unroll
        for (int t = 0; t < 16; ++t) { f32x4 acc = {0.f, 0.f, 0.f, 0.f};
#pragma unroll
            for (int ks = 0; ks < 8; ++ks) if (ks <= (t >> 1)) { const bf16x8 a = *(const bf16x8*)(tg + (size_t)t * 16 * 384 + 32 * ks); acc = MFMA16(a, uf[ks], acc); }
#pragma unroll
            for (int ks = 0; ks < 4; ++ks) { const bf16x8 a = *(const bf16x8*)(tg + (size_t)t * 16 * 384 + 256 + 32 * ks); acc = MFMA16(a, xf[ks], acc); }
            const f32x2v y0 = gelu_pk((f32x2v){acc[0], acc[1]}), y1 = gelu_pk((f32x2v){acc[2], acc[3]});
            u32x2 o; o.x = pk2(y0.x, y0.y); o.y = pk2(y1.x, y1.y);
            if (ok) *(u32x2*)(p.YG + ((size_t)(16 * (16 * mt + fr) + t)) * 512 + 16 * g + 4 * fq) = o; }
    }
}

DI void s5_b_lds(const Prm& p, LAS unsigned char* lds, int tid, int lane, int wave) {
    const int fr = lane & 15, fq = lane >> 4;
    for (int gp = blockIdx.x; gp < 256; gp += gridDim.x) { const int g = gp & 31, part = gp >> 5;
        for (int i = tid; i < 128 * 32; i += 512) { const int row = i >> 5, ch = i & 31;
            *(LAS u32x4v*)(lds + row * 528 + ch * 16) = *(const u32x4v*)(p.HT + ((size_t)(g * 128 + row)) * 256 + ch * 8); }
        __syncthreads();
        for (int mt = part + 8 * wave; mt < 131; mt += 64) {
            bf16x8 uf[8]; s5_load_u(p, mt, g, lane, uf);
#pragma unroll 1
            for (int nt = 0; nt < 8; ++nt) { f32x4 acc = {0.f, 0.f, 0.f, 0.f};
#pragma unroll
                for (int ks = 0; ks < 8; ++ks) { const bf16x8 b = *(const LAS bf16x8*)(lds + (16 * nt + fr) * 528 + 64 * ks + 16 * fq); acc = MFMA16(uf[ks], b, acc); }
#pragma unroll
                for (int j = 0; j < 4; ++j) { const int col = 16 * mt + 4 * fq + j; if (col < NCOL) p.XLOC[(size_t)col * 4096 + g * 128 + 16 * nt + fr] = acc[j]; } }
        }
        __syncthreads(); }
}
DI void s5_d_lds(const Prm& p, LAS unsigned char* lds, int tid, int lane, int wave) {
    const int fr = lane & 15, fq = lane >> 4;
    for (int gp = blockIdx.x; gp < 256; gp += gridDim.x) { const int g = gp & 31, part = gp >> 5;
        { const int row = tid >> 1, hf = tid & 1;
            *(LAS u32x4v*)(lds + row * 48 + hf * 16) = *(const u32x4v*)(p.TG + ((size_t)(g * 256 + row)) * 16 + hf * 8); }
        for (int i = tid; i < 256 * 16; i += 512) { const int row = i >> 4, ch = i & 15;
            *(LAS u32x4v*)(lds + 12288 + row * 272 + ch * 16) = *(const u32x4v*)(p.TG + 131072 + ((size_t)(g * 256 + row)) * 128 + ch * 8); }
        __syncthreads();
        const int lb = fr * 48 + (fq & 1) * 16, hi = fq >> 1;
        for (int mt = part + 8 * wave; mt < 131; mt += 64) {
            bf16x8 uf[8], xf[4]; s5_load_u(p, mt, g, lane, uf);
            int colc = 16 * mt + fr; if (colc >= NCOL) colc = NCOL - 1;
#pragma unroll
            for (int ks = 0; ks < 4; ++ks) xf[ks] = *(const bf16x8*)(p.XPREV + (size_t)colc * 4096 + g * 128 + 32 * ks + 8 * fq);
            const bool ok = 16 * mt + fr < NCOL;
#pragma unroll 1
            for (int t = 0; t < 16; ++t) { f32x4 acc = {0.f, 0.f, 0.f, 0.f};
#pragma unroll
                for (int ks = 0; ks < 8; ++ks) if (ks <= (t >> 1)) {
                    const int tau = t - 2 * ks - hi;
                    union { bf16x8 v; u32x4v u; } a; a.v = *(const LAS bf16x8*)(lds + (tau < 0 ? 0 : tau) * 768 + lb);
                    if (tau < 0) a.u = (u32x4v){0u, 0u, 0u, 0u};
                    acc = MFMA16(a.v, uf[ks], acc); }
#pragma unroll
                for (int ks = 0; ks < 4; ++ks) { const bf16x8 a = *(const LAS bf16x8*)(lds + 12288 + (t * 16 + fr) * 272 + 64 * ks + 16 * fq); acc = MFMA16(a, xf[ks], acc); }
                const f32x2v y0 = gelu_pk((f32x2v){acc[0], acc[1]}), y1 = gelu_pk((f32x2v){acc[2], acc[3]});
                u32x2 o; o.x = pk2(y0.x, y0.y); o.y = pk2(y1.x, y1.y);
                if (ok) *(u32x2*)(p.YG + ((size_t)(16 * (16 * mt + fr) + t)) * 512 + 16 * g + 4 * fq) = o; }
        }
        __syncthreads(); }
}
DI void cache_convert(const Prm& p, int gtid, int GT) {
    for (size_t i = (size_t)gtid; i < (size_t)8 * 1024 * 256; i += (size_t)GT) {
        const size_t row = i >> 8; const int c4 = (int)(i & 255) * 4, b = (int)(row >> 10), pos = (int)(row & 1023), h = c4 >> 7, d = c4 & 127;
        const f32x4 k = *(const f32x4*)(p.cache_k + row * 1024 + c4); u32x2 o; o.x = pk2(k.x, k.y); o.y = pk2(k.z, k.w);
        *(u32x2*)(p.KS + kf_index(b * 8 + h, 34, pos, d)) = o;
        const f32x4 v = *(const f32x4*)(p.cache_v + row * 1024 + c4); bf16_t* vt = p.VTS + vf_index(b * 8 + h, 34, pos, d);
        vt[0] = f2bf(v.x); vt[8] = f2bf(v.y); vt[16] = f2bf(v.z); vt[24] = f2bf(v.w); }
}
DI void attn_phase(const Prm& p, LAS unsigned char* lds, int wave, int gw, int NGW, int lane) {
    const int q = lane & 31, half = lane >> 5;
    LAS unsigned char* wl = lds + wave * 16384;
    for (int it = gw; it < 8256 + 128; it += NGW) {
        bool smp; int b, h, qb;
        if (it < 8064) { smp = false; b = it / 1008; const int rem = it - b * 1008; h = rem / 126; qb = 3 + rem - h * 126; }
        else if (it < 8192) { const int s = it - 8064; smp = true; b = s >> 4; h = (s >> 1) & 7; qb = s & 1; }
        else { const int s = it - 8192; smp = false; b = s / 24; const int rem = s - b * 24; h = rem / 3; qb = rem - h * 3; }
        const size_t tbase = (size_t)(b * 8 + h) * (smp ? 34 : 129) * 4096 + lane * 8;
        const bf16_t* Kb = (smp ? p.KS : p.KP) + tbase; const bf16_t* Vb = (smp ? p.VTS : p.VTP) + tbase;
        const int qpos0 = (smp ? 1024 : 0) + 32 * qb, qrow0 = smp ? NTP + b * 64 + 32 * qb : b * TP + 32 * qb;
        const int qpos = qpos0 + q; const bool qvalid = smp || qpos < TP; const size_t qrow = qvalid ? qrow0 + q : qrow0;
        bf16x8 qf[8];
#pragma unroll
        for (int ks = 0; ks < 8; ++ks) qf[ks] = *(const bf16x8*)(p.Q + qrow * 1024 + h * 128 + 16 * ks + 8 * half);
        f32x16 o[4];
#pragma unroll
        for (int db = 0; db < 4; ++db)
#pragma unroll
            for (int e = 0; e < 16; ++e) o[db][e] = 0.f;
        float C = 1.f;
        for (int kt = (qpos0 + 30) >> 5; kt >= 0; --kt) {
            f32x16 s;
#pragma unroll
            for (int e = 0; e < 16; ++e) s[e] = 0.f;
            const bf16_t* kr = Kb + (size_t)kt * 4096; const bf16_t* vr = Vb + (size_t)kt * 4096;
            bf16x8 kf[8], vf[8];
#pragma unroll
            for (int ks = 0; ks < 8; ++ks) kf[ks] = *(const bf16x8*)(kr + ks * 512);
#pragma unroll
            for (int ks = 0; ks < 8; ++ks) vf[ks] = *(const bf16x8*)(vr + ks * 512);
#pragma unroll
            for (int ks = 0; ks < 8; ++ks) s = MFMA32(kf[ks], qf[ks], s);
            float pr[16], be[16], G[4], Gp[4];
#pragma unroll
            for (int i = 0; i < 4; ++i) {
#pragma unroll
                for (int j = 0; j < 4; ++j) { const int key = 32 * kt + 8 * i + 4 * half + j; const bool valid = key < qpos;
                    float z = s[4 * i + j] * 0.08838834764831845f; z = fminf(fmaxf(z, -80.f), 80.f);
                    const float e = __expf(z), pp = __builtin_amdgcn_rcpf(1.f + e); pr[4 * i + j] = valid ? pp : 1.f; be[4 * i + j] = valid ? e * pp : 0.f; }
                G[i] = (pr[4 * i] * pr[4 * i + 1]) * (pr[4 * i + 2] * pr[4 * i + 3]); }
#pragma unroll
            for (int i = 0; i < 4; ++i) Gp[i] = __shfl_xor(G[i], 32);
            float w[16]; float E1 = 1.f;
#pragma unroll
            for (int i = 3; i >= 0; --i) { const float Glo = half ? Gp[i] : G[i], Ghi = half ? G[i] : Gp[i];
                float suf = C * (half ? E1 : E1 * Ghi);
#pragma unroll
                for (int j = 3; j >= 0; --j) { w[4 * i + j] = be[4 * i + j] * suf; suf *= pr[4 * i + j]; }
                E1 *= Glo * Ghi; }
            C *= E1;
#pragma unroll
            for (int c = 0; c < 2; ++c) { union { bf16x8 v; unsigned u[4]; } wf;
#pragma unroll
                for (int e = 0; e < 4; ++e) wf.u[e] = pk2(w[8 * c + 2 * e], w[8 * c + 2 * e + 1]);
#pragma unroll
                for (int db = 0; db < 4; ++db) o[db] = MFMA32(vf[4 * c + db], wf.v, o[db]); }
            if (__all(C < 1e-24f)) break;
        }
#pragma unroll
        for (int db = 0; db < 4; ++db)
#pragma unroll
            for (int i = 0; i < 4; ++i) { u32x2 ov; ov.x = pk2(o[db][4 * i], o[db][4 * i + 1]); ov.y = pk2(o[db][4 * i + 2], o[db][4 * i + 3]);
                *(LAS u32x2*)(wl + q * 272 + (32 * db + 8 * i + 4 * half) * 2) = ov; }
#pragma unroll
        for (int k = 0; k < 8; ++k) { const int r = (lane >> 4) + 4 * k, ch = lane & 15;
            const u32x4v v = *(const LAS u32x4v*)(wl + r * 272 + ch * 16);
            if (smp || qpos0 + r < TP) *(u32x4v*)(p.O + (size_t)(qrow0 + r) * 1024 + h * 128 + ch * 8) = v; }
    }
}
DI void final_norm(const Prm& p, int gw, int NGW, int lane) {
    for (int r = gw; r < 32768 + 512; r += NGW) {
        int grow; float* dst;
        if (r < 32768) { const int b = r >> 12, t = r & 4095; grow = b * TP + 16 + t; dst = p.out + O_YP + (size_t)r * 1024; } else { grow = NTP + (r - 32768); dst = p.out + O_YS + (size_t)(r - 32768) * 1024; }
        u32x2 x[4];
#pragma unroll
        for (int j = 0; j < 4; ++j) x[j] = ((const u32x2*)(p.XB + (size_t)grow * 1024))[lane + 64 * j];
        const float rr = row_rinv(p.SSQ, grow);
#pragma unroll
        for (int j = 0; j < 4; ++j) { f32x4 v; v.x = bflo(x[j].x); v.y = bfhi(x[j].x); v.z = bflo(x[j].y); v.w = bfhi(x[j].y); ((f32x4*)dst)[lane + 64 * j] = v * rr * ((const f32x4*)p.ln_final)[lane + 64 * j]; }
    }
}

#define XB_TMO      128
#define XB_XCNT(j)  (256  + 64 * (j))
#define XB_XSUB(j)  (1280 + 64 * (j))
#define XB_XGEN(j)  (2304 + 64 * (j))
#define XB_TOP      3328
#define XB_TOPGEN   3392
#define XCD_BAR_WORDS 3456
#define XB_SPIN_CAP (1u << 18)
DI unsigned xb_ld(unsigned* p) { return __hip_atomic_load(p, __ATOMIC_RELAXED, __HIP_MEMORY_SCOPE_AGENT); }
DI unsigned xb_add(unsigned* p, unsigned v) { return __hip_atomic_fetch_add(p, v, __ATOMIC_RELAXED, __HIP_MEMORY_SCOPE_AGENT); }
DI unsigned xb_xcc_id() { return (unsigned)__builtin_amdgcn_s_getreg((3 << 11) | 20) & 0xFu; }
#define XB_SPIN(cond, bar) do { unsigned _sp = 0; while (cond) { __builtin_amdgcn_s_sleep(1); \
    if ((++_sp & 255u) == 0u) { if (xb_ld(&(bar)[XB_TMO])) break; if (_sp > XB_SPIN_CAP) { atomicAdd(&(bar)[XB_TMO], 1u); break; } } } } while (0)
struct XcdBarrier { unsigned* bar; unsigned x; volatile LAS unsigned* st; };
DI XcdBarrier xcd_barrier_post(unsigned* bar, volatile LAS unsigned* st) {
    XcdBarrier b; b.bar = bar; b.x = xb_xcc_id(); b.st = st;
    if (threadIdx.x == 0) (void)xb_add(&bar[XB_XCNT(b.x)], 1u);
    return b;
}
DI void xcd_barrier_complete(unsigned* bar, unsigned x, unsigned& nloc, unsigned& nx) {
    const unsigned G = gridDim.x * gridDim.y * gridDim.z;
    unsigned sum, cnt, mine, sp = 0u;
    for (;;) {
        sum = 0u; cnt = 0u; mine = 0u;
#pragma unroll
        for (unsigned j = 0; j < 16; ++j) { const unsigned c = xb_ld(&bar[XB_XCNT(j)]); sum += c; cnt += (c > 0u) ? 1u : 0u; mine = (j == x) ? c : mine; }
        if (sum == G) break;
        __builtin_amdgcn_s_sleep(1);
        if ((++sp & 255u) == 0u) { if (xb_ld(&bar[XB_TMO])) break; if (sp > XB_SPIN_CAP) { atomicAdd(&bar[XB_TMO], 1u); break; } }
    }
    nloc = mine > 0u ? mine : 1u; nx = cnt > 0u ? cnt : 1u;
}
DI void xcd_barrier(const XcdBarrier& b) {
    asm volatile("s_waitcnt vmcnt(0)" ::: "memory");
    __syncthreads();
    if (threadIdx.x == 0) {
        unsigned* bar = b.bar;
        __builtin_amdgcn_s_waitcnt(0);
        unsigned nloc = b.st[0], nx = b.st[1];
        if (nloc == 0u) { xcd_barrier_complete(bar, b.x, nloc, nx); b.st[0] = nloc; b.st[1] = nx; }
        const unsigned old = xb_add(&bar[XB_XSUB(b.x)], 1u);
        const unsigned gen = old / nloc;
        if (old + 1u == (gen + 1u) * nloc) {
            __builtin_amdgcn_fence(__ATOMIC_RELEASE, "agent");
            asm volatile("s_waitcnt vmcnt(0)" ::: "memory");
            const unsigned og = xb_add(&bar[XB_TOP], 1u);
            const unsigned tg = og / nx;
            if (og + 1u == (tg + 1u) * nx) xb_add(&bar[XB_TOPGEN], 1u);
            else XB_SPIN(xb_ld(&bar[XB_TOPGEN]) == tg, bar);
            __builtin_amdgcn_fence(__ATOMIC_ACQUIRE, "agent");
            xb_add(&bar[XB_XGEN(b.x)], 1u);
            asm volatile("s_waitcnt vmcnt(0)" ::: "memory");
        } else {
            XB_SPIN(xb_ld(&bar[XB_XGEN(b.x)]) == gen, bar);
            __builtin_amdgcn_fence(__ATOMIC_ACQUIRE, "agent");
            asm volatile("s_waitcnt vmcnt(0)" ::: "memory");
        }
    }
    __syncthreads();
}
constexpr int LDS_BYTES = 131072 + 256;
__global__ void __launch_bounds__(512, 2) fwd_megakernel(Prm p) {
    extern __shared__ __attribute__((aligned(16))) unsigned char shm[];
    LAS unsigned char* lds = (LAS unsigned char*)shm;
    cg::grid_group grid = cg::this_grid();
    const int tid = threadIdx.x, lane = tid & 63, wave = __builtin_amdgcn_readfirstlane(tid >> 6);
    const int gw = blockIdx.x * 8 + wave, NGW = gridDim.x * 8, gtid = blockIdx.x * 512 + tid, GT = gridDim.x * 512;
    volatile LAS unsigned* xst = (volatile LAS unsigned*)(lds + 131072);
    if (tid == 0) { xst[0] = 0u; xst[1] = 0u; }
    __syncthreads();
    const XcdBarrier xb = xcd_barrier_post(p.BAR, xst);
    phase_prologue(p, lds, tid, lane, wave);
    grid.sync();
    { EpiIn0 E; E.SSQ = p.SSQ; E.RINV = p.RINV; E.LB = p.LB; E.Qh = p.Qh; E.IV = p.IV; E.GS = p.GS; E.U = p.U; E.LOGF = p.LOGF; run_gemm(lds, p.XB, p.Wt1, 2560, 1024, E); }
    xcd_barrier(xb);
    hgrn_b1_all(p, lds, tid, lane, wave);
    s5_b_lds(p, lds, tid, lane, wave);
    xcd_barrier(xb);
    hgrn_b2(p, gtid, GT);
    s5_c(p, gtid);
    xcd_barrier(xb);
    hgrn_b3_all(p, lds, tid, lane, wave);
    s5_d_lds(p, lds, tid, lane, wave);
    xcd_barrier(xb);
    { EpiGlu E; E.YG = p.YG; E.CAT = p.CAT; run_gemm(lds, p.YG, p.Wglu, 512, 512, E); }
    xcd_barrier(xb);
    { EpiRes E; E.XB = p.XB; E.SSQ = p.SSQ; run_gemm_split(lds, p.CAT, p.Wo0, 1024, 1024, E, (float*)p.H); xcd_barrier(xb); gemm_fixup(1024, 1024, E, (const float*)p.H, tid); rinv_pass(p, 1024, tid); }
    xcd_barrier(xb);
    { EpiUp E; E.SSQ = p.SSQ; E.RINV = p.RINV; E.H = p.H; run_gemm(lds, p.XB, p.Wup0, 4096, 1024, E); }
    xcd_barrier(xb);
    { EpiRes E; E.XB = p.XB; E.SSQ = p.SSQ; run_gemm_split(lds, p.H, p.Wdn0, 1024, 4096, E, (float*)p.CAT); xcd_barrier(xb); gemm_fixup(1024, 4096, E, (const float*)p.CAT, tid); rinv_pass(p, 4096, tid); }
    xcd_barrier(xb);
    { EpiQkv E; E.SSQ = p.SSQ; E.RINV = p.RINV; E.out = p.out; E.Q = p.Q; E.KP = p.KP; E.KS = p.KS; E.VTP = p.VTP; E.VTS = p.VTS; run_gemm(lds, p.XB, p.Wqkv, 3072, 1024, E); }
    if (gridDim.x > 36) { if (blockIdx.x >= 36) cache_convert(p, (blockIdx.x - 36) * 512 + tid, (gridDim.x - 36) * 512); } else cache_convert(p, gtid, GT);
    xcd_barrier(xb);
    attn_phase(p, lds, wave, gw, NGW, lane);
    xcd_barrier(xb);
    { EpiRes E; E.XB = p.XB; E.SSQ = p.SSQ; run_gemm_split(lds, p.O, p.Wo1, 1024, 1024, E, (float*)p.H); xcd_barrier(xb); gemm_fixup(1024, 1024, E, (const float*)p.H, tid); rinv_pass(p, 1024, tid); }
    xcd_barrier(xb);
    { EpiUp E; E.SSQ = p.SSQ; E.RINV = p.RINV; E.H = p.H; run_gemm(lds, p.XB, p.Wup1, 4096, 1024, E); }
    xcd_barrier(xb);
    { EpiRes E; E.XB = p.XB; E.SSQ = p.SSQ; run_gemm_split(lds, p.H, p.Wdn1, 1024, 4096, E, (float*)p.CAT); xcd_barrier(xb); gemm_fixup(1024, 4096, E, (const float*)p.CAT, tid); }
    xcd_barrier(xb);
    final_norm(p, gw, NGW, lane);
}

extern "C" void kernel_launch(void* const* d_in, const int* in_sizes, int n_in, void* d_out, int out_size, void* d_ws, size_t ws_size, hipStream_t stream) {
    static int grid_blocks = 0;
    if (grid_blocks == 0) {
        int dev = 0, cus = 0, per_cu = 0;
        hipGetDevice(&dev); hipDeviceGetAttribute(&cus, hipDeviceAttributeMultiprocessorCount, dev);
        if (hipFuncSetAttribute((const void*)fwd_megakernel, hipFuncAttributeMaxDynamicSharedMemorySize, LDS_BYTES) != hipSuccess) fprintf(stderr, "kernel_launch: hipFuncSetAttribute failed\n");
        if (hipOccupancyMaxActiveBlocksPerMultiprocessor(&per_cu, (const void*)fwd_megakernel, 512, LDS_BYTES) != hipSuccess || per_cu < 1) { fprintf(stderr, "kernel_launch: occupancy query says %d\n", per_cu); per_cu = 1; }
        (void)hipGetLastError();
        grid_blocks = cus > 0 ? cus : 256;
    }
    Prm p{};
    const float* const* in = (const float* const*)d_in;
    p.x_prompt = in[0]; p.x_sample = in[1]; p.state_hgrn = in[2]; p.ssm_re0 = in[3]; p.ssm_im0 = in[4]; p.cache_k = in[5]; p.cache_v = in[6]; p.meta = in[7]; p.ln_mix = in[8]; p.ln_mlp = in[9];
    p.ln_final = in[10]; p.w_in_even = in[11]; p.hgrn_lb = in[12]; p.hgrn_norm = in[13]; p.a_re = in[14]; p.a_im = in[15]; p.log_dt = in[16]; p.b_re = in[17]; p.b_im = in[18]; p.c_re = in[19];
    p.c_im = in[20]; p.ssm_d = in[21]; p.w_glu = in[22]; p.w_out_even = in[23]; p.w_in_odd = in[24]; p.w_out_odd = in[25]; p.w_up = in[26]; p.w_down = in[27];
    p.out = (float*)d_out;
    unsigned char* ws = (unsigned char*)d_ws; size_t off = 0;
    auto take = [&](size_t bytes) { unsigned char* r = ws + off; off += (bytes + 255) & ~(size_t)255; return r; };
    p.Wt1 = (bf16_t*)take((size_t)2560 * 1024 * 2); p.Wglu = (bf16_t*)take((size_t)512 * 512 * 2); p.Wo0 = (bf16_t*)take((size_t)1024 * 1024 * 2); p.Wup0 = (bf16_t*)take((size_t)4096 * 1024 * 2);
    p.Wdn0 = (bf16_t*)take((size_t)4096 * 1024 * 2); p.Wqkv = (bf16_t*)take((size_t)3072 * 1024 * 2); p.Wo1 = (bf16_t*)take((size_t)1024 * 1024 * 2); p.Wup1 = (bf16_t*)take((size_t)4096 * 1024 * 2);
    p.Wdn1 = (bf16_t*)take((size_t)4096 * 1024 * 2);
    p.XB = (bf16_t*)take((size_t)MP * 1024 * 2); p.SSQ = (float*)take((size_t)MP * 16 * 4); p.RINV = (float*)take((size_t)MP * 4); p.LB = (float*)take(2048); p.KTAB = (float*)take((size_t)32 * 16 * 256 * 4);
    p.TG = (bf16_t*)take((size_t)32 * 256 * 384 * 2); p.HT = (bf16_t*)take((size_t)32 * 128 * 256 * 2); p.A16 = (float*)take(32 * 64 * 2 * 4); p.BAR = (unsigned*)take(XCD_BAR_WORDS * 4);
    const size_t S0 = off; constexpr size_t SZ512 = (size_t)MP * 512 * 2;
    p.Qh = (bf16_t*)take(SZ512); p.LOGF = (unsigned short*)take(SZ512); p.IV = (bf16_t*)take(SZ512); p.GS = (bf16_t*)take(SZ512); p.U = (bf16_t*)take(SZ512);
    p.UT = (bf16_t*)take((size_t)NITEM_H * 16384 * 2); p.AL = (float*)take((size_t)NITEM_H * 128 * 4);
    p.XLOC = (float*)take(SZ512); p.YG = (bf16_t*)p.XLOC;
    p.XPREV = (bf16_t*)take((size_t)NCOL * 4096 * 2); p.CAT = (bf16_t*)take((size_t)MP * 1024 * 2);
    size_t end = off;
    off = S0; p.H = (bf16_t*)take((size_t)MP * 4096 * 2); if (off > end) end = off;
    off = S0; p.Q = (bf16_t*)take((size_t)MP * 1024 * 2); p.KP = (bf16_t*)take((size_t)64 * 129 * 4096 * 2); p.KS = (bf16_t*)take((size_t)64 * 34 * 4096 * 2);
    p.VTP = (bf16_t*)take((size_t)64 * 129 * 4096 * 2); p.VTS = (bf16_t*)take((size_t)64 * 34 * 4096 * 2); p.O = (bf16_t*)take((size_t)MP * 1024 * 2); if (off > end) end = off;
    if (end > ws_size || n_in != 28 || (size_t)out_size != O_END) { fprintf(stderr, "kernel_launch: workspace/shape mismatch: need %zu have %zu, n_in %d, out %d\n", end, ws_size, n_in, out_size); return; }
    (void)hipMemsetAsync(p.BAR, 0, XCD_BAR_WORDS * 4, stream);
    void* args[] = {&p};
    hipError_t e = hipLaunchCooperativeKernel((const void*)fwd_megakernel, dim3(grid_blocks), dim3(512), args, LDS_BYTES, stream);
    if (e != hipSuccess) fprintf(stderr, "cooperative launch failed: %s (grid %d)\n", hipGetErrorString(e), grid_blocks);
}
```

```cpp
#include <hip/hip_runtime.h>
#include <hip/hip_cooperative_groups.h>
#include <cstdio>
#include <cstdint>
namespace cg = cooperative_groups;
namespace pg8 {
#define PG8_LAS __attribute__((address_space(3)))
typedef unsigned short bf16_t;
typedef short bf16x8 __attribute__((ext_vector_type(8)));
typedef float f32x4 __attribute__((ext_vector_type(4)));
typedef unsigned u32x4 __attribute__((ext_vector_type(4)));
constexpr int BM = 256, BK = 64, HALF = 128, HTB = HALF * BK * 2  , STAGE_BYTES = 8 * HTB, NXCD = 8, WGM = 8;

__host__ __device__ __forceinline__ int lds_byte(int r, int c) { const int st = (r >> 4) * 2 + (c >> 5), rr = r & 15, cc = c & 31, ob = rr * 64 + cc * 2; return st * 1024 + (ob ^ (((ob >> 9) & 1) << 5)); }
__host__ __device__ __forceinline__ void stage_rc(int b, int& R, int& C) { const int st = b / 1024, sb = b % 1024, swz = sb ^ (((sb >> 9) & 1) << 5); R = (st >> 1) * 16 + swz / 64; C = (st & 1) * 32 + (swz % 64) / 2; }
__host__ __device__ __forceinline__ int perm32(int rho) { const int n = rho >> 4, i = rho & 15; return 8 * (i >> 2) + 4 * n + (i & 3); }

struct Unit { int pm, pn, kb, nk, part; };
struct Gemm { const bf16_t* A; const bf16_t* Bt; int M, N, K; float* part; };

struct StaticOrder {
    int nM, nN, nwg, G, c;
    __host__ __device__ void init(int M, int N, int G_, int c_) { nM = M / BM; nN = N / BM; nwg = nM * nN; G = G_; c = c_; }
    __host__ __device__ void map(int L, Unit& u) const {
        int wgid = L; { const int q = nwg / NXCD, r = nwg % NXCD, xcd = wgid % NXCD, off = wgid / NXCD; wgid = (xcd < r ? xcd * (q + 1) : r * (q + 1) + (xcd - r) * q) + off; }
        const int nig = WGM * nN, gid = wgid / nig, fm = gid * WGM, gsz = (nM - fm) < WGM ? (nM - fm) : WGM;
        u.pm = fm + ((wgid % nig) % gsz); u.pn = (wgid % nig) / gsz; u.kb = 0; u.nk = 0; u.part = -1;
    }
    __host__ __device__ bool next(int i, Unit& u) const {
        const long L = (long)i * G + c; if (L >= nwg) return false;
        map((int)L, u); return true;
    }
    __device__ __forceinline__ void a_ready(const Unit&) const {}
    __device__ __forceinline__ void done(const Unit&) const {}
};
template <class Epi, class Sched>
__device__ __forceinline__ void gemm_phase(PG8_LAS unsigned char* lds, const Gemm g, const Sched& S, const Epi& E) {
    int tid_ = threadIdx.x; asm volatile("" : "+v"(tid_));
    const int tid = tid_, wid = __builtin_amdgcn_readfirstlane(tid >> 6), lane = tid & 63, wr = wid >> 2, wc = wid & 3, fr = lane & 15, fq = lane >> 4;
    const int K = g.K, nt = K / BK;
    unsigned voffA[2], voffB[2];
#pragma unroll
    for (int i = 0; i < 2; ++i) { int R, C; stage_rc(tid * 16 + i * 8192, R, C); const int Rb = Epi::PERM ? ((R & ~31) + perm32(R & 31)) : R;
        voffA[i] = (unsigned)(R * K + C) * 2u; voffB[i] = (unsigned)(Rb * K + C) * 2u; }
    const size_t kstep = (size_t)(BK * 2);
    const size_t hstep = (size_t)HALF * K * 2;
    const size_t tstep = 2 * hstep;
    const unsigned ldsw = (unsigned)wid * 1024u;
    const int aoff = lds_byte(wr * 64 + fr, fq * 8), boff = lds_byte(wc * 32 + fr, fq * 8);
#define PG8_SA(b, h) (((b) * 2 + (h)) * HTB)
#define PG8_SB(b, h) ((4 + (b) * 2 + (h)) * HTB)
#define PG8_STAGE(bufoff, gbase, voff) do { _Pragma("unroll") for (int _i = 0; _i < 2; ++_i) \
        __builtin_amdgcn_global_load_lds((const unsigned*)((const char*)(gbase) + (voff)[_i]), (PG8_LAS unsigned*)(lds + (bufoff) + ldsw + _i * 8192), 16, 0, 0); } while (0)
#define PG8_LDA(dst, b, h) do { _Pragma("unroll") for (int m = 0; m < 4; ++m) _Pragma("unroll") for (int k = 0; k < 2; ++k) dst[m][k] = *(const PG8_LAS bf16x8*)(lds + PG8_SA(b, h) + aoff + m * 2048 + k * 1024); } while (0)
#define PG8_LDB(dst, b, h) do { _Pragma("unroll") for (int n = 0; n < 2; ++n) _Pragma("unroll") for (int k = 0; k < 2; ++k) dst[n][k] = *(const PG8_LAS bf16x8*)(lds + PG8_SB(b, h) + boff + n * 2048 + k * 1024); } while (0)
#define PG8_MMA(ai, bj, At, Bt) do { __builtin_amdgcn_s_setprio(1); _Pragma("unroll") for (int m = 0; m < 4; ++m) _Pragma("unroll") for (int n = 0; n < 2; ++n) _Pragma("unroll") for (int k = 0; k < 2; ++k) \
        acc[ai][bj][m][n] = __builtin_amdgcn_mfma_f32_16x16x32_bf16(Bt[n][k], At[m][k], acc[ai][bj][m][n], 0, 0, 0); __builtin_amdgcn_s_setprio(0); } while (0)
#define PG8_WAIT_V(n) asm volatile("s_waitcnt vmcnt(" #n ")" ::: "memory")
#define PG8_WAIT_L(n) asm volatile("s_waitcnt lgkmcnt(" #n ")" ::: "memory")
#define PG8_BAR __builtin_amdgcn_s_barrier()
#define PG8_SCHED __builtin_amdgcn_sched_barrier(0)
    Unit cur, nxt; int ui = 0; typename Epi::Pre pre;
    if (!S.next(0, cur)) return;
    f32x4 acc[2][2][4][2];
#pragma unroll
    for (int a = 0; a < 2; ++a)
#pragma unroll
        for (int b = 0; b < 2; ++b)
#pragma unroll
            for (int m = 0; m < 4; ++m)
#pragma unroll
                for (int n = 0; n < 2; ++n) acc[a][b][m][n] = (f32x4){0.f, 0.f, 0.f, 0.f};
    bf16x8 At[4][2], B0[2][2], B1[2][2];
    const char* cA = (const char*)g.A + (size_t)cur.pm * tstep + (size_t)cur.kb * kstep; const char* cB = (const char*)g.Bt + (size_t)cur.pn * tstep + (size_t)cur.kb * kstep;
    S.a_ready(cur);
    PG8_STAGE(PG8_SB(0, 0), cB, voffB); PG8_STAGE(PG8_SA(0, 0), cA, voffA); PG8_STAGE(PG8_SB(0, 1), cB + hstep, voffB); PG8_STAGE(PG8_SA(0, 1), cA + hstep, voffA);
    if (wr == 1) PG8_BAR;
    PG8_WAIT_V(4); PG8_BAR;
    PG8_STAGE(PG8_SB(1, 0), cB + kstep, voffB); PG8_STAGE(PG8_SA(1, 0), cA + kstep, voffA); PG8_STAGE(PG8_SB(1, 1), cB + hstep + kstep, voffB);
    PG8_WAIT_V(6); PG8_BAR;
    for (;;) {
        const bool has_next = S.next(ui + 1, nxt);
        const char* nA = has_next ? (const char*)g.A + (size_t)nxt.pm * tstep + (size_t)nxt.kb * kstep : cA; const char* nB = has_next ? (const char*)g.Bt + (size_t)nxt.pn * tstep + (size_t)nxt.kb * kstep : cB;
        const int cnk = cur.nk ? cur.nk : nt;
        for (int t = 0; t < cnk; t += 2) {
            const bool last = (t == cnk - 2);
            const char* a1 = cA + (size_t)(t + 1) * kstep;
            const char* a2 = last ? nA : cA + (size_t)(t + 2) * kstep; const char* b2 = last ? nB : cB + (size_t)(t + 2) * kstep;
            const char* a3 = a2 + kstep; const char* b3 = b2 + kstep;
            if (last && has_next) S.a_ready(nxt);
            if (last) E.prefetch(pre, cur, wr, fr);
            PG8_LDB(B0, 0, 0); PG8_SCHED; PG8_LDA(At, 0, 0); PG8_STAGE(PG8_SA(1, 1), a1 + hstep, voffA);
            PG8_WAIT_L(8); PG8_BAR; PG8_WAIT_L(0); PG8_MMA(0, 0, At, B0); PG8_BAR; PG8_SCHED;
            PG8_LDB(B1, 0, 1); PG8_STAGE(PG8_SB(0, 0), b2, voffB);
            PG8_BAR; PG8_WAIT_L(0); PG8_MMA(0, 1, At, B1); PG8_BAR;
            PG8_LDA(At, 0, 1); PG8_STAGE(PG8_SA(0, 0), a2, voffA);
            PG8_BAR; PG8_WAIT_L(0); PG8_MMA(1, 0, At, B0); PG8_BAR; PG8_SCHED;
            PG8_STAGE(PG8_SB(0, 1), b2 + hstep, voffB);
            PG8_WAIT_V(6); PG8_BAR; PG8_MMA(1, 1, At, B1); PG8_BAR;
            PG8_LDB(B0, 1, 0); PG8_SCHED; PG8_LDA(At, 1, 0); PG8_STAGE(PG8_SA(0, 1), a2 + hstep, voffA);
            PG8_WAIT_L(8); PG8_BAR; PG8_WAIT_L(0); PG8_MMA(0, 0, At, B0); PG8_BAR; PG8_SCHED;
            PG8_LDB(B1, 1, 1); PG8_STAGE(PG8_SB(1, 0), b3, voffB);
            PG8_BAR; PG8_WAIT_L(0); PG8_MMA(0, 1, At, B1); PG8_BAR;
            PG8_LDA(At, 1, 1); PG8_STAGE(PG8_SA(1, 0), a3, voffA);
            PG8_BAR; PG8_WAIT_L(0); PG8_MMA(1, 0, At, B0); PG8_BAR; PG8_SCHED;
            PG8_STAGE(PG8_SB(1, 1), b3 + hstep, voffB);
            PG8_WAIT_V(6); PG8_BAR; PG8_MMA(1, 1, At, B1); PG8_BAR;
        }
        if constexpr (!Epi::AFTER_DRAIN) {
            if (cur.part < 0) E(acc, cur, wr, wc, fr, fq, pre);
            else { f32x4* pp = (f32x4*)g.part + (size_t)cur.part * 32 * 512 + tid;
#pragma unroll
                for (int a = 0; a < 2; ++a)
#pragma unroll
                    for (int b = 0; b < 2; ++b)
#pragma unroll
                        for (int m = 0; m < 4; ++m)
#pragma unroll
                            for (int n = 0; n < 2; ++n) pp[(size_t)(((a * 2 + b) * 4 + m) * 2 + n) * 512] = acc[a][b][m][n]; }
            S.done(cur); }
        if (!has_next) break;
#pragma unroll
        for (int a = 0; a < 2; ++a)
#pragma unroll
            for (int b = 0; b < 2; ++b)
#pragma unroll
                for (int m = 0; m < 4; ++m)
#pragma unroll
                    for (int n = 0; n < 2; ++n) acc[a][b][m][n] = (f32x4){0.f, 0.f, 0.f, 0.f};
        cur = nxt; cA = nA; cB = nB; ++ui;
    }
    PG8_WAIT_V(0);
    if (wr == 0) PG8_BAR;
    PG8_BAR;
    if constexpr (Epi::AFTER_DRAIN) { E.fused(acc, cur, wr, wc, fr, fq, lds, wid, lane); S.done(cur); }
#undef PG8_SA
#undef PG8_SB
#undef PG8_STAGE
#undef PG8_LDA
#undef PG8_LDB
#undef PG8_MMA
#undef PG8_WAIT_V
#undef PG8_WAIT_L
#undef PG8_BAR
#undef PG8_SCHED
}
}
using pg8::bf16_t; using pg8::bf16x8; using pg8::f32x4; using pg8::Unit;
typedef float f32x16 __attribute__((ext_vector_type(16)));
typedef float f32x2v __attribute__((ext_vector_type(2)));
typedef unsigned u32x2 __attribute__((ext_vector_type(2)));
typedef unsigned u32x4v __attribute__((ext_vector_type(4)));
#define LAS __attribute__((address_space(3)))
#define DI __device__ __forceinline__

constexpr int DM = 1024, TP = 4112, NTP = 8 * TP  , NTS = 512, NT = NTP + NTS  , MP = 33536  ;
constexpr int NITEM_H = 2112;
constexpr int NCOL = NT / 16;
constexpr float EPSN = 1e-6f;
constexpr size_t O_YP = 0, O_YS = O_YP + (size_t)8 * 4096 * 1024, O_HGP = O_YS + 524288, O_HGS = O_HGP + 524288, O_SRP = O_HGS + 524288, O_SIP = O_SRP + 16384,
                 O_SRS = O_SIP + 16384, O_SIS = O_SRS + 16384, O_KP = O_SIS + 16384, O_VP = O_KP + (size_t)NTP * 1024, O_KS = O_VP + (size_t)NTP * 1024, O_VS = O_KS + 524288, O_END = O_VS + 524288;

struct Prm {
    const float *x_prompt, *x_sample, *state_hgrn, *ssm_re0, *ssm_im0, *cache_k, *cache_v, *meta, *ln_mix, *ln_mlp, *ln_final, *w_in_even, *hgrn_lb, *hgrn_norm,
        *a_re, *a_im, *log_dt, *b_re, *b_im, *c_re, *c_im, *ssm_d, *w_glu, *w_out_even, *w_in_odd, *w_out_odd, *w_up, *w_down;
    float* out;
    bf16_t *Wt1, *Wglu, *Wo0, *Wup0, *Wdn0, *Wqkv, *Wo1, *Wup1, *Wdn1;
    bf16_t* XB; float* SSQ; float* RINV; float* LB; float* KTAB; bf16_t* TG; bf16_t* HT; float* A16;
    bf16_t *Qh, *IV, *GS, *U; unsigned short* LOGF; bf16_t* UT; float* AL; float* XLOC; bf16_t* XPREV; bf16_t* YG; bf16_t* CAT;
    bf16_t* H;
    bf16_t *Q, *KP, *KS, *VTP, *VTS, *O; unsigned* BAR;
};

DI unsigned pk2(float lo, float hi) { unsigned r; asm volatile("v_cvt_pk_bf16_f32 %0, %1, %2" : "=v"(r) : "v"(lo), "v"(hi)); return r; }
DI float bflo(unsigned u) { return __uint_as_float(u << 16); }
DI float bfhi(unsigned u) { return __uint_as_float(u & 0xffff0000u); }
DI float bf2f(unsigned short b) { return __uint_as_float(((unsigned)b) << 16); }
DI unsigned short f2bf(float f) { return (unsigned short)(pk2(f, 0.f) & 0xffffu); }
DI unsigned pkh2(float lo, float hi) { union { _Float16 h[2]; unsigned u; } x; x.h[0] = (_Float16)lo; x.h[1] = (_Float16)hi; return x.u; }
DI float h2f(unsigned short h) { union { unsigned short s; _Float16 h; } x; x.s = h; return (float)x.h; }
DI float wave_sum(float v) {
#pragma unroll
    for (int o = 1; o < 64; o <<= 1) v += __shfl_xor(v, o);
    return v;
}
DI float fexp(float x) { return __expf(x); }
DI float sigm(float x) { return __builtin_amdgcn_rcpf(1.f + __expf(-x)); }
DI float row_rinv(const float* SSQ, int row) {
    const f32x4* s = (const f32x4*)(SSQ + (size_t)row * 16); f32x4 a = s[0] + s[1] + s[2] + s[3];
    return rsqrtf(((a.x + a.y) + (a.z + a.w)) * (1.f / 1024.f) + EPSN);
}
DI void rinv8(const float* SSQ, int row0, int fq, float (&r)[2][4]) {
    f32x4 v[2][4];
#pragma unroll
    for (int ai = 0; ai < 2; ++ai)
#pragma unroll
        for (int m = 0; m < 4; ++m) v[ai][m] = *(const f32x4*)(SSQ + (size_t)(row0 + ai * 128 + m * 16) * 16 + 4 * fq);
#pragma unroll
    for (int ai = 0; ai < 2; ++ai)
#pragma unroll
        for (int m = 0; m < 4; ++m) { float s = (v[ai][m].x + v[ai][m].y) + (v[ai][m].z + v[ai][m].w); s += __shfl_xor(s, 16); s += __shfl_xor(s, 32); r[ai][m] = rsqrtf(s * (1.f / 1024.f) + EPSN); }
}
#define LDS_WAIT() asm volatile("s_waitcnt lgkmcnt(0)" ::: "memory")

struct EpiIn0 {
    struct Pre { float r[2][4]; };
    DI void prefetch(Pre& pre, const Unit& u, int wr, int fr) const { const int row0 = u.pm * 256 + wr * 64 + fr;
#pragma unroll
        for (int ai = 0; ai < 2; ++ai)
#pragma unroll
            for (int m = 0; m < 4; ++m) pre.r[ai][m] = RINV[row0 + ai * 128 + m * 16]; }
    DI void scales(const Pre& pre, int row0, int fq, float (&rs)[2][4]) const {
        if (pre.r[0][0] > 0.f) {
#pragma unroll
            for (int ai = 0; ai < 2; ++ai)
#pragma unroll
                for (int m = 0; m < 4; ++m) rs[ai][m] = pre.r[ai][m]; }
        else rinv8(SSQ, row0, fq, rs);
    }
    static constexpr bool PERM = true, AFTER_DRAIN = false;
    const float* SSQ; const float* RINV; const float* LB; bf16_t *Qh, *IV, *GS, *U; unsigned short* LOGF;
    DI void operator()(const f32x4 (&acc)[2][2][4][2], const Unit& u, int wr, int wc, int fr, int fq, const Pre& pre) const {
        const int seg = u.pn >> 1, cb = (u.pn & 1) * 256 + wc * 32 + 8 * fq, row0 = u.pm * 256 + wr * 64 + fr;
        unsigned short* dst = seg == 0 ? Qh : seg == 1 ? LOGF : seg == 2 ? IV : seg == 3 ? GS : U;
        float rs[2][4]; scales(pre, row0, fq, rs);
        f32x4 lbv[2][2];
#pragma unroll
        for (int bj = 0; bj < 2; ++bj)
#pragma unroll
            for (int n = 0; n < 2; ++n) lbv[bj][n] = *(const f32x4*)(LB + cb + bj * 128 + 4 * n);
#pragma unroll
        for (int ai = 0; ai < 2; ++ai)
#pragma unroll
            for (int m = 0; m < 4; ++m) { const int row = row0 + ai * 128 + m * 16; const float r = rs[ai][m];
#pragma unroll
                for (int bj = 0; bj < 2; ++bj) { u32x4v o; unsigned w[4];
#pragma unroll
                    for (int n = 0; n < 2; ++n) { f32x4 v = acc[ai][bj][m][n] * r;
                        if (seg == 1) { const f32x4 lb = lbv[bj][n]; f32x4 f;
#pragma unroll
                            for (int e = 0; e < 4; ++e) f[e] = __logf(lb[e] + (1.f - lb[e]) * sigm(v[e]));
                            w[2 * n] = pkh2(f[0], f[1]); w[2 * n + 1] = pkh2(f[2], f[3]); }
                        else { if (seg == 3) {
#pragma unroll
                                for (int e = 0; e < 4; ++e) v[e] = v[e] * sigm(v[e]); }
                            w[2 * n] = pk2(v[0], v[1]); w[2 * n + 1] = pk2(v[2], v[3]); } }
                    o.x = w[0]; o.y = w[1]; o.z = w[2]; o.w = w[3];
                    *(u32x4v*)(dst + (size_t)row * 512 + cb + bj * 128) = o; } }
    }
};
struct EpiGlu {
    struct Pre {}; DI void prefetch(Pre&, const Unit&, int, int) const {}
    static constexpr bool PERM = true, AFTER_DRAIN = false;
    const bf16_t* YG; bf16_t* CAT;
    DI void operator()(const f32x4 (&acc)[2][2][4][2], const Unit& u, int wr, int wc, int fr, int fq, const Pre& pre) const {
        const int cb = u.pn * 256 + wc * 32 + 8 * fq, row0 = u.pm * 256 + wr * 64 + fr;
#pragma unroll
        for (int ai = 0; ai < 2; ++ai) {
            u32x4v y[4][2];
#pragma unroll
            for (int m = 0; m < 4; ++m)
#pragma unroll
                for (int bj = 0; bj < 2; ++bj) y[m][bj] = *(const u32x4v*)(YG + (size_t)(row0 + ai * 128 + m * 16) * 512 + cb + bj * 128);
#pragma unroll
            for (int m = 0; m < 4; ++m) { const int row = row0 + ai * 128 + m * 16;
#pragma unroll
                for (int bj = 0; bj < 2; ++bj) { const f32x4 v0 = acc[ai][bj][m][0], v1 = acc[ai][bj][m][1]; const u32x4v yy = y[m][bj]; u32x4v o;
                    o.x = pk2(bflo(yy.x) * sigm(v0[0]), bfhi(yy.x) * sigm(v0[1])); o.y = pk2(bflo(yy.y) * sigm(v0[2]), bfhi(yy.y) * sigm(v0[3]));
                    o.z = pk2(bflo(yy.z) * sigm(v1[0]), bfhi(yy.z) * sigm(v1[1])); o.w = pk2(bflo(yy.w) * sigm(v1[2]), bfhi(yy.w) * sigm(v1[3]));
                    *(u32x4v*)(CAT + (size_t)row * 1024 + 512 + cb + bj * 128) = o; } } }
    }
};
struct EpiRes {
    struct Pre {}; DI void prefetch(Pre&, const Unit&, int, int) const {}
    static constexpr bool PERM = true, AFTER_DRAIN = false;
    bf16_t* XB; float* SSQ;
    DI float upd(u32x4v* px, const u32x4v x, const f32x4 v0, const f32x4 v1) const {
        u32x4v o; o.x = pk2(bflo(x.x) + v0[0], bfhi(x.x) + v0[1]); o.y = pk2(bflo(x.y) + v0[2], bfhi(x.y) + v0[3]);
        o.z = pk2(bflo(x.z) + v1[0], bfhi(x.z) + v1[1]); o.w = pk2(bflo(x.w) + v1[2], bfhi(x.w) + v1[3]); *px = o;
        const float a0 = bflo(o.x), a1 = bfhi(o.x), a2 = bflo(o.y), a3 = bfhi(o.y), a4 = bflo(o.z), a5 = bfhi(o.z), a6 = bflo(o.w), a7 = bfhi(o.w);
        return ((a0 * a0 + a1 * a1) + (a2 * a2 + a3 * a3)) + ((a4 * a4 + a5 * a5) + (a6 * a6 + a7 * a7));
    }
    DI void row(const f32x4 (&a4)[2][2], const Unit& u, int ai, int m, int wr, int wc, int fr, int fq) const {
        const int cb = u.pn * 256 + wc * 32 + 8 * fq, row = u.pm * 256 + wr * 64 + fr + ai * 128 + m * 16;
        u32x4v* p0 = (u32x4v*)(XB + (size_t)row * 1024 + cb); u32x4v* p1 = (u32x4v*)(XB + (size_t)row * 1024 + cb + 128);
        const u32x4v x0 = *p0, x1 = *p1;
        float ss = upd(p0, x0, a4[0][0], a4[0][1]) + upd(p1, x1, a4[1][0], a4[1][1]);
        ss += __shfl_xor(ss, 16); ss += __shfl_xor(ss, 32);
        if (fq == 0) SSQ[(size_t)row * 16 + u.pn * 4 + wc] = ss;
    }
    DI void operator()(const f32x4 (&acc)[2][2][4][2], const Unit& u, int wr, int wc, int fr, int fq, const Pre& pre) const {
        const int cb = u.pn * 256 + wc * 32 + 8 * fq, row0 = u.pm * 256 + wr * 64 + fr;
#pragma unroll
        for (int ai = 0; ai < 2; ++ai) {
            u32x4v x[4][2];
#pragma unroll
            for (int m = 0; m < 4; ++m)
#pragma unroll
                for (int bj = 0; bj < 2; ++bj) x[m][bj] = *(const u32x4v*)(XB + (size_t)(row0 + ai * 128 + m * 16) * 1024 + cb + bj * 128);
#pragma unroll
            for (int m = 0; m < 4; ++m) { const int row = row0 + ai * 128 + m * 16;
                float ss = upd((u32x4v*)(XB + (size_t)row * 1024 + cb), x[m][0], acc[ai][0][m][0], acc[ai][0][m][1])
                         + upd((u32x4v*)(XB + (size_t)row * 1024 + cb + 128), x[m][1], acc[ai][1][m][0], acc[ai][1][m][1]);
                ss += __shfl_xor(ss, 16); ss += __shfl_xor(ss, 32);
                if (fq == 0) SSQ[(size_t)row * 16 + u.pn * 4 + wc] = ss; } }
    }
};
struct EpiUp {
    struct Pre { float r[2][4]; };
    DI void prefetch(Pre& pre, const Unit& u, int wr, int fr) const { const int row0 = u.pm * 256 + wr * 64 + fr;
#pragma unroll
        for (int ai = 0; ai < 2; ++ai)
#pragma unroll
            for (int m = 0; m < 4; ++m) pre.r[ai][m] = RINV[row0 + ai * 128 + m * 16]; }
    DI void scales(const Pre& pre, int row0, int fq, float (&rs)[2][4]) const {
        if (pre.r[0][0] > 0.f) {
#pragma unroll
            for (int ai = 0; ai < 2; ++ai)
#pragma unroll
                for (int m = 0; m < 4; ++m) rs[ai][m] = pre.r[ai][m]; }
        else rinv8(SSQ, row0, fq, rs);
    }
    static constexpr bool PERM = true, AFTER_DRAIN = false;
    const float* SSQ; const float* RINV; bf16_t* H;
    DI void operator()(const f32x4 (&acc)[2][2][4][2], const Unit& u, int wr, int wc, int fr, int fq, const Pre& pre) const {
        const int cb = u.pn * 256 + wc * 32 + 8 * fq, row0 = u.pm * 256 + wr * 64 + fr;
        float rs[2][4]; scales(pre, row0, fq, rs);
#pragma unroll
        for (int ai = 0; ai < 2; ++ai)
#pragma unroll
            for (int m = 0; m < 4; ++m) { const int row = row0 + ai * 128 + m * 16; const float r = rs[ai][m];
#pragma unroll
                for (int bj = 0; bj < 2; ++bj) { f32x4 v0 = acc[ai][bj][m][0] * r, v1 = acc[ai][bj][m][1] * r;
#pragma unroll
                    for (int e = 0; e < 4; ++e) { const float t0 = fmaxf(v0[e], 0.f), t1 = fmaxf(v1[e], 0.f); v0[e] = t0 * t0; v1[e] = t1 * t1; }
                    u32x4v o; o.x = pk2(v0[0], v0[1]); o.y = pk2(v0[2], v0[3]); o.z = pk2(v1[0], v1[1]); o.w = pk2(v1[2], v1[3]);
                    *(u32x4v*)(H + (size_t)row * 4096 + cb + bj * 128) = o; } }
    }
};
DI size_t kf_index(int seqh, int nkt, int key, int d) { return ((((size_t)seqh * nkt + (key >> 5)) * 8 + (d >> 4)) * 64 + ((key & 31) + 32 * ((d >> 3) & 1))) * 8 + (d & 7); }
DI size_t vf_index(int seqh, int nkt, int key, int d) { const int kk = key & 31;
    return ((((size_t)seqh * nkt + (key >> 5)) * 8 + (kk >> 4) * 4 + (d >> 5)) * 64 + ((d & 31) + 32 * ((kk >> 2) & 1))) * 8 + ((kk >> 3) & 1) * 4 + (kk & 3); }
struct EpiQkv {
    struct Pre { float r[2][4]; };
    DI void prefetch(Pre& pre, const Unit& u, int wr, int fr) const { const int row0 = u.pm * 256 + wr * 64 + fr;
#pragma unroll
        for (int ai = 0; ai < 2; ++ai)
#pragma unroll
            for (int m = 0; m < 4; ++m) pre.r[ai][m] = RINV[row0 + ai * 128 + m * 16]; }
    DI void scales(const Pre& pre, int row0, int fq, float (&rs)[2][4]) const {
        if (pre.r[0][0] > 0.f) {
#pragma unroll
            for (int ai = 0; ai < 2; ++ai)
#pragma unroll
                for (int m = 0; m < 4; ++m) rs[ai][m] = pre.r[ai][m]; }
        else rinv8(SSQ, row0, fq, rs);
    }
    static constexpr bool PERM = true, AFTER_DRAIN = false;
    const float* SSQ; const float* RINV; float* out; bf16_t *Q, *KP, *KS, *VTP, *VTS; LAS unsigned char* scr;
    DI void operator()(const f32x4 (&acc)[2][2][4][2], const Unit& u, int wr, int wc, int fr, int fq, const Pre& pre) const {
        const int third = u.pn >> 2, cb = (u.pn & 3) * 256 + wc * 32 + 8 * fq, row0 = u.pm * 256 + wr * 64 + fr;
        float rs[2][4]; scales(pre, row0, fq, rs);
        if (third == 2) {
            LAS unsigned char* ws = scr + (wr * 4 + wc) * 1024; const int ln = fr + 16 * fq, dl = ln & 31, hf = ln >> 5;
            LAS unsigned char* wsw = ws + fr * 64 + fq * 16; const LAS unsigned char* wsr = ws + hf * 256 + dl * 2;
#pragma unroll
            for (int ai = 0; ai < 2; ++ai)
#pragma unroll
                for (int m = 0; m < 4; ++m) { const int row = row0 + ai * 128 + m * 16; const float r = rs[ai][m];
                    const bool smp = row >= NTP; const int s = row - NTP; const int b = smp ? (s >> 6) : row / TP, key = smp ? 1024 + (s & 63) : row - b * TP, nkt = smp ? 34 : 129;
#pragma unroll
                    for (int bj = 0; bj < 2; ++bj) { const int cs = cb + bj * 128; const f32x4 v0 = acc[ai][bj][m][0] * r, v1 = acc[ai][bj][m][1] * r;
                        if (row < NT) { const int h = cs >> 7, d = cs & 127;
                            float* ov = out + (smp ? O_VS + (size_t)s * 1024 : O_VP + (size_t)row * 1024) + cs; *(f32x4*)ov = v0; *(f32x4*)(ov + 4) = v1;
                            u32x4v o; o.x = pk2(v0[0], v0[1]); o.y = pk2(v0[2], v0[3]); o.z = pk2(v1[0], v1[1]); o.w = pk2(v1[2], v1[3]);
                            *(LAS u32x4v*)wsw = o;
                            asm volatile("s_waitcnt lgkmcnt(0)" ::: "memory");
                            u32x4v t;
                            t.x = (unsigned)*(const LAS unsigned short*)(wsr) | ((unsigned)*(const LAS unsigned short*)(wsr + 64) << 16);
                            t.y = (unsigned)*(const LAS unsigned short*)(wsr + 128) | ((unsigned)*(const LAS unsigned short*)(wsr + 192) << 16);
                            t.z = (unsigned)*(const LAS unsigned short*)(wsr + 512) | ((unsigned)*(const LAS unsigned short*)(wsr + 576) << 16);
                            t.w = (unsigned)*(const LAS unsigned short*)(wsr + 640) | ((unsigned)*(const LAS unsigned short*)(wsr + 704) << 16);
                            *(u32x4v*)((smp ? VTS : VTP) + vf_index(b * 8 + h, nkt, key - fr, d & ~31) + ln * 8) = t;
                            asm volatile("s_waitcnt lgkmcnt(0)" ::: "memory"); } } }
            return; }
#pragma unroll
        for (int ai = 0; ai < 2; ++ai)
#pragma unroll
            for (int m = 0; m < 4; ++m) { const int row = row0 + ai * 128 + m * 16; const float r = rs[ai][m];
                const bool smp = row >= NTP; const int s = row - NTP; const int b = smp ? (s >> 6) : row / TP, key = smp ? 1024 + (s & 63) : row - b * TP, nkt = smp ? 34 : 129;
#pragma unroll
                for (int bj = 0; bj < 2; ++bj) { const int cs = cb + bj * 128; const f32x4 v0 = acc[ai][bj][m][0] * r, v1 = acc[ai][bj][m][1] * r;
                    u32x4v o; o.x = pk2(v0[0], v0[1]); o.y = pk2(v0[2], v0[3]); o.z = pk2(v1[0], v1[1]); o.w = pk2(v1[2], v1[3]);
                    if (third == 0) { *(u32x4v*)(Q + (size_t)row * 1024 + cs) = o; }
                    else if (row < NT) { const int h = cs >> 7, d = cs & 127;
                        float* ok = out + (smp ? O_KS + (size_t)s * 1024 : O_KP + (size_t)row * 1024) + cs; *(f32x4*)ok = v0; *(f32x4*)(ok + 4) = v1;
                        *(u32x4v*)((smp ? KS : KP) + kf_index(b * 8 + h, nkt, key, d)) = o; } } }
    }
};
struct EpiFin {
    struct Pre {}; DI void prefetch(Pre&, const Unit&, int, int) const {}
    static constexpr bool PERM = false, AFTER_DRAIN = false;
    const bf16_t* XB; float* SSQ; float* out;
    DI void row(const f32x4 (&a4)[2][2], const Unit& u, int ai, int m, int wr, int wc, int fr, int fq) const {
        const int cb = u.pn * 256 + wc * 32 + 4 * fq, row = u.pm * 256 + wr * 64 + fr + ai * 128 + m * 16; float ss = 0.f;
        const int b = row / TP, t = row - b * TP; const bool ok = row < NT && (row >= NTP || t >= 16);
        float* dst = out + (row >= NTP ? O_YS + (size_t)(row - NTP) * 1024 : O_YP + ((size_t)b * 4096 + (t - 16)) * 1024);
#pragma unroll
        for (int bj = 0; bj < 2; ++bj)
#pragma unroll
            for (int n = 0; n < 2; ++n) { const int cs = cb + bj * 128 + n * 16; f32x4 v = a4[bj][n];
                const u32x2 x = *(const u32x2*)(XB + (size_t)row * 1024 + cs);
                v[0] += bflo(x.x); v[1] += bfhi(x.x); v[2] += bflo(x.y); v[3] += bfhi(x.y);
                if (ok) *(f32x4*)(dst + cs) = v;
                ss += (v[0] * v[0] + v[1] * v[1]) + (v[2] * v[2] + v[3] * v[3]); }
        ss += __shfl_xor(ss, 16); ss += __shfl_xor(ss, 32);
        if (fq == 0) SSQ[(size_t)row * 16 + u.pn * 4 + wc] = ss;
    }
    DI void operator()(const f32x4 (&acc)[2][2][4][2], const Unit& u, int wr, int wc, int fr, int fq, const Pre& pre) const {
        const int cb = u.pn * 256 + wc * 32 + 4 * fq, row0 = u.pm * 256 + wr * 64 + fr;
#pragma unroll
        for (int ai = 0; ai < 2; ++ai) {
            u32x2 x[4][2][2];
#pragma unroll
            for (int m = 0; m < 4; ++m)
#pragma unroll
                for (int bj = 0; bj < 2; ++bj)
#pragma unroll
                    for (int n = 0; n < 2; ++n) x[m][bj][n] = *(const u32x2*)(XB + (size_t)(row0 + ai * 128 + m * 16) * 1024 + cb + bj * 128 + n * 16);
#pragma unroll
            for (int m = 0; m < 4; ++m) { const int row = row0 + ai * 128 + m * 16; float ss = 0.f;
                const int b = row / TP, t = row - b * TP; const bool ok = row < NT && (row >= NTP || t >= 16);
                float* dst = out + (row >= NTP ? O_YS + (size_t)(row - NTP) * 1024 : O_YP + ((size_t)b * 4096 + (t - 16)) * 1024);
#pragma unroll
                for (int bj = 0; bj < 2; ++bj)
#pragma unroll
                    for (int n = 0; n < 2; ++n) { const int cs = cb + bj * 128 + n * 16; f32x4 v = acc[ai][bj][m][n]; const u32x2 xx = x[m][bj][n];
                        v[0] += bflo(xx.x); v[1] += bfhi(xx.x); v[2] += bflo(xx.y); v[3] += bfhi(xx.y);
                        if (ok) *(f32x4*)(dst + cs) = v;
                        ss += (v[0] * v[0] + v[1] * v[1]) + (v[2] * v[2] + v[3] * v[3]); }
                ss += __shfl_xor(ss, 16); ss += __shfl_xor(ss, 32);
                if (fq == 0) SSQ[(size_t)row * 16 + u.pn * 4 + wc] = ss; } }
    }
};
template <class Epi> DI void run_gemm(LAS unsigned char* lds, const bf16_t* A, const bf16_t* Bt, int N, int K, const Epi& E) {
    pg8::Gemm g; g.A = A; g.Bt = Bt; g.M = MP; g.N = N; g.K = K; g.part = nullptr;
    pg8::StaticOrder S; S.init(MP, N, (int)gridDim.x, (int)blockIdx.x);
    pg8::gemm_phase<Epi, pg8::StaticOrder>(lds, g, S, E);
}
struct SplitOrder : pg8::StaticOrder {
    int nwhole, ntail, S, nks;
    DI void init2(int N, int K) { init(MP, N, (int)gridDim.x, (int)blockIdx.x); nwhole = nwg / G; ntail = nwg - nwhole * G; S = 0; nks = 0;
        if (ntail > 0) { int s = G / ntail; const int nkt = K / 64; while (s > 1 && (nkt % s != 0 || (nkt / s) < 4 || ((nkt / s) & 1))) --s; if (s > 1) { S = s; nks = nkt / s; } } }
    DI bool next(int i, Unit& u) const {
        if (S == 0) return pg8::StaticOrder::next(i, u);
        if (i < nwhole) { map(i * G + c, u); return true; }
        if (i == nwhole && c < ntail * S) { map(nwhole * G + c / S, u); u.kb = (c % S) * nks; u.nk = nks; u.part = c; return true; }
        return false;
    }
};
template <class Epi> DI void run_gemm_split(LAS unsigned char* lds, const bf16_t* A, const bf16_t* Bt, int N, int K, const Epi& E, float* part) {
    pg8::Gemm g; g.A = A; g.Bt = Bt; g.M = MP; g.N = N; g.K = K; g.part = part;
    SplitOrder S; S.init2(N, K);
    pg8::gemm_phase<Epi, SplitOrder>(lds, g, S, E);
}
template <class Epi> DI void gemm_fixup(int N, int K, const Epi& E, const float* part, int tid) {
    SplitOrder S; S.init2(N, K); if (S.S == 0) return;
    asm volatile("" : "+v"(tid));
    const int wid = tid >> 6, lane = tid & 63, wr = wid >> 2, wc = wid & 3, fr = lane & 15, fq = lane >> 4;
    for (int it = blockIdx.x; it < S.ntail * 8; it += gridDim.x) { const int j = it >> 3, ai = (it >> 2) & 1, m = it & 3; Unit u; S.map(S.nwhole * S.G + j, u);
        f32x4 a4[2][2];
#pragma unroll
        for (int b = 0; b < 2; ++b)
#pragma unroll
            for (int n = 0; n < 2; ++n) { const f32x4* pp = (const f32x4*)part + ((size_t)(j * S.S) * 32 + (((ai * 2 + b) * 4 + m) * 2 + n)) * 512 + tid;
                f32x4 v0 = {0.f, 0.f, 0.f, 0.f}, v1 = v0, v2 = v0, v3 = v0;
                for (int sl = 0; sl + 3 < S.S; sl += 4) { v0 += pp[(size_t)sl * 16384]; v1 += pp[(size_t)(sl + 1) * 16384]; v2 += pp[(size_t)(sl + 2) * 16384]; v3 += pp[(size_t)(sl + 3) * 16384]; }
                for (int sl = S.S & ~3; sl < S.S; ++sl) v0 += pp[(size_t)sl * 16384];
                a4[b][n] = (v0 + v1) + (v2 + v3); }
        E.row(a4, u, ai, m, wr, wc, fr, fq); }
}
DI void rinv_pass(const Prm& p, int K, int tid) {
    SplitOrder S; S.init2(1024, K);
    for (int pm = blockIdx.x; pm < MP / 256; pm += gridDim.x) {
        bool tail = false;
        if (S.S) for (int j = 0; j < S.ntail; ++j) { Unit u; S.map(S.nwhole * S.G + j, u); tail = tail || (u.pm == pm); }
        if (tid < 256) { const int row = pm * 256 + tid; float v = -1.f;
            if (!tail) { const f32x4* q = (const f32x4*)(p.SSQ + (size_t)row * 16); const f32x4 a = q[0] + q[1] + q[2] + q[3]; v = rsqrtf(((a.x + a.y) + (a.z + a.w)) * (1.f / 1024.f) + EPSN); }
            if (row >= NT) v = 1.f;
            p.RINV[row] = v; }
    }
}
DI void transpose_item(const float* W, int N, bf16_t* WT, size_t ldo, const float* sc, LAS float* scr, int item, int lane) {
    const int nblk = N / 32, kb = item / nblk, nb = item % nblk, k0 = 64 * kb, n0 = 32 * nb;
#pragma unroll 8
    for (int i = 0; i < 32; ++i) { const int kk = 2 * i + (lane >> 5); float w = W[(size_t)(k0 + kk) * N + n0 + (lane & 31)]; if (sc) w *= sc[k0 + kk]; scr[kk * 33 + (lane & 31)] = w; }
    LDS_WAIT();
    const int c = lane & 7;
#pragma unroll
    for (int j = 0; j < 4; ++j) { const int n = (lane >> 3) + 8 * j; const LAS float* s = scr + (8 * c) * 33 + n;
        u32x4v o; o.x = pk2(s[0 * 33], s[1 * 33]); o.y = pk2(s[2 * 33], s[3 * 33]); o.z = pk2(s[4 * 33], s[5 * 33]); o.w = pk2(s[6 * 33], s[7 * 33]);
        *(u32x4v*)(WT + (size_t)(n0 + n) * ldo + k0 + 8 * c) = o; }
    LDS_WAIT();
}
DI void s5_pow(const Prm& p, int g, int n, float k, float& re, float& im) {
    const float dt = __expf(p.log_dt[g]), ar = p.a_re[g * 64 + n], ai = p.a_im[g * 64 + n];
    const float mag = __expf(k * dt * ar); float rev = k * dt * ai * 0.15915494309189535f; rev -= rintf(rev);
    re = mag * __builtin_amdgcn_cosf(rev); im = mag * __builtin_amdgcn_sinf(rev);
}
DI void s5_bbar(const Prm& p, int g, int n, int pp, float& re, float& im) {
    const float ar = p.a_re[g * 64 + n], ai = p.a_im[g * 64 + n]; float abr, abi; s5_pow(p, g, n, 1.f, abr, abi);
    const float den = ar * ar + ai * ai, zr = ((abr - 1.f) * ar + abi * ai) / den, zi = (abi * ar - (abr - 1.f) * ai) / den;
    const float br = p.b_re[(g * 64 + n) * 16 + pp], bi = p.b_im[(g * 64 + n) * 16 + pp];
    re = zr * br - zi * bi; im = zr * bi + zi * br;
}
DI void phase_prologue(const Prm& p, LAS unsigned char* lds, int tid, int lane, int wave) {
    const int gw = blockIdx.x * 8 + wave, NGW = gridDim.x * 8, gtid = blockIdx.x * 512 + tid, GT = gridDim.x * 512;
    LAS float* scr = (LAS float*)(lds + wave * 16384);
    constexpr int I1 = 16 * 80, I2 = 8 * 16, I3 = 16 * 32, I4 = 16 * 128, I5 = 64 * 32, I6 = 16 * 96;
    constexpr int NITEMS = I1 + I2 + I3 + I4 + I5 + I6 + I3 + I4 + I5;
    for (int it = gw; it < NITEMS; it += NGW) {
        int r = it;
        if (r < I1) { transpose_item(p.w_in_even, 2560, p.Wt1, 1024, p.ln_mix, scr, r, lane); continue; } r -= I1;
        if (r < I2) { transpose_item(p.w_glu, 512, p.Wglu, 512, nullptr, scr, r, lane); continue; } r -= I2;
        if (r < I3) { transpose_item(p.w_out_even, 1024, p.Wo0, 1024, nullptr, scr, r, lane); continue; } r -= I3;
        if (r < I4) { transpose_item(p.w_up, 4096, p.Wup0, 1024, p.ln_mlp, scr, r, lane); continue; } r -= I4;
        if (r < I5) { transpose_item(p.w_down, 1024, p.Wdn0, 4096, nullptr, scr, r, lane); continue; } r -= I5;
        if (r < I6) { transpose_item(p.w_in_odd, 3072, p.Wqkv, 1024, p.ln_mix + 1024, scr, r, lane); continue; } r -= I6;
        if (r < I3) { transpose_item(p.w_out_odd, 1024, p.Wo1, 1024, nullptr, scr, r, lane); continue; } r -= I3;
        if (r < I4) { transpose_item(p.w_up + (size_t)1024 * 4096, 4096, p.Wup1, 1024, p.ln_mlp + 1024, scr, r, lane); continue; } r -= I4;
        transpose_item(p.w_down + (size_t)4096 * 1024, 1024, p.Wdn1, 4096, nullptr, scr, r, lane);
    }
    for (int row = gw; row < NT; row += NGW) {
        const float* src;
        if (row < NTP) { const int b = row / TP, t = row - b * TP; src = t < 16 ? p.meta + (size_t)t * 1024 : p.x_prompt + ((size_t)b * 4096 + (t - 16)) * 1024; }
        else src = p.x_sample + (size_t)(row - NTP) * 1024;
        float ss = 0.f;
#pragma unroll
        for (int j = 0; j < 4; ++j) { const f32x4 v = ((const f32x4*)src)[lane + 64 * j]; u32x2 o; o.x = pk2(v.x, v.y); o.y = pk2(v.z, v.w);
            const float a0 = bflo(o.x), a1 = bfhi(o.x), a2 = bflo(o.y), a3 = bfhi(o.y); ss += (a0 * a0 + a1 * a1) + (a2 * a2 + a3 * a3);
            ((u32x2*)(p.XB + (size_t)row * 1024))[lane + 64 * j] = o; }
        ss = wave_sum(ss);
        if (lane < 16) p.SSQ[(size_t)row * 16 + lane] = lane == 0 ? ss : 0.f;
        if (lane == 0) p.RINV[row] = rsqrtf(ss * (1.f / 1024.f) + EPSN);
    }
    if (gtid < MP - NT) p.RINV[NT + gtid] = 1.f;
    if (gtid < 512) p.LB[gtid] = 1.f / (1.f + __expf(p.hgrn_lb[512 + gtid] - p.hgrn_lb[gtid]));
    __syncthreads();
    {
        LAS float* zr_ = (LAS float*)lds; LAS float* zi_ = zr_ + 64; LAS float* wr_ = zi_ + 64; LAS float* wi_ = wr_ + 64;
        LAS float* bbr = wi_ + 64; LAS float* bbi = bbr + 1024; LAS float* cwr = bbi + 1024; LAS float* cwi = cwr + 16 * 65;
        for (int pair = blockIdx.x; pair < 512; pair += gridDim.x) { const int g = pair >> 4, tau = pair & 15;
            if (tid < 64) { const int n = tid; const float ar = p.a_re[g * 64 + n], ai = p.a_im[g * 64 + n]; float abr, abi; s5_pow(p, g, n, 1.f, abr, abi);
                const float den = ar * ar + ai * ai; zr_[n] = ((abr - 1.f) * ar + abi * ai) / den; zi_[n] = (abi * ar - (abr - 1.f) * ai) / den;
                float a, b; s5_pow(p, g, n, (float)tau, a, b); wr_[n] = a; wi_[n] = b; }
            __syncthreads();
#pragma unroll
            for (int k = 0; k < 2; ++k) { const int e = tid + 512 * k;
                { const int n = e >> 4; const float br = p.b_re[g * 1024 + e], bi = p.b_im[g * 1024 + e]; bbr[e] = zr_[n] * br - zi_[n] * bi; bbi[e] = zr_[n] * bi + zi_[n] * br; }
                { const int pch = e >> 6, n = e & 63; const float cr = p.c_re[g * 1024 + e], ci = p.c_im[g * 1024 + e]; cwr[pch * 65 + n] = cr * wr_[n] - ci * wi_[n]; cwi[pch * 65 + n] = cr * wi_[n] + ci * wr_[n]; } }
            __syncthreads();
            if (tid < 256) { const int pch = tid >> 4, pp = tid & 15; float acc = 0.f;
#pragma unroll 8
                for (int n = 0; n < 64; ++n) acc += cwr[pch * 65 + n] * bbr[n * 16 + pp] - cwi[pch * 65 + n] * bbi[n * 16 + pp];
                if (tau == 0 && pch == pp) acc += p.ssm_d[g * 16 + pch];
                const bf16_t kv = f2bf(acc);
                p.TG[((g * 16 + tau) * 16 + pch) * 16 + pp] = kv; }
            __syncthreads(); }
    }
    for (int i = gtid; i < 32 * 256 * 64; i += GT) {
        const int g = i >> 14, t = (i >> 10) & 15, pch = (i >> 6) & 15, n = i & 63; float wr_, wi_; s5_pow(p, g, n, (float)(t + 1), wr_, wi_);
        const float cr = p.c_re[(g * 16 + pch) * 64 + n], ci = p.c_im[(g * 16 + pch) * 64 + n];
        *(unsigned*)(p.TG + 131072 + ((size_t)(g * 256 + t * 16 + pch)) * 128 + 2 * n) = pk2(cr * wr_ - ci * wi_, -(cr * wi_ + ci * wr_)); }
    for (int i = gtid; i < 32 * 64 * 256; i += GT) {
        const int g = i >> 14, n = (i >> 8) & 63, s = (i >> 4) & 15, pp = i & 15; float wr_, wi_, br_, bi_; s5_pow(p, g, n, (float)(15 - s), wr_, wi_); s5_bbar(p, g, n, pp, br_, bi_);
        p.HT[((size_t)(g * 128 + 2 * n)) * 256 + s * 16 + pp] = f2bf(wr_ * br_ - wi_ * bi_);
        p.HT[((size_t)(g * 128 + 2 * n + 1)) * 256 + s * 16 + pp] = f2bf(wr_ * bi_ + wi_ * br_); }
    if (gtid < 2048) { float wr_, wi_; s5_pow(p, gtid >> 6, gtid & 63, 16.f, wr_, wi_); p.A16[2 * gtid] = wr_; p.A16[2 * gtid + 1] = wi_; }
}

constexpr int HP = 136, TPI = 72;
constexpr int L_QT = 0, L_QH = 17408, L_KT = 34816, L_KTT = 52224, L_IVT = 70656, L_ATT = 89088, L_SUM = 98304, L_VEC = 100352, L_OB = 0  ;
struct HItem { int row0, L, h, bh; };
DI HItem hgrn_item(int item) {
    HItem it;
    if (item < 2080) { const int bh = item / 65, c = item - bh * 65, b = bh >> 2; it.h = bh & 3; it.bh = bh; it.L = c == 0 ? 16 : 64; it.row0 = b * TP + (c == 0 ? 0 : 16 + 64 * (c - 1)); }
    else { const int s = item - 2080, b = s >> 2; it.h = s & 3; it.bh = 32 + s; it.L = 64; it.row0 = NTP + b * 64; }
    return it;
}
template <bool FULL> DI void hgrn_loadraw(const Prm& p, const HItem& it, int tid, unsigned (&rl)[16], unsigned (&rv)[16], unsigned (&rq)[16]) {
    const int d = tid & 127, t0 = 16 * (tid >> 7), col = it.h * 128 + d;
#pragma unroll
    for (int j = 0; j < 16; ++j) { const int t = t0 + j; const bool valid = t < it.L; const size_t o = (size_t)(it.row0 + t) * 512 + col;
        rl[j] = valid ? (unsigned)p.LOGF[o] : 0u; rv[j] = valid ? (unsigned)p.IV[o] : 0u; if (FULL) rq[j] = valid ? (unsigned)p.Qh[o] : 0u; }
}
template <bool FULL> DI void hgrn_prep(const HItem& it, LAS unsigned char* lds, int tid, const unsigned (&rl)[16], const unsigned (&rv)[16], const unsigned (&rq)[16]) {
    const int d = tid & 127, tq = tid >> 7, t0 = 16 * tq;
    LAS float* sums = (LAS float*)(lds + L_SUM); LAS float* vec = (LAS float*)(lds + L_VEC);
    float cs[16], lf[16];
    float run = 0.f;
#pragma unroll
    for (int j = 0; j < 16; ++j) { lf[j] = h2f((unsigned short)rl[j]); run += lf[j]; cs[j] = run; }
    sums[tq * 128 + d] = run;
    { LAS u32x4v* dst = (LAS u32x4v*)(lds + L_IVT + (d * TPI + t0) * 2); u32x4v a, b;
        a.x = rv[0] | (rv[1] << 16); a.y = rv[2] | (rv[3] << 16); a.z = rv[4] | (rv[5] << 16); a.w = rv[6] | (rv[7] << 16);
        b.x = rv[8] | (rv[9] << 16); b.y = rv[10] | (rv[11] << 16); b.z = rv[12] | (rv[13] << 16); b.w = rv[14] | (rv[15] << 16); dst[0] = a; dst[1] = b; }
    __syncthreads();
    const float s0 = sums[d], s1 = sums[128 + d], s2 = sums[256 + d], s3 = sums[384 + d];
    const float off = tq == 0 ? 0.f : tq == 1 ? s0 : tq == 2 ? s0 + s1 : s0 + s1 + s2, r = s0 + s1, bL = r + s2 + s3;
    if (tq == 0) { vec[d] = r; vec[128 + d] = bL; }
    unsigned ktp[8]; float kprev = 0.f;
#pragma unroll
    for (int j = 0; j < 16; ++j) { const int t = t0 + j; const bool valid = t < it.L; const float b = off + cs[j];
        const float kt = valid ? (1.f - __expf(lf[j])) * __expf(r - b) : 0.f;
        if (j & 1) ktp[j >> 1] = pk2(kprev, kt); else kprev = kt;
        if (FULL) { const float qv = bf2f((unsigned short)rq[j]);
            *(LAS unsigned short*)(lds + L_KT + (t * HP + d) * 2) = f2bf(kt);
            *(LAS unsigned short*)(lds + L_QT + (t * HP + d) * 2) = f2bf(qv * __expf(b - r));
            *(LAS unsigned short*)(lds + L_QH + (t * HP + d) * 2) = f2bf(qv * __expf(b)); } }
    if (!FULL) { LAS u32x4v* dst = (LAS u32x4v*)(lds + L_KTT + (d * TPI + t0) * 2); u32x4v a, b; a.x = ktp[0]; a.y = ktp[1]; a.z = ktp[2]; a.w = ktp[3]; b.x = ktp[4]; b.y = ktp[5]; b.z = ktp[6]; b.w = ktp[7]; dst[0] = a; dst[1] = b; }
    __syncthreads();
}
#define MFMA16(a, b, c) __builtin_amdgcn_mfma_f32_16x16x32_bf16((a), (b), (c), 0, 0, 0)
#define MFMA32(a, b, c) __builtin_amdgcn_mfma_f32_32x32x16_bf16((a), (b), (c), 0, 0, 0)
DI void hgrn_b1_all(const Prm& p, LAS unsigned char* lds, int tid, int lane, int wave) {
    const int fr = lane & 15, fq = lane >> 4;
    int item = blockIdx.x; if (item >= NITEM_H) return;
    unsigned rl[16], rv[16], rq[16];
    hgrn_loadraw<false>(p, hgrn_item(item), tid, rl, rv, rq);
    while (item < NITEM_H) {
        const HItem it = hgrn_item(item);
        hgrn_prep<false>(it, lds, tid, rl, rv, rq);
        const int next = item + gridDim.x;
        if (next < NITEM_H) hgrn_loadraw<false>(p, hgrn_item(next), tid, rl, rv, rq);
        const LAS float* vec = (const LAS float*)(lds + L_VEC);
        bf16x8 a[2];
#pragma unroll
        for (int ks = 0; ks < 2; ++ks) a[ks] = *(const LAS bf16x8*)(lds + L_KTT + ((16 * wave + fr) * TPI + 32 * ks + 8 * fq) * 2);
        float e2[4];
#pragma unroll
        for (int j = 0; j < 4; ++j) { const int d = 16 * wave + 4 * fq + j; e2[j] = __expf(vec[128 + d] - vec[d]); }
#pragma unroll
        for (int vt = 0; vt < 8; ++vt) { f32x4 acc = {0.f, 0.f, 0.f, 0.f};
#pragma unroll
            for (int ks = 0; ks < 2; ++ks) { const bf16x8 b = *(const LAS bf16x8*)(lds + L_IVT + ((16 * vt + fr) * TPI + 32 * ks + 8 * fq) * 2); acc = MFMA16(a[ks], b, acc); }
            u32x2 o; o.x = pk2(acc[0] * e2[0], acc[1] * e2[1]); o.y = pk2(acc[2] * e2[2], acc[3] * e2[3]);
            *(u32x2*)(p.UT + (size_t)item * 16384 + (16 * vt + fr) * 128 + 16 * wave + 4 * fq) = o; }
        if (tid < 128) p.AL[(size_t)item * 128 + tid] = __expf(vec[128 + tid]);
        __syncthreads();
        item = next;
    }
}
template <int NB> DI void hgrn_b2_steps(const Prm& p, int item, int v, int d4, float (&S)[4]) {
    u32x2 uu[NB]; f32x4 al[NB];
#pragma unroll
    for (int i = 0; i < NB; ++i) { uu[i] = *(const u32x2*)(p.UT + (size_t)(item + i) * 16384 + v * 128 + d4); al[i] = *(const f32x4*)(p.AL + (size_t)(item + i) * 128 + d4); }
#pragma unroll
    for (int i = 0; i < NB; ++i) { u32x2 o; o.x = pk2(S[0], S[1]); o.y = pk2(S[2], S[3]);
        *(u32x2*)(p.UT + (size_t)(item + i) * 16384 + v * 128 + d4) = o;
        S[0] = al[i][0] * S[0] + bflo(uu[i].x); S[1] = al[i][1] * S[1] + bfhi(uu[i].x); S[2] = al[i][2] * S[2] + bflo(uu[i].y); S[3] = al[i][3] * S[3] + bfhi(uu[i].y); }
}
DI void hgrn_b2(const Prm& p, int gtid, int GT) {
    for (int idx = gtid; idx < 64 * 4096; idx += GT) {
        const int bhx = idx >> 12, e = idx & 4095, v = e >> 5, d4 = (e & 31) * 4; const bool smp = bhx >= 32;
        float S[4] = {0.f, 0.f, 0.f, 0.f};
        if (smp) {
#pragma unroll
            for (int j = 0; j < 4; ++j) S[j] = p.state_hgrn[((size_t)(bhx - 32) * 128 + d4 + j) * 128 + v];
            hgrn_b2_steps<1>(p, 2080 + (bhx - 32), v, d4, S); }
        else { for (int c0 = 0; c0 < 65; c0 += 13) hgrn_b2_steps<13>(p, bhx * 65 + c0, v, d4, S); }
        float* dst = p.out + (smp ? O_HGS + (size_t)(bhx - 32) * 16384 : O_HGP + (size_t)bhx * 16384);
#pragma unroll
        for (int j = 0; j < 4; ++j) dst[(d4 + j) * 128 + v] = S[j];
    }
}
DI void hgrn_b3_all(const Prm& p, LAS unsigned char* lds, int tid, int lane, int wave) {
    const int fr = lane & 15, fq = lane >> 4;
    int item = blockIdx.x; if (item >= NITEM_H) return;
    unsigned rl[16], rv[16], rq[16];
    hgrn_loadraw<true>(p, hgrn_item(item), tid, rl, rv, rq);
    const int nt_ = tid >> 3, nsg = tid & 7;
    while (item < NITEM_H) {
        const HItem it = hgrn_item(item);
        bf16x8 sf[4][4];
#pragma unroll
        for (int i = 0; i < 4; ++i)
#pragma unroll
            for (int ks = 0; ks < 4; ++ks) sf[i][ks] = *(const bf16x8*)(p.UT + (size_t)item * 16384 + (16 * (4 * (wave >> 2) + i) + fr) * 128 + 32 * ks + 8 * fq);
        const size_t grow = (size_t)(it.row0 + (nt_ < it.L ? nt_ : 0)); const int gc0 = it.h * 128 + 16 * nsg;
        const u32x4v g0 = *(const u32x4v*)(p.GS + grow * 512 + gc0), g1 = *(const u32x4v*)(p.GS + grow * 512 + gc0 + 8);
        hgrn_prep<true>(it, lds, tid, rl, rv, rq);
        const int next = item + gridDim.x;
        if (next < NITEM_H) hgrn_loadraw<true>(p, hgrn_item(next), tid, rl, rv, rq);
        {
            const int tt = wave >> 1;
#pragma unroll
            for (int i = 0; i < 2; ++i) { const int st = 2 * (wave & 1) + i; f32x4 acc = {0.f, 0.f, 0.f, 0.f};
#pragma unroll
                for (int ks = 0; ks < 4; ++ks) { const bf16x8 a = *(const LAS bf16x8*)(lds + L_KT + ((16 * st + fr) * HP + 32 * ks + 8 * fq) * 2);
                    const bf16x8 b = *(const LAS bf16x8*)(lds + L_QT + ((16 * tt + fr) * HP + 32 * ks + 8 * fq) * 2); acc = MFMA16(a, b, acc); }
                const int t = 16 * tt + fr, s0 = 16 * st + 4 * fq;
                u32x2 o; o.x = pk2(s0 <= t ? acc[0] : 0.f, s0 + 1 <= t ? acc[1] : 0.f); o.y = pk2(s0 + 2 <= t ? acc[2] : 0.f, s0 + 3 <= t ? acc[3] : 0.f);
                *(LAS u32x2*)(lds + L_ATT + (t * TPI + s0) * 2) = o; }
        }
        __syncthreads();
        f32x4 oacc[4];
        {   const int tt = wave & 3;
            bf16x8 aa[2], aq[4];
#pragma unroll
            for (int ks = 0; ks < 2; ++ks) aa[ks] = *(const LAS bf16x8*)(lds + L_ATT + ((16 * tt + fr) * TPI + 32 * ks + 8 * fq) * 2);
#pragma unroll
            for (int ks = 0; ks < 4; ++ks) aq[ks] = *(const LAS bf16x8*)(lds + L_QH + ((16 * tt + fr) * HP + 32 * ks + 8 * fq) * 2);
#pragma unroll
            for (int i = 0; i < 4; ++i) { const int vt = 4 * (wave >> 2) + i; f32x4 acc = {0.f, 0.f, 0.f, 0.f};
#pragma unroll
                for (int ks = 0; ks < 2; ++ks) { const bf16x8 b = *(const LAS bf16x8*)(lds + L_IVT + ((16 * vt + fr) * TPI + 32 * ks + 8 * fq) * 2); acc = MFMA16(aa[ks], b, acc); }
#pragma unroll
                for (int ks = 0; ks < 4; ++ks) acc = MFMA16(aq[ks], sf[i][ks], acc);
                oacc[i] = acc; }
        }
        f32x4 gn[4];
#pragma unroll
        for (int j = 0; j < 4; ++j) gn[j] = ((const f32x4*)(p.hgrn_norm + 16 * nsg))[j];
        __syncthreads();
        {   const int tt = wave & 3; LAS float* ob = (LAS float*)(lds + L_OB);
#pragma unroll
            for (int i = 0; i < 4; ++i) { const int v = 16 * (4 * (wave >> 2) + i) + fr;
#pragma unroll
                for (int j = 0; j < 4; ++j) ob[(16 * tt + 4 * fq + j) * 132 + v] = oacc[i][j]; }
        }
        __syncthreads();
        {   const int t = nt_, sg = nsg; const LAS float* ob = (const LAS float*)(lds + L_OB) + t * 132 + 16 * sg;
            f32x4 x[4]; float ss = 0.f;
#pragma unroll
            for (int j = 0; j < 4; ++j) { x[j] = ((const LAS f32x4*)ob)[j]; ss += (x[j].x * x[j].x + x[j].y * x[j].y) + (x[j].z * x[j].z + x[j].w * x[j].w); }
            ss += __shfl_xor(ss, 1); ss += __shfl_xor(ss, 2); ss += __shfl_xor(ss, 4);
            const float rr = rsqrtf(ss * (1.f / 128.f) + EPSN);
            if (t < it.L) { const size_t row = it.row0 + t; const int c0 = it.h * 128 + 16 * sg;
                const f32x4 n0 = gn[0], n1 = gn[1], n2 = gn[2], n3 = gn[3];
                u32x4v o0, o1;
                o0.x = pk2(x[0].x * rr * n0.x * bflo(g0.x), x[0].y * rr * n0.y * bfhi(g0.x)); o0.y = pk2(x[0].z * rr * n0.z * bflo(g0.y), x[0].w * rr * n0.w * bfhi(g0.y));
                o0.z = pk2(x[1].x * rr * n1.x * bflo(g0.z), x[1].y * rr * n1.y * bfhi(g0.z)); o0.w = pk2(x[1].z * rr * n1.z * bflo(g0.w), x[1].w * rr * n1.w * bfhi(g0.w));
                o1.x = pk2(x[2].x * rr * n2.x * bflo(g1.x), x[2].y * rr * n2.y * bfhi(g1.x)); o1.y = pk2(x[2].z * rr * n2.z * bflo(g1.y), x[2].w * rr * n2.w * bfhi(g1.y));
                o1.z = pk2(x[3].x * rr * n3.x * bflo(g1.z), x[3].y * rr * n3.y * bfhi(g1.z)); o1.w = pk2(x[3].z * rr * n3.z * bflo(g1.w), x[3].w * rr * n3.w * bfhi(g1.w));
                *(u32x4v*)(p.CAT + row * 1024 + c0) = o0; *(u32x4v*)(p.CAT + row * 1024 + c0 + 8) = o1; }
        }
        __syncthreads();
        item = next;
    }
}
DI void s5_load_u(const Prm& p, int mt, int g, int lane, bf16x8 (&uf)[8]) {
    const int fr = lane & 15, fq = lane >> 4; int col = 16 * mt + fr; if (col >= NCOL) col = NCOL - 1;
#pragma unroll
    for (int ks = 0; ks < 8; ++ks) uf[ks] = *(const bf16x8*)(p.U + ((size_t)(16 * col + 2 * ks + (fq >> 1))) * 512 + 16 * g + 8 * (fq & 1));
}
DI void s5_b(const Prm& p, int gw, int NGW, int lane) {
    const int fr = lane & 15, fq = lane >> 4;
    for (int task = gw; task < 131 * 32; task += NGW) { const int mt = task >> 5, g = task & 31;
        bf16x8 uf[8]; s5_load_u(p, mt, g, lane, uf);
#pragma unroll
        for (int nt = 0; nt < 8; ++nt) { f32x4 acc = {0.f, 0.f, 0.f, 0.f};
#pragma unroll
            for (int ks = 0; ks < 8; ++ks) { const bf16x8 b = *(const bf16x8*)(p.HT + ((size_t)(g * 128 + 16 * nt + fr)) * 256 + 32 * ks + 8 * fq); acc = MFMA16(uf[ks], b, acc); }
#pragma unroll
            for (int j = 0; j < 4; ++j) { const int col = 16 * mt + 4 * fq + j; if (col < NCOL) p.XLOC[(size_t)col * 4096 + g * 128 + 16 * nt + fr] = acc[j]; } }
    }
}
template <int NB> DI void s5_c_steps(const Prm& p, int col, size_t base, float ar, float ai, float& xr, float& xi) {
    f32x2v xl[NB];
#pragma unroll
    for (int i = 0; i < NB; ++i) xl[i] = *(const f32x2v*)(p.XLOC + (size_t)(col + i) * 4096 + base);
#pragma unroll
    for (int i = 0; i < NB; ++i) { *(unsigned*)(p.XPREV + (size_t)(col + i) * 4096 + base) = pk2(xr, xi);
        const float nr = ar * xr - ai * xi + xl[i].x, ni = ar * xi + ai * xr + xl[i].y; xr = nr; xi = ni; }
}
DI void s5_c(const Prm& p, int gtid) {
    if (gtid >= 16 * 2048) return;
    const int seq = gtid >> 11, g = (gtid >> 6) & 31, n = gtid & 63; const bool smp = seq >= 8; const int b = seq & 7;
    float xr = 0.f, xi = 0.f; if (smp) { xr = p.ssm_re0[(b * 32 + g) * 64 + n]; xi = p.ssm_im0[(b * 32 + g) * 64 + n]; }
    const float ar = p.A16[2 * (g * 64 + n)], ai = p.A16[2 * (g * 64 + n) + 1];
    const size_t base = (size_t)g * 128 + 2 * n;
    if (smp) s5_c_steps<4>(p, 2056 + 4 * b, base, ar, ai, xr, xi);
    else { for (int c0 = 0; c0 < 256; c0 += 16) s5_c_steps<16>(p, 257 * b + c0, base, ar, ai, xr, xi); s5_c_steps<1>(p, 257 * b + 256, base, ar, ai, xr, xi); }
    const size_t o = (size_t)(b * 32 + g) * 64 + n;
    p.out[(smp ? O_SRS : O_SRP) + o] = xr; p.out[(smp ? O_SIS : O_SIP) + o] = xi;
}
DI f32x2v gelu_pk(f32x2v v) {
    const f32x2v av = __builtin_elementwise_abs(v), d = av * 0.2316418882f + 1.0f;
    f32x2v t; t.x = __builtin_amdgcn_rcpf(d.x); t.y = __builtin_amdgcn_rcpf(d.y);
    f32x2v q = t * 0.5307027145f + (-0.7265760135f); q = q * t + 0.7107068705f; q = q * t + (-0.142248368f); q = q * t + 0.127414796f; q = q * t;
    const f32x2v s = (v * v) * (-0.72134752044f);
    f32x2v e; e.x = __builtin_amdgcn_exp2f(s.x); e.y = __builtin_amdgcn_exp2f(s.y);
    const f32x2v m = v * (q * e), r = v - m;
    f32x2v o; o.x = v.x < 0.f ? m.x : r.x; o.y = v.y < 0.f ? m.y : r.y; return o;
}
DI void s5_d(const Prm& p, int gw, int NGW, int lane) {
    const int fr = lane & 15, fq = lane >> 4;
    for (int task = gw; task < 131 * 32; task += NGW) { const int mt = task >> 5, g = task & 31;
        bf16x8 uf[8], xf[4]; s5_load_u(p, mt, g, lane, uf);
        int colc = 16 * mt + fr; if (colc >= NCOL) colc = NCOL - 1;
#pragma unroll
        for (int ks = 0; ks < 4; ++ks) xf[ks] = *(const bf16x8*)(p.XPREV + (size_t)colc * 4096 + g * 128 + 32 * ks + 8 * fq);
        const bf16_t* tg = p.TG + ((size_t)(g * 256 + fr)) * 384 + 8 * fq;
        const bool ok = 16 * mt + fr < NCOL;
#pragma unroll
        for (int t = 0; t < 16; ++t) { f32x4 acc = {0.f, 0.f, 0.f, 0.f};
#pragma unroll
            for (int ks = 0; ks < 8; ++ks) if (ks <= (t >> 1)) { const bf16x8 a = *(const bf16x8*)(tg + (size_t)t * 16 * 384 + 32 * ks); acc = MFMA16(a, uf[ks], acc); }
#pragma unroll
            for (int ks = 0; ks < 4; ++ks) { const bf16x8 a = *(const bf16x8*)(tg + (size_t)t * 16 * 384 + 256 + 32 * ks); acc = MFMA16(a, xf[ks], acc); }
            const f32x2v y0 = gelu_pk((f32x2v){acc[0], acc[1]}), y1 = gelu_pk((f32x2v){acc[2], acc[3]});
            u32x2 o; o.x = pk2(y0.x, y0.y); o.y = pk2(y1.x, y1.y);
            if (ok) *(u32x2*)(p.YG + ((size_t)(16 * (16 * mt + fr) + t)) * 512 + 16 * g + 4 * fq) = o; }
    }
}

DI void s5_b_lds(const Prm& p, LAS unsigned char* lds, int tid, int lane, int wave) {
    const int fr = lane & 15, fq = lane >> 4;
    for (int gp = blockIdx.x; gp < 256; gp += gridDim.x) { const int g = gp & 31, part = gp >> 5;
        for (int i = tid; i < 128 * 32; i += 512) { const int row = i >> 5, ch = i & 31;
            *(LAS u32x4v*)(lds + row * 528 + ch * 16) = *(const u32x4v*)(p.HT + ((size_t)(g * 128 + row)) * 256 + ch * 8); }
        __syncthreads();
        for (int mt = part + 8 * wave; mt < 131; mt += 64) {
            bf16x8 uf[8]; s5_load_u(p, mt, g, lane, uf);
#pragma unroll 1
            for (int nt = 0; nt < 8; ++nt) { f32x4 acc = {0.f, 0.f, 0.f, 0.f};
#pragma unroll
                for (int ks = 0; ks < 8; ++ks) { const bf16x8 b = *(const LAS bf16x8*)(lds + (16 * nt + fr) * 528 + 64 * ks + 16 * fq); acc = MFMA16(uf[ks], b, acc); }
#pragma unroll
                for (int j = 0; j < 4; ++j) { const int col = 16 * mt + 4 * fq + j; if (col < NCOL) p.XLOC[(size_t)col * 4096 + g * 128 + 16 * nt + fr] = acc[j]; } }
        }
        __syncthreads(); }
}
DI void s5_d_lds(const Prm& p, LAS unsigned char* lds, int tid, int lane, int wave) {
    const int fr = lane & 15, fq = lane >> 4;
    for (int gp = blockIdx.x; gp < 256; gp += gridDim.x) { const int g = gp & 31, part = gp >> 5;
        { const int row = tid >> 1, hf = tid & 1;
            *(LAS u32x4v*)(lds + row * 48 + hf * 16) = *(const u32x4v*)(p.TG + ((size_t)(g * 256 + row)) * 16 + hf * 8); }
        for (int i = tid; i < 256 * 16; i += 512) { const int row = i >> 4, ch = i & 15;
            *(LAS u32x4v*)(lds + 12288 + row * 272 + ch * 16) = *(const u32x4v*)(p.TG + 131072 + ((size_t)(g * 256 + row)) * 128 + ch * 8); }
        __syncthreads();
        const int lb = fr * 48 + (fq & 1) * 16, hi = fq >> 1;
        for (int mt = part + 8 * wave; mt < 131; mt += 64) {
            bf16x8 uf[8], xf[4]; s5_load_u(p, mt, g, lane, uf);
            int colc = 16 * mt + fr; if (colc >= NCOL) colc = NCOL - 1;
#pragma unroll
            for (int ks = 0; ks < 4; ++ks) xf[ks] = *(const bf16x8*)(p.XPREV + (size_t)colc * 4096 + g * 128 + 32 * ks + 8 * fq);
            const bool ok = 16 * mt + fr < NCOL;
#pragma unroll 1
            for (int t = 0; t < 16; ++t) { f32x4 acc = {0.f, 0.f, 0.f, 0.f};
#pragma unroll
                for (int ks = 0; ks < 8; ++ks) if (ks <= (t >> 1)) {
                    const int tau = t - 2 * ks - hi;
                    union { bf16x8 v; u32x4v u; } a; a.v = *(const LAS bf16x8*)(lds + (tau < 0 ? 0 : tau) * 768 + lb);
                    if (tau < 0) a.u = (u32x4v){0u, 0u, 0u, 0u};
                    acc = MFMA16(a.v, uf[ks], acc); }
#pragma unroll
                for (int ks = 0; ks < 4; ++ks) { const bf16x8 a = *(const LAS bf16x8*)(lds + 12288 + (t * 16 + fr) * 272 + 64 * ks + 16 * fq); acc = MFMA16(a, xf[ks], acc); }
                const f32x2v y0 = gelu_pk((f32x2v){acc[0], acc[1]}), y1 = gelu_pk((f32x2v){acc[2], acc[3]});
                u32x2 o; o.x = pk2(y0.x, y0.y); o.y = pk2(y1.x, y1.y);
                if (ok) *(u32x2*)(p.YG + ((size_t)(16 * (16 * mt + fr) + t)) * 512 + 16 * g + 4 * fq) = o; }
        }
        __syncthreads(); }
}
DI void cache_convert(const Prm& p, int gtid, int GT) {
    for (size_t i = (size_t)gtid; i < (size_t)8 * 1024 * 256; i += (size_t)GT) {
        const size_t row = i >> 8; const int c4 = (int)(i & 255) * 4, b = (int)(row >> 10), pos = (int)(row & 1023), h = c4 >> 7, d = c4 & 127;
        const f32x4 k = *(const f32x4*)(p.cache_k + row * 1024 + c4); u32x2 o; o.x = pk2(k.x, k.y); o.y = pk2(k.z, k.w);
        *(u32x2*)(p.KS + kf_index(b * 8 + h, 34, pos, d)) = o;
        const f32x4 v = *(const f32x4*)(p.cache_v + row * 1024 + c4); bf16_t* vt = p.VTS + vf_index(b * 8 + h, 34, pos, d);
        vt[0] = f2bf(v.x); vt[8] = f2bf(v.y); vt[16] = f2bf(v.z); vt[24] = f2bf(v.w); }
}
DI void attn_phase(const Prm& p, LAS unsigned char* lds, int wave, int gw, int NGW, int lane) {
    const int q = lane & 31, half = lane >> 5;
    LAS unsigned char* wl = lds + wave * 16384;
    for (int it = gw; it < 8256 + 128; it += NGW) {
        bool smp; int b, h, qb;
        if (it < 8064) { smp = false; b = it / 1008; const int rem = it - b * 1008; h = rem / 126; qb = 3 + rem - h * 126; }
        else if (it < 8192) { const int s = it - 8064; smp = true; b = s >> 4; h = (s >> 1) & 7; qb = s & 1; }
        else { const int s = it - 8192; smp = false; b = s / 24; const int rem = s - b * 24; h = rem / 3; qb = rem - h * 3; }
        const size_t tbase = (size_t)(b * 8 + h) * (smp ? 34 : 129) * 4096 + lane * 8;
        const bf16_t* Kb = (smp ? p.KS : p.KP) + tbase; const bf16_t* Vb = (smp ? p.VTS : p.VTP) + tbase;
        const int qpos0 = (smp ? 1024 : 0) + 32 * qb, qrow0 = smp ? NTP + b * 64 + 32 * qb : b * TP + 32 * qb;
        const int qpos = qpos0 + q; const bool qvalid = smp || qpos < TP; const size_t qrow = qvalid ? qrow0 + q : qrow0;
        bf16x8 qf[8];
#pragma unroll
        for (int ks = 0; ks < 8; ++ks) qf[ks] = *(const bf16x8*)(p.Q + qrow * 1024 + h * 128 + 16 * ks + 8 * half);
        f32x16 o[4];
#pragma unroll
        for (int db = 0; db < 4; ++db)
#pragma unroll
            for (int e = 0; e < 16; ++e) o[db][e] = 0.f;
        float C = 1.f;
        for (int kt = (qpos0 + 30) >> 5; kt >= 0; --kt) {
            f32x16 s;
#pragma unroll
            for (int e = 0; e < 16; ++e) s[e] = 0.f;
            const bf16_t* kr = Kb + (size_t)kt * 4096; const bf16_t* vr = Vb + (size_t)kt * 4096;
            bf16x8 kf[8], vf[8];
#pragma unroll
            for (int ks = 0; ks < 8; ++ks) kf[ks] = *(const bf16x8*)(kr + ks * 512);
#pragma unroll
            for (int ks = 0; ks < 8; ++ks) vf[ks] = *(const bf16x8*)(vr + ks * 512);
#pragma unroll
            for (int ks = 0; ks < 8; ++ks) s = MFMA32(kf[ks], qf[ks], s);
            float pr[16], be[16], G[4], Gp[4];
#pragma unroll
            for (int i = 0; i < 4; ++i) {
#pragma unroll
                for (int j = 0; j < 4; ++j) { const int key = 32 * kt + 8 * i + 4 * half + j; const bool valid = key < qpos;
                    float z = s[4 * i + j] * 0.08838834764831845f; z = fminf(fmaxf(z, -80.f), 80.f);
                    const float e = __expf(z), pp = __builtin_amdgcn_rcpf(1.f + e); pr[4 * i + j] = valid ? pp : 1.f; be[4 * i + j] = valid ? e * pp : 0.f; }
                G[i] = (pr[4 * i] * pr[4 * i + 1]) * (pr[4 * i + 2] * pr[4 * i + 3]); }
#pragma unroll
            for (int i = 0; i < 4; ++i) Gp[i] = __shfl_xor(G[i], 32);
            float w[16]; float E1 = 1.f;
#pragma unroll
            for (int i = 3; i >= 0; --i) { const float Glo = half ? Gp[i] : G[i], Ghi = half ? G[i] : Gp[i];
                float suf = C * (half ? E1 : E1 * Ghi);
#pragma unroll
                for (int j = 3; j >= 0; --j) { w[4 * i + j] = be[4 * i + j] * suf; suf *= pr[4 * i + j]; }
                E1 *= Glo * Ghi; }
            C *= E1;
#pragma unroll
            for (int c = 0; c < 2; ++c) { union { bf16x8 v; unsigned u[4]; } wf;
#pragma unroll
                for (int e = 0; e < 4; ++e) wf.u[e] = pk2(w[8 * c + 2 * e], w[8 * c + 2 * e + 1]);
#pragma unroll
                for (int db = 0; db < 4; ++db) o[db] = MFMA32(vf[4 * c + db], wf.v, o[db]); }
            if (__all(C < 1e-24f)) break;
        }
#pragma unroll
        for (int db = 0; db < 4; ++db)
#pragma unroll
            for (int i = 0; i < 4; ++i) { u32x2 ov; ov.x = pk2(o[db][4 * i], o[db][4 * i + 1]); ov.y = pk2(o[db][4 * i + 2], o[db][4 * i + 3]);
                *(LAS u32x2*)(wl + q * 272 + (32 * db + 8 * i + 4 * half) * 2) = ov; }
#pragma unroll
        for (int k = 0; k < 8; ++k) { const int r = (lane >> 4) + 4 * k, ch = lane & 15;
            const u32x4v v = *(const LAS u32x4v*)(wl + r * 272 + ch * 16);
            if (smp || qpos0 + r < TP) *(u32x4v*)(p.O + (size_t)(qrow0 + r) * 1024 + h * 128 + ch * 8) = v; }
    }
}
DI void final_norm(const Prm& p, int gw, int NGW, int lane) {
    for (int r = gw; r < 32768 + 512; r += NGW) {
        int grow; float* dst;
        if (r < 32768) { const int b = r >> 12, t = r & 4095; grow = b * TP + 16 + t; dst = p.out + O_YP + (size_t)r * 1024; } else { grow = NTP + (r - 32768); dst = p.out + O_YS + (size_t)(r - 32768) * 1024; }
        u32x2 x[4];
#pragma unroll
        for (int j = 0; j < 4; ++j) x[j] = ((const u32x2*)(p.XB + (size_t)grow * 1024))[lane + 64 * j];
        const float rr = row_rinv(p.SSQ, grow);
#pragma unroll
        for (int j = 0; j < 4; ++j) { f32x4 v; v.x = bflo(x[j].x); v.y = bfhi(x[j].x); v.z = bflo(x[j].y); v.w = bfhi(x[j].y); ((f32x4*)dst)[lane + 64 * j] = v * rr * ((const f32x4*)p.ln_final)[lane + 64 * j]; }
    }
}

#define XB_TMO      128
#define XB_XCNT(j)  (256  + 64 * (j))
#define XB_XSUB(j)  (1280 + 64 * (j))
#define XB_XGEN(j)  (2304 + 64 * (j))
#define XB_TOP      3328
#define XB_TOPGEN   3392
#define XCD_BAR_WORDS 3456
#define XB_SPIN_CAP (1u << 18)
DI unsigned xb_ld(unsigned* p) { return __hip_atomic_load(p, __ATOMIC_RELAXED, __HIP_MEMORY_SCOPE_AGENT); }
DI unsigned xb_add(unsigned* p, unsigned v) { return __hip_atomic_fetch_add(p, v, __ATOMIC_RELAXED, __HIP_MEMORY_SCOPE_AGENT); }
DI unsigned xb_xcc_id() { return (unsigned)__builtin_amdgcn_s_getreg((3 << 11) | 20) & 0xFu; }
#define XB_SPIN(cond, bar) do { unsigned _sp = 0; while (cond) { __builtin_amdgcn_s_sleep(1); \
    if ((++_sp & 255u) == 0u) { if (xb_ld(&(bar)[XB_TMO])) break; if (_sp > XB_SPIN_CAP) { atomicAdd(&(bar)[XB_TMO], 1u); break; } } } } while (0)
struct XcdBarrier { unsigned* bar; unsigned x; volatile LAS unsigned* st; };
DI XcdBarrier xcd_barrier_post(unsigned* bar, volatile LAS unsigned* st) {
    XcdBarrier b; b.bar = bar; b.x = xb_xcc_id(); b.st = st;
    if (threadIdx.x == 0) (void)xb_add(&bar[XB_XCNT(b.x)], 1u);
    return b;
}
DI void xcd_barrier_complete(unsigned* bar, unsigned x, unsigned& nloc, unsigned& nx) {
    const unsigned G = gridDim.x * gridDim.y * gridDim.z;
    unsigned sum, cnt, mine, sp = 0u;
    for (;;) {
        sum = 0u; cnt = 0u; mine = 0u;
#pragma unroll
        for (unsigned j = 0; j < 16; ++j) { const unsigned c = xb_ld(&bar[XB_XCNT(j)]); sum += c; cnt += (c > 0u) ? 1u : 0u; mine = (j == x) ? c : mine; }
        if (sum == G) break;
        __builtin_amdgcn_s_sleep(1);
        if ((++sp & 255u) == 0u) { if (xb_ld(&bar[XB_TMO])) break; if (sp > XB_SPIN_CAP) { atomicAdd(&bar[XB_TMO], 1u); break; } }
    }
    nloc = mine > 0u ? mine : 1u; nx = cnt > 0u ? cnt : 1u;
}
DI void xcd_barrier(const XcdBarrier& b) {
    asm volatile("s_waitcnt vmcnt(0)" ::: "memory");
    __syncthreads();
    if (threadIdx.x == 0) {
        unsigned* bar = b.bar;
        __builtin_amdgcn_s_waitcnt(0);
        unsigned nloc = b.st[0], nx = b.st[1];
        if (nloc == 0u) { xcd_barrier_complete(bar, b.x, nloc, nx); b.st[0] = nloc; b.st[1] = nx; }
        const unsigned old = xb_add(&bar[XB_XSUB(b.x)], 1u);
        const unsigned gen = old / nloc;
        if (old + 1u == (gen + 1u) * nloc) {
            __builtin_amdgcn_fence(__ATOMIC_RELEASE, "agent");
            asm volatile("s_waitcnt vmcnt(0)" ::: "memory");
            const unsigned og = xb_add(&bar[XB_TOP], 1u);
            const unsigned tg = og / nx;
            if (og + 1u == (tg + 1u) * nx) xb_add(&bar[XB_TOPGEN], 1u);
            else XB_SPIN(xb_ld(&bar[XB_TOPGEN]) == tg, bar);
            __builtin_amdgcn_fence(__ATOMIC_ACQUIRE, "agent");
            xb_add(&bar[XB_XGEN(b.x)], 1u);
            asm volatile("s_waitcnt vmcnt(0)" ::: "memory");
        } else {
            XB_SPIN(xb_ld(&bar[XB_XGEN(b.x)]) == gen, bar);
            __builtin_amdgcn_fence(__ATOMIC_ACQUIRE, "agent");
            asm volatile("s_waitcnt vmcnt(0)" ::: "memory");
        }
    }
    __syncthreads();
}
constexpr int LDS_BYTES = 131072 + 256 + 8192;
__global__ void __launch_bounds__(512, 2) fwd_megakernel(Prm p) {
    extern __shared__ __attribute__((aligned(16))) unsigned char shm[];
    LAS unsigned char* lds = (LAS unsigned char*)shm;
    cg::grid_group grid = cg::this_grid();
    const int tid = threadIdx.x, lane = tid & 63, wave = __builtin_amdgcn_readfirstlane(tid >> 6);
    const int gw = blockIdx.x * 8 + wave, NGW = gridDim.x * 8, gtid = blockIdx.x * 512 + tid, GT = gridDim.x * 512;
    volatile LAS unsigned* xst = (volatile LAS unsigned*)(lds + 131072);
    if (tid == 0) { xst[0] = 0u; xst[1] = 0u; }
    __syncthreads();
    const XcdBarrier xb = xcd_barrier_post(p.BAR, xst);
    phase_prologue(p, lds, tid, lane, wave);
    grid.sync();
    { EpiIn0 E; E.SSQ = p.SSQ; E.RINV = p.RINV; E.LB = p.LB; E.Qh = p.Qh; E.IV = p.IV; E.GS = p.GS; E.U = p.U; E.LOGF = p.LOGF; run_gemm(lds, p.XB, p.Wt1, 2560, 1024, E); }
    xcd_barrier(xb);
    hgrn_b1_all(p, lds, tid, lane, wave);
    s5_b_lds(p, lds, tid, lane, wave);
    xcd_barrier(xb);
    hgrn_b2(p, gtid, GT);
    s5_c(p, gtid);
    xcd_barrier(xb);
    hgrn_b3_all(p, lds, tid, lane, wave);
    s5_d_lds(p, lds, tid, lane, wave);
    xcd_barrier(xb);
    { EpiGlu E; E.YG = p.YG; E.CAT = p.CAT; run_gemm(lds, p.YG, p.Wglu, 512, 512, E); }
    xcd_barrier(xb);
    { EpiRes E; E.XB = p.XB; E.SSQ = p.SSQ; run_gemm_split(lds, p.CAT, p.Wo0, 1024, 1024, E, (float*)p.H); xcd_barrier(xb); gemm_fixup(1024, 1024, E, (const float*)p.H, tid); rinv_pass(p, 1024, tid); }
    xcd_barrier(xb);
    { EpiUp E; E.SSQ = p.SSQ; E.RINV = p.RINV; E.H = p.H; run_gemm(lds, p.XB, p.Wup0, 4096, 1024, E); }
    xcd_barrier(xb);
    { EpiRes E; E.XB = p.XB; E.SSQ = p.SSQ; run_gemm_split(lds, p.H, p.Wdn0, 1024, 4096, E, (float*)p.CAT); xcd_barrier(xb); gemm_fixup(1024, 4096, E, (const float*)p.CAT, tid); rinv_pass(p, 4096, tid); }
    xcd_barrier(xb);
    { EpiQkv E; E.scr = lds + 131328; E.SSQ = p.SSQ; E.RINV = p.RINV; E.out = p.out; E.Q = p.Q; E.KP = p.KP; E.KS = p.KS; E.VTP = p.VTP; E.VTS = p.VTS; run_gemm(lds, p.XB, p.Wqkv, 3072, 1024, E); }
    if (gridDim.x > 36) { if (blockIdx.x >= 36) cache_convert(p, (blockIdx.x - 36) * 512 + tid, (gridDim.x - 36) * 512); } else cache_convert(p, gtid, GT);
    xcd_barrier(xb);
    attn_phase(p, lds, wave, gw, NGW, lane);
    xcd_barrier(xb);
    { EpiRes E; E.XB = p.XB; E.SSQ = p.SSQ; run_gemm_split(lds, p.O, p.Wo1, 1024, 1024, E, (float*)p.H); xcd_barrier(xb); gemm_fixup(1024, 1024, E, (const float*)p.H, tid); rinv_pass(p, 1024, tid); }
    xcd_barrier(xb);
    { EpiUp E; E.SSQ = p.SSQ; E.RINV = p.RINV; E.H = p.H; run_gemm(lds, p.XB, p.Wup1, 4096, 1024, E); }
    xcd_barrier(xb);
    { EpiRes E; E.XB = p.XB; E.SSQ = p.SSQ; run_gemm_split(lds, p.H, p.Wdn1, 1024, 4096, E, (float*)p.CAT); xcd_barrier(xb); gemm_fixup(1024, 4096, E, (const float*)p.CAT, tid); }
    xcd_barrier(xb);
    final_norm(p, gw, NGW, lane);
}

extern "C" void kernel_launch(void* const* d_in, const int* in_sizes, int n_in, void* d_out, int out_size, void* d_ws, size_t ws_size, hipStream_t stream) {
    static int grid_blocks = 0;
    if (grid_blocks == 0) {
        int dev = 0, cus = 0, per_cu = 0;
        hipGetDevice(&dev); hipDeviceGetAttribute(&cus, hipDeviceAttributeMultiprocessorCount, dev);
        if (hipFuncSetAttribute((const void*)fwd_megakernel, hipFuncAttributeMaxDynamicSharedMemorySize, LDS_BYTES) != hipSuccess) fprintf(stderr, "kernel_launch: hipFuncSetAttribute failed\n");
        if (hipOccupancyMaxActiveBlocksPerMultiprocessor(&per_cu, (const void*)fwd_megakernel, 512, LDS_BYTES) != hipSuccess || per_cu < 1) { fprintf(stderr, "kernel_launch: occupancy query says %d\n", per_cu); per_cu = 1; }
        (void)hipGetLastError();
        grid_blocks = cus > 0 ? cus : 256;
    }
    Prm p{};
    const float* const* in = (const float* const*)d_in;
    p.x_prompt = in[0]; p.x_sample = in[1]; p.state_hgrn = in[2]; p.ssm_re0 = in[3]; p.ssm_im0 = in[4]; p.cache_k = in[5]; p.cache_v = in[6]; p.meta = in[7]; p.ln_mix = in[8]; p.ln_mlp = in[9];
    p.ln_final = in[10]; p.w_in_even = in[11]; p.hgrn_lb = in[12]; p.hgrn_norm = in[13]; p.a_re = in[14]; p.a_im = in[15]; p.log_dt = in[16]; p.b_re = in[17]; p.b_im = in[18]; p.c_re = in[19];
    p.c_im = in[20]; p.ssm_d = in[21]; p.w_glu = in[22]; p.w_out_even = in[23]; p.w_in_odd = in[24]; p.w_out_odd = in[25]; p.w_up = in[26]; p.w_down = in[27];
    p.out = (float*)d_out;
    unsigned char* ws = (unsigned char*)d_ws; size_t off = 0;
    auto take = [&](size_t bytes) { unsigned char* r = ws + off; off += (bytes + 255) & ~(size_t)255; return r; };
    p.Wt1 = (bf16_t*)take((size_t)2560 * 1024 * 2); p.Wglu = (bf16_t*)take((size_t)512 * 512 * 2); p.Wo0 = (bf16_t*)take((size_t)1024 * 1024 * 2); p.Wup0 = (bf16_t*)take((size_t)4096 * 1024 * 2);
    p.Wdn0 = (bf16_t*)take((size_t)4096 * 1024 * 2); p.Wqkv = (bf16_t*)take((size_t)3072 * 1024 * 2); p.Wo1 = (bf16_t*)take((size_t)1024 * 1024 * 2); p.Wup1 = (bf16_t*)take((size_t)4096 * 1024 * 2);
    p.Wdn1 = (bf16_t*)take((size_t)4096 * 1024 * 2);
    p.XB = (bf16_t*)take((size_t)MP * 1024 * 2); p.SSQ = (float*)take((size_t)MP * 16 * 4); p.RINV = (float*)take((size_t)MP * 4); p.LB = (float*)take(2048); p.KTAB = (float*)take((size_t)32 * 16 * 256 * 4);
    p.TG = (bf16_t*)take((size_t)32 * 256 * 384 * 2); p.HT = (bf16_t*)take((size_t)32 * 128 * 256 * 2); p.A16 = (float*)take(32 * 64 * 2 * 4); p.BAR = (unsigned*)take(XCD_BAR_WORDS * 4);
    const size_t S0 = off; constexpr size_t SZ512 = (size_t)MP * 512 * 2;
    p.Qh = (bf16_t*)take(SZ512); p.LOGF = (unsigned short*)take(SZ512); p.IV = (bf16_t*)take(SZ512); p.GS = (bf16_t*)take(SZ512); p.U = (bf16_t*)take(SZ512);
    p.UT = (bf16_t*)take((size_t)NITEM_H * 16384 * 2); p.AL = (float*)take((size_t)NITEM_H * 128 * 4);
    p.XLOC = (float*)take(SZ512); p.YG = (bf16_t*)p.XLOC;
    p.XPREV = (bf16_t*)take((size_t)NCOL * 4096 * 2); p.CAT = (bf16_t*)take((size_t)MP * 1024 * 2);
    size_t end = off;
    off = S0; p.H = (bf16_t*)take((size_t)MP * 4096 * 2); if (off > end) end = off;
    off = S0; p.Q = (bf16_t*)take((size_t)MP * 1024 * 2); p.KP = (bf16_t*)take((size_t)64 * 129 * 4096 * 2); p.KS = (bf16_t*)take((size_t)64 * 34 * 4096 * 2);
    p.VTP = (bf16_t*)take((size_t)64 * 129 * 4096 * 2); p.VTS = (bf16_t*)take((size_t)64 * 34 * 4096 * 2); p.O = (bf16_t*)take((size_t)MP * 1024 * 2); if (off > end) end = off;
    if (end > ws_size || n_in != 28 || (size_t)out_size != O_END) { fprintf(stderr, "kernel_launch: workspace/shape mismatch: need %zu have %zu, n_in %d, out %d\n", end, ws_size, n_in, out_size); return; }
    (void)hipMemsetAsync(p.BAR, 0, XCD_BAR_WORDS * 4, stream);
    void* args[] = {&p};
    hipError_t e = hipLaunchCooperativeKernel((const void*)fwd_megakernel, dim3(grid_blocks), dim3(512), args, LDS_BYTES, stream);
    if (e != hipSuccess) fprintf(stderr, "cooperative launch failed: %s (grid %d)\n", hipGetErrorString(e), grid_blocks);
}
```

```cpp
#include <hip/hip_runtime.h>
#include <hip/hip_cooperative_groups.h>
#include <cstdio>
#include <cstdint>
namespace cg = cooperative_groups;
namespace pg8 {
#define PG8_LAS __attribute__((address_space(3)))
typedef unsigned short bf16_t;
typedef short bf16x8 __attribute__((ext_vector_type(8)));
typedef float f32x4 __attribute__((ext_vector_type(4)));
typedef unsigned u32x4 __attribute__((ext_vector_type(4)));
constexpr int BM = 256, BK = 64, HALF = 128, HTB = HALF * BK * 2  , STAGE_BYTES = 8 * HTB, NXCD = 8, WGM = 8;

__host__ __device__ __forceinline__ int lds_byte(int r, int c) { const int st = (r >> 4) * 2 + (c >> 5), rr = r & 15, cc = c & 31, ob = rr * 64 + cc * 2; return st * 1024 + (ob ^ (((ob >> 9) & 1) << 5)); }
__host__ __device__ __forceinline__ void stage_rc(int b, int& R, int& C) { const int st = b / 1024, sb = b % 1024, swz = sb ^ (((sb >> 9) & 1) << 5); R = (st >> 1) * 16 + swz / 64; C = (st & 1) * 32 + (swz % 64) / 2; }
__host__ __device__ __forceinline__ int perm32(int rho) { const int n = rho >> 4, i = rho & 15; return 8 * (i >> 2) + 4 * n + (i & 3); }

struct Unit { int pm, pn, kb, nk, part; };
struct Gemm { const bf16_t* A; const bf16_t* Bt; int M, N, K; float* part; };

struct StaticOrder {
    int nM, nN, nwg, G, c;
    __host__ __device__ void init(int M, int N, int G_, int c_) { nM = M / BM; nN = N / BM; nwg = nM * nN; G = G_; c = c_; }
    __host__ __device__ void map(int L, Unit& u) const {
        int wgid = L; { const int q = nwg / NXCD, r = nwg % NXCD, xcd = wgid % NXCD, off = wgid / NXCD; wgid = (xcd < r ? xcd * (q + 1) : r * (q + 1) + (xcd - r) * q) + off; }
        const int nig = WGM * nN, gid = wgid / nig, fm = gid * WGM, gsz = (nM - fm) < WGM ? (nM - fm) : WGM;
        u.pm = fm + ((wgid % nig) % gsz); u.pn = (wgid % nig) / gsz; u.kb = 0; u.nk = 0; u.part = -1;
    }
    __host__ __device__ bool next(int i, Unit& u) const {
        const long L = (long)i * G + c; if (L >= nwg) return false;
        map((int)L, u); return true;
    }
    __device__ __forceinline__ void a_ready(const Unit&) const {}
    __device__ __forceinline__ void done(const Unit&) const {}
};
template <class Epi, class Sched>
__device__ __forceinline__ void gemm_phase(PG8_LAS unsigned char* lds, const Gemm g, const Sched& S, const Epi& E) {
    int tid_ = threadIdx.x; asm volatile("" : "+v"(tid_));
    const int tid = tid_, wid = __builtin_amdgcn_readfirstlane(tid >> 6), lane = tid & 63, wr = wid >> 2, wc = wid & 3, fr = lane & 15, fq = lane >> 4;
    const int K = g.K, nt = K / BK;
    unsigned voffA[2], voffB[2];
#pragma unroll
    for (int i = 0; i < 2; ++i) { int R, C; stage_rc(tid * 16 + i * 8192, R, C); const int Rb = Epi::PERM ? ((R & ~31) + perm32(R & 31)) : R;
        voffA[i] = (unsigned)(R * K + C) * 2u; voffB[i] = (unsigned)(Rb * K + C) * 2u; }
    const size_t kstep = (size_t)(BK * 2);
    const size_t hstep = (size_t)HALF * K * 2;
    const size_t tstep = 2 * hstep;
    const unsigned ldsw = (unsigned)wid * 1024u;
    const int aoff = lds_byte(wr * 64 + fr, fq * 8), boff = lds_byte(wc * 32 + fr, fq * 8);
#define PG8_SA(b, h) (((b) * 2 + (h)) * HTB)
#define PG8_SB(b, h) ((4 + (b) * 2 + (h)) * HTB)
#define PG8_STAGE(bufoff, gbase, voff) do { _Pragma("unroll") for (int _i = 0; _i < 2; ++_i) \
        __builtin_amdgcn_global_load_lds((const unsigned*)((const char*)(gbase) + (voff)[_i]), (PG8_LAS unsigned*)(lds + (bufoff) + ldsw + _i * 8192), 16, 0, 0); } while (0)
#define PG8_LDA(dst, b, h) do { _Pragma("unroll") for (int m = 0; m < 4; ++m) _Pragma("unroll") for (int k = 0; k < 2; ++k) dst[m][k] = *(const PG8_LAS bf16x8*)(lds + PG8_SA(b, h) + aoff + m * 2048 + k * 1024); } while (0)
#define PG8_LDB(dst, b, h) do { _Pragma("unroll") for (int n = 0; n < 2; ++n) _Pragma("unroll") for (int k = 0; k < 2; ++k) dst[n][k] = *(const PG8_LAS bf16x8*)(lds + PG8_SB(b, h) + boff + n * 2048 + k * 1024); } while (0)
#define PG8_MMA(ai, bj, At, Bt) do { __builtin_amdgcn_s_setprio(1); _Pragma("unroll") for (int m = 0; m < 4; ++m) _Pragma("unroll") for (int n = 0; n < 2; ++n) _Pragma("unroll") for (int k = 0; k < 2; ++k) \
        acc[ai][bj][m][n] = __builtin_amdgcn_mfma_f32_16x16x32_bf16(Bt[n][k], At[m][k], acc[ai][bj][m][n], 0, 0, 0); __builtin_amdgcn_s_setprio(0); } while (0)
#define PG8_WAIT_V(n) asm volatile("s_waitcnt vmcnt(" #n ")" ::: "memory")
#define PG8_WAIT_L(n) asm volatile("s_waitcnt lgkmcnt(" #n ")" ::: "memory")
#define PG8_BAR __builtin_amdgcn_s_barrier()
#define PG8_SCHED __builtin_amdgcn_sched_barrier(0)
    Unit cur, nxt; int ui = 0; typename Epi::Pre pre;
    if (!S.next(0, cur)) return;
    f32x4 acc[2][2][4][2];
#pragma unroll
    for (int a = 0; a < 2; ++a)
#pragma unroll
        for (int b = 0; b < 2; ++b)
#pragma unroll
            for (int m = 0; m < 4; ++m)
#pragma unroll
                for (int n = 0; n < 2; ++n) acc[a][b][m][n] = (f32x4){0.f, 0.f, 0.f, 0.f};
    bf16x8 At[4][2], B0[2][2], B1[2][2];
    const char* cA = (const char*)g.A + (size_t)cur.pm * tstep + (size_t)cur.kb * kstep; const char* cB = (const char*)g.Bt + (size_t)cur.pn * tstep + (size_t)cur.kb * kstep;
    S.a_ready(cur);
    PG8_STAGE(PG8_SB(0, 0), cB, voffB); PG8_STAGE(PG8_SA(0, 0), cA, voffA); PG8_STAGE(PG8_SB(0, 1), cB + hstep, voffB); PG8_STAGE(PG8_SA(0, 1), cA + hstep, voffA);
    if (wr == 1) PG8_BAR;
    PG8_WAIT_V(4); PG8_BAR;
    PG8_STAGE(PG8_SB(1, 0), cB + kstep, voffB); PG8_STAGE(PG8_SA(1, 0), cA + kstep, voffA); PG8_STAGE(PG8_SB(1, 1), cB + hstep + kstep, voffB);
    PG8_WAIT_V(6); PG8_BAR;
    for (;;) {
        const bool has_next = S.next(ui + 1, nxt);
        const char* nA = has_next ? (const char*)g.A + (size_t)nxt.pm * tstep + (size_t)nxt.kb * kstep : cA; const char* nB = has_next ? (const char*)g.Bt + (size_t)nxt.pn * tstep + (size_t)nxt.kb * kstep : cB;
        const int cnk = cur.nk ? cur.nk : nt;
        for (int t = 0; t < cnk; t += 2) {
            const bool last = (t == cnk - 2);
            const char* a1 = cA + (size_t)(t + 1) * kstep;
            const char* a2 = last ? nA : cA + (size_t)(t + 2) * kstep; const char* b2 = last ? nB : cB + (size_t)(t + 2) * kstep;
            const char* a3 = a2 + kstep; const char* b3 = b2 + kstep;
            if (last && has_next) S.a_ready(nxt);
            if (last) E.prefetch(pre, cur, wr, fr);
            PG8_LDB(B0, 0, 0); PG8_SCHED; PG8_LDA(At, 0, 0); PG8_STAGE(PG8_SA(1, 1), a1 + hstep, voffA);
            PG8_WAIT_L(8); PG8_BAR; PG8_WAIT_L(0); PG8_MMA(0, 0, At, B0); PG8_BAR; PG8_SCHED;
            PG8_LDB(B1, 0, 1); PG8_STAGE(PG8_SB(0, 0), b2, voffB);
            PG8_BAR; PG8_WAIT_L(0); PG8_MMA(0, 1, At, B1); PG8_BAR;
            PG8_LDA(At, 0, 1); PG8_STAGE(PG8_SA(0, 0), a2, voffA);
            PG8_BAR; PG8_WAIT_L(0); PG8_MMA(1, 0, At, B0); PG8_BAR; PG8_SCHED;
            PG8_STAGE(PG8_SB(0, 1), b2 + hstep, voffB);
            PG8_WAIT_V(6); PG8_BAR; PG8_MMA(1, 1, At, B1); PG8_BAR;
            PG8_LDB(B0, 1, 0); PG8_SCHED; PG8_LDA(At, 1, 0); PG8_STAGE(PG8_SA(0, 1), a2 + hstep, voffA);
            PG8_WAIT_L(8); PG8_BAR; PG8_WAIT_L(0); PG8_MMA(0, 0, At, B0); PG8_BAR; PG8_SCHED;
            PG8_LDB(B1, 1, 1); PG8_STAGE(PG8_SB(1, 0), b3, voffB);
            PG8_BAR; PG8_WAIT_L(0); PG8_MMA(0, 1, At, B1); PG8_BAR;
            PG8_LDA(At, 1, 1); PG8_STAGE(PG8_SA(1, 0), a3, voffA);
            PG8_BAR; PG8_WAIT_L(0); PG8_MMA(1, 0, At, B0); PG8_BAR; PG8_SCHED;
            PG8_STAGE(PG8_SB(1, 1), b3 + hstep, voffB);
            PG8_WAIT_V(6); PG8_BAR; PG8_MMA(1, 1, At, B1); PG8_BAR;
        }
        if constexpr (!Epi::AFTER_DRAIN) {
            if (cur.part < 0) E(acc, cur, wr, wc, fr, fq, pre);
            else { f32x4* pp = (f32x4*)g.part + (size_t)cur.part * 32 * 512 + tid;
#pragma unroll
                for (int a = 0; a < 2; ++a)
#pragma unroll
                    for (int b = 0; b < 2; ++b)
#pragma unroll
                        for (int m = 0; m < 4; ++m)
#pragma unroll
                            for (int n = 0; n < 2; ++n) pp[(size_t)(((a * 2 + b) * 4 + m) * 2 + n) * 512] = acc[a][b][m][n]; }
            S.done(cur); }
        if (!has_next) break;
#pragma unroll
        for (int a = 0; a < 2; ++a)
#pragma unroll
            for (int b = 0; b < 2; ++b)
#pragma unroll
                for (int m = 0; m < 4; ++m)
#pragma unroll
                    for (int n = 0; n < 2; ++n) acc[a][b][m][n] = (f32x4){0.f, 0.f, 0.f, 0.f};
        cur = nxt; cA = nA; cB = nB; ++ui;
    }
    PG8_WAIT_V(0);
    if (wr == 0) PG8_BAR;
    PG8_BAR;
    if constexpr (Epi::AFTER_DRAIN) { E.fused(acc, cur, wr, wc, fr, fq, lds, wid, lane); S.done(cur); }
#undef PG8_SA
#undef PG8_SB
#undef PG8_STAGE
#undef PG8_LDA
#undef PG8_LDB
#undef PG8_MMA
#undef PG8_WAIT_V
#undef PG8_WAIT_L
#undef PG8_BAR
#undef PG8_SCHED
}
}
using pg8::bf16_t; using pg8::bf16x8; using pg8::f32x4; using pg8::Unit;
typedef float f32x16 __attribute__((ext_vector_type(16)));
typedef float f32x2v __attribute__((ext_vector_type(2)));
typedef unsigned u32x2 __attribute__((ext_vector_type(2)));
typedef unsigned u32x4v __attribute__((ext_vector_type(4)));
#define LAS __attribute__((address_space(3)))
#define DI __device__ __forceinline__

constexpr int DM = 1024, TP = 4112, NTP = 8 * TP  , NTS = 512, NT = NTP + NTS  , MP = 33536  ;
constexpr int NITEM_H = 2112;
constexpr int NCOL = NT / 16;
constexpr float EPSN = 1e-6f;
constexpr size_t O_YP = 0, O_YS = O_YP + (size_t)8 * 4096 * 1024, O_HGP = O_YS + 524288, O_HGS = O_HGP + 524288, O_SRP = O_HGS + 524288, O_SIP = O_SRP + 16384,
                 O_SRS = O_SIP + 16384, O_SIS = O_SRS + 16384, O_KP = O_SIS + 16384, O_VP = O_KP + (size_t)NTP * 1024, O_KS = O_VP + (size_t)NTP * 1024, O_VS = O_KS + 524288, O_END = O_VS + 524288;

struct Prm {
    const float *x_prompt, *x_sample, *state_hgrn, *ssm_re0, *ssm_im0, *cache_k, *cache_v, *meta, *ln_mix, *ln_mlp, *ln_final, *w_in_even, *hgrn_lb, *hgrn_norm,
        *a_re, *a_im, *log_dt, *b_re, *b_im, *c_re, *c_im, *ssm_d, *w_glu, *w_out_even, *w_in_odd, *w_out_odd, *w_up, *w_down;
    float* out;
    bf16_t *Wt1, *Wglu, *Wo0, *Wup0, *Wdn0, *Wqkv, *Wo1, *Wup1, *Wdn1;
    bf16_t* XB; float* SSQ; float* RINV; float* LB; float* KTAB; bf16_t* TG; bf16_t* HT; float* A16;
    bf16_t *Qh, *IV, *GS, *U; unsigned short* LOGF; bf16_t* UT; float* AL; float* XLOC; bf16_t* XPREV; bf16_t* YG; bf16_t* CAT;
    bf16_t* H;
    bf16_t *Q, *KP, *KS, *VTP, *VTS, *O; unsigned* BAR;
};

DI unsigned pk2(float lo, float hi) { unsigned r; asm volatile("v_cvt_pk_bf16_f32 %0, %1, %2" : "=v"(r) : "v"(lo), "v"(hi)); return r; }
DI float bflo(unsigned u) { return __uint_as_float(u << 16); }
DI float bfhi(unsigned u) { return __uint_as_float(u & 0xffff0000u); }
DI float bf2f(unsigned short b) { return __uint_as_float(((unsigned)b) << 16); }
DI unsigned short f2bf(float f) { return (unsigned short)(pk2(f, 0.f) & 0xffffu); }
DI unsigned pkh2(float lo, float hi) { union { _Float16 h[2]; unsigned u; } x; x.h[0] = (_Float16)lo; x.h[1] = (_Float16)hi; return x.u; }
DI float h2f(unsigned short h) { union { unsigned short s; _Float16 h; } x; x.s = h; return (float)x.h; }
DI float wave_sum(float v) {
#pragma unroll
    for (int o = 1; o < 64; o <<= 1) v += __shfl_xor(v, o);
    return v;
}
DI float fexp(float x) { return __expf(x); }
DI float sigm(float x) { return __builtin_amdgcn_rcpf(1.f + __expf(-x)); }
DI float row_rinv(const float* SSQ, int row) {
    const f32x4* s = (const f32x4*)(SSQ + (size_t)row * 16); f32x4 a = s[0] + s[1] + s[2] + s[3];
    return rsqrtf(((a.x + a.y) + (a.z + a.w)) * (1.f / 1024.f) + EPSN);
}
DI void rinv8(const float* SSQ, int row0, int fq, float (&r)[2][4]) {
    f32x4 v[2][4];
#pragma unroll
    for (int ai = 0; ai < 2; ++ai)
#pragma unroll
        for (int m = 0; m < 4; ++m) v[ai][m] = *(const f32x4*)(SSQ + (size_t)(row0 + ai * 128 + m * 16) * 16 + 4 * fq);
#pragma unroll
    for (int ai = 0; ai < 2; ++ai)
#pragma unroll
        for (int m = 0; m < 4; ++m) { float s = (v[ai][m].x + v[ai][m].y) + (v[ai][m].z + v[ai][m].w); s += __shfl_xor(s, 16); s += __shfl_xor(s, 32); r[ai][m] = rsqrtf(s * (1.f / 1024.f) + EPSN); }
}
#define LDS_WAIT() asm volatile("s_waitcnt lgkmcnt(0)" ::: "memory")

struct EpiIn0 {
    struct Pre { float r[2][4]; };
    DI void prefetch(Pre& pre, const Unit& u, int wr, int fr) const { const int row0 = u.pm * 256 + wr * 64 + fr;
#pragma unroll
        for (int ai = 0; ai < 2; ++ai)
#pragma unroll
            for (int m = 0; m < 4; ++m) pre.r[ai][m] = RINV[row0 + ai * 128 + m * 16]; }
    DI void scales(const Pre& pre, int row0, int fq, float (&rs)[2][4]) const {
        if (pre.r[0][0] > 0.f) {
#pragma unroll
            for (int ai = 0; ai < 2; ++ai)
#pragma unroll
                for (int m = 0; m < 4; ++m) rs[ai][m] = pre.r[ai][m]; }
        else rinv8(SSQ, row0, fq, rs);
    }
    static constexpr bool PERM = true, AFTER_DRAIN = false;
    const float* SSQ; const float* RINV; const float* LB; bf16_t *Qh, *IV, *GS, *U; unsigned short* LOGF;
    DI void operator()(const f32x4 (&acc)[2][2][4][2], const Unit& u, int wr, int wc, int fr, int fq, const Pre& pre) const {
        const int seg = u.pn >> 1, cb = (u.pn & 1) * 256 + wc * 32 + 8 * fq, row0 = u.pm * 256 + wr * 64 + fr;
        unsigned short* dst = seg == 0 ? Qh : seg == 1 ? LOGF : seg == 2 ? IV : seg == 3 ? GS : U;
        float rs[2][4]; scales(pre, row0, fq, rs);
        f32x4 lbv[2][2];
#pragma unroll
        for (int bj = 0; bj < 2; ++bj)
#pragma unroll
            for (int n = 0; n < 2; ++n) lbv[bj][n] = *(const f32x4*)(LB + cb + bj * 128 + 4 * n);
#pragma unroll
        for (int ai = 0; ai < 2; ++ai)
#pragma unroll
            for (int m = 0; m < 4; ++m) { const int row = row0 + ai * 128 + m * 16; const float r = rs[ai][m];
#pragma unroll
                for (int bj = 0; bj < 2; ++bj) { u32x4v o; unsigned w[4];
#pragma unroll
                    for (int n = 0; n < 2; ++n) { f32x4 v = acc[ai][bj][m][n] * r;
                        if (seg == 1) { const f32x4 lb = lbv[bj][n]; f32x4 f;
#pragma unroll
                            for (int e = 0; e < 4; ++e) f[e] = __logf(lb[e] + (1.f - lb[e]) * sigm(v[e]));
                            w[2 * n] = pkh2(f[0], f[1]); w[2 * n + 1] = pkh2(f[2], f[3]); }
                        else { if (seg == 3) {
#pragma unroll
                                for (int e = 0; e < 4; ++e) v[e] = v[e] * sigm(v[e]); }
                            w[2 * n] = pk2(v[0], v[1]); w[2 * n + 1] = pk2(v[2], v[3]); } }
                    o.x = w[0]; o.y = w[1]; o.z = w[2]; o.w = w[3];
                    *(u32x4v*)(dst + (size_t)row * 512 + cb + bj * 128) = o; } }
    }
};
struct EpiGlu {
    struct Pre {}; DI void prefetch(Pre&, const Unit&, int, int) const {}
    static constexpr bool PERM = true, AFTER_DRAIN = false;
    const bf16_t* YG; bf16_t* CAT;
    DI void operator()(const f32x4 (&acc)[2][2][4][2], const Unit& u, int wr, int wc, int fr, int fq, const Pre& pre) const {
        const int cb = u.pn * 256 + wc * 32 + 8 * fq, row0 = u.pm * 256 + wr * 64 + fr;
#pragma unroll
        for (int ai = 0; ai < 2; ++ai) {
            u32x4v y[4][2];
#pragma unroll
            for (int m = 0; m < 4; ++m)
#pragma unroll
                for (int bj = 0; bj < 2; ++bj) y[m][bj] = *(const u32x4v*)(YG + (size_t)(row0 + ai * 128 + m * 16) * 512 + cb + bj * 128);
#pragma unroll
            for (int m = 0; m < 4; ++m) { const int row = row0 + ai * 128 + m * 16;
#pragma unroll
                for (int bj = 0; bj < 2; ++bj) { const f32x4 v0 = acc[ai][bj][m][0], v1 = acc[ai][bj][m][1]; const u32x4v yy = y[m][bj]; u32x4v o;
                    o.x = pk2(bflo(yy.x) * sigm(v0[0]), bfhi(yy.x) * sigm(v0[1])); o.y = pk2(bflo(yy.y) * sigm(v0[2]), bfhi(yy.y) * sigm(v0[3]));
                    o.z = pk2(bflo(yy.z) * sigm(v1[0]), bfhi(yy.z) * sigm(v1[1])); o.w = pk2(bflo(yy.w) * sigm(v1[2]), bfhi(yy.w) * sigm(v1[3]));
                    *(u32x4v*)(CAT + (size_t)row * 1024 + 512 + cb + bj * 128) = o; } } }
    }
};
struct EpiRes {
    struct Pre {}; DI void prefetch(Pre&, const Unit&, int, int) const {}
    static constexpr bool PERM = true, AFTER_DRAIN = false;
    bf16_t* XB; float* SSQ;
    DI float upd(u32x4v* px, const u32x4v x, const f32x4 v0, const f32x4 v1) const {
        u32x4v o; o.x = pk2(bflo(x.x) + v0[0], bfhi(x.x) + v0[1]); o.y = pk2(bflo(x.y) + v0[2], bfhi(x.y) + v0[3]);
        o.z = pk2(bflo(x.z) + v1[0], bfhi(x.z) + v1[1]); o.w = pk2(bflo(x.w) + v1[2], bfhi(x.w) + v1[3]); *px = o;
        const float a0 = bflo(o.x), a1 = bfhi(o.x), a2 = bflo(o.y), a3 = bfhi(o.y), a4 = bflo(o.z), a5 = bfhi(o.z), a6 = bflo(o.w), a7 = bfhi(o.w);
        return ((a0 * a0 + a1 * a1) + (a2 * a2 + a3 * a3)) + ((a4 * a4 + a5 * a5) + (a6 * a6 + a7 * a7));
    }
    DI void row(const f32x4 (&a4)[2][2], const Unit& u, int ai, int m, int wr, int wc, int fr, int fq) const {
        const int cb = u.pn * 256 + wc * 32 + 8 * fq, row = u.pm * 256 + wr * 64 + fr + ai * 128 + m * 16;
        u32x4v* p0 = (u32x4v*)(XB + (size_t)row * 1024 + cb); u32x4v* p1 = (u32x4v*)(XB + (size_t)row * 1024 + cb + 128);
        const u32x4v x0 = *p0, x1 = *p1;
        float ss = upd(p0, x0, a4[0][0], a4[0][1]) + upd(p1, x1, a4[1][0], a4[1][1]);
        ss += __shfl_xor(ss, 16); ss += __shfl_xor(ss, 32);
        if (fq == 0) SSQ[(size_t)row * 16 + u.pn * 4 + wc] = ss;
    }
    DI void operator()(const f32x4 (&acc)[2][2][4][2], const Unit& u, int wr, int wc, int fr, int fq, const Pre& pre) const {
        const int cb = u.pn * 256 + wc * 32 + 8 * fq, row0 = u.pm * 256 + wr * 64 + fr;
#pragma unroll
        for (int ai = 0; ai < 2; ++ai) {
            u32x4v x[4][2];
#pragma unroll
            for (int m = 0; m < 4; ++m)
#pragma unroll
                for (int bj = 0; bj < 2; ++bj) x[m][bj] = *(const u32x4v*)(XB + (size_t)(row0 + ai * 128 + m * 16) * 1024 + cb + bj * 128);
#pragma unroll
            for (int m = 0; m < 4; ++m) { const int row = row0 + ai * 128 + m * 16;
                float ss = upd((u32x4v*)(XB + (size_t)row * 1024 + cb), x[m][0], acc[ai][0][m][0], acc[ai][0][m][1])
                         + upd((u32x4v*)(XB + (size_t)row * 1024 + cb + 128), x[m][1], acc[ai][1][m][0], acc[ai][1][m][1]);
                ss += __shfl_xor(ss, 16); ss += __shfl_xor(ss, 32);
                if (fq == 0) SSQ[(size_t)row * 16 + u.pn * 4 + wc] = ss; } }
    }
};
struct EpiUp {
    struct Pre { float r[2][4]; };
    DI void prefetch(Pre& pre, const Unit& u, int wr, int fr) const { const int row0 = u.pm * 256 + wr * 64 + fr;
#pragma unroll
        for (int ai = 0; ai < 2; ++ai)
#pragma unroll
            for (int m = 0; m < 4; ++m) pre.r[ai][m] = RINV[row0 + ai * 128 + m * 16]; }
    DI void scales(const Pre& pre, int row0, int fq, float (&rs)[2][4]) const {
        if (pre.r[0][0] > 0.f) {
#pragma unroll
            for (int ai = 0; ai < 2; ++ai)
#pragma unroll
                for (int m = 0; m < 4; ++m) rs[ai][m] = pre.r[ai][m]; }
        else rinv8(SSQ, row0, fq, rs);
    }
    static constexpr bool PERM = true, AFTER_DRAIN = false;
    const float* SSQ; const float* RINV; bf16_t* H;
    DI void operator()(const f32x4 (&acc)[2][2][4][2], const Unit& u, int wr, int wc, int fr, int fq, const Pre& pre) const {
        const int cb = u.pn * 256 + wc * 32 + 8 * fq, row0 = u.pm * 256 + wr * 64 + fr;
        float rs[2][4]; scales(pre, row0, fq, rs);
#pragma unroll
        for (int ai = 0; ai < 2; ++ai)
#pragma unroll
            for (int m = 0; m < 4; ++m) { const int row = row0 + ai * 128 + m * 16; const float r = rs[ai][m];
#pragma unroll
                for (int bj = 0; bj < 2; ++bj) { f32x4 v0 = acc[ai][bj][m][0] * r, v1 = acc[ai][bj][m][1] * r;
#pragma unroll
                    for (int e = 0; e < 4; ++e) { const float t0 = fmaxf(v0[e], 0.f), t1 = fmaxf(v1[e], 0.f); v0[e] = t0 * t0; v1[e] = t1 * t1; }
                    u32x4v o; o.x = pk2(v0[0], v0[1]); o.y = pk2(v0[2], v0[3]); o.z = pk2(v1[0], v1[1]); o.w = pk2(v1[2], v1[3]);
                    *(u32x4v*)(H + (size_t)row * 4096 + cb + bj * 128) = o; } }
    }
};
DI size_t kf_index(int seqh, int nkt, int key, int d) { return ((((size_t)seqh * nkt + (key >> 5)) * 8 + (d >> 4)) * 64 + ((key & 31) + 32 * ((d >> 3) & 1))) * 8 + (d & 7); }
DI size_t vf_index(int seqh, int nkt, int key, int d) { const int kk = key & 31;
    return ((((size_t)seqh * nkt + (key >> 5)) * 8 + (kk >> 4) * 4 + (d >> 5)) * 64 + ((d & 31) + 32 * ((kk >> 2) & 1))) * 8 + ((kk >> 3) & 1) * 4 + (kk & 3); }
struct EpiQkv {
    struct Pre { float r[2][4]; };
    DI void prefetch(Pre& pre, const Unit& u, int wr, int fr) const { const int row0 = u.pm * 256 + wr * 64 + fr;
#pragma unroll
        for (int ai = 0; ai < 2; ++ai)
#pragma unroll
            for (int m = 0; m < 4; ++m) pre.r[ai][m] = RINV[row0 + ai * 128 + m * 16]; }
    DI void scales(const Pre& pre, int row0, int fq, float (&rs)[2][4]) const {
        if (pre.r[0][0] > 0.f) {
#pragma unroll
            for (int ai = 0; ai < 2; ++ai)
#pragma unroll
                for (int m = 0; m < 4; ++m) rs[ai][m] = pre.r[ai][m]; }
        else rinv8(SSQ, row0, fq, rs);
    }
    static constexpr bool PERM = true, AFTER_DRAIN = false;
    const float* SSQ; const float* RINV; float* out; bf16_t *Q, *KP, *KS, *VTP, *VTS; LAS unsigned char* scr;
    DI void operator()(const f32x4 (&acc)[2][2][4][2], const Unit& u, int wr, int wc, int fr, int fq, const Pre& pre) const {
        const int third = u.pn >> 2, cb = (u.pn & 3) * 256 + wc * 32 + 8 * fq, row0 = u.pm * 256 + wr * 64 + fr;
        float rs[2][4]; scales(pre, row0, fq, rs);
        if (third == 2) {
            LAS unsigned char* ws = scr + (wr * 4 + wc) * 1024; const int ln = fr + 16 * fq, dl = ln & 31, hf = ln >> 5;
            LAS unsigned char* wsw = ws + fr * 64 + fq * 16; const LAS unsigned char* wsr = ws + hf * 256 + dl * 2;
#pragma unroll
            for (int ai = 0; ai < 2; ++ai)
#pragma unroll
                for (int m = 0; m < 4; ++m) { const int row = row0 + ai * 128 + m * 16; const float r = rs[ai][m];
                    const bool smp = row >= NTP; const int s = row - NTP; const int b = smp ? (s >> 6) : row / TP, key = smp ? 1024 + (s & 63) : row - b * TP, nkt = smp ? 34 : 129;
#pragma unroll
                    for (int bj = 0; bj < 2; ++bj) { const int cs = cb + bj * 128; const f32x4 v0 = acc[ai][bj][m][0] * r, v1 = acc[ai][bj][m][1] * r;
                        if (row < NT) { const int h = cs >> 7, d = cs & 127;
                            float* ov = out + (smp ? O_VS + (size_t)s * 1024 : O_VP + (size_t)row * 1024) + cs; *(f32x4*)ov = v0; *(f32x4*)(ov + 4) = v1;
                            u32x4v o; o.x = pk2(v0[0], v0[1]); o.y = pk2(v0[2], v0[3]); o.z = pk2(v1[0], v1[1]); o.w = pk2(v1[2], v1[3]);
                            *(LAS u32x4v*)wsw = o;
                            asm volatile("s_waitcnt lgkmcnt(0)" ::: "memory");
                            u32x4v t;
                            t.x = (unsigned)*(const LAS unsigned short*)(wsr) | ((unsigned)*(const LAS unsigned short*)(wsr + 64) << 16);
                            t.y = (unsigned)*(const LAS unsigned short*)(wsr + 128) | ((unsigned)*(const LAS unsigned short*)(wsr + 192) << 16);
                            t.z = (unsigned)*(const LAS unsigned short*)(wsr + 512) | ((unsigned)*(const LAS unsigned short*)(wsr + 576) << 16);
                            t.w = (unsigned)*(const LAS unsigned short*)(wsr + 640) | ((unsigned)*(const LAS unsigned short*)(wsr + 704) << 16);
                            *(u32x4v*)((smp ? VTS : VTP) + vf_index(b * 8 + h, nkt, key - fr, d & ~31) + ln * 8) = t;
                            asm volatile("s_waitcnt lgkmcnt(0)" ::: "memory"); } } }
            return; }
#pragma unroll
        for (int ai = 0; ai < 2; ++ai)
#pragma unroll
            for (int m = 0; m < 4; ++m) { const int row = row0 + ai * 128 + m * 16; const float r = rs[ai][m];
                const bool smp = row >= NTP; const int s = row - NTP; const int b = smp ? (s >> 6) : row / TP, key = smp ? 1024 + (s & 63) : row - b * TP, nkt = smp ? 34 : 129;
#pragma unroll
                for (int bj = 0; bj < 2; ++bj) { const int cs = cb + bj * 128; const f32x4 v0 = acc[ai][bj][m][0] * r, v1 = acc[ai][bj][m][1] * r;
                    u32x4v o; o.x = pk2(v0[0], v0[1]); o.y = pk2(v0[2], v0[3]); o.z = pk2(v1[0], v1[1]); o.w = pk2(v1[2], v1[3]);
                    if (third == 0) { *(u32x4v*)(Q + (size_t)row * 1024 + cs) = o; }
                    else if (row < NT) { const int h = cs >> 7, d = cs & 127;
                        float* ok = out + (smp ? O_KS + (size_t)s * 1024 : O_KP + (size_t)row * 1024) + cs; *(f32x4*)ok = v0; *(f32x4*)(ok + 4) = v1;
                        *(u32x4v*)((smp ? KS : KP) + kf_index(b * 8 + h, nkt, key, d)) = o; } } }
    }
};
struct EpiFin {
    struct Pre {}; DI void prefetch(Pre&, const Unit&, int, int) const {}
    static constexpr bool PERM = false, AFTER_DRAIN = false;
    const bf16_t* XB; float* SSQ; float* out;
    DI void row(const f32x4 (&a4)[2][2], const Unit& u, int ai, int m, int wr, int wc, int fr, int fq) const {
        const int cb = u.pn * 256 + wc * 32 + 4 * fq, row = u.pm * 256 + wr * 64 + fr + ai * 128 + m * 16; float ss = 0.f;
        const int b = row / TP, t = row - b * TP; const bool ok = row < NT && (row >= NTP || t >= 16);
        float* dst = out + (row >= NTP ? O_YS + (size_t)(row - NTP) * 1024 : O_YP + ((size_t)b * 4096 + (t - 16)) * 1024);
#pragma unroll
        for (int bj = 0; bj < 2; ++bj)
#pragma unroll
            for (int n = 0; n < 2; ++n) { const int cs = cb + bj * 128 + n * 16; f32x4 v = a4[bj][n];
                const u32x2 x = *(const u32x2*)(XB + (size_t)row * 1024 + cs);
                v[0] += bflo(x.x); v[1] += bfhi(x.x); v[2] += bflo(x.y); v[3] += bfhi(x.y);
                if (ok) *(f32x4*)(dst + cs) = v;
                ss += (v[0] * v[0] + v[1] * v[1]) + (v[2] * v[2] + v[3] * v[3]); }
        ss += __shfl_xor(ss, 16); ss += __shfl_xor(ss, 32);
        if (fq == 0) SSQ[(size_t)row * 16 + u.pn * 4 + wc] = ss;
    }
    DI void operator()(const f32x4 (&acc)[2][2][4][2], const Unit& u, int wr, int wc, int fr, int fq, const Pre& pre) const {
        const int cb = u.pn * 256 + wc * 32 + 4 * fq, row0 = u.pm * 256 + wr * 64 + fr;
#pragma unroll
        for (int ai = 0; ai < 2; ++ai) {
            u32x2 x[4][2][2];
#pragma unroll
            for (int m = 0; m < 4; ++m)
#pragma unroll
                for (int bj = 0; bj < 2; ++bj)
#pragma unroll
                    for (int n = 0; n < 2; ++n) x[m][bj][n] = *(const u32x2*)(XB + (size_t)(row0 + ai * 128 + m * 16) * 1024 + cb + bj * 128 + n * 16);
#pragma unroll
            for (int m = 0; m < 4; ++m) { const int row = row0 + ai * 128 + m * 16; float ss = 0.f;
                const int b = row / TP, t = row - b * TP; const bool ok = row < NT && (row >= NTP || t >= 16);
                float* dst = out + (row >= NTP ? O_YS + (size_t)(row - NTP) * 1024 : O_YP + ((size_t)b * 4096 + (t - 16)) * 1024);
#pragma unroll
                for (int bj = 0; bj < 2; ++bj)
#pragma unroll
                    for (int n = 0; n < 2; ++n) { const int cs = cb + bj * 128 + n * 16; f32x4 v = acc[ai][bj][m][n]; const u32x2 xx = x[m][bj][n];
                        v[0] += bflo(xx.x); v[1] += bfhi(xx.x); v[2] += bflo(xx.y); v[3] += bfhi(xx.y);
                        if (ok) *(f32x4*)(dst + cs) = v;
                        ss += (v[0] * v[0] + v[1] * v[1]) + (v[2] * v[2] + v[3] * v[3]); }
                ss += __shfl_xor(ss, 16); ss += __shfl_xor(ss, 32);
                if (fq == 0) SSQ[(size_t)row * 16 + u.pn * 4 + wc] = ss; } }
    }
};
template <class Epi> DI void run_gemm(LAS unsigned char* lds, const bf16_t* A, const bf16_t* Bt, int N, int K, const Epi& E) {
    pg8::Gemm g; g.A = A; g.Bt = Bt; g.M = MP; g.N = N; g.K = K; g.part = nullptr;
    pg8::StaticOrder S; S.init(MP, N, (int)gridDim.x, (int)blockIdx.x);
    pg8::gemm_phase<Epi, pg8::StaticOrder>(lds, g, S, E);
}
struct SplitOrder : pg8::StaticOrder {
    int nwhole, ntail, S, nks;
    DI void init2(int N, int K) { init(MP, N, (int)gridDim.x, (int)blockIdx.x); nwhole = nwg / G; ntail = nwg - nwhole * G; S = 0; nks = 0;
        if (ntail > 0) { int s = G / ntail; const int nkt = K / 64; while (s > 1 && (nkt % s != 0 || (nkt / s) < 4 || ((nkt / s) & 1))) --s; if (s > 1) { S = s; nks = nkt / s; } } }
    DI bool next(int i, Unit& u) const {
        if (S == 0) return pg8::StaticOrder::next(i, u);
        if (i < nwhole) { map(i * G + c, u); return true; }
        if (i == nwhole && c < ntail * S) { map(nwhole * G + c / S, u); u.kb = (c % S) * nks; u.nk = nks; u.part = c; return true; }
        return false;
    }
};
template <class Epi> DI void run_gemm_split(LAS unsigned char* lds, const bf16_t* A, const bf16_t* Bt, int N, int K, const Epi& E, float* part) {
    pg8::Gemm g; g.A = A; g.Bt = Bt; g.M = MP; g.N = N; g.K = K; g.part = part;
    SplitOrder S; S.init2(N, K);
    pg8::gemm_phase<Epi, SplitOrder>(lds, g, S, E);
}
template <class Epi> DI void gemm_fixup(int N, int K, const Epi& E, const float* part, int tid) {
    SplitOrder S; S.init2(N, K); if (S.S == 0) return;
    asm volatile("" : "+v"(tid));
    const int wid = tid >> 6, lane = tid & 63, wr = wid >> 2, wc = wid & 3, fr = lane & 15, fq = lane >> 4;
    for (int it = blockIdx.x; it < S.ntail * 8; it += gridDim.x) { const int j = it >> 3, ai = (it >> 2) & 1, m = it & 3; Unit u; S.map(S.nwhole * S.G + j, u);
        f32x4 a4[2][2];
#pragma unroll
        for (int b = 0; b < 2; ++b)
#pragma unroll
            for (int n = 0; n < 2; ++n) { const f32x4* pp = (const f32x4*)part + ((size_t)(j * S.S) * 32 + (((ai * 2 + b) * 4 + m) * 2 + n)) * 512 + tid;
                f32x4 v0 = {0.f, 0.f, 0.f, 0.f}, v1 = v0, v2 = v0, v3 = v0;
                for (int sl = 0; sl + 3 < S.S; sl += 4) { v0 += pp[(size_t)sl * 16384]; v1 += pp[(size_t)(sl + 1) * 16384]; v2 += pp[(size_t)(sl + 2) * 16384]; v3 += pp[(size_t)(sl + 3) * 16384]; }
                for (int sl = S.S & ~3; sl < S.S; ++sl) v0 += pp[(size_t)sl * 16384];
                a4[b][n] = (v0 + v1) + (v2 + v3); }
        E.row(a4, u, ai, m, wr, wc, fr, fq); }
}
DI void rinv_pass(const Prm& p, int K, int tid) {
    SplitOrder S; S.init2(1024, K);
    for (int pm = blockIdx.x; pm < MP / 256; pm += gridDim.x) {
        bool tail = false;
        if (S.S) for (int j = 0; j < S.ntail; ++j) { Unit u; S.map(S.nwhole * S.G + j, u); tail = tail || (u.pm == pm); }
        if (tid < 256) { const int row = pm * 256 + tid; float v = -1.f;
            if (!tail) { const f32x4* q = (const f32x4*)(p.SSQ + (size_t)row * 16); const f32x4 a = q[0] + q[1] + q[2] + q[3]; v = rsqrtf(((a.x + a.y) + (a.z + a.w)) * (1.f / 1024.f) + EPSN); }
            if (row >= NT) v = 1.f;
            p.RINV[row] = v; }
    }
}
DI void transpose_item(const float* W, int N, bf16_t* WT, size_t ldo, const float* sc, LAS float* scr, int item, int lane) {
    const int nblk = N / 32, kb = item / nblk, nb = item % nblk, k0 = 64 * kb, n0 = 32 * nb;
#pragma unroll 8
    for (int i = 0; i < 32; ++i) { const int kk = 2 * i + (lane >> 5); float w = W[(size_t)(k0 + kk) * N + n0 + (lane & 31)]; if (sc) w *= sc[k0 + kk]; scr[kk * 33 + (lane & 31)] = w; }
    LDS_WAIT();
    const int c = lane & 7;
#pragma unroll
    for (int j = 0; j < 4; ++j) { const int n = (lane >> 3) + 8 * j; const LAS float* s = scr + (8 * c) * 33 + n;
        u32x4v o; o.x = pk2(s[0 * 33], s[1 * 33]); o.y = pk2(s[2 * 33], s[3 * 33]); o.z = pk2(s[4 * 33], s[5 * 33]); o.w = pk2(s[6 * 33], s[7 * 33]);
        *(u32x4v*)(WT + (size_t)(n0 + n) * ldo + k0 + 8 * c) = o; }
    LDS_WAIT();
}
DI void s5_pow(const Prm& p, int g, int n, float k, float& re, float& im) {
    const float dt = __expf(p.log_dt[g]), ar = p.a_re[g * 64 + n], ai = p.a_im[g * 64 + n];
    const float mag = __expf(k * dt * ar); float rev = k * dt * ai * 0.15915494309189535f; rev -= rintf(rev);
    re = mag * __builtin_amdgcn_cosf(rev); im = mag * __builtin_amdgcn_sinf(rev);
}
DI void s5_bbar(const Prm& p, int g, int n, int pp, float& re, float& im) {
    const float ar = p.a_re[g * 64 + n], ai = p.a_im[g * 64 + n]; float abr, abi; s5_pow(p, g, n, 1.f, abr, abi);
    const float den = ar * ar + ai * ai, zr = ((abr - 1.f) * ar + abi * ai) / den, zi = (abi * ar - (abr - 1.f) * ai) / den;
    const float br = p.b_re[(g * 64 + n) * 16 + pp], bi = p.b_im[(g * 64 + n) * 16 + pp];
    re = zr * br - zi * bi; im = zr * bi + zi * br;
}
DI void phase_prologue(const Prm& p, LAS unsigned char* lds, int tid, int lane, int wave) {
    const int gw = blockIdx.x * 8 + wave, NGW = gridDim.x * 8, gtid = blockIdx.x * 512 + tid, GT = gridDim.x * 512;
    LAS float* scr = (LAS float*)(lds + wave * 16384);
    constexpr int I1 = 16 * 80, I2 = 8 * 16, I3 = 16 * 32, I4 = 16 * 128, I5 = 64 * 32, I6 = 16 * 96;
    constexpr int NITEMS = I1 + I2 + I3 + I4 + I5 + I6 + I3 + I4 + I5;
    for (int it = gw; it < NITEMS; it += NGW) {
        int r = it;
        if (r < I1) { transpose_item(p.w_in_even, 2560, p.Wt1, 1024, p.ln_mix, scr, r, lane); continue; } r -= I1;
        if (r < I2) { transpose_item(p.w_glu, 512, p.Wglu, 512, nullptr, scr, r, lane); continue; } r -= I2;
        if (r < I3) { transpose_item(p.w_out_even, 1024, p.Wo0, 1024, nullptr, scr, r, lane); continue; } r -= I3;
        if (r < I4) { transpose_item(p.w_up, 4096, p.Wup0, 1024, p.ln_mlp, scr, r, lane); continue; } r -= I4;
        if (r < I5) { transpose_item(p.w_down, 1024, p.Wdn0, 4096, nullptr, scr, r, lane); continue; } r -= I5;
        if (r < I6) { transpose_item(p.w_in_odd, 3072, p.Wqkv, 1024, p.ln_mix + 1024, scr, r, lane); continue; } r -= I6;
        if (r < I3) { transpose_item(p.w_out_odd, 1024, p.Wo1, 1024, nullptr, scr, r, lane); continue; } r -= I3;
        if (r < I4) { transpose_item(p.w_up + (size_t)1024 * 4096, 4096, p.Wup1, 1024, p.ln_mlp + 1024, scr, r, lane); continue; } r -= I4;
        transpose_item(p.w_down + (size_t)4096 * 1024, 1024, p.Wdn1, 4096, nullptr, scr, r, lane);
    }
    for (int row = gw; row < NT; row += NGW) {
        const float* src;
        if (row < NTP) { const int b = row / TP, t = row - b * TP; src = t < 16 ? p.meta + (size_t)t * 1024 : p.x_prompt + ((size_t)b * 4096 + (t - 16)) * 1024; }
        else src = p.x_sample + (size_t)(row - NTP) * 1024;
        float ss = 0.f;
#pragma unroll
        for (int j = 0; j < 4; ++j) { const f32x4 v = ((const f32x4*)src)[lane + 64 * j]; u32x2 o; o.x = pk2(v.x, v.y); o.y = pk2(v.z, v.w);
            const float a0 = bflo(o.x), a1 = bfhi(o.x), a2 = bflo(o.y), a3 = bfhi(o.y); ss += (a0 * a0 + a1 * a1) + (a2 * a2 + a3 * a3);
            ((u32x2*)(p.XB + (size_t)row * 1024))[lane + 64 * j] = o; }
        ss = wave_sum(ss);
        if (lane < 16) p.SSQ[(size_t)row * 16 + lane] = lane == 0 ? ss : 0.f;
        if (lane == 0) p.RINV[row] = rsqrtf(ss * (1.f / 1024.f) + EPSN);
    }
    if (gtid < MP - NT) p.RINV[NT + gtid] = 1.f;
    if (gtid < 512) p.LB[gtid] = 1.f / (1.f + __expf(p.hgrn_lb[512 + gtid] - p.hgrn_lb[gtid]));
    __syncthreads();
    {
        LAS float* zr_ = (LAS float*)lds; LAS float* zi_ = zr_ + 64; LAS float* wr_ = zi_ + 64; LAS float* wi_ = wr_ + 64;
        LAS float* bbr = wi_ + 64; LAS float* bbi = bbr + 1024; LAS float* cwr = bbi + 1024; LAS float* cwi = cwr + 16 * 65;
        for (int pair = blockIdx.x; pair < 512; pair += gridDim.x) { const int g = pair >> 4, tau = pair & 15;
            if (tid < 64) { const int n = tid; const float ar = p.a_re[g * 64 + n], ai = p.a_im[g * 64 + n]; float abr, abi; s5_pow(p, g, n, 1.f, abr, abi);
                const float den = ar * ar + ai * ai; zr_[n] = ((abr - 1.f) * ar + abi * ai) / den; zi_[n] = (abi * ar - (abr - 1.f) * ai) / den;
                float a, b; s5_pow(p, g, n, (float)tau, a, b); wr_[n] = a; wi_[n] = b; }
            __syncthreads();
#pragma unroll
            for (int k = 0; k < 2; ++k) { const int e = tid + 512 * k;
                { const int n = e >> 4; const float br = p.b_re[g * 1024 + e], bi = p.b_im[g * 1024 + e]; bbr[e] = zr_[n] * br - zi_[n] * bi; bbi[e] = zr_[n] * bi + zi_[n] * br; }
                { const int pch = e >> 6, n = e & 63; const float cr = p.c_re[g * 1024 + e], ci = p.c_im[g * 1024 + e]; cwr[pch * 65 + n] = cr * wr_[n] - ci * wi_[n]; cwi[pch * 65 + n] = cr * wi_[n] + ci * wr_[n]; } }
            __syncthreads();
            if (tid < 256) { const int pch = tid >> 4, pp = tid & 15; float acc = 0.f;
#pragma unroll 8
                for (int n = 0; n < 64; ++n) acc += cwr[pch * 65 + n] * bbr[n * 16 + pp] - cwi[pch * 65 + n] * bbi[n * 16 + pp];
                if (tau == 0 && pch == pp) acc += p.ssm_d[g * 16 + pch];
                const bf16_t kv = f2bf(acc);
                p.TG[((g * 16 + tau) * 16 + pch) * 16 + pp] = kv; }
            __syncthreads(); }
    }
    for (int i = gtid; i < 32 * 256 * 64; i += GT) {
        const int g = i >> 14, t = (i >> 10) & 15, pch = (i >> 6) & 15, n = i & 63; float wr_, wi_; s5_pow(p, g, n, (float)(t + 1), wr_, wi_);
        const float cr = p.c_re[(g * 16 + pch) * 64 + n], ci = p.c_im[(g * 16 + pch) * 64 + n];
        *(unsigned*)(p.TG + 131072 + ((size_t)(g * 256 + t * 16 + pch)) * 128 + 2 * n) = pk2(cr * wr_ - ci * wi_, -(cr * wi_ + ci * wr_)); }
    for (int i = gtid; i < 32 * 64 * 256; i += GT) {
        const int g = i >> 14, n = (i >> 8) & 63, s = (i >> 4) & 15, pp = i & 15; float wr_, wi_, br_, bi_; s5_pow(p, g, n, (float)(15 - s), wr_, wi_); s5_bbar(p, g, n, pp, br_, bi_);
        p.HT[((size_t)(g * 128 + 2 * n)) * 256 + s * 16 + pp] = f2bf(wr_ * br_ - wi_ * bi_);
        p.HT[((size_t)(g * 128 + 2 * n + 1)) * 256 + s * 16 + pp] = f2bf(wr_ * bi_ + wi_ * br_); }
    if (gtid < 2048) { float wr_, wi_; s5_pow(p, gtid >> 6, gtid & 63, 16.f, wr_, wi_); p.A16[2 * gtid] = wr_; p.A16[2 * gtid + 1] = wi_; }
}

constexpr int HP = 136, TPI = 72;
constexpr int L_QT = 0, L_QH = 17408, L_KT = 34816, L_KTT = 52224, L_IVT = 70656, L_ATT = 89088, L_SUM = 98304, L_VEC = 100352, L_OB = 0  ;
struct HItem { int row0, L, h, bh; };
DI HItem hgrn_item(int item) {
    HItem it;
    if (item < 2080) { const int bh = item / 65, c = item - bh * 65, b = bh >> 2; it.h = bh & 3; it.bh = bh; it.L = c == 0 ? 16 : 64; it.row0 = b * TP + (c == 0 ? 0 : 16 + 64 * (c - 1)); }
    else { const int s = item - 2080, b = s >> 2; it.h = s & 3; it.bh = 32 + s; it.L = 64; it.row0 = NTP + b * 64; }
    return it;
}
template <bool FULL> DI void hgrn_loadraw(const Prm& p, const HItem& it, int tid, unsigned (&rl)[16], unsigned (&rv)[16], unsigned (&rq)[16]) {
    const int d = tid & 127, t0 = 16 * (tid >> 7), col = it.h * 128 + d;
#pragma unroll
    for (int j = 0; j < 16; ++j) { const int t = t0 + j; const bool valid = t < it.L; const size_t o = (size_t)(it.row0 + t) * 512 + col;
        rl[j] = valid ? (unsigned)p.LOGF[o] : 0u; rv[j] = valid ? (unsigned)p.IV[o] : 0u; if (FULL) rq[j] = valid ? (unsigned)p.Qh[o] : 0u; }
}
template <bool FULL> DI void hgrn_prep(const HItem& it, LAS unsigned char* lds, int tid, const unsigned (&rl)[16], const unsigned (&rv)[16], const unsigned (&rq)[16]) {
    const int d = tid & 127, tq = tid >> 7, t0 = 16 * tq;
    LAS float* sums = (LAS float*)(lds + L_SUM); LAS float* vec = (LAS float*)(lds + L_VEC);
    float cs[16], lf[16];
    float run = 0.f;
#pragma unroll
    for (int j = 0; j < 16; ++j) { lf[j] = h2f((unsigned short)rl[j]); run += lf[j]; cs[j] = run; }
    sums[tq * 128 + d] = run;
    { LAS u32x4v* dst = (LAS u32x4v*)(lds + L_IVT + (d * TPI + t0) * 2); u32x4v a, b;
        a.x = rv[0] | (rv[1] << 16); a.y = rv[2] | (rv[3] << 16); a.z = rv[4] | (rv[5] << 16); a.w = rv[6] | (rv[7] << 16);
        b.x = rv[8] | (rv[9] << 16); b.y = rv[10] | (rv[11] << 16); b.z = rv[12] | (rv[13] << 16); b.w = rv[14] | (rv[15] << 16); dst[0] = a; dst[1] = b; }
    __syncthreads();
    const float s0 = sums[d], s1 = sums[128 + d], s2 = sums[256 + d], s3 = sums[384 + d];
    const float off = tq == 0 ? 0.f : tq == 1 ? s0 : tq == 2 ? s0 + s1 : s0 + s1 + s2, r = s0 + s1, bL = r + s2 + s3;
    if (tq == 0) { vec[d] = r; vec[128 + d] = bL; }
    unsigned ktp[8]; float kprev = 0.f;
#pragma unroll
    for (int j = 0; j < 16; ++j) { const int t = t0 + j; const bool valid = t < it.L; const float b = off + cs[j];
        const float kt = valid ? (1.f - __expf(lf[j])) * __expf(r - b) : 0.f;
        if (j & 1) ktp[j >> 1] = pk2(kprev, kt); else kprev = kt;
        if (FULL) { const float qv = bf2f((unsigned short)rq[j]);
            *(LAS unsigned short*)(lds + L_KT + (t * HP + d) * 2) = f2bf(kt);
            *(LAS unsigned short*)(lds + L_QT + (t * HP + d) * 2) = f2bf(qv * __expf(b - r));
            *(LAS unsigned short*)(lds + L_QH + (t * HP + d) * 2) = f2bf(qv * __expf(b)); } }
    if (!FULL) { LAS u32x4v* dst = (LAS u32x4v*)(lds + L_KTT + (d * TPI + t0) * 2); u32x4v a, b; a.x = ktp[0]; a.y = ktp[1]; a.z = ktp[2]; a.w = ktp[3]; b.x = ktp[4]; b.y = ktp[5]; b.z = ktp[6]; b.w = ktp[7]; dst[0] = a; dst[1] = b; }
    __syncthreads();
}
#define MFMA16(a, b, c) __builtin_amdgcn_mfma_f32_16x16x32_bf16((a), (b), (c), 0, 0, 0)
#define MFMA32(a, b, c) __builtin_amdgcn_mfma_f32_32x32x16_bf16((a), (b), (c), 0, 0, 0)
DI void hgrn_b1_all(const Prm& p, LAS unsigned char* lds, int tid, int lane, int wave) {
    const int fr = lane & 15, fq = lane >> 4;
    int item = blockIdx.x; if (item >= NITEM_H) return;
    unsigned rl[16], rv[16], rq[16];
    hgrn_loadraw<false>(p, hgrn_item(item), tid, rl, rv, rq);
    while (item < NITEM_H) {
        const HItem it = hgrn_item(item);
        hgrn_prep<false>(it, lds, tid, rl, rv, rq);
        const int next = item + gridDim.x;
        if (next < NITEM_H) hgrn_loadraw<false>(p, hgrn_item(next), tid, rl, rv, rq);
        const LAS float* vec = (const LAS float*)(lds + L_VEC);
        bf16x8 a[2];
#pragma unroll
        for (int ks = 0; ks < 2; ++ks) a[ks] = *(const LAS bf16x8*)(lds + L_KTT + ((16 * wave + fr) * TPI + 32 * ks + 8 * fq) * 2);
        float e2[4];
#pragma unroll
        for (int j = 0; j < 4; ++j) { const int d = 16 * wave + 4 * fq + j; e2[j] = __expf(vec[128 + d] - vec[d]); }
#pragma unroll
        for (int vt = 0; vt < 8; ++vt) { f32x4 acc = {0.f, 0.f, 0.f, 0.f};
#pragma unroll
            for (int ks = 0; ks < 2; ++ks) { const bf16x8 b = *(const LAS bf16x8*)(lds + L_IVT + ((16 * vt + fr) * TPI + 32 * ks + 8 * fq) * 2); acc = MFMA16(a[ks], b, acc); }
            u32x2 o; o.x = pk2(acc[0] * e2[0], acc[1] * e2[1]); o.y = pk2(acc[2] * e2[2], acc[3] * e2[3]);
            *(u32x2*)(p.UT + (size_t)item * 16384 + (16 * vt + fr) * 128 + 16 * wave + 4 * fq) = o; }
        if (tid < 128) p.AL[(size_t)item * 128 + tid] = __expf(vec[128 + tid]);
        __syncthreads();
        item = next;
    }
}
template <int NB> DI void hgrn_b2_steps(const Prm& p, int item, int v, int d4, float (&S)[4]) {
    u32x2 uu[NB]; f32x4 al[NB];
#pragma unroll
    for (int i = 0; i < NB; ++i) { uu[i] = *(const u32x2*)(p.UT + (size_t)(item + i) * 16384 + v * 128 + d4); al[i] = *(const f32x4*)(p.AL + (size_t)(item + i) * 128 + d4); }
#pragma unroll
    for (int i = 0; i < NB; ++i) { u32x2 o; o.x = pk2(S[0], S[1]); o.y = pk2(S[2], S[3]);
        *(u32x2*)(p.UT + (size_t)(item + i) * 16384 + v * 128 + d4) = o;
        S[0] = al[i][0] * S[0] + bflo(uu[i].x); S[1] = al[i][1] * S[1] + bfhi(uu[i].x); S[2] = al[i][2] * S[2] + bflo(uu[i].y); S[3] = al[i][3] * S[3] + bfhi(uu[i].y); }
}
DI void hgrn_b2(const Prm& p, int gtid, int GT) {
    for (int idx = gtid; idx < 64 * 4096; idx += GT) {
        const int bhx = idx >> 12, e = idx & 4095, v = e >> 5, d4 = (e & 31) * 4; const bool smp = bhx >= 32;
        float S[4] = {0.f, 0.f, 0.f, 0.f};
        if (smp) {
#pragma unroll
            for (int j = 0; j < 4; ++j) S[j] = p.state_hgrn[((size_t)(bhx - 32) * 128 + d4 + j) * 128 + v];
            hgrn_b2_steps<1>(p, 2080 + (bhx - 32), v, d4, S); }
        else { for (int c0 = 0; c0 < 65; c0 += 13) hgrn_b2_steps<13>(p, bhx * 65 + c0, v, d4, S); }
        float* dst = p.out + (smp ? O_HGS + (size_t)(bhx - 32) * 16384 : O_HGP + (size_t)bhx * 16384);
#pragma unroll
        for (int j = 0; j < 4; ++j) dst[(d4 + j) * 128 + v] = S[j];
    }
}
DI void hgrn_b3_all(const Prm& p, LAS unsigned char* lds, int tid, int lane, int wave) {
    const int fr = lane & 15, fq = lane >> 4;
    int item = blockIdx.x; if (item >= NITEM_H) return;
    unsigned rl[16], rv[16], rq[16];
    hgrn_loadraw<true>(p, hgrn_item(item), tid, rl, rv, rq);
    const int nt_ = tid >> 3, nsg = tid & 7;
    while (item < NITEM_H) {
        const HItem it = hgrn_item(item);
        bf16x8 sf[4][4];
#pragma unroll
        for (int i = 0; i < 4; ++i)
#pragma unroll
            for (int ks = 0; ks < 4; ++ks) sf[i][ks] = *(const bf16x8*)(p.UT + (size_t)item * 16384 + (16 * (4 * (wave >> 2) + i) + fr) * 128 + 32 * ks + 8 * fq);
        const size_t grow = (size_t)(it.row0 + (nt_ < it.L ? nt_ : 0)); const int gc0 = it.h * 128 + 16 * nsg;
        const u32x4v g0 = *(const u32x4v*)(p.GS + grow * 512 + gc0), g1 = *(const u32x4v*)(p.GS + grow * 512 + gc0 + 8);
        hgrn_prep<true>(it, lds, tid, rl, rv, rq);
        const int next = item + gridDim.x;
        if (next < NITEM_H) hgrn_loadraw<true>(p, hgrn_item(next), tid, rl, rv, rq);
        {
            const int tt = wave >> 1;
#pragma unroll
            for (int i = 0; i < 2; ++i) { const int st = 2 * (wave & 1) + i; f32x4 acc = {0.f, 0.f, 0.f, 0.f};
#pragma unroll
                for (int ks = 0; ks < 4; ++ks) { const bf16x8 a = *(const LAS bf16x8*)(lds + L_KT + ((16 * st + fr) * HP + 32 * ks + 8 * fq) * 2);
                    const bf16x8 b = *(const LAS bf16x8*)(lds + L_QT + ((16 * tt + fr) * HP + 32 * ks + 8 * fq) * 2); acc = MFMA16(a, b, acc); }
                const int t = 16 * tt + fr, s0 = 16 * st + 4 * fq;
                u32x2 o; o.x = pk2(s0 <= t ? acc[0] : 0.f, s0 + 1 <= t ? acc[1] : 0.f); o.y = pk2(s0 + 2 <= t ? acc[2] : 0.f, s0 + 3 <= t ? acc[3] : 0.f);
                *(LAS u32x2*)(lds + L_ATT + (t * TPI + s0) * 2) = o; }
        }
        __syncthreads();
        f32x4 oacc[4];
        {   const int tt = wave & 3;
            bf16x8 aa[2], aq[4];
#pragma unroll
            for (int ks = 0; ks < 2; ++ks) aa[ks] = *(const LAS bf16x8*)(lds + L_ATT + ((16 * tt + fr) * TPI + 32 * ks + 8 * fq) * 2);
#pragma unroll
            for (int ks = 0; ks < 4; ++ks) aq[ks] = *(const LAS bf16x8*)(lds + L_QH + ((16 * tt + fr) * HP + 32 * ks + 8 * fq) * 2);
#pragma unroll
            for (int i = 0; i < 4; ++i) { const int vt = 4 * (wave >> 2) + i; f32x4 acc = {0.f, 0.f, 0.f, 0.f};
#pragma unroll
                for (int ks = 0; ks < 2; ++ks) { const bf16x8 b = *(const LAS bf16x8*)(lds + L_IVT + ((16 * vt + fr) * TPI + 32 * ks + 8 * fq) * 2); acc = MFMA16(aa[ks], b, acc); }
#pragma unroll
                for (int ks = 0; ks < 4; ++ks) acc = MFMA16(aq[ks], sf[i][ks], acc);
                oacc[i] = acc; }
        }
        f32x4 gn[4];
#pragma unroll
        for (int j = 0; j < 4; ++j) gn[j] = ((const f32x4*)(p.hgrn_norm + 16 * nsg))[j];
        __syncthreads();
        {   const int tt = wave & 3; LAS float* ob = (LAS float*)(lds + L_OB);
#pragma unroll
            for (int i = 0; i < 4; ++i) { const int v = 16 * (4 * (wave >> 2) + i) + fr;
#pragma unroll
                for (int j = 0; j < 4; ++j) ob[(16 * tt + 4 * fq + j) * 132 + v] = oacc[i][j]; }
        }
        __syncthreads();
        {   const int t = nt_, sg = nsg; const LAS float* ob = (const LAS float*)(lds + L_OB) + t * 132 + 16 * sg;
            f32x4 x[4]; float ss = 0.f;
#pragma unroll
            for (int j = 0; j < 4; ++j) { x[j] = ((const LAS f32x4*)ob)[j]; ss += (x[j].x * x[j].x + x[j].y * x[j].y) + (x[j].z * x[j].z + x[j].w * x[j].w); }
            ss += __shfl_xor(ss, 1); ss += __shfl_xor(ss, 2); ss += __shfl_xor(ss, 4);
            const float rr = rsqrtf(ss * (1.f / 128.f) + EPSN);
            if (t < it.L) { const size_t row = it.row0 + t; const int c0 = it.h * 128 + 16 * sg;
                const f32x4 n0 = gn[0], n1 = gn[1], n2 = gn[2], n3 = gn[3];
                u32x4v o0, o1;
                o0.x = pk2(x[0].x * rr * n0.x * bflo(g0.x), x[0].y * rr * n0.y * bfhi(g0.x)); o0.y = pk2(x[0].z * rr * n0.z * bflo(g0.y), x[0].w * rr * n0.w * bfhi(g0.y));
                o0.z = pk2(x[1].x * rr * n1.x * bflo(g0.z), x[1].y * rr * n1.y * bfhi(g0.z)); o0.w = pk2(x[1].z * rr * n1.z * bflo(g0.w), x[1].w * rr * n1.w * bfhi(g0.w));
                o1.x = pk2(x[2].x * rr * n2.x * bflo(g1.x), x[2].y * rr * n2.y * bfhi(g1.x)); o1.y = pk2(x[2].z * rr * n2.z * bflo(g1.y), x[2].w * rr * n2.w * bfhi(g1.y));
                o1.z = pk2(x[3].x * rr * n3.x * bflo(g1.z), x[3].y * rr * n3.y * bfhi(g1.z)); o1.w = pk2(x[3].z * rr * n3.z * bflo(g1.w), x[3].w * rr * n3.w * bfhi(g1.w));
                *(u32x4v*)(p.CAT + row * 1024 + c0) = o0; *(u32x4v*)(p.CAT + row * 1024 + c0 + 8) = o1; }
        }
        __syncthreads();
        item = next;
    }
}
DI void s5_load_u(const Prm& p, int mt, int g, int lane, bf16x8 (&uf)[8]) {
    const int fr = lane & 15, fq = lane >> 4; int col = 16 * mt + fr; if (col >= NCOL) col = NCOL - 1;
#pragma unroll
    for (int ks = 0; ks < 8; ++ks) uf[ks] = *(const bf16x8*)(p.U + ((size_t)(16 * col + 2 * ks + (fq >> 1))) * 512 + 16 * g + 8 * (fq & 1));
}
DI void s5_b(const Prm& p, int gw, int NGW, int lane) {
    const int fr = lane & 15, fq = lane >> 4;
    for (int task = gw; task < 131 * 32; task += NGW) { const int mt = task >> 5, g = task & 31;
        bf16x8 uf[8]; s5_load_u(p, mt, g, lane, uf);
#pragma unroll
        for (int nt = 0; nt < 8; ++nt) { f32x4 acc = {0.f, 0.f, 0.f, 0.f};
#pragma unroll
            for (int ks = 0; ks < 8; ++ks) { const bf16x8 b = *(const bf16x8*)(p.HT + ((size_t)(g * 128 + 16 * nt + fr)) * 256 + 32 * ks + 8 * fq); acc = MFMA16(uf[ks], b, acc); }
#pragma unroll
            for (int j = 0; j < 4; ++j) { const int col = 16 * mt + 4 * fq + j; if (col < NCOL) p.XLOC[(size_t)col * 4096 + g * 128 + 16 * nt + fr] = acc[j]; } }
    }
}
template <int NB> DI void s5_c_steps(const Prm& p, int col, size_t base, float ar, float ai, float& xr, float& xi) {
    f32x2v xl[NB];
#pragma unroll
    for (int i = 0; i < NB; ++i) xl[i] = *(const f32x2v*)(p.XLOC + (size_t)(col + i) * 4096 + base);
#pragma unroll
    for (int i = 0; i < NB; ++i) { *(unsigned*)(p.XPREV + (size_t)(col + i) * 4096 + base) = pk2(xr, xi);
        const float nr = ar * xr - ai * xi + xl[i].x, ni = ar * xi + ai * xr + xl[i].y; xr = nr; xi = ni; }
}
DI void s5_c(const Prm& p, int gtid) {
    if (gtid >= 16 * 2048) return;
    const int seq = gtid >> 11, g = (gtid >> 6) & 31, n = gtid & 63; const bool smp = seq >= 8; const int b = seq & 7;
    float xr = 0.f, xi = 0.f; if (smp) { xr = p.ssm_re0[(b * 32 + g) * 64 + n]; xi = p.ssm_im0[(b * 32 + g) * 64 + n]; }
    const float ar = p.A16[2 * (g * 64 + n)], ai = p.A16[2 * (g * 64 + n) + 1];
    const size_t base = (size_t)g * 128 + 2 * n;
    if (smp) s5_c_steps<4>(p, 2056 + 4 * b, base, ar, ai, xr, xi);
    else { for (int c0 = 0; c0 < 256; c0 += 16) s5_c_steps<16>(p, 257 * b + c0, base, ar, ai, xr, xi); s5_c_steps<1>(p, 257 * b + 256, base, ar, ai, xr, xi); }
    const size_t o = (size_t)(b * 32 + g) * 64 + n;
    p.out[(smp ? O_SRS : O_SRP) + o] = xr; p.out[(smp ? O_SIS : O_SIP) + o] = xi;
}
DI f32x2v gelu_pk(f32x2v v) {
    const f32x2v av = __builtin_elementwise_abs(v), d = av * 0.2316418882f + 1.0f;
    f32x2v t; t.x = __builtin_amdgcn_rcpf(d.x); t.y = __builtin_amdgcn_rcpf(d.y);
    f32x2v q = t * 0.5307027145f + (-0.7265760135f); q = q * t + 0.7107068705f; q = q * t + (-0.142248368f); q = q * t + 0.127414796f; q = q * t;
    const f32x2v s = (v * v) * (-0.72134752044f);
    f32x2v e; e.x = __builtin_amdgcn_exp2f(s.x); e.y = __builtin_amdgcn_exp2f(s.y);
    const f32x2v m = v * (q * e), r = v - m;
    f32x2v o; o.x = v.x < 0.f ? m.x : r.x; o.y = v.y < 0.f ? m.y : r.y; return o;
}
DI void s5_d(const Prm& p, int gw, int NGW, int lane) {
    const int fr = lane & 15, fq = lane >> 4;
    for (int task = gw; task < 131 * 32; task += NGW) { const int mt = task >> 5, g = task & 31;
        bf16x8 uf[8], xf[4]; s5_load_u(p, mt, g, lane, uf);
        int colc = 16 * mt + fr; if (colc >= NCOL) colc = NCOL - 1;
#pragma unroll
        for (int ks = 0; ks < 4; ++ks) xf[ks] = *(const bf16x8*)(p.XPREV + (size_t)colc * 4096 + g * 128 + 32 * ks + 8 * fq);
        const bf16_t* tg = p.TG + ((size_t)(g * 256 + fr)) * 384 + 8 * fq;
        const bool ok = 16 * mt + fr < NCOL;
#pragma unroll
        for (int t = 0; t < 16; ++t) { f32x4 acc = {0.f, 0.f, 0.f, 0.f};
#pragma unroll
            for (int ks = 0; ks < 8; ++ks) if (ks <= (t >> 1)) { const bf16x8 a = *(const bf16x8*)(tg + (size_t)t * 16 * 384 + 32 * ks); acc = MFMA16(a, uf[ks], acc); }
#pragma unroll
            for (int ks = 0; ks < 4; ++ks) { const bf16x8 a = *(const bf16x8*)(tg + (size_t)t * 16 * 384 + 256 + 32 * ks); acc = MFMA16(a, xf[ks], acc); }
            const f32x2v y0 = gelu_pk((f32x2v){acc[0], acc[1]}), y1 = gelu_pk((f32x2v){acc[2], acc[3]});
            u32x2 o; o.x = pk2(y0.x, y0.y); o.y = pk2(y1.x, y1.y);
            if (ok) *(u32x2*)(p.YG + ((size_t)(16 * (16 * mt + fr) + t)) * 512 + 16 * g + 4 * fq) = o; }
    }
}

DI void s5_b_lds(const Prm& p, LAS unsigned char* lds, int tid, int lane, int wave) {
    const int fr = lane & 15, fq = lane >> 4;
    for (int gp = blockIdx.x; gp < 256; gp += gridDim.x) { const int g = gp & 31, part = gp >> 5;
        for (int i = tid; i < 128 * 32; i += 512) { const int row = i >> 5, ch = i & 31;
            *(LAS u32x4v*)(lds + row * 528 + ch * 16) = *(const u32x4v*)(p.HT + ((size_t)(g * 128 + row)) * 256 + ch * 8); }
        __syncthreads();
        for (int mt = part + 8 * wave; mt < 131; mt += 64) {
            bf16x8 uf[8]; s5_load_u(p, mt, g, lane, uf);
#pragma unroll 1
            for (int nt = 0; nt < 8; ++nt) { f32x4 acc = {0.f, 0.f, 0.f, 0.f};
#pragma unroll
                for (int ks = 0; ks < 8; ++ks) { const bf16x8 b = *(const LAS bf16x8*)(lds + (16 * nt + fr) * 528 + 64 * ks + 16 * fq); acc = MFMA16(uf[ks], b, acc); }
#pragma unroll
                for (int j = 0; j < 4; ++j) { const int col = 16 * mt + 4 * fq + j; if (col < NCOL) p.XLOC[(size_t)col * 4096 + g * 128 + 16 * nt + fr] = acc[j]; } }
        }
        __syncthreads(); }
}
DI void s5_d_lds(const Prm& p, LAS unsigned char* lds, int tid, int lane, int wave) {
    const int fr = lane & 15, fq = lane >> 4;
    for (int gp = blockIdx.x; gp < 256; gp += gridDim.x) { const int g = gp & 31, part = gp >> 5;
        { const int row = tid >> 1, hf = tid & 1;
            *(LAS u32x4v*)(lds + row * 48 + hf * 16) = *(const u32x4v*)(p.TG + ((size_t)(g * 256 + row)) * 16 + hf * 8); }
        for (int i = tid; i < 256 * 16; i += 512) { const int row = i >> 4, ch = i & 15;
            *(LAS u32x4v*)(lds + 12288 + row * 272 + ch * 16) = *(const u32x4v*)(p.TG + 131072 + ((size_t)(g * 256 + row)) * 128 + ch * 8); }
        __syncthreads();
        const int lb = fr * 48 + (fq & 1) * 16, hi = fq >> 1;
        for (int mt = part + 8 * wave; mt < 131; mt += 64) {
            bf16x8 uf[8], xf[4]; s5_load_u(p, mt, g, lane, uf);
            int colc = 16 * mt + fr; if (colc >= NCOL) colc = NCOL - 1;
#pragma unroll
            for (int ks = 0; ks < 4; ++ks) xf[ks] = *(const bf16x8*)(p.XPREV + (size_t)colc * 4096 + g * 128 + 32 * ks + 8 * fq);
            const bool ok = 16 * mt + fr < NCOL;
#pragma unroll 1
            for (int t = 0; t < 16; ++t) { f32x4 acc = {0.f, 0.f, 0.f, 0.f};
#pragma unroll
                for (int ks = 0; ks < 8; ++ks) if (ks <= (t >> 1)) {
                    const int tau = t - 2 * ks - hi;
                    union { bf16x8 v; u32x4v u; } a; a.v = *(const LAS bf16x8*)(lds + (tau < 0 ? 0 : tau) * 768 + lb);
                    if (tau < 0) a.u = (u32x4v){0u, 0u, 0u, 0u};
                    acc = MFMA16(a.v, uf[ks], acc); }
#pragma unroll
                for (int ks = 0; ks < 4; ++ks) { const bf16x8 a = *(const LAS bf16x8*)(lds + 12288 + (t * 16 + fr) * 272 + 64 * ks + 16 * fq); acc = MFMA16(a, xf[ks], acc); }
                const f32x2v y0 = gelu_pk((f32x2v){acc[0], acc[1]}), y1 = gelu_pk((f32x2v){acc[2], acc[3]});
                u32x2 o; o.x = pk2(y0.x, y0.y); o.y = pk2(y1.x, y1.y);
                if (ok) *(u32x2*)(p.YG + ((size_t)(16 * (16 * mt + fr) + t)) * 512 + 16 * g + 4 * fq) = o; }
        }
        __syncthreads(); }
}
DI void cache_convert(const Prm& p, int gtid, int GT) {
    for (size_t i = (size_t)gtid; i < (size_t)8 * 1024 * 256; i += (size_t)GT) {
        const size_t row = i >> 8; const int c4 = (int)(i & 255) * 4, b = (int)(row >> 10), pos = (int)(row & 1023), h = c4 >> 7, d = c4 & 127;
        const f32x4 k = *(const f32x4*)(p.cache_k + row * 1024 + c4); u32x2 o; o.x = pk2(k.x, k.y); o.y = pk2(k.z, k.w);
        *(u32x2*)(p.KS + kf_index(b * 8 + h, 34, pos, d)) = o;
        const f32x4 v = *(const f32x4*)(p.cache_v + row * 1024 + c4); bf16_t* vt = p.VTS + vf_index(b * 8 + h, 34, pos, d);
        vt[0] = f2bf(v.x); vt[8] = f2bf(v.y); vt[16] = f2bf(v.z); vt[24] = f2bf(v.w); }
}
DI void attn_phase(const Prm& p, LAS unsigned char* lds, int wave, int gw, int NGW, int lane) {
    const int q = lane & 31, half = lane >> 5;
    LAS unsigned char* wl = lds + wave * 16384;
    for (int it = gw; it < 8256 + 128; it += NGW) {
        bool smp; int b, h, qb;
        if (it < 8064) { smp = false; b = it / 1008; const int rem = it - b * 1008; h = rem / 126; qb = 3 + rem - h * 126; }
        else if (it < 8192) { const int s = it - 8064; smp = true; b = s >> 4; h = (s >> 1) & 7; qb = s & 1; }
        else { const int s = it - 8192; smp = false; b = s / 24; const int rem = s - b * 24; h = rem / 3; qb = rem - h * 3; }
        const size_t tbase = (size_t)(b * 8 + h) * (smp ? 34 : 129) * 4096 + lane * 8;
        const bf16_t* Kb = (smp ? p.KS : p.KP) + tbase; const bf16_t* Vb = (smp ? p.VTS : p.VTP) + tbase;
        const int qpos0 = (smp ? 1024 : 0) + 32 * qb, qrow0 = smp ? NTP + b * 64 + 32 * qb : b * TP + 32 * qb;
        const int qpos = qpos0 + q; const bool qvalid = smp || qpos < TP; const size_t qrow = qvalid ? qrow0 + q : qrow0;
        bf16x8 qf[8];
#pragma unroll
        for (int ks = 0; ks < 8; ++ks) qf[ks] = *(const bf16x8*)(p.Q + qrow * 1024 + h * 128 + 16 * ks + 8 * half);
        f32x16 o[4];
#pragma unroll
        for (int db = 0; db < 4; ++db)
#pragma unroll
            for (int e = 0; e < 16; ++e) o[db][e] = 0.f;
        float C = 1.f;
        for (int kt = (qpos0 + 30) >> 5; kt >= 0; --kt) {
            f32x16 s;
#pragma unroll
            for (int e = 0; e < 16; ++e) s[e] = 0.f;
            const bf16_t* kr = Kb + (size_t)kt * 4096; const bf16_t* vr = Vb + (size_t)kt * 4096;
            bf16x8 kf[8], vf[8];
#pragma unroll
            for (int ks = 0; ks < 8; ++ks) kf[ks] = *(const bf16x8*)(kr + ks * 512);
#pragma unroll
            for (int ks = 0; ks < 8; ++ks) vf[ks] = *(const bf16x8*)(vr + ks * 512);
#pragma unroll
            for (int ks = 0; ks < 8; ++ks) s = MFMA32(kf[ks], qf[ks], s);
            float pr[16], be[16], G[4], Gp[4];
#pragma unroll
            for (int i = 0; i < 4; ++i) {
#pragma unroll
                for (int j = 0; j < 4; ++j) { const int key = 32 * kt + 8 * i + 4 * half + j; const bool valid = key < qpos;
                    float z = s[4 * i + j] * 0.08838834764831845f; z = fminf(fmaxf(z, -80.f), 80.f);
                    const float e = __expf(z), pp = __builtin_amdgcn_rcpf(1.f + e); pr[4 * i + j] = valid ? pp : 1.f; be[4 * i + j] = valid ? e * pp : 0.f; }
                G[i] = (pr[4 * i] * pr[4 * i + 1]) * (pr[4 * i + 2] * pr[4 * i + 3]); }
#pragma unroll
            for (int i = 0; i < 4; ++i) Gp[i] = __shfl_xor(G[i], 32);
            float w[16]; float E1 = 1.f;
#pragma unroll
            for (int i = 3; i >= 0; --i) { const float Glo = half ? Gp[i] : G[i], Ghi = half ? G[i] : Gp[i];
                float suf = C * (half ? E1 : E1 * Ghi);
#pragma unroll
                for (int j = 3; j >= 0; --j) { w[4 * i + j] = be[4 * i + j] * suf; suf *= pr[4 * i + j]; }
                E1 *= Glo * Ghi; }
            C *= E1;
#pragma unroll
            for (int c = 0; c < 2; ++c) { union { bf16x8 v; unsigned u[4]; } wf;
#pragma unroll
                for (int e = 0; e < 4; ++e) wf.u[e] = pk2(w[8 * c + 2 * e], w[8 * c + 2 * e + 1]);
#pragma unroll
                for (int db = 0; db < 4; ++db) o[db] = MFMA32(vf[4 * c + db], wf.v, o[db]); }
            if (__all(C < 1e-24f)) break;
        }
#pragma unroll
        for (int db = 0; db < 4; ++db)
#pragma unroll
            for (int i = 0; i < 4; ++i) { u32x2 ov; ov.x = pk2(o[db][4 * i], o[db][4 * i + 1]); ov.y = pk2(o[db][4 * i + 2], o[db][4 * i + 3]);
                *(LAS u32x2*)(wl + q * 272 + (32 * db + 8 * i + 4 * half) * 2) = ov; }
#pragma unroll
        for (int k = 0; k < 8; ++k) { const int r = (lane >> 4) + 4 * k, ch = lane & 15;
            const u32x4v v = *(const LAS u32x4v*)(wl + r * 272 + ch * 16);
            if (smp || qpos0 + r < TP) *(u32x4v*)(p.O + (size_t)(qrow0 + r) * 1024 + h * 128 + ch * 8) = v; }
    }
}
DI void final_norm(const Prm& p, int gw, int NGW, int lane) {
    for (int r = gw; r < 32768 + 512; r += NGW) {
        int grow; float* dst;
        if (r < 32768) { const int b = r >> 12, t = r & 4095; grow = b * TP + 16 + t; dst = p.out + O_YP + (size_t)r * 1024; } else { grow = NTP + (r - 32768); dst = p.out + O_YS + (size_t)(r - 32768) * 1024; }
        u32x2 x[4];
#pragma unroll
        for (int j = 0; j < 4; ++j) x[j] = ((const u32x2*)(p.XB + (size_t)grow * 1024))[lane + 64 * j];
        const float rr = row_rinv(p.SSQ, grow);
#pragma unroll
        for (int j = 0; j < 4; ++j) { f32x4 v; v.x = bflo(x[j].x); v.y = bfhi(x[j].x); v.z = bflo(x[j].y); v.w = bfhi(x[j].y); ((f32x4*)dst)[lane + 64 * j] = v * rr * ((const f32x4*)p.ln_final)[lane + 64 * j]; }
    }
}

#define XB_TMO      128
#define XB_XCNT(j)  (256  + 64 * (j))
#define XB_XSUB(j)  (1280 + 64 * (j))
#define XB_XGEN(j)  (2304 + 64 * (j))
#define XB_TOP      3328
#define XB_TOPGEN   3392
#define XCD_BAR_WORDS 3456
#define XB_SPIN_CAP (1u << 18)
DI unsigned xb_ld(unsigned* p) { return __hip_atomic_load(p, __ATOMIC_RELAXED, __HIP_MEMORY_SCOPE_AGENT); }
DI unsigned xb_add(unsigned* p, unsigned v) { return __hip_atomic_fetch_add(p, v, __ATOMIC_RELAXED, __HIP_MEMORY_SCOPE_AGENT); }
DI unsigned xb_xcc_id() { return (unsigned)__builtin_amdgcn_s_getreg((3 << 11) | 20) & 0xFu; }
#define XB_SPIN(cond, bar) do { unsigned _sp = 0; while (cond) { __builtin_amdgcn_s_sleep(1); \
    if ((++_sp & 255u) == 0u) { if (xb_ld(&(bar)[XB_TMO])) break; if (_sp > XB_SPIN_CAP) { atomicAdd(&(bar)[XB_TMO], 1u); break; } } } } while (0)
struct XcdBarrier { unsigned* bar; unsigned x; volatile LAS unsigned* st; };
DI XcdBarrier xcd_barrier_post(unsigned* bar, volatile LAS unsigned* st) {
    XcdBarrier b; b.bar = bar; b.x = xb_xcc_id(); b.st = st;
    if (threadIdx.x == 0) (void)xb_add(&bar[XB_XCNT(b.x)], 1u);
    return b;
}
DI void xcd_barrier_complete(unsigned* bar, unsigned x, unsigned& nloc, unsigned& nx) {
    const unsigned G = gridDim.x * gridDim.y * gridDim.z;
    unsigned sum, cnt, mine, sp = 0u;
    for (;;) {
        sum = 0u; cnt = 0u; mine = 0u;
#pragma unroll
        for (unsigned j = 0; j < 16; ++j) { const unsigned c = xb_ld(&bar[XB_XCNT(j)]); sum += c; cnt += (c > 0u) ? 1u : 0u; mine = (j == x) ? c : mine; }
        if (sum == G) break;
        __builtin_amdgcn_s_sleep(1);
        if ((++sp & 255u) == 0u) { if (xb_ld(&bar[XB_TMO])) break; if (sp > XB_SPIN_CAP) { atomicAdd(&bar[XB_TMO], 1u); break; } }
    }
    nloc = mine > 0u ? mine : 1u; nx = cnt > 0u ? cnt : 1u;
}
DI void xcd_barrier(const XcdBarrier& b) {
    asm volatile("s_waitcnt vmcnt(0)" ::: "memory");
    __syncthreads();
    if (threadIdx.x == 0) {
        unsigned* bar = b.bar;
        __builtin_amdgcn_s_waitcnt(0);
        unsigned nloc = b.st[0], nx = b.st[1];
        if (nloc == 0u) { xcd_barrier_complete(bar, b.x, nloc, nx); b.st[0] = nloc; b.st[1] = nx; }
        const unsigned old = xb_add(&bar[XB_XSUB(b.x)], 1u);
        const unsigned gen = old / nloc;
        if (old + 1u == (gen + 1u) * nloc) {
            __builtin_amdgcn_fence(__ATOMIC_RELEASE, "agent");
            asm volatile("s_waitcnt vmcnt(0)" ::: "memory");
            const unsigned og = xb_add(&bar[XB_TOP], 1u);
            const unsigned tg = og / nx;
            if (og + 1u == (tg + 1u) * nx) xb_add(&bar[XB_TOPGEN], 1u);
            else XB_SPIN(xb_ld(&bar[XB_TOPGEN]) == tg, bar);
            __builtin_amdgcn_fence(__ATOMIC_ACQUIRE, "agent");
            xb_add(&bar[XB_XGEN(b.x)], 1u);
            asm volatile("s_waitcnt vmcnt(0)" ::: "memory");
        } else {
            XB_SPIN(xb_ld(&bar[XB_XGEN(b.x)]) == gen, bar);
            __builtin_amdgcn_fence(__ATOMIC_ACQUIRE, "agent");
            asm volatile("s_waitcnt vmcnt(0)" ::: "memory");
        }
    }
    __syncthreads();
}
constexpr int LDS_BYTES = 131072 + 256 + 8192;
__global__ void __launch_bounds__(512, 2) fwd_megakernel(Prm p) {
    extern __shared__ __attribute__((aligned(16))) unsigned char shm[];
    LAS unsigned char* lds = (LAS unsigned char*)shm;
    cg::grid_group grid = cg::this_grid();
    const int tid = threadIdx.x, lane = tid & 63, wave = __builtin_amdgcn_readfirstlane(tid >> 6);
    const int gw = blockIdx.x * 8 + wave, NGW = gridDim.x * 8, gtid = blockIdx.x * 512 + tid, GT = gridDim.x * 512;
    volatile LAS unsigned* xst = (volatile LAS unsigned*)(lds + 131072);
    if (tid == 0) { xst[0] = 0u; xst[1] = 0u; }
    __syncthreads();
    const XcdBarrier xb = xcd_barrier_post(p.BAR, xst);
    phase_prologue(p, lds, tid, lane, wave);
    xcd_barrier(xb);
    if (p.out == nullptr) grid.sync();
    { EpiIn0 E; E.SSQ = p.SSQ; E.RINV = p.RINV; E.LB = p.LB; E.Qh = p.Qh; E.IV = p.IV; E.GS = p.GS; E.U = p.U; E.LOGF = p.LOGF; run_gemm(lds, p.XB, p.Wt1, 2560, 1024, E); }
    xcd_barrier(xb);
    hgrn_b1_all(p, lds, tid, lane, wave);
    s5_b_lds(p, lds, tid, lane, wave);
    xcd_barrier(xb);
    hgrn_b2(p, gtid, GT);
    s5_c(p, gtid);
    xcd_barrier(xb);
    hgrn_b3_all(p, lds, tid, lane, wave);
    s5_d_lds(p, lds, tid, lane, wave);
    xcd_barrier(xb);
    { EpiGlu E; E.YG = p.YG; E.CAT = p.CAT; run_gemm(lds, p.YG, p.Wglu, 512, 512, E); }
    xcd_barrier(xb);
    { EpiRes E; E.XB = p.XB; E.SSQ = p.SSQ; run_gemm_split(lds, p.CAT, p.Wo0, 1024, 1024, E, (float*)p.H); xcd_barrier(xb); gemm_fixup(1024, 1024, E, (const float*)p.H, tid); rinv_pass(p, 1024, tid); }
    xcd_barrier(xb);
    { EpiUp E; E.SSQ = p.SSQ; E.RINV = p.RINV; E.H = p.H; run_gemm(lds, p.XB, p.Wup0, 4096, 1024, E); }
    xcd_barrier(xb);
    { EpiRes E; E.XB = p.XB; E.SSQ = p.SSQ; run_gemm_split(lds, p.H, p.Wdn0, 1024, 4096, E, (float*)p.CAT); xcd_barrier(xb); gemm_fixup(1024, 4096, E, (const float*)p.CAT, tid); rinv_pass(p, 4096, tid); }
    xcd_barrier(xb);
    { EpiQkv E; E.scr = lds + 131328; E.SSQ = p.SSQ; E.RINV = p.RINV; E.out = p.out; E.Q = p.Q; E.KP = p.KP; E.KS = p.KS; E.VTP = p.VTP; E.VTS = p.VTS; run_gemm(lds, p.XB, p.Wqkv, 3072, 1024, E); }
    if (gridDim.x > 36) { if (blockIdx.x >= 36) cache_convert(p, (blockIdx.x - 36) * 512 + tid, (gridDim.x - 36) * 512); } else cache_convert(p, gtid, GT);
    xcd_barrier(xb);
    attn_phase(p, lds, wave, gw, NGW, lane);
    xcd_barrier(xb);
    { EpiRes E; E.XB = p.XB; E.SSQ = p.SSQ; run_gemm_split(lds, p.O, p.Wo1, 1024, 1024, E, (float*)p.H); xcd_barrier(xb); gemm_fixup(1024, 1024, E, (const float*)p.H, tid); rinv_pass(p, 1024, tid); }
    xcd_barrier(xb);
    { EpiUp E; E.SSQ = p.SSQ; E.RINV = p.RINV; E.H = p.H; run_gemm(lds, p.XB, p.Wup1, 4096, 1024, E); }
    xcd_barrier(xb);
    { EpiRes E; E.XB = p.XB; E.SSQ = p.SSQ; run_gemm_split(lds, p.H, p.Wdn1, 1024, 4096, E, (float*)p.CAT); xcd_barrier(xb); gemm_fixup(1024, 4096, E, (const float*)p.CAT, tid); }
    xcd_barrier(xb);
    final_norm(p, gw, NGW, lane);
}

extern "C" void kernel_launch(void* const* d_in, const int* in_sizes, int n_in, void* d_out, int out_size, void* d_ws, size_t ws_size, hipStream_t stream) {
    static int grid_blocks = 0;
    if (grid_blocks == 0) {
        int dev = 0, cus = 0, per_cu = 0;
        hipGetDevice(&dev); hipDeviceGetAttribute(&cus, hipDeviceAttributeMultiprocessorCount, dev);
        if (hipFuncSetAttribute((const void*)fwd_megakernel, hipFuncAttributeMaxDynamicSharedMemorySize, LDS_BYTES) != hipSuccess) fprintf(stderr, "kernel_launch: hipFuncSetAttribute failed\n");
        if (hipOccupancyMaxActiveBlocksPerMultiprocessor(&per_cu, (const void*)fwd_megakernel, 512, LDS_BYTES) != hipSuccess || per_cu < 1) { fprintf(stderr, "kernel_launch: occupancy query says %d\n", per_cu); per_cu = 1; }
        (void)hipGetLastError();
        grid_blocks = cus > 0 ? cus : 256;
    }
    Prm p{};
    const float* const* in = (const float* const*)d_in;
    p.x_prompt = in[0]; p.x_sample = in[1]; p.state_hgrn = in[2]; p.ssm_re0 = in[3]; p.ssm_im0 = in[4]; p.cache_k = in[5]; p.cache_v = in[6]; p.meta = in[7]; p.ln_mix = in[8]; p.ln_mlp = in[9];
    p.ln_final = in[10]; p.w_in_even = in[11]; p.hgrn_lb = in[12]; p.hgrn_norm = in[13]; p.a_re = in[14]; p.a_im = in[15]; p.log_dt = in[16]; p.b_re = in[17]; p.b_im = in[18]; p.c_re = in[19];
    p.c_im = in[20]; p.ssm_d = in[21]; p.w_glu = in[22]; p.w_out_even = in[23]; p.w_in_odd = in[24]; p.w_out_odd = in[25]; p.w_up = in[26]; p.w_down = in[27];
    p.out = (float*)d_out;
    unsigned char* ws = (unsigned char*)d_ws; size_t off = 0;
    auto take = [&](size_t bytes) { unsigned char* r = ws + off; off += (bytes + 255) & ~(size_t)255; return r; };
    p.Wt1 = (bf16_t*)take((size_t)2560 * 1024 * 2); p.Wglu = (bf16_t*)take((size_t)512 * 512 * 2); p.Wo0 = (bf16_t*)take((size_t)1024 * 1024 * 2); p.Wup0 = (bf16_t*)take((size_t)4096 * 1024 * 2);
    p.Wdn0 = (bf16_t*)take((size_t)4096 * 1024 * 2); p.Wqkv = (bf16_t*)take((size_t)3072 * 1024 * 2); p.Wo1 = (bf16_t*)take((size_t)1024 * 1024 * 2); p.Wup1 = (bf16_t*)take((size_t)4096 * 1024 * 2);
    p.Wdn1 = (bf16_t*)take((size_t)4096 * 1024 * 2);
    p.XB = (bf16_t*)take((size_t)MP * 1024 * 2); p.SSQ = (float*)take((size_t)MP * 16 * 4); p.RINV = (float*)take((size_t)MP * 4); p.LB = (float*)take(2048); p.KTAB = (float*)take((size_t)32 * 16 * 256 * 4);
    p.TG = (bf16_t*)take((size_t)32 * 256 * 384 * 2); p.HT = (bf16_t*)take((size_t)32 * 128 * 256 * 2); p.A16 = (float*)take(32 * 64 * 2 * 4); p.BAR = (unsigned*)take(XCD_BAR_WORDS * 4);
    const size_t S0 = off; constexpr size_t SZ512 = (size_t)MP * 512 * 2;
    p.Qh = (bf16_t*)take(SZ512); p.LOGF = (unsigned short*)take(SZ512); p.IV = (bf16_t*)take(SZ512); p.GS = (bf16_t*)take(SZ512); p.U = (bf16_t*)take(SZ512);
    p.UT = (bf16_t*)take((size_t)NITEM_H * 16384 * 2); p.AL = (float*)take((size_t)NITEM_H * 128 * 4);
    p.XLOC = (float*)take(SZ512); p.YG = (bf16_t*)p.XLOC;
    p.XPREV = (bf16_t*)take((size_t)NCOL * 4096 * 2); p.CAT = (bf16_t*)take((size_t)MP * 1024 * 2);
    size_t end = off;
    off = S0; p.H = (bf16_t*)take((size_t)MP * 4096 * 2); if (off > end) end = off;
    off = S0; p.Q = (bf16_t*)take((size_t)MP * 1024 * 2); p.KP = (bf16_t*)take((size_t)64 * 129 * 4096 * 2); p.KS = (bf16_t*)take((size_t)64 * 34 * 4096 * 2);
    p.VTP = (bf16_t*)take((size_t)64 * 129 * 4096 * 2); p.VTS = (bf16_t*)take((size_t)64 * 34 * 4096 * 2); p.O = (bf16_t*)take((size_t)MP * 1024 * 2); if (off > end) end = off;
    if (end > ws_size || n_in != 28 || (size_t)out_size != O_END) { fprintf(stderr, "kernel_launch: workspace/shape mismatch: need %zu have %zu, n_in %d, out %d\n", end, ws_size, n_in, out_size); return; }
    (void)hipMemsetAsync(p.BAR, 0, XCD_BAR_WORDS * 4, stream);
    void* args[] = {&p};
    hipError_t e = hipLaunchCooperativeKernel((const void*)fwd_megakernel, dim3(grid_blocks), dim3(512), args, LDS_BYTES, stream);
    if (e != hipSuccess) fprintf(stderr, "cooperative launch failed: %s (grid %d)\n", hipGetErrorString(e), grid_blocks);
}
```

```cpp
#include <hip/hip_runtime.h>
#include <hip/hip_cooperative_groups.h>
#include <cstdio>
#include <cstdint>
namespace cg = cooperative_groups;
namespace pg8 {
#define PG8_LAS __attribute__((address_space(3)))
typedef unsigned short bf16_t;
typedef short bf16x8 __attribute__((ext_vector_type(8)));
typedef float f32x4 __attribute__((ext_vector_type(4)));
typedef unsigned u32x4 __attribute__((ext_vector_type(4)));
constexpr int BM = 256, BK = 64, HALF = 128, HTB = HALF * BK * 2  , STAGE_BYTES = 8 * HTB, NXCD = 8, WGM = 8;

__host__ __device__ __forceinline__ int lds_byte(int r, int c) { const int st = (r >> 4) * 2 + (c >> 5), rr = r & 15, cc = c & 31, ob = rr * 64 + cc * 2; return st * 1024 + (ob ^ (((ob >> 9) & 1) << 5)); }
__host__ __device__ __forceinline__ void stage_rc(int b, int& R, int& C) { const int st = b / 1024, sb = b % 1024, swz = sb ^ (((sb >> 9) & 1) << 5); R = (st >> 1) * 16 + swz / 64; C = (st & 1) * 32 + (swz % 64) / 2; }
__host__ __device__ __forceinline__ int perm32(int rho) { const int n = rho >> 4, i = rho & 15; return 8 * (i >> 2) + 4 * n + (i & 3); }

struct Unit { int pm, pn, kb, nk, part; };
struct Gemm { const bf16_t* A; const bf16_t* Bt; int M, N, K; float* part; };

struct StaticOrder {
    int nM, nN, nwg, G, c;
    __host__ __device__ void init(int M, int N, int G_, int c_) { nM = M / BM; nN = N / BM; nwg = nM * nN; G = G_; c = c_; }
    __host__ __device__ void map(int L, Unit& u) const {
        int wgid = L; { const int q = nwg / NXCD, r = nwg % NXCD, xcd = wgid % NXCD, off = wgid / NXCD; wgid = (xcd < r ? xcd * (q + 1) : r * (q + 1) + (xcd - r) * q) + off; }
        const int nig = WGM * nN, gid = wgid / nig, fm = gid * WGM, gsz = (nM - fm) < WGM ? (nM - fm) : WGM;
        u.pm = fm + ((wgid % nig) % gsz); u.pn = (wgid % nig) / gsz; u.kb = 0; u.nk = 0; u.part = -1;
    }
    __host__ __device__ bool next(int i, Unit& u) const {
        const long L = (long)i * G + c; if (L >= nwg) return false;
        map((int)L, u); return true;
    }
    __device__ __forceinline__ void a_ready(const Unit&) const {}
    __device__ __forceinline__ void done(const Unit&) const {}
};
template <class Epi, class Sched>
__device__ __forceinline__ void gemm_phase(PG8_LAS unsigned char* lds, const Gemm g, const Sched& S, const Epi& E) {
    int tid_ = threadIdx.x; asm volatile("" : "+v"(tid_));
    const int tid = tid_, wid = __builtin_amdgcn_readfirstlane(tid >> 6), lane = tid & 63, wr = wid >> 2, wc = wid & 3, fr = lane & 15, fq = lane >> 4;
    const int K = g.K, nt = K / BK;
    unsigned voffA[2], voffB[2];
#pragma unroll
    for (int i = 0; i < 2; ++i) { int R, C; stage_rc(tid * 16 + i * 8192, R, C); const int Rb = Epi::PERM ? ((R & ~31) + perm32(R & 31)) : R;
        voffA[i] = (unsigned)(R * K + C) * 2u; voffB[i] = (unsigned)(Rb * K + C) * 2u; }
    const size_t kstep = (size_t)(BK * 2);
    const size_t hstep = (size_t)HALF * K * 2;
    const size_t tstep = 2 * hstep;
    const unsigned ldsw = (unsigned)wid * 1024u;
    const int aoff = lds_byte(wr * 64 + fr, fq * 8), boff = lds_byte(wc * 32 + fr, fq * 8);
#define PG8_SA(b, h) (((b) * 2 + (h)) * HTB)
#define PG8_SB(b, h) ((4 + (b) * 2 + (h)) * HTB)
#define PG8_STAGE(bufoff, gbase, voff) do { _Pragma("unroll") for (int _i = 0; _i < 2; ++_i) \
        __builtin_amdgcn_global_load_lds((const unsigned*)((const char*)(gbase) + (voff)[_i]), (PG8_LAS unsigned*)(lds + (bufoff) + ldsw + _i * 8192), 16, 0, 0); } while (0)
#define PG8_LDA(dst, b, h) do { _Pragma("unroll") for (int m = 0; m < 4; ++m) _Pragma("unroll") for (int k = 0; k < 2; ++k) dst[m][k] = *(const PG8_LAS bf16x8*)(lds + PG8_SA(b, h) + aoff + m * 2048 + k * 1024); } while (0)
#define PG8_LDB(dst, b, h) do { _Pragma("unroll") for (int n = 0; n < 2; ++n) _Pragma("unroll") for (int k = 0; k < 2; ++k) dst[n][k] = *(const PG8_LAS bf16x8*)(lds + PG8_SB(b, h) + boff + n * 2048 + k * 1024); } while (0)
#define PG8_MMA(ai, bj, At, Bt) do { __builtin_amdgcn_s_setprio(1); _Pragma("unroll") for (int m = 0; m < 4; ++m) _Pragma("unroll") for (int n = 0; n < 2; ++n) _Pragma("unroll") for (int k = 0; k < 2; ++k) \
        acc[ai][bj][m][n] = __builtin_amdgcn_mfma_f32_16x16x32_bf16(Bt[n][k], At[m][k], acc[ai][bj][m][n], 0, 0, 0); __builtin_amdgcn_s_setprio(0); } while (0)
#define PG8_WAIT_V(n) asm volatile("s_waitcnt vmcnt(" #n ")" ::: "memory")
#define PG8_WAIT_L(n) asm volatile("s_waitcnt lgkmcnt(" #n ")" ::: "memory")
#define PG8_BAR __builtin_amdgcn_s_barrier()
#define PG8_SCHED __builtin_amdgcn_sched_barrier(0)
    Unit cur, nxt; int ui = 0; typename Epi::Pre pre;
    if (!S.next(0, cur)) return;
    f32x4 acc[2][2][4][2];
#pragma unroll
    for (int a = 0; a < 2; ++a)
#pragma unroll
        for (int b = 0; b < 2; ++b)
#pragma unroll
            for (int m = 0; m < 4; ++m)
#pragma unroll
                for (int n = 0; n < 2; ++n) acc[a][b][m][n] = (f32x4){0.f, 0.f, 0.f, 0.f};
    bf16x8 At[4][2], B0[2][2], B1[2][2];
    const char* cA = (const char*)g.A + (size_t)cur.pm * tstep + (size_t)cur.kb * kstep; const char* cB = (const char*)g.Bt + (size_t)cur.pn * tstep + (size_t)cur.kb * kstep;
    S.a_ready(cur);
    PG8_STAGE(PG8_SB(0, 0), cB, voffB); PG8_STAGE(PG8_SA(0, 0), cA, voffA); PG8_STAGE(PG8_SB(0, 1), cB + hstep, voffB); PG8_STAGE(PG8_SA(0, 1), cA + hstep, voffA);
    if (wr == 1) PG8_BAR;
    PG8_WAIT_V(4); PG8_BAR;
    PG8_STAGE(PG8_SB(1, 0), cB + kstep, voffB); PG8_STAGE(PG8_SA(1, 0), cA + kstep, voffA); PG8_STAGE(PG8_SB(1, 1), cB + hstep + kstep, voffB);
    PG8_WAIT_V(6); PG8_BAR;
    for (;;) {
        const bool has_next = S.next(ui + 1, nxt);
        const char* nA = has_next ? (const char*)g.A + (size_t)nxt.pm * tstep + (size_t)nxt.kb * kstep : cA; const char* nB = has_next ? (const char*)g.Bt + (size_t)nxt.pn * tstep + (size_t)nxt.kb * kstep : cB;
        const int cnk = cur.nk ? cur.nk : nt;
        for (int t = 0; t < cnk; t += 2) {
            const bool last = (t == cnk - 2);
            const char* a1 = cA + (size_t)(t + 1) * kstep;
            const char* a2 = last ? nA : cA + (size_t)(t + 2) * kstep; const char* b2 = last ? nB : cB + (size_t)(t + 2) * kstep;
            const char* a3 = a2 + kstep; const char* b3 = b2 + kstep;
            if (last && has_next) S.a_ready(nxt);
            if (last) E.prefetch(pre, cur, wr, fr);
            PG8_LDB(B0, 0, 0); PG8_SCHED; PG8_LDA(At, 0, 0); PG8_STAGE(PG8_SA(1, 1), a1 + hstep, voffA);
            PG8_WAIT_L(8); PG8_BAR; PG8_WAIT_L(0); PG8_MMA(0, 0, At, B0); PG8_BAR; PG8_SCHED;
            PG8_LDB(B1, 0, 1); PG8_STAGE(PG8_SB(0, 0), b2, voffB);
            PG8_BAR; PG8_WAIT_L(0); PG8_MMA(0, 1, At, B1); PG8_BAR;
            PG8_LDA(At, 0, 1); PG8_STAGE(PG8_SA(0, 0), a2, voffA);
            PG8_BAR; PG8_WAIT_L(0); PG8_MMA(1, 0, At, B0); PG8_BAR; PG8_SCHED;
            PG8_STAGE(PG8_SB(0, 1), b2 + hstep, voffB);
            PG8_WAIT_V(6); PG8_BAR; PG8_MMA(1, 1, At, B1); PG8_BAR;
            PG8_LDB(B0, 1, 0); PG8_SCHED; PG8_LDA(At, 1, 0); PG8_STAGE(PG8_SA(0, 1), a2 + hstep, voffA);
            PG8_WAIT_L(8); PG8_BAR; PG8_WAIT_L(0); PG8_MMA(0, 0, At, B0); PG8_BAR; PG8_SCHED;
            PG8_LDB(B1, 1, 1); PG8_STAGE(PG8_SB(1, 0), b3, voffB);
            PG8_BAR; PG8_WAIT_L(0); PG8_MMA(0, 1, At, B1); PG8_BAR;
            PG8_LDA(At, 1, 1); PG8_STAGE(PG8_SA(1, 0), a3, voffA);
            PG8_BAR; PG8_WAIT_L(0); PG8_MMA(1, 0, At, B0); PG8_BAR; PG8_SCHED;
            PG8_STAGE(PG8_SB(1, 1), b3 + hstep, voffB);
            PG8_WAIT_V(6); PG8_BAR; PG8_MMA(1, 1, At, B1); PG8_BAR;
        }
        if constexpr (!Epi::AFTER_DRAIN) {
            if (cur.part < 0) E(acc, cur, wr, wc, fr, fq, pre);
            else { f32x4* pp = (f32x4*)g.part + (size_t)cur.part * 32 * 512 + tid;
#pragma unroll
                for (int a = 0; a < 2; ++a)
#pragma unroll
                    for (int b = 0; b < 2; ++b)
#pragma unroll
                        for (int m = 0; m < 4; ++m)
#pragma unroll
                            for (int n = 0; n < 2; ++n) pp[(size_t)(((a * 2 + b) * 4 + m) * 2 + n) * 512] = acc[a][b][m][n]; }
            S.done(cur); }
        if (!has_next) break;
#pragma unroll
        for (int a = 0; a < 2; ++a)
#pragma unroll
            for (int b = 0; b < 2; ++b)
#pragma unroll
                for (int m = 0; m < 4; ++m)
#pragma unroll
                    for (int n = 0; n < 2; ++n) acc[a][b][m][n] = (f32x4){0.f, 0.f, 0.f, 0.f};
        cur = nxt; cA = nA; cB = nB; ++ui;
    }
    PG8_WAIT_V(0);
    if (wr == 0) PG8_BAR;
    PG8_BAR;
    if constexpr (Epi::AFTER_DRAIN) { E.fused(acc, cur, wr, wc, fr, fq, lds, wid, lane); S.done(cur); }
#undef PG8_SA
#undef PG8_SB
#undef PG8_STAGE
#undef PG8_LDA
#undef PG8_LDB
#undef PG8_MMA
#undef PG8_WAIT_V
#undef PG8_WAIT_L
#undef PG8_BAR
#undef PG8_SCHED
}
}
using pg8::bf16_t; using pg8::bf16x8; using pg8::f32x4; using pg8::Unit;
typedef float f32x16 __attribute__((ext_vector_type(16)));
typedef float f32x2v __attribute__((ext_vector_type(2)));
typedef unsigned u32x2 __attribute__((ext_vector_type(2)));
typedef unsigned u32x4v __attribute__((ext_vector_type(4)));
#define LAS __attribute__((address_space(3)))
#define DI __device__ __forceinline__

constexpr int DM = 1024, TP = 4112, NTP = 8 * TP  , NTS = 512, NT = NTP + NTS  , MP = 33536  ;
constexpr int NITEM_H = 2112;
constexpr int NCOL = NT / 16;
constexpr float EPSN = 1e-6f;
constexpr size_t O_YP = 0, O_YS = O_YP + (size_t)8 * 4096 * 1024, O_HGP = O_YS + 524288, O_HGS = O_HGP + 524288, O_SRP = O_HGS + 524288, O_SIP = O_SRP + 16384,
                 O_SRS = O_SIP + 16384, O_SIS = O_SRS + 16384, O_KP = O_SIS + 16384, O_VP = O_KP + (size_t)NTP * 1024, O_KS = O_VP + (size_t)NTP * 1024, O_VS = O_KS + 524288, O_END = O_VS + 524288;

struct Prm {
    const float *x_prompt, *x_sample, *state_hgrn, *ssm_re0, *ssm_im0, *cache_k, *cache_v, *meta, *ln_mix, *ln_mlp, *ln_final, *w_in_even, *hgrn_lb, *hgrn_norm,
        *a_re, *a_im, *log_dt, *b_re, *b_im, *c_re, *c_im, *ssm_d, *w_glu, *w_out_even, *w_in_odd, *w_out_odd, *w_up, *w_down;
    float* out;
    bf16_t *Wt1, *Wglu, *Wo0, *Wup0, *Wdn0, *Wqkv, *Wo1, *Wup1, *Wdn1;
    bf16_t* XB; float* SSQ; float* RINV; float* LB; float* KTAB; bf16_t* TG; bf16_t* HT; float* A16;
    bf16_t *Qh, *IV, *GS, *U; unsigned short* LOGF; bf16_t* UT; float* AL; float* XLOC; bf16_t* XPREV; bf16_t* YG; bf16_t* CAT;
    bf16_t* H;
    bf16_t *Q, *KP, *KS, *VTP, *VTS, *O; unsigned* BAR;
};

DI unsigned pk2(float lo, float hi) { unsigned r; asm volatile("v_cvt_pk_bf16_f32 %0, %1, %2" : "=v"(r) : "v"(lo), "v"(hi)); return r; }
DI float bflo(unsigned u) { return __uint_as_float(u << 16); }
DI float bfhi(unsigned u) { return __uint_as_float(u & 0xffff0000u); }
DI float bf2f(unsigned short b) { return __uint_as_float(((unsigned)b) << 16); }
DI unsigned short f2bf(float f) { return (unsigned short)(pk2(f, 0.f) & 0xffffu); }
DI unsigned pkh2(float lo, float hi) { union { _Float16 h[2]; unsigned u; } x; x.h[0] = (_Float16)lo; x.h[1] = (_Float16)hi; return x.u; }
DI float h2f(unsigned short h) { union { unsigned short s; _Float16 h; } x; x.s = h; return (float)x.h; }
DI float wave_sum(float v) {
#pragma unroll
    for (int o = 1; o < 64; o <<= 1) v += __shfl_xor(v, o);
    return v;
}
DI float fexp(float x) { return __expf(x); }
DI float sigm(float x) { return __builtin_amdgcn_rcpf(1.f + __expf(-x)); }
DI float row_rinv(const float* SSQ, int row) {
    const f32x4* s = (const f32x4*)(SSQ + (size_t)row * 16); f32x4 a = s[0] + s[1] + s[2] + s[3];
    return rsqrtf(((a.x + a.y) + (a.z + a.w)) * (1.f / 1024.f) + EPSN);
}
DI void rinv8(const float* SSQ, int row0, int fq, float (&r)[2][4]) {
    f32x4 v[2][4];
#pragma unroll
    for (int ai = 0; ai < 2; ++ai)
#pragma unroll
        for (int m = 0; m < 4; ++m) v[ai][m] = *(const f32x4*)(SSQ + (size_t)(row0 + ai * 128 + m * 16) * 16 + 4 * fq);
#pragma unroll
    for (int ai = 0; ai < 2; ++ai)
#pragma unroll
        for (int m = 0; m < 4; ++m) { float s = (v[ai][m].x + v[ai][m].y) + (v[ai][m].z + v[ai][m].w); s += __shfl_xor(s, 16); s += __shfl_xor(s, 32); r[ai][m] = rsqrtf(s * (1.f / 1024.f) + EPSN); }
}
#define LDS_WAIT() asm volatile("s_waitcnt lgkmcnt(0)" ::: "memory")

struct EpiIn0 {
    struct Pre { float r[2][4]; };
    DI void prefetch(Pre& pre, const Unit& u, int wr, int fr) const { const int row0 = u.pm * 256 + wr * 64 + fr;
#pragma unroll
        for (int ai = 0; ai < 2; ++ai)
#pragma unroll
            for (int m = 0; m < 4; ++m) pre.r[ai][m] = RINV[row0 + ai * 128 + m * 16]; }
    DI void scales(const Pre& pre, int row0, int fq, float (&rs)[2][4]) const {
        if (pre.r[0][0] > 0.f) {
#pragma unroll
            for (int ai = 0; ai < 2; ++ai)
#pragma unroll
                for (int m = 0; m < 4; ++m) rs[ai][m] = pre.r[ai][m]; }
        else rinv8(SSQ, row0, fq, rs);
    }
    static constexpr bool PERM = true, AFTER_DRAIN = false;
    const float* SSQ; const float* RINV; const float* LB; bf16_t *Qh, *IV, *GS, *U; unsigned short* LOGF;
    DI void operator()(const f32x4 (&acc)[2][2][4][2], const Unit& u, int wr, int wc, int fr, int fq, const Pre& pre) const {
        const int seg = u.pn >> 1, cb = (u.pn & 1) * 256 + wc * 32 + 8 * fq, row0 = u.pm * 256 + wr * 64 + fr;
        unsigned short* dst = seg == 0 ? Qh : seg == 1 ? LOGF : seg == 2 ? IV : seg == 3 ? GS : U;
        float rs[2][4]; scales(pre, row0, fq, rs);
        f32x4 lbv[2][2];
#pragma unroll
        for (int bj = 0; bj < 2; ++bj)
#pragma unroll
            for (int n = 0; n < 2; ++n) lbv[bj][n] = *(const f32x4*)(LB + cb + bj * 128 + 4 * n);
#pragma unroll
        for (int ai = 0; ai < 2; ++ai)
#pragma unroll
            for (int m = 0; m < 4; ++m) { const int row = row0 + ai * 128 + m * 16; const float r = rs[ai][m];
#pragma unroll
                for (int bj = 0; bj < 2; ++bj) { u32x4v o; unsigned w[4];
#pragma unroll
                    for (int n = 0; n < 2; ++n) { f32x4 v = acc[ai][bj][m][n] * r;
                        if (seg == 1) { const f32x4 lb = lbv[bj][n]; f32x4 f;
#pragma unroll
                            for (int e = 0; e < 4; ++e) f[e] = __logf(lb[e] + (1.f - lb[e]) * sigm(v[e]));
                            w[2 * n] = pkh2(f[0], f[1]); w[2 * n + 1] = pkh2(f[2], f[3]); }
                        else { if (seg == 3) {
#pragma unroll
                                for (int e = 0; e < 4; ++e) v[e] = v[e] * sigm(v[e]); }
                            w[2 * n] = pk2(v[0], v[1]); w[2 * n + 1] = pk2(v[2], v[3]); } }
                    o.x = w[0]; o.y = w[1]; o.z = w[2]; o.w = w[3];
                    *(u32x4v*)(dst + (size_t)row * 512 + cb + bj * 128) = o; } }
    }
};
struct EpiGlu {
    struct Pre {}; DI void prefetch(Pre&, const Unit&, int, int) const {}
    static constexpr bool PERM = true, AFTER_DRAIN = false;
    const bf16_t* YG; bf16_t* CAT;
    DI void operator()(const f32x4 (&acc)[2][2][4][2], const Unit& u, int wr, int wc, int fr, int fq, const Pre& pre) const {
        const int cb = u.pn * 256 + wc * 32 + 8 * fq, row0 = u.pm * 256 + wr * 64 + fr;
#pragma unroll
        for (int ai = 0; ai < 2; ++ai) {
            u32x4v y[4][2];
#pragma unroll
            for (int m = 0; m < 4; ++m)
#pragma unroll
                for (int bj = 0; bj < 2; ++bj) y[m][bj] = *(const u32x4v*)(YG + (size_t)(row0 + ai * 128 + m * 16) * 512 + cb + bj * 128);
#pragma unroll
            for (int m = 0; m < 4; ++m) { const int row = row0 + ai * 128 + m * 16;
#pragma unroll
                for (int bj = 0; bj < 2; ++bj) { const f32x4 v0 = acc[ai][bj][m][0], v1 = acc[ai][bj][m][1]; const u32x4v yy = y[m][bj]; u32x4v o;
                    o.x = pk2(bflo(yy.x) * sigm(v0[0]), bfhi(yy.x) * sigm(v0[1])); o.y = pk2(bflo(yy.y) * sigm(v0[2]), bfhi(yy.y) * sigm(v0[3]));
                    o.z = pk2(bflo(yy.z) * sigm(v1[0]), bfhi(yy.z) * sigm(v1[1])); o.w = pk2(bflo(yy.w) * sigm(v1[2]), bfhi(yy.w) * sigm(v1[3]));
                    *(u32x4v*)(CAT + (size_t)row * 1024 + 512 + cb + bj * 128) = o; } } }
    }
};
struct EpiRes {
    struct Pre {}; DI void prefetch(Pre&, const Unit&, int, int) const {}
    static constexpr bool PERM = true, AFTER_DRAIN = false;
    bf16_t* XB; float* SSQ;
    DI float upd(u32x4v* px, const u32x4v x, const f32x4 v0, const f32x4 v1) const {
        u32x4v o; o.x = pk2(bflo(x.x) + v0[0], bfhi(x.x) + v0[1]); o.y = pk2(bflo(x.y) + v0[2], bfhi(x.y) + v0[3]);
        o.z = pk2(bflo(x.z) + v1[0], bfhi(x.z) + v1[1]); o.w = pk2(bflo(x.w) + v1[2], bfhi(x.w) + v1[3]); *px = o;
        const float a0 = bflo(o.x), a1 = bfhi(o.x), a2 = bflo(o.y), a3 = bfhi(o.y), a4 = bflo(o.z), a5 = bfhi(o.z), a6 = bflo(o.w), a7 = bfhi(o.w);
        return ((a0 * a0 + a1 * a1) + (a2 * a2 + a3 * a3)) + ((a4 * a4 + a5 * a5) + (a6 * a6 + a7 * a7));
    }
    DI void row(const f32x4 (&a4)[2][2], const Unit& u, int ai, int m, int wr, int wc, int fr, int fq) const {
        const int cb = u.pn * 256 + wc * 32 + 8 * fq, row = u.pm * 256 + wr * 64 + fr + ai * 128 + m * 16;
        u32x4v* p0 = (u32x4v*)(XB + (size_t)row * 1024 + cb); u32x4v* p1 = (u32x4v*)(XB + (size_t)row * 1024 + cb + 128);
        const u32x4v x0 = *p0, x1 = *p1;
        float ss = upd(p0, x0, a4[0][0], a4[0][1]) + upd(p1, x1, a4[1][0], a4[1][1]);
        ss += __shfl_xor(ss, 16); ss += __shfl_xor(ss, 32);
        if (fq == 0) SSQ[(size_t)row * 16 + u.pn * 4 + wc] = ss;
    }
    DI void operator()(const f32x4 (&acc)[2][2][4][2], const Unit& u, int wr, int wc, int fr, int fq, const Pre& pre) const {
        const int cb = u.pn * 256 + wc * 32 + 8 * fq, row0 = u.pm * 256 + wr * 64 + fr;
#pragma unroll
        for (int ai = 0; ai < 2; ++ai) {
            u32x4v x[4][2];
#pragma unroll
            for (int m = 0; m < 4; ++m)
#pragma unroll
                for (int bj = 0; bj < 2; ++bj) x[m][bj] = *(const u32x4v*)(XB + (size_t)(row0 + ai * 128 + m * 16) * 1024 + cb + bj * 128);
#pragma unroll
            for (int m = 0; m < 4; ++m) { const int row = row0 + ai * 128 + m * 16;
                float ss = upd((u32x4v*)(XB + (size_t)row * 1024 + cb), x[m][0], acc[ai][0][m][0], acc[ai][0][m][1])
                         + upd((u32x4v*)(XB + (size_t)row * 1024 + cb + 128), x[m][1], acc[ai][1][m][0], acc[ai][1][m][1]);
                ss += __shfl_xor(ss, 16); ss += __shfl_xor(ss, 32);
                if (fq == 0) SSQ[(size_t)row * 16 + u.pn * 4 + wc] = ss; } }
    }
};
struct EpiUp {
    struct Pre { float r[2][4]; };
    DI void prefetch(Pre& pre, const Unit& u, int wr, int fr) const { const int row0 = u.pm * 256 + wr * 64 + fr;
#pragma unroll
        for (int ai = 0; ai < 2; ++ai)
#pragma unroll
            for (int m = 0; m < 4; ++m) pre.r[ai][m] = RINV[row0 + ai * 128 + m * 16]; }
    DI void scales(const Pre& pre, int row0, int fq, float (&rs)[2][4]) const {
        if (pre.r[0][0] > 0.f) {
#pragma unroll
            for (int ai = 0; ai < 2; ++ai)
#pragma unroll
                for (int m = 0; m < 4; ++m) rs[ai][m] = pre.r[ai][m]; }
        else rinv8(SSQ, row0, fq, rs);
    }
    static constexpr bool PERM = true, AFTER_DRAIN = false;
    const float* SSQ; const float* RINV; bf16_t* H;
    DI void operator()(const f32x4 (&acc)[2][2][4][2], const Unit& u, int wr, int wc, int fr, int fq, const Pre& pre) const {
        const int cb = u.pn * 256 + wc * 32 + 8 * fq, row0 = u.pm * 256 + wr * 64 + fr;
        float rs[2][4]; scales(pre, row0, fq, rs);
#pragma unroll
        for (int ai = 0; ai < 2; ++ai)
#pragma unroll
            for (int m = 0; m < 4; ++m) { const int row = row0 + ai * 128 + m * 16; const float r = rs[ai][m];
#pragma unroll
                for (int bj = 0; bj < 2; ++bj) { f32x4 v0 = acc[ai][bj][m][0] * r, v1 = acc[ai][bj][m][1] * r;
#pragma unroll
                    for (int e = 0; e < 4; ++e) { const float t0 = fmaxf(v0[e], 0.f), t1 = fmaxf(v1[e], 0.f); v0[e] = t0 * t0; v1[e] = t1 * t1; }
                    u32x4v o; o.x = pk2(v0[0], v0[1]); o.y = pk2(v0[2], v0[3]); o.z = pk2(v1[0], v1[1]); o.w = pk2(v1[2], v1[3]);
                    *(u32x4v*)(H + (size_t)row * 4096 + cb + bj * 128) = o; } }
    }
};
DI size_t kf_index(int seqh, int nkt, int key, int d) { return ((((size_t)seqh * nkt + (key >> 5)) * 8 + (d >> 4)) * 64 + ((key & 31) + 32 * ((d >> 3) & 1))) * 8 + (d & 7); }
DI size_t vf_index(int seqh, int nkt, int key, int d) { const int kk = key & 31;
    return ((((size_t)seqh * nkt + (key >> 5)) * 8 + (kk >> 4) * 4 + (d >> 5)) * 64 + ((d & 31) + 32 * ((kk >> 2) & 1))) * 8 + ((kk >> 3) & 1) * 4 + (kk & 3); }
struct EpiQkv {
    struct Pre { float r[2][4]; };
    DI void prefetch(Pre& pre, const Unit& u, int wr, int fr) const { const int row0 = u.pm * 256 + wr * 64 + fr;
#pragma unroll
        for (int ai = 0; ai < 2; ++ai)
#pragma unroll
            for (int m = 0; m < 4; ++m) pre.r[ai][m] = RINV[row0 + ai * 128 + m * 16]; }
    DI void scales(const Pre& pre, int row0, int fq, float (&rs)[2][4]) const {
        if (pre.r[0][0] > 0.f) {
#pragma unroll
            for (int ai = 0; ai < 2; ++ai)
#pragma unroll
                for (int m = 0; m < 4; ++m) rs[ai][m] = pre.r[ai][m]; }
        else rinv8(SSQ, row0, fq, rs);
    }
    static constexpr bool PERM = true, AFTER_DRAIN = false;
    const float* SSQ; const float* RINV; float* out; bf16_t *Q, *KP, *KS, *VTP, *VTS; LAS unsigned char* scr;
    DI void operator()(const f32x4 (&acc)[2][2][4][2], const Unit& u, int wr, int wc, int fr, int fq, const Pre& pre) const {
        const int third = u.pn >> 2, cb = (u.pn & 3) * 256 + wc * 32 + 8 * fq, row0 = u.pm * 256 + wr * 64 + fr;
        float rs[2][4]; scales(pre, row0, fq, rs);
        if (third == 2) {
            LAS unsigned char* ws = scr + (wr * 4 + wc) * 1024; const int ln = fr + 16 * fq, dl = ln & 31, hf = ln >> 5;
            LAS unsigned char* wsw = ws + fr * 64 + fq * 16; const LAS unsigned char* wsr = ws + hf * 256 + dl * 2;
#pragma unroll
            for (int ai = 0; ai < 2; ++ai)
#pragma unroll
                for (int m = 0; m < 4; ++m) { const int row = row0 + ai * 128 + m * 16; const float r = rs[ai][m];
                    const bool smp = row >= NTP; const int s = row - NTP; const int b = smp ? (s >> 6) : row / TP, key = smp ? 1024 + (s & 63) : row - b * TP, nkt = smp ? 34 : 129;
#pragma unroll
                    for (int bj = 0; bj < 2; ++bj) { const int cs = cb + bj * 128; const f32x4 v0 = acc[ai][bj][m][0] * r, v1 = acc[ai][bj][m][1] * r;
                        if (row < NT) { const int h = cs >> 7, d = cs & 127;
                            float* ov = out + (smp ? O_VS + (size_t)s * 1024 : O_VP + (size_t)row * 1024) + cs; *(f32x4*)ov = v0; *(f32x4*)(ov + 4) = v1;
                            u32x4v o; o.x = pk2(v0[0], v0[1]); o.y = pk2(v0[2], v0[3]); o.z = pk2(v1[0], v1[1]); o.w = pk2(v1[2], v1[3]);
                            *(LAS u32x4v*)wsw = o;
                            asm volatile("s_waitcnt lgkmcnt(0)" ::: "memory");
                            u32x4v t;
                            t.x = (unsigned)*(const LAS unsigned short*)(wsr) | ((unsigned)*(const LAS unsigned short*)(wsr + 64) << 16);
                            t.y = (unsigned)*(const LAS unsigned short*)(wsr + 128) | ((unsigned)*(const LAS unsigned short*)(wsr + 192) << 16);
                            t.z = (unsigned)*(const LAS unsigned short*)(wsr + 512) | ((unsigned)*(const LAS unsigned short*)(wsr + 576) << 16);
                            t.w = (unsigned)*(const LAS unsigned short*)(wsr + 640) | ((unsigned)*(const LAS unsigned short*)(wsr + 704) << 16);
                            *(u32x4v*)((smp ? VTS : VTP) + vf_index(b * 8 + h, nkt, key - fr, d & ~31) + ln * 8) = t;
                            asm volatile("s_waitcnt lgkmcnt(0)" ::: "memory"); } } }
            return; }
#pragma unroll
        for (int ai = 0; ai < 2; ++ai)
#pragma unroll
            for (int m = 0; m < 4; ++m) { const int row = row0 + ai * 128 + m * 16; const float r = rs[ai][m];
                const bool smp = row >= NTP; const int s = row - NTP; const int b = smp ? (s >> 6) : row / TP, key = smp ? 1024 + (s & 63) : row - b * TP, nkt = smp ? 34 : 129;
#pragma unroll
                for (int bj = 0; bj < 2; ++bj) { const int cs = cb + bj * 128; const f32x4 v0 = acc[ai][bj][m][0] * r, v1 = acc[ai][bj][m][1] * r;
                    u32x4v o; o.x = pk2(v0[0], v0[1]); o.y = pk2(v0[2], v0[3]); o.z = pk2(v1[0], v1[1]); o.w = pk2(v1[2], v1[3]);
                    if (third == 0) { *(u32x4v*)(Q + (size_t)row * 1024 + cs) = o; }
                    else if (row < NT) { const int h = cs >> 7, d = cs & 127;
                        float* ok = out + (smp ? O_KS + (size_t)s * 1024 : O_KP + (size_t)row * 1024) + cs; *(f32x4*)ok = v0; *(f32x4*)(ok + 4) = v1;
                        *(u32x4v*)((smp ? KS : KP) + kf_index(b * 8 + h, nkt, key, d)) = o; } } }
    }
};
struct EpiFin {
    struct Pre {}; DI void prefetch(Pre&, const Unit&, int, int) const {}
    static constexpr bool PERM = false, AFTER_DRAIN = false;
    const bf16_t* XB; float* SSQ; float* out;
    DI void row(const f32x4 (&a4)[2][2], const Unit& u, int ai, int m, int wr, int wc, int fr, int fq) const {
        const int cb = u.pn * 256 + wc * 32 + 4 * fq, row = u.pm * 256 + wr * 64 + fr + ai * 128 + m * 16; float ss = 0.f;
        const int b = row / TP, t = row - b * TP; const bool ok = row < NT && (row >= NTP || t >= 16);
        float* dst = out + (row >= NTP ? O_YS + (size_t)(row - NTP) * 1024 : O_YP + ((size_t)b * 4096 + (t - 16)) * 1024);
#pragma unroll
        for (int bj = 0; bj < 2; ++bj)
#pragma unroll
            for (int n = 0; n < 2; ++n) { const int cs = cb + bj * 128 + n * 16; f32x4 v = a4[bj][n];
                const u32x2 x = *(const u32x2*)(XB + (size_t)row * 1024 + cs);
                v[0] += bflo(x.x); v[1] += bfhi(x.x); v[2] += bflo(x.y); v[3] += bfhi(x.y);
                if (ok) *(f32x4*)(dst + cs) = v;
                ss += (v[0] * v[0] + v[1] * v[1]) + (v[2] * v[2] + v[3] * v[3]); }
        ss += __shfl_xor(ss, 16); ss += __shfl_xor(ss, 32);
        if (fq == 0) SSQ[(size_t)row * 16 + u.pn * 4 + wc] = ss;
    }
    DI void operator()(const f32x4 (&acc)[2][2][4][2], const Unit& u, int wr, int wc, int fr, int fq, const Pre& pre) const {
        const int cb = u.pn * 256 + wc * 32 + 4 * fq, row0 = u.pm * 256 + wr * 64 + fr;
#pragma unroll
        for (int ai = 0; ai < 2; ++ai) {
            u32x2 x[4][2][2];
#pragma unroll
            for (int m = 0; m < 4; ++m)
#pragma unroll
                for (int bj = 0; bj < 2; ++bj)
#pragma unroll
                    for (int n = 0; n < 2; ++n) x[m][bj][n] = *(const u32x2*)(XB + (size_t)(row0 + ai * 128 + m * 16) * 1024 + cb + bj * 128 + n * 16);
#pragma unroll
            for (int m = 0; m < 4; ++m) { const int row = row0 + ai * 128 + m * 16; float ss = 0.f;
                const int b = row / TP, t = row - b * TP; const bool ok = row < NT && (row >= NTP || t >= 16);
                float* dst = out + (row >= NTP ? O_YS + (size_t)(row - NTP) * 1024 : O_YP + ((size_t)b * 4096 + (t - 16)) * 1024);
#pragma unroll
                for (int bj = 0; bj < 2; ++bj)
#pragma unroll
                    for (int n = 0; n < 2; ++n) { const int cs = cb + bj * 128 + n * 16; f32x4 v = acc[ai][bj][m][n]; const u32x2 xx = x[m][bj][n];
                        v[0] += bflo(xx.x); v[1] += bfhi(xx.x); v[2] += bflo(xx.y); v[3] += bfhi(xx.y);
                        if (ok) *(f32x4*)(dst + cs) = v;
                        ss += (v[0] * v[0] + v[1] * v[1]) + (v[2] * v[2] + v[3] * v[3]); }
                ss += __shfl_xor(ss, 16); ss += __shfl_xor(ss, 32);
                if (fq == 0) SSQ[(size_t)row * 16 + u.pn * 4 + wc] = ss; } }
    }
};
template <class Epi> DI void run_gemm(LAS unsigned char* lds, const bf16_t* A, const bf16_t* Bt, int N, int K, const Epi& E) {
    pg8::Gemm g; g.A = A; g.Bt = Bt; g.M = MP; g.N = N; g.K = K; g.part = nullptr;
    pg8::StaticOrder S; S.init(MP, N, (int)gridDim.x, (int)blockIdx.x);
    pg8::gemm_phase<Epi, pg8::StaticOrder>(lds, g, S, E);
}
struct SplitOrder : pg8::StaticOrder {
    int nwhole, ntail, S, nks;
    DI void init2(int N, int K) { init(MP, N, (int)gridDim.x, (int)blockIdx.x); nwhole = nwg / G; ntail = nwg - nwhole * G; S = 0; nks = 0;
        if (ntail > 0) { int s = G / ntail; const int nkt = K / 64; while (s > 1 && (nkt % s != 0 || (nkt / s) < 4 || ((nkt / s) & 1))) --s; if (s > 1) { S = s; nks = nkt / s; } } }
    DI bool next(int i, Unit& u) const {
        if (S == 0) return pg8::StaticOrder::next(i, u);
        if (i < nwhole) { map(i * G + c, u); return true; }
        if (i == nwhole && c < ntail * S) { map(nwhole * G + c / S, u); u.kb = (c % S) * nks; u.nk = nks; u.part = c; return true; }
        return false;
    }
};
template <class Epi> DI void run_gemm_split(LAS unsigned char* lds, const bf16_t* A, const bf16_t* Bt, int N, int K, const Epi& E, float* part) {
    pg8::Gemm g; g.A = A; g.Bt = Bt; g.M = MP; g.N = N; g.K = K; g.part = part;
    SplitOrder S; S.init2(N, K);
    pg8::gemm_phase<Epi, SplitOrder>(lds, g, S, E);
}
template <class Epi> DI void gemm_fixup(int N, int K, const Epi& E, const float* part, int tid) {
    SplitOrder S; S.init2(N, K); if (S.S == 0) return;
    asm volatile("" : "+v"(tid));
    const int wid = tid >> 6, lane = tid & 63, wr = wid >> 2, wc = wid & 3, fr = lane & 15, fq = lane >> 4;
    for (int it = blockIdx.x; it < S.ntail * 8; it += gridDim.x) { const int j = it >> 3, ai = (it >> 2) & 1, m = it & 3; Unit u; S.map(S.nwhole * S.G + j, u);
        f32x4 a4[2][2];
#pragma unroll
        for (int b = 0; b < 2; ++b)
#pragma unroll
            for (int n = 0; n < 2; ++n) { const f32x4* pp = (const f32x4*)part + ((size_t)(j * S.S) * 32 + (((ai * 2 + b) * 4 + m) * 2 + n)) * 512 + tid;
                f32x4 v0 = {0.f, 0.f, 0.f, 0.f}, v1 = v0, v2 = v0, v3 = v0;
                for (int sl = 0; sl + 3 < S.S; sl += 4) { v0 += pp[(size_t)sl * 16384]; v1 += pp[(size_t)(sl + 1) * 16384]; v2 += pp[(size_t)(sl + 2) * 16384]; v3 += pp[(size_t)(sl + 3) * 16384]; }
                for (int sl = S.S & ~3; sl < S.S; ++sl) v0 += pp[(size_t)sl * 16384];
                a4[b][n] = (v0 + v1) + (v2 + v3); }
        E.row(a4, u, ai, m, wr, wc, fr, fq); }
}
DI void rinv_pass(const Prm& p, int K, int tid) {
    SplitOrder S; S.init2(1024, K);
    for (int pm = blockIdx.x; pm < MP / 256; pm += gridDim.x) {
        bool tail = false;
        if (S.S) for (int j = 0; j < S.ntail; ++j) { Unit u; S.map(S.nwhole * S.G + j, u); tail = tail || (u.pm == pm); }
        if (tid < 256) { const int row = pm * 256 + tid; float v = -1.f;
            if (!tail) { const f32x4* q = (const f32x4*)(p.SSQ + (size_t)row * 16); const f32x4 a = q[0] + q[1] + q[2] + q[3]; v = rsqrtf(((a.x + a.y) + (a.z + a.w)) * (1.f / 1024.f) + EPSN); }
            if (row >= NT) v = 1.f;
            p.RINV[row] = v; }
    }
}
DI void transpose_item(const float* W, int N, bf16_t* WT, size_t ldo, const float* sc, LAS float* scr, int item, int lane) {
    const int nblk = N / 32, kb = item / nblk, nb = item % nblk, k0 = 64 * kb, n0 = 32 * nb;
#pragma unroll 8
    for (int i = 0; i < 32; ++i) { const int kk = 2 * i + (lane >> 5); float w = W[(size_t)(k0 + kk) * N + n0 + (lane & 31)]; if (sc) w *= sc[k0 + kk]; scr[kk * 33 + (lane & 31)] = w; }
    LDS_WAIT();
    const int c = lane & 7;
#pragma unroll
    for (int j = 0; j < 4; ++j) { const int n = (lane >> 3) + 8 * j; const LAS float* s = scr + (8 * c) * 33 + n;
        u32x4v o; o.x = pk2(s[0 * 33], s[1 * 33]); o.y = pk2(s[2 * 33], s[3 * 33]); o.z = pk2(s[4 * 33], s[5 * 33]); o.w = pk2(s[6 * 33], s[7 * 33]);
        *(u32x4v*)(WT + (size_t)(n0 + n) * ldo + k0 + 8 * c) = o; }
    LDS_WAIT();
}
DI void s5_pow(const Prm& p, int g, int n, float k, float& re, float& im) {
    const float dt = __expf(p.log_dt[g]), ar = p.a_re[g * 64 + n], ai = p.a_im[g * 64 + n];
    const float mag = __expf(k * dt * ar); float rev = k * dt * ai * 0.15915494309189535f; rev -= rintf(rev);
    re = mag * __builtin_amdgcn_cosf(rev); im = mag * __builtin_amdgcn_sinf(rev);
}
DI void s5_bbar(const Prm& p, int g, int n, int pp, float& re, float& im) {
    const float ar = p.a_re[g * 64 + n], ai = p.a_im[g * 64 + n]; float abr, abi; s5_pow(p, g, n, 1.f, abr, abi);
    const float den = ar * ar + ai * ai, zr = ((abr - 1.f) * ar + abi * ai) / den, zi = (abi * ar - (abr - 1.f) * ai) / den;
    const float br = p.b_re[(g * 64 + n) * 16 + pp], bi = p.b_im[(g * 64 + n) * 16 + pp];
    re = zr * br - zi * bi; im = zr * bi + zi * br;
}
DI void phase_prologue(const Prm& p, LAS unsigned char* lds, int tid, int lane, int wave) {
    const int gw = blockIdx.x * 8 + wave, NGW = gridDim.x * 8, gtid = blockIdx.x * 512 + tid, GT = gridDim.x * 512;
    LAS float* scr = (LAS float*)(lds + wave * 16384);
    constexpr int I1 = 16 * 80, I2 = 8 * 16, I3 = 16 * 32, I4 = 16 * 128, I5 = 64 * 32, I6 = 16 * 96;
    constexpr int NITEMS = I1 + I2 + I3 + I4 + I5 + I6 + I3 + I4 + I5;
    for (int it = gw; it < NITEMS; it += NGW) {
        int r = it;
        if (r < I1) { transpose_item(p.w_in_even, 2560, p.Wt1, 1024, p.ln_mix, scr, r, lane); continue; } r -= I1;
        if (r < I2) { transpose_item(p.w_glu, 512, p.Wglu, 512, nullptr, scr, r, lane); continue; } r -= I2;
        if (r < I3) { transpose_item(p.w_out_even, 1024, p.Wo0, 1024, nullptr, scr, r, lane); continue; } r -= I3;
        if (r < I4) { transpose_item(p.w_up, 4096, p.Wup0, 1024, p.ln_mlp, scr, r, lane); continue; } r -= I4;
        if (r < I5) { transpose_item(p.w_down, 1024, p.Wdn0, 4096, nullptr, scr, r, lane); continue; } r -= I5;
        if (r < I6) { transpose_item(p.w_in_odd, 3072, p.Wqkv, 1024, p.ln_mix + 1024, scr, r, lane); continue; } r -= I6;
        if (r < I3) { transpose_item(p.w_out_odd, 1024, p.Wo1, 1024, nullptr, scr, r, lane); continue; } r -= I3;
        if (r < I4) { transpose_item(p.w_up + (size_t)1024 * 4096, 4096, p.Wup1, 1024, p.ln_mlp + 1024, scr, r, lane); continue; } r -= I4;
        transpose_item(p.w_down + (size_t)4096 * 1024, 1024, p.Wdn1, 4096, nullptr, scr, r, lane);
    }
    for (int row = gw; row < NT; row += NGW) {
        const float* src;
        if (row < NTP) { const int b = row / TP, t = row - b * TP; src = t < 16 ? p.meta + (size_t)t * 1024 : p.x_prompt + ((size_t)b * 4096 + (t - 16)) * 1024; }
        else src = p.x_sample + (size_t)(row - NTP) * 1024;
        float ss = 0.f;
#pragma unroll
        for (int j = 0; j < 4; ++j) { const f32x4 v = ((const f32x4*)src)[lane + 64 * j]; u32x2 o; o.x = pk2(v.x, v.y); o.y = pk2(v.z, v.w);
            const float a0 = bflo(o.x), a1 = bfhi(o.x), a2 = bflo(o.y), a3 = bfhi(o.y); ss += (a0 * a0 + a1 * a1) + (a2 * a2 + a3 * a3);
            ((u32x2*)(p.XB + (size_t)row * 1024))[lane + 64 * j] = o; }
        ss = wave_sum(ss);
        if (lane < 16) p.SSQ[(size_t)row * 16 + lane] = lane == 0 ? ss : 0.f;
        if (lane == 0) p.RINV[row] = rsqrtf(ss * (1.f / 1024.f) + EPSN);
    }
    if (gtid < MP - NT) p.RINV[NT + gtid] = 1.f;
    if (gtid < 512) p.LB[gtid] = 1.f / (1.f + __expf(p.hgrn_lb[512 + gtid] - p.hgrn_lb[gtid]));
    __syncthreads();
    {
        LAS float* zr_ = (LAS float*)lds; LAS float* zi_ = zr_ + 64; LAS float* wr_ = zi_ + 64; LAS float* wi_ = wr_ + 64;
        LAS float* bbr = wi_ + 64; LAS float* bbi = bbr + 1024; LAS float* cwr = bbi + 1024; LAS float* cwi = cwr + 16 * 65;
        for (int pair = blockIdx.x; pair < 512; pair += gridDim.x) { const int g = pair >> 4, tau = pair & 15;
            if (tid < 64) { const int n = tid; const float ar = p.a_re[g * 64 + n], ai = p.a_im[g * 64 + n]; float abr, abi; s5_pow(p, g, n, 1.f, abr, abi);
                const float den = ar * ar + ai * ai; zr_[n] = ((abr - 1.f) * ar + abi * ai) / den; zi_[n] = (abi * ar - (abr - 1.f) * ai) / den;
                float a, b; s5_pow(p, g, n, (float)tau, a, b); wr_[n] = a; wi_[n] = b; }
            __syncthreads();
#pragma unroll
            for (int k = 0; k < 2; ++k) { const int e = tid + 512 * k;
                { const int n = e >> 4; const float br = p.b_re[g * 1024 + e], bi = p.b_im[g * 1024 + e]; bbr[e] = zr_[n] * br - zi_[n] * bi; bbi[e] = zr_[n] * bi + zi_[n] * br; }
                { const int pch = e >> 6, n = e & 63; const float cr = p.c_re[g * 1024 + e], ci = p.c_im[g * 1024 + e]; cwr[pch * 65 + n] = cr * wr_[n] - ci * wi_[n]; cwi[pch * 65 + n] = cr * wi_[n] + ci * wr_[n]; } }
            __syncthreads();
            if (tid < 256) { const int pch = tid >> 4, pp = tid & 15; float acc = 0.f;
#pragma unroll 8
                for (int n = 0; n < 64; ++n) acc += cwr[pch * 65 + n] * bbr[n * 16 + pp] - cwi[pch * 65 + n] * bbi[n * 16 + pp];
                if (tau == 0 && pch == pp) acc += p.ssm_d[g * 16 + pch];
                const bf16_t kv = f2bf(acc);
                p.TG[((g * 16 + tau) * 16 + pch) * 16 + pp] = kv; }
            __syncthreads(); }
    }
    for (int i = gtid; i < 32 * 256 * 64; i += GT) {
        const int g = i >> 14, t = (i >> 10) & 15, pch = (i >> 6) & 15, n = i & 63; float wr_, wi_; s5_pow(p, g, n, (float)(t + 1), wr_, wi_);
        const float cr = p.c_re[(g * 16 + pch) * 64 + n], ci = p.c_im[(g * 16 + pch) * 64 + n];
        *(unsigned*)(p.TG + 131072 + ((size_t)(g * 256 + t * 16 + pch)) * 128 + 2 * n) = pk2(cr * wr_ - ci * wi_, -(cr * wi_ + ci * wr_)); }
    for (int i = gtid; i < 32 * 64 * 256; i += GT) {
        const int g = i >> 14, n = (i >> 8) & 63, s = (i >> 4) & 15, pp = i & 15; float wr_, wi_, br_, bi_; s5_pow(p, g, n, (float)(15 - s), wr_, wi_); s5_bbar(p, g, n, pp, br_, bi_);
        p.HT[((size_t)(g * 128 + 2 * n)) * 256 + s * 16 + pp] = f2bf(wr_ * br_ - wi_ * bi_);
        p.HT[((size_t)(g * 128 + 2 * n + 1)) * 256 + s * 16 + pp] = f2bf(wr_ * bi_ + wi_ * br_); }
    if (gtid < 2048) { float wr_, wi_; s5_pow(p, gtid >> 6, gtid & 63, 16.f, wr_, wi_); p.A16[2 * gtid] = wr_; p.A16[2 * gtid + 1] = wi_; }
}

constexpr int HP = 136, TPI = 72;
constexpr int L_QT = 0, L_QH = 17408, L_KT = 34816, L_KTT = 52224, L_IVT = 70656, L_ATT = 89088, L_SUM = 98304, L_VEC = 100352, L_OB = 0  ;
struct HItem { int row0, L, h, bh; };
DI HItem hgrn_item(int item) {
    HItem it;
    if (item < 2080) { const int bh = item / 65, c = item - bh * 65, b = bh >> 2; it.h = bh & 3; it.bh = bh; it.L = c == 0 ? 16 : 64; it.row0 = b * TP + (c == 0 ? 0 : 16 + 64 * (c - 1)); }
    else { const int s = item - 2080, b = s >> 2; it.h = s & 3; it.bh = 32 + s; it.L = 64; it.row0 = NTP + b * 64; }
    return it;
}
template <bool FULL> DI void hgrn_loadraw(const Prm& p, const HItem& it, int tid, unsigned (&rl)[16], unsigned (&rv)[16], unsigned (&rq)[16]) {
    const int d = tid & 127, t0 = 16 * (tid >> 7), col = it.h * 128 + d;
#pragma unroll
    for (int j = 0; j < 16; ++j) { const int t = t0 + j; const bool valid = t < it.L; const size_t o = (size_t)(it.row0 + t) * 512 + col;
        rl[j] = valid ? (unsigned)p.LOGF[o] : 0u; rv[j] = valid ? (unsigned)p.IV[o] : 0u; if (FULL) rq[j] = valid ? (unsigned)p.Qh[o] : 0u; }
}
template <bool FULL> DI void hgrn_prep(const HItem& it, LAS unsigned char* lds, int tid, const unsigned (&rl)[16], const unsigned (&rv)[16], const unsigned (&rq)[16]) {
    const int d = tid & 127, tq = tid >> 7, t0 = 16 * tq;
    LAS float* sums = (LAS float*)(lds + L_SUM); LAS float* vec = (LAS float*)(lds + L_VEC);
    float cs[16], lf[16];
    float run = 0.f;
#pragma unroll
    for (int j = 0; j < 16; ++j) { lf[j] = h2f((unsigned short)rl[j]); run += lf[j]; cs[j] = run; }
    sums[tq * 128 + d] = run;
    { LAS u32x4v* dst = (LAS u32x4v*)(lds + L_IVT + (d * TPI + t0) * 2); u32x4v a, b;
        a.x = rv[0] | (rv[1] << 16); a.y = rv[2] | (rv[3] << 16); a.z = rv[4] | (rv[5] << 16); a.w = rv[6] | (rv[7] << 16);
        b.x = rv[8] | (rv[9] << 16); b.y = rv[10] | (rv[11] << 16); b.z = rv[12] | (rv[13] << 16); b.w = rv[14] | (rv[15] << 16); dst[0] = a; dst[1] = b; }
    __syncthreads();
    const float s0 = sums[d], s1 = sums[128 + d], s2 = sums[256 + d], s3 = sums[384 + d];
    const float off = tq == 0 ? 0.f : tq == 1 ? s0 : tq == 2 ? s0 + s1 : s0 + s1 + s2, r = s0 + s1, bL = r + s2 + s3;
    if (tq == 0) { vec[d] = r; vec[128 + d] = bL; }
    unsigned ktp[8]; float kprev = 0.f;
#pragma unroll
    for (int j = 0; j < 16; ++j) { const int t = t0 + j; const bool valid = t < it.L; const float b = off + cs[j];
        const float kt = valid ? (1.f - __expf(lf[j])) * __expf(r - b) : 0.f;
        if (j & 1) ktp[j >> 1] = pk2(kprev, kt); else kprev = kt;
        if (FULL) { const float qv = bf2f((unsigned short)rq[j]);
            *(LAS unsigned short*)(lds + L_KT + (t * HP + d) * 2) = f2bf(kt);
            *(LAS unsigned short*)(lds + L_QT + (t * HP + d) * 2) = f2bf(qv * __expf(b - r));
            *(LAS unsigned short*)(lds + L_QH + (t * HP + d) * 2) = f2bf(qv * __expf(b)); } }
    if (!FULL) { LAS u32x4v* dst = (LAS u32x4v*)(lds + L_KTT + (d * TPI + t0) * 2); u32x4v a, b; a.x = ktp[0]; a.y = ktp[1]; a.z = ktp[2]; a.w = ktp[3]; b.x = ktp[4]; b.y = ktp[5]; b.z = ktp[6]; b.w = ktp[7]; dst[0] = a; dst[1] = b; }
    __syncthreads();
}
#define MFMA16(a, b, c) __builtin_amdgcn_mfma_f32_16x16x32_bf16((a), (b), (c), 0, 0, 0)
#define MFMA32(a, b, c) __builtin_amdgcn_mfma_f32_32x32x16_bf16((a), (b), (c), 0, 0, 0)
DI void hgrn_b1_all(const Prm& p, LAS unsigned char* lds, int tid, int lane, int wave) {
    const int fr = lane & 15, fq = lane >> 4;
    int item = blockIdx.x; if (item >= NITEM_H) return;
    unsigned rl[16], rv[16], rq[16];
    hgrn_loadraw<false>(p, hgrn_item(item), tid, rl, rv, rq);
    while (item < NITEM_H) {
        const HItem it = hgrn_item(item);
        hgrn_prep<false>(it, lds, tid, rl, rv, rq);
        const int next = item + gridDim.x;
        if (next < NITEM_H) hgrn_loadraw<false>(p, hgrn_item(next), tid, rl, rv, rq);
        const LAS float* vec = (const LAS float*)(lds + L_VEC);
        bf16x8 a[2];
#pragma unroll
        for (int ks = 0; ks < 2; ++ks) a[ks] = *(const LAS bf16x8*)(lds + L_KTT + ((16 * wave + fr) * TPI + 32 * ks + 8 * fq) * 2);
        float e2[4];
#pragma unroll
        for (int j = 0; j < 4; ++j) { const int d = 16 * wave + 4 * fq + j; e2[j] = __expf(vec[128 + d] - vec[d]); }
#pragma unroll
        for (int vt = 0; vt < 8; ++vt) { f32x4 acc = {0.f, 0.f, 0.f, 0.f};
#pragma unroll
            for (int ks = 0; ks < 2; ++ks) { const bf16x8 b = *(const LAS bf16x8*)(lds + L_IVT + ((16 * vt + fr) * TPI + 32 * ks + 8 * fq) * 2); acc = MFMA16(a[ks], b, acc); }
            u32x2 o; o.x = pk2(acc[0] * e2[0], acc[1] * e2[1]); o.y = pk2(acc[2] * e2[2], acc[3] * e2[3]);
            *(u32x2*)(p.UT + (size_t)item * 16384 + (16 * vt + fr) * 128 + 16 * wave + 4 * fq) = o; }
        if (tid < 128) p.AL[(size_t)item * 128 + tid] = __expf(vec[128 + tid]);
        __syncthreads();
        item = next;
    }
}
template <int NB> DI void hgrn_b2_steps(const Prm& p, int item, int v, int d4, float (&S)[4]) {
    u32x2 uu[NB]; f32x4 al[NB];
#pragma unroll
    for (int i = 0; i < NB; ++i) { uu[i] = *(const u32x2*)(p.UT + (size_t)(item + i) * 16384 + v * 128 + d4); al[i] = *(const f32x4*)(p.AL + (size_t)(item + i) * 128 + d4); }
#pragma unroll
    for (int i = 0; i < NB; ++i) { u32x2 o; o.x = pk2(S[0], S[1]); o.y = pk2(S[2], S[3]);
        *(u32x2*)(p.UT + (size_t)(item + i) * 16384 + v * 128 + d4) = o;
        S[0] = al[i][0] * S[0] + bflo(uu[i].x); S[1] = al[i][1] * S[1] + bfhi(uu[i].x); S[2] = al[i][2] * S[2] + bflo(uu[i].y); S[3] = al[i][3] * S[3] + bfhi(uu[i].y); }
}
DI void hgrn_b2(const Prm& p, int gtid, int GT) {
    for (int idx = gtid; idx < 64 * 4096; idx += GT) {
        const int bhx = idx >> 12, e = idx & 4095, v = e >> 5, d4 = (e & 31) * 4; const bool smp = bhx >= 32;
        float S[4] = {0.f, 0.f, 0.f, 0.f};
        if (smp) {
#pragma unroll
            for (int j = 0; j < 4; ++j) S[j] = p.state_hgrn[((size_t)(bhx - 32) * 128 + d4 + j) * 128 + v];
            hgrn_b2_steps<1>(p, 2080 + (bhx - 32), v, d4, S); }
        else { for (int c0 = 0; c0 < 65; c0 += 13) hgrn_b2_steps<13>(p, bhx * 65 + c0, v, d4, S); }
        float* dst = p.out + (smp ? O_HGS + (size_t)(bhx - 32) * 16384 : O_HGP + (size_t)bhx * 16384);
#pragma unroll
        for (int j = 0; j < 4; ++j) dst[(d4 + j) * 128 + v] = S[j];
    }
}
DI void hgrn_b3_all(const Prm& p, LAS unsigned char* lds, int tid, int lane, int wave) {
    const int fr = lane & 15, fq = lane >> 4;
    int item = blockIdx.x; if (item >= NITEM_H) return;
    unsigned rl[16], rv[16], rq[16];
    hgrn_loadraw<true>(p, hgrn_item(item), tid, rl, rv, rq);
    const int nt_ = tid >> 3, nsg = tid & 7;
    while (item < NITEM_H) {
        const HItem it = hgrn_item(item);
        bf16x8 sf[4][4];
#pragma unroll
        for (int i = 0; i < 4; ++i)
#pragma unroll
            for (int ks = 0; ks < 4; ++ks) sf[i][ks] = *(const bf16x8*)(p.UT + (size_t)item * 16384 + (16 * (4 * (wave >> 2) + i) + fr) * 128 + 32 * ks + 8 * fq);
        const size_t grow = (size_t)(it.row0 + (nt_ < it.L ? nt_ : 0)); const int gc0 = it.h * 128 + 16 * nsg;
        const u32x4v g0 = *(const u32x4v*)(p.GS + grow * 512 + gc0), g1 = *(const u32x4v*)(p.GS + grow * 512 + gc0 + 8);
        hgrn_prep<true>(it, lds, tid, rl, rv, rq);
        const int next = item + gridDim.x;
        if (next < NITEM_H) hgrn_loadraw<true>(p, hgrn_item(next), tid, rl, rv, rq);
        {
            const int tt = wave >> 1;
#pragma unroll
            for (int i = 0; i < 2; ++i) { const int st = 2 * (wave & 1) + i; f32x4 acc = {0.f, 0.f, 0.f, 0.f};
#pragma unroll
                for (int ks = 0; ks < 4; ++ks) { const bf16x8 a = *(const LAS bf16x8*)(lds + L_KT + ((16 * st + fr) * HP + 32 * ks + 8 * fq) * 2);
                    const bf16x8 b = *(const LAS bf16x8*)(lds + L_QT + ((16 * tt + fr) * HP + 32 * ks + 8 * fq) * 2); acc = MFMA16(a, b, acc); }
                const int t = 16 * tt + fr, s0 = 16 * st + 4 * fq;
                u32x2 o; o.x = pk2(s0 <= t ? acc[0] : 0.f, s0 + 1 <= t ? acc[1] : 0.f); o.y = pk2(s0 + 2 <= t ? acc[2] : 0.f, s0 + 3 <= t ? acc[3] : 0.f);
                *(LAS u32x2*)(lds + L_ATT + (t * TPI + s0) * 2) = o; }
        }
        __syncthreads();
        f32x4 oacc[4];
        {   const int tt = wave & 3;
            bf16x8 aa[2], aq[4];
#pragma unroll
            for (int ks = 0; ks < 2; ++ks) aa[ks] = *(const LAS bf16x8*)(lds + L_ATT + ((16 * tt + fr) * TPI + 32 * ks + 8 * fq) * 2);
#pragma unroll
            for (int ks = 0; ks < 4; ++ks) aq[ks] = *(const LAS bf16x8*)(lds + L_QH + ((16 * tt + fr) * HP + 32 * ks + 8 * fq) * 2);
#pragma unroll
            for (int i = 0; i < 4; ++i) { const int vt = 4 * (wave >> 2) + i; f32x4 acc = {0.f, 0.f, 0.f, 0.f};
#pragma unroll
                for (int ks = 0; ks < 2; ++ks) { const bf16x8 b = *(const LAS bf16x8*)(lds + L_IVT + ((16 * vt + fr) * TPI + 32 * ks + 8 * fq) * 2); acc = MFMA16(aa[ks], b, acc); }
#pragma unroll
                for (int ks = 0; ks < 4; ++ks) acc = MFMA16(aq[ks], sf[i][ks], acc);
                oacc[i] = acc; }
        }
        f32x4 gn[4];
#pragma unroll
        for (int j = 0; j < 4; ++j) gn[j] = ((const f32x4*)(p.hgrn_norm + 16 * nsg))[j];
        __syncthreads();
        {   const int tt = wave & 3; LAS float* ob = (LAS float*)(lds + L_OB);
#pragma unroll
            for (int i = 0; i < 4; ++i) { const int v = 16 * (4 * (wave >> 2) + i) + fr;
#pragma unroll
                for (int j = 0; j < 4; ++j) ob[(16 * tt + 4 * fq + j) * 132 + v] = oacc[i][j]; }
        }
        __syncthreads();
        {   const int t = nt_, sg = nsg; const LAS float* ob = (const LAS float*)(lds + L_OB) + t * 132 + 16 * sg;
            f32x4 x[4]; float ss = 0.f;
#pragma unroll
            for (int j = 0; j < 4; ++j) { x[j] = ((const LAS f32x4*)ob)[j]; ss += (x[j].x * x[j].x + x[j].y * x[j].y) + (x[j].z * x[j].z + x[j].w * x[j].w); }
            ss += __shfl_xor(ss, 1); ss += __shfl_xor(ss, 2); ss += __shfl_xor(ss, 4);
            const float rr = rsqrtf(ss * (1.f / 128.f) + EPSN);
            if (t < it.L) { const size_t row = it.row0 + t; const int c0 = it.h * 128 + 16 * sg;
                const f32x4 n0 = gn[0], n1 = gn[1], n2 = gn[2], n3 = gn[3];
                u32x4v o0, o1;
                o0.x = pk2(x[0].x * rr * n0.x * bflo(g0.x), x[0].y * rr * n0.y * bfhi(g0.x)); o0.y = pk2(x[0].z * rr * n0.z * bflo(g0.y), x[0].w * rr * n0.w * bfhi(g0.y));
                o0.z = pk2(x[1].x * rr * n1.x * bflo(g0.z), x[1].y * rr * n1.y * bfhi(g0.z)); o0.w = pk2(x[1].z * rr * n1.z * bflo(g0.w), x[1].w * rr * n1.w * bfhi(g0.w));
                o1.x = pk2(x[2].x * rr * n2.x * bflo(g1.x), x[2].y * rr * n2.y * bfhi(g1.x)); o1.y = pk2(x[2].z * rr * n2.z * bflo(g1.y), x[2].w * rr * n2.w * bfhi(g1.y));
                o1.z = pk2(x[3].x * rr * n3.x * bflo(g1.z), x[3].y * rr * n3.y * bfhi(g1.z)); o1.w = pk2(x[3].z * rr * n3.z * bflo(g1.w), x[3].w * rr * n3.w * bfhi(g1.w));
                *(u32x4v*)(p.CAT + row * 1024 + c0) = o0; *(u32x4v*)(p.CAT + row * 1024 + c0 + 8) = o1; }
        }
        __syncthreads();
        item = next;
    }
}
DI void s5_load_u(const Prm& p, int mt, int g, int lane, bf16x8 (&uf)[8]) {
    const int fr = lane & 15, fq = lane >> 4; int col = 16 * mt + fr; if (col >= NCOL) col = NCOL - 1;
#pragma unroll
    for (int ks = 0; ks < 8; ++ks) uf[ks] = *(const bf16x8*)(p.U + ((size_t)(16 * col + 2 * ks + (fq >> 1))) * 512 + 16 * g + 8 * (fq & 1));
}
DI void s5_b(const Prm& p, int gw, int NGW, int lane) {
    const int fr = lane & 15, fq = lane >> 4;
    for (int task = gw; task < 131 * 32; task += NGW) { const int mt = task >> 5, g = task & 31;
        bf16x8 uf[8]; s5_load_u(p, mt, g, lane, uf);
#pragma unroll
        for (int nt = 0; nt < 8; ++nt) { f32x4 acc = {0.f, 0.f, 0.f, 0.f};
#pragma unroll
            for (int ks = 0; ks < 8; ++ks) { const bf16x8 b = *(const bf16x8*)(p.HT + ((size_t)(g * 128 + 16 * nt + fr)) * 256 + 32 * ks + 8 * fq); acc = MFMA16(uf[ks], b, acc); }
#pragma unroll
            for (int j = 0; j < 4; ++j) { const int col = 16 * mt + 4 * fq + j; if (col < NCOL) p.XLOC[(size_t)col * 4096 + g * 128 + 16 * nt + fr] = acc[j]; } }
    }
}
template <int NB> DI void s5_c_steps(const Prm& p, int col, size_t base, float ar, float ai, float& xr, float& xi) {
    f32x2v xl[NB];
#pragma unroll
    for (int i = 0; i < NB; ++i) xl[i] = *(const f32x2v*)(p.XLOC + (size_t)(col + i) * 4096 + base);
#pragma unroll
    for (int i = 0; i < NB; ++i) { *(unsigned*)(p.XPREV + (size_t)(col + i) * 4096 + base) = pk2(xr, xi);
        const float nr = ar * xr - ai * xi + xl[i].x, ni = ar * xi + ai * xr + xl[i].y; xr = nr; xi = ni; }
}
DI void s5_c(const Prm& p, int gtid) {
    if (gtid >= 16 * 2048) return;
    const int seq = gtid >> 11, g = (gtid >> 6) & 31, n = gtid & 63; const bool smp = seq >= 8; const int b = seq & 7;
    float xr = 0.f, xi = 0.f; if (smp) { xr = p.ssm_re0[(b * 32 + g) * 64 + n]; xi = p.ssm_im0[(b * 32 + g) * 64 + n]; }
    const float ar = p.A16[2 * (g * 64 + n)], ai = p.A16[2 * (g * 64 + n) + 1];
    const size_t base = (size_t)g * 128 + 2 * n;
    if (smp) s5_c_steps<4>(p, 2056 + 4 * b, base, ar, ai, xr, xi);
    else { for (int c0 = 0; c0 < 256; c0 += 16) s5_c_steps<16>(p, 257 * b + c0, base, ar, ai, xr, xi); s5_c_steps<1>(p, 257 * b + 256, base, ar, ai, xr, xi); }
    const size_t o = (size_t)(b * 32 + g) * 64 + n;
    p.out[(smp ? O_SRS : O_SRP) + o] = xr; p.out[(smp ? O_SIS : O_SIP) + o] = xi;
}
DI f32x2v gelu_pk(f32x2v v) {
    const f32x2v av = __builtin_elementwise_abs(v), d = av * 0.2316418882f + 1.0f;
    f32x2v t; t.x = __builtin_amdgcn_rcpf(d.x); t.y = __builtin_amdgcn_rcpf(d.y);
    f32x2v q = t * 0.5307027145f + (-0.7265760135f); q = q * t + 0.7107068705f; q = q * t + (-0.142248368f); q = q * t + 0.127414796f; q = q * t;
    const f32x2v s = (v * v) * (-0.72134752044f);
    f32x2v e; e.x = __builtin_amdgcn_exp2f(s.x); e.y = __builtin_amdgcn_exp2f(s.y);
    const f32x2v m = v * (q * e), r = v - m;
    f32x2v o; o.x = v.x < 0.f ? m.x : r.x; o.y = v.y < 0.f ? m.y : r.y; return o;
}
DI void s5_d(const Prm& p, int gw, int NGW, int lane) {
    const int fr = lane & 15, fq = lane >> 4;
    for (int task = gw; task < 131 * 32; task += NGW) { const int mt = task >> 5, g = task & 31;
        bf16x8 uf[8], xf[4]; s5_load_u(p, mt, g, lane, uf);
        int colc = 16 * mt + fr; if (colc >= NCOL) colc = NCOL - 1;
#pragma unroll
        for (int ks = 0; ks < 4; ++ks) xf[ks] = *(const bf16x8*)(p.XPREV + (size_t)colc * 4096 + g * 128 + 32 * ks + 8 * fq);
        const bf16_t* tg = p.TG + ((size_t)(g * 256 + fr)) * 384 + 8 * fq;
        const bool ok = 16 * mt + fr < NCOL;
#pragma unroll
        for (int t = 0; t < 16; ++t) { f32x4 acc = {0.f, 0.f, 0.f, 0.f};
#pragma unroll
            for (int ks = 0; ks < 8; ++ks) if (ks <= (t >> 1)) { const bf16x8 a = *(const bf16x8*)(tg + (size_t)t * 16 * 384 + 32 * ks); acc = MFMA16(a, uf[ks], acc); }
#pragma unroll
            for (int ks = 0; ks < 4; ++ks) { const bf16x8 a = *(const bf16x8*)(tg + (size_t)t * 16 * 384 + 256 + 32 * ks); acc = MFMA16(a, xf[ks], acc); }
            const f32x2v y0 = gelu_pk((f32x2v){acc[0], acc[1]}), y1 = gelu_pk((f32x2v){acc[2], acc[3]});
            u32x2 o; o.x = pk2(y0.x, y0.y); o.y = pk2(y1.x, y1.y);
            if (ok) *(u32x2*)(p.YG + ((size_t)(16 * (16 * mt + fr) + t)) * 512 + 16 * g + 4 * fq) = o; }
    }
}

DI void s5_b_lds(const Prm& p, LAS unsigned char* lds, int tid, int lane, int wave) {
    const int fr = lane & 15, fq = lane >> 4;
    for (int gp = blockIdx.x; gp < 256; gp += gridDim.x) { const int g = gp & 31, part = gp >> 5;
        for (int i = tid; i < 128 * 32; i += 512) { const int row = i >> 5, ch = i & 31;
            *(LAS u32x4v*)(lds + row * 528 + ch * 16) = *(const u32x4v*)(p.HT + ((size_t)(g * 128 + row)) * 256 + ch * 8); }
        __syncthreads();
        for (int mt = part + 8 * wave; mt < 131; mt += 64) {
            bf16x8 uf[8]; s5_load_u(p, mt, g, lane, uf);
#pragma unroll 1
            for (int nt = 0; nt < 8; ++nt) { f32x4 acc = {0.f, 0.f, 0.f, 0.f};
#pragma unroll
                for (int ks = 0; ks < 8; ++ks) { const bf16x8 b = *(const LAS bf16x8*)(lds + (16 * nt + fr) * 528 + 64 * ks + 16 * fq); acc = MFMA16(uf[ks], b, acc); }
#pragma unroll
                for (int j = 0; j < 4; ++j) { const int col = 16 * mt + 4 * fq + j; if (col < NCOL) p.XLOC[(size_t)col * 4096 + g * 128 + 16 * nt + fr] = acc[j]; } }
        }
        __syncthreads(); }
}
DI void s5_d_lds(const Prm& p, LAS unsigned char* lds, int tid, int lane, int wave) {
    const int fr = lane & 15, fq = lane >> 4;
    for (int gp = blockIdx.x; gp < 256; gp += gridDim.x) { const int g = gp & 31, part = gp >> 5;
        { const int row = tid >> 1, hf = tid & 1;
            *(LAS u32x4v*)(lds + row * 48 + hf * 16) = *(const u32x4v*)(p.TG + ((size_t)(g * 256 + row)) * 16 + hf * 8); }
        for (int i = tid; i < 256 * 16; i += 512) { const int row = i >> 4, ch = i & 15;
            *(LAS u32x4v*)(lds + 12288 + row * 272 + ch * 16) = *(const u32x4v*)(p.TG + 131072 + ((size_t)(g * 256 + row)) * 128 + ch * 8); }
        __syncthreads();
        const int lb = fr * 48 + (fq & 1) * 16, hi = fq >> 1;
        for (int mt = part + 8 * wave; mt < 131; mt += 64) {
            bf16x8 uf[8], xf[4]; s5_load_u(p, mt, g, lane, uf);
            int colc = 16 * mt + fr; if (colc >= NCOL) colc = NCOL - 1;
#pragma unroll
            for (int ks = 0; ks < 4; ++ks) xf[ks] = *(const bf16x8*)(p.XPREV + (size_t)colc * 4096 + g * 128 + 32 * ks + 8 * fq);
            const bool ok = 16 * mt + fr < NCOL;
#pragma unroll 1
            for (int t = 0; t < 16; ++t) { f32x4 acc = {0.f, 0.f, 0.f, 0.f};
#pragma unroll
                for (int ks = 0; ks < 8; ++ks) if (ks <= (t >> 1)) {
                    const int tau = t - 2 * ks - hi;
                    union { bf16x8 v; u32x4v u; } a; a.v = *(const LAS bf16x8*)(lds + (tau < 0 ? 0 : tau) * 768 + lb);
                    if (tau < 0) a.u = (u32x4v){0u, 0u, 0u, 0u};
                    acc = MFMA16(a.v, uf[ks], acc); }
#pragma unroll
                for (int ks = 0; ks < 4; ++ks) { const bf16x8 a = *(const LAS bf16x8*)(lds + 12288 + (t * 16 + fr) * 272 + 64 * ks + 16 * fq); acc = MFMA16(a, xf[ks], acc); }
                const f32x2v y0 = gelu_pk((f32x2v){acc[0], acc[1]}), y1 = gelu_pk((f32x2v){acc[2], acc[3]});
                u32x2 o; o.x = pk2(y0.x, y0.y); o.y = pk2(y1.x, y1.y);
                if (ok) *(u32x2*)(p.YG + ((size_t)(16 * (16 * mt + fr) + t)) * 512 + 16 * g + 4 * fq) = o; }
        }
        __syncthreads(); }
}
DI void cache_convert(const Prm& p, int gtid, int GT) {
    for (size_t i = (size_t)gtid; i < (size_t)8 * 1024 * 256; i += (size_t)GT) {
        const size_t row = i >> 8; const int c4 = (int)(i & 255) * 4, b = (int)(row >> 10), pos = (int)(row & 1023), h = c4 >> 7, d = c4 & 127;
        const f32x4 k = *(const f32x4*)(p.cache_k + row * 1024 + c4); u32x2 o; o.x = pk2(k.x, k.y); o.y = pk2(k.z, k.w);
        *(u32x2*)(p.KS + kf_index(b * 8 + h, 34, pos, d)) = o;
        const f32x4 v = *(const f32x4*)(p.cache_v + row * 1024 + c4); bf16_t* vt = p.VTS + vf_index(b * 8 + h, 34, pos, d);
        vt[0] = f2bf(v.x); vt[8] = f2bf(v.y); vt[16] = f2bf(v.z); vt[24] = f2bf(v.w); }
}
DI void attn_phase(const Prm& p, LAS unsigned char* lds, int wave, int gw, int NGW, int lane) {
    const int q = lane & 31, half = lane >> 5;
    LAS unsigned char* wl = lds + wave * 16384;
    for (int it = gw; it < 8256 + 128; it += NGW) {
        bool smp; int b, h, qb;
        if (it < 8064) { smp = false; b = it / 1008; const int rem = it - b * 1008; h = rem / 126; qb = 3 + rem - h * 126; }
        else if (it < 8192) { const int s = it - 8064; smp = true; b = s >> 4; h = (s >> 1) & 7; qb = s & 1; }
        else { const int s = it - 8192; smp = false; b = s / 24; const int rem = s - b * 24; h = rem / 3; qb = rem - h * 3; }
        const size_t tbase = (size_t)(b * 8 + h) * (smp ? 34 : 129) * 4096 + lane * 8;
        const bf16_t* Kb = (smp ? p.KS : p.KP) + tbase; const bf16_t* Vb = (smp ? p.VTS : p.VTP) + tbase;
        const int qpos0 = (smp ? 1024 : 0) + 32 * qb, qrow0 = smp ? NTP + b * 64 + 32 * qb : b * TP + 32 * qb;
        const int qpos = qpos0 + q; const bool qvalid = smp || qpos < TP; const size_t qrow = qvalid ? qrow0 + q : qrow0;
        bf16x8 qf[8];
#pragma unroll
        for (int ks = 0; ks < 8; ++ks) qf[ks] = *(const bf16x8*)(p.Q + qrow * 1024 + h * 128 + 16 * ks + 8 * half);
        f32x16 o[4];
#pragma unroll
        for (int db = 0; db < 4; ++db)
#pragma unroll
            for (int e = 0; e < 16; ++e) o[db][e] = 0.f;
        float C = 1.f;
        for (int kt = (qpos0 + 30) >> 5; kt >= 0; --kt) {
            f32x16 s;
#pragma unroll
            for (int e = 0; e < 16; ++e) s[e] = 0.f;
            const bf16_t* kr = Kb + (size_t)kt * 4096; const bf16_t* vr = Vb + (size_t)kt * 4096;
            bf16x8 kf[8], vf[8];
#pragma unroll
            for (int ks = 0; ks < 8; ++ks) kf[ks] = *(const bf16x8*)(kr + ks * 512);
#pragma unroll
            for (int ks = 0; ks < 8; ++ks) vf[ks] = *(const bf16x8*)(vr + ks * 512);
#pragma unroll
            for (int ks = 0; ks < 8; ++ks) s = MFMA32(kf[ks], qf[ks], s);
            float pr[16], be[16], G[4], Gp[4];
#pragma unroll
            for (int i = 0; i < 4; ++i) {
#pragma unroll
                for (int j = 0; j < 4; ++j) { const int key = 32 * kt + 8 * i + 4 * half + j; const bool valid = key < qpos;
                    float z = s[4 * i + j] * 0.08838834764831845f; z = fminf(fmaxf(z, -80.f), 80.f);
                    const float e = __expf(z), pp = __builtin_amdgcn_rcpf(1.f + e); pr[4 * i + j] = valid ? pp : 1.f; be[4 * i + j] = valid ? e * pp : 0.f; }
                G[i] = (pr[4 * i] * pr[4 * i + 1]) * (pr[4 * i + 2] * pr[4 * i + 3]); }
#pragma unroll
            for (int i = 0; i < 4; ++i) Gp[i] = __shfl_xor(G[i], 32);
            float w[16]; float E1 = 1.f;
#pragma unroll
            for (int i = 3; i >= 0; --i) { const float Glo = half ? Gp[i] : G[i], Ghi = half ? G[i] : Gp[i];
                float suf = C * (half ? E1 : E1 * Ghi);
#pragma unroll
                for (int j = 3; j >= 0; --j) { w[4 * i + j] = be[4 * i + j] * suf; suf *= pr[4 * i + j]; }
                E1 *= Glo * Ghi; }
            C *= E1;
#pragma unroll
            for (int c = 0; c < 2; ++c) { union { bf16x8 v; unsigned u[4]; } wf;
#pragma unroll
                for (int e = 0; e < 4; ++e) wf.u[e] = pk2(w[8 * c + 2 * e], w[8 * c + 2 * e + 1]);
#pragma unroll
                for (int db = 0; db < 4; ++db) o[db] = MFMA32(vf[4 * c + db], wf.v, o[db]); }
            if (__all(C < 1e-24f)) break;
        }
#pragma unroll
        for (int db = 0; db < 4; ++db)
#pragma unroll
            for (int i = 0; i < 4; ++i) { u32x2 ov; ov.x = pk2(o[db][4 * i], o[db][4 * i + 1]); ov.y = pk2(o[db][4 * i + 2], o[db][4 * i + 3]);
                *(LAS u32x2*)(wl + q * 272 + (32 * db + 8 * i + 4 * half) * 2) = ov; }
#pragma unroll
        for (int k = 0; k < 8; ++k) { const int r = (lane >> 4) + 4 * k, ch = lane & 15;
            const u32x4v v = *(const LAS u32x4v*)(wl + r * 272 + ch * 16);
            if (smp || qpos0 + r < TP) *(u32x4v*)(p.O + (size_t)(qrow0 + r) * 1024 + h * 128 + ch * 8) = v; }
    }
}
DI void final_norm(const Prm& p, int gw, int NGW, int lane) {
    for (int r = gw; r < 32768 + 512; r += NGW) {
        int grow; float* dst;
        if (r < 32768) { const int b = r >> 12, t = r & 4095; grow = b * TP + 16 + t; dst = p.out + O_YP + (size_t)r * 1024; } else { grow = NTP + (r - 32768); dst = p.out + O_YS + (size_t)(r - 32768) * 1024; }
        u32x2 x[4];
#pragma unroll
        for (int j = 0; j < 4; ++j) x[j] = ((const u32x2*)(p.XB + (size_t)grow * 1024))[lane + 64 * j];
        const float rr = row_rinv(p.SSQ, grow);
#pragma unroll
        for (int j = 0; j < 4; ++j) { f32x4 v; v.x = bflo(x[j].x); v.y = bfhi(x[j].x); v.z = bflo(x[j].y); v.w = bfhi(x[j].y); ((f32x4*)dst)[lane + 64 * j] = v * rr * ((const f32x4*)p.ln_final)[lane + 64 * j]; }
    }
}

#define XB_TMO      128
#define XB_XCNT(j)  (256  + 64 * (j))
#define XB_XSUB(j)  (1280 + 64 * (j))
#define XB_XGEN(j)  (2304 + 64 * (j))
#define XB_TOP      3328
#define XB_TOPGEN   3392
#define XCD_BAR_WORDS 3456
#define XB_SPIN_CAP (1u << 18)
DI unsigned xb_ld(unsigned* p) { return __hip_atomic_load(p, __ATOMIC_RELAXED, __HIP_MEMORY_SCOPE_AGENT); }
DI unsigned xb_add(unsigned* p, unsigned v) { return __hip_atomic_fetch_add(p, v, __ATOMIC_RELAXED, __HIP_MEMORY_SCOPE_AGENT); }
DI unsigned xb_xcc_id() { return (unsigned)__builtin_amdgcn_s_getreg((3 << 11) | 20) & 0xFu; }
#define XB_SPIN(cond, bar) do { unsigned _sp = 0; while (cond) { __builtin_amdgcn_s_sleep(1); \
    if ((++_sp & 255u) == 0u) { if (xb_ld(&(bar)[XB_TMO])) break; if (_sp > XB_SPIN_CAP) { atomicAdd(&(bar)[XB_TMO], 1u); break; } } } } while (0)
struct XcdBarrier { unsigned* bar; unsigned x; volatile LAS unsigned* st; };
DI XcdBarrier xcd_barrier_post(unsigned* bar, volatile LAS unsigned* st) {
    XcdBarrier b; b.bar = bar; b.x = xb_xcc_id(); b.st = st;
    if (threadIdx.x == 0) (void)xb_add(&bar[XB_XCNT(b.x)], 1u);
    return b;
}
DI void xcd_barrier_complete(unsigned* bar, unsigned x, unsigned& nloc, unsigned& nx) {
    const unsigned G = gridDim.x * gridDim.y * gridDim.z;
    unsigned sum, cnt, mine, sp = 0u;
    for (;;) {
        sum = 0u; cnt = 0u; mine = 0u;
#pragma unroll
        for (unsigned j = 0; j < 16; ++j) { const unsigned c = xb_ld(&bar[XB_XCNT(j)]); sum += c; cnt += (c > 0u) ? 1u : 0u; mine = (j == x) ? c : mine; }
        if (sum == G) break;
        __builtin_amdgcn_s_sleep(1);
        if ((++sp & 255u) == 0u) { if (xb_ld(&bar[XB_TMO])) break; if (sp > XB_SPIN_CAP) { atomicAdd(&bar[XB_TMO], 1u); break; } }
    }
    nloc = mine > 0u ? mine : 1u; nx = cnt > 0u ? cnt : 1u;
}
DI void xcd_barrier(const XcdBarrier& b) {
    asm volatile("s_waitcnt vmcnt(0)" ::: "memory");
    __syncthreads();
    if (threadIdx.x == 0) {
        unsigned* bar = b.bar;
        __builtin_amdgcn_s_waitcnt(0);
        unsigned nloc = b.st[0], nx = b.st[1];
        if (nloc == 0u) { xcd_barrier_complete(bar, b.x, nloc, nx); b.st[0] = nloc; b.st[1] = nx; }
        const unsigned old = xb_add(&bar[XB_XSUB(b.x)], 1u);
        const unsigned gen = old / nloc;
        if (old + 1u == (gen + 1u) * nloc) {
            __builtin_amdgcn_fence(__ATOMIC_RELEASE, "agent");
            asm volatile("s_waitcnt vmcnt(0)" ::: "memory");
            const unsigned og = xb_add(&bar[XB_TOP], 1u);
            const unsigned tg = og / nx;
            if (og + 1u == (tg + 1u) * nx) xb_add(&bar[XB_TOPGEN], 1u);
            else XB_SPIN(xb_ld(&bar[XB_TOPGEN]) == tg, bar);
            __builtin_amdgcn_fence(__ATOMIC_ACQUIRE, "agent");
            xb_add(&bar[XB_XGEN(b.x)], 1u);
            asm volatile("s_waitcnt vmcnt(0)" ::: "memory");
        } else {
            XB_SPIN(xb_ld(&bar[XB_XGEN(b.x)]) == gen, bar);
            __builtin_amdgcn_fence(__ATOMIC_ACQUIRE, "agent");
            asm volatile("s_waitcnt vmcnt(0)" ::: "memory");
        }
    }
    __syncthreads();
}
constexpr int LDS_BYTES = 131072 + 256 + 8192;
__global__ void __launch_bounds__(512, 2) fwd_megakernel(Prm p) {
    extern __shared__ __attribute__((aligned(16))) unsigned char shm[];
    LAS unsigned char* lds = (LAS unsigned char*)shm;
    cg::grid_group grid = cg::this_grid();
    const int tid = threadIdx.x, lane = tid & 63, wave = __builtin_amdgcn_readfirstlane(tid >> 6);
    const int gw = blockIdx.x * 8 + wave, NGW = gridDim.x * 8, gtid = blockIdx.x * 512 + tid, GT = gridDim.x * 512;
    volatile LAS unsigned* xst = (volatile LAS unsigned*)(lds + 131072);
    if (tid == 0) { xst[0] = 0u; xst[1] = 0u; }
    __syncthreads();
    const XcdBarrier xb = xcd_barrier_post(p.BAR, xst);
    phase_prologue(p, lds, tid, lane, wave);
    xcd_barrier(xb);
    if (p.out == nullptr) grid.sync();
    { EpiIn0 E; E.SSQ = p.SSQ; E.RINV = p.RINV; E.LB = p.LB; E.Qh = p.Qh; E.IV = p.IV; E.GS = p.GS; E.U = p.U; E.LOGF = p.LOGF; run_gemm(lds, p.XB, p.Wt1, 2560, 1024, E); }
    xcd_barrier(xb);
    hgrn_b1_all(p, lds, tid, lane, wave);
    s5_b_lds(p, lds, tid, lane, wave);
    xcd_barrier(xb);
    if (gridDim.x == 256) {
        if (blockIdx.x < 192) hgrn_b2(p, gtid, 192 * 512); else s5_c(p, (int)(blockIdx.x - 192) * 512 + tid); }
    else { hgrn_b2(p, gtid, GT); s5_c(p, gtid); }
    xcd_barrier(xb);
    hgrn_b3_all(p, lds, tid, lane, wave);
    s5_d_lds(p, lds, tid, lane, wave);
    xcd_barrier(xb);
    { EpiGlu E; E.YG = p.YG; E.CAT = p.CAT; run_gemm(lds, p.YG, p.Wglu, 512, 512, E); }
    xcd_barrier(xb);
    { EpiRes E; E.XB = p.XB; E.SSQ = p.SSQ; run_gemm_split(lds, p.CAT, p.Wo0, 1024, 1024, E, (float*)p.H); xcd_barrier(xb); gemm_fixup(1024, 1024, E, (const float*)p.H, tid); rinv_pass(p, 1024, tid); }
    xcd_barrier(xb);
    { EpiUp E; E.SSQ = p.SSQ; E.RINV = p.RINV; E.H = p.H; run_gemm(lds, p.XB, p.Wup0, 4096, 1024, E); }
    xcd_barrier(xb);
    { EpiRes E; E.XB = p.XB; E.SSQ = p.SSQ; run_gemm_split(lds, p.H, p.Wdn0, 1024, 4096, E, (float*)p.CAT); xcd_barrier(xb); gemm_fixup(1024, 4096, E, (const float*)p.CAT, tid); rinv_pass(p, 4096, tid); }
    xcd_barrier(xb);
    { EpiQkv E; E.scr = lds + 131328; E.SSQ = p.SSQ; E.RINV = p.RINV; E.out = p.out; E.Q = p.Q; E.KP = p.KP; E.KS = p.KS; E.VTP = p.VTP; E.VTS = p.VTS; run_gemm(lds, p.XB, p.Wqkv, 3072, 1024, E); }
    if (gridDim.x > 36) { if (blockIdx.x >= 36) cache_convert(p, (blockIdx.x - 36) * 512 + tid, (gridDim.x - 36) * 512); } else cache_convert(p, gtid, GT);
    xcd_barrier(xb);
    attn_phase(p, lds, wave, gw, NGW, lane);
    xcd_barrier(xb);
    { EpiRes E; E.XB = p.XB; E.SSQ = p.SSQ; run_gemm_split(lds, p.O, p.Wo1, 1024, 1024, E, (float*)p.H); xcd_barrier(xb); gemm_fixup(1024, 1024, E, (const float*)p.H, tid); rinv_pass(p, 1024, tid); }
    xcd_barrier(xb);
    { EpiUp E; E.SSQ = p.SSQ; E.RINV = p.RINV; E.H = p.H; run_gemm(lds, p.XB, p.Wup1, 4096, 1024, E); }
    xcd_barrier(xb);
    { EpiRes E; E.XB = p.XB; E.SSQ = p.SSQ; run_gemm_split(lds, p.H, p.Wdn1, 1024, 4096, E, (float*)p.CAT); xcd_barrier(xb); gemm_fixup(1024, 4096, E, (const float*)p.CAT, tid); }
    xcd_barrier(xb);
    final_norm(p, gw, NGW, lane);
}

extern "C" void kernel_launch(void* const* d_in, const int* in_sizes, int n_in, void* d_out, int out_size, void* d_ws, size_t ws_size, hipStream_t stream) {
    static int grid_blocks = 0;
    if (grid_blocks == 0) {
        int dev = 0, cus = 0, per_cu = 0;
        hipGetDevice(&dev); hipDeviceGetAttribute(&cus, hipDeviceAttributeMultiprocessorCount, dev);
        if (hipFuncSetAttribute((const void*)fwd_megakernel, hipFuncAttributeMaxDynamicSharedMemorySize, LDS_BYTES) != hipSuccess) fprintf(stderr, "kernel_launch: hipFuncSetAttribute failed\n");
        if (hipOccupancyMaxActiveBlocksPerMultiprocessor(&per_cu, (const void*)fwd_megakernel, 512, LDS_BYTES) != hipSuccess || per_cu < 1) { fprintf(stderr, "kernel_launch: occupancy query says %d\n", per_cu); per_cu = 1; }
        (void)hipGetLastError();
        grid_blocks = cus > 0 ? cus : 256;
    }
    Prm p{};
    const float* const* in = (const float* const*)d_in;
    p.x_prompt = in[0]; p.x_sample = in[1]; p.state_hgrn = in[2]; p.ssm_re0 = in[3]; p.ssm_im0 = in[4]; p.cache_k = in[5]; p.cache_v = in[6]; p.meta = in[7]; p.ln_mix = in[8]; p.ln_mlp = in[9];
    p.ln_final = in[10]; p.w_in_even = in[11]; p.hgrn_lb = in[12]; p.hgrn_norm = in[13]; p.a_re = in[14]; p.a_im = in[15]; p.log_dt = in[16]; p.b_re = in[17]; p.b_im = in[18]; p.c_re = in[19];
    p.c_im = in[20]; p.ssm_d = in[21]; p.w_glu = in[22]; p.w_out_even = in[23]; p.w_in_odd = in[24]; p.w_out_odd = in[25]; p.w_up = in[26]; p.w_down = in[27];
    p.out = (float*)d_out;
    unsigned char* ws = (unsigned char*)d_ws; size_t off = 0;
    auto take = [&](size_t bytes) { unsigned char* r = ws + off; off += (bytes + 255) & ~(size_t)255; return r; };
    p.Wt1 = (bf16_t*)take((size_t)2560 * 1024 * 2); p.Wglu = (bf16_t*)take((size_t)512 * 512 * 2); p.Wo0 = (bf16_t*)take((size_t)1024 * 1024 * 2); p.Wup0 = (bf16_t*)take((size_t)4096 * 1024 * 2);
    p.Wdn0 = (bf16_t*)take((size_t)4096 * 1024 * 2); p.Wqkv = (bf16_t*)take((size_t)3072 * 1024 * 2); p.Wo1 = (bf16_t*)take((size_t)1024 * 1024 * 2); p.Wup1 = (bf16_t*)take((size_t)4096 * 1024 * 2);
    p.Wdn1 = (bf16_t*)take((size_t)4096 * 1024 * 2);
    p.XB = (bf16_t*)take((size_t)MP * 1024 * 2); p.SSQ = (float*)take((size_t)MP * 16 * 4); p.RINV = (float*)take((size_t)MP * 4); p.LB = (float*)take(2048); p.KTAB = (float*)take((size_t)32 * 16 * 256 * 4);
    p.TG = (bf16_t*)take((size_t)32 * 256 * 384 * 2); p.HT = (bf16_t*)take((size_t)32 * 128 * 256 * 2); p.A16 = (float*)take(32 * 64 * 2 * 4); p.BAR = (unsigned*)take(XCD_BAR_WORDS * 4);
    const size_t S0 = off; constexpr size_t SZ512 = (size_t)MP * 512 * 2;
    p.Qh = (bf16_t*)take(SZ512); p.LOGF = (unsigned short*)take(SZ512); p.IV = (bf16_t*)take(SZ512); p.GS = (bf16_t*)take(SZ512); p.U = (bf16_t*)take(SZ512);
    p.UT = (bf16_t*)take((size_t)NITEM_H * 16384 * 2); p.AL = (float*)take((size_t)NITEM_H * 128 * 4);
    p.XLOC = (float*)take(SZ512); p.YG = (bf16_t*)p.XLOC;
    p.XPREV = (bf16_t*)take((size_t)NCOL * 4096 * 2); p.CAT = (bf16_t*)take((size_t)MP * 1024 * 2);
    size_t end = off;
    off = S0; p.H = (bf16_t*)take((size_t)MP * 4096 * 2); if (off > end) end = off;
    off = S0; p.Q = (bf16_t*)take((size_t)MP * 1024 * 2); p.KP = (bf16_t*)take((size_t)64 * 129 * 4096 * 2); p.KS = (bf16_t*)take((size_t)64 * 34 * 4096 * 2);
    p.VTP = (bf16_t*)take((size_t)64 * 129 * 4096 * 2); p.VTS = (bf16_t*)take((size_t)64 * 34 * 4096 * 2); p.O = (bf16_t*)take((size_t)MP * 1024 * 2); if (off > end) end = off;
    if (end > ws_size || n_in != 28 || (size_t)out_size != O_END) { fprintf(stderr, "kernel_launch: workspace/shape mismatch: need %zu have %zu, n_in %d, out %d\n", end, ws_size, n_in, out_size); return; }
    (void)hipMemsetAsync(p.BAR, 0, XCD_BAR_WORDS * 4, stream);
    void* args[] = {&p};
    hipError_t e = hipLaunchCooperativeKernel((const void*)fwd_megakernel, dim3(grid_blocks), dim3(512), args, LDS_BYTES, stream);
    if (e != hipSuccess) fprintf(stderr, "cooperative launch failed: %s (grid %d)\n", hipGetErrorString(e), grid_blocks);
}
```

```cpp
#include <hip/hip_runtime.h>
#include <hip/hip_cooperative_groups.h>
#include <cstdio>
#include <cstdint>
namespace cg = cooperative_groups;
namespace pg8 {
#define PG8_LAS __attribute__((address_space(3)))
typedef unsigned short bf16_t;
typedef short bf16x8 __attribute__((ext_vector_type(8)));
typedef float f32x4 __attribute__((ext_vector_type(4)));
typedef unsigned u32x4 __attribute__((ext_vector_type(4)));
constexpr int BM = 256, BK = 64, HALF = 128, HTB = HALF * BK * 2  , STAGE_BYTES = 8 * HTB, NXCD = 8, WGM = 8;

__host__ __device__ __forceinline__ int lds_byte(int r, int c) { const int st = (r >> 4) * 2 + (c >> 5), rr = r & 15, cc = c & 31, ob = rr * 64 + cc * 2; return st * 1024 + (ob ^ (((ob >> 9) & 1) << 5)); }
__host__ __device__ __forceinline__ void stage_rc(int b, int& R, int& C) { const int st = b / 1024, sb = b % 1024, swz = sb ^ (((sb >> 9) & 1) << 5); R = (st >> 1) * 16 + swz / 64; C = (st & 1) * 32 + (swz % 64) / 2; }
__host__ __device__ __forceinline__ int perm32(int rho) { const int n = rho >> 4, i = rho & 15; return 8 * (i >> 2) + 4 * n + (i & 3); }

struct Unit { int pm, pn, kb, nk, part; };
struct Gemm { const bf16_t* A; const bf16_t* Bt; int M, N, K; float* part; };

struct StaticOrder {
    int nM, nN, nwg, G, c;
    __host__ __device__ void init(int M, int N, int G_, int c_) { nM = M / BM; nN = N / BM; nwg = nM * nN; G = G_; c = c_; }
    __host__ __device__ void map(int L, Unit& u) const {
        int wgid = L; { const int q = nwg / NXCD, r = nwg % NXCD, xcd = wgid % NXCD, off = wgid / NXCD; wgid = (xcd < r ? xcd * (q + 1) : r * (q + 1) + (xcd - r) * q) + off; }
        const int nig = WGM * nN, gid = wgid / nig, fm = gid * WGM, gsz = (nM - fm) < WGM ? (nM - fm) : WGM;
        u.pm = fm + ((wgid % nig) % gsz); u.pn = (wgid % nig) / gsz; u.kb = 0; u.nk = 0; u.part = -1;
    }
    __host__ __device__ bool next(int i, Unit& u) const {
        const long L = (long)i * G + c; if (L >= nwg) return false;
        map((int)L, u); return true;
    }
    __device__ __forceinline__ void a_ready(const Unit&) const {}
    __device__ __forceinline__ void done(const Unit&) const {}
};
template <class Epi, class Sched>
__device__ __forceinline__ void gemm_phase(PG8_LAS unsigned char* lds, const Gemm g, const Sched& S, const Epi& E) {
    int tid_ = threadIdx.x; asm volatile("" : "+v"(tid_));
    const int tid = tid_, wid = __builtin_amdgcn_readfirstlane(tid >> 6), lane = tid & 63, wr = wid >> 2, wc = wid & 3, fr = lane & 15, fq = lane >> 4;
    const int K = g.K, nt = K / BK;
    unsigned voffA[2], voffB[2];
#pragma unroll
    for (int i = 0; i < 2; ++i) { int R, C; stage_rc(tid * 16 + i * 8192, R, C); const int Rb = Epi::PERM ? ((R & ~31) + perm32(R & 31)) : R;
        voffA[i] = (unsigned)(R * K + C) * 2u; voffB[i] = (unsigned)(Rb * K + C) * 2u; }
    const size_t kstep = (size_t)(BK * 2);
    const size_t hstep = (size_t)HALF * K * 2;
    const size_t tstep = 2 * hstep;
    const unsigned ldsw = (unsigned)wid * 1024u;
    const int aoff = lds_byte(wr * 64 + fr, fq * 8), boff = lds_byte(wc * 32 + fr, fq * 8);
#define PG8_SA(b, h) (((b) * 2 + (h)) * HTB)
#define PG8_SB(b, h) ((4 + (b) * 2 + (h)) * HTB)
#define PG8_STAGE(bufoff, gbase, voff) do { _Pragma("unroll") for (int _i = 0; _i < 2; ++_i) \
        __builtin_amdgcn_global_load_lds((const unsigned*)((const char*)(gbase) + (voff)[_i]), (PG8_LAS unsigned*)(lds + (bufoff) + ldsw + _i * 8192), 16, 0, 0); } while (0)
#define PG8_LDA(dst, b, h) do { _Pragma("unroll") for (int m = 0; m < 4; ++m) _Pragma("unroll") for (int k = 0; k < 2; ++k) dst[m][k] = *(const PG8_LAS bf16x8*)(lds + PG8_SA(b, h) + aoff + m * 2048 + k * 1024); } while (0)
#define PG8_LDB(dst, b, h) do { _Pragma("unroll") for (int n = 0; n < 2; ++n) _Pragma("unroll") for (int k = 0; k < 2; ++k) dst[n][k] = *(const PG8_LAS bf16x8*)(lds + PG8_SB(b, h) + boff + n * 2048 + k * 1024); } while (0)
#define PG8_MMA(ai, bj, At, Bt) do { __builtin_amdgcn_s_setprio(1); _Pragma("unroll") for (int m = 0; m < 4; ++m) _Pragma("unroll") for (int n = 0; n < 2; ++n) _Pragma("unroll") for (int k = 0; k < 2; ++k) \
        acc[ai][bj][m][n] = __builtin_amdgcn_mfma_f32_16x16x32_bf16(Bt[n][k], At[m][k], acc[ai][bj][m][n], 0, 0, 0); __builtin_amdgcn_s_setprio(0); } while (0)
#define PG8_WAIT_V(n) asm volatile("s_waitcnt vmcnt(" #n ")" ::: "memory")
#define PG8_WAIT_L(n) asm volatile("s_waitcnt lgkmcnt(" #n ")" ::: "memory")
#define PG8_BAR __builtin_amdgcn_s_barrier()
#define PG8_SCHED __builtin_amdgcn_sched_barrier(0)
    Unit cur, nxt; int ui = 0; typename Epi::Pre pre;
    if (!S.next(0, cur)) return;
    f32x4 acc[2][2][4][2];
#pragma unroll
    for (int a = 0; a < 2; ++a)
#pragma unroll
        for (int b = 0; b < 2; ++b)
#pragma unroll
            for (int m = 0; m < 4; ++m)
#pragma unroll
                for (int n = 0; n < 2; ++n) acc[a][b][m][n] = (f32x4){0.f, 0.f, 0.f, 0.f};
    bf16x8 At[4][2], B0[2][2], B1[2][2];
    const char* cA = (const char*)g.A + (size_t)cur.pm * tstep + (size_t)cur.kb * kstep; const char* cB = (const char*)g.Bt + (size_t)cur.pn * tstep + (size_t)cur.kb * kstep;
    S.a_ready(cur);
    PG8_STAGE(PG8_SB(0, 0), cB, voffB); PG8_STAGE(PG8_SA(0, 0), cA, voffA); PG8_STAGE(PG8_SB(0, 1), cB + hstep, voffB); PG8_STAGE(PG8_SA(0, 1), cA + hstep, voffA);
    if (wr == 1) PG8_BAR;
    PG8_WAIT_V(4); PG8_BAR;
    PG8_STAGE(PG8_SB(1, 0), cB + kstep, voffB); PG8_STAGE(PG8_SA(1, 0), cA + kstep, voffA); PG8_STAGE(PG8_SB(1, 1), cB + hstep + kstep, voffB);
    PG8_WAIT_V(6); PG8_BAR;
    for (;;) {
        const bool has_next = S.next(ui + 1, nxt);
        const char* nA = has_next ? (const char*)g.A + (size_t)nxt.pm * tstep + (size_t)nxt.kb * kstep : cA; const char* nB = has_next ? (const char*)g.Bt + (size_t)nxt.pn * tstep + (size_t)nxt.kb * kstep : cB;
        const int cnk = cur.nk ? cur.nk : nt;
        for (int t = 0; t < cnk; t += 2) {
            const bool last = (t == cnk - 2);
            const char* a1 = cA + (size_t)(t + 1) * kstep;
            const char* a2 = last ? nA : cA + (size_t)(t + 2) * kstep; const char* b2 = last ? nB : cB + (size_t)(t + 2) * kstep;
            const char* a3 = a2 + kstep; const char* b3 = b2 + kstep;
            if (last && has_next) S.a_ready(nxt);
            if (last) E.prefetch(pre, cur, wr, fr);
            PG8_LDB(B0, 0, 0); PG8_SCHED; PG8_LDA(At, 0, 0); PG8_STAGE(PG8_SA(1, 1), a1 + hstep, voffA);
            PG8_WAIT_L(8); PG8_BAR; PG8_WAIT_L(0); PG8_MMA(0, 0, At, B0); PG8_BAR; PG8_SCHED;
            PG8_LDB(B1, 0, 1); PG8_STAGE(PG8_SB(0, 0), b2, voffB);
            PG8_BAR; PG8_WAIT_L(0); PG8_MMA(0, 1, At, B1); PG8_BAR;
            PG8_LDA(At, 0, 1); PG8_STAGE(PG8_SA(0, 0), a2, voffA);
            PG8_BAR; PG8_WAIT_L(0); PG8_MMA(1, 0, At, B0); PG8_BAR; PG8_SCHED;
            PG8_STAGE(PG8_SB(0, 1), b2 + hstep, voffB);
            PG8_WAIT_V(6); PG8_BAR; PG8_MMA(1, 1, At, B1); PG8_BAR;
            PG8_LDB(B0, 1, 0); PG8_SCHED; PG8_LDA(At, 1, 0); PG8_STAGE(PG8_SA(0, 1), a2 + hstep, voffA);
            PG8_WAIT_L(8); PG8_BAR; PG8_WAIT_L(0); PG8_MMA(0, 0, At, B0); PG8_BAR; PG8_SCHED;
            PG8_LDB(B1, 1, 1); PG8_STAGE(PG8_SB(1, 0), b3, voffB);
            PG8_BAR; PG8_WAIT_L(0); PG8_MMA(0, 1, At, B1); PG8_BAR;
            PG8_LDA(At, 1, 1); PG8_STAGE(PG8_SA(1, 0), a3, voffA);
            PG8_BAR; PG8_WAIT_L(0); PG8_MMA(1, 0, At, B0); PG8_BAR; PG8_SCHED;
            PG8_STAGE(PG8_SB(1, 1), b3 + hstep, voffB);
            PG8_WAIT_V(6); PG8_BAR; PG8_MMA(1, 1, At, B1); PG8_BAR;
        }
        if constexpr (!Epi::AFTER_DRAIN) {
            if (cur.part < 0) E(acc, cur, wr, wc, fr, fq, pre);
            else { f32x4* pp = (f32x4*)g.part + (size_t)cur.part * 32 * 512 + tid;
#pragma unroll
                for (int a = 0; a < 2; ++a)
#pragma unroll
                    for (int b = 0; b < 2; ++b)
#pragma unroll
                        for (int m = 0; m < 4; ++m)
#pragma unroll
                            for (int n = 0; n < 2; ++n) pp[(size_t)(((a * 2 + b) * 4 + m) * 2 + n) * 512] = acc[a][b][m][n]; }
            S.done(cur); }
        if (!has_next) break;
#pragma unroll
        for (int a = 0; a < 2; ++a)
#pragma unroll
            for (int b = 0; b < 2; ++b)
#pragma unroll
                for (int m = 0; m < 4; ++m)
#pragma unroll
                    for (int n = 0; n < 2; ++n) acc[a][b][m][n] = (f32x4){0.f, 0.f, 0.f, 0.f};
        cur = nxt; cA = nA; cB = nB; ++ui;
    }
    PG8_WAIT_V(0);
    if (wr == 0) PG8_BAR;
    PG8_BAR;
    if constexpr (Epi::AFTER_DRAIN) { E.fused(acc, cur, wr, wc, fr, fq, lds, wid, lane); S.done(cur); }
#undef PG8_SA
#undef PG8_SB
#undef PG8_STAGE
#undef PG8_LDA
#undef PG8_LDB
#undef PG8_MMA
#undef PG8_WAIT_V
#undef PG8_WAIT_L
#undef PG8_BAR
#undef PG8_SCHED
}
}
using pg8::bf16_t; using pg8::bf16x8; using pg8::f32x4; using pg8::Unit;
typedef float f32x16 __attribute__((ext_vector_type(16)));
typedef float f32x2v __attribute__((ext_vector_type(2)));
typedef unsigned u32x2 __attribute__((ext_vector_type(2)));
typedef unsigned u32x4v __attribute__((ext_vector_type(4)));
#define LAS __attribute__((address_space(3)))
#define DI __device__ __forceinline__

constexpr int DM = 1024, TP = 4112, NTP = 8 * TP  , NTS = 512, NT = NTP + NTS  , MP = 33536  ;
constexpr int NITEM_H = 2112;
constexpr int NCOL = NT / 16;
constexpr float EPSN = 1e-6f;
constexpr size_t O_YP = 0, O_YS = O_YP + (size_t)8 * 4096 * 1024, O_HGP = O_YS + 524288, O_HGS = O_HGP + 524288, O_SRP = O_HGS + 524288, O_SIP = O_SRP + 16384,
                 O_SRS = O_SIP + 16384, O_SIS = O_SRS + 16384, O_KP = O_SIS + 16384, O_VP = O_KP + (size_t)NTP * 1024, O_KS = O_VP + (size_t)NTP * 1024, O_VS = O_KS + 524288, O_END = O_VS + 524288;

struct Prm {
    const float *x_prompt, *x_sample, *state_hgrn, *ssm_re0, *ssm_im0, *cache_k, *cache_v, *meta, *ln_mix, *ln_mlp, *ln_final, *w_in_even, *hgrn_lb, *hgrn_norm,
        *a_re, *a_im, *log_dt, *b_re, *b_im, *c_re, *c_im, *ssm_d, *w_glu, *w_out_even, *w_in_odd, *w_out_odd, *w_up, *w_down;
    float* out;
    bf16_t *Wt1, *Wglu, *Wo0, *Wup0, *Wdn0, *Wqkv, *Wo1, *Wup1, *Wdn1;
    bf16_t* XB; float* SSQ; float* RINV; float* LB; float* KTAB; bf16_t* TG; bf16_t* HT; float* A16;
    bf16_t *Qh, *IV, *GS, *U; unsigned short* LOGF; bf16_t* UT; float* AL; float* XLOC; bf16_t* XPREV; bf16_t* YG; bf16_t* CAT;
    bf16_t* H;
    bf16_t *Q, *KP, *KS, *VTP, *VTS, *O; unsigned* BAR;
};

DI unsigned pk2(float lo, float hi) { unsigned r; asm volatile("v_cvt_pk_bf16_f32 %0, %1, %2" : "=v"(r) : "v"(lo), "v"(hi)); return r; }
DI float bflo(unsigned u) { return __uint_as_float(u << 16); }
DI float bfhi(unsigned u) { return __uint_as_float(u & 0xffff0000u); }
DI float bf2f(unsigned short b) { return __uint_as_float(((unsigned)b) << 16); }
DI unsigned short f2bf(float f) { return (unsigned short)(pk2(f, 0.f) & 0xffffu); }
DI unsigned pkh2(float lo, float hi) { union { _Float16 h[2]; unsigned u; } x; x.h[0] = (_Float16)lo; x.h[1] = (_Float16)hi; return x.u; }
DI float h2f(unsigned short h) { union { unsigned short s; _Float16 h; } x; x.s = h; return (float)x.h; }
DI float wave_sum(float v) {
#pragma unroll
    for (int o = 1; o < 64; o <<= 1) v += __shfl_xor(v, o);
    return v;
}
DI float fexp(float x) { return __expf(x); }
DI float sigm(float x) { return __builtin_amdgcn_rcpf(1.f + __expf(-x)); }
DI float row_rinv(const float* SSQ, int row) {
    const f32x4* s = (const f32x4*)(SSQ + (size_t)row * 16); f32x4 a = s[0] + s[1] + s[2] + s[3];
    return rsqrtf(((a.x + a.y) + (a.z + a.w)) * (1.f / 1024.f) + EPSN);
}
DI void rinv8(const float* SSQ, int row0, int fq, float (&r)[2][4]) {
    f32x4 v[2][4];
#pragma unroll
    for (int ai = 0; ai < 2; ++ai)
#pragma unroll
        for (int m = 0; m < 4; ++m) v[ai][m] = *(const f32x4*)(SSQ + (size_t)(row0 + ai * 128 + m * 16) * 16 + 4 * fq);
#pragma unroll
    for (int ai = 0; ai < 2; ++ai)
#pragma unroll
        for (int m = 0; m < 4; ++m) { float s = (v[ai][m].x + v[ai][m].y) + (v[ai][m].z + v[ai][m].w); s += __shfl_xor(s, 16); s += __shfl_xor(s, 32); r[ai][m] = rsqrtf(s * (1.f / 1024.f) + EPSN); }
}
#define LDS_WAIT() asm volatile("s_waitcnt lgkmcnt(0)" ::: "memory")

struct EpiIn0 {
    struct Pre { float r[2][4]; };
    DI void prefetch(Pre& pre, const Unit& u, int wr, int fr) const { const int row0 = u.pm * 256 + wr * 64 + fr;
#pragma unroll
        for (int ai = 0; ai < 2; ++ai)
#pragma unroll
            for (int m = 0; m < 4; ++m) pre.r[ai][m] = RINV[row0 + ai * 128 + m * 16]; }
    DI void scales(const Pre& pre, int row0, int fq, float (&rs)[2][4]) const {
        if (pre.r[0][0] > 0.f) {
#pragma unroll
            for (int ai = 0; ai < 2; ++ai)
#pragma unroll
                for (int m = 0; m < 4; ++m) rs[ai][m] = pre.r[ai][m]; }
        else rinv8(SSQ, row0, fq, rs);
    }
    static constexpr bool PERM = true, AFTER_DRAIN = false;
    const float* SSQ; const float* RINV; const float* LB; bf16_t *Qh, *IV, *GS, *U; unsigned short* LOGF;
    DI void operator()(const f32x4 (&acc)[2][2][4][2], const Unit& u, int wr, int wc, int fr, int fq, const Pre& pre) const {
        const int seg = u.pn >> 1, cb = (u.pn & 1) * 256 + wc * 32 + 8 * fq, row0 = u.pm * 256 + wr * 64 + fr;
        unsigned short* dst = seg == 0 ? Qh : seg == 1 ? LOGF : seg == 2 ? IV : seg == 3 ? GS : U;
        float rs[2][4]; scales(pre, row0, fq, rs);
        f32x4 lbv[2][2];
#pragma unroll
        for (int bj = 0; bj < 2; ++bj)
#pragma unroll
            for (int n = 0; n < 2; ++n) lbv[bj][n] = *(const f32x4*)(LB + cb + bj * 128 + 4 * n);
#pragma unroll
        for (int ai = 0; ai < 2; ++ai)
#pragma unroll
            for (int m = 0; m < 4; ++m) { const int row = row0 + ai * 128 + m * 16; const float r = rs[ai][m];
#pragma unroll
                for (int bj = 0; bj < 2; ++bj) { u32x4v o; unsigned w[4];
#pragma unroll
                    for (int n = 0; n < 2; ++n) { f32x4 v = acc[ai][bj][m][n] * r;
                        if (seg == 1) { const f32x4 lb = lbv[bj][n]; f32x4 f;
#pragma unroll
                            for (int e = 0; e < 4; ++e) f[e] = __logf(lb[e] + (1.f - lb[e]) * sigm(v[e]));
                            w[2 * n] = pkh2(f[0], f[1]); w[2 * n + 1] = pkh2(f[2], f[3]); }
                        else { if (seg == 3) {
#pragma unroll
                                for (int e = 0; e < 4; ++e) v[e] = v[e] * sigm(v[e]); }
                            w[2 * n] = pk2(v[0], v[1]); w[2 * n + 1] = pk2(v[2], v[3]); } }
                    o.x = w[0]; o.y = w[1]; o.z = w[2]; o.w = w[3];
                    *(u32x4v*)(dst + (size_t)row * 512 + cb + bj * 128) = o; } }
    }
};
struct EpiGlu {
    struct Pre {}; DI void prefetch(Pre&, const Unit&, int, int) const {}
    static constexpr bool PERM = true, AFTER_DRAIN = false;
    const bf16_t* YG; bf16_t* CAT;
    DI void operator()(const f32x4 (&acc)[2][2][4][2], const Unit& u, int wr, int wc, int fr, int fq, const Pre& pre) const {
        const int cb = u.pn * 256 + wc * 32 + 8 * fq, row0 = u.pm * 256 + wr * 64 + fr;
#pragma unroll
        for (int ai = 0; ai < 2; ++ai) {
            u32x4v y[4][2];
#pragma unroll
            for (int m = 0; m < 4; ++m)
#pragma unroll
                for (int bj = 0; bj < 2; ++bj) y[m][bj] = *(const u32x4v*)(YG + (size_t)(row0 + ai * 128 + m * 16) * 512 + cb + bj * 128);
#pragma unroll
            for (int m = 0; m < 4; ++m) { const int row = row0 + ai * 128 + m * 16;
#pragma unroll
                for (int bj = 0; bj < 2; ++bj) { const f32x4 v0 = acc[ai][bj][m][0], v1 = acc[ai][bj][m][1]; const u32x4v yy = y[m][bj]; u32x4v o;
                    o.x = pk2(bflo(yy.x) * sigm(v0[0]), bfhi(yy.x) * sigm(v0[1])); o.y = pk2(bflo(yy.y) * sigm(v0[2]), bfhi(yy.y) * sigm(v0[3]));
                    o.z = pk2(bflo(yy.z) * sigm(v1[0]), bfhi(yy.z) * sigm(v1[1])); o.w = pk2(bflo(yy.w) * sigm(v1[2]), bfhi(yy.w) * sigm(v1[3]));
                    *(u32x4v*)(CAT + (size_t)row * 1024 + 512 + cb + bj * 128) = o; } } }
    }
};
struct EpiRes {
    struct Pre {}; DI void prefetch(Pre&, const Unit&, int, int) const {}
    static constexpr bool PERM = true, AFTER_DRAIN = false;
    bf16_t* XB; float* SSQ;
    DI float upd(u32x4v* px, const u32x4v x, const f32x4 v0, const f32x4 v1) const {
        u32x4v o; o.x = pk2(bflo(x.x) + v0[0], bfhi(x.x) + v0[1]); o.y = pk2(bflo(x.y) + v0[2], bfhi(x.y) + v0[3]);
        o.z = pk2(bflo(x.z) + v1[0], bfhi(x.z) + v1[1]); o.w = pk2(bflo(x.w) + v1[2], bfhi(x.w) + v1[3]); *px = o;
        const float a0 = bflo(o.x), a1 = bfhi(o.x), a2 = bflo(o.y), a3 = bfhi(o.y), a4 = bflo(o.z), a5 = bfhi(o.z), a6 = bflo(o.w), a7 = bfhi(o.w);
        return ((a0 * a0 + a1 * a1) + (a2 * a2 + a3 * a3)) + ((a4 * a4 + a5 * a5) + (a6 * a6 + a7 * a7));
    }
    DI void row(const f32x4 (&a4)[2][2], const Unit& u, int ai, int m, int wr, int wc, int fr, int fq) const {
        const int cb = u.pn * 256 + wc * 32 + 8 * fq, row = u.pm * 256 + wr * 64 + fr + ai * 128 + m * 16;
        u32x4v* p0 = (u32x4v*)(XB + (size_t)row * 1024 + cb); u32x4v* p1 = (u32x4v*)(XB + (size_t)row * 1024 + cb + 128);
        const u32x4v x0 = *p0, x1 = *p1;
        float ss = upd(p0, x0, a4[0][0], a4[0][1]) + upd(p1, x1, a4[1][0], a4[1][1]);
        ss += __shfl_xor(ss, 16); ss += __shfl_xor(ss, 32);
        if (fq == 0) SSQ[(size_t)row * 16 + u.pn * 4 + wc] = ss;
    }
    DI void operator()(const f32x4 (&acc)[2][2][4][2], const Unit& u, int wr, int wc, int fr, int fq, const Pre& pre) const {
        const int cb = u.pn * 256 + wc * 32 + 8 * fq, row0 = u.pm * 256 + wr * 64 + fr;
#pragma unroll
        for (int ai = 0; ai < 2; ++ai) {
            u32x4v x[4][2];
#pragma unroll
            for (int m = 0; m < 4; ++m)
#pragma unroll
                for (int bj = 0; bj < 2; ++bj) x[m][bj] = *(const u32x4v*)(XB + (size_t)(row0 + ai * 128 + m * 16) * 1024 + cb + bj * 128);
#pragma unroll
            for (int m = 0; m < 4; ++m) { const int row = row0 + ai * 128 + m * 16;
                float ss = upd((u32x4v*)(XB + (size_t)row * 1024 + cb), x[m][0], acc[ai][0][m][0], acc[ai][0][m][1])
                         + upd((u32x4v*)(XB + (size_t)row * 1024 + cb + 128), x[m][1], acc[ai][1][m][0], acc[ai][1][m][1]);
                ss += __shfl_xor(ss, 16); ss += __shfl_xor(ss, 32);
                if (fq == 0) SSQ[(size_t)row * 16 + u.pn * 4 + wc] = ss; } }
    }
};
struct EpiUp {
    struct Pre { float r[2][4]; };
    DI void prefetch(Pre& pre, const Unit& u, int wr, int fr) const { const int row0 = u.pm * 256 + wr * 64 + fr;
#pragma unroll
        for (int ai = 0; ai < 2; ++ai)
#pragma unroll
            for (int m = 0; m < 4; ++m) pre.r[ai][m] = RINV[row0 + ai * 128 + m * 16]; }
    DI void scales(const Pre& pre, int row0, int fq, float (&rs)[2][4]) const {
        if (pre.r[0][0] > 0.f) {
#pragma unroll
            for (int ai = 0; ai < 2; ++ai)
#pragma unroll
                for (int m = 0; m < 4; ++m) rs[ai][m] = pre.r[ai][m]; }
        else rinv8(SSQ, row0, fq, rs);
    }
    static constexpr bool PERM = true, AFTER_DRAIN = false;
    const float* SSQ; const float* RINV; bf16_t* H;
    DI void operator()(const f32x4 (&acc)[2][2][4][2], const Unit& u, int wr, int wc, int fr, int fq, const Pre& pre) const {
        const int cb = u.pn * 256 + wc * 32 + 8 * fq, row0 = u.pm * 256 + wr * 64 + fr;
        float rs[2][4]; scales(pre, row0, fq, rs);
#pragma unroll
        for (int ai = 0; ai < 2; ++ai)
#pragma unroll
            for (int m = 0; m < 4; ++m) { const int row = row0 + ai * 128 + m * 16; const float r = rs[ai][m];
#pragma unroll
                for (int bj = 0; bj < 2; ++bj) { f32x4 v0 = acc[ai][bj][m][0] * r, v1 = acc[ai][bj][m][1] * r;
#pragma unroll
                    for (int e = 0; e < 4; ++e) { const float t0 = fmaxf(v0[e], 0.f), t1 = fmaxf(v1[e], 0.f); v0[e] = t0 * t0; v1[e] = t1 * t1; }
                    u32x4v o; o.x = pk2(v0[0], v0[1]); o.y = pk2(v0[2], v0[3]); o.z = pk2(v1[0], v1[1]); o.w = pk2(v1[2], v1[3]);
                    *(u32x4v*)(H + (size_t)row * 4096 + cb + bj * 128) = o; } }
    }
};
DI size_t kf_index(int seqh, int nkt, int key, int d) { return ((((size_t)seqh * nkt + (key >> 5)) * 8 + (d >> 4)) * 64 + ((key & 31) + 32 * ((d >> 3) & 1))) * 8 + (d & 7); }
DI size_t vf_index(int seqh, int nkt, int key, int d) { const int kk = key & 31;
    return ((((size_t)seqh * nkt + (key >> 5)) * 8 + (kk >> 4) * 4 + (d >> 5)) * 64 + ((d & 31) + 32 * ((kk >> 2) & 1))) * 8 + ((kk >> 3) & 1) * 4 + (kk & 3); }
struct EpiQkv {
    struct Pre { float r[2][4]; };
    DI void prefetch(Pre& pre, const Unit& u, int wr, int fr) const { const int row0 = u.pm * 256 + wr * 64 + fr;
#pragma unroll
        for (int ai = 0; ai < 2; ++ai)
#pragma unroll
            for (int m = 0; m < 4; ++m) pre.r[ai][m] = RINV[row0 + ai * 128 + m * 16]; }
    DI void scales(const Pre& pre, int row0, int fq, float (&rs)[2][4]) const {
        if (pre.r[0][0] > 0.f) {
#pragma unroll
            for (int ai = 0; ai < 2; ++ai)
#pragma unroll
                for (int m = 0; m < 4; ++m) rs[ai][m] = pre.r[ai][m]; }
        else rinv8(SSQ, row0, fq, rs);
    }
    static constexpr bool PERM = true, AFTER_DRAIN = false;
    const float* SSQ; const float* RINV; float* out; bf16_t *Q, *KP, *KS, *VTP, *VTS; LAS unsigned char* scr;
    DI void operator()(const f32x4 (&acc)[2][2][4][2], const Unit& u, int wr, int wc, int fr, int fq, const Pre& pre) const {
        const int third = u.pn >> 2, cb = (u.pn & 3) * 256 + wc * 32 + 8 * fq, row0 = u.pm * 256 + wr * 64 + fr;
        float rs[2][4]; scales(pre, row0, fq, rs);
        if (third == 2) {
            LAS unsigned char* ws = scr + (wr * 4 + wc) * 1024; const int ln = fr + 16 * fq, dl = ln & 31, hf = ln >> 5;
            LAS unsigned char* wsw = ws + fr * 64 + fq * 16; const LAS unsigned char* wsr = ws + hf * 256 + dl * 2;
#pragma unroll
            for (int ai = 0; ai < 2; ++ai)
#pragma unroll
                for (int m = 0; m < 4; ++m) { const int row = row0 + ai * 128 + m * 16; const float r = rs[ai][m];
                    const bool smp = row >= NTP; const int s = row - NTP; const int b = smp ? (s >> 6) : row / TP, key = smp ? 1024 + (s & 63) : row - b * TP, nkt = smp ? 34 : 129;
#pragma unroll
                    for (int bj = 0; bj < 2; ++bj) { const int cs = cb + bj * 128; const f32x4 v0 = acc[ai][bj][m][0] * r, v1 = acc[ai][bj][m][1] * r;
                        if (row < NT) { const int h = cs >> 7, d = cs & 127;
                            float* ov = out + (smp ? O_VS + (size_t)s * 1024 : O_VP + (size_t)row * 1024) + cs; *(f32x4*)ov = v0; *(f32x4*)(ov + 4) = v1;
                            u32x4v o; o.x = pk2(v0[0], v0[1]); o.y = pk2(v0[2], v0[3]); o.z = pk2(v1[0], v1[1]); o.w = pk2(v1[2], v1[3]);
                            *(LAS u32x4v*)wsw = o;
                            asm volatile("s_waitcnt lgkmcnt(0)" ::: "memory");
                            u32x4v t;
                            t.x = (unsigned)*(const LAS unsigned short*)(wsr) | ((unsigned)*(const LAS unsigned short*)(wsr + 64) << 16);
                            t.y = (unsigned)*(const LAS unsigned short*)(wsr + 128) | ((unsigned)*(const LAS unsigned short*)(wsr + 192) << 16);
                            t.z = (unsigned)*(const LAS unsigned short*)(wsr + 512) | ((unsigned)*(const LAS unsigned short*)(wsr + 576) << 16);
                            t.w = (unsigned)*(const LAS unsigned short*)(wsr + 640) | ((unsigned)*(const LAS unsigned short*)(wsr + 704) << 16);
                            *(u32x4v*)((smp ? VTS : VTP) + vf_index(b * 8 + h, nkt, key - fr, d & ~31) + ln * 8) = t;
                            asm volatile("s_waitcnt lgkmcnt(0)" ::: "memory"); } } }
            return; }
#pragma unroll
        for (int ai = 0; ai < 2; ++ai)
#pragma unroll
            for (int m = 0; m < 4; ++m) { const int row = row0 + ai * 128 + m * 16; const float r = rs[ai][m];
                const bool smp = row >= NTP; const int s = row - NTP; const int b = smp ? (s >> 6) : row / TP, key = smp ? 1024 + (s & 63) : row - b * TP, nkt = smp ? 34 : 129;
#pragma unroll
                for (int bj = 0; bj < 2; ++bj) { const int cs = cb + bj * 128; const f32x4 v0 = acc[ai][bj][m][0] * r, v1 = acc[ai][bj][m][1] * r;
                    u32x4v o; o.x = pk2(v0[0], v0[1]); o.y = pk2(v0[2], v0[3]); o.z = pk2(v1[0], v1[1]); o.w = pk2(v1[2], v1[3]);
                    if (third == 0) { *(u32x4v*)(Q + (size_t)row * 1024 + cs) = o; }
                    else if (row < NT) { const int h = cs >> 7, d = cs & 127;
                        float* ok = out + (smp ? O_KS + (size_t)s * 1024 : O_KP + (size_t)row * 1024) + cs; *(f32x4*)ok = v0; *(f32x4*)(ok + 4) = v1;
                        *(u32x4v*)((smp ? KS : KP) + kf_index(b * 8 + h, nkt, key, d)) = o; } } }
    }
};
struct EpiFin {
    struct Pre {}; DI void prefetch(Pre&, const Unit&, int, int) const {}
    static constexpr bool PERM = false, AFTER_DRAIN = false;
    const bf16_t* XB; float* SSQ; float* out;
    DI void row(const f32x4 (&a4)[2][2], const Unit& u, int ai, int m, int wr, int wc, int fr, int fq) const {
        const int cb = u.pn * 256 + wc * 32 + 4 * fq, row = u.pm * 256 + wr * 64 + fr + ai * 128 + m * 16; float ss = 0.f;
        const int b = row / TP, t = row - b * TP; const bool ok = row < NT && (row >= NTP || t >= 16);
        float* dst = out + (row >= NTP ? O_YS + (size_t)(row - NTP) * 1024 : O_YP + ((size_t)b * 4096 + (t - 16)) * 1024);
#pragma unroll
        for (int bj = 0; bj < 2; ++bj)
#pragma unroll
            for (int n = 0; n < 2; ++n) { const int cs = cb + bj * 128 + n * 16; f32x4 v = a4[bj][n];
                const u32x2 x = *(const u32x2*)(XB + (size_t)row * 1024 + cs);
                v[0] += bflo(x.x); v[1] += bfhi(x.x); v[2] += bflo(x.y); v[3] += bfhi(x.y);
                if (ok) *(f32x4*)(dst + cs) = v;
                ss += (v[0] * v[0] + v[1] * v[1]) + (v[2] * v[2] + v[3] * v[3]); }
        ss += __shfl_xor(ss, 16); ss += __shfl_xor(ss, 32);
        if (fq == 0) SSQ[(size_t)row * 16 + u.pn * 4 + wc] = ss;
    }
    DI void operator()(const f32x4 (&acc)[2][2][4][2], const Unit& u, int wr, int wc, int fr, int fq, const Pre& pre) const {
        const int cb = u.pn * 256 + wc * 32 + 4 * fq, row0 = u.pm * 256 + wr * 64 + fr;
#pragma unroll
        for (int ai = 0; ai < 2; ++ai) {
            u32x2 x[4][2][2];
#pragma unroll
            for (int m = 0; m < 4; ++m)
#pragma unroll
                for (int bj = 0; bj < 2; ++bj)
#pragma unroll
                    for (int n = 0; n < 2; ++n) x[m][bj][n] = *(const u32x2*)(XB + (size_t)(row0 + ai * 128 + m * 16) * 1024 + cb + bj * 128 + n * 16);
#pragma unroll
            for (int m = 0; m < 4; ++m) { const int row = row0 + ai * 128 + m * 16; float ss = 0.f;
                const int b = row / TP, t = row - b * TP; const bool ok = row < NT && (row >= NTP || t >= 16);
                float* dst = out + (row >= NTP ? O_YS + (size_t)(row - NTP) * 1024 : O_YP + ((size_t)b * 4096 + (t - 16)) * 1024);
#pragma unroll
                for (int bj = 0; bj < 2; ++bj)
#pragma unroll
                    for (int n = 0; n < 2; ++n) { const int cs = cb + bj * 128 + n * 16; f32x4 v = acc[ai][bj][m][n]; const u32x2 xx = x[m][bj][n];
                        v[0] += bflo(xx.x); v[1] += bfhi(xx.x); v[2] += bflo(xx.y); v[3] += bfhi(xx.y);
                        if (ok) *(f32x4*)(dst + cs) = v;
                        ss += (v[0] * v[0] + v[1] * v[1]) + (v[2] * v[2] + v[3] * v[3]); }
                ss += __shfl_xor(ss, 16); ss += __shfl_xor(ss, 32);
                if (fq == 0) SSQ[(size_t)row * 16 + u.pn * 4 + wc] = ss; } }
    }
};
template <class Epi> DI void run_gemm(LAS unsigned char* lds, const bf16_t* A, const bf16_t* Bt, int N, int K, const Epi& E) {
    pg8::Gemm g; g.A = A; g.Bt = Bt; g.M = MP; g.N = N; g.K = K; g.part = nullptr;
    pg8::StaticOrder S; S.init(MP, N, (int)gridDim.x, (int)blockIdx.x);
    pg8::gemm_phase<Epi, pg8::StaticOrder>(lds, g, S, E);
}
struct SplitOrder : pg8::StaticOrder {
    int nwhole, ntail, S, nks;
    DI void init2(int N, int K) { init(MP, N, (int)gridDim.x, (int)blockIdx.x); nwhole = nwg / G; ntail = nwg - nwhole * G; S = 0; nks = 0;
        if (ntail > 0) { int s = G / ntail; const int nkt = K / 64; while (s > 1 && (nkt % s != 0 || (nkt / s) < 4 || ((nkt / s) & 1))) --s; if (s > 1) { S = s; nks = nkt / s; } } }
    DI bool next(int i, Unit& u) const {
        if (S == 0) return pg8::StaticOrder::next(i, u);
        if (i < nwhole) { map(i * G + c, u); return true; }
        if (i == nwhole && c < ntail * S) { map(nwhole * G + c / S, u); u.kb = (c % S) * nks; u.nk = nks; u.part = c; return true; }
        return false;
    }
};
template <class Epi> DI void run_gemm_split(LAS unsigned char* lds, const bf16_t* A, const bf16_t* Bt, int N, int K, const Epi& E, float* part) {
    pg8::Gemm g; g.A = A; g.Bt = Bt; g.M = MP; g.N = N; g.K = K; g.part = part;
    SplitOrder S; S.init2(N, K);
    pg8::gemm_phase<Epi, SplitOrder>(lds, g, S, E);
}
template <class Epi> DI void gemm_fixup(int N, int K, const Epi& E, const float* part, int tid) {
    SplitOrder S; S.init2(N, K); if (S.S == 0) return;
    asm volatile("" : "+v"(tid));
    const int wid = tid >> 6, lane = tid & 63, wr = wid >> 2, wc = wid & 3, fr = lane & 15, fq = lane >> 4;
    for (int it = blockIdx.x; it < S.ntail * 8; it += gridDim.x) { const int j = it >> 3, ai = (it >> 2) & 1, m = it & 3; Unit u; S.map(S.nwhole * S.G + j, u);
        f32x4 a4[2][2];
#pragma unroll
        for (int b = 0; b < 2; ++b)
#pragma unroll
            for (int n = 0; n < 2; ++n) { const f32x4* pp = (const f32x4*)part + ((size_t)(j * S.S) * 32 + (((ai * 2 + b) * 4 + m) * 2 + n)) * 512 + tid;
                f32x4 v0 = {0.f, 0.f, 0.f, 0.f}, v1 = v0, v2 = v0, v3 = v0;
                for (int sl = 0; sl + 3 < S.S; sl += 4) { v0 += pp[(size_t)sl * 16384]; v1 += pp[(size_t)(sl + 1) * 16384]; v2 += pp[(size_t)(sl + 2) * 16384]; v3 += pp[(size_t)(sl + 3) * 16384]; }
                for (int sl = S.S & ~3; sl < S.S; ++sl) v0 += pp[(size_t)sl * 16384];
                a4[b][n] = (v0 + v1) + (v2 + v3); }
        E.row(a4, u, ai, m, wr, wc, fr, fq); }
}
DI void rinv_pass(const Prm& p, int K, int tid) {
    SplitOrder S; S.init2(1024, K);
    for (int pm = blockIdx.x; pm < MP / 256; pm += gridDim.x) {
        bool tail = false;
        if (S.S) for (int j = 0; j < S.ntail; ++j) { Unit u; S.map(S.nwhole * S.G + j, u); tail = tail || (u.pm == pm); }
        if (tid < 256) { const int row = pm * 256 + tid; float v = -1.f;
            if (!tail) { const f32x4* q = (const f32x4*)(p.SSQ + (size_t)row * 16); const f32x4 a = q[0] + q[1] + q[2] + q[3]; v = rsqrtf(((a.x + a.y) + (a.z + a.w)) * (1.f / 1024.f) + EPSN); }
            if (row >= NT) v = 1.f;
            p.RINV[row] = v; }
    }
}
DI void transpose_item(const float* W, int N, bf16_t* WT, size_t ldo, const float* sc, LAS float* scr, int item, int lane) {
    const int nblk = N / 32, kb = item / nblk, nb = item % nblk, k0 = 64 * kb, n0 = 32 * nb;
#pragma unroll
    for (int i = 0; i < 8; ++i) { const int kk = 8 * i + (lane >> 3), n4 = (lane & 7) * 4;
        f32x4 w = *(const f32x4*)(W + (size_t)(k0 + kk) * N + n0 + n4); if (sc) w = w * sc[k0 + kk];
        LAS float* d = scr + kk * 33 + n4; d[0] = w.x; d[1] = w.y; d[2] = w.z; d[3] = w.w; }
    LDS_WAIT();
    const int c = lane & 7;
#pragma unroll
    for (int j = 0; j < 4; ++j) { const int n = (lane >> 3) + 8 * j; const LAS float* s = scr + (8 * c) * 33 + n;
        u32x4v o; o.x = pk2(s[0 * 33], s[1 * 33]); o.y = pk2(s[2 * 33], s[3 * 33]); o.z = pk2(s[4 * 33], s[5 * 33]); o.w = pk2(s[6 * 33], s[7 * 33]);
        *(u32x4v*)(WT + (size_t)(n0 + n) * ldo + k0 + 8 * c) = o; }
    LDS_WAIT();
}
DI void s5_pow(const Prm& p, int g, int n, float k, float& re, float& im) {
    const float dt = __expf(p.log_dt[g]), ar = p.a_re[g * 64 + n], ai = p.a_im[g * 64 + n];
    const float mag = __expf(k * dt * ar); float rev = k * dt * ai * 0.15915494309189535f; rev -= rintf(rev);
    re = mag * __builtin_amdgcn_cosf(rev); im = mag * __builtin_amdgcn_sinf(rev);
}
DI void s5_bbar(const Prm& p, int g, int n, int pp, float& re, float& im) {
    const float ar = p.a_re[g * 64 + n], ai = p.a_im[g * 64 + n]; float abr, abi; s5_pow(p, g, n, 1.f, abr, abi);
    const float den = ar * ar + ai * ai, zr = ((abr - 1.f) * ar + abi * ai) / den, zi = (abi * ar - (abr - 1.f) * ai) / den;
    const float br = p.b_re[(g * 64 + n) * 16 + pp], bi = p.b_im[(g * 64 + n) * 16 + pp];
    re = zr * br - zi * bi; im = zr * bi + zi * br;
}
DI void phase_prologue(const Prm& p, LAS unsigned char* lds, int tid, int lane, int wave) {
    const int gw = blockIdx.x * 8 + wave, NGW = gridDim.x * 8, gtid = blockIdx.x * 512 + tid, GT = gridDim.x * 512;
    LAS float* scr = (LAS float*)(lds + wave * 16384);
    constexpr int I1 = 16 * 80, I2 = 8 * 16, I3 = 16 * 32, I4 = 16 * 128, I5 = 64 * 32, I6 = 16 * 96;
    constexpr int NITEMS = I1 + I2 + I3 + I4 + I5 + I6 + I3 + I4 + I5;
    for (int it = gw; it < NITEMS; it += NGW) {
        int r = it;
        if (r < I1) { transpose_item(p.w_in_even, 2560, p.Wt1, 1024, p.ln_mix, scr, r, lane); continue; } r -= I1;
        if (r < I2) { transpose_item(p.w_glu, 512, p.Wglu, 512, nullptr, scr, r, lane); continue; } r -= I2;
        if (r < I3) { transpose_item(p.w_out_even, 1024, p.Wo0, 1024, nullptr, scr, r, lane); continue; } r -= I3;
        if (r < I4) { transpose_item(p.w_up, 4096, p.Wup0, 1024, p.ln_mlp, scr, r, lane); continue; } r -= I4;
        if (r < I5) { transpose_item(p.w_down, 1024, p.Wdn0, 4096, nullptr, scr, r, lane); continue; } r -= I5;
        if (r < I6) { transpose_item(p.w_in_odd, 3072, p.Wqkv, 1024, p.ln_mix + 1024, scr, r, lane); continue; } r -= I6;
        if (r < I3) { transpose_item(p.w_out_odd, 1024, p.Wo1, 1024, nullptr, scr, r, lane); continue; } r -= I3;
        if (r < I4) { transpose_item(p.w_up + (size_t)1024 * 4096, 4096, p.Wup1, 1024, p.ln_mlp + 1024, scr, r, lane); continue; } r -= I4;
        transpose_item(p.w_down + (size_t)4096 * 1024, 1024, p.Wdn1, 4096, nullptr, scr, r, lane);
    }
    for (int row = gw; row < NT; row += NGW) {
        const float* src;
        if (row < NTP) { const int b = row / TP, t = row - b * TP; src = t < 16 ? p.meta + (size_t)t * 1024 : p.x_prompt + ((size_t)b * 4096 + (t - 16)) * 1024; }
        else src = p.x_sample + (size_t)(row - NTP) * 1024;
        float ss = 0.f;
#pragma unroll
        for (int j = 0; j < 4; ++j) { const f32x4 v = ((const f32x4*)src)[lane + 64 * j]; u32x2 o; o.x = pk2(v.x, v.y); o.y = pk2(v.z, v.w);
            const float a0 = bflo(o.x), a1 = bfhi(o.x), a2 = bflo(o.y), a3 = bfhi(o.y); ss += (a0 * a0 + a1 * a1) + (a2 * a2 + a3 * a3);
            ((u32x2*)(p.XB + (size_t)row * 1024))[lane + 64 * j] = o; }
        ss = wave_sum(ss);
        if (lane < 16) p.SSQ[(size_t)row * 16 + lane] = lane == 0 ? ss : 0.f;
        if (lane == 0) p.RINV[row] = rsqrtf(ss * (1.f / 1024.f) + EPSN);
    }
    if (gtid < MP - NT) p.RINV[NT + gtid] = 1.f;
    if (gtid < 512) p.LB[gtid] = 1.f / (1.f + __expf(p.hgrn_lb[512 + gtid] - p.hgrn_lb[gtid]));
    __syncthreads();
    {
        LAS float* zr_ = (LAS float*)lds; LAS float* zi_ = zr_ + 64; LAS float* wr_ = zi_ + 64; LAS float* wi_ = wr_ + 64;
        LAS float* bbr = wi_ + 64; LAS float* bbi = bbr + 1024; LAS float* cwr = bbi + 1024; LAS float* cwi = cwr + 16 * 65;
        for (int pair = blockIdx.x; pair < 512; pair += gridDim.x) { const int g = pair >> 4, tau = pair & 15;
            if (tid < 64) { const int n = tid; const float ar = p.a_re[g * 64 + n], ai = p.a_im[g * 64 + n]; float abr, abi; s5_pow(p, g, n, 1.f, abr, abi);
                const float den = ar * ar + ai * ai; zr_[n] = ((abr - 1.f) * ar + abi * ai) / den; zi_[n] = (abi * ar - (abr - 1.f) * ai) / den;
                float a, b; s5_pow(p, g, n, (float)tau, a, b); wr_[n] = a; wi_[n] = b; }
            __syncthreads();
#pragma unroll
            for (int k = 0; k < 2; ++k) { const int e = tid + 512 * k;
                { const int n = e >> 4; const float br = p.b_re[g * 1024 + e], bi = p.b_im[g * 1024 + e]; bbr[e] = zr_[n] * br - zi_[n] * bi; bbi[e] = zr_[n] * bi + zi_[n] * br; }
                { const int pch = e >> 6, n = e & 63; const float cr = p.c_re[g * 1024 + e], ci = p.c_im[g * 1024 + e]; cwr[pch * 65 + n] = cr * wr_[n] - ci * wi_[n]; cwi[pch * 65 + n] = cr * wi_[n] + ci * wr_[n]; } }
            __syncthreads();
            if (tid < 256) { const int pch = tid >> 4, pp = tid & 15; float acc = 0.f;
#pragma unroll 8
                for (int n = 0; n < 64; ++n) acc += cwr[pch * 65 + n] * bbr[n * 16 + pp] - cwi[pch * 65 + n] * bbi[n * 16 + pp];
                if (tau == 0 && pch == pp) acc += p.ssm_d[g * 16 + pch];
                const bf16_t kv = f2bf(acc);
                p.TG[((g * 16 + tau) * 16 + pch) * 16 + pp] = kv; }
            __syncthreads(); }
    }
    for (int i = gtid; i < 32 * 256 * 64; i += GT) {
        const int g = i >> 14, t = (i >> 10) & 15, pch = (i >> 6) & 15, n = i & 63; float wr_, wi_; s5_pow(p, g, n, (float)(t + 1), wr_, wi_);
        const float cr = p.c_re[(g * 16 + pch) * 64 + n], ci = p.c_im[(g * 16 + pch) * 64 + n];
        *(unsigned*)(p.TG + 131072 + ((size_t)(g * 256 + t * 16 + pch)) * 128 + 2 * n) = pk2(cr * wr_ - ci * wi_, -(cr * wi_ + ci * wr_)); }
    for (int i = gtid; i < 32 * 64 * 256; i += GT) {
        const int g = i >> 14, n = (i >> 8) & 63, s = (i >> 4) & 15, pp = i & 15; float wr_, wi_, br_, bi_; s5_pow(p, g, n, (float)(15 - s), wr_, wi_); s5_bbar(p, g, n, pp, br_, bi_);
        p.HT[((size_t)(g * 128 + 2 * n)) * 256 + s * 16 + pp] = f2bf(wr_ * br_ - wi_ * bi_);
        p.HT[((size_t)(g * 128 + 2 * n + 1)) * 256 + s * 16 + pp] = f2bf(wr_ * bi_ + wi_ * br_); }
    if (gtid < 2048) { float wr_, wi_; s5_pow(p, gtid >> 6, gtid & 63, 16.f, wr_, wi_); p.A16[2 * gtid] = wr_; p.A16[2 * gtid + 1] = wi_; }
}

constexpr int HP = 136, TPI = 72;
constexpr int L_QT = 0, L_QH = 17408, L_KT = 34816, L_KTT = 52224, L_IVT = 70656, L_ATT = 89088, L_SUM = 98304, L_VEC = 100352, L_OB = 0  ;
struct HItem { int row0, L, h, bh; };
DI HItem hgrn_item(int item) {
    HItem it;
    if (item < 2080) { const int bh = item / 65, c = item - bh * 65, b = bh >> 2; it.h = bh & 3; it.bh = bh; it.L = c == 0 ? 16 : 64; it.row0 = b * TP + (c == 0 ? 0 : 16 + 64 * (c - 1)); }
    else { const int s = item - 2080, b = s >> 2; it.h = s & 3; it.bh = 32 + s; it.L = 64; it.row0 = NTP + b * 64; }
    return it;
}
template <bool FULL> DI void hgrn_loadraw(const Prm& p, const HItem& it, int tid, unsigned (&rl)[16], unsigned (&rv)[16], unsigned (&rq)[16]) {
    const int d = tid & 127, t0 = 16 * (tid >> 7), col = it.h * 128 + d;
#pragma unroll
    for (int j = 0; j < 16; ++j) { const int t = t0 + j; const bool valid = t < it.L; const size_t o = (size_t)(it.row0 + t) * 512 + col;
        rl[j] = valid ? (unsigned)p.LOGF[o] : 0u; rv[j] = valid ? (unsigned)p.IV[o] : 0u; if (FULL) rq[j] = valid ? (unsigned)p.Qh[o] : 0u; }
}
template <bool FULL> DI void hgrn_prep(const HItem& it, LAS unsigned char* lds, int tid, const unsigned (&rl)[16], const unsigned (&rv)[16], const unsigned (&rq)[16]) {
    const int d = tid & 127, tq = tid >> 7, t0 = 16 * tq;
    LAS float* sums = (LAS float*)(lds + L_SUM); LAS float* vec = (LAS float*)(lds + L_VEC);
    float cs[16], lf[16];
    float run = 0.f;
#pragma unroll
    for (int j = 0; j < 16; ++j) { lf[j] = h2f((unsigned short)rl[j]); run += lf[j]; cs[j] = run; }
    sums[tq * 128 + d] = run;
    { LAS u32x4v* dst = (LAS u32x4v*)(lds + L_IVT + (d * TPI + t0) * 2); u32x4v a, b;
        a.x = rv[0] | (rv[1] << 16); a.y = rv[2] | (rv[3] << 16); a.z = rv[4] | (rv[5] << 16); a.w = rv[6] | (rv[7] << 16);
        b.x = rv[8] | (rv[9] << 16); b.y = rv[10] | (rv[11] << 16); b.z = rv[12] | (rv[13] << 16); b.w = rv[14] | (rv[15] << 16); dst[0] = a; dst[1] = b; }
    __syncthreads();
    const float s0 = sums[d], s1 = sums[128 + d], s2 = sums[256 + d], s3 = sums[384 + d];
    const float off = tq == 0 ? 0.f : tq == 1 ? s0 : tq == 2 ? s0 + s1 : s0 + s1 + s2, r = s0 + s1, bL = r + s2 + s3;
    if (tq == 0) { vec[d] = r; vec[128 + d] = bL; }
    unsigned ktp[8]; float kprev = 0.f;
#pragma unroll
    for (int j = 0; j < 16; ++j) { const int t = t0 + j; const bool valid = t < it.L; const float b = off + cs[j];
        const float kt = valid ? (1.f - __expf(lf[j])) * __expf(r - b) : 0.f;
        if (j & 1) ktp[j >> 1] = pk2(kprev, kt); else kprev = kt;
        if (FULL) { const float qv = bf2f((unsigned short)rq[j]);
            *(LAS unsigned short*)(lds + L_KT + (t * HP + d) * 2) = f2bf(kt);
            *(LAS unsigned short*)(lds + L_QT + (t * HP + d) * 2) = f2bf(qv * __expf(b - r));
            *(LAS unsigned short*)(lds + L_QH + (t * HP + d) * 2) = f2bf(qv * __expf(b)); } }
    if (!FULL) { LAS u32x4v* dst = (LAS u32x4v*)(lds + L_KTT + (d * TPI + t0) * 2); u32x4v a, b; a.x = ktp[0]; a.y = ktp[1]; a.z = ktp[2]; a.w = ktp[3]; b.x = ktp[4]; b.y = ktp[5]; b.z = ktp[6]; b.w = ktp[7]; dst[0] = a; dst[1] = b; }
    __syncthreads();
}
#define MFMA16(a, b, c) __builtin_amdgcn_mfma_f32_16x16x32_bf16((a), (b), (c), 0, 0, 0)
#define MFMA32(a, b, c) __builtin_amdgcn_mfma_f32_32x32x16_bf16((a), (b), (c), 0, 0, 0)
DI void hgrn_b1_all(const Prm& p, LAS unsigned char* lds, int tid, int lane, int wave) {
    const int fr = lane & 15, fq = lane >> 4;
    int item = blockIdx.x; if (item >= NITEM_H) return;
    unsigned rl[16], rv[16], rq[16];
    hgrn_loadraw<false>(p, hgrn_item(item), tid, rl, rv, rq);
    while (item < NITEM_H) {
        const HItem it = hgrn_item(item);
        hgrn_prep<false>(it, lds, tid, rl, rv, rq);
        const int next = item + gridDim.x;
        if (next < NITEM_H) hgrn_loadraw<false>(p, hgrn_item(next), tid, rl, rv, rq);
        const LAS float* vec = (const LAS float*)(lds + L_VEC);
        bf16x8 a[2];
#pragma unroll
        for (int ks = 0; ks < 2; ++ks) a[ks] = *(const LAS bf16x8*)(lds + L_KTT + ((16 * wave + fr) * TPI + 32 * ks + 8 * fq) * 2);
        float e2[4];
#pragma unroll
        for (int j = 0; j < 4; ++j) { const int d = 16 * wave + 4 * fq + j; e2[j] = __expf(vec[128 + d] - vec[d]); }
#pragma unroll
        for (int vt = 0; vt < 8; ++vt) { f32x4 acc = {0.f, 0.f, 0.f, 0.f};
#pragma unroll
            for (int ks = 0; ks < 2; ++ks) { const bf16x8 b = *(const LAS bf16x8*)(lds + L_IVT + ((16 * vt + fr) * TPI + 32 * ks + 8 * fq) * 2); acc = MFMA16(a[ks], b, acc); }
            u32x2 o; o.x = pk2(acc[0] * e2[0], acc[1] * e2[1]); o.y = pk2(acc[2] * e2[2], acc[3] * e2[3]);
            *(u32x2*)(p.UT + (size_t)item * 16384 + (16 * vt + fr) * 128 + 16 * wave + 4 * fq) = o; }
        if (tid < 128) p.AL[(size_t)item * 128 + tid] = __expf(vec[128 + tid]);
        __syncthreads();
        item = next;
    }
}
template <int NB> DI void hgrn_b2_steps(const Prm& p, int item, int v, int d4, float (&S)[4]) {
    u32x2 uu[NB]; f32x4 al[NB];
#pragma unroll
    for (int i = 0; i < NB; ++i) { uu[i] = *(const u32x2*)(p.UT + (size_t)(item + i) * 16384 + v * 128 + d4); al[i] = *(const f32x4*)(p.AL + (size_t)(item + i) * 128 + d4); }
#pragma unroll
    for (int i = 0; i < NB; ++i) { u32x2 o; o.x = pk2(S[0], S[1]); o.y = pk2(S[2], S[3]);
        *(u32x2*)(p.UT + (size_t)(item + i) * 16384 + v * 128 + d4) = o;
        S[0] = al[i][0] * S[0] + bflo(uu[i].x); S[1] = al[i][1] * S[1] + bfhi(uu[i].x); S[2] = al[i][2] * S[2] + bflo(uu[i].y); S[3] = al[i][3] * S[3] + bfhi(uu[i].y); }
}
DI void hgrn_b2(const Prm& p, int gtid, int GT) {
    for (int idx = gtid; idx < 64 * 4096; idx += GT) {
        const int bhx = idx >> 12, e = idx & 4095, v = e >> 5, d4 = (e & 31) * 4; const bool smp = bhx >= 32;
        float S[4] = {0.f, 0.f, 0.f, 0.f};
        if (smp) {
#pragma unroll
            for (int j = 0; j < 4; ++j) S[j] = p.state_hgrn[((size_t)(bhx - 32) * 128 + d4 + j) * 128 + v];
            hgrn_b2_steps<1>(p, 2080 + (bhx - 32), v, d4, S); }
        else { for (int c0 = 0; c0 < 65; c0 += 13) hgrn_b2_steps<13>(p, bhx * 65 + c0, v, d4, S); }
        float* dst = p.out + (smp ? O_HGS + (size_t)(bhx - 32) * 16384 : O_HGP + (size_t)bhx * 16384);
#pragma unroll
        for (int j = 0; j < 4; ++j) dst[(d4 + j) * 128 + v] = S[j];
    }
}
DI void hgrn_b3_all(const Prm& p, LAS unsigned char* lds, int tid, int lane, int wave) {
    const int fr = lane & 15, fq = lane >> 4;
    int item = blockIdx.x; if (item >= NITEM_H) return;
    unsigned rl[16], rv[16], rq[16];
    hgrn_loadraw<true>(p, hgrn_item(item), tid, rl, rv, rq);
    const int nt_ = tid >> 3, nsg = tid & 7;
    while (item < NITEM_H) {
        const HItem it = hgrn_item(item);
        bf16x8 sf[4][4];
#pragma unroll
        for (int i = 0; i < 4; ++i)
#pragma unroll
            for (int ks = 0; ks < 4; ++ks) sf[i][ks] = *(const bf16x8*)(p.UT + (size_t)item * 16384 + (16 * (4 * (wave >> 2) + i) + fr) * 128 + 32 * ks + 8 * fq);
        const size_t grow = (size_t)(it.row0 + (nt_ < it.L ? nt_ : 0)); const int gc0 = it.h * 128 + 16 * nsg;
        const u32x4v g0 = *(const u32x4v*)(p.GS + grow * 512 + gc0), g1 = *(const u32x4v*)(p.GS + grow * 512 + gc0 + 8);
        hgrn_prep<true>(it, lds, tid, rl, rv, rq);
        const int next = item + gridDim.x;
        if (next < NITEM_H) hgrn_loadraw<true>(p, hgrn_item(next), tid, rl, rv, rq);
        {
            const int tt = wave >> 1;
#pragma unroll
            for (int i = 0; i < 2; ++i) { const int st = 2 * (wave & 1) + i; f32x4 acc = {0.f, 0.f, 0.f, 0.f};
#pragma unroll
                for (int ks = 0; ks < 4; ++ks) { const bf16x8 a = *(const LAS bf16x8*)(lds + L_KT + ((16 * st + fr) * HP + 32 * ks + 8 * fq) * 2);
                    const bf16x8 b = *(const LAS bf16x8*)(lds + L_QT + ((16 * tt + fr) * HP + 32 * ks + 8 * fq) * 2); acc = MFMA16(a, b, acc); }
                const int t = 16 * tt + fr, s0 = 16 * st + 4 * fq;
                u32x2 o; o.x = pk2(s0 <= t ? acc[0] : 0.f, s0 + 1 <= t ? acc[1] : 0.f); o.y = pk2(s0 + 2 <= t ? acc[2] : 0.f, s0 + 3 <= t ? acc[3] : 0.f);
                *(LAS u32x2*)(lds + L_ATT + (t * TPI + s0) * 2) = o; }
        }
        __syncthreads();
        f32x4 oacc[4];
        {   const int tt = wave & 3;
            bf16x8 aa[2], aq[4];
#pragma unroll
            for (int ks = 0; ks < 2; ++ks) aa[ks] = *(const LAS bf16x8*)(lds + L_ATT + ((16 * tt + fr) * TPI + 32 * ks + 8 * fq) * 2);
#pragma unroll
            for (int ks = 0; ks < 4; ++ks) aq[ks] = *(const LAS bf16x8*)(lds + L_QH + ((16 * tt + fr) * HP + 32 * ks + 8 * fq) * 2);
#pragma unroll
            for (int i = 0; i < 4; ++i) { const int vt = 4 * (wave >> 2) + i; f32x4 acc = {0.f, 0.f, 0.f, 0.f};
#pragma unroll
                for (int ks = 0; ks < 2; ++ks) { const bf16x8 b = *(const LAS bf16x8*)(lds + L_IVT + ((16 * vt + fr) * TPI + 32 * ks + 8 * fq) * 2); acc = MFMA16(aa[ks], b, acc); }
#pragma unroll
                for (int ks = 0; ks < 4; ++ks) acc = MFMA16(aq[ks], sf[i][ks], acc);
                oacc[i] = acc; }
        }
        f32x4 gn[4];
#pragma unroll
        for (int j = 0; j < 4; ++j) gn[j] = ((const f32x4*)(p.hgrn_norm + 16 * nsg))[j];
        __syncthreads();
        {   const int tt = wave & 3; LAS float* ob = (LAS float*)(lds + L_OB);
#pragma unroll
            for (int i = 0; i < 4; ++i) { const int v = 16 * (4 * (wave >> 2) + i) + fr;
#pragma unroll
                for (int j = 0; j < 4; ++j) ob[(16 * tt + 4 * fq + j) * 132 + v] = oacc[i][j]; }
        }
        __syncthreads();
        {   const int t = nt_, sg = nsg; const LAS float* ob = (const LAS float*)(lds + L_OB) + t * 132 + 16 * sg;
            f32x4 x[4]; float ss = 0.f;
#pragma unroll
            for (int j = 0; j < 4; ++j) { x[j] = ((const LAS f32x4*)ob)[j]; ss += (x[j].x * x[j].x + x[j].y * x[j].y) + (x[j].z * x[j].z + x[j].w * x[j].w); }
            ss += __shfl_xor(ss, 1); ss += __shfl_xor(ss, 2); ss += __shfl_xor(ss, 4);
            const float rr = rsqrtf(ss * (1.f / 128.f) + EPSN);
            if (t < it.L) { const size_t row = it.row0 + t; const int c0 = it.h * 128 + 16 * sg;
                const f32x4 n0 = gn[0], n1 = gn[1], n2 = gn[2], n3 = gn[3];
                u32x4v o0, o1;
                o0.x = pk2(x[0].x * rr * n0.x * bflo(g0.x), x[0].y * rr * n0.y * bfhi(g0.x)); o0.y = pk2(x[0].z * rr * n0.z * bflo(g0.y), x[0].w * rr * n0.w * bfhi(g0.y));
                o0.z = pk2(x[1].x * rr * n1.x * bflo(g0.z), x[1].y * rr * n1.y * bfhi(g0.z)); o0.w = pk2(x[1].z * rr * n1.z * bflo(g0.w), x[1].w * rr * n1.w * bfhi(g0.w));
                o1.x = pk2(x[2].x * rr * n2.x * bflo(g1.x), x[2].y * rr * n2.y * bfhi(g1.x)); o1.y = pk2(x[2].z * rr * n2.z * bflo(g1.y), x[2].w * rr * n2.w * bfhi(g1.y));
                o1.z = pk2(x[3].x * rr * n3.x * bflo(g1.z), x[3].y * rr * n3.y * bfhi(g1.z)); o1.w = pk2(x[3].z * rr * n3.z * bflo(g1.w), x[3].w * rr * n3.w * bfhi(g1.w));
                *(u32x4v*)(p.CAT + row * 1024 + c0) = o0; *(u32x4v*)(p.CAT + row * 1024 + c0 + 8) = o1; }
        }
        __syncthreads();
        item = next;
    }
}
DI void s5_load_u(const Prm& p, int mt, int g, int lane, bf16x8 (&uf)[8]) {
    const int fr = lane & 15, fq = lane >> 4; int col = 16 * mt + fr; if (col >= NCOL) col = NCOL - 1;
#pragma unroll
    for (int ks = 0; ks < 8; ++ks) uf[ks] = *(const bf16x8*)(p.U + ((size_t)(16 * col + 2 * ks + (fq >> 1))) * 512 + 16 * g + 8 * (fq & 1));
}
DI void s5_b(const Prm& p, int gw, int NGW, int lane) {
    const int fr = lane & 15, fq = lane >> 4;
    for (int task = gw; task < 131 * 32; task += NGW) { const int mt = task >> 5, g = task & 31;
        bf16x8 uf[8]; s5_load_u(p, mt, g, lane, uf);
#pragma unroll
        for (int nt = 0; nt < 8; ++nt) { f32x4 acc = {0.f, 0.f, 0.f, 0.f};
#pragma unroll
            for (int ks = 0; ks < 8; ++ks) { const bf16x8 b = *(const bf16x8*)(p.HT + ((size_t)(g * 128 + 16 * nt + fr)) * 256 + 32 * ks + 8 * fq); acc = MFMA16(uf[ks], b, acc); }
#pragma unroll
            for (int j = 0; j < 4; ++j) { const int col = 16 * mt + 4 * fq + j; if (col < NCOL) p.XLOC[(size_t)col * 4096 + g * 128 + 16 * nt + fr] = acc[j]; } }
    }
}
template <int NB> DI void s5_c_steps(const Prm& p, int col, size_t base, float ar, float ai, float& xr, float& xi) {
    f32x2v xl[NB];
#pragma unroll
    for (int i = 0; i < NB; ++i) xl[i] = *(const f32x2v*)(p.XLOC + (size_t)(col + i) * 4096 + base);
#pragma unroll
    for (int i = 0; i < NB; ++i) { *(unsigned*)(p.XPREV + (size_t)(col + i) * 4096 + base) = pk2(xr, xi);
        const float nr = ar * xr - ai * xi + xl[i].x, ni = ar * xi + ai * xr + xl[i].y; xr = nr; xi = ni; }
}
DI void s5_c(const Prm& p, int gtid) {
    if (gtid >= 16 * 2048) return;
    const int seq = gtid >> 11, g = (gtid >> 6) & 31, n = gtid & 63; const bool smp = seq >= 8; const int b = seq & 7;
    float xr = 0.f, xi = 0.f; if (smp) { xr = p.ssm_re0[(b * 32 + g) * 64 + n]; xi = p.ssm_im0[(b * 32 + g) * 64 + n]; }
    const float ar = p.A16[2 * (g * 64 + n)], ai = p.A16[2 * (g * 64 + n) + 1];
    const size_t base = (size_t)g * 128 + 2 * n;
    if (smp) s5_c_steps<4>(p, 2056 + 4 * b, base, ar, ai, xr, xi);
    else { for (int c0 = 0; c0 < 256; c0 += 16) s5_c_steps<16>(p, 257 * b + c0, base, ar, ai, xr, xi); s5_c_steps<1>(p, 257 * b + 256, base, ar, ai, xr, xi); }
    const size_t o = (size_t)(b * 32 + g) * 64 + n;
    p.out[(smp ? O_SRS : O_SRP) + o] = xr; p.out[(smp ? O_SIS : O_SIP) + o] = xi;
}
DI f32x2v gelu_pk(f32x2v v) {
    const f32x2v av = __builtin_elementwise_abs(v), d = av * 0.2316418882f + 1.0f;
    f32x2v t; t.x = __builtin_amdgcn_rcpf(d.x); t.y = __builtin_amdgcn_rcpf(d.y);
    f32x2v q = t * 0.5307027145f + (-0.7265760135f); q = q * t + 0.7107068705f; q = q * t + (-0.142248368f); q = q * t + 0.127414796f; q = q * t;
    const f32x2v s = (v * v) * (-0.72134752044f);
    f32x2v e; e.x = __builtin_amdgcn_exp2f(s.x); e.y = __builtin_amdgcn_exp2f(s.y);
    const f32x2v m = v * (q * e), r = v - m;
    f32x2v o; o.x = v.x < 0.f ? m.x : r.x; o.y = v.y < 0.f ? m.y : r.y; return o;
}
DI void s5_d(const Prm& p, int gw, int NGW, int lane) {
    const int fr = lane & 15, fq = lane >> 4;
    for (int task = gw; task < 131 * 32; task += NGW) { const int mt = task >> 5, g = task & 31;
        bf16x8 uf[8], xf[4]; s5_load_u(p, mt, g, lane, uf);
        int colc = 16 * mt + fr; if (colc >= NCOL) colc = NCOL - 1;
#pragma unroll
        for (int ks = 0; ks < 4; ++ks) xf[ks] = *(const bf16x8*)(p.XPREV + (size_t)colc * 4096 + g * 128 + 32 * ks + 8 * fq);
        const bf16_t* tg = p.TG + ((size_t)(g * 256 + fr)) * 384 + 8 * fq;
        const bool ok = 16 * mt + fr < NCOL;
#pragma unroll
        for (int t = 0; t < 16; ++t) { f32x4 acc = {0.f, 0.f, 0.f, 0.f};
#pragma unroll
            for (int ks = 0; ks < 8; ++ks) if (ks <= (t >> 1)) { const bf16x8 a = *(const bf16x8*)(tg + (size_t)t * 16 * 384 + 32 * ks); acc = MFMA16(a, uf[ks], acc); }
#pragma unroll
            for (int ks = 0; ks < 4; ++ks) { const bf16x8 a = *(const bf16x8*)(tg + (size_t)t * 16 * 384 + 256 + 32 * ks); acc = MFMA16(a, xf[ks], acc); }
            const f32x2v y0 = gelu_pk((f32x2v){acc[0], acc[1]}), y1 = gelu_pk((f32x2v){acc[2], acc[3]});
            u32x2 o; o.x = pk2(y0.x, y0.y); o.y = pk2(y1.x, y1.y);
            if (ok) *(u32x2*)(p.YG + ((size_t)(16 * (16 * mt + fr) + t)) * 512 + 16 * g + 4 * fq) = o; }
    }
}

DI void s5_b_lds(const Prm& p, LAS unsigned char* lds, int tid, int lane, int wave) {
    const int fr = lane & 15, fq = lane >> 4;
    for (int gp = blockIdx.x; gp < 256; gp += gridDim.x) { const int g = gp & 31, part = gp >> 5;
        for (int i = tid; i < 128 * 32; i += 512) { const int row = i >> 5, ch = i & 31;
            *(LAS u32x4v*)(lds + row * 528 + ch * 16) = *(const u32x4v*)(p.HT + ((size_t)(g * 128 + row)) * 256 + ch * 8); }
        __syncthreads();
        for (int mt = part + 8 * wave; mt < 131; mt += 64) {
            bf16x8 uf[8]; s5_load_u(p, mt, g, lane, uf);
#pragma unroll 1
            for (int nt = 0; nt < 8; ++nt) { f32x4 acc = {0.f, 0.f, 0.f, 0.f};
#pragma unroll
                for (int ks = 0; ks < 8; ++ks) { const bf16x8 b = *(const LAS bf16x8*)(lds + (16 * nt + fr) * 528 + 64 * ks + 16 * fq); acc = MFMA16(uf[ks], b, acc); }
#pragma unroll
                for (int j = 0; j < 4; ++j) { const int col = 16 * mt + 4 * fq + j; if (col < NCOL) p.XLOC[(size_t)col * 4096 + g * 128 + 16 * nt + fr] = acc[j]; } }
        }
        __syncthreads(); }
}
DI void s5_d_lds(const Prm& p, LAS unsigned char* lds, int tid, int lane, int wave) {
    const int fr = lane & 15, fq = lane >> 4;
    for (int gp = blockIdx.x; gp < 256; gp += gridDim.x) { const int g = gp & 31, part = gp >> 5;
        { const int row = tid >> 1, hf = tid & 1;
            *(LAS u32x4v*)(lds + row * 48 + hf * 16) = *(const u32x4v*)(p.TG + ((size_t)(g * 256 + row)) * 16 + hf * 8); }
        for (int i = tid; i < 256 * 16; i += 512) { const int row = i >> 4, ch = i & 15;
            *(LAS u32x4v*)(lds + 12288 + row * 272 + ch * 16) = *(const u32x4v*)(p.TG + 131072 + ((size_t)(g * 256 + row)) * 128 + ch * 8); }
        __syncthreads();
        const int lb = fr * 48 + (fq & 1) * 16, hi = fq >> 1;
        for (int mt = part + 8 * wave; mt < 131; mt += 64) {
            bf16x8 uf[8], xf[4]; s5_load_u(p, mt, g, lane, uf);
            int colc = 16 * mt + fr; if (colc >= NCOL) colc = NCOL - 1;
#pragma unroll
            for (int ks = 0; ks < 4; ++ks) xf[ks] = *(const bf16x8*)(p.XPREV + (size_t)colc * 4096 + g * 128 + 32 * ks + 8 * fq);
            const bool ok = 16 * mt + fr < NCOL;
#pragma unroll 1
            for (int t = 0; t < 16; ++t) { f32x4 acc = {0.f, 0.f, 0.f, 0.f};
#pragma unroll
                for (int ks = 0; ks < 8; ++ks) if (ks <= (t >> 1)) {
                    const int tau = t - 2 * ks - hi;
                    union { bf16x8 v; u32x4v u; } a; a.v = *(const LAS bf16x8*)(lds + (tau < 0 ? 0 : tau) * 768 + lb);
                    if (tau < 0) a.u = (u32x4v){0u, 0u, 0u, 0u};
                    acc = MFMA16(a.v, uf[ks], acc); }
#pragma unroll
                for (int ks = 0; ks < 4; ++ks) { const bf16x8 a = *(const LAS bf16x8*)(lds + 12288 + (t * 16 + fr) * 272 + 64 * ks + 16 * fq); acc = MFMA16(a, xf[ks], acc); }
                const f32x2v y0 = gelu_pk((f32x2v){acc[0], acc[1]}), y1 = gelu_pk((f32x2v){acc[2], acc[3]});
                u32x2 o; o.x = pk2(y0.x, y0.y); o.y = pk2(y1.x, y1.y);
                if (ok) *(u32x2*)(p.YG + ((size_t)(16 * (16 * mt + fr) + t)) * 512 + 16 * g + 4 * fq) = o; }
        }
        __syncthreads(); }
}
DI void cache_convert(const Prm& p, int gtid, int GT) {
    for (size_t i = (size_t)gtid; i < (size_t)8 * 1024 * 256; i += (size_t)GT) {
        const size_t row = i >> 8; const int c4 = (int)(i & 255) * 4, b = (int)(row >> 10), pos = (int)(row & 1023), h = c4 >> 7, d = c4 & 127;
        const f32x4 k = *(const f32x4*)(p.cache_k + row * 1024 + c4); u32x2 o; o.x = pk2(k.x, k.y); o.y = pk2(k.z, k.w);
        *(u32x2*)(p.KS + kf_index(b * 8 + h, 34, pos, d)) = o;
        const f32x4 v = *(const f32x4*)(p.cache_v + row * 1024 + c4); bf16_t* vt = p.VTS + vf_index(b * 8 + h, 34, pos, d);
        vt[0] = f2bf(v.x); vt[8] = f2bf(v.y); vt[16] = f2bf(v.z); vt[24] = f2bf(v.w); }
}
DI void attn_phase(const Prm& p, LAS unsigned char* lds, int wave, int gw, int NGW, int lane) {
    const int q = lane & 31, half = lane >> 5;
    LAS unsigned char* wl = lds + wave * 16384;
    for (int it = gw; it < 8256 + 128; it += NGW) {
        bool smp; int b, h, qb;
        if (it < 8064) { smp = false; b = it / 1008; const int rem = it - b * 1008; h = rem / 126; qb = 3 + rem - h * 126; }
        else if (it < 8192) { const int s = it - 8064; smp = true; b = s >> 4; h = (s >> 1) & 7; qb = s & 1; }
        else { const int s = it - 8192; smp = false; b = s / 24; const int rem = s - b * 24; h = rem / 3; qb = rem - h * 3; }
        const size_t tbase = (size_t)(b * 8 + h) * (smp ? 34 : 129) * 4096 + lane * 8;
        const bf16_t* Kb = (smp ? p.KS : p.KP) + tbase; const bf16_t* Vb = (smp ? p.VTS : p.VTP) + tbase;
        const int qpos0 = (smp ? 1024 : 0) + 32 * qb, qrow0 = smp ? NTP + b * 64 + 32 * qb : b * TP + 32 * qb;
        const int qpos = qpos0 + q; const bool qvalid = smp || qpos < TP; const size_t qrow = qvalid ? qrow0 + q : qrow0;
        bf16x8 qf[8];
#pragma unroll
        for (int ks = 0; ks < 8; ++ks) qf[ks] = *(const bf16x8*)(p.Q + qrow * 1024 + h * 128 + 16 * ks + 8 * half);
        f32x16 o[4];
#pragma unroll
        for (int db = 0; db < 4; ++db)
#pragma unroll
            for (int e = 0; e < 16; ++e) o[db][e] = 0.f;
        float C = 1.f;
        for (int kt = (qpos0 + 30) >> 5; kt >= 0; --kt) {
            f32x16 s;
#pragma unroll
            for (int e = 0; e < 16; ++e) s[e] = 0.f;
            const bf16_t* kr = Kb + (size_t)kt * 4096; const bf16_t* vr = Vb + (size_t)kt * 4096;
            bf16x8 kf[8], vf[8];
#pragma unroll
            for (int ks = 0; ks < 8; ++ks) kf[ks] = *(const bf16x8*)(kr + ks * 512);
#pragma unroll
            for (int ks = 0; ks < 8; ++ks) vf[ks] = *(const bf16x8*)(vr + ks * 512);
#pragma unroll
            for (int ks = 0; ks < 8; ++ks) s = MFMA32(kf[ks], qf[ks], s);
            float pr[16], be[16], G[4], Gp[4];
#pragma unroll
            for (int i = 0; i < 4; ++i) {
#pragma unroll
                for (int j = 0; j < 4; ++j) { const int key = 32 * kt + 8 * i + 4 * half + j; const bool valid = key < qpos;
                    float z = s[4 * i + j] * 0.08838834764831845f; z = fminf(fmaxf(z, -80.f), 80.f);
                    const float e = __expf(z), pp = __builtin_amdgcn_rcpf(1.f + e); pr[4 * i + j] = valid ? pp : 1.f; be[4 * i + j] = valid ? e * pp : 0.f; }
                G[i] = (pr[4 * i] * pr[4 * i + 1]) * (pr[4 * i + 2] * pr[4 * i + 3]); }
#pragma unroll
            for (int i = 0; i < 4; ++i) Gp[i] = __shfl_xor(G[i], 32);
            float w[16]; float E1 = 1.f;
#pragma unroll
            for (int i = 3; i >= 0; --i) { const float Glo = half ? Gp[i] : G[i], Ghi = half ? G[i] : Gp[i];
                float suf = C * (half ? E1 : E1 * Ghi);
#pragma unroll
                for (int j = 3; j >= 0; --j) { w[4 * i + j] = be[4 * i + j] * suf; suf *= pr[4 * i + j]; }
                E1 *= Glo * Ghi; }
            C *= E1;
#pragma unroll
            for (int c = 0; c < 2; ++c) { union { bf16x8 v; unsigned u[4]; } wf;
#pragma unroll
                for (int e = 0; e < 4; ++e) wf.u[e] = pk2(w[8 * c + 2 * e], w[8 * c + 2 * e + 1]);
#pragma unroll
                for (int db = 0; db < 4; ++db) o[db] = MFMA32(vf[4 * c + db], wf.v, o[db]); }
            if (__all(C < 1e-24f)) break;
        }
#pragma unroll
        for (int db = 0; db < 4; ++db)
#pragma unroll
            for (int i = 0; i < 4; ++i) { u32x2 ov; ov.x = pk2(o[db][4 * i], o[db][4 * i + 1]); ov.y = pk2(o[db][4 * i + 2], o[db][4 * i + 3]);
                *(LAS u32x2*)(wl + q * 272 + (32 * db + 8 * i + 4 * half) * 2) = ov; }
#pragma unroll
        for (int k = 0; k < 8; ++k) { const int r = (lane >> 4) + 4 * k, ch = lane & 15;
            const u32x4v v = *(const LAS u32x4v*)(wl + r * 272 + ch * 16);
            if (smp || qpos0 + r < TP) *(u32x4v*)(p.O + (size_t)(qrow0 + r) * 1024 + h * 128 + ch * 8) = v; }
    }
}
DI void final_norm(const Prm& p, int gw, int NGW, int lane) {
    for (int r = gw; r < 32768 + 512; r += NGW) {
        int grow; float* dst;
        if (r < 32768) { const int b = r >> 12, t = r & 4095; grow = b * TP + 16 + t; dst = p.out + O_YP + (size_t)r * 1024; } else { grow = NTP + (r - 32768); dst = p.out + O_YS + (size_t)(r - 32768) * 1024; }
        u32x2 x[4];
#pragma unroll
        for (int j = 0; j < 4; ++j) x[j] = ((const u32x2*)(p.XB + (size_t)grow * 1024))[lane + 64 * j];
        const float rr = row_rinv(p.SSQ, grow);
#pragma unroll
        for (int j = 0; j < 4; ++j) { f32x4 v; v.x = bflo(x[j].x); v.y = bfhi(x[j].x); v.z = bflo(x[j].y); v.w = bfhi(x[j].y); ((f32x4*)dst)[lane + 64 * j] = v * rr * ((const f32x4*)p.ln_final)[lane + 64 * j]; }
    }
}

#define XB_TMO      128
#define XB_XCNT(j)  (256  + 64 * (j))
#define XB_XSUB(j)  (1280 + 64 * (j))
#define XB_XGEN(j)  (2304 + 64 * (j))
#define XB_TOP      3328
#define XB_TOPGEN   3392
#define XCD_BAR_WORDS 3456
#define XB_SPIN_CAP (1u << 18)
DI unsigned xb_ld(unsigned* p) { return __hip_atomic_load(p, __ATOMIC_RELAXED, __HIP_MEMORY_SCOPE_AGENT); }
DI unsigned xb_add(unsigned* p, unsigned v) { return __hip_atomic_fetch_add(p, v, __ATOMIC_RELAXED, __HIP_MEMORY_SCOPE_AGENT); }
DI unsigned xb_xcc_id() { return (unsigned)__builtin_amdgcn_s_getreg((3 << 11) | 20) & 0xFu; }
#define XB_SPIN(cond, bar) do { unsigned _sp = 0; while (cond) { __builtin_amdgcn_s_sleep(1); \
    if ((++_sp & 255u) == 0u) { if (xb_ld(&(bar)[XB_TMO])) break; if (_sp > XB_SPIN_CAP) { atomicAdd(&(bar)[XB_TMO], 1u); break; } } } } while (0)
struct XcdBarrier { unsigned* bar; unsigned x; volatile LAS unsigned* st; };
DI XcdBarrier xcd_barrier_post(unsigned* bar, volatile LAS unsigned* st) {
    XcdBarrier b; b.bar = bar; b.x = xb_xcc_id(); b.st = st;
    if (threadIdx.x == 0) (void)xb_add(&bar[XB_XCNT(b.x)], 1u);
    return b;
}
DI void xcd_barrier_complete(unsigned* bar, unsigned x, unsigned& nloc, unsigned& nx) {
    const unsigned G = gridDim.x * gridDim.y * gridDim.z;
    unsigned sum, cnt, mine, sp = 0u;
    for (;;) {
        sum = 0u; cnt = 0u; mine = 0u;
#pragma unroll
        for (unsigned j = 0; j < 16; ++j) { const unsigned c = xb_ld(&bar[XB_XCNT(j)]); sum += c; cnt += (c > 0u) ? 1u : 0u; mine = (j == x) ? c : mine; }
        if (sum == G) break;
        __builtin_amdgcn_s_sleep(1);
        if ((++sp & 255u) == 0u) { if (xb_ld(&bar[XB_TMO])) break; if (sp > XB_SPIN_CAP) { atomicAdd(&bar[XB_TMO], 1u); break; } }
    }
    nloc = mine > 0u ? mine : 1u; nx = cnt > 0u ? cnt : 1u;
}
DI void xcd_barrier(const XcdBarrier& b) {
    asm volatile("s_waitcnt vmcnt(0)" ::: "memory");
    __syncthreads();
    if (threadIdx.x == 0) {
        unsigned* bar = b.bar;
        __builtin_amdgcn_s_waitcnt(0);
        unsigned nloc = b.st[0], nx = b.st[1];
        if (nloc == 0u) { xcd_barrier_complete(bar, b.x, nloc, nx); b.st[0] = nloc; b.st[1] = nx; }
        const unsigned old = xb_add(&bar[XB_XSUB(b.x)], 1u);
        const unsigned gen = old / nloc;
        if (old + 1u == (gen + 1u) * nloc) {
            __builtin_amdgcn_fence(__ATOMIC_RELEASE, "agent");
            asm volatile("s_waitcnt vmcnt(0)" ::: "memory");
            const unsigned og = xb_add(&bar[XB_TOP], 1u);
            const unsigned tg = og / nx;
            if (og + 1u == (tg + 1u) * nx) xb_add(&bar[XB_TOPGEN], 1u);
            else XB_SPIN(xb_ld(&bar[XB_TOPGEN]) == tg, bar);
            __builtin_amdgcn_fence(__ATOMIC_ACQUIRE, "agent");
            xb_add(&bar[XB_XGEN(b.x)], 1u);
            asm volatile("s_waitcnt vmcnt(0)" ::: "memory");
        } else {
            XB_SPIN(xb_ld(&bar[XB_XGEN(b.x)]) == gen, bar);
            __builtin_amdgcn_fence(__ATOMIC_ACQUIRE, "agent");
            asm volatile("s_waitcnt vmcnt(0)" ::: "memory");
        }
    }
    __syncthreads();
}
constexpr int LDS_BYTES = 131072 + 256 + 8192;
__global__ void __launch_bounds__(512, 2) fwd_megakernel(Prm p) {
    extern __shared__ __attribute__((aligned(16))) unsigned char shm[];
    LAS unsigned char* lds = (LAS unsigned char*)shm;
    cg::grid_group grid = cg::this_grid();
    const int tid = threadIdx.x, lane = tid & 63, wave = __builtin_amdgcn_readfirstlane(tid >> 6);
    const int gw = blockIdx.x * 8 + wave, NGW = gridDim.x * 8, gtid = blockIdx.x * 512 + tid, GT = gridDim.x * 512;
    volatile LAS unsigned* xst = (volatile LAS unsigned*)(lds + 131072);
    if (tid == 0) { xst[0] = 0u; xst[1] = 0u; }
    __syncthreads();
    const XcdBarrier xb = xcd_barrier_post(p.BAR, xst);
    phase_prologue(p, lds, tid, lane, wave);
    xcd_barrier(xb);
    if (p.out == nullptr) grid.sync();
    { EpiIn0 E; E.SSQ = p.SSQ; E.RINV = p.RINV; E.LB = p.LB; E.Qh = p.Qh; E.IV = p.IV; E.GS = p.GS; E.U = p.U; E.LOGF = p.LOGF; run_gemm(lds, p.XB, p.Wt1, 2560, 1024, E); }
    xcd_barrier(xb);
    hgrn_b1_all(p, lds, tid, lane, wave);
    s5_b_lds(p, lds, tid, lane, wave);
    xcd_barrier(xb);
    if (gridDim.x == 256) {
        if (blockIdx.x < 192) hgrn_b2(p, gtid, 192 * 512); else s5_c(p, (int)(blockIdx.x - 192) * 512 + tid); }
    else { hgrn_b2(p, gtid, GT); s5_c(p, gtid); }
    xcd_barrier(xb);
    hgrn_b3_all(p, lds, tid, lane, wave);
    s5_d_lds(p, lds, tid, lane, wave);
    xcd_barrier(xb);
    { EpiGlu E; E.YG = p.YG; E.CAT = p.CAT; run_gemm(lds, p.YG, p.Wglu, 512, 512, E); }
    xcd_barrier(xb);
    { EpiRes E; E.XB = p.XB; E.SSQ = p.SSQ; run_gemm_split(lds, p.CAT, p.Wo0, 1024, 1024, E, (float*)p.H); xcd_barrier(xb); gemm_fixup(1024, 1024, E, (const float*)p.H, tid); rinv_pass(p, 1024, tid); }
    xcd_barrier(xb);
    { EpiUp E; E.SSQ = p.SSQ; E.RINV = p.RINV; E.H = p.H; run_gemm(lds, p.XB, p.Wup0, 4096, 1024, E); }
    xcd_barrier(xb);
    { EpiRes E; E.XB = p.XB; E.SSQ = p.SSQ; run_gemm_split(lds, p.H, p.Wdn0, 1024, 4096, E, (float*)p.CAT); xcd_barrier(xb); gemm_fixup(1024, 4096, E, (const float*)p.CAT, tid); rinv_pass(p, 4096, tid); }
    xcd_barrier(xb);
    { EpiQkv E; E.scr = lds + 131328; E.SSQ = p.SSQ; E.RINV = p.RINV; E.out = p.out; E.Q = p.Q; E.KP = p.KP; E.KS = p.KS; E.VTP = p.VTP; E.VTS = p.VTS; run_gemm(lds, p.XB, p.Wqkv, 3072, 1024, E); }
    if (gridDim.x > 36) { if (blockIdx.x >= 36) cache_convert(p, (blockIdx.x - 36) * 512 + tid, (gridDim.x - 36) * 512); } else cache_convert(p, gtid, GT);
    xcd_barrier(xb);
    attn_phase(p, lds, wave, gw, NGW, lane);
    xcd_barrier(xb);
    { EpiRes E; E.XB = p.XB; E.SSQ = p.SSQ; run_gemm_split(lds, p.O, p.Wo1, 1024, 1024, E, (float*)p.H); xcd_barrier(xb); gemm_fixup(1024, 1024, E, (const float*)p.H, tid); rinv_pass(p, 1024, tid); }
    xcd_barrier(xb);
    { EpiUp E; E.SSQ = p.SSQ; E.RINV = p.RINV; E.H = p.H; run_gemm(lds, p.XB, p.Wup1, 4096, 1024, E); }
    xcd_barrier(xb);
    { EpiRes E; E.XB = p.XB; E.SSQ = p.SSQ; run_gemm_split(lds, p.H, p.Wdn1, 1024, 4096, E, (float*)p.CAT); xcd_barrier(xb); gemm_fixup(1024, 4096, E, (const float*)p.CAT, tid); }
    xcd_barrier(xb);
    final_norm(p, gw, NGW, lane);
}

extern "C" void kernel_launch(void* const* d_in, const int* in_sizes, int n_in, void* d_out, int out_size, void* d_ws, size_t ws_size, hipStream_t stream) {
    static int grid_blocks = 0;
    if (grid_blocks == 0) {
        int dev = 0, cus = 0, per_cu = 0;
        hipGetDevice(&dev); hipDeviceGetAttribute(&cus, hipDeviceAttributeMultiprocessorCount, dev);
        if (hipFuncSetAttribute((const void*)fwd_megakernel, hipFuncAttributeMaxDynamicSharedMemorySize, LDS_BYTES) != hipSuccess) fprintf(stderr, "kernel_launch: hipFuncSetAttribute failed\n");
        if (hipOccupancyMaxActiveBlocksPerMultiprocessor(&per_cu, (const void*)fwd_megakernel, 512, LDS_BYTES) != hipSuccess || per_cu < 1) { fprintf(stderr, "kernel_launch: occupancy query says %d\n", per_cu); per_cu = 1; }
        (void)hipGetLastError();
        grid_blocks = cus > 0 ? cus : 256;
    }
    Prm p{};
    const float* const* in = (const float* const*)d_in;
    p.x_prompt = in[0]; p.x_sample = in[1]; p.state_hgrn = in[2]; p.ssm_re0 = in[3]; p.ssm_im0 = in[4]; p.cache_k = in[5]; p.cache_v = in[6]; p.meta = in[7]; p.ln_mix = in[8]; p.ln_mlp = in[9];
    p.ln_final = in[10]; p.w_in_even = in[11]; p.hgrn_lb = in[12]; p.hgrn_norm = in[13]; p.a_re = in[14]; p.a_im = in[15]; p.log_dt = in[16]; p.b_re = in[17]; p.b_im = in[18]; p.c_re = in[19];
    p.c_im = in[20]; p.ssm_d = in[21]; p.w_glu = in[22]; p.w_out_even = in[23]; p.w_in_odd = in[24]; p.w_out_odd = in[25]; p.w_up = in[26]; p.w_down = in[27];
    p.out = (float*)d_out;
    unsigned char* ws = (unsigned char*)d_ws; size_t off = 0;
    auto take = [&](size_t bytes) { unsigned char* r = ws + off; off += (bytes + 255) & ~(size_t)255; return r; };
    p.Wt1 = (bf16_t*)take((size_t)2560 * 1024 * 2); p.Wglu = (bf16_t*)take((size_t)512 * 512 * 2); p.Wo0 = (bf16_t*)take((size_t)1024 * 1024 * 2); p.Wup0 = (bf16_t*)take((size_t)4096 * 1024 * 2);
    p.Wdn0 = (bf16_t*)take((size_t)4096 * 1024 * 2); p.Wqkv = (bf16_t*)take((size_t)3072 * 1024 * 2); p.Wo1 = (bf16_t*)take((size_t)1024 * 1024 * 2); p.Wup1 = (bf16_t*)take((size_t)4096 * 1024 * 2);
    p.Wdn1 = (bf16_t*)take((size_t)4096 * 1024 * 2);
    p.XB = (bf16_t*)take((size_t)MP * 1024 * 2); p.SSQ = (float*)take((size_t)MP * 16 * 4); p.RINV = (float*)take((size_t)MP * 4); p.LB = (float*)take(2048); p.KTAB = (float*)take((size_t)32 * 16 * 256 * 4);
    p.TG = (bf16_t*)take((size_t)32 * 256 * 384 * 2); p.HT = (bf16_t*)take((size_t)32 * 128 * 256 * 2); p.A16 = (float*)take(32 * 64 * 2 * 4); p.BAR = (unsigned*)take(XCD_BAR_WORDS * 4);
    const size_t S0 = off; constexpr size_t SZ512 = (size_t)MP * 512 * 2;
    p.Qh = (bf16_t*)take(SZ512); p.LOGF = (unsigned short*)take(SZ512); p.IV = (bf16_t*)take(SZ512); p.GS = (bf16_t*)take(SZ512); p.U = (bf16_t*)take(SZ512);
    p.UT = (bf16_t*)take((size_t)NITEM_H * 16384 * 2); p.AL = (float*)take((size_t)NITEM_H * 128 * 4);
    p.XLOC = (float*)take(SZ512); p.YG = (bf16_t*)p.XLOC;
    p.XPREV = (bf16_t*)take((size_t)NCOL * 4096 * 2); p.CAT = (bf16_t*)take((size_t)MP * 1024 * 2);
    size_t end = off;
    off = S0; p.H = (bf16_t*)take((size_t)MP * 4096 * 2); if (off > end) end = off;
    off = S0; p.Q = (bf16_t*)take((size_t)MP * 1024 * 2); p.KP = (bf16_t*)take((size_t)64 * 129 * 4096 * 2); p.KS = (bf16_t*)take((size_t)64 * 34 * 4096 * 2);
    p.VTP = (bf16_t*)take((size_t)64 * 129 * 4096 * 2); p.VTS = (bf16_t*)take((size_t)64 * 34 * 4096 * 2); p.O = (bf16_t*)take((size_t)MP * 1024 * 2); if (off > end) end = off;
    if (end > ws_size || n_in != 28 || (size_t)out_size != O_END) { fprintf(stderr, "kernel_launch: workspace/shape mismatch: need %zu have %zu, n_in %d, out %d\n", end, ws_size, n_in, out_size); return; }
    (void)hipMemsetAsync(p.BAR, 0, XCD_BAR_WORDS * 4, stream);
    void* args[] = {&p};
    hipError_t e = hipLaunchCooperativeKernel((const void*)fwd_megakernel, dim3(grid_blocks), dim3(512), args, LDS_BYTES, stream);
    if (e != hipSuccess) fprintf(stderr, "cooperative launch failed: %s (grid %d)\n", hipGetErrorString(e), grid_blocks);
}
```
